# Optimizing an MI355X kernel written in HIP

```python
import jax, jax.numpy as jnp
from jax import lax
import numpy as np

D_MODEL = 1024
BATCH = 16
SEQ = 4096
DEPTH = 1

GRID_W = 64
CTX_LEN = 256
MIX_WIDTH = D_MODEL
RG_WIDTH = MIX_WIDTH // 2
RG_BLOCKS = 8
RG_BLOCK = RG_WIDTH // RG_BLOCKS
RG_C = 8.0
CONV_W = 4
CONV_PAD_L = (CONV_W - 1) // 2
CONV_PAD_R = CONV_W - 1 - CONV_PAD_L
HG_WIDTH = MIX_WIDTH - RG_WIDTH
HG_HEAD = 128
HG_HEADS = HG_WIDTH // HG_HEAD
HG_CHUNK = 64
IN_SIZES = (RG_WIDTH, RG_WIDTH, HG_WIDTH, HG_WIDTH, HG_WIDTH, HG_WIDTH, HG_WIDTH)
N_IN = sum(IN_SIZES)
N_GROUPS = 4
EXPERTS_PER_GROUP = 8
N_EXPERTS = N_GROUPS * EXPERTS_PER_GROUP
TOP_K = 2
D_EXPERT = D_MODEL // 2
MOE_BLOCK = 256
ALPHA = (2.0 * DEPTH) ** 0.25
BETA = (8.0 * DEPTH) ** -0.25
LN_EPS = 1e-6

kernel_name = "hymba_rglru_hgrn2_hmoe_deepnorm_prefix"


def layer_norm(x, g, b):
    xf = x.astype(jnp.float32)
    mu = jnp.mean(xf, axis=-1, keepdims=True)
    var = jnp.mean(jnp.square(xf - mu), axis=-1, keepdims=True)
    return ((xf - mu) * lax.rsqrt(var + LN_EPS) * g.astype(jnp.float32) + b.astype(jnp.float32)).astype(x.dtype)


def modulation(cvec, w, b):
    m = jax.nn.silu(cvec) @ w + b
    return jnp.split(m, 6, axis=-1)


def short_conv(x, w, b):
    L = x.shape[-2]
    pad = [(0, 0)] * (x.ndim - 2) + [(CONV_PAD_L, CONV_PAD_R), (0, 0)]
    xp = jnp.pad(x, pad)
    out = b + xp[..., 0:L, :] * w[0]
    for j in range(1, CONV_W):
        out = out + xp[..., j:j + L, :] * w[j]
    return out


def rglru_scan(xc, gate_w, gate_b, lam, h0):
    B, L, W = xc.shape
    xf = xc.astype(jnp.float32)
    xb = xf.reshape(B, L, RG_BLOCKS, RG_BLOCK)
    gates = jnp.einsum('blnc,gncd->gblnd', xb, gate_w.astype(jnp.float32)).reshape(2, B, L, W)
    gates = gates + gate_b.astype(jnp.float32)[:, None, None, :]
    r = jax.nn.sigmoid(gates[0])
    i = jax.nn.sigmoid(gates[1])
    log_a = -RG_C * r * jax.nn.softplus(-lam.astype(jnp.float32))
    a = jnp.exp(log_a)
    u = jnp.sqrt(-jnp.expm1(2.0 * log_a)) * (i * xf)
    u = u.at[:, 0].add(a[:, 0] * h0)

    def combine(lhs, rhs):
        a1, b1 = lhs
        a2, b2 = rhs
        return a1 * a2, a2 * b1 + b2

    _, h = lax.associative_scan(combine, (a, u), axis=1)
    return h, h[:, -1]


def hgrn2_scan(q, k, v, log_f, s0):
    B, L, H, dk = q.shape
    n = L // HG_CHUNK

    def to_chunks(t):
        return t.reshape(B, n, HG_CHUNK, H, t.shape[-1]).transpose(1, 0, 3, 2, 4)

    causal = jnp.tril(jnp.ones((HG_CHUNK, HG_CHUNK), dtype=bool))[:, :, None]

    def step(S, inp):
        qc, kc, vc, gc = inp
        G = jnp.cumsum(gc, axis=-2)
        o_inter = jnp.einsum('bhtk,bhkv->bhtv', qc * jnp.exp(G), S)
        diff = G[..., :, None, :] - G[..., None, :, :]
        decay = jnp.exp(jnp.where(causal, diff, -jnp.inf))
        A = jnp.einsum('bhtk,bhtsk,bhsk->bhts', qc, decay, kc)
        o = o_inter + jnp.einsum('bhts,bhsv->bhtv', A, vc)
        G_last = G[..., -1:, :]
        S_new = jnp.exp(G_last[..., 0, :])[..., None] * S + jnp.einsum('bhsk,bhsv->bhkv', kc * jnp.exp(G_last - G), vc)
        return S_new, o

    S_fin, o = lax.scan(step, s0, (to_chunks(q), to_chunks(k), to_chunks(v), to_chunks(log_f)))
    o = o.transpose(1, 0, 3, 2, 4).reshape(B, L, H, v.shape[-1])
    return o, S_fin


def token_mixer(u, w_in, conv_w, conv_b, gate_w, gate_b, lam, lb, norm_g, w_out, states, on_grid, with_output):
    B, L, _ = u.shape
    proj = u @ w_in
    split_points = np.cumsum(IN_SIZES)[:-1].tolist()
    rg_x, rg_g, hq, hff, hfb, hi, hg = jnp.split(proj, split_points, axis=-1)
    h0f, h0b, s0f, s0b = states

    if on_grid:
        rows = L // GRID_W
        xc = short_conv(rg_x.reshape(B, rows, GRID_W, RG_WIDTH), conv_w, conv_b).reshape(B, L, RG_WIDTH)
    else:
        xc = short_conv(rg_x, conv_w, conv_b)
    hf, hf_last = rglru_scan(xc, gate_w[0], gate_b[0], lam[0], h0f)
    hb, hb_last = rglru_scan(xc[:, ::-1], gate_w[1], gate_b[1], lam[1], h0b)

    q = jax.nn.silu(hq.astype(jnp.float32)).reshape(B, L, HG_HEADS, HG_HEAD)
    v = hi.astype(jnp.float32).reshape(B, L, HG_HEADS, HG_HEAD)

    def forget(z, lb_d):
        z = z.astype(jnp.float32)
        log_f = jnp.log(lb_d + (1.0 - lb_d) * jax.nn.sigmoid(z))
        k = (1.0 - lb_d) * jax.nn.sigmoid(-z)
        return k.reshape(B, L, HG_HEADS, HG_HEAD), log_f.reshape(B, L, HG_HEADS, HG_HEAD)

    kf, lff = forget(hff, lb[0])
    kb, lfb = forget(hfb, lb[1])
    of, sf = hgrn2_scan(q, kf, v, lff, s0f)
    ob, sb = hgrn2_scan(q[:, ::-1], kb[:, ::-1], v[:, ::-1], lfb[:, ::-1], s0b)
    new_states = (hf_last, hb_last, sf, sb)
    if not with_output:
        return None, new_states

    rg_out = (hf + hb[:, ::-1]) * jax.nn.gelu(rg_g.astype(jnp.float32))
    o = of + ob[:, ::-1]
    o = o * lax.rsqrt(jnp.mean(jnp.square(o), axis=-1, keepdims=True) + LN_EPS)
    hg_out = o.reshape(B, L, HG_WIDTH) * norm_g.astype(jnp.float32) * jax.nn.silu(hg.astype(jnp.float32))
    mixed = jnp.concatenate([rg_out, hg_out], axis=-1).astype(u.dtype)
    return mixed @ w_out, new_states


def hier_moe(t, rg_w, rg_b, re_w, re_b, w1, w3, w2):
    T, D = t.shape
    p_group = jax.nn.softmax((t @ rg_w + rg_b).astype(jnp.float32), axis=-1)
    g_val, g_idx = lax.top_k(p_group, 1)
    e_logits = (t @ re_w + re_b).astype(jnp.float32).reshape(T, N_GROUPS, EXPERTS_PER_GROUP)
    in_group = jnp.take_along_axis(e_logits, g_idx[:, :, None], axis=1)[:, 0]
    e_val, e_idx = lax.top_k(in_group, TOP_K)
    weights = g_val * jax.nn.softmax(e_val, axis=-1)
    expert_id = g_idx * EXPERTS_PER_GROUP + e_idx

    N = T * TOP_K
    flat_e = expert_id.reshape(N)
    flat_tok = jnp.repeat(jnp.arange(T), TOP_K)
    flat_w = weights.reshape(N)
    order = jnp.argsort(flat_e)
    sorted_e = flat_e[order]
    sorted_tok = flat_tok[order]
    counts = jnp.bincount(flat_e, length=N_EXPERTS)
    starts = jnp.cumsum(counts) - counts
    padded = ((counts + MOE_BLOCK - 1) // MOE_BLOCK) * MOE_BLOCK
    pends = jnp.cumsum(padded)
    pstarts = pends - padded
    dest = pstarts[sorted_e] + (jnp.arange(N) - starts[sorted_e])
    n_blocks = (N + MOE_BLOCK - 1) // MOE_BLOCK + N_EXPERTS
    buf = jnp.zeros((n_blocks * MOE_BLOCK, D), t.dtype).at[dest].set(t[sorted_tok])
    block_e = jnp.minimum(jnp.searchsorted(pends, jnp.arange(n_blocks) * MOE_BLOCK, side='right'), N_EXPERTS - 1)

    def expert_block(args):
        xb, e = args
        hid = jax.nn.silu(xb @ w1[e]) * (xb @ w3[e])
        return hid @ w2[e]

    y = lax.map(expert_block, (buf.reshape(n_blocks, MOE_BLOCK, D), block_e)).reshape(n_blocks * MOE_BLOCK, D)
    y_slots = y[dest] * flat_w[order][:, None].astype(y.dtype)
    return jnp.zeros((T, D), y.dtype).at[sorted_tok].add(y_slots)


def setup_inputs(seed: int = 0) -> dict:
    key = jax.random.key(seed)
    ks = jax.random.split(key, 28)
    f32 = jnp.float32

    def nrm(k, shape, s):
        return jax.random.normal(k, shape, f32) * s

    u = jax.random.uniform(ks[11], (DEPTH, 2, RG_WIDTH), f32, 0.9, 0.999)
    s = u ** (1.0 / RG_C)
    return {
        "x": nrm(ks[0], (BATCH, SEQ, D_MODEL), 1.0),
        "c": nrm(ks[1], (BATCH, D_MODEL), 1.0),
        "ctx": nrm(ks[2], (BATCH, CTX_LEN, D_MODEL), 1.0),
        "c_ctx": nrm(ks[3], (D_MODEL,), 1.0),
        "ada_w": nrm(ks[4], (DEPTH, D_MODEL, 6 * D_MODEL), 0.5 * D_MODEL ** -0.5),
        "ada_b": nrm(ks[5], (DEPTH, 6 * D_MODEL), 0.01),
        "w_in": nrm(ks[6], (DEPTH, D_MODEL, N_IN), D_MODEL ** -0.5),
        "rg_conv_w": nrm(ks[7], (DEPTH, CONV_W, RG_WIDTH), CONV_W ** -0.5),
        "rg_conv_b": nrm(ks[8], (DEPTH, RG_WIDTH), 0.01),
        "rg_gate_w": nrm(ks[9], (DEPTH, 2, 2, RG_BLOCKS, RG_BLOCK, RG_BLOCK), RG_BLOCK ** -0.5),
        "rg_gate_b": nrm(ks[10], (DEPTH, 2, 2, RG_WIDTH), 0.01),
        "rg_lambda": jnp.log(s) - jnp.log1p(-s),
        "hg_lb_logits": nrm(ks[12], (DEPTH + 1, 2, HG_WIDTH), 0.1),
        "hg_norm_g": 1.0 + nrm(ks[13], (DEPTH, HG_WIDTH), 0.02),
        "w_out": nrm(ks[14], (DEPTH, MIX_WIDTH, D_MODEL), BETA * MIX_WIDTH ** -0.5),
        "ln1_g": 1.0 + nrm(ks[15], (DEPTH, D_MODEL), 0.02),
        "ln1_b": nrm(ks[16], (DEPTH, D_MODEL), 0.01),
        "router_g_w": nrm(ks[17], (DEPTH, D_MODEL, N_GROUPS), D_MODEL ** -0.5),
        "router_g_b": nrm(ks[18], (DEPTH, N_GROUPS), 0.01),
        "router_e_w": nrm(ks[19], (DEPTH, D_MODEL, N_EXPERTS), D_MODEL ** -0.5),
        "router_e_b": nrm(ks[20], (DEPTH, N_EXPERTS), 0.01),
        "exp_w1": nrm(ks[21], (DEPTH, N_EXPERTS, D_MODEL, D_EXPERT), D_MODEL ** -0.5),
        "exp_w3": nrm(ks[22], (DEPTH, N_EXPERTS, D_MODEL, D_EXPERT), D_MODEL ** -0.5),
        "exp_w2": nrm(ks[23], (DEPTH, N_EXPERTS, D_EXPERT, D_MODEL), BETA * D_EXPERT ** -0.5),
        "ln2_g": 1.0 + nrm(ks[24], (DEPTH, D_MODEL), 0.02),
        "ln2_b": nrm(ks[25], (DEPTH, D_MODEL), 0.01),
    }


def reference(x, c, ctx, c_ctx, ada_w, ada_b, w_in, rg_conv_w, rg_conv_b, rg_gate_w, rg_gate_b, rg_lambda,
              hg_lb_logits, hg_norm_g, w_out, ln1_g, ln1_b, router_g_w, router_g_b, router_e_w, router_e_b,
              exp_w1, exp_w3, exp_w2, ln2_g, ln2_b):
    B, L, D = x.shape
    Lc = ctx.shape[1]
    lb_all = jnp.cumsum(jax.nn.softmax(hg_lb_logits.astype(jnp.float32), axis=0), axis=0)
    h = x
    hc = ctx
    for l in range(DEPTH):
        last = l == DEPTH - 1
        sh1, sc1, g1, sh2, sc2, g2 = modulation(c[:, None, :], ada_w[l], ada_b[l])
        sh1c, sc1c, g1c, sh2c, sc2c, g2c = modulation(c_ctx[None, None, :], ada_w[l], ada_b[l])
        mix_params = (w_in[l], rg_conv_w[l], rg_conv_b[l], rg_gate_w[l], rg_gate_b[l], rg_lambda[l],
                      lb_all[l], hg_norm_g[l], w_out[l])
        zero_states = (jnp.zeros((B, RG_WIDTH), jnp.float32), jnp.zeros((B, RG_WIDTH), jnp.float32),
                       jnp.zeros((B, HG_HEADS, HG_HEAD, HG_HEAD), jnp.float32),
                       jnp.zeros((B, HG_HEADS, HG_HEAD, HG_HEAD), jnp.float32))
        yc, ctx_states = token_mixer(hc * (1.0 + sc1c) + sh1c, *mix_params, zero_states,
                                     on_grid=False, with_output=not last)
        y, _ = token_mixer(h * (1.0 + sc1) + sh1, *mix_params, ctx_states, on_grid=True, with_output=True)
        h = layer_norm(ALPHA * h + g1 * y, ln1_g[l], ln1_b[l])
        u2 = h * (1.0 + sc2) + sh2
        moe_params = (router_g_w[l], router_g_b[l], router_e_w[l], router_e_b[l], exp_w1[l], exp_w3[l], exp_w2[l])
        if last:
            f = hier_moe(u2.reshape(B * L, D), *moe_params).reshape(B, L, D)
        else:
            hc = layer_norm(ALPHA * hc + g1c * yc, ln1_g[l], ln1_b[l])
            u2c = hc * (1.0 + sc2c) + sh2c
            both = hier_moe(jnp.concatenate([u2c, u2], axis=1).reshape(B * (Lc + L), D), *moe_params)
            both = both.reshape(B, Lc + L, D)
            fc, f = both[:, :Lc], both[:, Lc:]
            hc = layer_norm(ALPHA * hc + g2c * fc, ln2_g[l], ln2_b[l])
        h = layer_norm(ALPHA * h + g2 * f, ln2_g[l], ln2_b[l])
    return h
```

```cpp
#include <hip/hip_runtime.h>
#include <cstdio>
#include <cstdint>

typedef unsigned short bf16_t;
typedef short bf16x8 __attribute__((ext_vector_type(8)));
typedef float f32x4 __attribute__((ext_vector_type(4)));

constexpr int NB = 16, SEQ = 4096, LC = 256, DM = 1024;
constexpr int T = NB * SEQ;
constexpr int TC = NB * LC;
constexpr int TA = T + TC;
constexpr int NIN = 3584;
constexpr int NE = 32, DE = 512;
constexpr int MAXROWS = 2 * T + NE * 256;
constexpr float ALPHA = 1.189207115002721f;
constexpr float LN_EPS = 1e-6f;

constexpr size_t MiB = 1u << 20;
constexpr size_t WS_CTL = 0;
constexpr size_t WS_MOD = 1 * MiB;
constexpr size_t WS_EIDX = 3 * MiB;
constexpr size_t WS_EPOS = 3 * MiB + 512 * 1024;
constexpr size_t WS_EW = 4 * MiB;
constexpr size_t WS_DEST = 4 * MiB + 512 * 1024;
constexpr size_t WS_WINT = 6 * MiB;
constexpr size_t WS_WOUTT = 13 * MiB;
constexpr size_t WS_W13T = 15 * MiB;
constexpr size_t WS_W2T = 79 * MiB;
constexpr size_t WS_U = 112 * MiB;
constexpr size_t WS_PROJ = 248 * MiB;
constexpr size_t WS_XG = 248 * MiB;
constexpr size_t WS_HID = 520 * MiB;
constexpr size_t WS_Y = 656 * MiB;
constexpr size_t WS_MIXED = 724 * MiB;
constexpr size_t WS_OSUM = 852 * MiB;
constexpr size_t WS_END = 980 * MiB;

__device__ __forceinline__ float bf2f(bf16_t b) { return __uint_as_float(((unsigned)b) << 16); }
__device__ __forceinline__ bf16_t f2bf(float f) { unsigned u = __float_as_uint(f); return (bf16_t)((u + 0x7fffu + ((u >> 16) & 1u)) >> 16); }
__device__ __forceinline__ float sigmoidf_(float x) { return 1.0f / (1.0f + __expf(-x)); }
__device__ __forceinline__ float siluf_(float x) { return x / (1.0f + __expf(-x)); }
__device__ __forceinline__ float gelu_tanh(float x) {
    const float y = 0.7978845608028654f * (x + 0.044715f * x * x * x);
    const float t = 1.0f - 2.0f / (__expf(2.0f * y) + 1.0f);
    return 0.5f * x * (1.0f + t);
}
__device__ __forceinline__ float softplusf_(float x) { return fmaxf(x, 0.f) + log1pf(expf(-fabsf(x))); }

__global__ __launch_bounds__(256) void k_mod(const float* __restrict__ c, const float* __restrict__ c_ctx, const float* __restrict__ ada_w,
                                              const float* __restrict__ ada_b, float* __restrict__ mod) {
    __shared__ float s[DM];
    const int r = blockIdx.y;
    const float* cv = r < NB ? c + (size_t)r * DM : c_ctx;
    for (int i = threadIdx.x; i < DM; i += 256) { const float v = cv[i]; s[i] = v / (1.0f + expf(-v)); }
    __syncthreads();
    const int col = blockIdx.x * 256 + threadIdx.x;
    float acc = 0.f;
    for (int k = 0; k < DM; ++k) acc += s[k] * ada_w[(size_t)k * 6144 + col];
    mod[(size_t)r * 6144 + col] = acc + ada_b[col];
}

__global__ __launch_bounds__(256) void k_transpose(const float* __restrict__ in, size_t in_stride, int K, int N, bf16_t* __restrict__ out, size_t out_stride, int mode) {
    __shared__ float tile[64][65];
    const float* W = in + (size_t)blockIdx.z * in_stride;
    bf16_t* O = out + (size_t)blockIdx.z * out_stride;
    const int k0 = blockIdx.x * 64, n0 = blockIdx.y * 64;
    for (int i = threadIdx.x; i < 64 * 64; i += 256) { const int kk = i >> 6, nn = i & 63; tile[kk][nn] = W[(size_t)(k0 + kk) * N + n0 + nn]; }
    __syncthreads();
    for (int i = threadIdx.x; i < 64 * 32; i += 256) {
        const int nn = i >> 5, kp = i & 31, n = n0 + nn;
        const int orow = mode == 0 ? n : ((n >> 4) * 32 + (mode == 2 ? 16 : 0) + (n & 15));
        const unsigned v = (unsigned)f2bf(tile[2 * kp][nn]) | ((unsigned)f2bf(tile[2 * kp + 1][nn]) << 16);
        *(unsigned*)(O + (size_t)orow * K + k0 + 2 * kp) = v;
    }
}

__global__ __launch_bounds__(256) void k_u(const float* __restrict__ x, const float* __restrict__ ctx, const float* __restrict__ mod, bf16_t* __restrict__ U) {
    const size_t i4 = (size_t)blockIdx.x * 256 + threadIdx.x;
    const int row = (int)(i4 >> 8), c4 = (int)(i4 & 255) * 4;
    const float* src; const float* m;
    if (row < T) { src = x + (size_t)row * DM; m = mod + (size_t)(row / SEQ) * 6144; }
    else { src = ctx + (size_t)(row - T) * DM; m = mod + (size_t)16 * 6144; }
    const f32x4 v = *(const f32x4*)(src + c4), sh = *(const f32x4*)(m + c4), sc = *(const f32x4*)(m + 1024 + c4);
    unsigned lo = (unsigned)f2bf(v[0] * (1.f + sc[0]) + sh[0]) | ((unsigned)f2bf(v[1] * (1.f + sc[1]) + sh[1]) << 16);
    unsigned hi = (unsigned)f2bf(v[2] * (1.f + sc[2]) + sh[2]) | ((unsigned)f2bf(v[3] * (1.f + sc[3]) + sh[3]) << 16);
    *(uint2*)(U + (size_t)row * DM + c4) = make_uint2(lo, hi);
}

__device__ __forceinline__ int expert_of_row(const int* __restrict__ counts, int row0) {
    int acc = 0, e_found = -1;
    for (int e = 0; e < NE; ++e) { const int p = ((counts[e] + 255) >> 8) << 8; if (row0 >= acc && row0 < acc + p) e_found = e; acc += p; }
    return e_found;
}
__device__ __forceinline__ int pstart_of(const int* __restrict__ counts, int e) {
    int acc = 0;
    for (int i = 0; i < NE; ++i) { const int p = ((counts[i] + 255) >> 8) << 8; if (i < e) acc += p; }
    return acc;
}

struct EpiInProj {
    bf16_t* P;
    __device__ __forceinline__ void operator()(const f32x4 (&acc)[4][4], int brow, int bcol, int wr, int wc, int fr, int fq) const {
        const int grp = bcol / 512;
#pragma unroll
        for (int m = 0; m < 4; ++m)
#pragma unroll
            for (int n = 0; n < 4; ++n)
#pragma unroll
                for (int j = 0; j < 4; ++j) {
                    const int row = brow + wr * 64 + m * 16 + fq * 4 + j, col = bcol + wc * 64 + n * 16 + fr;
                    float v = acc[m][n][j];
                    if (grp == 1) v = gelu_tanh(v); else if (grp == 2 || grp == 6) v = siluf_(v);
                    P[(size_t)row * NIN + col] = f2bf(v);
                }
    }
};
struct EpiF32Out {
    float* C; int ldc; int pad;
    __device__ __forceinline__ void operator()(const f32x4 (&acc)[4][4], int brow, int bcol, int wr, int wc, int fr, int fq) const {
#pragma unroll
        for (int m = 0; m < 4; ++m)
#pragma unroll
            for (int n = 0; n < 4; ++n)
#pragma unroll
                for (int j = 0; j < 4; ++j) C[(size_t)(brow + wr * 64 + m * 16 + fq * 4 + j) * ldc + bcol + wc * 64 + n * 16 + fr] = acc[m][n][j];
    }
};
struct EpiExp1 {
    bf16_t* H;
    __device__ __forceinline__ void operator()(const f32x4 (&acc)[4][4], int brow, int bcol, int wr, int wc, int fr, int fq) const {
#pragma unroll
        for (int m = 0; m < 4; ++m)
#pragma unroll
            for (int np = 0; np < 2; ++np)
#pragma unroll
                for (int j = 0; j < 4; ++j) {
                    const int row = brow + wr * 64 + m * 16 + fq * 4 + j;
                    const int hcol = ((bcol + wc * 64) >> 1) + np * 16 + fr;
                    const float a = acc[m][2 * np][j], b = acc[m][2 * np + 1][j];
                    H[(size_t)row * DE + hcol] = f2bf(siluf_(a) * b);
                }
    }
};
struct EpiBf16Out {
    bf16_t* O; int ldc; int pad;
    __device__ __forceinline__ void operator()(const f32x4 (&acc)[4][4], int brow, int bcol, int wr, int wc, int fr, int fq) const {
#pragma unroll
        for (int m = 0; m < 4; ++m)
#pragma unroll
            for (int n = 0; n < 4; ++n)
#pragma unroll
                for (int j = 0; j < 4; ++j) O[(size_t)(brow + wr * 64 + m * 16 + fq * 4 + j) * ldc + bcol + wc * 64 + n * 16 + fr] = f2bf(acc[m][n][j]);
    }
};

template <class Epi>
__global__ __launch_bounds__(256, 2) void k_gemm128(const bf16_t* __restrict__ A, const bf16_t* __restrict__ Bt, int K, int tilesN, Epi E,
                                                      const int* __restrict__ counts, size_t bt_group_stride) {
    extern __shared__ __attribute__((aligned(16))) unsigned char shm_g[];
    constexpr int BM = 128, BK = 32, HT = BM * BK;
    const int rb = blockIdx.x / tilesN, nb = blockIdx.x % tilesN;
    const int brow = rb * BM, bcol = nb * BM;
    const bf16_t* Bg = Bt;
    if (counts) { const int e = expert_of_row(counts, brow); if (e < 0) return; Bg = Bt + (size_t)e * bt_group_stride; }
    const bf16_t* Ag = A;
    const int wid = threadIdx.x >> 6, lane = threadIdx.x & 63, wr = wid >> 1, wc = wid & 1, fr = lane & 15, fq = lane >> 4;
    bf16_t* SA = (bf16_t*)shm_g; bf16_t* SB = SA + HT;
    f32x4 acc[4][4];
#pragma unroll
    for (int m = 0; m < 4; ++m)
#pragma unroll
        for (int n = 0; n < 4; ++n) acc[m][n] = (f32x4){0.f, 0.f, 0.f, 0.f};
    bf16x8 At[4], Btl[4];
    for (int t = 0; t < K / BK; ++t) {
#pragma unroll
        for (int i = 0; i < 2; ++i) {
            const int b = threadIdx.x * 16 + i * 4096, r = b / 64, c = (b % 64) / 2;
            __builtin_amdgcn_global_load_lds((const unsigned*)(Ag + (size_t)(brow + r) * K + t * BK + c), (__attribute__((address_space(3))) unsigned*)((unsigned char*)SA + b), 16, 0, 0);
            __builtin_amdgcn_global_load_lds((const unsigned*)(Bg + (size_t)(bcol + r) * K + t * BK + c), (__attribute__((address_space(3))) unsigned*)((unsigned char*)SB + b), 16, 0, 0);
        }
        asm volatile("s_waitcnt vmcnt(0)" ::: "memory"); __syncthreads();
#pragma unroll
        for (int m = 0; m < 4; ++m) At[m] = *(const bf16x8*)((const unsigned char*)SA + (wr * 64 + m * 16 + fr) * BK * 2 + fq * 16);
#pragma unroll
        for (int n = 0; n < 4; ++n) Btl[n] = *(const bf16x8*)((const unsigned char*)SB + (wc * 64 + n * 16 + fr) * BK * 2 + fq * 16);
        asm volatile("s_waitcnt lgkmcnt(0)" ::: "memory"); __builtin_amdgcn_sched_barrier(0);
#pragma unroll
        for (int m = 0; m < 4; ++m)
#pragma unroll
            for (int n = 0; n < 4; ++n) acc[m][n] = __builtin_amdgcn_mfma_f32_16x16x32_bf16(At[m], Btl[n], acc[m][n], 0, 0, 0);
        __syncthreads();
    }
    E(acc, brow, bcol, wr, wc, fr, fq);
}

__global__ __launch_bounds__(64) void k_rglru_naive(const bf16_t* __restrict__ proj, const float* __restrict__ conv_w, const float* __restrict__ conv_b,
                                                     const float* __restrict__ gate_w, const float* __restrict__ gate_b, const float* __restrict__ lam,
                                                     float* __restrict__ rgsum, int dir) {
    __shared__ float gw[2][64][64];
    __shared__ float xcs[64][64];
    const int b = blockIdx.x >> 3, n = blockIdx.x & 7, c = threadIdx.x, ch = n * 64 + c;
    for (int g = 0; g < 2; ++g)
        for (int cc = 0; cc < 64; ++cc) gw[g][cc][c] = gate_w[((size_t)((dir * 2 + g) * 8 + n) * 64 + cc) * 64 + c];
    const float gb0 = gate_b[(dir * 2 + 0) * 512 + ch], gb1 = gate_b[(dir * 2 + 1) * 512 + ch];
    const float sp = softplusf_(-lam[dir * 512 + ch]);
    const float cw0 = conv_w[0 * 512 + ch], cw1 = conv_w[1 * 512 + ch], cw2 = conv_w[2 * 512 + ch], cw3 = conv_w[3 * 512 + ch], cb = conv_b[ch];
    float h = 0.f;
    __syncthreads();
    for (int step = 0; step < 68; ++step) {
        int rowbase, p0, lo, hi; bool latent;
        if (step < 4) { const int cidx = dir == 0 ? step : 3 - step; rowbase = T + b * LC; p0 = cidx * 64; lo = 0; hi = LC; latent = false; }
        else { const int cidx = dir == 0 ? step - 4 : 63 - (step - 4); rowbase = b * SEQ; p0 = cidx * 64; lo = p0; hi = p0 + 64; latent = true; }
        float xv[67];
#pragma unroll
        for (int i = 0; i < 67; ++i) { const int p = p0 - 1 + i; xv[i] = (p >= lo && p < hi) ? bf2f(proj[(size_t)(rowbase + p) * NIN + ch]) : 0.f; }
#pragma unroll
        for (int i = 0; i < 64; ++i) xcs[i][c] = cb + cw0 * xv[i] + cw1 * xv[i + 1] + cw2 * xv[i + 2] + cw3 * xv[i + 3];
        __syncthreads();
        for (int ii = 0; ii < 64; ++ii) {
            const int i = dir == 0 ? ii : 63 - ii;
            float rp = gb0, ip = gb1;
            for (int cc = 0; cc < 64; ++cc) { const float xv = xcs[i][cc]; rp += xv * gw[0][cc][c]; ip += xv * gw[1][cc][c]; }
            const float r = sigmoidf_(rp), ig = sigmoidf_(ip);
            const float log_a = -8.0f * r * sp, a = expf(log_a), mult = sqrtf(-expm1f(2.0f * log_a));
            h = a * h + mult * ig * xcs[i][c];
            if (latent) { const size_t idx = (size_t)(rowbase + p0 + i) * 512 + ch; if (dir == 0) rgsum[idx] = h; else rgsum[idx] += h; }
        }
        __syncthreads();
    }
}

__global__ __launch_bounds__(256) void k_hgrn2_naive(const bf16_t* __restrict__ proj, const float* __restrict__ lb_logits, float* __restrict__ osum, int dir) {
    __shared__ float sq[16][128], sf[16][128], sk[16][128], sv[16][128];
    __shared__ float part[16][2][128];
    const int b = blockIdx.x >> 2, hd = blockIdx.x & 3, v = threadIdx.x & 127, kh = threadIdx.x >> 7;
    float S[64];
#pragma unroll
    for (int i = 0; i < 64; ++i) S[i] = 0.f;
    const int zcol = (dir == 0 ? 1536 : 2048) + hd * 128;
    const float l0 = lb_logits[(0 * 2 + dir) * 512 + hd * 128 + v], l1 = lb_logits[(1 * 2 + dir) * 512 + hd * 128 + v];
    const float lbv = 1.0f / (1.0f + expf(l1 - l0));
    for (int step = 0; step < 272; ++step) {
        int rowbase, p0; bool latent;
        if (step < 16) { const int cidx = dir == 0 ? step : 15 - step; rowbase = T + b * LC; p0 = cidx * 16; latent = false; }
        else { const int cidx = dir == 0 ? step - 16 : 255 - (step - 16); rowbase = b * SEQ; p0 = cidx * 16; latent = true; }
        __syncthreads();
        for (int i = kh; i < 16; i += 2) {
            const bf16_t* pr = proj + (size_t)(rowbase + p0 + i) * NIN;
            const float z = bf2f(pr[zcol + v]);
            const float f = lbv + (1.0f - lbv) * sigmoidf_(z);
            sq[i][v] = bf2f(pr[1024 + hd * 128 + v]); sf[i][v] = f; sk[i][v] = (1.0f - lbv) * sigmoidf_(-z); sv[i][v] = bf2f(pr[2560 + hd * 128 + v]);
        }
        __syncthreads();
        for (int ii = 0; ii < 16; ++ii) {
            const int i = dir == 0 ? ii : 15 - ii;
            const float vv = sv[i][v]; float o = 0.f;
#pragma unroll
            for (int kk = 0; kk < 64; ++kk) { const int k = kh * 64 + kk; S[kk] = sf[i][k] * S[kk] + sk[i][k] * vv; o += sq[i][k] * S[kk]; }
            part[i][kh][v] = o;
        }
        __syncthreads();
        if (latent) for (int i = kh; i < 16; i += 2) {
            const size_t idx = (size_t)(rowbase + p0 + i) * 512 + hd * 128 + v; const float o = part[i][0][v] + part[i][1][v];
            if (dir == 0) osum[idx] = o; else osum[idx] += o;
        }
    }
}

__global__ __launch_bounds__(512) void k_scan_final(const bf16_t* __restrict__ proj, const float* __restrict__ rgsum, const float* __restrict__ osum,
                                                     const float* __restrict__ norm_g, bf16_t* __restrict__ mixed) {
    __shared__ float ws[8];
    const int tok = blockIdx.x, j = threadIdx.x;
    const bf16_t* pr = proj + (size_t)tok * NIN;
    mixed[(size_t)tok * DM + j] = f2bf(rgsum[(size_t)tok * 512 + j] * bf2f(pr[512 + j]));
    const float o = osum[(size_t)tok * 512 + j];
    float s = o * o;
#pragma unroll
    for (int off = 1; off < 64; off <<= 1) s += __shfl_xor(s, off);
    if ((j & 63) == 0) ws[j >> 6] = s;
    __syncthreads();
    const int hd = j >> 7;
    const float ms = (ws[2 * hd] + ws[2 * hd + 1]) * (1.0f / 128.0f);
    mixed[(size_t)tok * DM + 512 + j] = f2bf(o * rsqrtf(ms + LN_EPS) * norm_g[j] * bf2f(pr[3072 + j]));
}

__device__ __forceinline__ float block_sum256(float v, float* red) {
#pragma unroll
    for (int off = 1; off < 64; off <<= 1) v += __shfl_xor(v, off);
    __syncthreads();
    if ((threadIdx.x & 63) == 0) red[threadIdx.x >> 6] = v;
    __syncthreads();
    return red[0] + red[1] + red[2] + red[3];
}

__global__ __launch_bounds__(256) void k_ln1_router(const float* __restrict__ x, float* __restrict__ yo_h1, const float* __restrict__ mod,
                                                     const float* __restrict__ ln_g, const float* __restrict__ ln_b,
                                                     const float* __restrict__ rgw, const float* __restrict__ rgb, const float* __restrict__ rew, const float* __restrict__ reb,
                                                     bf16_t* __restrict__ U2, int* __restrict__ counts, int2* __restrict__ eidx, int2* __restrict__ epos, float2* __restrict__ ew) {
    __shared__ float red[4];
    __shared__ float lred[4][36];
    __shared__ float lg[36];
    const int tok = blockIdx.x, tid = threadIdx.x, c4 = tid * 4;
    const float* m = mod + (size_t)(tok / SEQ) * 6144;
    const f32x4 xv = *(const f32x4*)(x + (size_t)tok * DM + c4), yv = *(const f32x4*)(yo_h1 + (size_t)tok * DM + c4), g1 = *(const f32x4*)(m + 2048 + c4);
    f32x4 v = ALPHA * xv + g1 * yv;
    const float mean = block_sum256((v[0] + v[1]) + (v[2] + v[3]), red) * (1.0f / DM);
    v = v - mean;
    const float var = block_sum256((v[0] * v[0] + v[1] * v[1]) + (v[2] * v[2] + v[3] * v[3]), red) * (1.0f / DM);
    const float rstd = rsqrtf(var + LN_EPS);
    const f32x4 h1 = v * rstd * *(const f32x4*)(ln_g + c4) + *(const f32x4*)(ln_b + c4);
    *(f32x4*)(yo_h1 + (size_t)tok * DM + c4) = h1;
    const f32x4 u2 = h1 * (1.0f + *(const f32x4*)(m + 4096 + c4)) + *(const f32x4*)(m + 3072 + c4);
    *(uint2*)(U2 + (size_t)tok * DM + c4) = make_uint2((unsigned)f2bf(u2[0]) | ((unsigned)f2bf(u2[1]) << 16), (unsigned)f2bf(u2[2]) | ((unsigned)f2bf(u2[3]) << 16));
    float pl[36];
#pragma unroll
    for (int e = 0; e < 36; ++e) pl[e] = 0.f;
#pragma unroll
    for (int jj = 0; jj < 4; ++jj) {
        const float uu = u2[jj];
        const f32x4 wg = *(const f32x4*)(rgw + (size_t)(c4 + jj) * 4);
#pragma unroll
        for (int e = 0; e < 4; ++e) pl[e] += uu * wg[e];
#pragma unroll
        for (int e4 = 0; e4 < 8; ++e4) { const f32x4 we = *(const f32x4*)(rew + (size_t)(c4 + jj) * 32 + e4 * 4);
#pragma unroll
            for (int q = 0; q < 4; ++q) pl[4 + e4 * 4 + q] += uu * we[q]; }
    }
#pragma unroll
    for (int e = 0; e < 36; ++e) {
        float s = pl[e];
#pragma unroll
        for (int off = 1; off < 64; off <<= 1) s += __shfl_xor(s, off);
        pl[e] = s;
    }
    if ((tid & 63) == 0) {
#pragma unroll
        for (int e = 0; e < 36; ++e) lred[tid >> 6][e] = pl[e];
    }
    __syncthreads();
    if (tid < 36) lg[tid] = lred[0][tid] + lred[1][tid] + lred[2][tid] + lred[3][tid] + (tid < 4 ? rgb[tid] : reb[tid - 4]);
    __syncthreads();
    if (tid == 0) {
        int gi = 0; float gm = lg[0];
        for (int g = 1; g < 4; ++g) if (lg[g] > gm) { gm = lg[g]; gi = g; }
        float den = 0.f; for (int g = 0; g < 4; ++g) den += expf(lg[g] - gm);
        const float gval = 1.0f / den;
        int e0 = 0; float v0 = lg[4 + gi * 8];
        for (int e = 1; e < 8; ++e) { const float vv = lg[4 + gi * 8 + e]; if (vv > v0) { v0 = vv; e0 = e; } }
        int e1 = -1; float v1 = 0.f;
        for (int e = 0; e < 8; ++e) { if (e == e0) continue; const float vv = lg[4 + gi * 8 + e]; if (e1 < 0 || vv > v1) { v1 = vv; e1 = e; } }
        const float t = expf(v1 - v0), w0 = 1.0f / (1.0f + t), w1 = t / (1.0f + t);
        const int id0 = gi * 8 + e0, id1 = gi * 8 + e1;
        const int p0 = atomicAdd(&counts[id0], 1), p1 = atomicAdd(&counts[id1], 1);
        eidx[tok] = make_int2(id0, id1); epos[tok] = make_int2(p0, p1); ew[tok] = make_float2(gval * w0, gval * w1);
    }
}

__global__ __launch_bounds__(128) void k_gather(const bf16_t* __restrict__ U2, const int* __restrict__ counts, const int2* __restrict__ eidx, const int2* __restrict__ epos,
                                                 bf16_t* __restrict__ XG, int2* __restrict__ dest) {
    const int tok = blockIdx.x, tid = threadIdx.x;
    const int2 ei = eidx[tok], ep = epos[tok];
    const int d0 = pstart_of(counts, ei.x) + ep.x, d1 = pstart_of(counts, ei.y) + ep.y;
    const uint4 v = *(const uint4*)(U2 + (size_t)tok * DM + tid * 8);
    *(uint4*)(XG + (size_t)d0 * DM + tid * 8) = v;
    *(uint4*)(XG + (size_t)d1 * DM + tid * 8) = v;
    if (tid == 0) dest[tok] = make_int2(d0, d1);
}

__global__ __launch_bounds__(256) void k_combine_ln2(float* __restrict__ out, const bf16_t* __restrict__ Y, const int2* __restrict__ dest, const float2* __restrict__ ew,
                                                      const float* __restrict__ mod, const float* __restrict__ ln_g, const float* __restrict__ ln_b) {
    __shared__ float red[4];
    const int tok = blockIdx.x, tid = threadIdx.x, c4 = tid * 4;
    const float* m = mod + (size_t)(tok / SEQ) * 6144;
    const int2 d = dest[tok]; const float2 w = ew[tok];
    const uint2 ya = *(const uint2*)(Y + (size_t)d.x * DM + c4), yb = *(const uint2*)(Y + (size_t)d.y * DM + c4);
    f32x4 f;
    f[0] = w.x * bf2f((bf16_t)(ya.x & 0xffff)) + w.y * bf2f((bf16_t)(yb.x & 0xffff));
    f[1] = w.x * bf2f((bf16_t)(ya.x >> 16)) + w.y * bf2f((bf16_t)(yb.x >> 16));
    f[2] = w.x * bf2f((bf16_t)(ya.y & 0xffff)) + w.y * bf2f((bf16_t)(yb.y & 0xffff));
    f[3] = w.x * bf2f((bf16_t)(ya.y >> 16)) + w.y * bf2f((bf16_t)(yb.y >> 16));
    const f32x4 h1 = *(const f32x4*)(out + (size_t)tok * DM + c4), g2 = *(const f32x4*)(m + 5120 + c4);
    f32x4 v = ALPHA * h1 + g2 * f;
    const float mean = block_sum256((v[0] + v[1]) + (v[2] + v[3]), red) * (1.0f / DM);
    v = v - mean;
    const float var = block_sum256((v[0] * v[0] + v[1] * v[1]) + (v[2] * v[2] + v[3] * v[3]), red) * (1.0f / DM);
    const float rstd = rsqrtf(var + LN_EPS);
    *(f32x4*)(out + (size_t)tok * DM + c4) = v * rstd * *(const f32x4*)(ln_g + c4) + *(const f32x4*)(ln_b + c4);
}

extern "C" void kernel_launch(void* const* d_in, const int* in_sizes, int n_in, void* d_out, int out_size, void* d_ws, size_t ws_size, hipStream_t stream) {
    if (ws_size < WS_END) { fprintf(stderr, "kernel_launch: workspace too small: %zu < %zu\n", ws_size, (size_t)WS_END); return; }
    const float* x = (const float*)d_in[0]; const float* c = (const float*)d_in[1]; const float* ctx = (const float*)d_in[2]; const float* c_ctx = (const float*)d_in[3];
    const float* ada_w = (const float*)d_in[4]; const float* ada_b = (const float*)d_in[5]; const float* w_in = (const float*)d_in[6];
    const float* conv_w = (const float*)d_in[7]; const float* conv_b = (const float*)d_in[8]; const float* gate_w = (const float*)d_in[9]; const float* gate_b = (const float*)d_in[10];
    const float* lam = (const float*)d_in[11]; const float* lb_logits = (const float*)d_in[12]; const float* norm_g = (const float*)d_in[13]; const float* w_out = (const float*)d_in[14];
    const float* ln1_g = (const float*)d_in[15]; const float* ln1_b = (const float*)d_in[16]; const float* rgw = (const float*)d_in[17]; const float* rgb = (const float*)d_in[18];
    const float* rew = (const float*)d_in[19]; const float* reb = (const float*)d_in[20]; const float* w1 = (const float*)d_in[21]; const float* w3 = (const float*)d_in[22];
    const float* w2 = (const float*)d_in[23]; const float* ln2_g = (const float*)d_in[24]; const float* ln2_b = (const float*)d_in[25];
    unsigned char* ws = (unsigned char*)d_ws; float* out = (float*)d_out;
    int* counts = (int*)(ws + WS_CTL); float* mod = (float*)(ws + WS_MOD);
    int2* eidx = (int2*)(ws + WS_EIDX); int2* epos = (int2*)(ws + WS_EPOS); float2* ew = (float2*)(ws + WS_EW); int2* dest = (int2*)(ws + WS_DEST);
    bf16_t* WinT = (bf16_t*)(ws + WS_WINT); bf16_t* WoutT = (bf16_t*)(ws + WS_WOUTT); bf16_t* W13T = (bf16_t*)(ws + WS_W13T); bf16_t* W2T = (bf16_t*)(ws + WS_W2T);
    bf16_t* U = (bf16_t*)(ws + WS_U); float* rgsum = (float*)(ws + WS_U); bf16_t* U2 = (bf16_t*)(ws + WS_U);
    bf16_t* PROJ = (bf16_t*)(ws + WS_PROJ); bf16_t* XG = (bf16_t*)(ws + WS_XG); bf16_t* HID = (bf16_t*)(ws + WS_HID); bf16_t* Y = (bf16_t*)(ws + WS_Y);
    bf16_t* MIXED = (bf16_t*)(ws + WS_MIXED); float* osum = (float*)(ws + WS_OSUM);

    (void)hipMemsetAsync(ws + WS_CTL, 0, 4096, stream);
    k_mod<<<dim3(24, 17), 256, 0, stream>>>(c, c_ctx, ada_w, ada_b, mod);
    k_transpose<<<dim3(DM / 64, NIN / 64, 1), 256, 0, stream>>>(w_in, 0, DM, NIN, WinT, 0, 0);
    k_transpose<<<dim3(DM / 64, DM / 64, 1), 256, 0, stream>>>(w_out, 0, DM, DM, WoutT, 0, 0);
    k_transpose<<<dim3(DM / 64, DE / 64, NE), 256, 0, stream>>>(w1, (size_t)DM * DE, DM, DE, W13T, (size_t)DM * DM, 1);
    k_transpose<<<dim3(DM / 64, DE / 64, NE), 256, 0, stream>>>(w3, (size_t)DM * DE, DM, DE, W13T, (size_t)DM * DM, 2);
    k_transpose<<<dim3(DE / 64, DM / 64, NE), 256, 0, stream>>>(w2, (size_t)DE * DM, DE, DM, W2T, (size_t)DM * DE, 0);
    k_u<<<TA, 256, 0, stream>>>(x, ctx, mod, U);
    k_gemm128<EpiInProj><<<(TA / 128) * (NIN / 128), 256, 16384, stream>>>(U, WinT, DM, NIN / 128, EpiInProj{PROJ}, nullptr, 0);
    k_rglru_naive<<<NB * 8, 64, 0, stream>>>(PROJ, conv_w, conv_b, gate_w, gate_b, lam, rgsum, 0);
    k_rglru_naive<<<NB * 8, 64, 0, stream>>>(PROJ, conv_w, conv_b, gate_w, gate_b, lam, rgsum, 1);
    k_hgrn2_naive<<<NB * 4, 256, 0, stream>>>(PROJ, lb_logits, osum, 0);
    k_hgrn2_naive<<<NB * 4, 256, 0, stream>>>(PROJ, lb_logits, osum, 1);
    k_scan_final<<<T, 512, 0, stream>>>(PROJ, rgsum, osum, norm_g, MIXED);
    k_gemm128<EpiF32Out><<<(T / 128) * (DM / 128), 256, 16384, stream>>>(MIXED, WoutT, DM, DM / 128, EpiF32Out{out, DM, 0}, nullptr, 0);
    k_ln1_router<<<T, 256, 0, stream>>>(x, out, mod, ln1_g, ln1_b, rgw, rgb, rew, reb, U2, counts, eidx, epos, ew);
    k_gather<<<T, 128, 0, stream>>>(U2, counts, eidx, epos, XG, dest);
    k_gemm128<EpiExp1><<<(MAXROWS / 128) * (DM / 128), 256, 16384, stream>>>(XG, W13T, DM, DM / 128, EpiExp1{HID}, counts, (size_t)DM * DM);
    k_gemm128<EpiBf16Out><<<(MAXROWS / 128) * (DM / 128), 256, 16384, stream>>>(HID, W2T, DE, DM / 128, EpiBf16Out{Y, DM, 0}, counts, (size_t)DM * DE);
    k_combine_ln2<<<T, 256, 0, stream>>>(out, Y, dest, ew, mod, ln2_g, ln2_b);
}
```

```cpp
#include <hip/hip_runtime.h>
#include <hip/hip_cooperative_groups.h>
#include <cstdio>
#include <cstdint>
namespace cg = cooperative_groups;

typedef unsigned short bf16_t;
typedef short bf16x8 __attribute__((ext_vector_type(8)));
typedef float f32x4 __attribute__((ext_vector_type(4)));
typedef float f32x2 __attribute__((ext_vector_type(2)));
typedef unsigned u32x4 __attribute__((ext_vector_type(4)));
typedef unsigned u32x2 __attribute__((ext_vector_type(2)));
#define LAS __attribute__((address_space(3)))

constexpr int NB = 16, SEQ = 4096, LC = 256, DM = 1024;
constexpr int T = NB * SEQ;
constexpr int TC = NB * LC;
constexpr int TA = T + TC;
constexpr int NIN = 3584;
constexpr int NE = 32, DE = 512;
constexpr int MAXROWS = 2 * T + NE * 256;
constexpr float ALPHA = 1.189207115002721f;
constexpr float LN_EPS = 1e-6f;
constexpr int NTHREADS = 512;

constexpr size_t MiB = 1u << 20;
constexpr size_t WS_CTL = 0;
constexpr size_t WS_MOD = 1 * MiB;
constexpr size_t WS_EIDX = 3 * MiB;
constexpr size_t WS_EPOS = 3 * MiB + 512 * 1024;
constexpr size_t WS_EW = 4 * MiB;
constexpr size_t WS_DEST = 4 * MiB + 512 * 1024;
constexpr size_t WS_WINT = 6 * MiB;
constexpr size_t WS_WOUTT = 13 * MiB;
constexpr size_t WS_W13T = 15 * MiB;
constexpr size_t WS_W2T = 79 * MiB;
constexpr size_t WS_U = 112 * MiB;
constexpr size_t WS_PROJ = 248 * MiB;
constexpr size_t WS_XG = 248 * MiB;
constexpr size_t WS_HID = 520 * MiB;
constexpr size_t WS_Y = 656 * MiB;
constexpr size_t WS_MIXED = 724 * MiB;
constexpr size_t WS_OSUM = 852 * MiB;
constexpr size_t WS_END = 980 * MiB;
constexpr int LDS_BYTES = 147456;

__device__ __forceinline__ float bf2f(bf16_t b) { return __uint_as_float(((unsigned)b) << 16); }
__device__ __forceinline__ bf16_t f2bf(float f) { unsigned u = __float_as_uint(f); return (bf16_t)((u + 0x7fffu + ((u >> 16) & 1u)) >> 16); }
__device__ __forceinline__ unsigned pk2(float lo, float hi) { return (unsigned)f2bf(lo) | ((unsigned)f2bf(hi) << 16); }
__device__ __forceinline__ float sigmoidf_(float x) { return 1.0f / (1.0f + __expf(-x)); }
__device__ __forceinline__ float siluf_(float x) { return x / (1.0f + __expf(-x)); }
__device__ __forceinline__ float gelu_tanh(float x) {
    const float y = 0.7978845608028654f * (x + 0.044715f * x * x * x);
    const float t = 1.0f - 2.0f / (__expf(2.0f * y) + 1.0f);
    return 0.5f * x * (1.0f + t);
}
__device__ __forceinline__ float softplusf_(float x) { return fmaxf(x, 0.f) + log1pf(expf(-fabsf(x))); }
__device__ __forceinline__ float wave_sum(float v) {
#pragma unroll
    for (int o = 1; o < 64; o <<= 1) v += __shfl_xor(v, o);
    return v;
}
__device__ __forceinline__ int pstart_of(const int* __restrict__ counts, int e) {
    int acc = 0;
    for (int i = 0; i < NE; ++i) { const int p = ((counts[i] + 255) >> 8) << 8; if (i < e) acc += p; }
    return acc;
}

namespace pg8 {
#define PG8_LAS __attribute__((address_space(3)))
typedef unsigned short bf16_t;
typedef short bf16x8 __attribute__((ext_vector_type(8)));
typedef float f32x4 __attribute__((ext_vector_type(4)));
typedef unsigned u32x4 __attribute__((ext_vector_type(4)));
constexpr int BM = 256, BK = 64, HALF = 128, HTB = HALF * BK * 2  , STAGE_BYTES = 8 * HTB, NXCD = 8, WGM = 8;

__host__ __device__ __forceinline__ int lds_byte(int r, int c) { const int st = (r >> 4) * 2 + (c >> 5), rr = r & 15, cc = c & 31, ob = rr * 64 + cc * 2; return st * 1024 + (ob ^ (((ob >> 9) & 1) << 5)); }
__host__ __device__ __forceinline__ void stage_rc(int b, int& R, int& C) { const int st = b / 1024, sb = b % 1024, swz = sb ^ (((sb >> 9) & 1) << 5); R = (st >> 1) * 16 + swz / 64; C = (st & 1) * 32 + (swz % 64) / 2; }
__host__ __device__ __forceinline__ int perm32(int rho) { const int n = rho >> 4, i = rho & 15; return 8 * (i >> 2) + 4 * n + (i & 3); }

struct Unit { int pm, pn; };
struct Gemm { const bf16_t* A; const bf16_t* Bt; int M, N, K; };

struct StaticOrder {
    int nM, nN, nwg, G, c;
    __host__ __device__ void init(int M, int N, int G_, int c_) { nM = M / BM; nN = N / BM; nwg = nM * nN; G = G_; c = c_; }
    __host__ __device__ bool next(int i, Unit& u) const {
        const long L = (long)i * G + c; if (L >= nwg) return false;
        int wgid = (int)L; { const int q = nwg / NXCD, r = nwg % NXCD, xcd = wgid % NXCD, off = wgid / NXCD; wgid = (xcd < r ? xcd * (q + 1) : r * (q + 1) + (xcd - r) * q) + off; }
        const int nig = WGM * nN, gid = wgid / nig, fm = gid * WGM, gsz = (nM - fm) < WGM ? (nM - fm) : WGM;
        u.pm = fm + ((wgid % nig) % gsz); u.pn = (wgid % nig) / gsz; return true;
    }
    __device__ __forceinline__ void a_ready(const Unit&) const {}
    __device__ __forceinline__ void done(const Unit&) const {}
};

__device__ __forceinline__ unsigned cvt_pk_bf16(float lo, float hi) { unsigned r; asm volatile("v_cvt_pk_bf16_f32 %0, %1, %2" : "=v"(r) : "v"(lo), "v"(hi)); return r; }

struct EpiInProj {
    static constexpr bool PERM = true, AFTER_DRAIN = false;
    bf16_t* P;
    __device__ __forceinline__ void operator()(const f32x4 (&acc)[2][2][4][2], const Unit& u, int wr, int wc, int fr, int fq) const {
        const int row0 = u.pm * BM + wr * 64 + fr, col0 = u.pn * BM + wc * 32 + 8 * fq, grp = u.pn >> 1;
#pragma unroll
        for (int ai = 0; ai < 2; ++ai)
#pragma unroll
            for (int m = 0; m < 4; ++m) { bf16_t* rowp = P + (size_t)(row0 + ai * HALF + m * 16) * NIN + col0;
#pragma unroll
                for (int bj = 0; bj < 2; ++bj) { f32x4 v0 = acc[ai][bj][m][0], v1 = acc[ai][bj][m][1];
                    if (grp == 1) {
#pragma unroll
                        for (int j = 0; j < 4; ++j) { v0[j] = gelu_tanh(v0[j]); v1[j] = gelu_tanh(v1[j]); } }
                    else if (grp == 2 || grp == 6) {
#pragma unroll
                        for (int j = 0; j < 4; ++j) { v0[j] = siluf_(v0[j]); v1[j] = siluf_(v1[j]); } }
                    u32x4 w; w.x = cvt_pk_bf16(v0[0], v0[1]); w.y = cvt_pk_bf16(v0[2], v0[3]); w.z = cvt_pk_bf16(v1[0], v1[1]); w.w = cvt_pk_bf16(v1[2], v1[3]);
                    *(u32x4*)(rowp + bj * HALF) = w; } }
    }
};
struct EpiF32 {
    static constexpr bool PERM = false, AFTER_DRAIN = false;
    float* C; int ldc; int pad;
    __device__ __forceinline__ void operator()(const f32x4 (&acc)[2][2][4][2], const Unit& u, int wr, int wc, int fr, int fq) const {
        const int row0 = u.pm * BM + wr * 64 + fr, col0 = u.pn * BM + wc * 32 + 4 * fq;
#pragma unroll
        for (int ai = 0; ai < 2; ++ai)
#pragma unroll
            for (int m = 0; m < 4; ++m) { float* rowp = C + (size_t)(row0 + ai * HALF + m * 16) * ldc + col0;
#pragma unroll
                for (int bj = 0; bj < 2; ++bj)
#pragma unroll
                    for (int n = 0; n < 2; ++n) *(f32x4*)(rowp + bj * HALF + n * 16) = acc[ai][bj][m][n]; }
    }
};
struct EpiExp1 {
    static constexpr bool PERM = false, AFTER_DRAIN = false;
    bf16_t* H;
    __device__ __forceinline__ void operator()(const f32x4 (&acc)[2][2][4][2], const Unit& u, int wr, int wc, int fr, int fq) const {
        const int row0 = u.pm * BM + wr * 64 + fr, hc0 = (((u.pn & 3) * BM + wc * 32) >> 1) + 4 * fq;
#pragma unroll
        for (int ai = 0; ai < 2; ++ai)
#pragma unroll
            for (int m = 0; m < 4; ++m) { bf16_t* rowp = H + (size_t)(row0 + ai * HALF + m * 16) * DE + hc0;
#pragma unroll
                for (int bj = 0; bj < 2; ++bj) { const f32x4 a = acc[ai][bj][m][0], b = acc[ai][bj][m][1];
                    u32x2 w; w.x = cvt_pk_bf16(siluf_(a[0]) * b[0], siluf_(a[1]) * b[1]); w.y = cvt_pk_bf16(siluf_(a[2]) * b[2], siluf_(a[3]) * b[3]);
                    *(u32x2*)(rowp + bj * 64) = w; } }
    }
};
struct EpiY {
    static constexpr bool PERM = true, AFTER_DRAIN = false;
    bf16_t* Y;
    __device__ __forceinline__ void operator()(const f32x4 (&acc)[2][2][4][2], const Unit& u, int wr, int wc, int fr, int fq) const {
        const int row0 = u.pm * BM + wr * 64 + fr, col0 = (u.pn & 3) * BM + wc * 32 + 8 * fq;
#pragma unroll
        for (int ai = 0; ai < 2; ++ai)
#pragma unroll
            for (int m = 0; m < 4; ++m) { bf16_t* rowp = Y + (size_t)(row0 + ai * HALF + m * 16) * DM + col0;
#pragma unroll
                for (int bj = 0; bj < 2; ++bj) { const f32x4 v0 = acc[ai][bj][m][0], v1 = acc[ai][bj][m][1];
                    u32x4 w; w.x = cvt_pk_bf16(v0[0], v0[1]); w.y = cvt_pk_bf16(v0[2], v0[3]); w.z = cvt_pk_bf16(v1[0], v1[1]); w.w = cvt_pk_bf16(v1[2], v1[3]);
                    *(u32x4*)(rowp + bj * HALF) = w; } }
    }
};
struct ExpertOrder {
    const int* counts; int G, c;
    __device__ __forceinline__ bool next(int i, Unit& u) const {
        const int L = i * G + c, rb = L >> 2; int acc = 0, ef = -1;
        for (int e = 0; e < NE; ++e) { const int nb = (counts[e] + 255) >> 8; if (rb >= acc && rb < acc + nb) ef = e; acc += nb; }
        if (ef < 0) return false;
        u.pm = rb; u.pn = ef * 4 + (L & 3); return true;
    }
    __device__ __forceinline__ void a_ready(const Unit&) const {}
    __device__ __forceinline__ void done(const Unit&) const {}
};

template <class Epi, class Sched, bool ALIGN_EPI = false, bool SP2 = false>
__device__ __forceinline__ void gemm_phase(PG8_LAS unsigned char* lds, const Gemm g, const Sched& S, const Epi& E) {
    const int tid = threadIdx.x, wid = __builtin_amdgcn_readfirstlane(tid >> 6), lane = tid & 63, wr = wid >> 2, wc = wid & 3, fr = lane & 15, fq = lane >> 4;
    const int K = g.K, nt = K / BK;
    unsigned voffA[2], voffB[2];
#pragma unroll
    for (int i = 0; i < 2; ++i) { int R, C; stage_rc(tid * 16 + i * 8192, R, C); const int Rb = Epi::PERM ? ((R & ~31) + perm32(R & 31)) : R;
        voffA[i] = (unsigned)(R * K + C) * 2u; voffB[i] = (unsigned)(Rb * K + C) * 2u; }
    const size_t kstep = (size_t)(BK * 2);
    const size_t hstep = (size_t)HALF * K * 2;
    const size_t tstep = 2 * hstep;
    const unsigned ldsw = (unsigned)wid * 1024u;
    const int aoff = lds_byte(wr * 64 + fr, fq * 8), boff = lds_byte(wc * 32 + fr, fq * 8);
#define PG8_SA(b, h) (((b) * 2 + (h)) * HTB)
#define PG8_SB(b, h) ((4 + (b) * 2 + (h)) * HTB)
#define PG8_STAGE(bufoff, gbase, voff) do { _Pragma("unroll") for (int _i = 0; _i < 2; ++_i) \
        __builtin_amdgcn_global_load_lds((const unsigned*)((const char*)(gbase) + (voff)[_i]), (PG8_LAS unsigned*)(lds + (bufoff) + ldsw + _i * 8192), 16, 0, 0); } while (0)
#define PG8_LDA(dst, b, h) do { _Pragma("unroll") for (int m = 0; m < 4; ++m) _Pragma("unroll") for (int k = 0; k < 2; ++k) dst[m][k] = *(const PG8_LAS bf16x8*)(lds + PG8_SA(b, h) + aoff + m * 2048 + k * 1024); } while (0)
#define PG8_LDB(dst, b, h) do { _Pragma("unroll") for (int n = 0; n < 2; ++n) _Pragma("unroll") for (int k = 0; k < 2; ++k) dst[n][k] = *(const PG8_LAS bf16x8*)(lds + PG8_SB(b, h) + boff + n * 2048 + k * 1024); } while (0)
#define PG8_MMA(ai, bj, At, Bt) do { __builtin_amdgcn_s_setprio(1); _Pragma("unroll") for (int m = 0; m < 4; ++m) _Pragma("unroll") for (int n = 0; n < 2; ++n) _Pragma("unroll") for (int k = 0; k < 2; ++k) \
        acc[ai][bj][m][n] = __builtin_amdgcn_mfma_f32_16x16x32_bf16(Bt[n][k], At[m][k], acc[ai][bj][m][n], 0, 0, 0); __builtin_amdgcn_s_setprio(0); } while (0)
#define PG8_WAIT_V(n) asm volatile("s_waitcnt vmcnt(" #n ")" ::: "memory")
#define PG8_WAIT_L(n) asm volatile("s_waitcnt lgkmcnt(" #n ")" ::: "memory")
#define PG8_BAR __builtin_amdgcn_s_barrier()
#define PG8_SCHED __builtin_amdgcn_sched_barrier(0)
    Unit cur, nxt; int ui = 0;
    if (!S.next(0, cur)) return;
    f32x4 acc[2][2][4][2];
#pragma unroll
    for (int a = 0; a < 2; ++a)
#pragma unroll
        for (int b = 0; b < 2; ++b)
#pragma unroll
            for (int m = 0; m < 4; ++m)
#pragma unroll
                for (int n = 0; n < 2; ++n) acc[a][b][m][n] = (f32x4){0.f, 0.f, 0.f, 0.f};
    bf16x8 At[4][2], B0[2][2], B1[2][2];
    const char* cA = (const char*)g.A + (size_t)cur.pm * tstep; const char* cB = (const char*)g.Bt + (size_t)cur.pn * tstep;
    S.a_ready(cur);
    if constexpr (SP2) {
        PG8_STAGE(PG8_SB(0, 0), cB, voffB); PG8_STAGE(PG8_SB(0, 1), cB + hstep, voffB); PG8_STAGE(PG8_SA(0, 0), cA, voffA); PG8_STAGE(PG8_SA(0, 1), cA + hstep, voffA);
        if (wr == 1) PG8_BAR;
        PG8_WAIT_V(2); PG8_BAR;
        PG8_STAGE(PG8_SB(1, 0), cB + kstep, voffB); PG8_STAGE(PG8_SA(1, 0), cA + kstep, voffA); PG8_STAGE(PG8_SB(1, 1), cB + hstep + kstep, voffB);
        PG8_WAIT_V(6); PG8_BAR;
    } else {
        PG8_STAGE(PG8_SB(0, 0), cB, voffB); PG8_STAGE(PG8_SA(0, 0), cA, voffA); PG8_STAGE(PG8_SB(0, 1), cB + hstep, voffB); PG8_STAGE(PG8_SA(0, 1), cA + hstep, voffA);
        if (wr == 1) PG8_BAR;
        PG8_WAIT_V(4); PG8_BAR;
        PG8_STAGE(PG8_SB(1, 0), cB + kstep, voffB); PG8_STAGE(PG8_SA(1, 0), cA + kstep, voffA); PG8_STAGE(PG8_SB(1, 1), cB + hstep + kstep, voffB);
        PG8_WAIT_V(6); PG8_BAR;
    }
    for (;;) {
        const bool has_next = S.next(ui + 1, nxt);
        const char* nA = has_next ? (const char*)g.A + (size_t)nxt.pm * tstep : cA; const char* nB = has_next ? (const char*)g.Bt + (size_t)nxt.pn * tstep : cB;
        for (int t = 0; t < nt; t += 2) {
            const bool last = (t == nt - 2);
            const char* a1 = cA + (size_t)(t + 1) * kstep;
            const char* a2 = last ? nA : cA + (size_t)(t + 2) * kstep; const char* b2 = last ? nB : cB + (size_t)(t + 2) * kstep;
            const char* a3 = a2 + kstep; const char* b3 = b2 + kstep;
            if (last && has_next) S.a_ready(nxt);
            if constexpr (SP2) {
            PG8_LDB(B0, 0, 0); PG8_LDB(B1, 0, 1); PG8_SCHED; PG8_LDA(At, 0, 0); PG8_STAGE(PG8_SA(1, 1), a1 + hstep, voffA);
            PG8_WAIT_V(8); PG8_WAIT_L(0); PG8_BAR; PG8_MMA(0, 0, At, B0); PG8_MMA(0, 1, At, B1); PG8_BAR; PG8_SCHED;
            PG8_LDA(At, 0, 1); PG8_STAGE(PG8_SB(0, 0), b2, voffB); PG8_STAGE(PG8_SB(0, 1), b2 + hstep, voffB); PG8_STAGE(PG8_SA(0, 0), a2, voffA);
            PG8_WAIT_V(8); PG8_WAIT_L(0); PG8_BAR; PG8_MMA(1, 0, At, B0); PG8_MMA(1, 1, At, B1); PG8_BAR; PG8_SCHED;
            PG8_LDB(B0, 1, 0); PG8_LDB(B1, 1, 1); PG8_SCHED; PG8_LDA(At, 1, 0); PG8_STAGE(PG8_SA(0, 1), a2 + hstep, voffA);
            PG8_WAIT_V(8); PG8_WAIT_L(0); PG8_BAR; PG8_MMA(0, 0, At, B0); PG8_MMA(0, 1, At, B1); PG8_BAR; PG8_SCHED;
            PG8_LDA(At, 1, 1); PG8_STAGE(PG8_SB(1, 0), b3, voffB); PG8_STAGE(PG8_SB(1, 1), b3 + hstep, voffB); PG8_STAGE(PG8_SA(1, 0), a3, voffA);
            PG8_WAIT_V(8); PG8_WAIT_L(0); PG8_BAR; PG8_MMA(1, 0, At, B0); PG8_MMA(1, 1, At, B1); PG8_BAR; PG8_SCHED;
            } else {
            PG8_LDB(B0, 0, 0); PG8_SCHED; PG8_LDA(At, 0, 0); PG8_STAGE(PG8_SA(1, 1), a1 + hstep, voffA);
            PG8_WAIT_L(8); PG8_BAR; PG8_WAIT_L(0); PG8_MMA(0, 0, At, B0); PG8_BAR; PG8_SCHED;
            PG8_LDB(B1, 0, 1); PG8_STAGE(PG8_SB(0, 0), b2, voffB);
            PG8_BAR; PG8_WAIT_L(0); PG8_MMA(0, 1, At, B1); PG8_BAR;
            PG8_LDA(At, 0, 1); PG8_STAGE(PG8_SA(0, 0), a2, voffA);
            PG8_BAR; PG8_WAIT_L(0); PG8_MMA(1, 0, At, B0); PG8_BAR; PG8_SCHED;
            PG8_STAGE(PG8_SB(0, 1), b2 + hstep, voffB);
            PG8_WAIT_V(6); PG8_BAR; PG8_MMA(1, 1, At, B1); PG8_BAR;
            PG8_LDB(B0, 1, 0); PG8_SCHED; PG8_LDA(At, 1, 0); PG8_STAGE(PG8_SA(0, 1), a2 + hstep, voffA);
            PG8_WAIT_L(8); PG8_BAR; PG8_WAIT_L(0); PG8_MMA(0, 0, At, B0); PG8_BAR; PG8_SCHED;
            PG8_LDB(B1, 1, 1); PG8_STAGE(PG8_SB(1, 0), b3, voffB);
            PG8_BAR; PG8_WAIT_L(0); PG8_MMA(0, 1, At, B1); PG8_BAR;
            PG8_LDA(At, 1, 1); PG8_STAGE(PG8_SA(1, 0), a3, voffA);
            PG8_BAR; PG8_WAIT_L(0); PG8_MMA(1, 0, At, B0); PG8_BAR; PG8_SCHED;
            PG8_STAGE(PG8_SB(1, 1), b3 + hstep, voffB);
            PG8_WAIT_V(6); PG8_BAR; PG8_MMA(1, 1, At, B1); PG8_BAR;
            }
        }
        if constexpr (ALIGN_EPI) { if (wr == 0) PG8_BAR; }
        if constexpr (!Epi::AFTER_DRAIN) { E(acc, cur, wr, wc, fr, fq); S.done(cur); }
        if (!has_next) break;
#pragma unroll
        for (int a = 0; a < 2; ++a)
#pragma unroll
            for (int b = 0; b < 2; ++b)
#pragma unroll
                for (int m = 0; m < 4; ++m)
#pragma unroll
                    for (int n = 0; n < 2; ++n) acc[a][b][m][n] = (f32x4){0.f, 0.f, 0.f, 0.f};
        cur = nxt; cA = nA; cB = nB; ++ui;
        if constexpr (ALIGN_EPI) { if (wr == 1) PG8_BAR; }
    }
    PG8_WAIT_V(0);
    if constexpr (!ALIGN_EPI) { if (wr == 0) PG8_BAR; }
    PG8_BAR;
    if constexpr (Epi::AFTER_DRAIN) { E.fused(acc, cur, wr, wc, fr, fq, lds, wid, lane); S.done(cur); }
#undef PG8_SA
#undef PG8_SB
#undef PG8_STAGE
#undef PG8_LDA
#undef PG8_LDB
#undef PG8_MMA
#undef PG8_WAIT_V
#undef PG8_WAIT_L
#undef PG8_BAR
#undef PG8_SCHED
}
}

struct Args { const float* in[26]; float* out; unsigned char* ws; };

__device__ __forceinline__ void p_mod(LAS unsigned char* lds, const float* __restrict__ c, const float* __restrict__ c_ctx, const float* __restrict__ ada_w,
                                      const float* __restrict__ ada_b, float* __restrict__ mod, int bid, int G, int tid) {
    if (bid >= 96) return;
    LAS float* s = (LAS float*)lds;
    LAS float* red = s + 17 * 1024;
    for (int i = tid; i < 17 * 1024; i += NTHREADS) { const int r = i >> 10, k = i & 1023; const float v = r < NB ? c[r * DM + k] : c_ctx[k]; s[i] = v / (1.0f + expf(-v)); }
    __syncthreads();
    for (int it = bid; it < 96; it += G) {
        const int cc = tid & 63, kg = tid >> 6, col = it * 64 + cc;
        float acc[17];
#pragma unroll
        for (int r = 0; r < 17; ++r) acc[r] = 0.f;
        for (int k = kg * 128; k < kg * 128 + 128; ++k) {
            const float w = ada_w[(size_t)k * 6144 + col];
#pragma unroll
            for (int r = 0; r < 17; ++r) acc[r] += s[r * 1024 + k] * w;
        }
#pragma unroll
        for (int r = 0; r < 17; ++r) red[(kg * 17 + r) * 64 + cc] = acc[r];
        __syncthreads();
        for (int i = tid; i < 17 * 64; i += NTHREADS) {
            const int r = i >> 6, c2 = i & 63; float sum = 0.f;
#pragma unroll
            for (int g = 0; g < 8; ++g) sum += red[(g * 17 + r) * 64 + c2];
            mod[(size_t)r * 6144 + it * 64 + c2] = sum + ada_b[it * 64 + c2];
        }
        __syncthreads();
    }
}

__device__ __forceinline__ void transpose_tile(LAS float* tile, const float* __restrict__ W, int K, int N, bf16_t* __restrict__ O, int mode, int k0, int n0, int tid) {
    for (int i = tid; i < 64 * 64; i += NTHREADS) { const int kk = i >> 6, nn = i & 63; tile[kk * 65 + nn] = W[(size_t)(k0 + kk) * N + n0 + nn]; }
    __syncthreads();
    for (int i = tid; i < 64 * 32; i += NTHREADS) {
        const int nn = i >> 5, kp = i & 31, n = n0 + nn;
        const int orow = mode == 0 ? n : ((n >> 4) * 32 + (mode == 2 ? 16 : 0) + (n & 15));
        *(unsigned*)(O + (size_t)orow * K + k0 + 2 * kp) = pk2(tile[(2 * kp) * 65 + nn], tile[(2 * kp + 1) * 65 + nn]);
    }
    __syncthreads();
}
__device__ __forceinline__ void p_transposes(LAS unsigned char* lds, const Args& a, int bid, int G, int tid) {
    LAS float* tile = (LAS float*)lds;
    unsigned char* ws = a.ws;
    constexpr int I_IN = 16 * 56, I_OUT = 16 * 16, I_E = 32 * 128;
    constexpr int NITEMS = I_IN + I_OUT + 3 * I_E;
    for (int it = bid; it < NITEMS; it += G) {
        int r = it;
        if (r < I_IN) { transpose_tile(tile, a.in[6], DM, NIN, (bf16_t*)(ws + WS_WINT), 0, (r & 15) * 64, (r >> 4) * 64, tid); continue; } r -= I_IN;
        if (r < I_OUT) { transpose_tile(tile, a.in[14], DM, DM, (bf16_t*)(ws + WS_WOUTT), 0, (r & 15) * 64, (r >> 4) * 64, tid); continue; } r -= I_OUT;
        if (r < I_E) { const int e = r >> 7, q = r & 127; transpose_tile(tile, a.in[21] + (size_t)e * DM * DE, DM, DE, (bf16_t*)(ws + WS_W13T) + (size_t)e * DM * DM, 1, (q & 15) * 64, (q >> 4) * 64, tid); continue; } r -= I_E;
        if (r < I_E) { const int e = r >> 7, q = r & 127; transpose_tile(tile, a.in[22] + (size_t)e * DM * DE, DM, DE, (bf16_t*)(ws + WS_W13T) + (size_t)e * DM * DM, 2, (q & 15) * 64, (q >> 4) * 64, tid); continue; } r -= I_E;
        { const int e = r >> 7, q = r & 127; transpose_tile(tile, a.in[23] + (size_t)e * DE * DM, DE, DM, (bf16_t*)(ws + WS_W2T) + (size_t)e * DM * DE, 0, (q & 7) * 64, (q >> 3) * 64, tid); }
    }
}

__device__ __forceinline__ void p_u(const float* __restrict__ x, const float* __restrict__ ctx, const float* __restrict__ mod, bf16_t* __restrict__ U, int bid, int G, int tid) {
    for (size_t i4 = (size_t)bid * NTHREADS + tid; i4 < (size_t)TA * 256; i4 += (size_t)G * NTHREADS) {
        const int row = (int)(i4 >> 8), c4 = (int)(i4 & 255) * 4;
        const float* src; const float* m;
        if (row < T) { src = x + (size_t)row * DM; m = mod + (size_t)(row / SEQ) * 6144; }
        else { src = ctx + (size_t)(row - T) * DM; m = mod + (size_t)16 * 6144; }
        const f32x4 v = *(const f32x4*)(src + c4), sh = *(const f32x4*)(m + c4), sc = *(const f32x4*)(m + 1024 + c4);
        u32x2 w; w.x = pk2(v[0] * (1.f + sc[0]) + sh[0], v[1] * (1.f + sc[1]) + sh[1]); w.y = pk2(v[2] * (1.f + sc[2]) + sh[2], v[3] * (1.f + sc[3]) + sh[3]);
        *(u32x2*)(U + (size_t)row * DM + c4) = w;
    }
}

__device__ __forceinline__ void p_rglru_naive(LAS unsigned char* lds, const bf16_t* __restrict__ proj, const float* __restrict__ conv_w, const float* __restrict__ conv_b,
                                              const float* __restrict__ gate_w, const float* __restrict__ gate_b, const float* __restrict__ lam,
                                              float* __restrict__ rgsum, int b, int wave, int lane) {
    LAS float* xcs = (LAS float*)lds + wave * 4096;
    const int n = wave, c = lane, ch = n * 64 + c;
    const float cw0 = conv_w[0 * 512 + ch], cw1 = conv_w[1 * 512 + ch], cw2 = conv_w[2 * 512 + ch], cw3 = conv_w[3 * 512 + ch], cb = conv_b[ch];
    for (int dir = 0; dir < 2; ++dir) {
        float gw0[64], gw1[64];
#pragma unroll
        for (int cc = 0; cc < 64; ++cc) { gw0[cc] = gate_w[((size_t)((dir * 2 + 0) * 8 + n) * 64 + cc) * 64 + c]; gw1[cc] = gate_w[((size_t)((dir * 2 + 1) * 8 + n) * 64 + cc) * 64 + c]; }
        const float gb0 = gate_b[(dir * 2 + 0) * 512 + ch], gb1 = gate_b[(dir * 2 + 1) * 512 + ch];
        const float sp = softplusf_(-lam[dir * 512 + ch]);
        float h = 0.f;
        for (int step = 0; step < 68; ++step) {
            int rowbase, p0, lo, hi; bool latent;
            if (step < 4) { const int cidx = dir == 0 ? step : 3 - step; rowbase = T + b * LC; p0 = cidx * 64; lo = 0; hi = LC; latent = false; }
            else { const int cidx = dir == 0 ? step - 4 : 63 - (step - 4); rowbase = b * SEQ; p0 = cidx * 64; lo = p0; hi = p0 + 64; latent = true; }
            __syncthreads();
            for (int i = 0; i < 64; ++i) {
                float xc = cb;
                const int p = p0 + i;
                if (p - 1 >= lo) xc += cw0 * bf2f(proj[(size_t)(rowbase + p - 1) * NIN + ch]);
                xc += cw1 * bf2f(proj[(size_t)(rowbase + p) * NIN + ch]);
                if (p + 1 < hi) xc += cw2 * bf2f(proj[(size_t)(rowbase + p + 1) * NIN + ch]);
                if (p + 2 < hi) xc += cw3 * bf2f(proj[(size_t)(rowbase + p + 2) * NIN + ch]);
                xcs[i * 64 + c] = xc;
            }
            __syncthreads();
            for (int ii = 0; ii < 64; ++ii) {
                const int i = dir == 0 ? ii : 63 - ii;
                float rp = gb0, ip = gb1;
#pragma unroll
                for (int cc = 0; cc < 64; ++cc) { const float xv = xcs[i * 64 + cc]; rp += xv * gw0[cc]; ip += xv * gw1[cc]; }
                const float r = sigmoidf_(rp), ig = sigmoidf_(ip);
                const float log_a = -8.0f * r * sp, aa = expf(log_a), mult = sqrtf(-expm1f(2.0f * log_a));
                h = aa * h + mult * ig * xcs[i * 64 + c];
                if (latent) { const size_t idx = (size_t)(rowbase + p0 + i) * 512 + ch; if (dir == 0) rgsum[idx] = h; else rgsum[idx] += h; }
            }
        }
    }
}
__device__ __forceinline__ void p_hgrn2_naive(LAS unsigned char* lds, const bf16_t* __restrict__ proj, const float* __restrict__ lb_logits, float* __restrict__ osum, int b, int hd, int tid) {
    LAS float* sq = (LAS float*)lds; LAS float* sf = sq + 2048; LAS float* sk = sf + 2048; LAS float* sv = sk + 2048; LAS float* part = sv + 2048;
    const int v = tid & 127, kq = tid >> 7;
    for (int dir = 0; dir < 2; ++dir) {
        float S[32];
#pragma unroll
        for (int i = 0; i < 32; ++i) S[i] = 0.f;
        const int zcol = (dir == 0 ? 1536 : 2048) + hd * 128;
        const float l0 = lb_logits[(0 * 2 + dir) * 512 + hd * 128 + v], l1 = lb_logits[(1 * 2 + dir) * 512 + hd * 128 + v];
        const float lbv = 1.0f / (1.0f + expf(l1 - l0));
        for (int step = 0; step < 272; ++step) {
            int rowbase, p0; bool latent;
            if (step < 16) { const int cidx = dir == 0 ? step : 15 - step; rowbase = T + b * LC; p0 = cidx * 16; latent = false; }
            else { const int cidx = dir == 0 ? step - 16 : 255 - (step - 16); rowbase = b * SEQ; p0 = cidx * 16; latent = true; }
            __syncthreads();
            for (int i = kq; i < 16; i += 4) {
                const bf16_t* pr = proj + (size_t)(rowbase + p0 + i) * NIN;
                const float z = bf2f(pr[zcol + v]);
                sq[i * 128 + v] = bf2f(pr[1024 + hd * 128 + v]); sf[i * 128 + v] = lbv + (1.0f - lbv) * sigmoidf_(z);
                sk[i * 128 + v] = (1.0f - lbv) * sigmoidf_(-z); sv[i * 128 + v] = bf2f(pr[2560 + hd * 128 + v]);
            }
            __syncthreads();
            for (int ii = 0; ii < 16; ++ii) {
                const int i = dir == 0 ? ii : 15 - ii;
                const float vv = sv[i * 128 + v]; float o = 0.f;
#pragma unroll
                for (int kk = 0; kk < 32; ++kk) { const int k = kq * 32 + kk; S[kk] = sf[i * 128 + k] * S[kk] + sk[i * 128 + k] * vv; o += sq[i * 128 + k] * S[kk]; }
                part[(i * 4 + kq) * 128 + v] = o;
            }
            __syncthreads();
            if (latent) for (int i = kq; i < 16; i += 4) {
                const size_t idx = (size_t)(rowbase + p0 + i) * 512 + hd * 128 + v;
                const float o = (part[(i * 4 + 0) * 128 + v] + part[(i * 4 + 1) * 128 + v]) + (part[(i * 4 + 2) * 128 + v] + part[(i * 4 + 3) * 128 + v]);
                if (dir == 0) osum[idx] = o; else osum[idx] += o;
            }
        }
    }
}
__device__ __forceinline__ void p_scan_final(LAS unsigned char* lds, const bf16_t* __restrict__ proj, const float* __restrict__ rgsum, const float* __restrict__ osum,
                                             const float* __restrict__ norm_g, bf16_t* __restrict__ mixed, int bid, int G, int tid) {
    LAS float* wsum = (LAS float*)lds;
    const int j = tid;
    for (int tok = bid; tok < T; tok += G) {
        const bf16_t* pr = proj + (size_t)tok * NIN;
        mixed[(size_t)tok * DM + j] = f2bf(rgsum[(size_t)tok * 512 + j] * bf2f(pr[512 + j]));
        const float o = osum[(size_t)tok * 512 + j];
        const float s = wave_sum(o * o);
        __syncthreads();
        if ((j & 63) == 0) wsum[j >> 6] = s;
        __syncthreads();
        const int hd = j >> 7;
        const float ms = (wsum[2 * hd] + wsum[2 * hd + 1]) * (1.0f / 128.0f);
        mixed[(size_t)tok * DM + 512 + j] = f2bf(o * rsqrtf(ms + LN_EPS) * norm_g[j] * bf2f(pr[3072 + j]));
    }
}

__device__ __forceinline__ void p_ln1_router(const Args& a, int bid, int G, int wave, int lane) {
    const float* __restrict__ x = a.in[0]; float* yo = a.out; const float* mod = (const float*)(a.ws + WS_MOD);
    const float* __restrict__ ln_g = a.in[15]; const float* __restrict__ ln_b = a.in[16];
    const float* __restrict__ rgw = a.in[17]; const float* __restrict__ rgb = a.in[18]; const float* __restrict__ rew = a.in[19]; const float* __restrict__ reb = a.in[20];
    bf16_t* U2 = (bf16_t*)(a.ws + WS_U); int* counts = (int*)(a.ws + WS_CTL);
    int2* eidx = (int2*)(a.ws + WS_EIDX); int2* epos = (int2*)(a.ws + WS_EPOS); float2* ew = (float2*)(a.ws + WS_EW);
    for (int tok = bid * 8 + wave; tok < T; tok += G * 8) {
        const float* m = mod + (size_t)(tok / SEQ) * 6144;
        f32x4 v[4]; float s = 0.f;
#pragma unroll
        for (int j = 0; j < 4; ++j) { const int c4 = 4 * lane + 256 * j;
            const f32x4 xv = *(const f32x4*)(x + (size_t)tok * DM + c4), yv = *(const f32x4*)(yo + (size_t)tok * DM + c4), g1 = *(const f32x4*)(m + 2048 + c4);
            v[j] = ALPHA * xv + g1 * yv; s += (v[j][0] + v[j][1]) + (v[j][2] + v[j][3]); }
        const float mean = wave_sum(s) * (1.0f / DM); float s2 = 0.f;
#pragma unroll
        for (int j = 0; j < 4; ++j) { v[j] = v[j] - mean; s2 += (v[j][0] * v[j][0] + v[j][1] * v[j][1]) + (v[j][2] * v[j][2] + v[j][3] * v[j][3]); }
        const float rstd = rsqrtf(wave_sum(s2) * (1.0f / DM) + LN_EPS);
        float pl[36];
#pragma unroll
        for (int e = 0; e < 36; ++e) pl[e] = 0.f;
#pragma unroll
        for (int j = 0; j < 4; ++j) { const int c4 = 4 * lane + 256 * j;
            const f32x4 h1 = v[j] * rstd * *(const f32x4*)(ln_g + c4) + *(const f32x4*)(ln_b + c4);
            *(f32x4*)(yo + (size_t)tok * DM + c4) = h1;
            const f32x4 u2 = h1 * (1.0f + *(const f32x4*)(m + 4096 + c4)) + *(const f32x4*)(m + 3072 + c4);
            u32x2 w; w.x = pk2(u2[0], u2[1]); w.y = pk2(u2[2], u2[3]);
            *(u32x2*)(U2 + (size_t)tok * DM + c4) = w;
#pragma unroll
            for (int q = 0; q < 4; ++q) { const float uu = u2[q];
                const f32x4 wg = *(const f32x4*)(rgw + (size_t)(c4 + q) * 4);
#pragma unroll
                for (int e = 0; e < 4; ++e) pl[e] += uu * wg[e];
#pragma unroll
                for (int e4 = 0; e4 < 8; ++e4) { const f32x4 we = *(const f32x4*)(rew + (size_t)(c4 + q) * 32 + e4 * 4);
#pragma unroll
                    for (int r = 0; r < 4; ++r) pl[4 + e4 * 4 + r] += uu * we[r]; } }
        }
#pragma unroll
        for (int e = 0; e < 36; ++e) pl[e] = wave_sum(pl[e]) + (e < 4 ? rgb[e] : reb[e - 4]);
        int gi = 0; float gm = pl[0];
#pragma unroll
        for (int g = 1; g < 4; ++g) if (pl[g] > gm) { gm = pl[g]; gi = g; }
        float den = 0.f;
#pragma unroll
        for (int g = 0; g < 4; ++g) den += expf(pl[g] - gm);
        const float gval = 1.0f / den;
        float lv[8];
#pragma unroll
        for (int e = 0; e < 8; ++e) lv[e] = gi == 0 ? pl[4 + e] : gi == 1 ? pl[12 + e] : gi == 2 ? pl[20 + e] : pl[28 + e];
        int e0 = 0; float v0 = lv[0];
#pragma unroll
        for (int e = 1; e < 8; ++e) if (lv[e] > v0) { v0 = lv[e]; e0 = e; }
        int e1 = -1; float v1 = -3.0e38f;
#pragma unroll
        for (int e = 0; e < 8; ++e) if (e != e0 && (e1 < 0 || lv[e] > v1)) { v1 = lv[e]; e1 = e; }
        if (lane == 0) {
            const float t = expf(v1 - v0), w0 = 1.0f / (1.0f + t), w1 = t / (1.0f + t);
            const int id0 = gi * 8 + e0, id1 = gi * 8 + e1;
            const int p0 = atomicAdd(&counts[id0], 1), p1 = atomicAdd(&counts[id1], 1);
            eidx[tok] = make_int2(id0, id1); epos[tok] = make_int2(p0, p1); ew[tok] = make_float2(gval * w0, gval * w1);
        }
    }
}

__device__ __forceinline__ void p_gather(const Args& a, int bid, int G, int wave, int lane) {
    const bf16_t* U2 = (const bf16_t*)(a.ws + WS_U); const int* counts = (const int*)(a.ws + WS_CTL);
    const int2* eidx = (const int2*)(a.ws + WS_EIDX); const int2* epos = (const int2*)(a.ws + WS_EPOS); int2* dest = (int2*)(a.ws + WS_DEST);
    bf16_t* XG = (bf16_t*)(a.ws + WS_XG);
    for (int tok = bid * 8 + wave; tok < T; tok += G * 8) {
        const int2 ei = eidx[tok], ep = epos[tok];
        const int d0 = pstart_of(counts, ei.x) + ep.x, d1 = pstart_of(counts, ei.y) + ep.y;
        const u32x4 v0 = *(const u32x4*)(U2 + (size_t)tok * DM + lane * 8), v1 = *(const u32x4*)(U2 + (size_t)tok * DM + 512 + lane * 8);
        *(u32x4*)(XG + (size_t)d0 * DM + lane * 8) = v0; *(u32x4*)(XG + (size_t)d0 * DM + 512 + lane * 8) = v1;
        *(u32x4*)(XG + (size_t)d1 * DM + lane * 8) = v0; *(u32x4*)(XG + (size_t)d1 * DM + 512 + lane * 8) = v1;
        if (lane == 0) dest[tok] = make_int2(d0, d1);
    }
}

__device__ __forceinline__ void p_combine_ln2(const Args& a, int bid, int G, int wave, int lane) {
    float* out = a.out; const bf16_t* Y = (const bf16_t*)(a.ws + WS_Y); const int2* dest = (const int2*)(a.ws + WS_DEST); const float2* ew = (const float2*)(a.ws + WS_EW);
    const float* mod = (const float*)(a.ws + WS_MOD); const float* __restrict__ ln_g = a.in[24]; const float* __restrict__ ln_b = a.in[25];
    for (int tok = bid * 8 + wave; tok < T; tok += G * 8) {
        const float* m = mod + (size_t)(tok / SEQ) * 6144;
        const int2 d = dest[tok]; const float2 w = ew[tok];
        f32x4 v[4]; float s = 0.f;
#pragma unroll
        for (int j = 0; j < 4; ++j) { const int c4 = 4 * lane + 256 * j;
            const u32x2 ya = *(const u32x2*)(Y + (size_t)d.x * DM + c4), yb = *(const u32x2*)(Y + (size_t)d.y * DM + c4);
            f32x4 f;
            f[0] = w.x * __uint_as_float(ya.x << 16) + w.y * __uint_as_float(yb.x << 16);
            f[1] = w.x * __uint_as_float(ya.x & 0xffff0000u) + w.y * __uint_as_float(yb.x & 0xffff0000u);
            f[2] = w.x * __uint_as_float(ya.y << 16) + w.y * __uint_as_float(yb.y << 16);
            f[3] = w.x * __uint_as_float(ya.y & 0xffff0000u) + w.y * __uint_as_float(yb.y & 0xffff0000u);
            const f32x4 h1 = *(const f32x4*)(out + (size_t)tok * DM + c4), g2 = *(const f32x4*)(m + 5120 + c4);
            v[j] = ALPHA * h1 + g2 * f; s += (v[j][0] + v[j][1]) + (v[j][2] + v[j][3]); }
        const float mean = wave_sum(s) * (1.0f / DM); float s2 = 0.f;
#pragma unroll
        for (int j = 0; j < 4; ++j) { v[j] = v[j] - mean; s2 += (v[j][0] * v[j][0] + v[j][1] * v[j][1]) + (v[j][2] * v[j][2] + v[j][3] * v[j][3]); }
        const float rstd = rsqrtf(wave_sum(s2) * (1.0f / DM) + LN_EPS);
#pragma unroll
        for (int j = 0; j < 4; ++j) { const int c4 = 4 * lane + 256 * j;
            *(f32x4*)(out + (size_t)tok * DM + c4) = v[j] * rstd * *(const f32x4*)(ln_g + c4) + *(const f32x4*)(ln_b + c4); }
    }
}

__global__ void __launch_bounds__(NTHREADS, 2) mega(Args a) {
    extern __shared__ __attribute__((aligned(16))) unsigned char lds_raw[];
    LAS unsigned char* lds = (LAS unsigned char*)lds_raw;
    cg::grid_group grid = cg::this_grid();
    const int tid = threadIdx.x, lane = tid & 63, wave = __builtin_amdgcn_readfirstlane(tid >> 6), bid = blockIdx.x, G = gridDim.x;
    unsigned char* ws = a.ws;
    float* mod = (float*)(ws + WS_MOD);
    bf16_t* U = (bf16_t*)(ws + WS_U); float* rgsum = (float*)(ws + WS_U);
    bf16_t* PROJ = (bf16_t*)(ws + WS_PROJ); bf16_t* MIXED = (bf16_t*)(ws + WS_MIXED); float* osum = (float*)(ws + WS_OSUM);

    p_mod(lds, a.in[1], a.in[3], a.in[4], a.in[5], mod, bid, G, tid);
    p_transposes(lds, a, bid, G, tid);
    grid.sync();
    p_u(a.in[0], a.in[2], mod, U, bid, G, tid);
    grid.sync();
    { pg8::Gemm g{U, (const bf16_t*)(ws + WS_WINT), TA, NIN, DM}; pg8::StaticOrder S; S.init(TA, NIN, G, bid);
      pg8::EpiInProj E{PROJ};
      pg8::gemm_phase<pg8::EpiInProj, pg8::StaticOrder, true, true>(lds, g, S, E); }
    grid.sync();
    if (bid < 16) p_rglru_naive(lds, PROJ, a.in[7], a.in[8], a.in[9], a.in[10], a.in[11], rgsum, bid, wave, lane);
    else if (bid < 80) p_hgrn2_naive(lds, PROJ, a.in[12], osum, (bid - 16) >> 2, (bid - 16) & 3, tid);
    grid.sync();
    p_scan_final(lds, PROJ, rgsum, osum, a.in[13], MIXED, bid, G, tid);
    grid.sync();
    { pg8::Gemm g{MIXED, (const bf16_t*)(ws + WS_WOUTT), T, DM, DM}; pg8::StaticOrder S; S.init(T, DM, G, bid);
      pg8::EpiF32 E{a.out, DM, 0};
      pg8::gemm_phase<pg8::EpiF32, pg8::StaticOrder, true, true>(lds, g, S, E); }
    grid.sync();
    p_ln1_router(a, bid, G, wave, lane);
    grid.sync();
    p_gather(a, bid, G, wave, lane);
    grid.sync();
    { pg8::Gemm g{(const bf16_t*)(ws + WS_XG), (const bf16_t*)(ws + WS_W13T), MAXROWS, NE * DM, DM}; pg8::ExpertOrder S{(const int*)(ws + WS_CTL), G, bid};
      pg8::EpiExp1 E{(bf16_t*)(ws + WS_HID)};
      pg8::gemm_phase<pg8::EpiExp1, pg8::ExpertOrder, true, true>(lds, g, S, E); }
    grid.sync();
    { pg8::Gemm g{(const bf16_t*)(ws + WS_HID), (const bf16_t*)(ws + WS_W2T), MAXROWS, NE * DM, DE}; pg8::ExpertOrder S{(const int*)(ws + WS_CTL), G, bid};
      pg8::EpiY E{(bf16_t*)(ws + WS_Y)};
      pg8::gemm_phase<pg8::EpiY, pg8::ExpertOrder, true, true>(lds, g, S, E); }
    grid.sync();
    p_combine_ln2(a, bid, G, wave, lane);
}

extern "C" void kernel_launch(void* const* d_in, const int* in_sizes, int n_in, void* d_out, int out_size, void* d_ws, size_t ws_size, hipStream_t stream) {
    static int grid = 0;
    if (grid == 0) {
        if (n_in != 26 || ws_size < WS_END) { fprintf(stderr, "kernel_launch: unexpected n_in %d or workspace %zu < %zu\n", n_in, ws_size, (size_t)WS_END); grid = -1; return; }
        int dev = 0, cus = 0, per_cu = 0;
        if (hipGetDevice(&dev) != hipSuccess || hipDeviceGetAttribute(&cus, hipDeviceAttributeMultiprocessorCount, dev) != hipSuccess) { grid = -1; return; }
        if (hipFuncSetAttribute((const void*)mega, hipFuncAttributeMaxDynamicSharedMemorySize, LDS_BYTES) != hipSuccess) { fprintf(stderr, "kernel_launch: hipFuncSetAttribute failed\n"); grid = -1; return; }
        if (hipOccupancyMaxActiveBlocksPerMultiprocessor(&per_cu, (const void*)mega, NTHREADS, LDS_BYTES) != hipSuccess || per_cu < 1) { fprintf(stderr, "kernel_launch: occupancy query says %d\n", per_cu); per_cu = 1; }
        (void)hipGetLastError();
        grid = cus;
        fprintf(stderr, "kernel_launch: grid %d (cus %d, per_cu %d), ws %zu\n", grid, cus, per_cu, ws_size);
    }
    if (grid < 0) return;
    (void)hipMemsetAsync(d_ws, 0, 4096, stream);
    Args a{};
    for (int i = 0; i < 26; ++i) a.in[i] = (const float*)d_in[i];
    a.out = (float*)d_out; a.ws = (unsigned char*)d_ws;
    void* params[] = {&a};
    hipError_t e = hipLaunchCooperativeKernel((const void*)mega, dim3(grid), dim3(NTHREADS), params, LDS_BYTES, stream);
    if (e != hipSuccess) fprintf(stderr, "kernel_launch: cooperative launch failed: %s (grid %d)\n", hipGetErrorString(e), grid);
}
```

```cpp
#include <hip/hip_runtime.h>
#include <hip/hip_cooperative_groups.h>
#include <cstdio>
#include <cstdint>
namespace cg = cooperative_groups;

typedef unsigned short bf16_t;
typedef short bf16x8 __attribute__((ext_vector_type(8)));
typedef float f32x4 __attribute__((ext_vector_type(4)));
typedef float f32x2 __attribute__((ext_vector_type(2)));
typedef unsigned u32x4 __attribute__((ext_vector_type(4)));
typedef unsigned u32x2 __attribute__((ext_vector_type(2)));
#define LAS __attribute__((address_space(3)))

constexpr int NB = 16, SEQ = 4096, LC = 256, DM = 1024;
constexpr int T = NB * SEQ;
constexpr int TC = NB * LC;
constexpr int TA = T + TC;
constexpr int NIN = 3584;
constexpr int NE = 32, DE = 512;
constexpr int MAXROWS = 2 * T + NE * 256;
constexpr float ALPHA = 1.189207115002721f;
constexpr float LN_EPS = 1e-6f;
constexpr int NTHREADS = 512;

constexpr size_t MiB = 1u << 20;
constexpr size_t WS_CTL = 0;
constexpr size_t WS_MOD = 1 * MiB;
constexpr size_t WS_EIDX = 3 * MiB;
constexpr size_t WS_EPOS = 3 * MiB + 512 * 1024;
constexpr size_t WS_EW = 4 * MiB;
constexpr size_t WS_DEST = 4 * MiB + 512 * 1024;
constexpr size_t WS_WINT = 6 * MiB;
constexpr size_t WS_WOUTT = 13 * MiB;
constexpr size_t WS_W13T = 15 * MiB;
constexpr size_t WS_W2T = 79 * MiB;
constexpr size_t WS_U = 112 * MiB;
constexpr size_t WS_PROJ = 248 * MiB;
constexpr size_t WS_XG = 248 * MiB;
constexpr size_t WS_HID = 520 * MiB;
constexpr size_t WS_Y = 656 * MiB;
constexpr size_t WS_MIXED = 724 * MiB;
constexpr size_t WS_OSUM = 852 * MiB;
constexpr size_t WS_END = 980 * MiB;
constexpr int LDS_BYTES = 147456;

__device__ __forceinline__ float bf2f(bf16_t b) { return __uint_as_float(((unsigned)b) << 16); }
__device__ __forceinline__ bf16_t f2bf(float f) { unsigned u = __float_as_uint(f); return (bf16_t)((u + 0x7fffu + ((u >> 16) & 1u)) >> 16); }
__device__ __forceinline__ unsigned pk2(float lo, float hi) { return (unsigned)f2bf(lo) | ((unsigned)f2bf(hi) << 16); }
__device__ __forceinline__ float sigmoidf_(float x) { return 1.0f / (1.0f + __expf(-x)); }
__device__ __forceinline__ float siluf_(float x) { return x / (1.0f + __expf(-x)); }
__device__ __forceinline__ float gelu_tanh(float x) {
    const float y = 0.7978845608028654f * (x + 0.044715f * x * x * x);
    const float t = 1.0f - 2.0f / (__expf(2.0f * y) + 1.0f);
    return 0.5f * x * (1.0f + t);
}
__device__ __forceinline__ float softplusf_(float x) { return fmaxf(x, 0.f) + log1pf(expf(-fabsf(x))); }
__device__ __forceinline__ float wave_sum(float v) {
#pragma unroll
    for (int o = 1; o < 64; o <<= 1) v += __shfl_xor(v, o);
    return v;
}
__device__ __forceinline__ int pstart_of(const int* __restrict__ counts, int e) {
    int acc = 0;
    for (int i = 0; i < NE; ++i) { const int p = ((counts[i] + 255) >> 8) << 8; if (i < e) acc += p; }
    return acc;
}

namespace pg8 {
#define PG8_LAS __attribute__((address_space(3)))
typedef unsigned short bf16_t;
typedef short bf16x8 __attribute__((ext_vector_type(8)));
typedef float f32x4 __attribute__((ext_vector_type(4)));
typedef unsigned u32x4 __attribute__((ext_vector_type(4)));
constexpr int BM = 256, BK = 64, HALF = 128, HTB = HALF * BK * 2  , STAGE_BYTES = 8 * HTB, NXCD = 8, WGM = 8;

__host__ __device__ __forceinline__ int lds_byte(int r, int c) { const int st = (r >> 4) * 2 + (c >> 5), rr = r & 15, cc = c & 31, ob = rr * 64 + cc * 2; return st * 1024 + (ob ^ (((ob >> 9) & 1) << 5)); }
__host__ __device__ __forceinline__ void stage_rc(int b, int& R, int& C) { const int st = b / 1024, sb = b % 1024, swz = sb ^ (((sb >> 9) & 1) << 5); R = (st >> 1) * 16 + swz / 64; C = (st & 1) * 32 + (swz % 64) / 2; }
__host__ __device__ __forceinline__ int perm32(int rho) { const int n = rho >> 4, i = rho & 15; return 8 * (i >> 2) + 4 * n + (i & 3); }

struct Unit { int pm, pn; };
struct Gemm { const bf16_t* A; const bf16_t* Bt; int M, N, K; };

struct StaticOrder {
    int nM, nN, nwg, G, c;
    __host__ __device__ void init(int M, int N, int G_, int c_) { nM = M / BM; nN = N / BM; nwg = nM * nN; G = G_; c = c_; }
    __host__ __device__ bool next(int i, Unit& u) const {
        const long L = (long)i * G + c; if (L >= nwg) return false;
        int wgid = (int)L; { const int q = nwg / NXCD, r = nwg % NXCD, xcd = wgid % NXCD, off = wgid / NXCD; wgid = (xcd < r ? xcd * (q + 1) : r * (q + 1) + (xcd - r) * q) + off; }
        const int nig = WGM * nN, gid = wgid / nig, fm = gid * WGM, gsz = (nM - fm) < WGM ? (nM - fm) : WGM;
        u.pm = fm + ((wgid % nig) % gsz); u.pn = (wgid % nig) / gsz; return true;
    }
    __device__ __forceinline__ void a_ready(const Unit&) const {}
    __device__ __forceinline__ void done(const Unit&) const {}
};

__device__ __forceinline__ unsigned cvt_pk_bf16(float lo, float hi) { unsigned r; asm volatile("v_cvt_pk_bf16_f32 %0, %1, %2" : "=v"(r) : "v"(lo), "v"(hi)); return r; }

struct EpiInProj {
    static constexpr bool PERM = true, AFTER_DRAIN = false;
    bf16_t* P;
    __device__ __forceinline__ void operator()(const f32x4 (&acc)[2][2][4][2], const Unit& u, int wr, int wc, int fr, int fq) const {
        const int row0 = u.pm * BM + wr * 64 + fr, col0 = u.pn * BM + wc * 32 + 8 * fq, grp = u.pn >> 1;
#pragma unroll
        for (int ai = 0; ai < 2; ++ai)
#pragma unroll
            for (int m = 0; m < 4; ++m) { bf16_t* rowp = P + (size_t)(row0 + ai * HALF + m * 16) * NIN + col0;
#pragma unroll
                for (int bj = 0; bj < 2; ++bj) { f32x4 v0 = acc[ai][bj][m][0], v1 = acc[ai][bj][m][1];
                    if (grp == 1) {
#pragma unroll
                        for (int j = 0; j < 4; ++j) { v0[j] = gelu_tanh(v0[j]); v1[j] = gelu_tanh(v1[j]); } }
                    else if (grp == 2 || grp == 6) {
#pragma unroll
                        for (int j = 0; j < 4; ++j) { v0[j] = siluf_(v0[j]); v1[j] = siluf_(v1[j]); } }
                    u32x4 w; w.x = cvt_pk_bf16(v0[0], v0[1]); w.y = cvt_pk_bf16(v0[2], v0[3]); w.z = cvt_pk_bf16(v1[0], v1[1]); w.w = cvt_pk_bf16(v1[2], v1[3]);
                    *(u32x4*)(rowp + bj * HALF) = w; } }
    }
};
struct EpiF32 {
    static constexpr bool PERM = false, AFTER_DRAIN = false;
    float* C; int ldc; int pad;
    __device__ __forceinline__ void operator()(const f32x4 (&acc)[2][2][4][2], const Unit& u, int wr, int wc, int fr, int fq) const {
        const int row0 = u.pm * BM + wr * 64 + fr, col0 = u.pn * BM + wc * 32 + 4 * fq;
#pragma unroll
        for (int ai = 0; ai < 2; ++ai)
#pragma unroll
            for (int m = 0; m < 4; ++m) { float* rowp = C + (size_t)(row0 + ai * HALF + m * 16) * ldc + col0;
#pragma unroll
                for (int bj = 0; bj < 2; ++bj)
#pragma unroll
                    for (int n = 0; n < 2; ++n) *(f32x4*)(rowp + bj * HALF + n * 16) = acc[ai][bj][m][n]; }
    }
};
struct EpiExp1 {
    static constexpr bool PERM = false, AFTER_DRAIN = false;
    bf16_t* H;
    __device__ __forceinline__ void operator()(const f32x4 (&acc)[2][2][4][2], const Unit& u, int wr, int wc, int fr, int fq) const {
        const int row0 = u.pm * BM + wr * 64 + fr, hc0 = (((u.pn & 3) * BM + wc * 32) >> 1) + 4 * fq;
#pragma unroll
        for (int ai = 0; ai < 2; ++ai)
#pragma unroll
            for (int m = 0; m < 4; ++m) { bf16_t* rowp = H + (size_t)(row0 + ai * HALF + m * 16) * DE + hc0;
#pragma unroll
                for (int bj = 0; bj < 2; ++bj) { const f32x4 a = acc[ai][bj][m][0], b = acc[ai][bj][m][1];
                    u32x2 w; w.x = cvt_pk_bf16(siluf_(a[0]) * b[0], siluf_(a[1]) * b[1]); w.y = cvt_pk_bf16(siluf_(a[2]) * b[2], siluf_(a[3]) * b[3]);
                    *(u32x2*)(rowp + bj * 64) = w; } }
    }
};
struct EpiY {
    static constexpr bool PERM = true, AFTER_DRAIN = false;
    bf16_t* Y;
    __device__ __forceinline__ void operator()(const f32x4 (&acc)[2][2][4][2], const Unit& u, int wr, int wc, int fr, int fq) const {
        const int row0 = u.pm * BM + wr * 64 + fr, col0 = (u.pn & 3) * BM + wc * 32 + 8 * fq;
#pragma unroll
        for (int ai = 0; ai < 2; ++ai)
#pragma unroll
            for (int m = 0; m < 4; ++m) { bf16_t* rowp = Y + (size_t)(row0 + ai * HALF + m * 16) * DM + col0;
#pragma unroll
                for (int bj = 0; bj < 2; ++bj) { const f32x4 v0 = acc[ai][bj][m][0], v1 = acc[ai][bj][m][1];
                    u32x4 w; w.x = cvt_pk_bf16(v0[0], v0[1]); w.y = cvt_pk_bf16(v0[2], v0[3]); w.z = cvt_pk_bf16(v1[0], v1[1]); w.w = cvt_pk_bf16(v1[2], v1[3]);
                    *(u32x4*)(rowp + bj * HALF) = w; } }
    }
};
struct ExpertOrder {
    const int* counts; int G, c;
    __device__ __forceinline__ bool next(int i, Unit& u) const {
        const int L = i * G + c, rb = L >> 2; int acc = 0, ef = -1;
        for (int e = 0; e < NE; ++e) { const int nb = (counts[e] + 255) >> 8; if (rb >= acc && rb < acc + nb) ef = e; acc += nb; }
        if (ef < 0) return false;
        u.pm = rb; u.pn = ef * 4 + (L & 3); return true;
    }
    __device__ __forceinline__ void a_ready(const Unit&) const {}
    __device__ __forceinline__ void done(const Unit&) const {}
};

template <class Epi, class Sched, bool ALIGN_EPI = false, bool SP2 = false>
__device__ __forceinline__ void gemm_phase(PG8_LAS unsigned char* lds, const Gemm g, const Sched& S, const Epi& E) {
    const int tid = threadIdx.x, wid = __builtin_amdgcn_readfirstlane(tid >> 6), lane = tid & 63, wr = wid >> 2, wc = wid & 3, fr = lane & 15, fq = lane >> 4;
    const int K = g.K, nt = K / BK;
    unsigned voffA[2], voffB[2];
#pragma unroll
    for (int i = 0; i < 2; ++i) { int R, C; stage_rc(tid * 16 + i * 8192, R, C); const int Rb = Epi::PERM ? ((R & ~31) + perm32(R & 31)) : R;
        voffA[i] = (unsigned)(R * K + C) * 2u; voffB[i] = (unsigned)(Rb * K + C) * 2u; }
    const size_t kstep = (size_t)(BK * 2);
    const size_t hstep = (size_t)HALF * K * 2;
    const size_t tstep = 2 * hstep;
    const unsigned ldsw = (unsigned)wid * 1024u;
    const int aoff = lds_byte(wr * 64 + fr, fq * 8), boff = lds_byte(wc * 32 + fr, fq * 8);
#define PG8_SA(b, h) (((b) * 2 + (h)) * HTB)
#define PG8_SB(b, h) ((4 + (b) * 2 + (h)) * HTB)
#define PG8_STAGE(bufoff, gbase, voff) do { _Pragma("unroll") for (int _i = 0; _i < 2; ++_i) \
        __builtin_amdgcn_global_load_lds((const unsigned*)((const char*)(gbase) + (voff)[_i]), (PG8_LAS unsigned*)(lds + (bufoff) + ldsw + _i * 8192), 16, 0, 0); } while (0)
#define PG8_LDA(dst, b, h) do { _Pragma("unroll") for (int m = 0; m < 4; ++m) _Pragma("unroll") for (int k = 0; k < 2; ++k) dst[m][k] = *(const PG8_LAS bf16x8*)(lds + PG8_SA(b, h) + aoff + m * 2048 + k * 1024); } while (0)
#define PG8_LDB(dst, b, h) do { _Pragma("unroll") for (int n = 0; n < 2; ++n) _Pragma("unroll") for (int k = 0; k < 2; ++k) dst[n][k] = *(const PG8_LAS bf16x8*)(lds + PG8_SB(b, h) + boff + n * 2048 + k * 1024); } while (0)
#define PG8_MMA(ai, bj, At, Bt) do { __builtin_amdgcn_s_setprio(1); _Pragma("unroll") for (int m = 0; m < 4; ++m) _Pragma("unroll") for (int n = 0; n < 2; ++n) _Pragma("unroll") for (int k = 0; k < 2; ++k) \
        acc[ai][bj][m][n] = __builtin_amdgcn_mfma_f32_16x16x32_bf16(Bt[n][k], At[m][k], acc[ai][bj][m][n], 0, 0, 0); __builtin_amdgcn_s_setprio(0); } while (0)
#define PG8_WAIT_V(n) asm volatile("s_waitcnt vmcnt(" #n ")" ::: "memory")
#define PG8_WAIT_L(n) asm volatile("s_waitcnt lgkmcnt(" #n ")" ::: "memory")
#define PG8_BAR __builtin_amdgcn_s_barrier()
#define PG8_SCHED __builtin_amdgcn_sched_barrier(0)
    Unit cur, nxt; int ui = 0;
    if (!S.next(0, cur)) return;
    f32x4 acc[2][2][4][2];
#pragma unroll
    for (int a = 0; a < 2; ++a)
#pragma unroll
        for (int b = 0; b < 2; ++b)
#pragma unroll
            for (int m = 0; m < 4; ++m)
#pragma unroll
                for (int n = 0; n < 2; ++n) acc[a][b][m][n] = (f32x4){0.f, 0.f, 0.f, 0.f};
    bf16x8 At[4][2], B0[2][2], B1[2][2];
    const char* cA = (const char*)g.A + (size_t)cur.pm * tstep; const char* cB = (const char*)g.Bt + (size_t)cur.pn * tstep;
    S.a_ready(cur);
    if constexpr (SP2) {
        PG8_STAGE(PG8_SB(0, 0), cB, voffB); PG8_STAGE(PG8_SB(0, 1), cB + hstep, voffB); PG8_STAGE(PG8_SA(0, 0), cA, voffA); PG8_STAGE(PG8_SA(0, 1), cA + hstep, voffA);
        if (wr == 1) PG8_BAR;
        PG8_WAIT_V(2); PG8_BAR;
        PG8_STAGE(PG8_SB(1, 0), cB + kstep, voffB); PG8_STAGE(PG8_SA(1, 0), cA + kstep, voffA); PG8_STAGE(PG8_SB(1, 1), cB + hstep + kstep, voffB);
        PG8_WAIT_V(6); PG8_BAR;
    } else {
        PG8_STAGE(PG8_SB(0, 0), cB, voffB); PG8_STAGE(PG8_SA(0, 0), cA, voffA); PG8_STAGE(PG8_SB(0, 1), cB + hstep, voffB); PG8_STAGE(PG8_SA(0, 1), cA + hstep, voffA);
        if (wr == 1) PG8_BAR;
        PG8_WAIT_V(4); PG8_BAR;
        PG8_STAGE(PG8_SB(1, 0), cB + kstep, voffB); PG8_STAGE(PG8_SA(1, 0), cA + kstep, voffA); PG8_STAGE(PG8_SB(1, 1), cB + hstep + kstep, voffB);
        PG8_WAIT_V(6); PG8_BAR;
    }
    for (;;) {
        const bool has_next = S.next(ui + 1, nxt);
        const char* nA = has_next ? (const char*)g.A + (size_t)nxt.pm * tstep : cA; const char* nB = has_next ? (const char*)g.Bt + (size_t)nxt.pn * tstep : cB;
        for (int t = 0; t < nt; t += 2) {
            const bool last = (t == nt - 2);
            const char* a1 = cA + (size_t)(t + 1) * kstep;
            const char* a2 = last ? nA : cA + (size_t)(t + 2) * kstep; const char* b2 = last ? nB : cB + (size_t)(t + 2) * kstep;
            const char* a3 = a2 + kstep; const char* b3 = b2 + kstep;
            if (last && has_next) S.a_ready(nxt);
            if constexpr (SP2) {
            PG8_LDB(B0, 0, 0); PG8_LDB(B1, 0, 1); PG8_SCHED; PG8_LDA(At, 0, 0); PG8_STAGE(PG8_SA(1, 1), a1 + hstep, voffA);
            PG8_WAIT_V(8); PG8_WAIT_L(0); PG8_BAR; PG8_MMA(0, 0, At, B0); PG8_MMA(0, 1, At, B1); PG8_BAR; PG8_SCHED;
            PG8_LDA(At, 0, 1); PG8_STAGE(PG8_SB(0, 0), b2, voffB); PG8_STAGE(PG8_SB(0, 1), b2 + hstep, voffB); PG8_STAGE(PG8_SA(0, 0), a2, voffA);
            PG8_WAIT_V(8); PG8_WAIT_L(0); PG8_BAR; PG8_MMA(1, 0, At, B0); PG8_MMA(1, 1, At, B1); PG8_BAR; PG8_SCHED;
            PG8_LDB(B0, 1, 0); PG8_LDB(B1, 1, 1); PG8_SCHED; PG8_LDA(At, 1, 0); PG8_STAGE(PG8_SA(0, 1), a2 + hstep, voffA);
            PG8_WAIT_V(8); PG8_WAIT_L(0); PG8_BAR; PG8_MMA(0, 0, At, B0); PG8_MMA(0, 1, At, B1); PG8_BAR; PG8_SCHED;
            PG8_LDA(At, 1, 1); PG8_STAGE(PG8_SB(1, 0), b3, voffB); PG8_STAGE(PG8_SB(1, 1), b3 + hstep, voffB); PG8_STAGE(PG8_SA(1, 0), a3, voffA);
            PG8_WAIT_V(8); PG8_WAIT_L(0); PG8_BAR; PG8_MMA(1, 0, At, B0); PG8_MMA(1, 1, At, B1); PG8_BAR; PG8_SCHED;
            } else {
            PG8_LDB(B0, 0, 0); PG8_SCHED; PG8_LDA(At, 0, 0); PG8_STAGE(PG8_SA(1, 1), a1 + hstep, voffA);
            PG8_WAIT_L(8); PG8_BAR; PG8_WAIT_L(0); PG8_MMA(0, 0, At, B0); PG8_BAR; PG8_SCHED;
            PG8_LDB(B1, 0, 1); PG8_STAGE(PG8_SB(0, 0), b2, voffB);
            PG8_BAR; PG8_WAIT_L(0); PG8_MMA(0, 1, At, B1); PG8_BAR;
            PG8_LDA(At, 0, 1); PG8_STAGE(PG8_SA(0, 0), a2, voffA);
            PG8_BAR; PG8_WAIT_L(0); PG8_MMA(1, 0, At, B0); PG8_BAR; PG8_SCHED;
            PG8_STAGE(PG8_SB(0, 1), b2 + hstep, voffB);
            PG8_WAIT_V(6); PG8_BAR; PG8_MMA(1, 1, At, B1); PG8_BAR;
            PG8_LDB(B0, 1, 0); PG8_SCHED; PG8_LDA(At, 1, 0); PG8_STAGE(PG8_SA(0, 1), a2 + hstep, voffA);
            PG8_WAIT_L(8); PG8_BAR; PG8_WAIT_L(0); PG8_MMA(0, 0, At, B0); PG8_BAR; PG8_SCHED;
            PG8_LDB(B1, 1, 1); PG8_STAGE(PG8_SB(1, 0), b3, voffB);
            PG8_BAR; PG8_WAIT_L(0); PG8_MMA(0, 1, At, B1); PG8_BAR;
            PG8_LDA(At, 1, 1); PG8_STAGE(PG8_SA(1, 0), a3, voffA);
            PG8_BAR; PG8_WAIT_L(0); PG8_MMA(1, 0, At, B0); PG8_BAR; PG8_SCHED;
            PG8_STAGE(PG8_SB(1, 1), b3 + hstep, voffB);
            PG8_WAIT_V(6); PG8_BAR; PG8_MMA(1, 1, At, B1); PG8_BAR;
            }
        }
        if constexpr (ALIGN_EPI) { if (wr == 0) PG8_BAR; }
        if constexpr (!Epi::AFTER_DRAIN) { E(acc, cur, wr, wc, fr, fq); S.done(cur); }
        if (!has_next) break;
#pragma unroll
        for (int a = 0; a < 2; ++a)
#pragma unroll
            for (int b = 0; b < 2; ++b)
#pragma unroll
                for (int m = 0; m < 4; ++m)
#pragma unroll
                    for (int n = 0; n < 2; ++n) acc[a][b][m][n] = (f32x4){0.f, 0.f, 0.f, 0.f};
        cur = nxt; cA = nA; cB = nB; ++ui;
        if constexpr (ALIGN_EPI) { if (wr == 1) PG8_BAR; }
    }
    PG8_WAIT_V(0);
    if constexpr (!ALIGN_EPI) { if (wr == 0) PG8_BAR; }
    PG8_BAR;
    if constexpr (Epi::AFTER_DRAIN) { E.fused(acc, cur, wr, wc, fr, fq, lds, wid, lane); S.done(cur); }
#undef PG8_SA
#undef PG8_SB
#undef PG8_STAGE
#undef PG8_LDA
#undef PG8_LDB
#undef PG8_MMA
#undef PG8_WAIT_V
#undef PG8_WAIT_L
#undef PG8_BAR
#undef PG8_SCHED
}
}

struct Args { const float* in[26]; float* out; unsigned char* ws; };

__device__ __forceinline__ void p_mod(LAS unsigned char* lds, const float* __restrict__ c, const float* __restrict__ c_ctx, const float* __restrict__ ada_w,
                                      const float* __restrict__ ada_b, float* __restrict__ mod, int bid, int G, int tid) {
    if (bid >= 96) return;
    LAS float* s = (LAS float*)lds;
    LAS float* red = s + 17 * 1024;
    for (int i = tid; i < 17 * 1024; i += NTHREADS) { const int r = i >> 10, k = i & 1023; const float v = r < NB ? c[r * DM + k] : c_ctx[k]; s[i] = v / (1.0f + expf(-v)); }
    __syncthreads();
    for (int it = bid; it < 96; it += G) {
        const int cc = tid & 63, kg = tid >> 6, col = it * 64 + cc;
        float acc[17];
#pragma unroll
        for (int r = 0; r < 17; ++r) acc[r] = 0.f;
        for (int k = kg * 128; k < kg * 128 + 128; ++k) {
            const float w = ada_w[(size_t)k * 6144 + col];
#pragma unroll
            for (int r = 0; r < 17; ++r) acc[r] += s[r * 1024 + k] * w;
        }
#pragma unroll
        for (int r = 0; r < 17; ++r) red[(kg * 17 + r) * 64 + cc] = acc[r];
        __syncthreads();
        for (int i = tid; i < 17 * 64; i += NTHREADS) {
            const int r = i >> 6, c2 = i & 63; float sum = 0.f;
#pragma unroll
            for (int g = 0; g < 8; ++g) sum += red[(g * 17 + r) * 64 + c2];
            mod[(size_t)r * 6144 + it * 64 + c2] = sum + ada_b[it * 64 + c2];
        }
        __syncthreads();
    }
}

__device__ __forceinline__ void transpose_tile(LAS float* tile, const float* __restrict__ W, int K, int N, bf16_t* __restrict__ O, int mode, int k0, int n0, int tid) {
    for (int i = tid; i < 64 * 64; i += NTHREADS) { const int kk = i >> 6, nn = i & 63; tile[kk * 65 + nn] = W[(size_t)(k0 + kk) * N + n0 + nn]; }
    __syncthreads();
    for (int i = tid; i < 64 * 32; i += NTHREADS) {
        const int nn = i >> 5, kp = i & 31, n = n0 + nn;
        const int orow = mode == 0 ? n : ((n >> 4) * 32 + (mode == 2 ? 16 : 0) + (n & 15));
        *(unsigned*)(O + (size_t)orow * K + k0 + 2 * kp) = pk2(tile[(2 * kp) * 65 + nn], tile[(2 * kp + 1) * 65 + nn]);
    }
    __syncthreads();
}
__device__ __forceinline__ void p_transposes(LAS unsigned char* lds, const Args& a, int bid, int G, int tid) {
    LAS float* tile = (LAS float*)lds;
    unsigned char* ws = a.ws;
    constexpr int I_IN = 16 * 56, I_OUT = 16 * 16, I_E = 32 * 128;
    constexpr int NITEMS = I_IN + I_OUT + 3 * I_E;
    for (int it = bid; it < NITEMS; it += G) {
        int r = it;
        if (r < I_IN) { transpose_tile(tile, a.in[6], DM, NIN, (bf16_t*)(ws + WS_WINT), 0, (r & 15) * 64, (r >> 4) * 64, tid); continue; } r -= I_IN;
        if (r < I_OUT) { transpose_tile(tile, a.in[14], DM, DM, (bf16_t*)(ws + WS_WOUTT), 0, (r & 15) * 64, (r >> 4) * 64, tid); continue; } r -= I_OUT;
        if (r < I_E) { const int e = r >> 7, q = r & 127; transpose_tile(tile, a.in[21] + (size_t)e * DM * DE, DM, DE, (bf16_t*)(ws + WS_W13T) + (size_t)e * DM * DM, 1, (q & 15) * 64, (q >> 4) * 64, tid); continue; } r -= I_E;
        if (r < I_E) { const int e = r >> 7, q = r & 127; transpose_tile(tile, a.in[22] + (size_t)e * DM * DE, DM, DE, (bf16_t*)(ws + WS_W13T) + (size_t)e * DM * DM, 2, (q & 15) * 64, (q >> 4) * 64, tid); continue; } r -= I_E;
        { const int e = r >> 7, q = r & 127; transpose_tile(tile, a.in[23] + (size_t)e * DE * DM, DE, DM, (bf16_t*)(ws + WS_W2T) + (size_t)e * DM * DE, 0, (q & 7) * 64, (q >> 3) * 64, tid); }
    }
}

__device__ __forceinline__ void p_u(const float* __restrict__ x, const float* __restrict__ ctx, const float* __restrict__ mod, bf16_t* __restrict__ U, int bid, int G, int tid) {
    for (size_t i4 = (size_t)bid * NTHREADS + tid; i4 < (size_t)TA * 256; i4 += (size_t)G * NTHREADS) {
        const int row = (int)(i4 >> 8), c4 = (int)(i4 & 255) * 4;
        const float* src; const float* m;
        if (row < T) { src = x + (size_t)row * DM; m = mod + (size_t)(row / SEQ) * 6144; }
        else { src = ctx + (size_t)(row - T) * DM; m = mod + (size_t)16 * 6144; }
        const f32x4 v = *(const f32x4*)(src + c4), sh = *(const f32x4*)(m + c4), sc = *(const f32x4*)(m + 1024 + c4);
        u32x2 w; w.x = pk2(v[0] * (1.f + sc[0]) + sh[0], v[1] * (1.f + sc[1]) + sh[1]); w.y = pk2(v[2] * (1.f + sc[2]) + sh[2], v[3] * (1.f + sc[3]) + sh[3]);
        *(u32x2*)(U + (size_t)row * DM + c4) = w;
    }
}

__device__ __forceinline__ void p_ln1_router(const Args& a, int bid, int G, int wave, int lane) {
    const float* __restrict__ x = a.in[0]; float* yo = a.out; const float* mod = (const float*)(a.ws + WS_MOD);
    const float* __restrict__ ln_g = a.in[15]; const float* __restrict__ ln_b = a.in[16];
    const float* __restrict__ rgw = a.in[17]; const float* __restrict__ rgb = a.in[18]; const float* __restrict__ rew = a.in[19]; const float* __restrict__ reb = a.in[20];
    bf16_t* U2 = (bf16_t*)(a.ws + WS_U); int* counts = (int*)(a.ws + WS_CTL);
    int2* eidx = (int2*)(a.ws + WS_EIDX); int2* epos = (int2*)(a.ws + WS_EPOS); float2* ew = (float2*)(a.ws + WS_EW);
    for (int tok = bid * 8 + wave; tok < T; tok += G * 8) {
        const float* m = mod + (size_t)(tok / SEQ) * 6144;
        f32x4 v[4]; float s = 0.f;
#pragma unroll
        for (int j = 0; j < 4; ++j) { const int c4 = 4 * lane + 256 * j;
            const f32x4 xv = *(const f32x4*)(x + (size_t)tok * DM + c4), yv = *(const f32x4*)(yo + (size_t)tok * DM + c4), g1 = *(const f32x4*)(m + 2048 + c4);
            v[j] = ALPHA * xv + g1 * yv; s += (v[j][0] + v[j][1]) + (v[j][2] + v[j][3]); }
        const float mean = wave_sum(s) * (1.0f / DM); float s2 = 0.f;
#pragma unroll
        for (int j = 0; j < 4; ++j) { v[j] = v[j] - mean; s2 += (v[j][0] * v[j][0] + v[j][1] * v[j][1]) + (v[j][2] * v[j][2] + v[j][3] * v[j][3]); }
        const float rstd = rsqrtf(wave_sum(s2) * (1.0f / DM) + LN_EPS);
        float pl[36];
#pragma unroll
        for (int e = 0; e < 36; ++e) pl[e] = 0.f;
#pragma unroll
        for (int j = 0; j < 4; ++j) { const int c4 = 4 * lane + 256 * j;
            const f32x4 h1 = v[j] * rstd * *(const f32x4*)(ln_g + c4) + *(const f32x4*)(ln_b + c4);
            *(f32x4*)(yo + (size_t)tok * DM + c4) = h1;
            const f32x4 u2 = h1 * (1.0f + *(const f32x4*)(m + 4096 + c4)) + *(const f32x4*)(m + 3072 + c4);
            u32x2 w; w.x = pk2(u2[0], u2[1]); w.y = pk2(u2[2], u2[3]);
            *(u32x2*)(U2 + (size_t)tok * DM + c4) = w;
#pragma unroll
            for (int q = 0; q < 4; ++q) { const float uu = u2[q];
                const f32x4 wg = *(const f32x4*)(rgw + (size_t)(c4 + q) * 4);
#pragma unroll
                for (int e = 0; e < 4; ++e) pl[e] += uu * wg[e];
#pragma unroll
                for (int e4 = 0; e4 < 8; ++e4) { const f32x4 we = *(const f32x4*)(rew + (size_t)(c4 + q) * 32 + e4 * 4);
#pragma unroll
                    for (int r = 0; r < 4; ++r) pl[4 + e4 * 4 + r] += uu * we[r]; } }
        }
#pragma unroll
        for (int e = 0; e < 36; ++e) pl[e] = wave_sum(pl[e]) + (e < 4 ? rgb[e] : reb[e - 4]);
        int gi = 0; float gm = pl[0];
#pragma unroll
        for (int g = 1; g < 4; ++g) if (pl[g] > gm) { gm = pl[g]; gi = g; }
        float den = 0.f;
#pragma unroll
        for (int g = 0; g < 4; ++g) den += expf(pl[g] - gm);
        const float gval = 1.0f / den;
        float lv[8];
#pragma unroll
        for (int e = 0; e < 8; ++e) lv[e] = gi == 0 ? pl[4 + e] : gi == 1 ? pl[12 + e] : gi == 2 ? pl[20 + e] : pl[28 + e];
        int e0 = 0; float v0 = lv[0];
#pragma unroll
        for (int e = 1; e < 8; ++e) if (lv[e] > v0) { v0 = lv[e]; e0 = e; }
        int e1 = -1; float v1 = -3.0e38f;
#pragma unroll
        for (int e = 0; e < 8; ++e) if (e != e0 && (e1 < 0 || lv[e] > v1)) { v1 = lv[e]; e1 = e; }
        if (lane == 0) {
            const float t = expf(v1 - v0), w0 = 1.0f / (1.0f + t), w1 = t / (1.0f + t);
            const int id0 = gi * 8 + e0, id1 = gi * 8 + e1;
            const int p0 = atomicAdd(&counts[id0], 1), p1 = atomicAdd(&counts[id1], 1);
            eidx[tok] = make_int2(id0, id1); epos[tok] = make_int2(p0, p1); ew[tok] = make_float2(gval * w0, gval * w1);
        }
    }
}

__device__ __forceinline__ void p_gather(const Args& a, int bid, int G, int wave, int lane) {
    const bf16_t* U2 = (const bf16_t*)(a.ws + WS_U); const int* counts = (const int*)(a.ws + WS_CTL);
    const int2* eidx = (const int2*)(a.ws + WS_EIDX); const int2* epos = (const int2*)(a.ws + WS_EPOS); int2* dest = (int2*)(a.ws + WS_DEST);
    bf16_t* XG = (bf16_t*)(a.ws + WS_XG);
    for (int tok = bid * 8 + wave; tok < T; tok += G * 8) {
        const int2 ei = eidx[tok], ep = epos[tok];
        const int d0 = pstart_of(counts, ei.x) + ep.x, d1 = pstart_of(counts, ei.y) + ep.y;
        const u32x4 v0 = *(const u32x4*)(U2 + (size_t)tok * DM + lane * 8), v1 = *(const u32x4*)(U2 + (size_t)tok * DM + 512 + lane * 8);
        *(u32x4*)(XG + (size_t)d0 * DM + lane * 8) = v0; *(u32x4*)(XG + (size_t)d0 * DM + 512 + lane * 8) = v1;
        *(u32x4*)(XG + (size_t)d1 * DM + lane * 8) = v0; *(u32x4*)(XG + (size_t)d1 * DM + 512 + lane * 8) = v1;
        if (lane == 0) dest[tok] = make_int2(d0, d1);
    }
}

__device__ __forceinline__ void p_combine_ln2(const Args& a, int bid, int G, int wave, int lane) {
    float* out = a.out; const bf16_t* Y = (const bf16_t*)(a.ws + WS_Y); const int2* dest = (const int2*)(a.ws + WS_DEST); const float2* ew = (const float2*)(a.ws + WS_EW);
    const float* mod = (const float*)(a.ws + WS_MOD); const float* __restrict__ ln_g = a.in[24]; const float* __restrict__ ln_b = a.in[25];
    for (int tok = bid * 8 + wave; tok < T; tok += G * 8) {
        const float* m = mod + (size_t)(tok / SEQ) * 6144;
        const int2 d = dest[tok]; const float2 w = ew[tok];
        f32x4 v[4]; float s = 0.f;
#pragma unroll
        for (int j = 0; j < 4; ++j) { const int c4 = 4 * lane + 256 * j;
            const u32x2 ya = *(const u32x2*)(Y + (size_t)d.x * DM + c4), yb = *(const u32x2*)(Y + (size_t)d.y * DM + c4);
            f32x4 f;
            f[0] = w.x * __uint_as_float(ya.x << 16) + w.y * __uint_as_float(yb.x << 16);
            f[1] = w.x * __uint_as_float(ya.x & 0xffff0000u) + w.y * __uint_as_float(yb.x & 0xffff0000u);
            f[2] = w.x * __uint_as_float(ya.y << 16) + w.y * __uint_as_float(yb.y << 16);
            f[3] = w.x * __uint_as_float(ya.y & 0xffff0000u) + w.y * __uint_as_float(yb.y & 0xffff0000u);
            const f32x4 h1 = *(const f32x4*)(out + (size_t)tok * DM + c4), g2 = *(const f32x4*)(m + 5120 + c4);
            v[j] = ALPHA * h1 + g2 * f; s += (v[j][0] + v[j][1]) + (v[j][2] + v[j][3]); }
        const float mean = wave_sum(s) * (1.0f / DM); float s2 = 0.f;
#pragma unroll
        for (int j = 0; j < 4; ++j) { v[j] = v[j] - mean; s2 += (v[j][0] * v[j][0] + v[j][1] * v[j][1]) + (v[j][2] * v[j][2] + v[j][3] * v[j][3]); }
        const float rstd = rsqrtf(wave_sum(s2) * (1.0f / DM) + LN_EPS);
#pragma unroll
        for (int j = 0; j < 4; ++j) { const int c4 = 4 * lane + 256 * j;
            *(f32x4*)(out + (size_t)tok * DM + c4) = v[j] * rstd * *(const f32x4*)(ln_g + c4) + *(const f32x4*)(ln_b + c4); }
    }
}

constexpr size_t WS_HGK = WS_U;
constexpr size_t WS_HGD = 852 * MiB;
constexpr size_t WS_RGAGG = 854 * MiB;
constexpr size_t WS_RGCARRY = 864 * MiB;
constexpr size_t WS_GWT = 870 * MiB;
constexpr size_t WS_OFST = 880 * MiB;
constexpr int RG_UNITS_PER_B = 68, HG_SEGS = 17;

__device__ __forceinline__ bf16x8 mk_bf16x8(u32x4 v) { return __builtin_bit_cast(bf16x8, v); }
__device__ __forceinline__ float bf_lo(unsigned w) { return __uint_as_float(w << 16); }
__device__ __forceinline__ float bf_hi(unsigned w) { return __uint_as_float(w & 0xffff0000u); }
__device__ __forceinline__ unsigned cvt2(float lo, float hi) { unsigned r; asm volatile("v_cvt_pk_bf16_f32 %0, %1, %2" : "=v"(r) : "v"(lo), "v"(hi)); return r; }

__device__ __forceinline__ void p_gwt(const float* __restrict__ gate_w, bf16_t* __restrict__ gwt, int bid, int G, int tid) {
    for (int o = bid * NTHREADS + tid; o < 32 * 4096; o += G * NTHREADS) { const int mat = o >> 12, d = (o >> 6) & 63, c = o & 63; gwt[o] = f2bf(gate_w[mat * 4096 + c * 64 + d]); }
}

constexpr int XC_STRIDE = 1040;
constexpr int RG_XC = 0, RG_OUT = 64 * XC_STRIDE;
template <int MODE>
__device__ __forceinline__ void rg_unit(LAS unsigned char* lds, const Args& a, int b, int k, int tid, int wave, int lane) {
    const bf16_t* __restrict__ proj = (const bf16_t*)(a.ws + WS_PROJ);
    const float* __restrict__ conv_w = a.in[7]; const float* __restrict__ conv_b = a.in[8]; const float* __restrict__ gate_b = a.in[10]; const float* __restrict__ lam = a.in[11];
    const bf16_t* __restrict__ gwt = (const bf16_t*)(a.ws + WS_GWT);
    float* rgagg = (float*)(a.ws + WS_RGAGG); const float* rgcarry = (const float*)(a.ws + WS_RGCARRY);
    int rowbase, p0, lo, hi;
    if (k < 4) { rowbase = T + b * LC; p0 = k * 64; lo = 0; hi = LC; } else { rowbase = b * SEQ; p0 = (k - 4) * 64; lo = p0; hi = p0 + 64; }
    const int unit = b * RG_UNITS_PER_B + k;
    {
        const int cgp = tid & 63, tg = tid >> 6, c0 = cgp * 8, i0 = tg * 8;
        u32x4 raw[11];
#pragma unroll
        for (int r = 0; r < 11; ++r) { const int p = p0 + i0 - 1 + r;
            raw[r] = (p >= lo && p < hi) ? *(const u32x4*)(proj + (size_t)(rowbase + p) * NIN + c0) : (u32x4){0u, 0u, 0u, 0u}; }
        float cw[4][8], cb[8];
#pragma unroll
        for (int t4 = 0; t4 < 4; ++t4) { const f32x4 w0 = *(const f32x4*)(conv_w + t4 * 512 + c0), w1 = *(const f32x4*)(conv_w + t4 * 512 + c0 + 4);
#pragma unroll
            for (int q = 0; q < 4; ++q) { cw[t4][q] = w0[q]; cw[t4][4 + q] = w1[q]; } }
        { const f32x4 b0 = *(const f32x4*)(conv_b + c0), b1 = *(const f32x4*)(conv_b + c0 + 4);
#pragma unroll
            for (int q = 0; q < 4; ++q) { cb[q] = b0[q]; cb[4 + q] = b1[q]; } }
#pragma unroll
        for (int ii = 0; ii < 8; ++ii) {
            float xc[8];
#pragma unroll
            for (int c = 0; c < 8; ++c) xc[c] = cb[c];
#pragma unroll
            for (int t4 = 0; t4 < 4; ++t4) { const u32x4 rw = raw[ii + t4];
#pragma unroll
                for (int q = 0; q < 4; ++q) { xc[2 * q] += cw[t4][2 * q] * bf_lo(rw[q]); xc[2 * q + 1] += cw[t4][2 * q + 1] * bf_hi(rw[q]); } }
            u32x4 w; w.x = cvt2(xc[0], xc[1]); w.y = cvt2(xc[2], xc[3]); w.z = cvt2(xc[4], xc[5]); w.w = cvt2(xc[6], xc[7]);
            *(LAS u32x4*)(lds + RG_XC + (i0 + ii) * XC_STRIDE + c0 * 2) = w;
        }
    }
    __syncthreads();
    {
        const int n = wave, fr = lane & 15, fq = lane >> 4;
        bf16x8 afr[4][2];
#pragma unroll
        for (int m = 0; m < 4; ++m)
#pragma unroll
            for (int ks = 0; ks < 2; ++ks) afr[m][ks] = *(const LAS bf16x8*)(lds + RG_XC + (16 * m + fr) * XC_STRIDE + (n * 64 + ks * 32 + fq * 8) * 2);
        for (int nt = 0; nt < 4; ++nt) {
            const int ch = n * 64 + nt * 16 + fr;
            float xcv[4][4];
#pragma unroll
            for (int m = 0; m < 4; ++m)
#pragma unroll
                for (int j = 0; j < 4; ++j) xcv[m][j] = bf2f(*(const LAS bf16_t*)(lds + RG_XC + (16 * m + 4 * fq + j) * XC_STRIDE + ch * 2));
            float hsum[4][4];
#pragma unroll
            for (int dir = 0; dir < 2; ++dir) {
                f32x4 accr[4], acci[4];
#pragma unroll
                for (int m = 0; m < 4; ++m) { accr[m] = (f32x4){0.f, 0.f, 0.f, 0.f}; acci[m] = (f32x4){0.f, 0.f, 0.f, 0.f}; }
#pragma unroll
                for (int ks = 0; ks < 2; ++ks) {
                    const bf16x8 br = *(const bf16x8*)(gwt + ((size_t)(((dir * 2 + 0) * 8 + n) * 64 + nt * 16 + fr)) * 64 + ks * 32 + fq * 8);
                    const bf16x8 bi = *(const bf16x8*)(gwt + ((size_t)(((dir * 2 + 1) * 8 + n) * 64 + nt * 16 + fr)) * 64 + ks * 32 + fq * 8);
#pragma unroll
                    for (int m = 0; m < 4; ++m) { accr[m] = __builtin_amdgcn_mfma_f32_16x16x32_bf16(afr[m][ks], br, accr[m], 0, 0, 0); acci[m] = __builtin_amdgcn_mfma_f32_16x16x32_bf16(afr[m][ks], bi, acci[m], 0, 0, 0); }
                }
                const float gbr = gate_b[(dir * 2 + 0) * 512 + ch], gbi = gate_b[(dir * 2 + 1) * 512 + ch];
                const float sp = softplusf_(-lam[dir * 512 + ch]);
                float av[4][4], uv[4][4];
#pragma unroll
                for (int m = 0; m < 4; ++m)
#pragma unroll
                    for (int j = 0; j < 4; ++j) {
                        const float r = sigmoidf_(accr[m][j] + gbr), ig = sigmoidf_(acci[m][j] + gbi);
                        const float la = -8.0f * r * sp, t2 = 2.0f * la;
                        av[m][j] = __expf(la);
                        const float om = (t2 > -0.25f) ? -t2 * (1.f + t2 * (0.5f + t2 * (0.16666667f + t2 * (0.041666668f + t2 * 0.0083333338f)))) : 1.f - __expf(t2);
                        uv[m][j] = sqrtf(om) * ig * xcv[m][j];
                    }
                float carry = (MODE == 1) ? rgcarry[((size_t)unit * 2 + dir) * 512 + ch] : 0.f;
                float atot = 1.f;
#pragma unroll
                for (int mm = 0; mm < 4; ++mm) {
                    const int m = dir == 0 ? mm : 3 - mm;
                    float P, H;
                    if (dir == 0) { P = av[m][0]; H = uv[m][0];
#pragma unroll
                        for (int j = 1; j < 4; ++j) { H = av[m][j] * H + uv[m][j]; P *= av[m][j]; } }
                    else { P = av[m][3]; H = uv[m][3];
#pragma unroll
                        for (int j = 2; j >= 0; --j) { H = av[m][j] * H + uv[m][j]; P *= av[m][j]; } }
                    float Pn, Hn, Pe, He, Pt, Ht;
                    if (dir == 0) {
                        Pn = __shfl_up(P, 16); Hn = __shfl_up(H, 16); if (fq >= 1) { H = P * Hn + H; P = P * Pn; }
                        Pn = __shfl_up(P, 32); Hn = __shfl_up(H, 32); if (fq >= 2) { H = P * Hn + H; P = P * Pn; }
                        Pe = __shfl_up(P, 16); He = __shfl_up(H, 16); if (fq == 0) { Pe = 1.f; He = 0.f; }
                        Pt = __shfl(P, fr + 48); Ht = __shfl(H, fr + 48);
                    } else {
                        Pn = __shfl_down(P, 16); Hn = __shfl_down(H, 16); if (fq <= 2) { H = P * Hn + H; P = P * Pn; }
                        Pn = __shfl_down(P, 32); Hn = __shfl_down(H, 32); if (fq <= 1) { H = P * Hn + H; P = P * Pn; }
                        Pe = __shfl_down(P, 16); He = __shfl_down(H, 16); if (fq == 3) { Pe = 1.f; He = 0.f; }
                        Pt = __shfl(P, fr); Ht = __shfl(H, fr);
                    }
                    if (MODE == 1) {
                        float hp = Pe * carry + He;
                        if (dir == 0) {
#pragma unroll
                            for (int j = 0; j < 4; ++j) { hp = av[m][j] * hp + uv[m][j]; hsum[m][j] = hp; }
                        } else {
#pragma unroll
                            for (int j = 3; j >= 0; --j) { hp = av[m][j] * hp + uv[m][j]; hsum[m][j] += hp; }
                        }
                    }
                    carry = Pt * carry + Ht; atot *= Pt;
                }
                if (MODE == 0 && fq == 0) { rgagg[(((size_t)unit * 2 + dir) * 2 + 0) * 512 + ch] = atot; rgagg[(((size_t)unit * 2 + dir) * 2 + 1) * 512 + ch] = carry; }
            }
            if (MODE == 1) {
#pragma unroll
                for (int m = 0; m < 4; ++m)
#pragma unroll
                    for (int j = 0; j < 4; ++j) { const int t = 16 * m + 4 * fq + j;
                        const float gg = bf2f(proj[(size_t)(rowbase + p0 + t) * NIN + 512 + ch]);
                        *(LAS bf16_t*)(lds + RG_OUT + t * XC_STRIDE + ch * 2) = f2bf(hsum[m][j] * gg); }
            }
        }
    }
    __syncthreads();
    if (MODE == 1) {
        bf16_t* mixed = (bf16_t*)(a.ws + WS_MIXED);
        const int cgp = tid & 63, tg = tid >> 6, c0 = cgp * 8, i0 = tg * 8;
#pragma unroll
        for (int ii = 0; ii < 8; ++ii) { const u32x4 w = *(const LAS u32x4*)(lds + RG_OUT + (i0 + ii) * XC_STRIDE + c0 * 2);
            *(u32x4*)(mixed + (size_t)(rowbase + p0 + i0 + ii) * DM + c0) = w; }
    }
}

__device__ __forceinline__ void rg_carry_item(const Args& a, int item, int tid) {
    const float* rgagg = (const float*)(a.ws + WS_RGAGG); float* rgcarry = (float*)(a.ws + WS_RGCARRY);
    const int gidx = item * NTHREADS + tid;
    const int ch = gidx & 511, dir = (gidx >> 9) & 1, b = gidx >> 10;
    float h = 0.f;
    for (int s = 0; s < RG_UNITS_PER_B; ++s) {
        int k;
        if (dir == 0) k = s; else k = s < 4 ? 3 - s : 67 - (s - 4);
        const size_t unit = (size_t)b * RG_UNITS_PER_B + k;
        rgcarry[(unit * 2 + dir) * 512 + ch] = h;
        const float A = rgagg[((unit * 2 + dir) * 2 + 0) * 512 + ch], H = rgagg[((unit * 2 + dir) * 2 + 1) * 512 + ch];
        h = A * h + H;
    }
}

constexpr int HG_RAWZ = 0, HG_RAWV = 16384, HG_RAWQ = 32768;
constexpr int HG_KHT = 49152, HG_VT = 67584;
constexpr int HG_QT = 86016, HG_KT = 103424;
constexpr int HG_AM = 120832;
constexpr int HG_DS = 130048, HG_QSUM = 130560, HG_PART = 132608;
constexpr int HG_OST = 0;
constexpr int TS = 144, QS = 272;

struct HgRaw { u32x4 z[2], v[2], q[2]; };
template <bool FULL>
__device__ __forceinline__ void hg_load_raw(HgRaw& r, const bf16_t* __restrict__ proj, int row0, int hd, int dir, int tid) {
#pragma unroll
    for (int i = 0; i < 2; ++i) { const bf16_t* p = proj + (size_t)(row0 + (tid >> 4) + 32 * i) * NIN + hd * 128 + (tid & 15) * 8;
        r.z[i] = *(const u32x4*)(p + (dir == 0 ? 1536 : 2048)); r.v[i] = *(const u32x4*)(p + 2560); if (FULL) r.q[i] = *(const u32x4*)(p + 1024); }
}
template <bool FULL>
__device__ __forceinline__ void hg_store_raw(LAS unsigned char* lds, const HgRaw& r, int tid) {
#pragma unroll
    for (int i = 0; i < 2; ++i) { const int off = ((tid >> 4) + 32 * i) * 256 + (tid & 15) * 16;
        *(LAS u32x4*)(lds + HG_RAWZ + off) = r.z[i]; *(LAS u32x4*)(lds + HG_RAWV + off) = r.v[i]; if (FULL) *(LAS u32x4*)(lds + HG_RAWQ + off) = r.q[i]; }
}

template <int DIR, bool FULL>
__device__ __forceinline__ void hg_chunk(LAS unsigned char* lds, f32x4 (&accS)[8], f32x4 (&o)[4], float lbv, float& dseg, int tid, int wave, int lane) {
    const int kc = tid & 127, tq = tid >> 7, fr = lane & 15, fq = lane >> 4;
    float Gc[16];
    float qt = 0.f;
#pragma unroll
    for (int i = 0; i < 16; ++i) { const float z = bf2f(*(const LAS bf16_t*)(lds + HG_RAWZ + (16 * tq + i) * 256 + kc * 2));
        const float f = lbv + (1.0f - lbv) * sigmoidf_(z); Gc[i] = __logf(f); qt += Gc[i]; }
    *(LAS float*)(lds + HG_QSUM + (tq * 128 + kc) * 4) = qt;
    __syncthreads();
    float offs = 0.f, gtot = 0.f;
#pragma unroll
    for (int q4 = 0; q4 < 4; ++q4) { const float v = *(const LAS float*)(lds + HG_QSUM + (q4 * 128 + kc) * 4); gtot += v; if (DIR == 0 ? (q4 < tq) : (q4 > tq)) offs += v; }
    if (DIR == 0) { float c = offs;
#pragma unroll
        for (int i = 0; i < 16; ++i) { c += Gc[i]; Gc[i] = c; } }
    else { float c = offs;
#pragma unroll
        for (int i = 15; i >= 0; --i) { c += Gc[i]; Gc[i] = c; } }
    {
#pragma unroll
        for (int h2 = 0; h2 < 2; ++h2) {
            unsigned kh[4], vt[4];
#pragma unroll
            for (int i2 = 0; i2 < 4; ++i2) { const int i = 4 * h2 + i2;
                const float z0 = bf2f(*(const LAS bf16_t*)(lds + HG_RAWZ + (16 * tq + 2 * i) * 256 + kc * 2)), z1 = bf2f(*(const LAS bf16_t*)(lds + HG_RAWZ + (16 * tq + 2 * i + 1) * 256 + kc * 2));
                const float k0 = (1.0f - lbv) * (1.0f - sigmoidf_(z0)), k1 = (1.0f - lbv) * (1.0f - sigmoidf_(z1));
                kh[i2] = cvt2(k0 * __expf(gtot - Gc[2 * i]), k1 * __expf(gtot - Gc[2 * i + 1]));
                const unsigned v0 = *(const LAS bf16_t*)(lds + HG_RAWV + (16 * tq + 2 * i) * 256 + kc * 2), v1 = *(const LAS bf16_t*)(lds + HG_RAWV + (16 * tq + 2 * i + 1) * 256 + kc * 2);
                vt[i2] = v0 | (v1 << 16);
                if (FULL) {
                    const float q0 = bf2f(*(const LAS bf16_t*)(lds + HG_RAWQ + (16 * tq + 2 * i) * 256 + kc * 2)), q1 = bf2f(*(const LAS bf16_t*)(lds + HG_RAWQ + (16 * tq + 2 * i + 1) * 256 + kc * 2));
                    *(LAS bf16_t*)(lds + HG_QT + (16 * tq + 2 * i) * QS + kc * 2) = f2bf(q0 * __expf(Gc[2 * i]));
                    *(LAS bf16_t*)(lds + HG_QT + (16 * tq + 2 * i + 1) * QS + kc * 2) = f2bf(q1 * __expf(Gc[2 * i + 1]));
                    *(LAS bf16_t*)(lds + HG_KT + (16 * tq + 2 * i) * QS + kc * 2) = f2bf(k0 * __expf(-Gc[2 * i]));
                    *(LAS bf16_t*)(lds + HG_KT + (16 * tq + 2 * i + 1) * QS + kc * 2) = f2bf(k1 * __expf(-Gc[2 * i + 1]));
                }
            }
            *(LAS u32x4*)(lds + HG_KHT + kc * TS + tq * 32 + 16 * h2) = (u32x4){kh[0], kh[1], kh[2], kh[3]};
            *(LAS u32x4*)(lds + HG_VT + kc * TS + tq * 32 + 16 * h2) = (u32x4){vt[0], vt[1], vt[2], vt[3]};
        }
        if (tq == 0) { const float dc = __expf(gtot); *(LAS float*)(lds + HG_DS + kc * 4) = dc; dseg *= dc; }
    }
    __syncthreads();
    if (FULL) {
#pragma unroll
        for (int tt = 0; tt < 2; ++tt) {
            const int tl = 2 * wave + tt, ti = tl >> 2, si = tl & 3;
            f32x4 accA = (f32x4){0.f, 0.f, 0.f, 0.f};
#pragma unroll
            for (int ks = 0; ks < 4; ++ks) {
                const bf16x8 af = *(const LAS bf16x8*)(lds + HG_QT + (16 * ti + fr) * QS + (ks * 32 + fq * 8) * 2);
                const bf16x8 bf = *(const LAS bf16x8*)(lds + HG_KT + (16 * si + fr) * QS + (ks * 32 + fq * 8) * 2);
                accA = __builtin_amdgcn_mfma_f32_16x16x32_bf16(af, bf, accA, 0, 0, 0);
            }
#pragma unroll
            for (int j = 0; j < 4; ++j) { const int t = 16 * ti + 4 * fq + j, s = 16 * si + fr;
                const bool keep = DIR == 0 ? (s <= t) : (s >= t);
                *(LAS bf16_t*)(lds + HG_AM + t * TS + s * 2) = f2bf(keep ? accA[j] : 0.f); }
        }
        __syncthreads();
#pragma unroll
        for (int m = 0; m < 4; ++m) o[m] = (f32x4){0.f, 0.f, 0.f, 0.f};
#pragma unroll
        for (int ks = 0; ks < 4; ++ks) {
            const u32x4 sw = (u32x4){cvt2(accS[2 * ks][0], accS[2 * ks][1]), cvt2(accS[2 * ks][2], accS[2 * ks][3]), cvt2(accS[2 * ks + 1][0], accS[2 * ks + 1][1]), cvt2(accS[2 * ks + 1][2], accS[2 * ks + 1][3])};
            const bf16x8 sf = mk_bf16x8(sw);
#pragma unroll
            for (int m = 0; m < 4; ++m) {
                const u32x2 qlo = *(const LAS u32x2*)(lds + HG_QT + (16 * m + fr) * QS + (32 * ks + 4 * fq) * 2), qhi = *(const LAS u32x2*)(lds + HG_QT + (16 * m + fr) * QS + (32 * ks + 16 + 4 * fq) * 2);
                const bf16x8 qf = mk_bf16x8((u32x4){qlo.x, qlo.y, qhi.x, qhi.y});
                o[m] = __builtin_amdgcn_mfma_f32_16x16x32_bf16(qf, sf, o[m], 0, 0, 0);
            }
        }
#pragma unroll
        for (int ks = 0; ks < 2; ++ks) {
            const bf16x8 vf = *(const LAS bf16x8*)(lds + HG_VT + (16 * wave + fr) * TS + (ks * 32 + fq * 8) * 2);
#pragma unroll
            for (int m = 0; m < 4; ++m) { const bf16x8 af = *(const LAS bf16x8*)(lds + HG_AM + (16 * m + fr) * TS + (ks * 32 + fq * 8) * 2);
                o[m] = __builtin_amdgcn_mfma_f32_16x16x32_bf16(af, vf, o[m], 0, 0, 0); }
        }
    }
#pragma unroll
    for (int i = 0; i < 8; ++i) { const f32x4 dv = *(const LAS f32x4*)(lds + HG_DS + (16 * i + 4 * fq) * 4); accS[i] = accS[i] * dv; }
#pragma unroll
    for (int ks = 0; ks < 2; ++ks) {
        const bf16x8 vf = *(const LAS bf16x8*)(lds + HG_VT + (16 * wave + fr) * TS + (ks * 32 + fq * 8) * 2);
#pragma unroll
        for (int i = 0; i < 8; ++i) { const bf16x8 af = *(const LAS bf16x8*)(lds + HG_KHT + (16 * i + fr) * TS + (ks * 32 + fq * 8) * 2);
            accS[i] = __builtin_amdgcn_mfma_f32_16x16x32_bf16(af, vf, accS[i], 0, 0, 0); }
    }
}

__device__ __forceinline__ float hg_lb(const float* __restrict__ lb_logits, int dir, int col) {
    const float l0 = lb_logits[(0 * 2 + dir) * 512 + col], l1 = lb_logits[(1 * 2 + dir) * 512 + col];
    return 1.0f / (1.0f + expf(l1 - l0));
}

template <int DIR>
__device__ __forceinline__ void hg_agg_unit(LAS unsigned char* lds, const Args& a, int b, int hd, int sidx, int unit, int tid, int wave, int lane) {
    const bf16_t* __restrict__ proj = (const bf16_t*)(a.ws + WS_PROJ);
    const int rowbase = sidx == 0 ? T + b * LC : b * SEQ + (sidx - 1) * 256;
    const float lbv = hg_lb(a.in[12], DIR, hd * 128 + (tid & 127));
    f32x4 accS[8], odummy[4];
#pragma unroll
    for (int i = 0; i < 8; ++i) accS[i] = (f32x4){0.f, 0.f, 0.f, 0.f};
    float dseg = 1.f;
    HgRaw raw;
    hg_load_raw<false>(raw, proj, rowbase + (DIR == 0 ? 0 : 3) * 64, hd, DIR, tid);
    __syncthreads();
    hg_store_raw<false>(lds, raw, tid);
    __syncthreads();
#pragma unroll 1
    for (int cc = 0; cc < 4; ++cc) {
        if (cc < 3) hg_load_raw<false>(raw, proj, rowbase + (DIR == 0 ? cc + 1 : 2 - cc) * 64, hd, DIR, tid);
        hg_chunk<DIR, false>(lds, accS, odummy, lbv, dseg, tid, wave, lane);
        __syncthreads();
        if (cc < 3) { hg_store_raw<false>(lds, raw, tid); __syncthreads(); }
    }
    float* K = (float*)(a.ws + WS_HGK) + (size_t)unit * 16384;
    const int fr = lane & 15, fq = lane >> 4;
#pragma unroll
    for (int i = 0; i < 8; ++i)
#pragma unroll
        for (int j = 0; j < 4; ++j) K[(16 * i + 4 * fq + j) * 128 + 16 * wave + fr] = accS[i][j];
    if (tid < 128) ((float*)(a.ws + WS_HGD))[(size_t)unit * 128 + tid] = dseg;
}

__device__ __forceinline__ void hg_carry_item(const Args& a, int item, int tid) {
    const int chain = item >> 3, part = item & 7, dir = chain & 1;
    float* K = (float*)(a.ws + WS_HGK) + (size_t)chain * HG_SEGS * 16384; const float* D = (const float*)(a.ws + WS_HGD) + (size_t)chain * HG_SEGS * 128;
    const int e4 = part * 512 + tid, dk = e4 >> 5;
    f32x4 kv[HG_SEGS]; float dv[HG_SEGS];
#pragma unroll
    for (int s = 0; s < HG_SEGS; ++s) { const int sidx = s == 0 ? 0 : (dir == 0 ? s : HG_SEGS - s); kv[s] = *(const f32x4*)(K + (size_t)sidx * 16384 + e4 * 4); dv[s] = D[sidx * 128 + dk]; }
    f32x4 S = (f32x4){0.f, 0.f, 0.f, 0.f};
#pragma unroll
    for (int s = 0; s < HG_SEGS; ++s) { const int sidx = s == 0 ? 0 : (dir == 0 ? s : HG_SEGS - s); *(f32x4*)(K + (size_t)sidx * 16384 + e4 * 4) = S; S = S * dv[s] + kv[s]; }
}

__device__ __forceinline__ void hg_final_unit(LAS unsigned char* lds, const Args& a, int b, int hd, int seg, int tid, int wave, int lane) {
    const bf16_t* __restrict__ proj = (const bf16_t*)(a.ws + WS_PROJ); bf16_t* mixed = (bf16_t*)(a.ws + WS_MIXED);
    const int rowbase = b * SEQ + seg * 256, fr = lane & 15, fq = lane >> 4;
    const float lbf = hg_lb(a.in[12], 0, hd * 128 + (tid & 127)), lbb = hg_lb(a.in[12], 1, hd * 128 + (tid & 127));
    const float ng = a.in[13][hd * 128 + 16 * wave + fr];
    f32x4 accS[8], o[4];
    float dseg = 1.f;
    HgRaw raw;
    f32x4* ofst = (f32x4*)(a.ws + WS_OFST) + (size_t)blockIdx.x * 8192 + wave * 256 + lane;
    {
        const float* Sin = (const float*)(a.ws + WS_HGK) + (size_t)((((b * 4 + hd) * 2 + 0) * HG_SEGS) + 1 + seg) * 16384;
#pragma unroll
        for (int i = 0; i < 8; ++i)
#pragma unroll
            for (int j = 0; j < 4; ++j) accS[i][j] = Sin[(16 * i + 4 * fq + j) * 128 + 16 * wave + fr];
    }
    hg_load_raw<true>(raw, proj, rowbase, hd, 0, tid);
    __syncthreads();
    hg_store_raw<true>(lds, raw, tid);
    __syncthreads();
#pragma unroll 1
    for (int cc = 0; cc < 4; ++cc) {
        if (cc < 3) hg_load_raw<true>(raw, proj, rowbase + (cc + 1) * 64, hd, 0, tid); else hg_load_raw<true>(raw, proj, rowbase + 3 * 64, hd, 1, tid);
        hg_chunk<0, true>(lds, accS, o, lbf, dseg, tid, wave, lane);
#pragma unroll
        for (int m = 0; m < 4; ++m) ofst[cc * 2048 + m * 64] = o[m];
        __syncthreads();
        hg_store_raw<true>(lds, raw, tid);
        __syncthreads();
    }
    {
        const float* Sin = (const float*)(a.ws + WS_HGK) + (size_t)((((b * 4 + hd) * 2 + 1) * HG_SEGS) + 1 + seg) * 16384;
#pragma unroll
        for (int i = 0; i < 8; ++i)
#pragma unroll
            for (int j = 0; j < 4; ++j) accS[i][j] = Sin[(16 * i + 4 * fq + j) * 128 + 16 * wave + fr];
    }
#pragma unroll 1
    for (int cc = 0; cc < 4; ++cc) {
        const int c = 3 - cc;
        if (cc < 3) hg_load_raw<true>(raw, proj, rowbase + (c - 1) * 64, hd, 1, tid);
        hg_chunk<1, true>(lds, accS, o, lbb, dseg, tid, wave, lane);
        float gate[4][4];
#pragma unroll
        for (int m = 0; m < 4; ++m) { o[m] = o[m] + ofst[c * 2048 + m * 64];
#pragma unroll
            for (int j = 0; j < 4; ++j) { float s = o[m][j] * o[m][j];
                s += __shfl_xor(s, 1); s += __shfl_xor(s, 2); s += __shfl_xor(s, 4); s += __shfl_xor(s, 8);
                if (fr == 0) *(LAS float*)(lds + HG_PART + ((16 * m + 4 * fq + j) * 8 + wave) * 4) = s;
                gate[m][j] = bf2f(proj[(size_t)(rowbase + c * 64 + 16 * m + 4 * fq + j) * NIN + 3072 + hd * 128 + 16 * wave + fr]); } }
        __syncthreads();
#pragma unroll
        for (int m = 0; m < 4; ++m)
#pragma unroll
            for (int j = 0; j < 4; ++j) { const int t = 16 * m + 4 * fq + j;
                const f32x4 p0 = *(const LAS f32x4*)(lds + HG_PART + t * 32), p1 = *(const LAS f32x4*)(lds + HG_PART + t * 32 + 16);
                const float ms = ((p0[0] + p0[1]) + (p0[2] + p0[3]) + (p1[0] + p1[1]) + (p1[2] + p1[3])) * (1.0f / 128.0f);
                *(LAS bf16_t*)(lds + HG_OST + t * QS + (16 * wave + fr) * 2) = f2bf(o[m][j] * rsqrtf(ms + LN_EPS) * ng * gate[m][j]); }
        __syncthreads();
#pragma unroll
        for (int i = 0; i < 2; ++i) { const int t = (tid >> 4) + 32 * i, c8 = (tid & 15) * 8;
            *(u32x4*)(mixed + (size_t)(rowbase + c * 64 + t) * DM + 512 + hd * 128 + c8) = *(const LAS u32x4*)(lds + HG_OST + t * QS + c8 * 2); }
        __syncthreads();
        if (cc < 3) { hg_store_raw<true>(lds, raw, tid); __syncthreads(); }
    }
}

__device__ __forceinline__ void p_scan_a(LAS unsigned char* lds, const Args& a, int bid, int G, int tid, int wave, int lane) {
    constexpr int N_HG = NB * 4 * 2 * HG_SEGS, N_RG = NB * RG_UNITS_PER_B;
#pragma unroll 1
    for (int it = bid; it < N_HG + N_RG; it += G) {
        int t2 = tid; asm volatile("" : "+v"(t2)); const int tid = t2, lane = t2 & 63;
        if (it < N_HG) { const int sidx = it % HG_SEGS, rest = it / HG_SEGS, dir = rest & 1, hd = (rest >> 1) & 3, b = rest >> 3;
            if (dir == 0) hg_agg_unit<0>(lds, a, b, hd, sidx, it, tid, wave, lane); else hg_agg_unit<1>(lds, a, b, hd, sidx, it, tid, wave, lane); }
        else { const int r = it - N_HG; __syncthreads(); rg_unit<0>(lds, a, r / RG_UNITS_PER_B, r % RG_UNITS_PER_B, tid, wave, lane); }
    }
}
__device__ __forceinline__ void p_scan_b(const Args& a, int bid, int G, int tid) {
    for (int it = bid; it < 1024 + 32; it += G) { if (it < 1024) hg_carry_item(a, it, tid); else rg_carry_item(a, it - 1024, tid); }
}
__device__ __forceinline__ void p_scan_c(LAS unsigned char* lds, const Args& a, int bid, int G, int tid, int wave, int lane) {
#pragma unroll 1
    for (int it = bid; it < 1024; it += G) { const int seg = it & 15, hd = (it >> 4) & 3, b = it >> 6; int t2 = tid; asm volatile("" : "+v"(t2)); hg_final_unit(lds, a, b, hd, seg, t2, wave, t2 & 63); }
#pragma unroll 1
    for (int r = bid; r < 1024; r += G) { __syncthreads(); int t2 = tid; asm volatile("" : "+v"(t2)); rg_unit<1>(lds, a, r >> 6, 4 + (r & 63), t2, wave, t2 & 63); }
}

__global__ void __launch_bounds__(NTHREADS, 2) mega(Args a) {
    extern __shared__ __attribute__((aligned(16))) unsigned char lds_raw[];
    LAS unsigned char* lds = (LAS unsigned char*)lds_raw;
    cg::grid_group grid = cg::this_grid();
    const int tid = threadIdx.x, lane = tid & 63, wave = __builtin_amdgcn_readfirstlane(tid >> 6), bid = blockIdx.x, G = gridDim.x;
    unsigned char* ws = a.ws;
    float* mod = (float*)(ws + WS_MOD);
    bf16_t* U = (bf16_t*)(ws + WS_U);
    bf16_t* PROJ = (bf16_t*)(ws + WS_PROJ); bf16_t* MIXED = (bf16_t*)(ws + WS_MIXED);

#ifndef SKIP_P0
    p_mod(lds, a.in[1], a.in[3], a.in[4], a.in[5], mod, bid, G, tid);
    p_transposes(lds, a, bid, G, tid);
    p_gwt(a.in[9], (bf16_t*)(ws + WS_GWT), bid, G, tid);
#endif
    grid.sync();
#ifndef SKIP_P1
    p_u(a.in[0], a.in[2], mod, U, bid, G, tid);
#endif
    grid.sync();
#ifndef SKIP_P2
    { pg8::Gemm g{U, (const bf16_t*)(ws + WS_WINT), TA, NIN, DM}; pg8::StaticOrder S; S.init(TA, NIN, G, bid);
      pg8::EpiInProj E{PROJ};
      pg8::gemm_phase<pg8::EpiInProj, pg8::StaticOrder, true, true>(lds, g, S, E); }
#endif
    grid.sync();
#ifndef SKIP_P3A
    p_scan_a(lds, a, bid, G, tid, wave, lane);
#endif
    grid.sync();
#ifndef SKIP_P3B
    p_scan_b(a, bid, G, tid);
#endif
    grid.sync();
#ifndef SKIP_P3C
    p_scan_c(lds, a, bid, G, tid, wave, lane);
#endif
    grid.sync();
#ifndef SKIP_P5
    { pg8::Gemm g{MIXED, (const bf16_t*)(ws + WS_WOUTT), T, DM, DM}; pg8::StaticOrder S; S.init(T, DM, G, bid);
      pg8::EpiF32 E{a.out, DM, 0};
      pg8::gemm_phase<pg8::EpiF32, pg8::StaticOrder, true, true>(lds, g, S, E); }
#endif
    grid.sync();
#ifndef SKIP_P6
    p_ln1_router(a, bid, G, wave, lane);
#endif
    grid.sync();
#ifndef SKIP_P7
    p_gather(a, bid, G, wave, lane);
#endif
    grid.sync();
#ifndef SKIP_P8
    { pg8::Gemm g{(const bf16_t*)(ws + WS_XG), (const bf16_t*)(ws + WS_W13T), MAXROWS, NE * DM, DM}; pg8::ExpertOrder S{(const int*)(ws + WS_CTL), G, bid};
      pg8::EpiExp1 E{(bf16_t*)(ws + WS_HID)};
      pg8::gemm_phase<pg8::EpiExp1, pg8::ExpertOrder, true, true>(lds, g, S, E); }
#endif
    grid.sync();
#ifndef SKIP_P9
    { pg8::Gemm g{(const bf16_t*)(ws + WS_HID), (const bf16_t*)(ws + WS_W2T), MAXROWS, NE * DM, DE}; pg8::ExpertOrder S{(const int*)(ws + WS_CTL), G, bid};
      pg8::EpiY E{(bf16_t*)(ws + WS_Y)};
      pg8::gemm_phase<pg8::EpiY, pg8::ExpertOrder, true, true>(lds, g, S, E); }
#endif
    grid.sync();
#ifndef SKIP_P10
    p_combine_ln2(a, bid, G, wave, lane);
#endif
}

extern "C" void kernel_launch(void* const* d_in, const int* in_sizes, int n_in, void* d_out, int out_size, void* d_ws, size_t ws_size, hipStream_t stream) {
    static int grid = 0;
    if (grid == 0) {
        if (n_in != 26 || ws_size < WS_END) { fprintf(stderr, "kernel_launch: unexpected n_in %d or workspace %zu < %zu\n", n_in, ws_size, (size_t)WS_END); grid = -1; return; }
        int dev = 0, cus = 0, per_cu = 0;
        if (hipGetDevice(&dev) != hipSuccess || hipDeviceGetAttribute(&cus, hipDeviceAttributeMultiprocessorCount, dev) != hipSuccess) { grid = -1; return; }
        if (hipFuncSetAttribute((const void*)mega, hipFuncAttributeMaxDynamicSharedMemorySize, LDS_BYTES) != hipSuccess) { fprintf(stderr, "kernel_launch: hipFuncSetAttribute failed\n"); grid = -1; return; }
        if (hipOccupancyMaxActiveBlocksPerMultiprocessor(&per_cu, (const void*)mega, NTHREADS, LDS_BYTES) != hipSuccess || per_cu < 1) { fprintf(stderr, "kernel_launch: occupancy query says %d\n", per_cu); per_cu = 1; }
        (void)hipGetLastError();
        grid = cus;
        fprintf(stderr, "kernel_launch: grid %d (cus %d, per_cu %d), ws %zu\n", grid, cus, per_cu, ws_size);
    }
    if (grid < 0) return;
    (void)hipMemsetAsync(d_ws, 0, 4096, stream);
    Args a{};
    for (int i = 0; i < 26; ++i) a.in[i] = (const float*)d_in[i];
    a.out = (float*)d_out; a.ws = (unsigned char*)d_ws;
    void* params[] = {&a};
    hipError_t e = hipLaunchCooperativeKernel((const void*)mega, dim3(grid), dim3(NTHREADS), params, LDS_BYTES, stream);
    if (e != hipSuccess) fprintf(stderr, "kernel_launch: cooperative launch failed: %s (grid %d)\n", hipGetErrorString(e), grid);
}
```

```cpp
#include <hip/hip_runtime.h>
#include <hip/hip_cooperative_groups.h>
#include <cstdio>
#include <cstdint>
namespace cg = cooperative_groups;

typedef unsigned short bf16_t;
typedef short bf16x8 __attribute__((ext_vector_type(8)));
typedef float f32x4 __attribute__((ext_vector_type(4)));
typedef float f32x2 __attribute__((ext_vector_type(2)));
typedef unsigned u32x4 __attribute__((ext_vector_type(4)));
typedef unsigned u32x2 __attribute__((ext_vector_type(2)));
#define LAS __attribute__((address_space(3)))

constexpr int NB = 16, SEQ = 4096, LC = 256, DM = 1024;
constexpr int T = NB * SEQ;
constexpr int TC = NB * LC;
constexpr int TA = T + TC;
constexpr int NIN = 3584;
constexpr int NE = 32, DE = 512;
constexpr int MAXROWS = 2 * T + NE * 256;
constexpr float ALPHA = 1.189207115002721f;
constexpr float LN_EPS = 1e-6f;
constexpr int NTHREADS = 512;

constexpr size_t MiB = 1u << 20;
constexpr size_t WS_CTL = 0;
constexpr size_t WS_MOD = 1 * MiB;
constexpr size_t WS_EIDX = 3 * MiB;
constexpr size_t WS_EPOS = 3 * MiB + 512 * 1024;
constexpr size_t WS_EW = 4 * MiB;
constexpr size_t WS_DEST = 4 * MiB + 512 * 1024;
constexpr size_t WS_WINT = 6 * MiB;
constexpr size_t WS_WOUTT = 13 * MiB;
constexpr size_t WS_W13T = 15 * MiB;
constexpr size_t WS_W2T = 79 * MiB;
constexpr size_t WS_U = 112 * MiB;
constexpr size_t WS_PROJ = 248 * MiB;
constexpr size_t WS_XG = 248 * MiB;
constexpr size_t WS_HID = 520 * MiB;
constexpr size_t WS_Y = 656 * MiB;
constexpr size_t WS_MIXED = 724 * MiB;
constexpr size_t WS_OSUM = 852 * MiB;
constexpr size_t WS_END = 980 * MiB;
constexpr int LDS_BYTES = 163840;

__device__ __forceinline__ float bf2f(bf16_t b) { return __uint_as_float(((unsigned)b) << 16); }
__device__ __forceinline__ bf16_t f2bf(float f) { unsigned u = __float_as_uint(f); return (bf16_t)((u + 0x7fffu + ((u >> 16) & 1u)) >> 16); }
__device__ __forceinline__ unsigned pk2(float lo, float hi) { return (unsigned)f2bf(lo) | ((unsigned)f2bf(hi) << 16); }
__device__ __forceinline__ float sigmoidf_(float x) { return 1.0f / (1.0f + __expf(-x)); }
__device__ __forceinline__ float siluf_(float x) { return x / (1.0f + __expf(-x)); }
__device__ __forceinline__ float gelu_tanh(float x) {
    const float y = 0.7978845608028654f * (x + 0.044715f * x * x * x);
    const float t = 1.0f - 2.0f / (__expf(2.0f * y) + 1.0f);
    return 0.5f * x * (1.0f + t);
}
__device__ __forceinline__ float softplusf_(float x) { return fmaxf(x, 0.f) + log1pf(expf(-fabsf(x))); }
__device__ __forceinline__ float wave_sum(float v) {
#pragma unroll
    for (int o = 1; o < 64; o <<= 1) v += __shfl_xor(v, o);
    return v;
}
__device__ __forceinline__ int pstart_of(const int* __restrict__ counts, int e) {
    int acc = 0;
    for (int i = 0; i < NE; ++i) { const int p = ((counts[i] + 255) >> 8) << 8; if (i < e) acc += p; }
    return acc;
}

namespace pg8 {
#define PG8_LAS __attribute__((address_space(3)))
typedef unsigned short bf16_t;
typedef short bf16x8 __attribute__((ext_vector_type(8)));
typedef float f32x4 __attribute__((ext_vector_type(4)));
typedef unsigned u32x4 __attribute__((ext_vector_type(4)));
constexpr int BM = 256, BK = 64, HALF = 128, HTB = HALF * BK * 2  , STAGE_BYTES = 8 * HTB, NXCD = 8, WGM = 8;

__host__ __device__ __forceinline__ int lds_byte(int r, int c) { const int st = (r >> 4) * 2 + (c >> 5), rr = r & 15, cc = c & 31, ob = rr * 64 + cc * 2; return st * 1024 + (ob ^ (((ob >> 9) & 1) << 5)); }
__host__ __device__ __forceinline__ void stage_rc(int b, int& R, int& C) { const int st = b / 1024, sb = b % 1024, swz = sb ^ (((sb >> 9) & 1) << 5); R = (st >> 1) * 16 + swz / 64; C = (st & 1) * 32 + (swz % 64) / 2; }
__host__ __device__ __forceinline__ int perm32(int rho) { const int n = rho >> 4, i = rho & 15; return 8 * (i >> 2) + 4 * n + (i & 3); }

struct Unit { int pm, pn; };
struct Gemm { const bf16_t* A; const bf16_t* Bt; int M, N, K; };

struct StaticOrder {
    int nM, nN, nwg, G, c;
    __host__ __device__ void init(int M, int N, int G_, int c_) { nM = M / BM; nN = N / BM; nwg = nM * nN; G = G_; c = c_; }
    __host__ __device__ bool next(int i, Unit& u) const {
        const long L = (long)i * G + c; if (L >= nwg) return false;
        int wgid = (int)L; { const int q = nwg / NXCD, r = nwg % NXCD, xcd = wgid % NXCD, off = wgid / NXCD; wgid = (xcd < r ? xcd * (q + 1) : r * (q + 1) + (xcd - r) * q) + off; }
        const int nig = WGM * nN, gid = wgid / nig, fm = gid * WGM, gsz = (nM - fm) < WGM ? (nM - fm) : WGM;
        u.pm = fm + ((wgid % nig) % gsz); u.pn = (wgid % nig) / gsz; return true;
    }
    __device__ __forceinline__ void a_ready(const Unit&) const {}
    __device__ __forceinline__ void done(const Unit&) const {}
};

__device__ __forceinline__ unsigned cvt_pk_bf16(float lo, float hi) { unsigned r; asm volatile("v_cvt_pk_bf16_f32 %0, %1, %2" : "=v"(r) : "v"(lo), "v"(hi)); return r; }

struct EpiInProj {
    static constexpr bool PERM = true, AFTER_DRAIN = false;
    bf16_t* P;
    __device__ __forceinline__ void operator()(const f32x4 (&acc)[2][2][4][2], const Unit& u, int wr, int wc, int fr_, int fq_) const {
        int fr = fr_, fq = fq_; asm volatile("" : "+v"(fr), "+v"(fq));
        const int row0 = u.pm * BM + wr * 64 + fr, col0 = u.pn * BM + wc * 32 + 8 * fq, grp = u.pn >> 1;
#pragma unroll
        for (int ai = 0; ai < 2; ++ai)
#pragma unroll
            for (int m = 0; m < 4; ++m) { bf16_t* rowp = P + (size_t)(row0 + ai * HALF + m * 16) * NIN + col0;
#pragma unroll
                for (int bj = 0; bj < 2; ++bj) { f32x4 v0 = acc[ai][bj][m][0], v1 = acc[ai][bj][m][1];
                    if (grp == 1) {
#pragma unroll
                        for (int j = 0; j < 4; ++j) { v0[j] = gelu_tanh(v0[j]); v1[j] = gelu_tanh(v1[j]); } }
                    else if (grp == 2 || grp == 6) {
#pragma unroll
                        for (int j = 0; j < 4; ++j) { v0[j] = siluf_(v0[j]); v1[j] = siluf_(v1[j]); } }
                    u32x4 w; w.x = cvt_pk_bf16(v0[0], v0[1]); w.y = cvt_pk_bf16(v0[2], v0[3]); w.z = cvt_pk_bf16(v1[0], v1[1]); w.w = cvt_pk_bf16(v1[2], v1[3]);
                    *(u32x4*)(rowp + bj * HALF) = w; } }
    }
};
struct EpiF32 {
    static constexpr bool PERM = false, AFTER_DRAIN = false;
    float* C; int ldc; int pad;
    __device__ __forceinline__ void operator()(const f32x4 (&acc)[2][2][4][2], const Unit& u, int wr, int wc, int fr_, int fq_) const {
        int fr = fr_, fq = fq_; asm volatile("" : "+v"(fr), "+v"(fq));
        const int row0 = u.pm * BM + wr * 64 + fr, col0 = u.pn * BM + wc * 32 + 4 * fq;
#pragma unroll
        for (int ai = 0; ai < 2; ++ai)
#pragma unroll
            for (int m = 0; m < 4; ++m) { float* rowp = C + (size_t)(row0 + ai * HALF + m * 16) * ldc + col0;
#pragma unroll
                for (int bj = 0; bj < 2; ++bj)
#pragma unroll
                    for (int n = 0; n < 2; ++n) *(f32x4*)(rowp + bj * HALF + n * 16) = acc[ai][bj][m][n]; }
    }
};
struct EpiExp1 {
    static constexpr bool PERM = false, AFTER_DRAIN = false;
    bf16_t* H;
    __device__ __forceinline__ void operator()(const f32x4 (&acc)[2][2][4][2], const Unit& u, int wr, int wc, int fr_, int fq_) const {
        int fr = fr_, fq = fq_; asm volatile("" : "+v"(fr), "+v"(fq));
        const int row0 = u.pm * BM + wr * 64 + fr, hc0 = (((u.pn & 3) * BM + wc * 32) >> 1) + 4 * fq;
#pragma unroll
        for (int ai = 0; ai < 2; ++ai)
#pragma unroll
            for (int m = 0; m < 4; ++m) { bf16_t* rowp = H + (size_t)(row0 + ai * HALF + m * 16) * DE + hc0;
#pragma unroll
                for (int bj = 0; bj < 2; ++bj) { const f32x4 a = acc[ai][bj][m][0], b = acc[ai][bj][m][1];
                    u32x2 w; w.x = cvt_pk_bf16(siluf_(a[0]) * b[0], siluf_(a[1]) * b[1]); w.y = cvt_pk_bf16(siluf_(a[2]) * b[2], siluf_(a[3]) * b[3]);
                    *(u32x2*)(rowp + bj * 64) = w; } }
    }
};
struct EpiY {
    static constexpr bool PERM = true, AFTER_DRAIN = false;
    bf16_t* Y;
    __device__ __forceinline__ void operator()(const f32x4 (&acc)[2][2][4][2], const Unit& u, int wr, int wc, int fr_, int fq_) const {
        int fr = fr_, fq = fq_; asm volatile("" : "+v"(fr), "+v"(fq));
        const int row0 = u.pm * BM + wr * 64 + fr, col0 = (u.pn & 3) * BM + wc * 32 + 8 * fq;
#pragma unroll
        for (int ai = 0; ai < 2; ++ai)
#pragma unroll
            for (int m = 0; m < 4; ++m) { bf16_t* rowp = Y + (size_t)(row0 + ai * HALF + m * 16) * DM + col0;
#pragma unroll
                for (int bj = 0; bj < 2; ++bj) { const f32x4 v0 = acc[ai][bj][m][0], v1 = acc[ai][bj][m][1];
                    u32x4 w; w.x = cvt_pk_bf16(v0[0], v0[1]); w.y = cvt_pk_bf16(v0[2], v0[3]); w.z = cvt_pk_bf16(v1[0], v1[1]); w.w = cvt_pk_bf16(v1[2], v1[3]);
                    *(u32x4*)(rowp + bj * HALF) = w; } }
    }
};
struct ExpertOrder {
    const int* counts; int G, c;
    __device__ __forceinline__ bool next(int i, Unit& u) const {
        const int L = i * G + c, rb = L >> 2; int acc = 0, ef = -1;
        for (int e = 0; e < NE; ++e) { const int nb = (counts[e] + 255) >> 8; if (rb >= acc && rb < acc + nb) ef = e; acc += nb; }
        if (ef < 0) return false;
        u.pm = rb; u.pn = ef * 4 + (L & 3); return true;
    }
    __device__ __forceinline__ void a_ready(const Unit&) const {}
    __device__ __forceinline__ void done(const Unit&) const {}
};

template <class Epi, class Sched, bool ALIGN_EPI = false, bool SP2 = false>
__device__ __forceinline__ void gemm_phase(PG8_LAS unsigned char* lds, const Gemm g, const Sched& S, const Epi& E) {
    const int tid = threadIdx.x, wid = __builtin_amdgcn_readfirstlane(tid >> 6), lane = tid & 63, wr = wid >> 2, wc = wid & 3, fr = lane & 15, fq = lane >> 4;
    const int K = g.K, nt = K / BK;
    unsigned voffA[2], voffB[2];
#pragma unroll
    for (int i = 0; i < 2; ++i) { int R, C; stage_rc(tid * 16 + i * 8192, R, C); const int Rb = Epi::PERM ? ((R & ~31) + perm32(R & 31)) : R;
        voffA[i] = (unsigned)(R * K + C) * 2u; voffB[i] = (unsigned)(Rb * K + C) * 2u; }
    const size_t kstep = (size_t)(BK * 2);
    const size_t hstep = (size_t)HALF * K * 2;
    const size_t tstep = 2 * hstep;
    const unsigned ldsw = (unsigned)wid * 1024u;
    const int aoff = lds_byte(wr * 64 + fr, fq * 8), boff = lds_byte(wc * 32 + fr, fq * 8);
#define PG8_SA(b, h) (((b) * 2 + (h)) * HTB)
#define PG8_SB(b, h) ((4 + (b) * 2 + (h)) * HTB)
#define PG8_STAGE(bufoff, gbase, voff) do { _Pragma("unroll") for (int _i = 0; _i < 2; ++_i) \
        __builtin_amdgcn_global_load_lds((const unsigned*)((const char*)(gbase) + (voff)[_i]), (PG8_LAS unsigned*)(lds + (bufoff) + ldsw + _i * 8192), 16, 0, 0); } while (0)
#define PG8_LDA(dst, b, h) do { _Pragma("unroll") for (int m = 0; m < 4; ++m) _Pragma("unroll") for (int k = 0; k < 2; ++k) dst[m][k] = *(const PG8_LAS bf16x8*)(lds + PG8_SA(b, h) + aoff + m * 2048 + k * 1024); } while (0)
#define PG8_LDB(dst, b, h) do { _Pragma("unroll") for (int n = 0; n < 2; ++n) _Pragma("unroll") for (int k = 0; k < 2; ++k) dst[n][k] = *(const PG8_LAS bf16x8*)(lds + PG8_SB(b, h) + boff + n * 2048 + k * 1024); } while (0)
#define PG8_MMA(ai, bj, At, Bt) do { __builtin_amdgcn_s_setprio(1); _Pragma("unroll") for (int m = 0; m < 4; ++m) _Pragma("unroll") for (int n = 0; n < 2; ++n) _Pragma("unroll") for (int k = 0; k < 2; ++k) \
        acc[ai][bj][m][n] = __builtin_amdgcn_mfma_f32_16x16x32_bf16(Bt[n][k], At[m][k], acc[ai][bj][m][n], 0, 0, 0); __builtin_amdgcn_s_setprio(0); } while (0)
#define PG8_WAIT_V(n) asm volatile("s_waitcnt vmcnt(" #n ")" ::: "memory")
#define PG8_WAIT_L(n) asm volatile("s_waitcnt lgkmcnt(" #n ")" ::: "memory")
#define PG8_BAR __builtin_amdgcn_s_barrier()
#define PG8_SCHED __builtin_amdgcn_sched_barrier(0)
    Unit cur, nxt; int ui = 0;
    if (!S.next(0, cur)) return;
    f32x4 acc[2][2][4][2];
#pragma unroll
    for (int a = 0; a < 2; ++a)
#pragma unroll
        for (int b = 0; b < 2; ++b)
#pragma unroll
            for (int m = 0; m < 4; ++m)
#pragma unroll
                for (int n = 0; n < 2; ++n) acc[a][b][m][n] = (f32x4){0.f, 0.f, 0.f, 0.f};
    bf16x8 At[4][2], B0[2][2], B1[2][2];
    const char* cA = (const char*)g.A + (size_t)cur.pm * tstep; const char* cB = (const char*)g.Bt + (size_t)cur.pn * tstep;
    S.a_ready(cur);
    if constexpr (SP2) {
        PG8_STAGE(PG8_SB(0, 0), cB, voffB); PG8_STAGE(PG8_SB(0, 1), cB + hstep, voffB); PG8_STAGE(PG8_SA(0, 0), cA, voffA); PG8_STAGE(PG8_SA(0, 1), cA + hstep, voffA);
        if (wr == 1) PG8_BAR;
        PG8_WAIT_V(2); PG8_BAR;
        PG8_STAGE(PG8_SB(1, 0), cB + kstep, voffB); PG8_STAGE(PG8_SA(1, 0), cA + kstep, voffA); PG8_STAGE(PG8_SB(1, 1), cB + hstep + kstep, voffB);
        PG8_WAIT_V(6); PG8_BAR;
    } else {
        PG8_STAGE(PG8_SB(0, 0), cB, voffB); PG8_STAGE(PG8_SA(0, 0), cA, voffA); PG8_STAGE(PG8_SB(0, 1), cB + hstep, voffB); PG8_STAGE(PG8_SA(0, 1), cA + hstep, voffA);
        if (wr == 1) PG8_BAR;
        PG8_WAIT_V(4); PG8_BAR;
        PG8_STAGE(PG8_SB(1, 0), cB + kstep, voffB); PG8_STAGE(PG8_SA(1, 0), cA + kstep, voffA); PG8_STAGE(PG8_SB(1, 1), cB + hstep + kstep, voffB);
        PG8_WAIT_V(6); PG8_BAR;
    }
    for (;;) {
        const bool has_next = S.next(ui + 1, nxt);
        const char* nA = has_next ? (const char*)g.A + (size_t)nxt.pm * tstep : cA; const char* nB = has_next ? (const char*)g.Bt + (size_t)nxt.pn * tstep : cB;
        for (int t = 0; t < nt; t += 2) {
            const bool last = (t == nt - 2);
            const char* a1 = cA + (size_t)(t + 1) * kstep;
            const char* a2 = last ? nA : cA + (size_t)(t + 2) * kstep; const char* b2 = last ? nB : cB + (size_t)(t + 2) * kstep;
            const char* a3 = a2 + kstep; const char* b3 = b2 + kstep;
            if (last && has_next) S.a_ready(nxt);
            if constexpr (SP2) {
            PG8_LDB(B0, 0, 0); PG8_LDB(B1, 0, 1); PG8_SCHED; PG8_LDA(At, 0, 0); PG8_STAGE(PG8_SA(1, 1), a1 + hstep, voffA);
            PG8_WAIT_V(8); PG8_WAIT_L(0); PG8_BAR; PG8_MMA(0, 0, At, B0); PG8_MMA(0, 1, At, B1); PG8_BAR; PG8_SCHED;
            PG8_LDA(At, 0, 1); PG8_STAGE(PG8_SB(0, 0), b2, voffB); PG8_STAGE(PG8_SB(0, 1), b2 + hstep, voffB); PG8_STAGE(PG8_SA(0, 0), a2, voffA);
            PG8_WAIT_V(8); PG8_WAIT_L(0); PG8_BAR; PG8_MMA(1, 0, At, B0); PG8_MMA(1, 1, At, B1); PG8_BAR; PG8_SCHED;
            PG8_LDB(B0, 1, 0); PG8_LDB(B1, 1, 1); PG8_SCHED; PG8_LDA(At, 1, 0); PG8_STAGE(PG8_SA(0, 1), a2 + hstep, voffA);
            PG8_WAIT_V(8); PG8_WAIT_L(0); PG8_BAR; PG8_MMA(0, 0, At, B0); PG8_MMA(0, 1, At, B1); PG8_BAR; PG8_SCHED;
            PG8_LDA(At, 1, 1); PG8_STAGE(PG8_SB(1, 0), b3, voffB); PG8_STAGE(PG8_SB(1, 1), b3 + hstep, voffB); PG8_STAGE(PG8_SA(1, 0), a3, voffA);
            PG8_WAIT_V(8); PG8_WAIT_L(0); PG8_BAR; PG8_MMA(1, 0, At, B0); PG8_MMA(1, 1, At, B1); PG8_BAR; PG8_SCHED;
            } else {
            PG8_LDB(B0, 0, 0); PG8_SCHED; PG8_LDA(At, 0, 0); PG8_STAGE(PG8_SA(1, 1), a1 + hstep, voffA);
            PG8_WAIT_L(8); PG8_BAR; PG8_WAIT_L(0); PG8_MMA(0, 0, At, B0); PG8_BAR; PG8_SCHED;
            PG8_LDB(B1, 0, 1); PG8_STAGE(PG8_SB(0, 0), b2, voffB);
            PG8_BAR; PG8_WAIT_L(0); PG8_MMA(0, 1, At, B1); PG8_BAR;
            PG8_LDA(At, 0, 1); PG8_STAGE(PG8_SA(0, 0), a2, voffA);
            PG8_BAR; PG8_WAIT_L(0); PG8_MMA(1, 0, At, B0); PG8_BAR; PG8_SCHED;
            PG8_STAGE(PG8_SB(0, 1), b2 + hstep, voffB);
            PG8_WAIT_V(6); PG8_BAR; PG8_MMA(1, 1, At, B1); PG8_BAR;
            PG8_LDB(B0, 1, 0); PG8_SCHED; PG8_LDA(At, 1, 0); PG8_STAGE(PG8_SA(0, 1), a2 + hstep, voffA);
            PG8_WAIT_L(8); PG8_BAR; PG8_WAIT_L(0); PG8_MMA(0, 0, At, B0); PG8_BAR; PG8_SCHED;
            PG8_LDB(B1, 1, 1); PG8_STAGE(PG8_SB(1, 0), b3, voffB);
            PG8_BAR; PG8_WAIT_L(0); PG8_MMA(0, 1, At, B1); PG8_BAR;
            PG8_LDA(At, 1, 1); PG8_STAGE(PG8_SA(1, 0), a3, voffA);
            PG8_BAR; PG8_WAIT_L(0); PG8_MMA(1, 0, At, B0); PG8_BAR; PG8_SCHED;
            PG8_STAGE(PG8_SB(1, 1), b3 + hstep, voffB);
            PG8_WAIT_V(6); PG8_BAR; PG8_MMA(1, 1, At, B1); PG8_BAR;
            }
        }
        if constexpr (ALIGN_EPI) { if (wr == 0) PG8_BAR; }
        if constexpr (!Epi::AFTER_DRAIN) { E(acc, cur, wr, wc, fr, fq); S.done(cur); }
        if (!has_next) break;
#pragma unroll
        for (int a = 0; a < 2; ++a)
#pragma unroll
            for (int b = 0; b < 2; ++b)
#pragma unroll
                for (int m = 0; m < 4; ++m)
#pragma unroll
                    for (int n = 0; n < 2; ++n) acc[a][b][m][n] = (f32x4){0.f, 0.f, 0.f, 0.f};
        cur = nxt; cA = nA; cB = nB; ++ui;
        if constexpr (ALIGN_EPI) { if (wr == 1) PG8_BAR; }
    }
    PG8_WAIT_V(0);
    if constexpr (!ALIGN_EPI) { if (wr == 0) PG8_BAR; }
    PG8_BAR;
    if constexpr (Epi::AFTER_DRAIN) { E.fused(acc, cur, wr, wc, fr, fq, lds, wid, lane); S.done(cur); }
#undef PG8_SA
#undef PG8_SB
#undef PG8_STAGE
#undef PG8_LDA
#undef PG8_LDB
#undef PG8_MMA
#undef PG8_WAIT_V
#undef PG8_WAIT_L
#undef PG8_BAR
#undef PG8_SCHED
}
}

struct Args { const float* in[26]; float* out; unsigned char* ws; };

__device__ __forceinline__ void p_mod(LAS unsigned char* lds, const float* __restrict__ c, const float* __restrict__ c_ctx, const float* __restrict__ ada_w,
                                      const float* __restrict__ ada_b, float* __restrict__ mod, int bid, int G, int tid) {
    if (bid >= 96) return;
    LAS float* s = (LAS float*)lds;
    LAS float* red = s + 17 * 1024;
    for (int i = tid; i < 17 * 1024; i += NTHREADS) { const int r = i >> 10, k = i & 1023; const float v = r < NB ? c[r * DM + k] : c_ctx[k]; s[i] = v / (1.0f + expf(-v)); }
    __syncthreads();
    for (int it = bid; it < 96; it += G) {
        const int cc = tid & 63, kg = tid >> 6, col = it * 64 + cc;
        float acc[17];
#pragma unroll
        for (int r = 0; r < 17; ++r) acc[r] = 0.f;
        for (int k = kg * 128; k < kg * 128 + 128; ++k) {
            const float w = ada_w[(size_t)k * 6144 + col];
#pragma unroll
            for (int r = 0; r < 17; ++r) acc[r] += s[r * 1024 + k] * w;
        }
#pragma unroll
        for (int r = 0; r < 17; ++r) red[(kg * 17 + r) * 64 + cc] = acc[r];
        __syncthreads();
        for (int i = tid; i < 17 * 64; i += NTHREADS) {
            const int r = i >> 6, c2 = i & 63; float sum = 0.f;
#pragma unroll
            for (int g = 0; g < 8; ++g) sum += red[(g * 17 + r) * 64 + c2];
            mod[(size_t)r * 6144 + it * 64 + c2] = sum + ada_b[it * 64 + c2];
        }
        __syncthreads();
    }
}

__device__ __forceinline__ void transpose_tile(LAS float* tile, const float* __restrict__ W, int K, int N, bf16_t* __restrict__ O, int mode, int k0, int n0, int tid) {
    for (int i = tid; i < 64 * 64; i += NTHREADS) { const int kk = i >> 6, nn = i & 63; tile[kk * 65 + nn] = W[(size_t)(k0 + kk) * N + n0 + nn]; }
    __syncthreads();
    for (int i = tid; i < 64 * 32; i += NTHREADS) {
        const int nn = i >> 5, kp = i & 31, n = n0 + nn;
        const int orow = mode == 0 ? n : ((n >> 4) * 32 + (mode == 2 ? 16 : 0) + (n & 15));
        *(unsigned*)(O + (size_t)orow * K + k0 + 2 * kp) = pk2(tile[(2 * kp) * 65 + nn], tile[(2 * kp + 1) * 65 + nn]);
    }
    __syncthreads();
}
__device__ __forceinline__ void p_transposes(LAS unsigned char* lds, const Args& a, int bid, int G, int tid) {
    LAS float* tile = (LAS float*)lds;
    unsigned char* ws = a.ws;
    constexpr int I_IN = 16 * 56, I_OUT = 16 * 16, I_E = 32 * 128;
    constexpr int NITEMS = I_IN + I_OUT + 3 * I_E;
    for (int it = bid; it < NITEMS; it += G) {
        int r = it;
        if (r < I_IN) { transpose_tile(tile, a.in[6], DM, NIN, (bf16_t*)(ws + WS_WINT), 0, (r & 15) * 64, (r >> 4) * 64, tid); continue; } r -= I_IN;
        if (r < I_OUT) { transpose_tile(tile, a.in[14], DM, DM, (bf16_t*)(ws + WS_WOUTT), 0, (r & 15) * 64, (r >> 4) * 64, tid); continue; } r -= I_OUT;
        if (r < I_E) { const int e = r >> 7, q = r & 127; transpose_tile(tile, a.in[21] + (size_t)e * DM * DE, DM, DE, (bf16_t*)(ws + WS_W13T) + (size_t)e * DM * DM, 1, (q & 15) * 64, (q >> 4) * 64, tid); continue; } r -= I_E;
        if (r < I_E) { const int e = r >> 7, q = r & 127; transpose_tile(tile, a.in[22] + (size_t)e * DM * DE, DM, DE, (bf16_t*)(ws + WS_W13T) + (size_t)e * DM * DM, 2, (q & 15) * 64, (q >> 4) * 64, tid); continue; } r -= I_E;
        { const int e = r >> 7, q = r & 127; transpose_tile(tile, a.in[23] + (size_t)e * DE * DM, DE, DM, (bf16_t*)(ws + WS_W2T) + (size_t)e * DM * DE, 0, (q & 7) * 64, (q >> 3) * 64, tid); }
    }
}

__device__ __forceinline__ void p_u(const float* __restrict__ x, const float* __restrict__ ctx, const float* __restrict__ mod, bf16_t* __restrict__ U, int bid, int G, int tid) {
    for (size_t i4 = (size_t)bid * NTHREADS + tid; i4 < (size_t)TA * 256; i4 += (size_t)G * NTHREADS) {
        const int row = (int)(i4 >> 8), c4 = (int)(i4 & 255) * 4;
        const float* src; const float* m;
        if (row < T) { src = x + (size_t)row * DM; m = mod + (size_t)(row / SEQ) * 6144; }
        else { src = ctx + (size_t)(row - T) * DM; m = mod + (size_t)16 * 6144; }
        const f32x4 v = *(const f32x4*)(src + c4), sh = *(const f32x4*)(m + c4), sc = *(const f32x4*)(m + 1024 + c4);
        u32x2 w; w.x = pk2(v[0] * (1.f + sc[0]) + sh[0], v[1] * (1.f + sc[1]) + sh[1]); w.y = pk2(v[2] * (1.f + sc[2]) + sh[2], v[3] * (1.f + sc[3]) + sh[3]);
        *(u32x2*)(U + (size_t)row * DM + c4) = w;
    }
}

__device__ __forceinline__ void router_decide(const float (&pl)[36], int tok, int lane, int* counts, int2* eidx, int2* epos, float2* ew) {
    int gi = 0; float gm = pl[0];
#pragma unroll
    for (int g = 1; g < 4; ++g) if (pl[g] > gm) { gm = pl[g]; gi = g; }
    float den = 0.f;
#pragma unroll
    for (int g = 0; g < 4; ++g) den += expf(pl[g] - gm);
    const float gval = 1.0f / den;
    int j0 = -1; float v0 = -3.0e38f;
#pragma unroll
    for (int j = 0; j < 32; ++j) { const bool in = (j >> 3) == gi; if (in && (j0 < 0 || pl[4 + j] > v0)) { v0 = pl[4 + j]; j0 = j; } }
    int j1 = -1; float v1 = -3.0e38f;
#pragma unroll
    for (int j = 0; j < 32; ++j) { const bool in = (j >> 3) == gi; if (in && j != j0 && (j1 < 0 || pl[4 + j] > v1)) { v1 = pl[4 + j]; j1 = j; } }
    const int e0 = j0 & 7, e1 = j1 & 7;
    if (lane == 0) {
        const float t = expf(v1 - v0), w0 = 1.0f / (1.0f + t), w1 = t / (1.0f + t);
        const int id0 = gi * 8 + e0, id1 = gi * 8 + e1;
        const int p0 = atomicAdd(&counts[id0], 1), p1 = atomicAdd(&counts[id1], 1);
        eidx[tok] = make_int2(id0, id1); epos[tok] = make_int2(p0, p1); ew[tok] = make_float2(gval * w0, gval * w1);
    }
}
__device__ __forceinline__ void p_ln1_router(LAS unsigned char* lds, const Args& a, int bid, int G, int tid, int wave, int lane) {
    const float* __restrict__ x = a.in[0]; float* yo = a.out; const float* mod = (const float*)(a.ws + WS_MOD);
    const float* __restrict__ ln_g = a.in[15]; const float* __restrict__ ln_b = a.in[16];
    const float* __restrict__ rgw = a.in[17]; const float* __restrict__ rgb = a.in[18]; const float* __restrict__ rew = a.in[19]; const float* __restrict__ reb = a.in[20];
    bf16_t* U2 = (bf16_t*)(a.ws + WS_U); int* counts = (int*)(a.ws + WS_CTL);
    int2* eidx = (int2*)(a.ws + WS_EIDX); int2* epos = (int2*)(a.ws + WS_EPOS); float2* ew = (float2*)(a.ws + WS_EW);
    LAS float* WT = (LAS float*)lds;
    for (int i = tid; i < 1024 * 4; i += NTHREADS) WT[(i & 3) * 1024 + (i >> 2)] = rgw[i];
    for (int i = tid; i < 1024 * 32; i += NTHREADS) WT[(4 + (i & 31)) * 1024 + (i >> 5)] = rew[i];
    LAS float* BIAS = WT + 36 * 1024;
    if (tid < 36) BIAS[tid] = tid < 4 ? rgb[tid] : reb[tid - 4];
    __syncthreads();
#pragma unroll 1
    for (int pr = bid * 8 + wave; pr < T / 2; pr += G * 8) {
        int l2 = lane; asm volatile("" : "+v"(l2)); const int lane = l2;
        const int tok0 = 2 * pr;
        const float* m = mod + (size_t)(tok0 / SEQ) * 6144;
        f32x4 v[2][4]; float s[2] = {0.f, 0.f};
#pragma unroll
        for (int t = 0; t < 2; ++t)
#pragma unroll
            for (int j = 0; j < 4; ++j) { const int c4 = 4 * lane + 256 * j;
                const f32x4 xv = *(const f32x4*)(x + (size_t)(tok0 + t) * DM + c4), yv = *(const f32x4*)(yo + (size_t)(tok0 + t) * DM + c4), g1 = *(const f32x4*)(m + 2048 + c4);
                v[t][j] = ALPHA * xv + g1 * yv; s[t] += (v[t][j][0] + v[t][j][1]) + (v[t][j][2] + v[t][j][3]); }
        float rstd[2];
#pragma unroll
        for (int t = 0; t < 2; ++t) { const float mean = wave_sum(s[t]) * (1.0f / DM); float s2 = 0.f;
#pragma unroll
            for (int j = 0; j < 4; ++j) { v[t][j] = v[t][j] - mean; s2 += (v[t][j][0] * v[t][j][0] + v[t][j][1] * v[t][j][1]) + (v[t][j][2] * v[t][j][2] + v[t][j][3] * v[t][j][3]); }
            rstd[t] = rsqrtf(wave_sum(s2) * (1.0f / DM) + LN_EPS); }
        float plA[36], plB[36];
#pragma unroll
        for (int e = 0; e < 36; ++e) { plA[e] = 0.f; plB[e] = 0.f; }
#pragma unroll
        for (int j = 0; j < 4; ++j) { const int c4 = 4 * lane + 256 * j;
            const f32x4 lg = *(const f32x4*)(ln_g + c4), lb = *(const f32x4*)(ln_b + c4), sc2 = *(const f32x4*)(m + 4096 + c4), sh2 = *(const f32x4*)(m + 3072 + c4);
            f32x4 u2[2];
#pragma unroll
            for (int t = 0; t < 2; ++t) { const f32x4 h1 = v[t][j] * rstd[t] * lg + lb;
                *(f32x4*)(yo + (size_t)(tok0 + t) * DM + c4) = h1;
                u2[t] = h1 * (1.0f + sc2) + sh2;
                u32x2 w; w.x = pk2(u2[t][0], u2[t][1]); w.y = pk2(u2[t][2], u2[t][3]);
                *(u32x2*)(U2 + (size_t)(tok0 + t) * DM + c4) = w; }
#pragma unroll
            for (int e = 0; e < 36; ++e) { const f32x4 w4 = *(const LAS f32x4*)(WT + e * 1024 + c4);
                plA[e] += (u2[0][0] * w4[0] + u2[0][1] * w4[1]) + (u2[0][2] * w4[2] + u2[0][3] * w4[3]);
                plB[e] += (u2[1][0] * w4[0] + u2[1][1] * w4[1]) + (u2[1][2] * w4[2] + u2[1][3] * w4[3]); }
        }
#pragma unroll
        for (int e = 0; e < 36; ++e) { const float be = BIAS[e]; plA[e] = wave_sum(plA[e]) + be; plB[e] = wave_sum(plB[e]) + be; if ((e & 3) == 3) __builtin_amdgcn_sched_barrier(0); }
        router_decide(plA, tok0, lane, counts, eidx, epos, ew);
        router_decide(plB, tok0 + 1, lane, counts, eidx, epos, ew);
    }
    __syncthreads();
}

__device__ __forceinline__ void p_gather(const Args& a, int bid, int G, int wave, int lane) {
    const bf16_t* U2 = (const bf16_t*)(a.ws + WS_U); const int* counts = (const int*)(a.ws + WS_CTL);
    const int2* eidx = (const int2*)(a.ws + WS_EIDX); const int2* epos = (const int2*)(a.ws + WS_EPOS); int2* dest = (int2*)(a.ws + WS_DEST);
    bf16_t* XG = (bf16_t*)(a.ws + WS_XG);
    for (int tok = bid * 8 + wave; tok < T; tok += G * 8) {
        const int2 ei = eidx[tok], ep = epos[tok];
        const int d0 = pstart_of(counts, ei.x) + ep.x, d1 = pstart_of(counts, ei.y) + ep.y;
        const u32x4 v0 = *(const u32x4*)(U2 + (size_t)tok * DM + lane * 8), v1 = *(const u32x4*)(U2 + (size_t)tok * DM + 512 + lane * 8);
        *(u32x4*)(XG + (size_t)d0 * DM + lane * 8) = v0; *(u32x4*)(XG + (size_t)d0 * DM + 512 + lane * 8) = v1;
        *(u32x4*)(XG + (size_t)d1 * DM + lane * 8) = v0; *(u32x4*)(XG + (size_t)d1 * DM + 512 + lane * 8) = v1;
        if (lane == 0) dest[tok] = make_int2(d0, d1);
    }
}

__device__ __forceinline__ void p_combine_ln2(const Args& a, int bid, int G, int wave, int lane) {
    float* out = a.out; const bf16_t* Y = (const bf16_t*)(a.ws + WS_Y); const int2* dest = (const int2*)(a.ws + WS_DEST); const float2* ew = (const float2*)(a.ws + WS_EW);
    const float* mod = (const float*)(a.ws + WS_MOD); const float* __restrict__ ln_g = a.in[24]; const float* __restrict__ ln_b = a.in[25];
    for (int tok = bid * 8 + wave; tok < T; tok += G * 8) {
        const float* m = mod + (size_t)(tok / SEQ) * 6144;
        const int2 d = dest[tok]; const float2 w = ew[tok];
        f32x4 v[4]; float s = 0.f;
#pragma unroll
        for (int j = 0; j < 4; ++j) { const int c4 = 4 * lane + 256 * j;
            const u32x2 ya = *(const u32x2*)(Y + (size_t)d.x * DM + c4), yb = *(const u32x2*)(Y + (size_t)d.y * DM + c4);
            f32x4 f;
            f[0] = w.x * __uint_as_float(ya.x << 16) + w.y * __uint_as_float(yb.x << 16);
            f[1] = w.x * __uint_as_float(ya.x & 0xffff0000u) + w.y * __uint_as_float(yb.x & 0xffff0000u);
            f[2] = w.x * __uint_as_float(ya.y << 16) + w.y * __uint_as_float(yb.y << 16);
            f[3] = w.x * __uint_as_float(ya.y & 0xffff0000u) + w.y * __uint_as_float(yb.y & 0xffff0000u);
            const f32x4 h1 = *(const f32x4*)(out + (size_t)tok * DM + c4), g2 = *(const f32x4*)(m + 5120 + c4);
            v[j] = ALPHA * h1 + g2 * f; s += (v[j][0] + v[j][1]) + (v[j][2] + v[j][3]); }
        const float mean = wave_sum(s) * (1.0f / DM); float s2 = 0.f;
#pragma unroll
        for (int j = 0; j < 4; ++j) { v[j] = v[j] - mean; s2 += (v[j][0] * v[j][0] + v[j][1] * v[j][1]) + (v[j][2] * v[j][2] + v[j][3] * v[j][3]); }
        const float rstd = rsqrtf(wave_sum(s2) * (1.0f / DM) + LN_EPS);
#pragma unroll
        for (int j = 0; j < 4; ++j) { const int c4 = 4 * lane + 256 * j;
            *(f32x4*)(out + (size_t)tok * DM + c4) = v[j] * rstd * *(const f32x4*)(ln_g + c4) + *(const f32x4*)(ln_b + c4); }
    }
}

constexpr size_t WS_HGK = WS_U;
constexpr size_t WS_HGD = 852 * MiB;
constexpr size_t WS_RGAGG = 854 * MiB;
constexpr size_t WS_RGCARRY = 864 * MiB;
constexpr size_t WS_GWT = 870 * MiB;
constexpr size_t WS_OFST = 880 * MiB;
constexpr int RG_UNITS_PER_B = 68, HG_SEGS = 17;

__device__ __forceinline__ void lds_barrier() { asm volatile("s_waitcnt lgkmcnt(0)" ::: "memory"); __builtin_amdgcn_s_barrier(); asm volatile("" ::: "memory"); }
__device__ __forceinline__ bf16x8 mk_bf16x8(u32x4 v) { return __builtin_bit_cast(bf16x8, v); }
__device__ __forceinline__ float bf_lo(unsigned w) { return __uint_as_float(w << 16); }
__device__ __forceinline__ float bf_hi(unsigned w) { return __uint_as_float(w & 0xffff0000u); }
__device__ __forceinline__ unsigned cvt2(float lo, float hi) { unsigned r; asm volatile("v_cvt_pk_bf16_f32 %0, %1, %2" : "=v"(r) : "v"(lo), "v"(hi)); return r; }

__device__ __forceinline__ void p_gwt(const float* __restrict__ gate_w, bf16_t* __restrict__ gwt, int bid, int G, int tid) {
    for (int o = bid * NTHREADS + tid; o < 32 * 4096; o += G * NTHREADS) { const int mat = o >> 12, d = (o >> 6) & 63, c = o & 63; gwt[o] = f2bf(gate_w[mat * 4096 + c * 64 + d]); }
}

constexpr int XC_STRIDE = 1040;
constexpr int RG_XC = 0, RG_OUT = 64 * XC_STRIDE;
template <int MODE>
__device__ __forceinline__ void rg_unit(LAS unsigned char* lds, const Args& a, int b, int k, int tid, int wave, int lane) {
    const bf16_t* __restrict__ proj = (const bf16_t*)(a.ws + WS_PROJ);
    const float* __restrict__ conv_w = a.in[7]; const float* __restrict__ conv_b = a.in[8]; const float* __restrict__ gate_b = a.in[10]; const float* __restrict__ lam = a.in[11];
    const bf16_t* __restrict__ gwt = (const bf16_t*)(a.ws + WS_GWT);
    float* rgagg = (float*)(a.ws + WS_RGAGG); const float* rgcarry = (const float*)(a.ws + WS_RGCARRY);
    int rowbase, p0, lo, hi;
    if (k < 4) { rowbase = T + b * LC; p0 = k * 64; lo = 0; hi = LC; } else { rowbase = b * SEQ; p0 = (k - 4) * 64; lo = p0; hi = p0 + 64; }
    const int unit = b * RG_UNITS_PER_B + k;
    {
        const int cgp = tid & 63, tg = tid >> 6, c0 = cgp * 8, i0 = tg * 8;
        u32x4 raw[11];
#pragma unroll
        for (int r = 0; r < 11; ++r) { const int p = p0 + i0 - 1 + r;
            raw[r] = (p >= lo && p < hi) ? *(const u32x4*)(proj + (size_t)(rowbase + p) * NIN + c0) : (u32x4){0u, 0u, 0u, 0u}; }
        float cw[4][8], cb[8];
#pragma unroll
        for (int t4 = 0; t4 < 4; ++t4) { const f32x4 w0 = *(const f32x4*)(conv_w + t4 * 512 + c0), w1 = *(const f32x4*)(conv_w + t4 * 512 + c0 + 4);
#pragma unroll
            for (int q = 0; q < 4; ++q) { cw[t4][q] = w0[q]; cw[t4][4 + q] = w1[q]; } }
        { const f32x4 b0 = *(const f32x4*)(conv_b + c0), b1 = *(const f32x4*)(conv_b + c0 + 4);
#pragma unroll
            for (int q = 0; q < 4; ++q) { cb[q] = b0[q]; cb[4 + q] = b1[q]; } }
#pragma unroll
        for (int ii = 0; ii < 8; ++ii) {
            float xc[8];
#pragma unroll
            for (int c = 0; c < 8; ++c) xc[c] = cb[c];
#pragma unroll
            for (int t4 = 0; t4 < 4; ++t4) { const u32x4 rw = raw[ii + t4];
#pragma unroll
                for (int q = 0; q < 4; ++q) { xc[2 * q] += cw[t4][2 * q] * bf_lo(rw[q]); xc[2 * q + 1] += cw[t4][2 * q + 1] * bf_hi(rw[q]); } }
            u32x4 w; w.x = cvt2(xc[0], xc[1]); w.y = cvt2(xc[2], xc[3]); w.z = cvt2(xc[4], xc[5]); w.w = cvt2(xc[6], xc[7]);
            *(LAS u32x4*)(lds + RG_XC + (i0 + ii) * XC_STRIDE + c0 * 2) = w;
        }
    }
    lds_barrier();
    {
        const int n = wave, fr = lane & 15, fq = lane >> 4;
        bf16x8 afr[4][2];
#pragma unroll
        for (int m = 0; m < 4; ++m)
#pragma unroll
            for (int ks = 0; ks < 2; ++ks) afr[m][ks] = *(const LAS bf16x8*)(lds + RG_XC + (16 * m + fr) * XC_STRIDE + (n * 64 + ks * 32 + fq * 8) * 2);
        for (int nt = 0; nt < 4; ++nt) {
            const int ch = n * 64 + nt * 16 + fr;
            float xcv[4][4];
#pragma unroll
            for (int m = 0; m < 4; ++m)
#pragma unroll
                for (int j = 0; j < 4; ++j) xcv[m][j] = bf2f(*(const LAS bf16_t*)(lds + RG_XC + (16 * m + 4 * fq + j) * XC_STRIDE + ch * 2));
            float hsum[4][4];
#pragma unroll
            for (int dir = 0; dir < 2; ++dir) {
                f32x4 accr[4], acci[4];
#pragma unroll
                for (int m = 0; m < 4; ++m) { accr[m] = (f32x4){0.f, 0.f, 0.f, 0.f}; acci[m] = (f32x4){0.f, 0.f, 0.f, 0.f}; }
#pragma unroll
                for (int ks = 0; ks < 2; ++ks) {
                    const bf16x8 br = *(const bf16x8*)(gwt + ((size_t)(((dir * 2 + 0) * 8 + n) * 64 + nt * 16 + fr)) * 64 + ks * 32 + fq * 8);
                    const bf16x8 bi = *(const bf16x8*)(gwt + ((size_t)(((dir * 2 + 1) * 8 + n) * 64 + nt * 16 + fr)) * 64 + ks * 32 + fq * 8);
#pragma unroll
                    for (int m = 0; m < 4; ++m) { accr[m] = __builtin_amdgcn_mfma_f32_16x16x32_bf16(afr[m][ks], br, accr[m], 0, 0, 0); acci[m] = __builtin_amdgcn_mfma_f32_16x16x32_bf16(afr[m][ks], bi, acci[m], 0, 0, 0); }
                }
                const float gbr = gate_b[(dir * 2 + 0) * 512 + ch], gbi = gate_b[(dir * 2 + 1) * 512 + ch];
                const float sp = softplusf_(-lam[dir * 512 + ch]);
                float av[4][4], uv[4][4];
#pragma unroll
                for (int m = 0; m < 4; ++m)
#pragma unroll
                    for (int j = 0; j < 4; ++j) {
                        const float r = sigmoidf_(accr[m][j] + gbr), ig = sigmoidf_(acci[m][j] + gbi);
                        const float la = -8.0f * r * sp, t2 = 2.0f * la;
                        av[m][j] = __expf(la);
                        const float om = (t2 > -0.25f) ? -t2 * (1.f + t2 * (0.5f + t2 * (0.16666667f + t2 * (0.041666668f + t2 * 0.0083333338f)))) : 1.f - __expf(t2);
                        uv[m][j] = sqrtf(om) * ig * xcv[m][j];
                    }
                float carry = (MODE == 1) ? rgcarry[((size_t)unit * 2 + dir) * 512 + ch] : 0.f;
                float atot = 1.f;
#pragma unroll
                for (int mm = 0; mm < 4; ++mm) {
                    const int m = dir == 0 ? mm : 3 - mm;
                    float P, H;
                    if (dir == 0) { P = av[m][0]; H = uv[m][0];
#pragma unroll
                        for (int j = 1; j < 4; ++j) { H = av[m][j] * H + uv[m][j]; P *= av[m][j]; } }
                    else { P = av[m][3]; H = uv[m][3];
#pragma unroll
                        for (int j = 2; j >= 0; --j) { H = av[m][j] * H + uv[m][j]; P *= av[m][j]; } }
                    float Pn, Hn, Pe, He, Pt, Ht;
                    if (dir == 0) {
                        Pn = __shfl_up(P, 16); Hn = __shfl_up(H, 16); if (fq >= 1) { H = P * Hn + H; P = P * Pn; }
                        Pn = __shfl_up(P, 32); Hn = __shfl_up(H, 32); if (fq >= 2) { H = P * Hn + H; P = P * Pn; }
                        Pe = __shfl_up(P, 16); He = __shfl_up(H, 16); if (fq == 0) { Pe = 1.f; He = 0.f; }
                        Pt = __shfl(P, fr + 48); Ht = __shfl(H, fr + 48);
                    } else {
                        Pn = __shfl_down(P, 16); Hn = __shfl_down(H, 16); if (fq <= 2) { H = P * Hn + H; P = P * Pn; }
                        Pn = __shfl_down(P, 32); Hn = __shfl_down(H, 32); if (fq <= 1) { H = P * Hn + H; P = P * Pn; }
                        Pe = __shfl_down(P, 16); He = __shfl_down(H, 16); if (fq == 3) { Pe = 1.f; He = 0.f; }
                        Pt = __shfl(P, fr); Ht = __shfl(H, fr);
                    }
                    if (MODE == 1) {
                        float hp = Pe * carry + He;
                        if (dir == 0) {
#pragma unroll
                            for (int j = 0; j < 4; ++j) { hp = av[m][j] * hp + uv[m][j]; hsum[m][j] = hp; }
                        } else {
#pragma unroll
                            for (int j = 3; j >= 0; --j) { hp = av[m][j] * hp + uv[m][j]; hsum[m][j] += hp; }
                        }
                    }
                    carry = Pt * carry + Ht; atot *= Pt;
                }
                if (MODE == 0 && fq == 0) { rgagg[(((size_t)unit * 2 + dir) * 2 + 0) * 512 + ch] = atot; rgagg[(((size_t)unit * 2 + dir) * 2 + 1) * 512 + ch] = carry; }
            }
            if (MODE == 1) {
#pragma unroll
                for (int m = 0; m < 4; ++m)
#pragma unroll
                    for (int j = 0; j < 4; ++j) { const int t = 16 * m + 4 * fq + j;
                        const float gg = bf2f(proj[(size_t)(rowbase + p0 + t) * NIN + 512 + ch]);
                        *(LAS bf16_t*)(lds + RG_OUT + t * XC_STRIDE + ch * 2) = f2bf(hsum[m][j] * gg); }
            }
        }
    }
    lds_barrier();
    if (MODE == 1) {
        bf16_t* mixed = (bf16_t*)(a.ws + WS_MIXED);
        const int cgp = tid & 63, tg = tid >> 6, c0 = cgp * 8, i0 = tg * 8;
#pragma unroll
        for (int ii = 0; ii < 8; ++ii) { const u32x4 w = *(const LAS u32x4*)(lds + RG_OUT + (i0 + ii) * XC_STRIDE + c0 * 2);
            *(u32x4*)(mixed + (size_t)(rowbase + p0 + i0 + ii) * DM + c0) = w; }
    }
}

__device__ __forceinline__ void rg_carry_item(const Args& a, int item, int tid) {
    const float* rgagg = (const float*)(a.ws + WS_RGAGG); float* rgcarry = (float*)(a.ws + WS_RGCARRY);
    const int gidx = item * NTHREADS + tid;
    const int ch = gidx & 511, dir = (gidx >> 9) & 1, b = gidx >> 10;
    float h = 0.f;
    float Av[RG_UNITS_PER_B], Hv[RG_UNITS_PER_B];
#pragma unroll
    for (int s = 0; s < RG_UNITS_PER_B; ++s) {
        const int k = dir == 0 ? s : (s < 4 ? 3 - s : 67 - (s - 4));
        const size_t unit = (size_t)b * RG_UNITS_PER_B + k;
        Av[s] = rgagg[((unit * 2 + dir) * 2 + 0) * 512 + ch]; Hv[s] = rgagg[((unit * 2 + dir) * 2 + 1) * 512 + ch];
    }
#pragma unroll
    for (int s = 0; s < RG_UNITS_PER_B; ++s) {
        const int k = dir == 0 ? s : (s < 4 ? 3 - s : 67 - (s - 4));
        const size_t unit = (size_t)b * RG_UNITS_PER_B + k;
        rgcarry[(unit * 2 + dir) * 512 + ch] = h;
        h = Av[s] * h + Hv[s];
    }
}

constexpr int HG_RAWZ = 0, HG_RAWV = 16384, HG_RAWQ = 32768;
constexpr int HG_KHT = 49152, HG_VT = 67584;
constexpr int HG_QT = 86016, HG_KT = 103424;
constexpr int HG_AM = 120832;
constexpr int HG_DS = 130048, HG_QSUM = 130560, HG_PART = 132608;
constexpr int HG_OST = 0;
constexpr int TS = 144, QS = 272;

struct HgRaw { u32x4 z[2], v[2], q[2]; };
template <bool FULL>
__device__ __forceinline__ void hg_load_raw(HgRaw& r, const bf16_t* __restrict__ proj, int row0, int hd, int dir, int tid) {
#pragma unroll
    for (int i = 0; i < 2; ++i) { const bf16_t* p = proj + (size_t)(row0 + (tid >> 4) + 32 * i) * NIN + hd * 128 + (tid & 15) * 8;
        r.z[i] = *(const u32x4*)(p + (dir == 0 ? 1536 : 2048)); r.v[i] = *(const u32x4*)(p + 2560); if (FULL) r.q[i] = *(const u32x4*)(p + 1024); }
}
template <bool FULL>
__device__ __forceinline__ void hg_store_raw(LAS unsigned char* lds, const HgRaw& r, int tid) {
#pragma unroll
    for (int i = 0; i < 2; ++i) { const int off = ((tid >> 4) + 32 * i) * 256 + (tid & 15) * 16;
        *(LAS u32x4*)(lds + HG_RAWZ + off) = r.z[i]; *(LAS u32x4*)(lds + HG_RAWV + off) = r.v[i]; if (FULL) *(LAS u32x4*)(lds + HG_RAWQ + off) = r.q[i]; }
}

template <int DIR, bool FULL>
__device__ __forceinline__ void hg_chunk(LAS unsigned char* lds, f32x4 (&accS)[8], f32x4 (&o)[4], float lbv, float& dseg, int tid, int wave, int lane) {
    const int kc = tid & 127, tq = tid >> 7, fr = lane & 15, fq = lane >> 4;
    float Gc[16];
    float qt = 0.f;
#pragma unroll
    for (int i = 0; i < 16; ++i) { const float z = bf2f(*(const LAS bf16_t*)(lds + HG_RAWZ + (16 * tq + i) * 256 + kc * 2));
        const float f = lbv + (1.0f - lbv) * sigmoidf_(z); Gc[i] = __logf(f); qt += Gc[i]; }
    *(LAS float*)(lds + HG_QSUM + (tq * 128 + kc) * 4) = qt;
    lds_barrier();
    float offs = 0.f, gtot = 0.f;
#pragma unroll
    for (int q4 = 0; q4 < 4; ++q4) { const float v = *(const LAS float*)(lds + HG_QSUM + (q4 * 128 + kc) * 4); gtot += v; if (DIR == 0 ? (q4 < tq) : (q4 > tq)) offs += v; }
    if (DIR == 0) { float c = offs;
#pragma unroll
        for (int i = 0; i < 16; ++i) { c += Gc[i]; Gc[i] = c; } }
    else { float c = offs;
#pragma unroll
        for (int i = 15; i >= 0; --i) { c += Gc[i]; Gc[i] = c; } }
    {
#pragma unroll
        for (int h2 = 0; h2 < 2; ++h2) {
            unsigned kh[4], vt[4];
#pragma unroll
            for (int i2 = 0; i2 < 4; ++i2) { const int i = 4 * h2 + i2;
                const float z0 = bf2f(*(const LAS bf16_t*)(lds + HG_RAWZ + (16 * tq + 2 * i) * 256 + kc * 2)), z1 = bf2f(*(const LAS bf16_t*)(lds + HG_RAWZ + (16 * tq + 2 * i + 1) * 256 + kc * 2));
                const float k0 = (1.0f - lbv) * (1.0f - sigmoidf_(z0)), k1 = (1.0f - lbv) * (1.0f - sigmoidf_(z1));
                kh[i2] = cvt2(k0 * __expf(gtot - Gc[2 * i]), k1 * __expf(gtot - Gc[2 * i + 1]));
                const unsigned v0 = *(const LAS bf16_t*)(lds + HG_RAWV + (16 * tq + 2 * i) * 256 + kc * 2), v1 = *(const LAS bf16_t*)(lds + HG_RAWV + (16 * tq + 2 * i + 1) * 256 + kc * 2);
                vt[i2] = v0 | (v1 << 16);
                if (FULL) {
                    const float q0 = bf2f(*(const LAS bf16_t*)(lds + HG_RAWQ + (16 * tq + 2 * i) * 256 + kc * 2)), q1 = bf2f(*(const LAS bf16_t*)(lds + HG_RAWQ + (16 * tq + 2 * i + 1) * 256 + kc * 2));
                    *(LAS bf16_t*)(lds + HG_QT + (16 * tq + 2 * i) * QS + kc * 2) = f2bf(q0 * __expf(Gc[2 * i]));
                    *(LAS bf16_t*)(lds + HG_QT + (16 * tq + 2 * i + 1) * QS + kc * 2) = f2bf(q1 * __expf(Gc[2 * i + 1]));
                    *(LAS bf16_t*)(lds + HG_KT + (16 * tq + 2 * i) * QS + kc * 2) = f2bf(k0 * __expf(-Gc[2 * i]));
                    *(LAS bf16_t*)(lds + HG_KT + (16 * tq + 2 * i + 1) * QS + kc * 2) = f2bf(k1 * __expf(-Gc[2 * i + 1]));
                }
            }
            *(LAS u32x4*)(lds + HG_KHT + kc * TS + tq * 32 + 16 * h2) = (u32x4){kh[0], kh[1], kh[2], kh[3]};
            *(LAS u32x4*)(lds + HG_VT + kc * TS + tq * 32 + 16 * h2) = (u32x4){vt[0], vt[1], vt[2], vt[3]};
        }
        if (tq == 0) { const float dc = __expf(gtot); *(LAS float*)(lds + HG_DS + kc * 4) = dc; dseg *= dc; }
    }
    lds_barrier();
    if (FULL) {
#pragma unroll
        for (int tt = 0; tt < 2; ++tt) {
            const int tl = 2 * wave + tt, ti = tl >> 2, si = tl & 3;
            f32x4 accA = (f32x4){0.f, 0.f, 0.f, 0.f};
#pragma unroll
            for (int ks = 0; ks < 4; ++ks) {
                const bf16x8 af = *(const LAS bf16x8*)(lds + HG_QT + (16 * ti + fr) * QS + (ks * 32 + fq * 8) * 2);
                const bf16x8 bf = *(const LAS bf16x8*)(lds + HG_KT + (16 * si + fr) * QS + (ks * 32 + fq * 8) * 2);
                accA = __builtin_amdgcn_mfma_f32_16x16x32_bf16(af, bf, accA, 0, 0, 0);
            }
#pragma unroll
            for (int j = 0; j < 4; ++j) { const int t = 16 * ti + 4 * fq + j, s = 16 * si + fr;
                const bool keep = DIR == 0 ? (s <= t) : (s >= t);
                *(LAS bf16_t*)(lds + HG_AM + t * TS + s * 2) = f2bf(keep ? accA[j] : 0.f); }
        }
        lds_barrier();
#pragma unroll
        for (int m = 0; m < 4; ++m) o[m] = (f32x4){0.f, 0.f, 0.f, 0.f};
#pragma unroll
        for (int ks = 0; ks < 4; ++ks) {
            const u32x4 sw = (u32x4){cvt2(accS[2 * ks][0], accS[2 * ks][1]), cvt2(accS[2 * ks][2], accS[2 * ks][3]), cvt2(accS[2 * ks + 1][0], accS[2 * ks + 1][1]), cvt2(accS[2 * ks + 1][2], accS[2 * ks + 1][3])};
            const bf16x8 sf = mk_bf16x8(sw);
#pragma unroll
            for (int m = 0; m < 4; ++m) {
                const u32x2 qlo = *(const LAS u32x2*)(lds + HG_QT + (16 * m + fr) * QS + (32 * ks + 4 * fq) * 2), qhi = *(const LAS u32x2*)(lds + HG_QT + (16 * m + fr) * QS + (32 * ks + 16 + 4 * fq) * 2);
                const bf16x8 qf = mk_bf16x8((u32x4){qlo.x, qlo.y, qhi.x, qhi.y});
                o[m] = __builtin_amdgcn_mfma_f32_16x16x32_bf16(qf, sf, o[m], 0, 0, 0);
            }
        }
#pragma unroll
        for (int ks = 0; ks < 2; ++ks) {
            const bf16x8 vf = *(const LAS bf16x8*)(lds + HG_VT + (16 * wave + fr) * TS + (ks * 32 + fq * 8) * 2);
#pragma unroll
            for (int m = 0; m < 4; ++m) { const bf16x8 af = *(const LAS bf16x8*)(lds + HG_AM + (16 * m + fr) * TS + (ks * 32 + fq * 8) * 2);
                o[m] = __builtin_amdgcn_mfma_f32_16x16x32_bf16(af, vf, o[m], 0, 0, 0); }
        }
    }
#pragma unroll
    for (int i = 0; i < 8; ++i) { const f32x4 dv = *(const LAS f32x4*)(lds + HG_DS + (16 * i + 4 * fq) * 4); accS[i] = accS[i] * dv; }
#pragma unroll
    for (int ks = 0; ks < 2; ++ks) {
        const bf16x8 vf = *(const LAS bf16x8*)(lds + HG_VT + (16 * wave + fr) * TS + (ks * 32 + fq * 8) * 2);
#pragma unroll
        for (int i = 0; i < 8; ++i) { const bf16x8 af = *(const LAS bf16x8*)(lds + HG_KHT + (16 * i + fr) * TS + (ks * 32 + fq * 8) * 2);
            accS[i] = __builtin_amdgcn_mfma_f32_16x16x32_bf16(af, vf, accS[i], 0, 0, 0); }
    }
}

__device__ __forceinline__ float hg_lb(const float* __restrict__ lb_logits, int dir, int col) {
    const float l0 = lb_logits[(0 * 2 + dir) * 512 + col], l1 = lb_logits[(1 * 2 + dir) * 512 + col];
    return 1.0f / (1.0f + expf(l1 - l0));
}

template <int DIR>
__device__ __forceinline__ void hg_agg_unit(LAS unsigned char* lds, const Args& a, int b, int hd, int sidx, int unit, int tid, int wave, int lane) {
    const bf16_t* __restrict__ proj = (const bf16_t*)(a.ws + WS_PROJ);
    const int rowbase = sidx == 0 ? T + b * LC : b * SEQ + (sidx - 1) * 256;
    const float lbv = hg_lb(a.in[12], DIR, hd * 128 + (tid & 127));
    f32x4 accS[8], odummy[4];
#pragma unroll
    for (int i = 0; i < 8; ++i) accS[i] = (f32x4){0.f, 0.f, 0.f, 0.f};
    float dseg = 1.f;
    HgRaw raw;
    hg_load_raw<false>(raw, proj, rowbase + (DIR == 0 ? 0 : 3) * 64, hd, DIR, tid);
    lds_barrier();
    hg_store_raw<false>(lds, raw, tid);
    lds_barrier();
#pragma unroll 1
    for (int cc = 0; cc < 4; ++cc) {
        if (cc < 3) hg_load_raw<false>(raw, proj, rowbase + (DIR == 0 ? cc + 1 : 2 - cc) * 64, hd, DIR, tid);
        hg_chunk<DIR, false>(lds, accS, odummy, lbv, dseg, tid, wave, lane);
        lds_barrier();
        if (cc < 3) { hg_store_raw<false>(lds, raw, tid); lds_barrier(); }
    }
    float* K = (float*)(a.ws + WS_HGK) + (size_t)unit * 16384;
    const int fr = lane & 15, fq = lane >> 4;
#pragma unroll
    for (int i = 0; i < 8; ++i)
#pragma unroll
        for (int j = 0; j < 4; ++j) K[(16 * i + 4 * fq + j) * 128 + 16 * wave + fr] = accS[i][j];
    if (tid < 128) ((float*)(a.ws + WS_HGD))[(size_t)unit * 128 + tid] = dseg;
}

__device__ __forceinline__ void hg_carry_item(const Args& a, int item, int tid) {
    const int chain = item >> 3, part = item & 7, dir = chain & 1;
    float* K = (float*)(a.ws + WS_HGK) + (size_t)chain * HG_SEGS * 16384; const float* D = (const float*)(a.ws + WS_HGD) + (size_t)chain * HG_SEGS * 128;
    const int e4 = part * 512 + tid, dk = e4 >> 5;
    f32x4 kv[HG_SEGS]; float dv[HG_SEGS];
#pragma unroll
    for (int s = 0; s < HG_SEGS; ++s) { const int sidx = s == 0 ? 0 : (dir == 0 ? s : HG_SEGS - s); kv[s] = *(const f32x4*)(K + (size_t)sidx * 16384 + e4 * 4); dv[s] = D[sidx * 128 + dk]; }
    f32x4 S = (f32x4){0.f, 0.f, 0.f, 0.f};
#pragma unroll
    for (int s = 0; s < HG_SEGS; ++s) { const int sidx = s == 0 ? 0 : (dir == 0 ? s : HG_SEGS - s); *(f32x4*)(K + (size_t)sidx * 16384 + e4 * 4) = S; S = S * dv[s] + kv[s]; }
}

__device__ __forceinline__ void hg_final_unit(LAS unsigned char* lds, const Args& a, int b, int hd, int seg, int tid, int wave, int lane) {
    const bf16_t* __restrict__ proj = (const bf16_t*)(a.ws + WS_PROJ); bf16_t* mixed = (bf16_t*)(a.ws + WS_MIXED);
    const int rowbase = b * SEQ + seg * 256, fr = lane & 15, fq = lane >> 4;
    const float lbf = hg_lb(a.in[12], 0, hd * 128 + (tid & 127)), lbb = hg_lb(a.in[12], 1, hd * 128 + (tid & 127));
    const float ng = a.in[13][hd * 128 + 16 * wave + fr];
    f32x4 accS[8], o[4];
    float dseg = 1.f;
    HgRaw raw;
    f32x4* ofst = (f32x4*)(a.ws + WS_OFST) + (size_t)blockIdx.x * 8192 + wave * 256 + lane;
    {
        const float* Sin = (const float*)(a.ws + WS_HGK) + (size_t)((((b * 4 + hd) * 2 + 0) * HG_SEGS) + 1 + seg) * 16384;
#pragma unroll
        for (int i = 0; i < 8; ++i)
#pragma unroll
            for (int j = 0; j < 4; ++j) accS[i][j] = Sin[(16 * i + 4 * fq + j) * 128 + 16 * wave + fr];
    }
    hg_load_raw<true>(raw, proj, rowbase, hd, 0, tid);
    lds_barrier();
    hg_store_raw<true>(lds, raw, tid);
    lds_barrier();
#pragma unroll 1
    for (int cc = 0; cc < 4; ++cc) {
        if (cc < 3) hg_load_raw<true>(raw, proj, rowbase + (cc + 1) * 64, hd, 0, tid); else hg_load_raw<true>(raw, proj, rowbase + 3 * 64, hd, 1, tid);
        hg_chunk<0, true>(lds, accS, o, lbf, dseg, tid, wave, lane);
#pragma unroll
        for (int m = 0; m < 4; ++m) ofst[cc * 2048 + m * 64] = o[m];
        lds_barrier();
        hg_store_raw<true>(lds, raw, tid);
        lds_barrier();
    }
    {
        const float* Sin = (const float*)(a.ws + WS_HGK) + (size_t)((((b * 4 + hd) * 2 + 1) * HG_SEGS) + 1 + seg) * 16384;
#pragma unroll
        for (int i = 0; i < 8; ++i)
#pragma unroll
            for (int j = 0; j < 4; ++j) accS[i][j] = Sin[(16 * i + 4 * fq + j) * 128 + 16 * wave + fr];
    }
#pragma unroll 1
    for (int cc = 0; cc < 4; ++cc) {
        const int c = 3 - cc;
        if (cc < 3) hg_load_raw<true>(raw, proj, rowbase + (c - 1) * 64, hd, 1, tid);
        hg_chunk<1, true>(lds, accS, o, lbb, dseg, tid, wave, lane);
        float gate[4][4];
#pragma unroll
        for (int m = 0; m < 4; ++m) { o[m] = o[m] + ofst[c * 2048 + m * 64];
#pragma unroll
            for (int j = 0; j < 4; ++j) { float s = o[m][j] * o[m][j];
                s += __shfl_xor(s, 1); s += __shfl_xor(s, 2); s += __shfl_xor(s, 4); s += __shfl_xor(s, 8);
                if (fr == 0) *(LAS float*)(lds + HG_PART + ((16 * m + 4 * fq + j) * 8 + wave) * 4) = s;
                gate[m][j] = bf2f(proj[(size_t)(rowbase + c * 64 + 16 * m + 4 * fq + j) * NIN + 3072 + hd * 128 + 16 * wave + fr]); } }
        lds_barrier();
#pragma unroll
        for (int m = 0; m < 4; ++m)
#pragma unroll
            for (int j = 0; j < 4; ++j) { const int t = 16 * m + 4 * fq + j;
                const f32x4 p0 = *(const LAS f32x4*)(lds + HG_PART + t * 32), p1 = *(const LAS f32x4*)(lds + HG_PART + t * 32 + 16);
                const float ms = ((p0[0] + p0[1]) + (p0[2] + p0[3]) + (p1[0] + p1[1]) + (p1[2] + p1[3])) * (1.0f / 128.0f);
                *(LAS bf16_t*)(lds + HG_OST + t * QS + (16 * wave + fr) * 2) = f2bf(o[m][j] * rsqrtf(ms + LN_EPS) * ng * gate[m][j]); }
        lds_barrier();
#pragma unroll
        for (int i = 0; i < 2; ++i) { const int t = (tid >> 4) + 32 * i, c8 = (tid & 15) * 8;
            *(u32x4*)(mixed + (size_t)(rowbase + c * 64 + t) * DM + 512 + hd * 128 + c8) = *(const LAS u32x4*)(lds + HG_OST + t * QS + c8 * 2); }
        lds_barrier();
        if (cc < 3) { hg_store_raw<true>(lds, raw, tid); lds_barrier(); }
    }
}

__device__ __forceinline__ void p_scan_a(LAS unsigned char* lds, const Args& a, int bid, int G, int tid, int wave, int lane) {
    constexpr int N_HG = NB * 4 * 2 * HG_SEGS, N_RG = NB * RG_UNITS_PER_B;
#pragma unroll 1
    for (int it = bid; it < N_HG + N_RG; it += G) {
        int t2 = tid; asm volatile("" : "+v"(t2)); const int tid = t2, lane = t2 & 63;
        if (it < N_HG) { const int sidx = it % HG_SEGS, rest = it / HG_SEGS, dir = rest & 1, hd = (rest >> 1) & 3, b = rest >> 3;
            if (dir == 0) hg_agg_unit<0>(lds, a, b, hd, sidx, it, tid, wave, lane); else hg_agg_unit<1>(lds, a, b, hd, sidx, it, tid, wave, lane); }
        else { const int r = it - N_HG; __syncthreads(); rg_unit<0>(lds, a, r / RG_UNITS_PER_B, r % RG_UNITS_PER_B, tid, wave, lane); }
    }
}
__device__ __forceinline__ void p_scan_b(const Args& a, int bid, int G, int tid) {
    for (int it = bid; it < 1024 + 32; it += G) { if (it < 1024) hg_carry_item(a, it, tid); else rg_carry_item(a, it - 1024, tid); }
}
__device__ __forceinline__ void p_scan_c(LAS unsigned char* lds, const Args& a, int bid, int G, int tid, int wave, int lane) {
#pragma unroll 1
    for (int it = bid; it < 1024; it += G) { const int seg = it & 15, hd = (it >> 4) & 3, b = it >> 6; int t2 = tid; asm volatile("" : "+v"(t2)); hg_final_unit(lds, a, b, hd, seg, t2, wave, t2 & 63); }
#pragma unroll 1
    for (int r = bid; r < 1024; r += G) { __syncthreads(); int t2 = tid; asm volatile("" : "+v"(t2)); rg_unit<1>(lds, a, r >> 6, 4 + (r & 63), t2, wave, t2 & 63); }
}

__global__ void __launch_bounds__(NTHREADS, 2) mega(Args a) {
    extern __shared__ __attribute__((aligned(16))) unsigned char lds_raw[];
    LAS unsigned char* lds = (LAS unsigned char*)lds_raw;
    cg::grid_group grid = cg::this_grid();
    const int tid = threadIdx.x, lane = tid & 63, wave = __builtin_amdgcn_readfirstlane(tid >> 6), bid = blockIdx.x, G = gridDim.x;
    unsigned char* ws = a.ws;
    float* mod = (float*)(ws + WS_MOD);
    bf16_t* U = (bf16_t*)(ws + WS_U);
    bf16_t* PROJ = (bf16_t*)(ws + WS_PROJ); bf16_t* MIXED = (bf16_t*)(ws + WS_MIXED);

#ifndef SKIP_P0
    p_mod(lds, a.in[1], a.in[3], a.in[4], a.in[5], mod, bid, G, tid);
    p_transposes(lds, a, bid, G, tid);
    p_gwt(a.in[9], (bf16_t*)(ws + WS_GWT), bid, G, tid);
#endif
#ifdef REP_P0
    grid.sync();
    p_mod(lds, a.in[1], a.in[3], a.in[4], a.in[5], mod, bid, G, tid);
    p_transposes(lds, a, bid, G, tid);
    p_gwt(a.in[9], (bf16_t*)(ws + WS_GWT), bid, G, tid);
#endif
    grid.sync();
#ifdef REP_SYNC
    for (int r = 0; r < 10; ++r) grid.sync();
#endif
#ifndef SKIP_P1
    p_u(a.in[0], a.in[2], mod, U, bid, G, tid);
#endif
#ifdef REP_P1
    grid.sync();
    p_u(a.in[0], a.in[2], mod, U, bid, G, tid);
#endif
    grid.sync();
#ifndef SKIP_P2
    { pg8::Gemm g{U, (const bf16_t*)(ws + WS_WINT), TA, NIN, DM}; pg8::StaticOrder S; S.init(TA, NIN, G, bid);
      pg8::EpiInProj E{PROJ};
      pg8::gemm_phase<pg8::EpiInProj, pg8::StaticOrder, true, true>(lds, g, S, E); }
#endif
#ifdef REP_P2
    grid.sync();
    { pg8::Gemm g{U, (const bf16_t*)(ws + WS_WINT), TA, NIN, DM}; pg8::StaticOrder S; S.init(TA, NIN, G, bid);
      pg8::EpiInProj E{PROJ};
      pg8::gemm_phase<pg8::EpiInProj, pg8::StaticOrder, true, true>(lds, g, S, E); }
#endif
    grid.sync();
#ifndef SKIP_P3A
    p_scan_a(lds, a, bid, G, tid, wave, lane);
#endif
#ifdef REP_P3A
    grid.sync();
    p_scan_a(lds, a, bid, G, tid, wave, lane);
#endif
    grid.sync();
#ifndef SKIP_P3B
    p_scan_b(a, bid, G, tid);
#endif
    grid.sync();
#ifndef SKIP_P3C
    p_scan_c(lds, a, bid, G, tid, wave, lane);
#endif
#ifdef REP_P3C
    grid.sync();
    p_scan_c(lds, a, bid, G, tid, wave, lane);
#endif
    grid.sync();
#ifndef SKIP_P5
    { pg8::Gemm g{MIXED, (const bf16_t*)(ws + WS_WOUTT), T, DM, DM}; pg8::StaticOrder S; S.init(T, DM, G, bid);
      pg8::EpiF32 E{a.out, DM, 0};
      pg8::gemm_phase<pg8::EpiF32, pg8::StaticOrder, true, true>(lds, g, S, E); }
#endif
#ifdef REP_P5
    grid.sync();
    { pg8::Gemm g{MIXED, (const bf16_t*)(ws + WS_WOUTT), T, DM, DM}; pg8::StaticOrder S; S.init(T, DM, G, bid);
      pg8::EpiF32 E{a.out, DM, 0};
      pg8::gemm_phase<pg8::EpiF32, pg8::StaticOrder, true, true>(lds, g, S, E); }
#endif
    grid.sync();
#ifndef SKIP_P6
    p_ln1_router(lds, a, bid, G, tid, wave, lane);
#endif
    grid.sync();
#ifndef SKIP_P7
    p_gather(a, bid, G, wave, lane);
#endif
#ifdef REP_P7
    grid.sync();
    p_gather(a, bid, G, wave, lane);
#endif
    grid.sync();
#ifndef SKIP_P8
    { pg8::Gemm g{(const bf16_t*)(ws + WS_XG), (const bf16_t*)(ws + WS_W13T), MAXROWS, NE * DM, DM}; pg8::ExpertOrder S{(const int*)(ws + WS_CTL), G, bid};
      pg8::EpiExp1 E{(bf16_t*)(ws + WS_HID)};
      pg8::gemm_phase<pg8::EpiExp1, pg8::ExpertOrder, true, true>(lds, g, S, E); }
#endif
#ifdef REP_P8
    grid.sync();
    { pg8::Gemm g{(const bf16_t*)(ws + WS_XG), (const bf16_t*)(ws + WS_W13T), MAXROWS, NE * DM, DM}; pg8::ExpertOrder S{(const int*)(ws + WS_CTL), G, bid};
      pg8::EpiExp1 E{(bf16_t*)(ws + WS_HID)};
      pg8::gemm_phase<pg8::EpiExp1, pg8::ExpertOrder, true, true>(lds, g, S, E); }
#endif
    grid.sync();
#ifndef SKIP_P9
    { pg8::Gemm g{(const bf16_t*)(ws + WS_HID), (const bf16_t*)(ws + WS_W2T), MAXROWS, NE * DM, DE}; pg8::ExpertOrder S{(const int*)(ws + WS_CTL), G, bid};
      pg8::EpiY E{(bf16_t*)(ws + WS_Y)};
      pg8::gemm_phase<pg8::EpiY, pg8::ExpertOrder, true, true>(lds, g, S, E); }
#endif
#ifdef REP_P9
    grid.sync();
    { pg8::Gemm g{(const bf16_t*)(ws + WS_HID), (const bf16_t*)(ws + WS_W2T), MAXROWS, NE * DM, DE}; pg8::ExpertOrder S{(const int*)(ws + WS_CTL), G, bid};
      pg8::EpiY E{(bf16_t*)(ws + WS_Y)};
      pg8::gemm_phase<pg8::EpiY, pg8::ExpertOrder, true, true>(lds, g, S, E); }
#endif
    grid.sync();
#ifndef SKIP_P10
    p_combine_ln2(a, bid, G, wave, lane);
#endif
}

extern "C" void kernel_launch(void* const* d_in, const int* in_sizes, int n_in, void* d_out, int out_size, void* d_ws, size_t ws_size, hipStream_t stream) {
    static int grid = 0;
    if (grid == 0) {
        if (n_in != 26 || ws_size < WS_END) { fprintf(stderr, "kernel_launch: unexpected n_in %d or workspace %zu < %zu\n", n_in, ws_size, (size_t)WS_END); grid = -1; return; }
        int dev = 0, cus = 0, per_cu = 0;
        if (hipGetDevice(&dev) != hipSuccess || hipDeviceGetAttribute(&cus, hipDeviceAttributeMultiprocessorCount, dev) != hipSuccess) { grid = -1; return; }
        if (hipFuncSetAttribute((const void*)mega, hipFuncAttributeMaxDynamicSharedMemorySize, LDS_BYTES) != hipSuccess) { fprintf(stderr, "kernel_launch: hipFuncSetAttribute failed\n"); grid = -1; return; }
        if (hipOccupancyMaxActiveBlocksPerMultiprocessor(&per_cu, (const void*)mega, NTHREADS, LDS_BYTES) != hipSuccess || per_cu < 1) { fprintf(stderr, "kernel_launch: occupancy query says %d\n", per_cu); per_cu = 1; }
        (void)hipGetLastError();
        grid = cus;
        fprintf(stderr, "kernel_launch: grid %d (cus %d, per_cu %d), ws %zu\n", grid, cus, per_cu, ws_size);
    }
    if (grid < 0) return;
    (void)hipMemsetAsync(d_ws, 0, 4096, stream);
    Args a{};
    for (int i = 0; i < 26; ++i) a.in[i] = (const float*)d_in[i];
    a.out = (float*)d_out; a.ws = (unsigned char*)d_ws;
    void* params[] = {&a};
    hipError_t e = hipLaunchCooperativeKernel((const void*)mega, dim3(grid), dim3(NTHREADS), params, LDS_BYTES, stream);
    if (e != hipSuccess) fprintf(stderr, "kernel_launch: cooperative launch failed: %s (grid %d)\n", hipGetErrorString(e), grid);
}
```

```cpp
#include <hip/hip_runtime.h>
#include <hip/hip_cooperative_groups.h>
#include <cstdio>
#include <cstdint>
namespace cg = cooperative_groups;

typedef unsigned short bf16_t;
typedef short bf16x8 __attribute__((ext_vector_type(8)));
typedef float f32x4 __attribute__((ext_vector_type(4)));
typedef float f32x2 __attribute__((ext_vector_type(2)));
typedef unsigned u32x4 __attribute__((ext_vector_type(4)));
typedef unsigned u32x2 __attribute__((ext_vector_type(2)));
typedef int i32x4 __attribute__((ext_vector_type(4)));
#define LAS __attribute__((address_space(3)))

constexpr int NB = 16, SEQ = 4096, LC = 256, DM = 1024;
constexpr int T = NB * SEQ;
constexpr int TC = NB * LC;
constexpr int TA = T + TC;
constexpr int NIN = 3584;
constexpr int NE = 32, DE = 512;
constexpr int MAXROWS = 2 * T + NE * 256;
constexpr float ALPHA = 1.189207115002721f;
constexpr float LN_EPS = 1e-6f;
constexpr int NTHREADS = 512;

constexpr size_t MiB = 1u << 20;
constexpr size_t WS_CTL = 0;
constexpr size_t WS_MOD = 1 * MiB;
constexpr size_t WS_EIDX = 3 * MiB;
constexpr size_t WS_EPOS = 3 * MiB + 512 * 1024;
constexpr size_t WS_EW = 4 * MiB;
constexpr size_t WS_DEST = 4 * MiB + 512 * 1024;
constexpr size_t WS_WINT = 6 * MiB;
constexpr size_t WS_WOUTT = 13 * MiB;
constexpr size_t WS_W13T = 15 * MiB;
constexpr size_t WS_W2T = 79 * MiB;
constexpr size_t WS_U = 112 * MiB;
constexpr size_t WS_PROJ = 248 * MiB;
constexpr size_t WS_XG = 248 * MiB;
constexpr size_t WS_HID = 520 * MiB;
constexpr size_t WS_Y = 656 * MiB;
constexpr size_t WS_MIXED = 724 * MiB;
constexpr size_t WS_OSUM = 852 * MiB;
constexpr size_t WS_END = 980 * MiB;
constexpr int LDS_BYTES = 163840;

__device__ __forceinline__ float bf2f(bf16_t b) { return __uint_as_float(((unsigned)b) << 16); }
__device__ __forceinline__ bf16_t f2bf(float f) { unsigned u = __float_as_uint(f); return (bf16_t)((u + 0x7fffu + ((u >> 16) & 1u)) >> 16); }
__device__ __forceinline__ unsigned pk2(float lo, float hi) { return (unsigned)f2bf(lo) | ((unsigned)f2bf(hi) << 16); }
__device__ __forceinline__ float frcp(float x) { return __builtin_amdgcn_rcpf(x); }
__device__ __forceinline__ float sigmoidf_(float x) { return frcp(1.0f + __expf(-x)); }
__device__ __forceinline__ float siluf_(float x) { return x * frcp(1.0f + __expf(-x)); }
__device__ __forceinline__ float gelu_tanh(float x) {
    const float y = 0.7978845608028654f * (x + 0.044715f * x * x * x);
    return x * frcp(1.0f + __expf(-2.0f * y));
}
__device__ __forceinline__ float softplusf_(float x) { return fmaxf(x, 0.f) + log1pf(expf(-fabsf(x))); }
__device__ __forceinline__ float wave_sum(float v) {
#pragma unroll
    for (int o = 1; o < 64; o <<= 1) v += __shfl_xor(v, o);
    return v;
}
constexpr int CSTR = 64;
__device__ __forceinline__ int pstart_of(const int* __restrict__ counts, int e) {
    int acc = 0;
    for (int i = 0; i < NE; ++i) { const int p = ((counts[i * CSTR] + 255) >> 8) << 8; if (i < e) acc += p; }
    return acc;
}

namespace pg8 {
#define PG8_LAS __attribute__((address_space(3)))
typedef unsigned short bf16_t;
typedef short bf16x8 __attribute__((ext_vector_type(8)));
typedef float f32x4 __attribute__((ext_vector_type(4)));
typedef unsigned u32x4 __attribute__((ext_vector_type(4)));
constexpr int BM = 256, BK = 64, HALF = 128, HTB = HALF * BK * 2  , STAGE_BYTES = 8 * HTB, NXCD = 8, WGM = 8;

__host__ __device__ __forceinline__ int lds_byte(int r, int c) { const int st = (r >> 4) * 2 + (c >> 5), rr = r & 15, cc = c & 31, ob = rr * 64 + cc * 2; return st * 1024 + (ob ^ (((ob >> 9) & 1) << 5)); }
__host__ __device__ __forceinline__ void stage_rc(int b, int& R, int& C) { const int st = b / 1024, sb = b % 1024, swz = sb ^ (((sb >> 9) & 1) << 5); R = (st >> 1) * 16 + swz / 64; C = (st & 1) * 32 + (swz % 64) / 2; }
__host__ __device__ __forceinline__ int perm32(int rho) { const int n = rho >> 4, i = rho & 15; return 8 * (i >> 2) + 4 * n + (i & 3); }

struct Unit { int pm, pn; };
struct Gemm { const bf16_t* A; const bf16_t* Bt; int M, N, K; };

struct StaticOrder {
    int nM, nN, nwg, G, c;
    __host__ __device__ void init(int M, int N, int G_, int c_) { nM = M / BM; nN = N / BM; nwg = nM * nN; G = G_; c = c_; }
    __host__ __device__ bool next(int i, Unit& u) const {
        const long L = (long)i * G + c; if (L >= nwg) return false;
        int wgid = (int)L; { const int q = nwg / NXCD, r = nwg % NXCD, xcd = wgid % NXCD, off = wgid / NXCD; wgid = (xcd < r ? xcd * (q + 1) : r * (q + 1) + (xcd - r) * q) + off; }
        const int nig = WGM * nN, gid = wgid / nig, fm = gid * WGM, gsz = (nM - fm) < WGM ? (nM - fm) : WGM;
        u.pm = fm + ((wgid % nig) % gsz); u.pn = (wgid % nig) / gsz; return true;
    }
    __device__ __forceinline__ void a_ready(const Unit&) const {}
    __device__ __forceinline__ void done(const Unit&) const {}
};

__device__ __forceinline__ unsigned cvt_pk_bf16(float lo, float hi) { unsigned r; asm volatile("v_cvt_pk_bf16_f32 %0, %1, %2" : "=v"(r) : "v"(lo), "v"(hi)); return r; }

struct EpiInProj {
    static constexpr bool PERM = true, AFTER_DRAIN = false;
    bf16_t* P;
    __device__ __forceinline__ void operator()(const f32x4 (&acc)[2][2][4][2], const Unit& u, int wr, int wc, int fr_, int fq_) const {
        int fr = fr_, fq = fq_; asm volatile("" : "+v"(fr), "+v"(fq));
        const int row0 = u.pm * BM + wr * 64 + fr, col0 = u.pn * BM + wc * 32 + 8 * fq, grp = u.pn >> 1;
#pragma unroll
        for (int ai = 0; ai < 2; ++ai)
#pragma unroll
            for (int m = 0; m < 4; ++m) { bf16_t* rowp = P + (size_t)(row0 + ai * HALF + m * 16) * NIN + col0;
#pragma unroll
                for (int bj = 0; bj < 2; ++bj) { f32x4 v0 = acc[ai][bj][m][0], v1 = acc[ai][bj][m][1];
                    if (grp == 1) {
#pragma unroll
                        for (int j = 0; j < 4; ++j) { v0[j] = gelu_tanh(v0[j]); v1[j] = gelu_tanh(v1[j]); } }
                    else if (grp == 2 || grp == 6) {
#pragma unroll
                        for (int j = 0; j < 4; ++j) { v0[j] = siluf_(v0[j]); v1[j] = siluf_(v1[j]); } }
                    u32x4 w; w.x = cvt_pk_bf16(v0[0], v0[1]); w.y = cvt_pk_bf16(v0[2], v0[3]); w.z = cvt_pk_bf16(v1[0], v1[1]); w.w = cvt_pk_bf16(v1[2], v1[3]);
                    *(u32x4*)(rowp + bj * HALF) = w; } }
    }
};
struct EpiF32 {
    static constexpr bool PERM = false, AFTER_DRAIN = false;
    float* C; int ldc; int pad;
    __device__ __forceinline__ void operator()(const f32x4 (&acc)[2][2][4][2], const Unit& u, int wr, int wc, int fr_, int fq_) const {
        int fr = fr_, fq = fq_; asm volatile("" : "+v"(fr), "+v"(fq));
        const int row0 = u.pm * BM + wr * 64 + fr, col0 = u.pn * BM + wc * 32 + 4 * fq;
#pragma unroll
        for (int ai = 0; ai < 2; ++ai)
#pragma unroll
            for (int m = 0; m < 4; ++m) { float* rowp = C + (size_t)(row0 + ai * HALF + m * 16) * ldc + col0;
#pragma unroll
                for (int bj = 0; bj < 2; ++bj)
#pragma unroll
                    for (int n = 0; n < 2; ++n) *(f32x4*)(rowp + bj * HALF + n * 16) = acc[ai][bj][m][n]; }
    }
};
struct EpiExp1 {
    static constexpr bool PERM = false, AFTER_DRAIN = false;
    bf16_t* H;
    __device__ __forceinline__ void operator()(const f32x4 (&acc)[2][2][4][2], const Unit& u, int wr, int wc, int fr_, int fq_) const {
        int fr = fr_, fq = fq_; asm volatile("" : "+v"(fr), "+v"(fq));
        const int row0 = u.pm * BM + wr * 64 + fr, hc0 = (((u.pn & 3) * BM + wc * 32) >> 1) + 4 * fq;
#pragma unroll
        for (int ai = 0; ai < 2; ++ai)
#pragma unroll
            for (int m = 0; m < 4; ++m) { bf16_t* rowp = H + (size_t)(row0 + ai * HALF + m * 16) * DE + hc0;
#pragma unroll
                for (int bj = 0; bj < 2; ++bj) { const f32x4 a = acc[ai][bj][m][0], b = acc[ai][bj][m][1];
                    u32x2 w; w.x = cvt_pk_bf16(siluf_(a[0]) * b[0], siluf_(a[1]) * b[1]); w.y = cvt_pk_bf16(siluf_(a[2]) * b[2], siluf_(a[3]) * b[3]);
                    *(u32x2*)(rowp + bj * 64) = w; } }
    }
};
struct EpiY {
    static constexpr bool PERM = true, AFTER_DRAIN = false;
    bf16_t* Y;
    __device__ __forceinline__ void operator()(const f32x4 (&acc)[2][2][4][2], const Unit& u, int wr, int wc, int fr_, int fq_) const {
        int fr = fr_, fq = fq_; asm volatile("" : "+v"(fr), "+v"(fq));
        const int row0 = u.pm * BM + wr * 64 + fr, col0 = (u.pn & 3) * BM + wc * 32 + 8 * fq;
#pragma unroll
        for (int ai = 0; ai < 2; ++ai)
#pragma unroll
            for (int m = 0; m < 4; ++m) { bf16_t* rowp = Y + (size_t)(row0 + ai * HALF + m * 16) * DM + col0;
#pragma unroll
                for (int bj = 0; bj < 2; ++bj) { const f32x4 v0 = acc[ai][bj][m][0], v1 = acc[ai][bj][m][1];
                    u32x4 w; w.x = cvt_pk_bf16(v0[0], v0[1]); w.y = cvt_pk_bf16(v0[2], v0[3]); w.z = cvt_pk_bf16(v1[0], v1[1]); w.w = cvt_pk_bf16(v1[2], v1[3]);
                    *(u32x4*)(rowp + bj * HALF) = w; } }
    }
};
struct ExpertOrder {
    const int* counts; int G, c;
    __device__ __forceinline__ bool next(int i, Unit& u) const {
        const int L = i * G + c, rb = L >> 2; int acc = 0, ef = -1;
        for (int e = 0; e < NE; ++e) { const int nb = (counts[e * CSTR] + 255) >> 8; if (rb >= acc && rb < acc + nb) ef = e; acc += nb; }
        if (ef < 0) return false;
        u.pm = rb; u.pn = ef * 4 + (L & 3); return true;
    }
    __device__ __forceinline__ void a_ready(const Unit&) const {}
    __device__ __forceinline__ void done(const Unit&) const {}
};

template <class Epi, class Sched, bool ALIGN_EPI = false, bool SP2 = false>
__device__ __forceinline__ void gemm_phase(PG8_LAS unsigned char* lds, const Gemm g, const Sched& S, const Epi& E) {
    int tid_o = threadIdx.x; asm volatile("" : "+v"(tid_o));
    const int tid = tid_o, wid = __builtin_amdgcn_readfirstlane(tid >> 6), lane = tid & 63, wr = wid >> 2, wc = wid & 3, fr = lane & 15, fq = lane >> 4;
    const int K = g.K, nt = K / BK;
    unsigned voffA[2], voffB[2];
#pragma unroll
    for (int i = 0; i < 2; ++i) { int R, C; stage_rc(tid * 16 + i * 8192, R, C); const int Rb = Epi::PERM ? ((R & ~31) + perm32(R & 31)) : R;
        voffA[i] = (unsigned)(R * K + C) * 2u; voffB[i] = (unsigned)(Rb * K + C) * 2u; }
    const size_t kstep = (size_t)(BK * 2);
    const size_t hstep = (size_t)HALF * K * 2;
    const size_t tstep = 2 * hstep;
    const unsigned ldsw = (unsigned)wid * 1024u;
    const int aoff = lds_byte(wr * 64 + fr, fq * 8), boff = lds_byte(wc * 32 + fr, fq * 8);
#define PG8_SA(b, h) (((b) * 2 + (h)) * HTB)
#define PG8_SB(b, h) ((4 + (b) * 2 + (h)) * HTB)
#define PG8_STAGE(bufoff, gbase, voff) do { _Pragma("unroll") for (int _i = 0; _i < 2; ++_i) \
        __builtin_amdgcn_global_load_lds((const unsigned*)((const char*)(gbase) + (voff)[_i]), (PG8_LAS unsigned*)(lds + (bufoff) + ldsw + _i * 8192), 16, 0, 0); } while (0)
#define PG8_LDA(dst, b, h) do { _Pragma("unroll") for (int m = 0; m < 4; ++m) _Pragma("unroll") for (int k = 0; k < 2; ++k) dst[m][k] = *(const PG8_LAS bf16x8*)(lds + PG8_SA(b, h) + aoff + m * 2048 + k * 1024); } while (0)
#define PG8_LDB(dst, b, h) do { _Pragma("unroll") for (int n = 0; n < 2; ++n) _Pragma("unroll") for (int k = 0; k < 2; ++k) dst[n][k] = *(const PG8_LAS bf16x8*)(lds + PG8_SB(b, h) + boff + n * 2048 + k * 1024); } while (0)
#define PG8_MMA(ai, bj, At, Bt) do { __builtin_amdgcn_s_setprio(1); _Pragma("unroll") for (int m = 0; m < 4; ++m) _Pragma("unroll") for (int n = 0; n < 2; ++n) _Pragma("unroll") for (int k = 0; k < 2; ++k) \
        acc[ai][bj][m][n] = __builtin_amdgcn_mfma_f32_16x16x32_bf16(Bt[n][k], At[m][k], acc[ai][bj][m][n], 0, 0, 0); __builtin_amdgcn_s_setprio(0); } while (0)
#define PG8_WAIT_V(n) asm volatile("s_waitcnt vmcnt(" #n ")" ::: "memory")
#define PG8_WAIT_L(n) asm volatile("s_waitcnt lgkmcnt(" #n ")" ::: "memory")
#define PG8_BAR __builtin_amdgcn_s_barrier()
#define PG8_SCHED __builtin_amdgcn_sched_barrier(0)
    Unit cur, nxt; int ui = 0;
    if (!S.next(0, cur)) return;
    f32x4 acc[2][2][4][2];
#pragma unroll
    for (int a = 0; a < 2; ++a)
#pragma unroll
        for (int b = 0; b < 2; ++b)
#pragma unroll
            for (int m = 0; m < 4; ++m)
#pragma unroll
                for (int n = 0; n < 2; ++n) acc[a][b][m][n] = (f32x4){0.f, 0.f, 0.f, 0.f};
    bf16x8 At[4][2], B0[2][2], B1[2][2];
    const char* cA = (const char*)g.A + (size_t)cur.pm * tstep; const char* cB = (const char*)g.Bt + (size_t)cur.pn * tstep;
    S.a_ready(cur);
    if constexpr (SP2) {
        PG8_STAGE(PG8_SB(0, 0), cB, voffB); PG8_STAGE(PG8_SB(0, 1), cB + hstep, voffB); PG8_STAGE(PG8_SA(0, 0), cA, voffA); PG8_STAGE(PG8_SA(0, 1), cA + hstep, voffA);
        if (wr == 1) PG8_BAR;
        PG8_WAIT_V(2); PG8_BAR;
        PG8_STAGE(PG8_SB(1, 0), cB + kstep, voffB); PG8_STAGE(PG8_SA(1, 0), cA + kstep, voffA); PG8_STAGE(PG8_SB(1, 1), cB + hstep + kstep, voffB);
        PG8_WAIT_V(6); PG8_BAR;
    } else {
        PG8_STAGE(PG8_SB(0, 0), cB, voffB); PG8_STAGE(PG8_SA(0, 0), cA, voffA); PG8_STAGE(PG8_SB(0, 1), cB + hstep, voffB); PG8_STAGE(PG8_SA(0, 1), cA + hstep, voffA);
        if (wr == 1) PG8_BAR;
        PG8_WAIT_V(4); PG8_BAR;
        PG8_STAGE(PG8_SB(1, 0), cB + kstep, voffB); PG8_STAGE(PG8_SA(1, 0), cA + kstep, voffA); PG8_STAGE(PG8_SB(1, 1), cB + hstep + kstep, voffB);
        PG8_WAIT_V(6); PG8_BAR;
    }
    for (;;) {
        const bool has_next = S.next(ui + 1, nxt);
        const char* nA = has_next ? (const char*)g.A + (size_t)nxt.pm * tstep : cA; const char* nB = has_next ? (const char*)g.Bt + (size_t)nxt.pn * tstep : cB;
        for (int t = 0; t < nt; t += 2) {
            const bool last = (t == nt - 2);
            const char* a1 = cA + (size_t)(t + 1) * kstep;
            const char* a2 = last ? nA : cA + (size_t)(t + 2) * kstep; const char* b2 = last ? nB : cB + (size_t)(t + 2) * kstep;
            const char* a3 = a2 + kstep; const char* b3 = b2 + kstep;
            if (last && has_next) S.a_ready(nxt);
            if constexpr (SP2) {
            PG8_LDB(B0, 0, 0); PG8_LDB(B1, 0, 1); PG8_SCHED; PG8_LDA(At, 0, 0); PG8_STAGE(PG8_SA(1, 1), a1 + hstep, voffA);
            PG8_WAIT_V(8); PG8_WAIT_L(0); PG8_BAR; PG8_MMA(0, 0, At, B0); PG8_MMA(0, 1, At, B1); PG8_BAR; PG8_SCHED;
            PG8_LDA(At, 0, 1); PG8_STAGE(PG8_SB(0, 0), b2, voffB); PG8_STAGE(PG8_SB(0, 1), b2 + hstep, voffB); PG8_STAGE(PG8_SA(0, 0), a2, voffA);
            PG8_WAIT_V(8); PG8_WAIT_L(0); PG8_BAR; PG8_MMA(1, 0, At, B0); PG8_MMA(1, 1, At, B1); PG8_BAR; PG8_SCHED;
            PG8_LDB(B0, 1, 0); PG8_LDB(B1, 1, 1); PG8_SCHED; PG8_LDA(At, 1, 0); PG8_STAGE(PG8_SA(0, 1), a2 + hstep, voffA);
            PG8_WAIT_V(8); PG8_WAIT_L(0); PG8_BAR; PG8_MMA(0, 0, At, B0); PG8_MMA(0, 1, At, B1); PG8_BAR; PG8_SCHED;
            PG8_LDA(At, 1, 1); PG8_STAGE(PG8_SB(1, 0), b3, voffB); PG8_STAGE(PG8_SB(1, 1), b3 + hstep, voffB); PG8_STAGE(PG8_SA(1, 0), a3, voffA);
            PG8_WAIT_V(8); PG8_WAIT_L(0); PG8_BAR; PG8_MMA(1, 0, At, B0); PG8_MMA(1, 1, At, B1); PG8_BAR; PG8_SCHED;
            } else {
            PG8_LDB(B0, 0, 0); PG8_SCHED; PG8_LDA(At, 0, 0); PG8_STAGE(PG8_SA(1, 1), a1 + hstep, voffA);
            PG8_WAIT_L(8); PG8_BAR; PG8_WAIT_L(0); PG8_MMA(0, 0, At, B0); PG8_BAR; PG8_SCHED;
            PG8_LDB(B1, 0, 1); PG8_STAGE(PG8_SB(0, 0), b2, voffB);
            PG8_BAR; PG8_WAIT_L(0); PG8_MMA(0, 1, At, B1); PG8_BAR;
            PG8_LDA(At, 0, 1); PG8_STAGE(PG8_SA(0, 0), a2, voffA);
            PG8_BAR; PG8_WAIT_L(0); PG8_MMA(1, 0, At, B0); PG8_BAR; PG8_SCHED;
            PG8_STAGE(PG8_SB(0, 1), b2 + hstep, voffB);
            PG8_WAIT_V(6); PG8_BAR; PG8_MMA(1, 1, At, B1); PG8_BAR;
            PG8_LDB(B0, 1, 0); PG8_SCHED; PG8_LDA(At, 1, 0); PG8_STAGE(PG8_SA(0, 1), a2 + hstep, voffA);
            PG8_WAIT_L(8); PG8_BAR; PG8_WAIT_L(0); PG8_MMA(0, 0, At, B0); PG8_BAR; PG8_SCHED;
            PG8_LDB(B1, 1, 1); PG8_STAGE(PG8_SB(1, 0), b3, voffB);
            PG8_BAR; PG8_WAIT_L(0); PG8_MMA(0, 1, At, B1); PG8_BAR;
            PG8_LDA(At, 1, 1); PG8_STAGE(PG8_SA(1, 0), a3, voffA);
            PG8_BAR; PG8_WAIT_L(0); PG8_MMA(1, 0, At, B0); PG8_BAR; PG8_SCHED;
            PG8_STAGE(PG8_SB(1, 1), b3 + hstep, voffB);
            PG8_WAIT_V(6); PG8_BAR; PG8_MMA(1, 1, At, B1); PG8_BAR;
            }
        }
        if constexpr (ALIGN_EPI) { if (wr == 0) PG8_BAR; }
        if constexpr (!Epi::AFTER_DRAIN) { E(acc, cur, wr, wc, fr, fq); S.done(cur); }
        if (!has_next) break;
#pragma unroll
        for (int a = 0; a < 2; ++a)
#pragma unroll
            for (int b = 0; b < 2; ++b)
#pragma unroll
                for (int m = 0; m < 4; ++m)
#pragma unroll
                    for (int n = 0; n < 2; ++n) acc[a][b][m][n] = (f32x4){0.f, 0.f, 0.f, 0.f};
        cur = nxt; cA = nA; cB = nB; ++ui;
        if constexpr (ALIGN_EPI) { if (wr == 1) PG8_BAR; }
    }
    PG8_WAIT_V(0);
    if constexpr (!ALIGN_EPI) { if (wr == 0) PG8_BAR; }
    PG8_BAR;
    if constexpr (Epi::AFTER_DRAIN) { E.fused(acc, cur, wr, wc, fr, fq, lds, wid, lane); S.done(cur); }
#undef PG8_SA
#undef PG8_SB
#undef PG8_STAGE
#undef PG8_LDA
#undef PG8_LDB
#undef PG8_MMA
#undef PG8_WAIT_V
#undef PG8_WAIT_L
#undef PG8_BAR
#undef PG8_SCHED
}
}

struct Args { const float* in[26]; float* out; unsigned char* ws; };

__device__ __forceinline__ void p_mod(LAS unsigned char* lds, const float* __restrict__ c, const float* __restrict__ c_ctx, const float* __restrict__ ada_w,
                                      const float* __restrict__ ada_b, float* __restrict__ mod, int bid, int G, int tid) {
    if (bid >= 96) return;
    LAS float* s = (LAS float*)lds;
    LAS float* red = s + 17 * 1024;
    for (int i = tid; i < 17 * 1024; i += NTHREADS) { const int r = i >> 10, k = i & 1023; const float v = r < NB ? c[r * DM + k] : c_ctx[k]; s[i] = v / (1.0f + expf(-v)); }
    __syncthreads();
    for (int it = bid; it < 96; it += G) {
        const int cc = tid & 63, kg = tid >> 6, col = it * 64 + cc;
        float acc[17];
#pragma unroll
        for (int r = 0; r < 17; ++r) acc[r] = 0.f;
        for (int k = kg * 128; k < kg * 128 + 128; ++k) {
            const float w = ada_w[(size_t)k * 6144 + col];
#pragma unroll
            for (int r = 0; r < 17; ++r) acc[r] += s[r * 1024 + k] * w;
        }
#pragma unroll
        for (int r = 0; r < 17; ++r) red[(kg * 17 + r) * 64 + cc] = acc[r];
        __syncthreads();
        for (int i = tid; i < 17 * 64; i += NTHREADS) {
            const int r = i >> 6, c2 = i & 63; float sum = 0.f;
#pragma unroll
            for (int g = 0; g < 8; ++g) sum += red[(g * 17 + r) * 64 + c2];
            mod[(size_t)r * 6144 + it * 64 + c2] = sum + ada_b[it * 64 + c2];
        }
        __syncthreads();
    }
}

__device__ __forceinline__ void transpose_tile(LAS float* tile, const float* __restrict__ W, int K, int N, bf16_t* __restrict__ O, int mode, int k0, int n0, int tid) {
    for (int i = tid; i < 64 * 64; i += NTHREADS) { const int kk = i >> 6, nn = i & 63; tile[kk * 65 + nn] = W[(size_t)(k0 + kk) * N + n0 + nn]; }
    __syncthreads();
    for (int i = tid; i < 64 * 32; i += NTHREADS) {
        const int nn = i >> 5, kp = i & 31, n = n0 + nn;
        const int orow = mode == 0 ? n : ((n >> 4) * 32 + (mode == 2 ? 16 : 0) + (n & 15));
        *(unsigned*)(O + (size_t)orow * K + k0 + 2 * kp) = pk2(tile[(2 * kp) * 65 + nn], tile[(2 * kp + 1) * 65 + nn]);
    }
    __syncthreads();
}
__device__ __forceinline__ void p_transposes(LAS unsigned char* lds, const Args& a, int bid, int G, int tid) {
    LAS float* tile = (LAS float*)lds;
    unsigned char* ws = a.ws;
    constexpr int I_IN = 16 * 56, I_OUT = 16 * 16, I_E = 32 * 128;
    constexpr int NITEMS = I_IN + I_OUT + 3 * I_E;
    for (int it = bid; it < NITEMS; it += G) {
        int r = it;
        if (r < I_IN) { transpose_tile(tile, a.in[6], DM, NIN, (bf16_t*)(ws + WS_WINT), 0, (r & 15) * 64, (r >> 4) * 64, tid); continue; } r -= I_IN;
        if (r < I_OUT) { transpose_tile(tile, a.in[14], DM, DM, (bf16_t*)(ws + WS_WOUTT), 0, (r & 15) * 64, (r >> 4) * 64, tid); continue; } r -= I_OUT;
        if (r < I_E) { const int e = r >> 7, q = r & 127; transpose_tile(tile, a.in[21] + (size_t)e * DM * DE, DM, DE, (bf16_t*)(ws + WS_W13T) + (size_t)e * DM * DM, 1, (q & 15) * 64, (q >> 4) * 64, tid); continue; } r -= I_E;
        if (r < I_E) { const int e = r >> 7, q = r & 127; transpose_tile(tile, a.in[22] + (size_t)e * DM * DE, DM, DE, (bf16_t*)(ws + WS_W13T) + (size_t)e * DM * DM, 2, (q & 15) * 64, (q >> 4) * 64, tid); continue; } r -= I_E;
        { const int e = r >> 7, q = r & 127; transpose_tile(tile, a.in[23] + (size_t)e * DE * DM, DE, DM, (bf16_t*)(ws + WS_W2T) + (size_t)e * DM * DE, 0, (q & 7) * 64, (q >> 3) * 64, tid); }
    }
}

__device__ __forceinline__ void p_u(const float* __restrict__ x, const float* __restrict__ ctx, const float* __restrict__ mod, bf16_t* __restrict__ U, int bid, int G, int tid) {
    for (size_t i4 = (size_t)bid * NTHREADS + tid; i4 < (size_t)TA * 256; i4 += (size_t)G * NTHREADS) {
        const int row = (int)(i4 >> 8), c4 = (int)(i4 & 255) * 4;
        const float* src; const float* m;
        if (row < T) { src = x + (size_t)row * DM; m = mod + (size_t)(row / SEQ) * 6144; }
        else { src = ctx + (size_t)(row - T) * DM; m = mod + (size_t)16 * 6144; }
        const f32x4 v = *(const f32x4*)(src + c4), sh = *(const f32x4*)(m + c4), sc = *(const f32x4*)(m + 1024 + c4);
        u32x2 w; w.x = pk2(v[0] * (1.f + sc[0]) + sh[0], v[1] * (1.f + sc[1]) + sh[1]); w.y = pk2(v[2] * (1.f + sc[2]) + sh[2], v[3] * (1.f + sc[3]) + sh[3]);
        *(u32x2*)(U + (size_t)row * DM + c4) = w;
    }
}

__device__ __forceinline__ void router_decide(const float (&pl)[36], int slot, int lane, LAS int* lcnt, LAS i32x4* tinfo, LAS f32x2* tw) {
    int gi = 0; float gm = pl[0];
#pragma unroll
    for (int g = 1; g < 4; ++g) if (pl[g] > gm) { gm = pl[g]; gi = g; }
    float den = 0.f;
#pragma unroll
    for (int g = 0; g < 4; ++g) den += __expf(pl[g] - gm);
    const float gval = frcp(den);
    int j0 = -1; float v0 = -3.0e38f;
#pragma unroll
    for (int j = 0; j < 32; ++j) { const bool in = (j >> 3) == gi; if (in && (j0 < 0 || pl[4 + j] > v0)) { v0 = pl[4 + j]; j0 = j; } }
    int j1 = -1; float v1 = -3.0e38f;
#pragma unroll
    for (int j = 0; j < 32; ++j) { const bool in = (j >> 3) == gi; if (in && j != j0 && (j1 < 0 || pl[4 + j] > v1)) { v1 = pl[4 + j]; j1 = j; } }
    if (lane == 0) {
        const float t = __expf(v1 - v0), w0 = frcp(1.0f + t), w1 = t * w0;
        const int p0 = __hip_atomic_fetch_add(lcnt + j0, 1, __ATOMIC_RELAXED, __HIP_MEMORY_SCOPE_WORKGROUP), p1 = __hip_atomic_fetch_add(lcnt + j1, 1, __ATOMIC_RELAXED, __HIP_MEMORY_SCOPE_WORKGROUP);
        tinfo[slot] = (i32x4){j0, j1, p0, p1}; tw[slot] = (f32x2){gval * w0, gval * w1};
    }
}
__device__ __forceinline__ void p_ln1_router(LAS unsigned char* lds, const Args& a, int bid, int G, int tid, int wave, int lane, bool dry = false) {
    const float* __restrict__ x = a.in[0]; const float* yo = a.out; float* h1o = dry ? (float*)(a.ws + WS_XG) : a.out; const float* mod = (const float*)(a.ws + WS_MOD);
    const float* __restrict__ ln_g = a.in[15]; const float* __restrict__ ln_b = a.in[16];
    const float* __restrict__ rgw = a.in[17]; const float* __restrict__ rgb = a.in[18]; const float* __restrict__ rew = a.in[19]; const float* __restrict__ reb = a.in[20];
    bf16_t* U2 = (bf16_t*)(a.ws + (dry ? WS_HID : WS_U)); int* counts = (int*)(a.ws + WS_CTL) + (dry ? 32 * CSTR : 0);
    int2* eidx = (int2*)(a.ws + (dry ? WS_Y : WS_EIDX)); int2* epos = (int2*)(a.ws + (dry ? WS_Y + 4 * MiB : WS_EPOS)); float2* ew = (float2*)(a.ws + (dry ? WS_Y + 8 * MiB : WS_EW));
    LAS float* WT = (LAS float*)lds;
    for (int i = tid; i < 1024 * 4; i += NTHREADS) WT[(i & 3) * 1024 + (i >> 2)] = rgw[i];
    for (int i = tid; i < 1024 * 32; i += NTHREADS) WT[(4 + (i & 31)) * 1024 + (i >> 5)] = rew[i];
    LAS float* BIAS = WT + 36 * 1024;
    LAS int* lcnt = (LAS int*)(BIAS + 64);
    LAS int* lbase = lcnt + 32;
    LAS i32x4* tinfo = (LAS i32x4*)(lbase + 32);
    LAS f32x2* tw = (LAS f32x2*)(tinfo + 256);
    if (tid < 36) BIAS[tid] = tid < 4 ? rgb[tid] : reb[tid - 4];
    if (tid < 32) lcnt[tid] = 0;
    __syncthreads();
    int nslot = 0;
#pragma unroll 1
    for (int pr = bid * 8 + wave; pr < T / 2; pr += G * 8) {
        int l2 = lane; asm volatile("" : "+v"(l2)); const int lane = l2;
        const int tok0 = 2 * pr;
        const float* m = mod + (size_t)(tok0 / SEQ) * 6144;
        f32x4 v[2][4]; float s[2] = {0.f, 0.f};
#pragma unroll
        for (int t = 0; t < 2; ++t)
#pragma unroll
            for (int j = 0; j < 4; ++j) { const int c4 = 4 * lane + 256 * j;
                const f32x4 xv = *(const f32x4*)(x + (size_t)(tok0 + t) * DM + c4), yv = *(const f32x4*)(yo + (size_t)(tok0 + t) * DM + c4), g1 = *(const f32x4*)(m + 2048 + c4);
                v[t][j] = ALPHA * xv + g1 * yv; s[t] += (v[t][j][0] + v[t][j][1]) + (v[t][j][2] + v[t][j][3]); }
        float rstd[2];
#pragma unroll
        for (int t = 0; t < 2; ++t) { const float mean = wave_sum(s[t]) * (1.0f / DM); float s2 = 0.f;
#pragma unroll
            for (int j = 0; j < 4; ++j) { v[t][j] = v[t][j] - mean; s2 += (v[t][j][0] * v[t][j][0] + v[t][j][1] * v[t][j][1]) + (v[t][j][2] * v[t][j][2] + v[t][j][3] * v[t][j][3]); }
            rstd[t] = rsqrtf(wave_sum(s2) * (1.0f / DM) + LN_EPS); }
        float plA[36], plB[36];
#pragma unroll
        for (int e = 0; e < 36; ++e) { plA[e] = 0.f; plB[e] = 0.f; }
#pragma unroll
        for (int j = 0; j < 4; ++j) { const int c4 = 4 * lane + 256 * j;
            const f32x4 lg = *(const f32x4*)(ln_g + c4), lb = *(const f32x4*)(ln_b + c4), sc2 = *(const f32x4*)(m + 4096 + c4), sh2 = *(const f32x4*)(m + 3072 + c4);
            f32x4 u2[2];
#pragma unroll
            for (int t = 0; t < 2; ++t) { const f32x4 h1 = v[t][j] * rstd[t] * lg + lb;
                *(f32x4*)(h1o + (size_t)(tok0 + t) * DM + c4) = h1;
                u2[t] = h1 * (1.0f + sc2) + sh2;
                u32x2 w; w.x = pk2(u2[t][0], u2[t][1]); w.y = pk2(u2[t][2], u2[t][3]);
                *(u32x2*)(U2 + (size_t)(tok0 + t) * DM + c4) = w; }
#pragma unroll
            for (int e = 0; e < 36; ++e) { const f32x4 w4 = *(const LAS f32x4*)(WT + e * 1024 + c4);
                plA[e] += (u2[0][0] * w4[0] + u2[0][1] * w4[1]) + (u2[0][2] * w4[2] + u2[0][3] * w4[3]);
                plB[e] += (u2[1][0] * w4[0] + u2[1][1] * w4[1]) + (u2[1][2] * w4[2] + u2[1][3] * w4[3]);
                if ((e % 6) == 5) __builtin_amdgcn_sched_barrier(0); }
        }
#pragma unroll
        for (int e = 0; e < 36; ++e) { const float be = BIAS[e]; plA[e] = wave_sum(plA[e]) + be; plB[e] = wave_sum(plB[e]) + be; if ((e & 3) == 3) __builtin_amdgcn_sched_barrier(0); }
        router_decide(plA, wave * 32 + nslot, lane, lcnt, tinfo, tw);
        router_decide(plB, wave * 32 + nslot + 1, lane, lcnt, tinfo, tw);
        nslot += 2;
    }
    __syncthreads();
    if (tid < 32) lbase[tid] = atomicAdd(&counts[tid * CSTR], lcnt[tid]);
    __syncthreads();
    if (lane < nslot) {
        const int pr = bid * 8 + wave + (lane >> 1) * (G * 8), tok = 2 * pr + (lane & 1);
        const i32x4 ti = tinfo[wave * 32 + lane]; const f32x2 wv = tw[wave * 32 + lane];
        eidx[tok] = make_int2(ti[0], ti[1]); epos[tok] = make_int2(lbase[ti[0]] + ti[2], lbase[ti[1]] + ti[3]); ew[tok] = make_float2(wv[0], wv[1]);
    }
    __syncthreads();
}

__device__ __forceinline__ void p_gather(const Args& a, int bid, int G, int wave, int lane) {
    const bf16_t* U2 = (const bf16_t*)(a.ws + WS_U); const int* counts = (const int*)(a.ws + WS_CTL);
    const int2* eidx = (const int2*)(a.ws + WS_EIDX); const int2* epos = (const int2*)(a.ws + WS_EPOS); int2* dest = (int2*)(a.ws + WS_DEST);
    bf16_t* XG = (bf16_t*)(a.ws + WS_XG);
    for (int tok = bid * 8 + wave; tok < T; tok += G * 8) {
        const int2 ei = eidx[tok], ep = epos[tok];
        const int d0 = pstart_of(counts, ei.x) + ep.x, d1 = pstart_of(counts, ei.y) + ep.y;
        const u32x4 v0 = *(const u32x4*)(U2 + (size_t)tok * DM + lane * 8), v1 = *(const u32x4*)(U2 + (size_t)tok * DM + 512 + lane * 8);
        *(u32x4*)(XG + (size_t)d0 * DM + lane * 8) = v0; *(u32x4*)(XG + (size_t)d0 * DM + 512 + lane * 8) = v1;
        *(u32x4*)(XG + (size_t)d1 * DM + lane * 8) = v0; *(u32x4*)(XG + (size_t)d1 * DM + 512 + lane * 8) = v1;
        if (lane == 0) dest[tok] = make_int2(d0, d1);
    }
}

__device__ __forceinline__ void p_combine_ln2(const Args& a, int bid, int G, int wave, int lane, bool dry = false) {
    const float* out = a.out; float* outw = dry ? (float*)(a.ws + WS_XG) : a.out; const bf16_t* Y = (const bf16_t*)(a.ws + WS_Y); const int2* dest = (const int2*)(a.ws + WS_DEST); const float2* ew = (const float2*)(a.ws + WS_EW);
    const float* mod = (const float*)(a.ws + WS_MOD); const float* __restrict__ ln_g = a.in[24]; const float* __restrict__ ln_b = a.in[25];
    for (int tok = bid * 8 + wave; tok < T; tok += G * 8) {
        const float* m = mod + (size_t)(tok / SEQ) * 6144;
        const int2 d = dest[tok]; const float2 w = ew[tok];
        f32x4 v[4]; float s = 0.f;
#pragma unroll
        for (int j = 0; j < 4; ++j) { const int c4 = 4 * lane + 256 * j;
            const u32x2 ya = *(const u32x2*)(Y + (size_t)d.x * DM + c4), yb = *(const u32x2*)(Y + (size_t)d.y * DM + c4);
            f32x4 f;
            f[0] = w.x * __uint_as_float(ya.x << 16) + w.y * __uint_as_float(yb.x << 16);
            f[1] = w.x * __uint_as_float(ya.x & 0xffff0000u) + w.y * __uint_as_float(yb.x & 0xffff0000u);
            f[2] = w.x * __uint_as_float(ya.y << 16) + w.y * __uint_as_float(yb.y << 16);
            f[3] = w.x * __uint_as_float(ya.y & 0xffff0000u) + w.y * __uint_as_float(yb.y & 0xffff0000u);
            const f32x4 h1 = *(const f32x4*)(out + (size_t)tok * DM + c4), g2 = *(const f32x4*)(m + 5120 + c4);
            v[j] = ALPHA * h1 + g2 * f; s += (v[j][0] + v[j][1]) + (v[j][2] + v[j][3]); }
        const float mean = wave_sum(s) * (1.0f / DM); float s2 = 0.f;
#pragma unroll
        for (int j = 0; j < 4; ++j) { v[j] = v[j] - mean; s2 += (v[j][0] * v[j][0] + v[j][1] * v[j][1]) + (v[j][2] * v[j][2] + v[j][3] * v[j][3]); }
        const float rstd = rsqrtf(wave_sum(s2) * (1.0f / DM) + LN_EPS);
#pragma unroll
        for (int j = 0; j < 4; ++j) { const int c4 = 4 * lane + 256 * j;
            *(f32x4*)(outw + (size_t)tok * DM + c4) = v[j] * rstd * *(const f32x4*)(ln_g + c4) + *(const f32x4*)(ln_b + c4); }
    }
}

constexpr size_t WS_HGK = WS_U;
constexpr size_t WS_HGD = 852 * MiB;
constexpr size_t WS_RGAGG = 854 * MiB;
constexpr size_t WS_RGCARRY = 864 * MiB;
constexpr size_t WS_GWT = 870 * MiB;
constexpr size_t WS_OFST = 880 * MiB;
constexpr int RG_UNITS_PER_B = 68, HG_SEGS = 17;

__device__ __forceinline__ void lds_barrier() { asm volatile("s_waitcnt lgkmcnt(0)" ::: "memory"); __builtin_amdgcn_s_barrier(); asm volatile("" ::: "memory"); }
__device__ __forceinline__ bf16x8 mk_bf16x8(u32x4 v) { return __builtin_bit_cast(bf16x8, v); }
__device__ __forceinline__ float bf_lo(unsigned w) { return __uint_as_float(w << 16); }
__device__ __forceinline__ float bf_hi(unsigned w) { return __uint_as_float(w & 0xffff0000u); }
__device__ __forceinline__ unsigned cvt2(float lo, float hi) { unsigned r; asm volatile("v_cvt_pk_bf16_f32 %0, %1, %2" : "=v"(r) : "v"(lo), "v"(hi)); return r; }

__device__ __forceinline__ void p_gwt(const float* __restrict__ gate_w, bf16_t* __restrict__ gwt, int bid, int G, int tid) {
    for (int o = bid * NTHREADS + tid; o < 32 * 4096; o += G * NTHREADS) { const int mat = o >> 12, d = (o >> 6) & 63, c = o & 63; gwt[o] = f2bf(gate_w[mat * 4096 + c * 64 + d]); }
}

constexpr int XC_STRIDE = 1040;
constexpr int RG_XC = 0, RG_OUT = 64 * XC_STRIDE;
template <int MODE>
__device__ __forceinline__ void rg_unit(LAS unsigned char* lds, const Args& a, int b, int k, int tid, int wave, int lane) {
    const bf16_t* __restrict__ proj = (const bf16_t*)(a.ws + WS_PROJ);
    const float* __restrict__ conv_w = a.in[7]; const float* __restrict__ conv_b = a.in[8]; const float* __restrict__ gate_b = a.in[10]; const float* __restrict__ lam = a.in[11];
    const bf16_t* __restrict__ gwt = (const bf16_t*)(a.ws + WS_GWT);
    float* rgagg = (float*)(a.ws + WS_RGAGG); const float* rgcarry = (const float*)(a.ws + WS_RGCARRY);
    int rowbase, p0, lo, hi;
    if (k < 4) { rowbase = T + b * LC; p0 = k * 64; lo = 0; hi = LC; } else { rowbase = b * SEQ; p0 = (k - 4) * 64; lo = p0; hi = p0 + 64; }
    const int unit = b * RG_UNITS_PER_B + k;
    {
        const int cgp = tid & 63, tg = tid >> 6, c0 = cgp * 8, i0 = tg * 8;
        u32x4 raw[11];
#pragma unroll
        for (int r = 0; r < 11; ++r) { const int p = p0 + i0 - 1 + r;
            raw[r] = (p >= lo && p < hi) ? *(const u32x4*)(proj + (size_t)(rowbase + p) * NIN + c0) : (u32x4){0u, 0u, 0u, 0u}; }
        float cw[4][8], cb[8];
#pragma unroll
        for (int t4 = 0; t4 < 4; ++t4) { const f32x4 w0 = *(const f32x4*)(conv_w + t4 * 512 + c0), w1 = *(const f32x4*)(conv_w + t4 * 512 + c0 + 4);
#pragma unroll
            for (int q = 0; q < 4; ++q) { cw[t4][q] = w0[q]; cw[t4][4 + q] = w1[q]; } }
        { const f32x4 b0 = *(const f32x4*)(conv_b + c0), b1 = *(const f32x4*)(conv_b + c0 + 4);
#pragma unroll
            for (int q = 0; q < 4; ++q) { cb[q] = b0[q]; cb[4 + q] = b1[q]; } }
#pragma unroll
        for (int ii = 0; ii < 8; ++ii) {
            float xc[8];
#pragma unroll
            for (int c = 0; c < 8; ++c) xc[c] = cb[c];
#pragma unroll
            for (int t4 = 0; t4 < 4; ++t4) { const u32x4 rw = raw[ii + t4];
#pragma unroll
                for (int q = 0; q < 4; ++q) { xc[2 * q] += cw[t4][2 * q] * bf_lo(rw[q]); xc[2 * q + 1] += cw[t4][2 * q + 1] * bf_hi(rw[q]); } }
            u32x4 w; w.x = cvt2(xc[0], xc[1]); w.y = cvt2(xc[2], xc[3]); w.z = cvt2(xc[4], xc[5]); w.w = cvt2(xc[6], xc[7]);
            *(LAS u32x4*)(lds + RG_XC + (i0 + ii) * XC_STRIDE + c0 * 2) = w;
        }
    }
    lds_barrier();
    {
        const int n = wave, fr = lane & 15, fq = lane >> 4;
        bf16x8 afr[4][2];
#pragma unroll
        for (int m = 0; m < 4; ++m)
#pragma unroll
            for (int ks = 0; ks < 2; ++ks) afr[m][ks] = *(const LAS bf16x8*)(lds + RG_XC + (16 * m + fr) * XC_STRIDE + (n * 64 + ks * 32 + fq * 8) * 2);
        for (int nt = 0; nt < 4; ++nt) {
            const int ch = n * 64 + nt * 16 + fr;
            float xcv[4][4];
#pragma unroll
            for (int m = 0; m < 4; ++m)
#pragma unroll
                for (int j = 0; j < 4; ++j) xcv[m][j] = bf2f(*(const LAS bf16_t*)(lds + RG_XC + (16 * m + 4 * fq + j) * XC_STRIDE + ch * 2));
            float hsum[4][4];
#pragma unroll
            for (int dir = 0; dir < 2; ++dir) {
                f32x4 accr[4], acci[4];
#pragma unroll
                for (int m = 0; m < 4; ++m) { accr[m] = (f32x4){0.f, 0.f, 0.f, 0.f}; acci[m] = (f32x4){0.f, 0.f, 0.f, 0.f}; }
#pragma unroll
                for (int ks = 0; ks < 2; ++ks) {
                    const bf16x8 br = *(const bf16x8*)(gwt + ((size_t)(((dir * 2 + 0) * 8 + n) * 64 + nt * 16 + fr)) * 64 + ks * 32 + fq * 8);
                    const bf16x8 bi = *(const bf16x8*)(gwt + ((size_t)(((dir * 2 + 1) * 8 + n) * 64 + nt * 16 + fr)) * 64 + ks * 32 + fq * 8);
#pragma unroll
                    for (int m = 0; m < 4; ++m) { accr[m] = __builtin_amdgcn_mfma_f32_16x16x32_bf16(afr[m][ks], br, accr[m], 0, 0, 0); acci[m] = __builtin_amdgcn_mfma_f32_16x16x32_bf16(afr[m][ks], bi, acci[m], 0, 0, 0); }
                }
                const float gbr = gate_b[(dir * 2 + 0) * 512 + ch], gbi = gate_b[(dir * 2 + 1) * 512 + ch];
                const float sp = softplusf_(-lam[dir * 512 + ch]);
                float av[4][4], uv[4][4];
#pragma unroll
                for (int m = 0; m < 4; ++m)
#pragma unroll
                    for (int j = 0; j < 4; ++j) {
                        const float r = sigmoidf_(accr[m][j] + gbr), ig = sigmoidf_(acci[m][j] + gbi);
                        const float la = -8.0f * r * sp, t2 = 2.0f * la;
                        av[m][j] = __expf(la);
                        float om = -t2 * (1.f + t2 * (0.5f + t2 * (0.16666667f + t2 * (0.041666668f + t2 * 0.0083333338f))));
                        if (__builtin_expect(__any(t2 <= -0.25f), 0)) om = (t2 > -0.25f) ? om : 1.f - __expf(t2);
                        uv[m][j] = __builtin_amdgcn_sqrtf(om) * ig * xcv[m][j];
                    }
                float carry = (MODE == 1) ? rgcarry[((size_t)unit * 2 + dir) * 512 + ch] : 0.f;
                float atot = 1.f;
#pragma unroll
                for (int mm = 0; mm < 4; ++mm) {
                    const int m = dir == 0 ? mm : 3 - mm;
                    float P, H;
                    if (dir == 0) { P = av[m][0]; H = uv[m][0];
#pragma unroll
                        for (int j = 1; j < 4; ++j) { H = av[m][j] * H + uv[m][j]; P *= av[m][j]; } }
                    else { P = av[m][3]; H = uv[m][3];
#pragma unroll
                        for (int j = 2; j >= 0; --j) { H = av[m][j] * H + uv[m][j]; P *= av[m][j]; } }
                    float Pn, Hn, Pe, He, Pt, Ht;
                    if (dir == 0) {
                        Pn = __shfl_up(P, 16); Hn = __shfl_up(H, 16); if (fq >= 1) { H = P * Hn + H; P = P * Pn; }
                        Pn = __shfl_up(P, 32); Hn = __shfl_up(H, 32); if (fq >= 2) { H = P * Hn + H; P = P * Pn; }
                        Pe = __shfl_up(P, 16); He = __shfl_up(H, 16); if (fq == 0) { Pe = 1.f; He = 0.f; }
                        Pt = __shfl(P, fr + 48); Ht = __shfl(H, fr + 48);
                    } else {
                        Pn = __shfl_down(P, 16); Hn = __shfl_down(H, 16); if (fq <= 2) { H = P * Hn + H; P = P * Pn; }
                        Pn = __shfl_down(P, 32); Hn = __shfl_down(H, 32); if (fq <= 1) { H = P * Hn + H; P = P * Pn; }
                        Pe = __shfl_down(P, 16); He = __shfl_down(H, 16); if (fq == 3) { Pe = 1.f; He = 0.f; }
                        Pt = __shfl(P, fr); Ht = __shfl(H, fr);
                    }
                    if (MODE == 1) {
                        float hp = Pe * carry + He;
                        if (dir == 0) {
#pragma unroll
                            for (int j = 0; j < 4; ++j) { hp = av[m][j] * hp + uv[m][j]; hsum[m][j] = hp; }
                        } else {
#pragma unroll
                            for (int j = 3; j >= 0; --j) { hp = av[m][j] * hp + uv[m][j]; hsum[m][j] += hp; }
                        }
                    }
                    carry = Pt * carry + Ht; atot *= Pt;
                }
                if (MODE == 0 && fq == 0) { rgagg[(((size_t)unit * 2 + dir) * 2 + 0) * 512 + ch] = atot; rgagg[(((size_t)unit * 2 + dir) * 2 + 1) * 512 + ch] = carry; }
            }
            if (MODE == 1) {
#pragma unroll
                for (int m = 0; m < 4; ++m)
#pragma unroll
                    for (int j = 0; j < 4; ++j) { const int t = 16 * m + 4 * fq + j;
                        const float gg = bf2f(proj[(size_t)(rowbase + p0 + t) * NIN + 512 + ch]);
                        *(LAS bf16_t*)(lds + RG_OUT + t * XC_STRIDE + ch * 2) = f2bf(hsum[m][j] * gg); }
            }
        }
    }
    lds_barrier();
    if (MODE == 1) {
        bf16_t* mixed = (bf16_t*)(a.ws + WS_MIXED);
        const int cgp = tid & 63, tg = tid >> 6, c0 = cgp * 8, i0 = tg * 8;
#pragma unroll
        for (int ii = 0; ii < 8; ++ii) { const u32x4 w = *(const LAS u32x4*)(lds + RG_OUT + (i0 + ii) * XC_STRIDE + c0 * 2);
            *(u32x4*)(mixed + (size_t)(rowbase + p0 + i0 + ii) * DM + c0) = w; }
    }
}

__device__ __forceinline__ void rg_carry_item(const Args& a, int item, int tid) {
    const float* rgagg = (const float*)(a.ws + WS_RGAGG); float* rgcarry = (float*)(a.ws + WS_RGCARRY);
    const int gidx = item * NTHREADS + tid;
    const int ch = gidx & 511, dir = (gidx >> 9) & 1, b = gidx >> 10;
    float h = 0.f;
#pragma unroll 1
    for (int s0 = 0; s0 < RG_UNITS_PER_B; s0 += 17) {
        float Av[17], Hv[17];
#pragma unroll
        for (int s1 = 0; s1 < 17; ++s1) { const int s = s0 + s1;
            const int k = dir == 0 ? s : (s < 4 ? 3 - s : 67 - (s - 4));
            const size_t unit = (size_t)b * RG_UNITS_PER_B + k;
            Av[s1] = rgagg[((unit * 2 + dir) * 2 + 0) * 512 + ch]; Hv[s1] = rgagg[((unit * 2 + dir) * 2 + 1) * 512 + ch]; }
#pragma unroll
        for (int s1 = 0; s1 < 17; ++s1) { const int s = s0 + s1;
            const int k = dir == 0 ? s : (s < 4 ? 3 - s : 67 - (s - 4));
            const size_t unit = (size_t)b * RG_UNITS_PER_B + k;
            rgcarry[(unit * 2 + dir) * 512 + ch] = h;
            h = Av[s1] * h + Hv[s1]; }
    }
}

constexpr int HG_RAWZ = 0, HG_RAWV = 16384, HG_RAWQ = 32768;
constexpr int HG_KHT = 49152, HG_VT = 67584;
constexpr int HG_QT = 86016, HG_KT = 103424;
constexpr int HG_AM = 120832;
constexpr int HG_DS = 130048, HG_QSUM = 130560, HG_PART = 132608;
constexpr int HG_OST = 0;
constexpr int TS = 144, QS = 272;

struct HgRaw { u32x4 z[2], v[2], q[2]; };
template <bool FULL>
__device__ __forceinline__ void hg_load_raw(HgRaw& r, const bf16_t* __restrict__ proj, int row0, int hd, int dir, int tid) {
#pragma unroll
    for (int i = 0; i < 2; ++i) { const bf16_t* p = proj + (size_t)(row0 + (tid >> 4) + 32 * i) * NIN + hd * 128 + (tid & 15) * 8;
        r.z[i] = *(const u32x4*)(p + (dir == 0 ? 1536 : 2048)); r.v[i] = *(const u32x4*)(p + 2560); if (FULL) r.q[i] = *(const u32x4*)(p + 1024); }
}
template <bool FULL>
__device__ __forceinline__ void hg_store_raw(LAS unsigned char* lds, const HgRaw& r, int tid) {
#pragma unroll
    for (int i = 0; i < 2; ++i) { const int off = ((tid >> 4) + 32 * i) * 256 + (tid & 15) * 16;
        *(LAS u32x4*)(lds + HG_RAWZ + off) = r.z[i]; *(LAS u32x4*)(lds + HG_RAWV + off) = r.v[i]; if (FULL) *(LAS u32x4*)(lds + HG_RAWQ + off) = r.q[i]; }
}

template <int DIR, bool FULL>
__device__ __forceinline__ void hg_chunk(LAS unsigned char* lds, f32x4 (&accS)[8], f32x4 (&o)[4], float lbv, float& dseg, int tid, int wave, int lane) {
    const int kc = tid & 127, tq = tid >> 7, fr = lane & 15, fq = lane >> 4;
    float Gc[16];
    float qt = 0.f;
#pragma unroll
    for (int i = 0; i < 16; ++i) { const float z = bf2f(*(const LAS bf16_t*)(lds + HG_RAWZ + (16 * tq + i) * 256 + kc * 2));
        const float f = lbv + (1.0f - lbv) * sigmoidf_(z); Gc[i] = __logf(f); qt += Gc[i]; }
    *(LAS float*)(lds + HG_QSUM + (tq * 128 + kc) * 4) = qt;
    lds_barrier();
    float offs = 0.f, gtot = 0.f;
#pragma unroll
    for (int q4 = 0; q4 < 4; ++q4) { const float v = *(const LAS float*)(lds + HG_QSUM + (q4 * 128 + kc) * 4); gtot += v; if (DIR == 0 ? (q4 < tq) : (q4 > tq)) offs += v; }
    if (DIR == 0) { float c = offs;
#pragma unroll
        for (int i = 0; i < 16; ++i) { c += Gc[i]; Gc[i] = c; } }
    else { float c = offs;
#pragma unroll
        for (int i = 15; i >= 0; --i) { c += Gc[i]; Gc[i] = c; } }
    {
#pragma unroll
        for (int h2 = 0; h2 < 2; ++h2) {
            unsigned kh[4], vt[4];
#pragma unroll
            for (int i2 = 0; i2 < 4; ++i2) { const int i = 4 * h2 + i2;
                const float z0 = bf2f(*(const LAS bf16_t*)(lds + HG_RAWZ + (16 * tq + 2 * i) * 256 + kc * 2)), z1 = bf2f(*(const LAS bf16_t*)(lds + HG_RAWZ + (16 * tq + 2 * i + 1) * 256 + kc * 2));
                const float k0 = (1.0f - lbv) * (1.0f - sigmoidf_(z0)), k1 = (1.0f - lbv) * (1.0f - sigmoidf_(z1));
                kh[i2] = cvt2(k0 * __expf(gtot - Gc[2 * i]), k1 * __expf(gtot - Gc[2 * i + 1]));
                const unsigned v0 = *(const LAS bf16_t*)(lds + HG_RAWV + (16 * tq + 2 * i) * 256 + kc * 2), v1 = *(const LAS bf16_t*)(lds + HG_RAWV + (16 * tq + 2 * i + 1) * 256 + kc * 2);
                vt[i2] = v0 | (v1 << 16);
                if (FULL) {
                    const float q0 = bf2f(*(const LAS bf16_t*)(lds + HG_RAWQ + (16 * tq + 2 * i) * 256 + kc * 2)), q1 = bf2f(*(const LAS bf16_t*)(lds + HG_RAWQ + (16 * tq + 2 * i + 1) * 256 + kc * 2));
                    *(LAS bf16_t*)(lds + HG_QT + (16 * tq + 2 * i) * QS + kc * 2) = f2bf(q0 * __expf(Gc[2 * i]));
                    *(LAS bf16_t*)(lds + HG_QT + (16 * tq + 2 * i + 1) * QS + kc * 2) = f2bf(q1 * __expf(Gc[2 * i + 1]));
                    *(LAS bf16_t*)(lds + HG_KT + (16 * tq + 2 * i) * QS + kc * 2) = f2bf(k0 * __expf(-Gc[2 * i]));
                    *(LAS bf16_t*)(lds + HG_KT + (16 * tq + 2 * i + 1) * QS + kc * 2) = f2bf(k1 * __expf(-Gc[2 * i + 1]));
                }
            }
            *(LAS u32x4*)(lds + HG_KHT + kc * TS + tq * 32 + 16 * h2) = (u32x4){kh[0], kh[1], kh[2], kh[3]};
            *(LAS u32x4*)(lds + HG_VT + kc * TS + tq * 32 + 16 * h2) = (u32x4){vt[0], vt[1], vt[2], vt[3]};
        }
        if (tq == 0) { const float dc = __expf(gtot); *(LAS float*)(lds + HG_DS + kc * 4) = dc; dseg *= dc; }
    }
    lds_barrier();
    if (FULL) {
#pragma unroll
        for (int tt = 0; tt < 2; ++tt) {
            const int tl = 2 * wave + tt, ti = tl >> 2, si = tl & 3;
            f32x4 accA = (f32x4){0.f, 0.f, 0.f, 0.f};
#pragma unroll
            for (int ks = 0; ks < 4; ++ks) {
                const bf16x8 af = *(const LAS bf16x8*)(lds + HG_QT + (16 * ti + fr) * QS + (ks * 32 + fq * 8) * 2);
                const bf16x8 bf = *(const LAS bf16x8*)(lds + HG_KT + (16 * si + fr) * QS + (ks * 32 + fq * 8) * 2);
                accA = __builtin_amdgcn_mfma_f32_16x16x32_bf16(af, bf, accA, 0, 0, 0);
            }
#pragma unroll
            for (int j = 0; j < 4; ++j) { const int t = 16 * ti + 4 * fq + j, s = 16 * si + fr;
                const bool keep = DIR == 0 ? (s <= t) : (s >= t);
                *(LAS bf16_t*)(lds + HG_AM + t * TS + s * 2) = f2bf(keep ? accA[j] : 0.f); }
        }
        lds_barrier();
#pragma unroll
        for (int m = 0; m < 4; ++m) o[m] = (f32x4){0.f, 0.f, 0.f, 0.f};
#pragma unroll
        for (int ks = 0; ks < 4; ++ks) {
            const u32x4 sw = (u32x4){cvt2(accS[2 * ks][0], accS[2 * ks][1]), cvt2(accS[2 * ks][2], accS[2 * ks][3]), cvt2(accS[2 * ks + 1][0], accS[2 * ks + 1][1]), cvt2(accS[2 * ks + 1][2], accS[2 * ks + 1][3])};
            const bf16x8 sf = mk_bf16x8(sw);
#pragma unroll
            for (int m = 0; m < 4; ++m) {
                const u32x2 qlo = *(const LAS u32x2*)(lds + HG_QT + (16 * m + fr) * QS + (32 * ks + 4 * fq) * 2), qhi = *(const LAS u32x2*)(lds + HG_QT + (16 * m + fr) * QS + (32 * ks + 16 + 4 * fq) * 2);
                const bf16x8 qf = mk_bf16x8((u32x4){qlo.x, qlo.y, qhi.x, qhi.y});
                o[m] = __builtin_amdgcn_mfma_f32_16x16x32_bf16(qf, sf, o[m], 0, 0, 0);
            }
        }
#pragma unroll
        for (int ks = 0; ks < 2; ++ks) {
            const bf16x8 vf = *(const LAS bf16x8*)(lds + HG_VT + (16 * wave + fr) * TS + (ks * 32 + fq * 8) * 2);
#pragma unroll
            for (int m = 0; m < 4; ++m) { const bf16x8 af = *(const LAS bf16x8*)(lds + HG_AM + (16 * m + fr) * TS + (ks * 32 + fq * 8) * 2);
                o[m] = __builtin_amdgcn_mfma_f32_16x16x32_bf16(af, vf, o[m], 0, 0, 0); }
        }
    }
#pragma unroll
    for (int i = 0; i < 8; ++i) { const f32x4 dv = *(const LAS f32x4*)(lds + HG_DS + (16 * i + 4 * fq) * 4); accS[i] = accS[i] * dv; }
#pragma unroll
    for (int ks = 0; ks < 2; ++ks) {
        const bf16x8 vf = *(const LAS bf16x8*)(lds + HG_VT + (16 * wave + fr) * TS + (ks * 32 + fq * 8) * 2);
#pragma unroll
        for (int i = 0; i < 8; ++i) { const bf16x8 af = *(const LAS bf16x8*)(lds + HG_KHT + (16 * i + fr) * TS + (ks * 32 + fq * 8) * 2);
            accS[i] = __builtin_amdgcn_mfma_f32_16x16x32_bf16(af, vf, accS[i], 0, 0, 0); }
    }
}

__device__ __forceinline__ float hg_lb(const float* __restrict__ lb_logits, int dir, int col) {
    const float l0 = lb_logits[(0 * 2 + dir) * 512 + col], l1 = lb_logits[(1 * 2 + dir) * 512 + col];
    return 1.0f / (1.0f + expf(l1 - l0));
}

template <int DIR>
__device__ __forceinline__ void hg_agg_unit(LAS unsigned char* lds, const Args& a, int b, int hd, int sidx, int unit, int tid, int wave, int lane) {
    const bf16_t* __restrict__ proj = (const bf16_t*)(a.ws + WS_PROJ);
    const int rowbase = sidx == 0 ? T + b * LC : b * SEQ + (sidx - 1) * 256;
    const float lbv = hg_lb(a.in[12], DIR, hd * 128 + (tid & 127));
    f32x4 accS[8], odummy[4];
#pragma unroll
    for (int i = 0; i < 8; ++i) accS[i] = (f32x4){0.f, 0.f, 0.f, 0.f};
    float dseg = 1.f;
    HgRaw raw;
    hg_load_raw<false>(raw, proj, rowbase + (DIR == 0 ? 0 : 3) * 64, hd, DIR, tid);
    lds_barrier();
    hg_store_raw<false>(lds, raw, tid);
    lds_barrier();
#pragma unroll 1
    for (int cc = 0; cc < 4; ++cc) {
        if (cc < 3) hg_load_raw<false>(raw, proj, rowbase + (DIR == 0 ? cc + 1 : 2 - cc) * 64, hd, DIR, tid);
        hg_chunk<DIR, false>(lds, accS, odummy, lbv, dseg, tid, wave, lane);
        lds_barrier();
        if (cc < 3) { hg_store_raw<false>(lds, raw, tid); lds_barrier(); }
    }
    float* K = (float*)(a.ws + WS_HGK) + (size_t)unit * 16384;
    const int fr = lane & 15, fq = lane >> 4;
#pragma unroll
    for (int i = 0; i < 8; ++i)
#pragma unroll
        for (int j = 0; j < 4; ++j) K[(16 * i + 4 * fq + j) * 128 + 16 * wave + fr] = accS[i][j];
    if (tid < 128) ((float*)(a.ws + WS_HGD))[(size_t)unit * 128 + tid] = dseg;
}

__device__ __forceinline__ void hg_carry_item(const Args& a, int item, int tid, bool dry = false) {
    const int chain = item >> 3, part = item & 7, dir = chain & 1;
    float* K = (float*)(a.ws + WS_HGK) + (size_t)chain * HG_SEGS * 16384; const float* D = (const float*)(a.ws + WS_HGD) + (size_t)chain * HG_SEGS * 128;
    const int e4 = part * 512 + tid, dk = e4 >> 5;
    f32x4 kv[HG_SEGS]; float dv[HG_SEGS];
#pragma unroll
    for (int s = 0; s < HG_SEGS; ++s) { const int sidx = s == 0 ? 0 : (dir == 0 ? s : HG_SEGS - s); kv[s] = *(const f32x4*)(K + (size_t)sidx * 16384 + e4 * 4); dv[s] = D[sidx * 128 + dk]; }
    f32x4 S = (f32x4){0.f, 0.f, 0.f, 0.f};
#pragma unroll
    for (int s = 0; s < HG_SEGS; ++s) { const int sidx = s == 0 ? 0 : (dir == 0 ? s : HG_SEGS - s); if (dry) { const size_t o = ((size_t)(chain * HG_SEGS + sidx) * 16384 + e4 * 4) % (size_t)(32 * MiB); *(f32x4*)((float*)(a.ws + WS_MIXED) + o) = S; } else *(f32x4*)(K + (size_t)sidx * 16384 + e4 * 4) = S; S = S * dv[s] + kv[s]; }
}

__device__ __forceinline__ void hg_final_unit(LAS unsigned char* lds, const Args& a, int b, int hd, int seg, int tid, int wave, int lane) {
    const bf16_t* __restrict__ proj = (const bf16_t*)(a.ws + WS_PROJ); bf16_t* mixed = (bf16_t*)(a.ws + WS_MIXED);
    const int rowbase = b * SEQ + seg * 256, fr = lane & 15, fq = lane >> 4;
    const float lbf = hg_lb(a.in[12], 0, hd * 128 + (tid & 127)), lbb = hg_lb(a.in[12], 1, hd * 128 + (tid & 127));
    const float ng = a.in[13][hd * 128 + 16 * wave + fr];
    f32x4 accS[8], o[4];
    float dseg = 1.f;
    HgRaw raw;
    f32x4* ofst = (f32x4*)(a.ws + WS_OFST) + (size_t)blockIdx.x * 8192 + wave * 256 + lane;
    {
        const float* Sin = (const float*)(a.ws + WS_HGK) + (size_t)((((b * 4 + hd) * 2 + 0) * HG_SEGS) + 1 + seg) * 16384;
#pragma unroll
        for (int i = 0; i < 8; ++i)
#pragma unroll
            for (int j = 0; j < 4; ++j) accS[i][j] = Sin[(16 * i + 4 * fq + j) * 128 + 16 * wave + fr];
    }
    hg_load_raw<true>(raw, proj, rowbase, hd, 0, tid);
    lds_barrier();
    hg_store_raw<true>(lds, raw, tid);
    lds_barrier();
#pragma unroll 1
    for (int cc = 0; cc < 4; ++cc) {
        if (cc < 3) hg_load_raw<true>(raw, proj, rowbase + (cc + 1) * 64, hd, 0, tid); else hg_load_raw<true>(raw, proj, rowbase + 3 * 64, hd, 1, tid);
        hg_chunk<0, true>(lds, accS, o, lbf, dseg, tid, wave, lane);
#pragma unroll
        for (int m = 0; m < 4; ++m) ofst[cc * 2048 + m * 64] = o[m];
        lds_barrier();
        hg_store_raw<true>(lds, raw, tid);
        lds_barrier();
    }
    {
        const float* Sin = (const float*)(a.ws + WS_HGK) + (size_t)((((b * 4 + hd) * 2 + 1) * HG_SEGS) + 1 + seg) * 16384;
#pragma unroll
        for (int i = 0; i < 8; ++i)
#pragma unroll
            for (int j = 0; j < 4; ++j) accS[i][j] = Sin[(16 * i + 4 * fq + j) * 128 + 16 * wave + fr];
    }
#pragma unroll 1
    for (int cc = 0; cc < 4; ++cc) {
        const int c = 3 - cc;
        if (cc < 3) hg_load_raw<true>(raw, proj, rowbase + (c - 1) * 64, hd, 1, tid);
        hg_chunk<1, true>(lds, accS, o, lbb, dseg, tid, wave, lane);
        float gate[4][4];
#pragma unroll
        for (int m = 0; m < 4; ++m) { o[m] = o[m] + ofst[c * 2048 + m * 64];
#pragma unroll
            for (int j = 0; j < 4; ++j) { float s = o[m][j] * o[m][j];
                s += __shfl_xor(s, 1); s += __shfl_xor(s, 2); s += __shfl_xor(s, 4); s += __shfl_xor(s, 8);
                if (fr == 0) *(LAS float*)(lds + HG_PART + ((16 * m + 4 * fq + j) * 8 + wave) * 4) = s;
                gate[m][j] = bf2f(proj[(size_t)(rowbase + c * 64 + 16 * m + 4 * fq + j) * NIN + 3072 + hd * 128 + 16 * wave + fr]); } }
        lds_barrier();
#pragma unroll
        for (int m = 0; m < 4; ++m)
#pragma unroll
            for (int j = 0; j < 4; ++j) { const int t = 16 * m + 4 * fq + j;
                const f32x4 p0 = *(const LAS f32x4*)(lds + HG_PART + t * 32), p1 = *(const LAS f32x4*)(lds + HG_PART + t * 32 + 16);
                const float ms = ((p0[0] + p0[1]) + (p0[2] + p0[3]) + (p1[0] + p1[1]) + (p1[2] + p1[3])) * (1.0f / 128.0f);
                *(LAS bf16_t*)(lds + HG_OST + t * QS + (16 * wave + fr) * 2) = f2bf(o[m][j] * rsqrtf(ms + LN_EPS) * ng * gate[m][j]); }
        lds_barrier();
#pragma unroll
        for (int i = 0; i < 2; ++i) { const int t = (tid >> 4) + 32 * i, c8 = (tid & 15) * 8;
            *(u32x4*)(mixed + (size_t)(rowbase + c * 64 + t) * DM + 512 + hd * 128 + c8) = *(const LAS u32x4*)(lds + HG_OST + t * QS + c8 * 2); }
        lds_barrier();
        if (cc < 3) { hg_store_raw<true>(lds, raw, tid); lds_barrier(); }
    }
}

__device__ __forceinline__ void p_scan_a(LAS unsigned char* lds, const Args& a, int bid, int G, int tid, int wave, int lane, int mask = 3) {
    constexpr int N_HG = NB * 4 * 2 * HG_SEGS, N_RG = NB * RG_UNITS_PER_B;
#pragma unroll 1
    for (int it = bid; it < N_HG + N_RG; it += G) {
        int t2 = tid; asm volatile("" : "+v"(t2)); const int tid = t2, lane = t2 & 63;
        if ((it < N_HG) ? !(mask & 1) : !(mask & 2)) continue;
        if (it < N_HG) { const int sidx = it % HG_SEGS, rest = it / HG_SEGS, dir = rest & 1, hd = (rest >> 1) & 3, b = rest >> 3;
            if (dir == 0) hg_agg_unit<0>(lds, a, b, hd, sidx, it, tid, wave, lane); else hg_agg_unit<1>(lds, a, b, hd, sidx, it, tid, wave, lane); }
        else { const int r = it - N_HG; __syncthreads(); rg_unit<0>(lds, a, r / RG_UNITS_PER_B, r % RG_UNITS_PER_B, tid, wave, lane); }
    }
}
__device__ __forceinline__ void p_scan_b(const Args& a, int bid, int G, int tid, bool dry = false) {
#pragma unroll 1
    for (int it = bid; it < 1024; it += G) hg_carry_item(a, it, tid, dry);
    if (bid >= G - 32) rg_carry_item(a, bid - (G - 32), tid);
}
__device__ __forceinline__ void p_scan_c(LAS unsigned char* lds, const Args& a, int bid, int G, int tid, int wave, int lane, int mask = 3) {
#pragma unroll 1
    for (int it = bid; it < ((mask & 1) ? 1024 : 0); it += G) { const int seg = it & 15, hd = (it >> 4) & 3, b = it >> 6; int t2 = tid; asm volatile("" : "+v"(t2)); hg_final_unit(lds, a, b, hd, seg, t2, wave, t2 & 63); }
#pragma unroll 1
    for (int r = bid; r < ((mask & 2) ? 1024 : 0); r += G) { __syncthreads(); int t2 = tid; asm volatile("" : "+v"(t2)); rg_unit<1>(lds, a, r >> 6, 4 + (r & 63), t2, wave, t2 & 63); }
}

__global__ void __launch_bounds__(NTHREADS, 2) mega(Args a) {
    extern __shared__ __attribute__((aligned(16))) unsigned char lds_raw[];
    LAS unsigned char* lds = (LAS unsigned char*)lds_raw;
    cg::grid_group grid = cg::this_grid();
    const int wave = __builtin_amdgcn_readfirstlane(threadIdx.x >> 6), bid = blockIdx.x, G = gridDim.x;
    int tid = threadIdx.x, lane = tid & 63;
#define FRESH_TID() do { tid = threadIdx.x; asm volatile("" : "+v"(tid)); lane = tid & 63; } while (0)
    unsigned char* ws = a.ws;
    float* mod = (float*)(ws + WS_MOD);
    bf16_t* U = (bf16_t*)(ws + WS_U);
    bf16_t* PROJ = (bf16_t*)(ws + WS_PROJ); bf16_t* MIXED = (bf16_t*)(ws + WS_MIXED);

#ifndef SKIP_P0
    p_mod(lds, a.in[1], a.in[3], a.in[4], a.in[5], mod, bid, G, tid);
    p_transposes(lds, a, bid, G, tid);
    p_gwt(a.in[9], (bf16_t*)(ws + WS_GWT), bid, G, tid);
#endif
#ifdef REP_P0
    grid.sync();
    FRESH_TID();
    p_mod(lds, a.in[1], a.in[3], a.in[4], a.in[5], mod, bid, G, tid);
    p_transposes(lds, a, bid, G, tid);
    p_gwt(a.in[9], (bf16_t*)(ws + WS_GWT), bid, G, tid);
#endif
    grid.sync();
    FRESH_TID();
#ifdef REP_SYNC
    for (int r = 0; r < 10; ++r) grid.sync();
#endif
#ifndef SKIP_P1
    p_u(a.in[0], a.in[2], mod, U, bid, G, tid);
#endif
#ifdef REP_P1
    grid.sync();
    FRESH_TID();
    p_u(a.in[0], a.in[2], mod, U, bid, G, tid);
#endif
    grid.sync();
    FRESH_TID();
#ifndef SKIP_P2
    { pg8::Gemm g{U, (const bf16_t*)(ws + WS_WINT), TA, NIN, DM}; pg8::StaticOrder S; S.init(TA, NIN, G, bid);
      pg8::EpiInProj E{PROJ};
      pg8::gemm_phase<pg8::EpiInProj, pg8::StaticOrder, true, true>(lds, g, S, E); }
#endif
#ifdef REP_P2
    grid.sync();
    FRESH_TID();
    { pg8::Gemm g{U, (const bf16_t*)(ws + WS_WINT), TA, NIN, DM}; pg8::StaticOrder S; S.init(TA, NIN, G, bid);
      pg8::EpiInProj E{PROJ};
      pg8::gemm_phase<pg8::EpiInProj, pg8::StaticOrder, true, true>(lds, g, S, E); }
#endif
    grid.sync();
    FRESH_TID();
#ifndef SKIP_P3A
    p_scan_a(lds, a, bid, G, tid, wave, lane);
#endif
#ifdef REP_P3A
    grid.sync();
    FRESH_TID();
    p_scan_a(lds, a, bid, G, tid, wave, lane, REP_P3A);
#endif
    grid.sync();
    FRESH_TID();
#ifdef REP_P3B
    p_scan_b(a, bid, G, tid, true);
    grid.sync();
    FRESH_TID();
#endif
#ifndef SKIP_P3B
    p_scan_b(a, bid, G, tid);
#endif
    grid.sync();
    FRESH_TID();
#ifndef SKIP_P3C
    p_scan_c(lds, a, bid, G, tid, wave, lane);
#endif
#ifdef REP_P3C
    grid.sync();
    FRESH_TID();
    p_scan_c(lds, a, bid, G, tid, wave, lane, REP_P3C);
#endif
    grid.sync();
    FRESH_TID();
#ifndef SKIP_P5
    { pg8::Gemm g{MIXED, (const bf16_t*)(ws + WS_WOUTT), T, DM, DM}; pg8::StaticOrder S; S.init(T, DM, G, bid);
      pg8::EpiF32 E{a.out, DM, 0};
      pg8::gemm_phase<pg8::EpiF32, pg8::StaticOrder, true, true>(lds, g, S, E); }
#endif
#ifdef REP_P5
    grid.sync();
    FRESH_TID();
    { pg8::Gemm g{MIXED, (const bf16_t*)(ws + WS_WOUTT), T, DM, DM}; pg8::StaticOrder S; S.init(T, DM, G, bid);
      pg8::EpiF32 E{a.out, DM, 0};
      pg8::gemm_phase<pg8::EpiF32, pg8::StaticOrder, true, true>(lds, g, S, E); }
#endif
    grid.sync();
    FRESH_TID();
#ifdef REP_P6
#pragma unroll 1
    for (int rep = 0; rep < 2; ++rep) { p_ln1_router(lds, a, bid, G, tid, wave, lane, rep == 0); if (rep == 0) grid.sync(); }
#else
    p_ln1_router(lds, a, bid, G, tid, wave, lane);
#endif
    grid.sync();
    FRESH_TID();
#ifndef SKIP_P7
    p_gather(a, bid, G, wave, lane);
#endif
#ifdef REP_P7
    grid.sync();
    FRESH_TID();
    p_gather(a, bid, G, wave, lane);
#endif
    grid.sync();
    FRESH_TID();
#ifndef SKIP_P8
    { pg8::Gemm g{(const bf16_t*)(ws + WS_XG), (const bf16_t*)(ws + WS_W13T), MAXROWS, NE * DM, DM}; pg8::ExpertOrder S{(const int*)(ws + WS_CTL), G, bid};
      pg8::EpiExp1 E{(bf16_t*)(ws + WS_HID)};
      pg8::gemm_phase<pg8::EpiExp1, pg8::ExpertOrder, true, true>(lds, g, S, E); }
#endif
#ifdef REP_P8
    grid.sync();
    FRESH_TID();
    { pg8::Gemm g{(const bf16_t*)(ws + WS_XG), (const bf16_t*)(ws + WS_W13T), MAXROWS, NE * DM, DM}; pg8::ExpertOrder S{(const int*)(ws + WS_CTL), G, bid};
      pg8::EpiExp1 E{(bf16_t*)(ws + WS_HID)};
      pg8::gemm_phase<pg8::EpiExp1, pg8::ExpertOrder, true, true>(lds, g, S, E); }
#endif
    grid.sync();
    FRESH_TID();
#ifndef SKIP_P9
    { pg8::Gemm g{(const bf16_t*)(ws + WS_HID), (const bf16_t*)(ws + WS_W2T), MAXROWS, NE * DM, DE}; pg8::ExpertOrder S{(const int*)(ws + WS_CTL), G, bid};
      pg8::EpiY E{(bf16_t*)(ws + WS_Y)};
      pg8::gemm_phase<pg8::EpiY, pg8::ExpertOrder, true, true>(lds, g, S, E); }
#endif
#ifdef REP_P9
    grid.sync();
    FRESH_TID();
    { pg8::Gemm g{(const bf16_t*)(ws + WS_HID), (const bf16_t*)(ws + WS_W2T), MAXROWS, NE * DM, DE}; pg8::ExpertOrder S{(const int*)(ws + WS_CTL), G, bid};
      pg8::EpiY E{(bf16_t*)(ws + WS_Y)};
      pg8::gemm_phase<pg8::EpiY, pg8::ExpertOrder, true, true>(lds, g, S, E); }
#endif
    grid.sync();
    FRESH_TID();
#ifdef REP_P10
    p_combine_ln2(a, bid, G, wave, lane, true);
    grid.sync();
    FRESH_TID();
#endif
#ifndef SKIP_P10
    p_combine_ln2(a, bid, G, wave, lane);
#endif
}

extern "C" void kernel_launch(void* const* d_in, const int* in_sizes, int n_in, void* d_out, int out_size, void* d_ws, size_t ws_size, hipStream_t stream) {
    static int grid = 0;
    if (grid == 0) {
        if (n_in != 26 || ws_size < WS_END) { fprintf(stderr, "kernel_launch: unexpected n_in %d or workspace %zu < %zu\n", n_in, ws_size, (size_t)WS_END); grid = -1; return; }
        int dev = 0, cus = 0, per_cu = 0;
        if (hipGetDevice(&dev) != hipSuccess || hipDeviceGetAttribute(&cus, hipDeviceAttributeMultiprocessorCount, dev) != hipSuccess) { grid = -1; return; }
        if (hipFuncSetAttribute((const void*)mega, hipFuncAttributeMaxDynamicSharedMemorySize, LDS_BYTES) != hipSuccess) { fprintf(stderr, "kernel_launch: hipFuncSetAttribute failed\n"); grid = -1; return; }
        if (hipOccupancyMaxActiveBlocksPerMultiprocessor(&per_cu, (const void*)mega, NTHREADS, LDS_BYTES) != hipSuccess || per_cu < 1) { fprintf(stderr, "kernel_launch: occupancy query says %d\n", per_cu); per_cu = 1; }
        (void)hipGetLastError();
        grid = cus;
        fprintf(stderr, "kernel_launch: grid %d (cus %d, per_cu %d), ws %zu\n", grid, cus, per_cu, ws_size);
    }
    if (grid < 0) return;
    (void)hipMemsetAsync(d_ws, 0, 16384, stream);
    Args a{};
    for (int i = 0; i < 26; ++i) a.in[i] = (const float*)d_in[i];
    a.out = (float*)d_out; a.ws = (unsigned char*)d_ws;
    void* params[] = {&a};
    hipError_t e = hipLaunchCooperativeKernel((const void*)mega, dim3(grid), dim3(NTHREADS), params, LDS_BYTES, stream);
    if (e != hipSuccess) fprintf(stderr, "kernel_launch: cooperative launch failed: %s (grid %d)\n", hipGetErrorString(e), grid);
}
```

```cpp
#include <hip/hip_runtime.h>
#include <hip/hip_cooperative_groups.h>
#include <cstdio>
#include <cstdint>
namespace cg = cooperative_groups;

typedef unsigned short bf16_t;
typedef short bf16x8 __attribute__((ext_vector_type(8)));
typedef float f32x4 __attribute__((ext_vector_type(4)));
typedef float f32x2 __attribute__((ext_vector_type(2)));
typedef unsigned u32x4 __attribute__((ext_vector_type(4)));
typedef unsigned u32x2 __attribute__((ext_vector_type(2)));
typedef int i32x4 __attribute__((ext_vector_type(4)));
#define LAS __attribute__((address_space(3)))

constexpr int NB = 16, SEQ = 4096, LC = 256, DM = 1024;
constexpr int T = NB * SEQ;
constexpr int TC = NB * LC;
constexpr int TA = T + TC;
constexpr int NIN = 3584;
constexpr int NE = 32, DE = 512;
constexpr int MAXROWS = 2 * T + NE * 256;
constexpr float ALPHA = 1.189207115002721f;
constexpr float LN_EPS = 1e-6f;
constexpr int NTHREADS = 512;

constexpr size_t MiB = 1u << 20;
constexpr size_t WS_CTL = 0;
constexpr size_t WS_BAR = 65536;
constexpr size_t WS_MOD = 1 * MiB;
constexpr size_t WS_EIDX = 3 * MiB;
constexpr size_t WS_EPOS = 3 * MiB + 512 * 1024;
constexpr size_t WS_EW = 4 * MiB;
constexpr size_t WS_DEST = 4 * MiB + 512 * 1024;
constexpr size_t WS_WINT = 6 * MiB;
constexpr size_t WS_WOUTT = 13 * MiB;
constexpr size_t WS_W13T = 15 * MiB;
constexpr size_t WS_W2T = 79 * MiB;
constexpr size_t WS_U = 112 * MiB;
constexpr size_t WS_PROJ = 248 * MiB;
constexpr size_t WS_XG = 248 * MiB;
constexpr size_t WS_HID = 520 * MiB;
constexpr size_t WS_Y = 656 * MiB;
constexpr size_t WS_MIXED = 724 * MiB;
constexpr size_t WS_OSUM = 852 * MiB;
constexpr size_t WS_END = 980 * MiB;
constexpr int LDS_BYTES = 163840;

__device__ __forceinline__ float bf2f(bf16_t b) { return __uint_as_float(((unsigned)b) << 16); }
__device__ __forceinline__ bf16_t f2bf(float f) { unsigned u = __float_as_uint(f); return (bf16_t)((u + 0x7fffu + ((u >> 16) & 1u)) >> 16); }
__device__ __forceinline__ unsigned pk2(float lo, float hi) { return (unsigned)f2bf(lo) | ((unsigned)f2bf(hi) << 16); }
__device__ __forceinline__ float frcp(float x) { return __builtin_amdgcn_rcpf(x); }
__device__ __forceinline__ float sigmoidf_(float x) { return frcp(1.0f + __expf(-x)); }
__device__ __forceinline__ float siluf_(float x) { return x * frcp(1.0f + __expf(-x)); }
__device__ __forceinline__ float gelu_tanh(float x) {
    const float y = 0.7978845608028654f * (x + 0.044715f * x * x * x);
    return x * frcp(1.0f + __expf(-2.0f * y));
}
__device__ __forceinline__ float softplusf_(float x) { return fmaxf(x, 0.f) + log1pf(expf(-fabsf(x))); }
__device__ __forceinline__ float wave_sum(float v) {
#pragma unroll
    for (int o = 1; o < 64; o <<= 1) v += __shfl_xor(v, o);
    return v;
}
constexpr int CSTR = 64;
__device__ __forceinline__ int pstart_of(const int* __restrict__ counts, int e) {
    int acc = 0;
    for (int i = 0; i < NE; ++i) { const int p = ((counts[i * CSTR] + 255) >> 8) << 8; if (i < e) acc += p; }
    return acc;
}

namespace pg8 {
#define PG8_LAS __attribute__((address_space(3)))
typedef unsigned short bf16_t;
typedef short bf16x8 __attribute__((ext_vector_type(8)));
typedef float f32x4 __attribute__((ext_vector_type(4)));
typedef unsigned u32x4 __attribute__((ext_vector_type(4)));
constexpr int BM = 256, BK = 64, HALF = 128, HTB = HALF * BK * 2  , STAGE_BYTES = 8 * HTB, NXCD = 8, WGM = 8;

__host__ __device__ __forceinline__ int lds_byte(int r, int c) { const int st = (r >> 4) * 2 + (c >> 5), rr = r & 15, cc = c & 31, ob = rr * 64 + cc * 2; return st * 1024 + (ob ^ (((ob >> 9) & 1) << 5)); }
__host__ __device__ __forceinline__ void stage_rc(int b, int& R, int& C) { const int st = b / 1024, sb = b % 1024, swz = sb ^ (((sb >> 9) & 1) << 5); R = (st >> 1) * 16 + swz / 64; C = (st & 1) * 32 + (swz % 64) / 2; }
__host__ __device__ __forceinline__ int perm32(int rho) { const int n = rho >> 4, i = rho & 15; return 8 * (i >> 2) + 4 * n + (i & 3); }

struct Unit { int pm, pn; };
struct Gemm { const bf16_t* A; const bf16_t* Bt; int M, N, K; };

struct StaticOrder {
    int nM, nN, nwg, G, c;
    __host__ __device__ void init(int M, int N, int G_, int c_) { nM = M / BM; nN = N / BM; nwg = nM * nN; G = G_; c = c_; }
    __host__ __device__ bool next(int i, Unit& u) const {
        const long L = (long)i * G + c; if (L >= nwg) return false;
        int wgid = (int)L; { const int q = nwg / NXCD, r = nwg % NXCD, xcd = wgid % NXCD, off = wgid / NXCD; wgid = (xcd < r ? xcd * (q + 1) : r * (q + 1) + (xcd - r) * q) + off; }
        const int nig = WGM * nN, gid = wgid / nig, fm = gid * WGM, gsz = (nM - fm) < WGM ? (nM - fm) : WGM;
        u.pm = fm + ((wgid % nig) % gsz); u.pn = (wgid % nig) / gsz; return true;
    }
    __device__ __forceinline__ void a_ready(const Unit&) const {}
    __device__ __forceinline__ void done(const Unit&) const {}
};

__device__ __forceinline__ unsigned cvt_pk_bf16(float lo, float hi) { unsigned r; asm volatile("v_cvt_pk_bf16_f32 %0, %1, %2" : "=v"(r) : "v"(lo), "v"(hi)); return r; }

struct EpiInProj {
    static constexpr bool PERM = true, AFTER_DRAIN = false;
    bf16_t* P;
    __device__ __forceinline__ void operator()(const f32x4 (&acc)[2][2][4][2], const Unit& u, int wr, int wc, int fr_, int fq_) const {
        int fr = fr_, fq = fq_; asm volatile("" : "+v"(fr), "+v"(fq));
        const int row0 = u.pm * BM + wr * 64 + fr, col0 = u.pn * BM + wc * 32 + 8 * fq, grp = u.pn >> 1;
#pragma unroll
        for (int ai = 0; ai < 2; ++ai)
#pragma unroll
            for (int m = 0; m < 4; ++m) { bf16_t* rowp = P + (size_t)(row0 + ai * HALF + m * 16) * NIN + col0;
#pragma unroll
                for (int bj = 0; bj < 2; ++bj) { f32x4 v0 = acc[ai][bj][m][0], v1 = acc[ai][bj][m][1];
                    if (grp == 1) {
#pragma unroll
                        for (int j = 0; j < 4; ++j) { v0[j] = gelu_tanh(v0[j]); v1[j] = gelu_tanh(v1[j]); } }
                    else if (grp == 2 || grp == 6) {
#pragma unroll
                        for (int j = 0; j < 4; ++j) { v0[j] = siluf_(v0[j]); v1[j] = siluf_(v1[j]); } }
                    u32x4 w; w.x = cvt_pk_bf16(v0[0], v0[1]); w.y = cvt_pk_bf16(v0[2], v0[3]); w.z = cvt_pk_bf16(v1[0], v1[1]); w.w = cvt_pk_bf16(v1[2], v1[3]);
                    *(u32x4*)(rowp + bj * HALF) = w; } }
    }
};
struct EpiF32 {
    static constexpr bool PERM = false, AFTER_DRAIN = false;
    float* C; int ldc; int pad;
    __device__ __forceinline__ void operator()(const f32x4 (&acc)[2][2][4][2], const Unit& u, int wr, int wc, int fr_, int fq_) const {
        int fr = fr_, fq = fq_; asm volatile("" : "+v"(fr), "+v"(fq));
        const int row0 = u.pm * BM + wr * 64 + fr, col0 = u.pn * BM + wc * 32 + 4 * fq;
#pragma unroll
        for (int ai = 0; ai < 2; ++ai)
#pragma unroll
            for (int m = 0; m < 4; ++m) { float* rowp = C + (size_t)(row0 + ai * HALF + m * 16) * ldc + col0;
#pragma unroll
                for (int bj = 0; bj < 2; ++bj)
#pragma unroll
                    for (int n = 0; n < 2; ++n) *(f32x4*)(rowp + bj * HALF + n * 16) = acc[ai][bj][m][n]; }
    }
};
struct EpiExp1 {
    static constexpr bool PERM = false, AFTER_DRAIN = false;
    bf16_t* H;
    __device__ __forceinline__ void operator()(const f32x4 (&acc)[2][2][4][2], const Unit& u, int wr, int wc, int fr_, int fq_) const {
        int fr = fr_, fq = fq_; asm volatile("" : "+v"(fr), "+v"(fq));
        const int row0 = u.pm * BM + wr * 64 + fr, hc0 = (((u.pn & 3) * BM + wc * 32) >> 1) + 4 * fq;
#pragma unroll
        for (int ai = 0; ai < 2; ++ai)
#pragma unroll
            for (int m = 0; m < 4; ++m) { bf16_t* rowp = H + (size_t)(row0 + ai * HALF + m * 16) * DE + hc0;
#pragma unroll
                for (int bj = 0; bj < 2; ++bj) { const f32x4 a = acc[ai][bj][m][0], b = acc[ai][bj][m][1];
                    u32x2 w; w.x = cvt_pk_bf16(siluf_(a[0]) * b[0], siluf_(a[1]) * b[1]); w.y = cvt_pk_bf16(siluf_(a[2]) * b[2], siluf_(a[3]) * b[3]);
                    *(u32x2*)(rowp + bj * 64) = w; } }
    }
};
struct EpiY {
    static constexpr bool PERM = true, AFTER_DRAIN = false;
    bf16_t* Y;
    __device__ __forceinline__ void operator()(const f32x4 (&acc)[2][2][4][2], const Unit& u, int wr, int wc, int fr_, int fq_) const {
        int fr = fr_, fq = fq_; asm volatile("" : "+v"(fr), "+v"(fq));
        const int row0 = u.pm * BM + wr * 64 + fr, col0 = (u.pn & 3) * BM + wc * 32 + 8 * fq;
#pragma unroll
        for (int ai = 0; ai < 2; ++ai)
#pragma unroll
            for (int m = 0; m < 4; ++m) { bf16_t* rowp = Y + (size_t)(row0 + ai * HALF + m * 16) * DM + col0;
#pragma unroll
                for (int bj = 0; bj < 2; ++bj) { const f32x4 v0 = acc[ai][bj][m][0], v1 = acc[ai][bj][m][1];
                    u32x4 w; w.x = cvt_pk_bf16(v0[0], v0[1]); w.y = cvt_pk_bf16(v0[2], v0[3]); w.z = cvt_pk_bf16(v1[0], v1[1]); w.w = cvt_pk_bf16(v1[2], v1[3]);
                    *(u32x4*)(rowp + bj * HALF) = w; } }
    }
};
struct ExpertOrder {
    const int* counts; int G, c;
    __device__ __forceinline__ bool next(int i, Unit& u) const {
        const int L = i * G + c, rb = L >> 2; int acc = 0, ef = -1;
        for (int e = 0; e < NE; ++e) { const int nb = (counts[e * CSTR] + 255) >> 8; if (rb >= acc && rb < acc + nb) ef = e; acc += nb; }
        if (ef < 0) return false;
        u.pm = rb; u.pn = ef * 4 + (L & 3); return true;
    }
    __device__ __forceinline__ void a_ready(const Unit&) const {}
    __device__ __forceinline__ void done(const Unit&) const {}
};

template <class Epi, class Sched, bool ALIGN_EPI = false, bool SP2 = false>
__device__ __forceinline__ void gemm_phase(PG8_LAS unsigned char* lds, const Gemm g, const Sched& S, const Epi& E) {
    int tid_o = threadIdx.x; asm volatile("" : "+v"(tid_o));
    const int tid = tid_o, wid = __builtin_amdgcn_readfirstlane(tid >> 6), lane = tid & 63, wr = wid >> 2, wc = wid & 3, fr = lane & 15, fq = lane >> 4;
    const int K = g.K, nt = K / BK;
    unsigned voffA[2], voffB[2];
#pragma unroll
    for (int i = 0; i < 2; ++i) { int R, C; stage_rc(tid * 16 + i * 8192, R, C); const int Rb = Epi::PERM ? ((R & ~31) + perm32(R & 31)) : R;
        voffA[i] = (unsigned)(R * K + C) * 2u; voffB[i] = (unsigned)(Rb * K + C) * 2u; }
    const size_t kstep = (size_t)(BK * 2);
    const size_t hstep = (size_t)HALF * K * 2;
    const size_t tstep = 2 * hstep;
    const unsigned ldsw = (unsigned)wid * 1024u;
    const int aoff = lds_byte(wr * 64 + fr, fq * 8), boff = lds_byte(wc * 32 + fr, fq * 8);
#define PG8_SA(b, h) (((b) * 2 + (h)) * HTB)
#define PG8_SB(b, h) ((4 + (b) * 2 + (h)) * HTB)
#define PG8_STAGE(bufoff, gbase, voff) do { _Pragma("unroll") for (int _i = 0; _i < 2; ++_i) \
        __builtin_amdgcn_global_load_lds((const unsigned*)((const char*)(gbase) + (voff)[_i]), (PG8_LAS unsigned*)(lds + (bufoff) + ldsw + _i * 8192), 16, 0, 0); } while (0)
#define PG8_LDA(dst, b, h) do { _Pragma("unroll") for (int m = 0; m < 4; ++m) _Pragma("unroll") for (int k = 0; k < 2; ++k) dst[m][k] = *(const PG8_LAS bf16x8*)(lds + PG8_SA(b, h) + aoff + m * 2048 + k * 1024); } while (0)
#define PG8_LDB(dst, b, h) do { _Pragma("unroll") for (int n = 0; n < 2; ++n) _Pragma("unroll") for (int k = 0; k < 2; ++k) dst[n][k] = *(const PG8_LAS bf16x8*)(lds + PG8_SB(b, h) + boff + n * 2048 + k * 1024); } while (0)
#define PG8_MMA(ai, bj, At, Bt) do { __builtin_amdgcn_s_setprio(1); _Pragma("unroll") for (int m = 0; m < 4; ++m) _Pragma("unroll") for (int n = 0; n < 2; ++n) _Pragma("unroll") for (int k = 0; k < 2; ++k) \
        acc[ai][bj][m][n] = __builtin_amdgcn_mfma_f32_16x16x32_bf16(Bt[n][k], At[m][k], acc[ai][bj][m][n], 0, 0, 0); __builtin_amdgcn_s_setprio(0); } while (0)
#define PG8_WAIT_V(n) asm volatile("s_waitcnt vmcnt(" #n ")" ::: "memory")
#define PG8_WAIT_L(n) asm volatile("s_waitcnt lgkmcnt(" #n ")" ::: "memory")
#define PG8_BAR __builtin_amdgcn_s_barrier()
#define PG8_SCHED __builtin_amdgcn_sched_barrier(0)
    Unit cur, nxt; int ui = 0;
    if (!S.next(0, cur)) return;
    f32x4 acc[2][2][4][2];
#pragma unroll
    for (int a = 0; a < 2; ++a)
#pragma unroll
        for (int b = 0; b < 2; ++b)
#pragma unroll
            for (int m = 0; m < 4; ++m)
#pragma unroll
                for (int n = 0; n < 2; ++n) acc[a][b][m][n] = (f32x4){0.f, 0.f, 0.f, 0.f};
    bf16x8 At[4][2], B0[2][2], B1[2][2];
    const char* cA = (const char*)g.A + (size_t)cur.pm * tstep; const char* cB = (const char*)g.Bt + (size_t)cur.pn * tstep;
    S.a_ready(cur);
    if constexpr (SP2) {
        PG8_STAGE(PG8_SB(0, 0), cB, voffB); PG8_STAGE(PG8_SB(0, 1), cB + hstep, voffB); PG8_STAGE(PG8_SA(0, 0), cA, voffA); PG8_STAGE(PG8_SA(0, 1), cA + hstep, voffA);
        if (wr == 1) PG8_BAR;
        PG8_WAIT_V(2); PG8_BAR;
        PG8_STAGE(PG8_SB(1, 0), cB + kstep, voffB); PG8_STAGE(PG8_SA(1, 0), cA + kstep, voffA); PG8_STAGE(PG8_SB(1, 1), cB + hstep + kstep, voffB);
        PG8_WAIT_V(6); PG8_BAR;
    } else {
        PG8_STAGE(PG8_SB(0, 0), cB, voffB); PG8_STAGE(PG8_SA(0, 0), cA, voffA); PG8_STAGE(PG8_SB(0, 1), cB + hstep, voffB); PG8_STAGE(PG8_SA(0, 1), cA + hstep, voffA);
        if (wr == 1) PG8_BAR;
        PG8_WAIT_V(4); PG8_BAR;
        PG8_STAGE(PG8_SB(1, 0), cB + kstep, voffB); PG8_STAGE(PG8_SA(1, 0), cA + kstep, voffA); PG8_STAGE(PG8_SB(1, 1), cB + hstep + kstep, voffB);
        PG8_WAIT_V(6); PG8_BAR;
    }
    for (;;) {
        const bool has_next = S.next(ui + 1, nxt);
        const char* nA = has_next ? (const char*)g.A + (size_t)nxt.pm * tstep : cA; const char* nB = has_next ? (const char*)g.Bt + (size_t)nxt.pn * tstep : cB;
        for (int t = 0; t < nt; t += 2) {
            const bool last = (t == nt - 2);
            const char* a1 = cA + (size_t)(t + 1) * kstep;
            const char* a2 = last ? nA : cA + (size_t)(t + 2) * kstep; const char* b2 = last ? nB : cB + (size_t)(t + 2) * kstep;
            const char* a3 = a2 + kstep; const char* b3 = b2 + kstep;
            if (last && has_next) S.a_ready(nxt);
            if constexpr (SP2) {
            PG8_LDB(B0, 0, 0); PG8_LDB(B1, 0, 1); PG8_SCHED; PG8_LDA(At, 0, 0); PG8_STAGE(PG8_SA(1, 1), a1 + hstep, voffA);
            PG8_WAIT_V(8); PG8_WAIT_L(0); PG8_BAR; PG8_MMA(0, 0, At, B0); PG8_MMA(0, 1, At, B1); PG8_BAR; PG8_SCHED;
            PG8_LDA(At, 0, 1); PG8_STAGE(PG8_SB(0, 0), b2, voffB); PG8_STAGE(PG8_SB(0, 1), b2 + hstep, voffB); PG8_STAGE(PG8_SA(0, 0), a2, voffA);
            PG8_WAIT_V(8); PG8_WAIT_L(0); PG8_BAR; PG8_MMA(1, 0, At, B0); PG8_MMA(1, 1, At, B1); PG8_BAR; PG8_SCHED;
            PG8_LDB(B0, 1, 0); PG8_LDB(B1, 1, 1); PG8_SCHED; PG8_LDA(At, 1, 0); PG8_STAGE(PG8_SA(0, 1), a2 + hstep, voffA);
            PG8_WAIT_V(8); PG8_WAIT_L(0); PG8_BAR; PG8_MMA(0, 0, At, B0); PG8_MMA(0, 1, At, B1); PG8_BAR; PG8_SCHED;
            PG8_LDA(At, 1, 1); PG8_STAGE(PG8_SB(1, 0), b3, voffB); PG8_STAGE(PG8_SB(1, 1), b3 + hstep, voffB); PG8_STAGE(PG8_SA(1, 0), a3, voffA);
            PG8_WAIT_V(8); PG8_WAIT_L(0); PG8_BAR; PG8_MMA(1, 0, At, B0); PG8_MMA(1, 1, At, B1); PG8_BAR; PG8_SCHED;
            } else {
            PG8_LDB(B0, 0, 0); PG8_SCHED; PG8_LDA(At, 0, 0); PG8_STAGE(PG8_SA(1, 1), a1 + hstep, voffA);
            PG8_WAIT_L(8); PG8_BAR; PG8_WAIT_L(0); PG8_MMA(0, 0, At, B0); PG8_BAR; PG8_SCHED;
            PG8_LDB(B1, 0, 1); PG8_STAGE(PG8_SB(0, 0), b2, voffB);
            PG8_BAR; PG8_WAIT_L(0); PG8_MMA(0, 1, At, B1); PG8_BAR;
            PG8_LDA(At, 0, 1); PG8_STAGE(PG8_SA(0, 0), a2, voffA);
            PG8_BAR; PG8_WAIT_L(0); PG8_MMA(1, 0, At, B0); PG8_BAR; PG8_SCHED;
            PG8_STAGE(PG8_SB(0, 1), b2 + hstep, voffB);
            PG8_WAIT_V(6); PG8_BAR; PG8_MMA(1, 1, At, B1); PG8_BAR;
            PG8_LDB(B0, 1, 0); PG8_SCHED; PG8_LDA(At, 1, 0); PG8_STAGE(PG8_SA(0, 1), a2 + hstep, voffA);
            PG8_WAIT_L(8); PG8_BAR; PG8_WAIT_L(0); PG8_MMA(0, 0, At, B0); PG8_BAR; PG8_SCHED;
            PG8_LDB(B1, 1, 1); PG8_STAGE(PG8_SB(1, 0), b3, voffB);
            PG8_BAR; PG8_WAIT_L(0); PG8_MMA(0, 1, At, B1); PG8_BAR;
            PG8_LDA(At, 1, 1); PG8_STAGE(PG8_SA(1, 0), a3, voffA);
            PG8_BAR; PG8_WAIT_L(0); PG8_MMA(1, 0, At, B0); PG8_BAR; PG8_SCHED;
            PG8_STAGE(PG8_SB(1, 1), b3 + hstep, voffB);
            PG8_WAIT_V(6); PG8_BAR; PG8_MMA(1, 1, At, B1); PG8_BAR;
            }
        }
        if constexpr (ALIGN_EPI) { if (wr == 0) PG8_BAR; }
        if constexpr (!Epi::AFTER_DRAIN) { E(acc, cur, wr, wc, fr, fq); S.done(cur); }
        if (!has_next) break;
#pragma unroll
        for (int a = 0; a < 2; ++a)
#pragma unroll
            for (int b = 0; b < 2; ++b)
#pragma unroll
                for (int m = 0; m < 4; ++m)
#pragma unroll
                    for (int n = 0; n < 2; ++n) acc[a][b][m][n] = (f32x4){0.f, 0.f, 0.f, 0.f};
        cur = nxt; cA = nA; cB = nB; ++ui;
        if constexpr (ALIGN_EPI) { if (wr == 1) PG8_BAR; }
    }
    PG8_WAIT_V(0);
    if constexpr (!ALIGN_EPI) { if (wr == 0) PG8_BAR; }
    PG8_BAR;
    if constexpr (Epi::AFTER_DRAIN) { E.fused(acc, cur, wr, wc, fr, fq, lds, wid, lane); S.done(cur); }
#undef PG8_SA
#undef PG8_SB
#undef PG8_STAGE
#undef PG8_LDA
#undef PG8_LDB
#undef PG8_MMA
#undef PG8_WAIT_V
#undef PG8_WAIT_L
#undef PG8_BAR
#undef PG8_SCHED
}
}

struct Args { const float* in[26]; float* out; unsigned char* ws; };

__device__ __forceinline__ void p_mod(LAS unsigned char* lds, const float* __restrict__ c, const float* __restrict__ c_ctx, const float* __restrict__ ada_w,
                                      const float* __restrict__ ada_b, float* __restrict__ mod, int bid, int G, int tid) {
    if (bid >= 96) return;
    LAS float* s = (LAS float*)lds;
    LAS float* red = s + 17 * 1024;
    for (int i = tid; i < 17 * 1024; i += NTHREADS) { const int r = i >> 10, k = i & 1023; const float v = r < NB ? c[r * DM + k] : c_ctx[k]; s[i] = v / (1.0f + expf(-v)); }
    __syncthreads();
    for (int it = bid; it < 96; it += G) {
        const int cc = tid & 63, kg = tid >> 6, col = it * 64 + cc;
        float acc[17];
#pragma unroll
        for (int r = 0; r < 17; ++r) acc[r] = 0.f;
        for (int k = kg * 128; k < kg * 128 + 128; ++k) {
            const float w = ada_w[(size_t)k * 6144 + col];
#pragma unroll
            for (int r = 0; r < 17; ++r) acc[r] += s[r * 1024 + k] * w;
        }
#pragma unroll
        for (int r = 0; r < 17; ++r) red[(kg * 17 + r) * 64 + cc] = acc[r];
        __syncthreads();
        for (int i = tid; i < 17 * 64; i += NTHREADS) {
            const int r = i >> 6, c2 = i & 63; float sum = 0.f;
#pragma unroll
            for (int g = 0; g < 8; ++g) sum += red[(g * 17 + r) * 64 + c2];
            mod[(size_t)r * 6144 + it * 64 + c2] = sum + ada_b[it * 64 + c2];
        }
        __syncthreads();
    }
}

__device__ __forceinline__ void transpose_tile(LAS float* tile, const float* __restrict__ W, int K, int N, bf16_t* __restrict__ O, int mode, int k0, int n0, int tid) {
    for (int i = tid; i < 64 * 64; i += NTHREADS) { const int kk = i >> 6, nn = i & 63; tile[kk * 65 + nn] = W[(size_t)(k0 + kk) * N + n0 + nn]; }
    __syncthreads();
    for (int i = tid; i < 64 * 32; i += NTHREADS) {
        const int nn = i >> 5, kp = i & 31, n = n0 + nn;
        const int orow = mode == 0 ? n : ((n >> 4) * 32 + (mode == 2 ? 16 : 0) + (n & 15));
        *(unsigned*)(O + (size_t)orow * K + k0 + 2 * kp) = pk2(tile[(2 * kp) * 65 + nn], tile[(2 * kp + 1) * 65 + nn]);
    }
    __syncthreads();
}
__device__ __forceinline__ void p_transposes(LAS unsigned char* lds, const Args& a, int bid, int G, int tid) {
    LAS float* tile = (LAS float*)lds;
    unsigned char* ws = a.ws;
    constexpr int I_IN = 16 * 56, I_OUT = 16 * 16, I_E = 32 * 128;
    constexpr int NITEMS = I_IN + I_OUT + 3 * I_E;
    for (int it = bid; it < NITEMS; it += G) {
        int r = it;
        if (r < I_IN) { transpose_tile(tile, a.in[6], DM, NIN, (bf16_t*)(ws + WS_WINT), 0, (r & 15) * 64, (r >> 4) * 64, tid); continue; } r -= I_IN;
        if (r < I_OUT) { transpose_tile(tile, a.in[14], DM, DM, (bf16_t*)(ws + WS_WOUTT), 0, (r & 15) * 64, (r >> 4) * 64, tid); continue; } r -= I_OUT;
        if (r < I_E) { const int e = r >> 7, q = r & 127; transpose_tile(tile, a.in[21] + (size_t)e * DM * DE, DM, DE, (bf16_t*)(ws + WS_W13T) + (size_t)e * DM * DM, 1, (q & 15) * 64, (q >> 4) * 64, tid); continue; } r -= I_E;
        if (r < I_E) { const int e = r >> 7, q = r & 127; transpose_tile(tile, a.in[22] + (size_t)e * DM * DE, DM, DE, (bf16_t*)(ws + WS_W13T) + (size_t)e * DM * DM, 2, (q & 15) * 64, (q >> 4) * 64, tid); continue; } r -= I_E;
        { const int e = r >> 7, q = r & 127; transpose_tile(tile, a.in[23] + (size_t)e * DE * DM, DE, DM, (bf16_t*)(ws + WS_W2T) + (size_t)e * DM * DE, 0, (q & 7) * 64, (q >> 3) * 64, tid); }
    }
}

__device__ __forceinline__ void p_u(const float* __restrict__ x, const float* __restrict__ ctx, const float* __restrict__ mod, bf16_t* __restrict__ U, int bid, int G, int tid) {
    for (size_t i4 = (size_t)bid * NTHREADS + tid; i4 < (size_t)TA * 256; i4 += (size_t)G * NTHREADS) {
        const int row = (int)(i4 >> 8), c4 = (int)(i4 & 255) * 4;
        const float* src; const float* m;
        if (row < T) { src = x + (size_t)row * DM; m = mod + (size_t)(row / SEQ) * 6144; }
        else { src = ctx + (size_t)(row - T) * DM; m = mod + (size_t)16 * 6144; }
        const f32x4 v = *(const f32x4*)(src + c4), sh = *(const f32x4*)(m + c4), sc = *(const f32x4*)(m + 1024 + c4);
        u32x2 w; w.x = pk2(v[0] * (1.f + sc[0]) + sh[0], v[1] * (1.f + sc[1]) + sh[1]); w.y = pk2(v[2] * (1.f + sc[2]) + sh[2], v[3] * (1.f + sc[3]) + sh[3]);
        *(u32x2*)(U + (size_t)row * DM + c4) = w;
    }
}

__device__ __forceinline__ void router_decide(const float (&pl)[36], int slot, int lane, LAS int* lcnt, LAS i32x4* tinfo, LAS f32x2* tw) {
    int gi = 0; float gm = pl[0];
#pragma unroll
    for (int g = 1; g < 4; ++g) if (pl[g] > gm) { gm = pl[g]; gi = g; }
    float den = 0.f;
#pragma unroll
    for (int g = 0; g < 4; ++g) den += __expf(pl[g] - gm);
    const float gval = frcp(den);
    int j0 = -1; float v0 = -3.0e38f;
#pragma unroll
    for (int j = 0; j < 32; ++j) { const bool in = (j >> 3) == gi; if (in && (j0 < 0 || pl[4 + j] > v0)) { v0 = pl[4 + j]; j0 = j; } }
    int j1 = -1; float v1 = -3.0e38f;
#pragma unroll
    for (int j = 0; j < 32; ++j) { const bool in = (j >> 3) == gi; if (in && j != j0 && (j1 < 0 || pl[4 + j] > v1)) { v1 = pl[4 + j]; j1 = j; } }
    if (lane == 0) {
        const float t = __expf(v1 - v0), w0 = frcp(1.0f + t), w1 = t * w0;
        const int p0 = __hip_atomic_fetch_add(lcnt + j0, 1, __ATOMIC_RELAXED, __HIP_MEMORY_SCOPE_WORKGROUP), p1 = __hip_atomic_fetch_add(lcnt + j1, 1, __ATOMIC_RELAXED, __HIP_MEMORY_SCOPE_WORKGROUP);
        tinfo[slot] = (i32x4){j0, j1, p0, p1}; tw[slot] = (f32x2){gval * w0, gval * w1};
    }
}
__device__ __forceinline__ void p_ln1_router(LAS unsigned char* lds, const Args& a, int bid, int G, int tid, int wave, int lane, bool dry = false) {
    const float* __restrict__ x = a.in[0]; const float* yo = a.out; float* h1o = dry ? (float*)(a.ws + WS_XG) : a.out; const float* mod = (const float*)(a.ws + WS_MOD);
    const float* __restrict__ ln_g = a.in[15]; const float* __restrict__ ln_b = a.in[16];
    const float* __restrict__ rgw = a.in[17]; const float* __restrict__ rgb = a.in[18]; const float* __restrict__ rew = a.in[19]; const float* __restrict__ reb = a.in[20];
    bf16_t* U2 = (bf16_t*)(a.ws + (dry ? WS_HID : WS_U)); int* counts = (int*)(a.ws + WS_CTL) + (dry ? 32 * CSTR : 0);
    int2* eidx = (int2*)(a.ws + (dry ? WS_Y : WS_EIDX)); int2* epos = (int2*)(a.ws + (dry ? WS_Y + 4 * MiB : WS_EPOS)); float2* ew = (float2*)(a.ws + (dry ? WS_Y + 8 * MiB : WS_EW));
    LAS float* WT = (LAS float*)lds;
    for (int i = tid; i < 1024 * 4; i += NTHREADS) WT[(i & 3) * 1024 + (i >> 2)] = rgw[i];
    for (int i = tid; i < 1024 * 32; i += NTHREADS) WT[(4 + (i & 31)) * 1024 + (i >> 5)] = rew[i];
    LAS float* BIAS = WT + 36 * 1024;
    LAS int* lcnt = (LAS int*)(BIAS + 64);
    LAS int* lbase = lcnt + 32;
    LAS i32x4* tinfo = (LAS i32x4*)(lbase + 32);
    LAS f32x2* tw = (LAS f32x2*)(tinfo + 256);
    if (tid < 36) BIAS[tid] = tid < 4 ? rgb[tid] : reb[tid - 4];
    if (tid < 32) lcnt[tid] = 0;
    __syncthreads();
    int nslot = 0;
#pragma unroll 1
    for (int pr = bid * 8 + wave; pr < T / 2; pr += G * 8) {
        int l2 = lane; asm volatile("" : "+v"(l2)); const int lane = l2;
        const int tok0 = 2 * pr;
        const float* m = mod + (size_t)(tok0 / SEQ) * 6144;
        f32x4 v[2][4]; float s[2] = {0.f, 0.f};
#pragma unroll
        for (int t = 0; t < 2; ++t)
#pragma unroll
            for (int j = 0; j < 4; ++j) { const int c4 = 4 * lane + 256 * j;
                const f32x4 xv = *(const f32x4*)(x + (size_t)(tok0 + t) * DM + c4), yv = *(const f32x4*)(yo + (size_t)(tok0 + t) * DM + c4), g1 = *(const f32x4*)(m + 2048 + c4);
                v[t][j] = ALPHA * xv + g1 * yv; s[t] += (v[t][j][0] + v[t][j][1]) + (v[t][j][2] + v[t][j][3]); }
        float rstd[2];
#pragma unroll
        for (int t = 0; t < 2; ++t) { const float mean = wave_sum(s[t]) * (1.0f / DM); float s2 = 0.f;
#pragma unroll
            for (int j = 0; j < 4; ++j) { v[t][j] = v[t][j] - mean; s2 += (v[t][j][0] * v[t][j][0] + v[t][j][1] * v[t][j][1]) + (v[t][j][2] * v[t][j][2] + v[t][j][3] * v[t][j][3]); }
            rstd[t] = rsqrtf(wave_sum(s2) * (1.0f / DM) + LN_EPS); }
        float plA[36], plB[36];
#pragma unroll
        for (int e = 0; e < 36; ++e) { plA[e] = 0.f; plB[e] = 0.f; }
#pragma unroll
        for (int j = 0; j < 4; ++j) { const int c4 = 4 * lane + 256 * j;
            const f32x4 lg = *(const f32x4*)(ln_g + c4), lb = *(const f32x4*)(ln_b + c4), sc2 = *(const f32x4*)(m + 4096 + c4), sh2 = *(const f32x4*)(m + 3072 + c4);
            f32x4 u2[2];
#pragma unroll
            for (int t = 0; t < 2; ++t) { const f32x4 h1 = v[t][j] * rstd[t] * lg + lb;
                *(f32x4*)(h1o + (size_t)(tok0 + t) * DM + c4) = h1;
                u2[t] = h1 * (1.0f + sc2) + sh2;
                u32x2 w; w.x = pk2(u2[t][0], u2[t][1]); w.y = pk2(u2[t][2], u2[t][3]);
                *(u32x2*)(U2 + (size_t)(tok0 + t) * DM + c4) = w; }
#pragma unroll
            for (int e = 0; e < 36; ++e) { const f32x4 w4 = *(const LAS f32x4*)(WT + e * 1024 + c4);
                plA[e] += (u2[0][0] * w4[0] + u2[0][1] * w4[1]) + (u2[0][2] * w4[2] + u2[0][3] * w4[3]);
                plB[e] += (u2[1][0] * w4[0] + u2[1][1] * w4[1]) + (u2[1][2] * w4[2] + u2[1][3] * w4[3]);
                if ((e % 6) == 5) __builtin_amdgcn_sched_barrier(0); }
        }
#pragma unroll
        for (int e = 0; e < 36; ++e) { const float be = BIAS[e]; plA[e] = wave_sum(plA[e]) + be; plB[e] = wave_sum(plB[e]) + be; if ((e & 3) == 3) __builtin_amdgcn_sched_barrier(0); }
        router_decide(plA, wave * 32 + nslot, lane, lcnt, tinfo, tw);
        router_decide(plB, wave * 32 + nslot + 1, lane, lcnt, tinfo, tw);
        nslot += 2;
    }
    __syncthreads();
    if (tid < 32) lbase[tid] = atomicAdd(&counts[tid * CSTR], lcnt[tid]);
    __syncthreads();
    if (lane < nslot) {
        const int pr = bid * 8 + wave + (lane >> 1) * (G * 8), tok = 2 * pr + (lane & 1);
        const i32x4 ti = tinfo[wave * 32 + lane]; const f32x2 wv = tw[wave * 32 + lane];
        eidx[tok] = make_int2(ti[0], ti[1]); epos[tok] = make_int2(lbase[ti[0]] + ti[2], lbase[ti[1]] + ti[3]); ew[tok] = make_float2(wv[0], wv[1]);
    }
    __syncthreads();
}

__device__ __forceinline__ void p_gather(const Args& a, int bid, int G, int wave, int lane) {
    const bf16_t* U2 = (const bf16_t*)(a.ws + WS_U); const int* counts = (const int*)(a.ws + WS_CTL);
    const int2* eidx = (const int2*)(a.ws + WS_EIDX); const int2* epos = (const int2*)(a.ws + WS_EPOS); int2* dest = (int2*)(a.ws + WS_DEST);
    bf16_t* XG = (bf16_t*)(a.ws + WS_XG);
    for (int tok = bid * 8 + wave; tok < T; tok += G * 8) {
        const int2 ei = eidx[tok], ep = epos[tok];
        const int d0 = pstart_of(counts, ei.x) + ep.x, d1 = pstart_of(counts, ei.y) + ep.y;
        const u32x4 v0 = *(const u32x4*)(U2 + (size_t)tok * DM + lane * 8), v1 = *(const u32x4*)(U2 + (size_t)tok * DM + 512 + lane * 8);
        *(u32x4*)(XG + (size_t)d0 * DM + lane * 8) = v0; *(u32x4*)(XG + (size_t)d0 * DM + 512 + lane * 8) = v1;
        *(u32x4*)(XG + (size_t)d1 * DM + lane * 8) = v0; *(u32x4*)(XG + (size_t)d1 * DM + 512 + lane * 8) = v1;
        if (lane == 0) dest[tok] = make_int2(d0, d1);
    }
}

__device__ __forceinline__ void p_combine_ln2(const Args& a, int bid, int G, int wave, int lane, bool dry = false) {
    const float* out = a.out; float* outw = dry ? (float*)(a.ws + WS_XG) : a.out; const bf16_t* Y = (const bf16_t*)(a.ws + WS_Y); const int2* dest = (const int2*)(a.ws + WS_DEST); const float2* ew = (const float2*)(a.ws + WS_EW);
    const float* mod = (const float*)(a.ws + WS_MOD); const float* __restrict__ ln_g = a.in[24]; const float* __restrict__ ln_b = a.in[25];
    for (int tok = bid * 8 + wave; tok < T; tok += G * 8) {
        const float* m = mod + (size_t)(tok / SEQ) * 6144;
        const int2 d = dest[tok]; const float2 w = ew[tok];
        f32x4 v[4]; float s = 0.f;
#pragma unroll
        for (int j = 0; j < 4; ++j) { const int c4 = 4 * lane + 256 * j;
            const u32x2 ya = *(const u32x2*)(Y + (size_t)d.x * DM + c4), yb = *(const u32x2*)(Y + (size_t)d.y * DM + c4);
            f32x4 f;
            f[0] = w.x * __uint_as_float(ya.x << 16) + w.y * __uint_as_float(yb.x << 16);
            f[1] = w.x * __uint_as_float(ya.x & 0xffff0000u) + w.y * __uint_as_float(yb.x & 0xffff0000u);
            f[2] = w.x * __uint_as_float(ya.y << 16) + w.y * __uint_as_float(yb.y << 16);
            f[3] = w.x * __uint_as_float(ya.y & 0xffff0000u) + w.y * __uint_as_float(yb.y & 0xffff0000u);
            const f32x4 h1 = *(const f32x4*)(out + (size_t)tok * DM + c4), g2 = *(const f32x4*)(m + 5120 + c4);
            v[j] = ALPHA * h1 + g2 * f; s += (v[j][0] + v[j][1]) + (v[j][2] + v[j][3]); }
        const float mean = wave_sum(s) * (1.0f / DM); float s2 = 0.f;
#pragma unroll
        for (int j = 0; j < 4; ++j) { v[j] = v[j] - mean; s2 += (v[j][0] * v[j][0] + v[j][1] * v[j][1]) + (v[j][2] * v[j][2] + v[j][3] * v[j][3]); }
        const float rstd = rsqrtf(wave_sum(s2) * (1.0f / DM) + LN_EPS);
#pragma unroll
        for (int j = 0; j < 4; ++j) { const int c4 = 4 * lane + 256 * j;
            *(f32x4*)(outw + (size_t)tok * DM + c4) = v[j] * rstd * *(const f32x4*)(ln_g + c4) + *(const f32x4*)(ln_b + c4); }
    }
}

constexpr size_t WS_HGK = WS_U;
constexpr size_t WS_HGD = 852 * MiB;
constexpr size_t WS_RGAGG = 854 * MiB;
constexpr size_t WS_RGCARRY = 864 * MiB;
constexpr size_t WS_GWT = 870 * MiB;
constexpr size_t WS_OFST = 880 * MiB;
constexpr int RG_UNITS_PER_B = 68, HG_SEGS = 17;

__device__ __forceinline__ void lds_barrier() { asm volatile("s_waitcnt lgkmcnt(0)" ::: "memory"); __builtin_amdgcn_s_barrier(); asm volatile("" ::: "memory"); }
__device__ __forceinline__ bf16x8 mk_bf16x8(u32x4 v) { return __builtin_bit_cast(bf16x8, v); }
__device__ __forceinline__ float bf_lo(unsigned w) { return __uint_as_float(w << 16); }
__device__ __forceinline__ float bf_hi(unsigned w) { return __uint_as_float(w & 0xffff0000u); }
__device__ __forceinline__ unsigned cvt2(float lo, float hi) { unsigned r; asm volatile("v_cvt_pk_bf16_f32 %0, %1, %2" : "=v"(r) : "v"(lo), "v"(hi)); return r; }

__device__ __forceinline__ void p_gwt(const float* __restrict__ gate_w, bf16_t* __restrict__ gwt, int bid, int G, int tid) {
    for (int o = bid * NTHREADS + tid; o < 32 * 4096; o += G * NTHREADS) { const int mat = o >> 12, d = (o >> 6) & 63, c = o & 63; gwt[o] = f2bf(gate_w[mat * 4096 + c * 64 + d]); }
}

constexpr int XC_STRIDE = 1040;
constexpr int RG_XC = 0, RG_OUT = 64 * XC_STRIDE;
template <int MODE>
__device__ __forceinline__ void rg_unit(LAS unsigned char* lds, const Args& a, int b, int k, int tid, int wave, int lane) {
    const bf16_t* __restrict__ proj = (const bf16_t*)(a.ws + WS_PROJ);
    const float* __restrict__ conv_w = a.in[7]; const float* __restrict__ conv_b = a.in[8]; const float* __restrict__ gate_b = a.in[10]; const float* __restrict__ lam = a.in[11];
    const bf16_t* __restrict__ gwt = (const bf16_t*)(a.ws + WS_GWT);
    float* rgagg = (float*)(a.ws + WS_RGAGG); const float* rgcarry = (const float*)(a.ws + WS_RGCARRY);
    int rowbase, p0, lo, hi;
    if (k < 4) { rowbase = T + b * LC; p0 = k * 64; lo = 0; hi = LC; } else { rowbase = b * SEQ; p0 = (k - 4) * 64; lo = p0; hi = p0 + 64; }
    const int unit = b * RG_UNITS_PER_B + k;
    {
        const int cgp = tid & 63, tg = tid >> 6, c0 = cgp * 8, i0 = tg * 8;
        u32x4 raw[11];
#pragma unroll
        for (int r = 0; r < 11; ++r) { const int p = p0 + i0 - 1 + r;
            raw[r] = (p >= lo && p < hi) ? *(const u32x4*)(proj + (size_t)(rowbase + p) * NIN + c0) : (u32x4){0u, 0u, 0u, 0u}; }
        float cw[4][8], cb[8];
#pragma unroll
        for (int t4 = 0; t4 < 4; ++t4) { const f32x4 w0 = *(const f32x4*)(conv_w + t4 * 512 + c0), w1 = *(const f32x4*)(conv_w + t4 * 512 + c0 + 4);
#pragma unroll
            for (int q = 0; q < 4; ++q) { cw[t4][q] = w0[q]; cw[t4][4 + q] = w1[q]; } }
        { const f32x4 b0 = *(const f32x4*)(conv_b + c0), b1 = *(const f32x4*)(conv_b + c0 + 4);
#pragma unroll
            for (int q = 0; q < 4; ++q) { cb[q] = b0[q]; cb[4 + q] = b1[q]; } }
#pragma unroll
        for (int ii = 0; ii < 8; ++ii) {
            float xc[8];
#pragma unroll
            for (int c = 0; c < 8; ++c) xc[c] = cb[c];
#pragma unroll
            for (int t4 = 0; t4 < 4; ++t4) { const u32x4 rw = raw[ii + t4];
#pragma unroll
                for (int q = 0; q < 4; ++q) { xc[2 * q] += cw[t4][2 * q] * bf_lo(rw[q]); xc[2 * q + 1] += cw[t4][2 * q + 1] * bf_hi(rw[q]); } }
            u32x4 w; w.x = cvt2(xc[0], xc[1]); w.y = cvt2(xc[2], xc[3]); w.z = cvt2(xc[4], xc[5]); w.w = cvt2(xc[6], xc[7]);
            *(LAS u32x4*)(lds + RG_XC + (i0 + ii) * XC_STRIDE + c0 * 2) = w;
        }
    }
    lds_barrier();
    {
        const int n = wave, fr = lane & 15, fq = lane >> 4;
        bf16x8 afr[4][2];
#pragma unroll
        for (int m = 0; m < 4; ++m)
#pragma unroll
            for (int ks = 0; ks < 2; ++ks) afr[m][ks] = *(const LAS bf16x8*)(lds + RG_XC + (16 * m + fr) * XC_STRIDE + (n * 64 + ks * 32 + fq * 8) * 2);
        for (int nt = 0; nt < 4; ++nt) {
            const int ch = n * 64 + nt * 16 + fr;
            float xcv[4][4];
#pragma unroll
            for (int m = 0; m < 4; ++m)
#pragma unroll
                for (int j = 0; j < 4; ++j) xcv[m][j] = bf2f(*(const LAS bf16_t*)(lds + RG_XC + (16 * m + 4 * fq + j) * XC_STRIDE + ch * 2));
            float hsum[4][4];
#pragma unroll
            for (int dir = 0; dir < 2; ++dir) {
                f32x4 accr[4], acci[4];
#pragma unroll
                for (int m = 0; m < 4; ++m) { accr[m] = (f32x4){0.f, 0.f, 0.f, 0.f}; acci[m] = (f32x4){0.f, 0.f, 0.f, 0.f}; }
#pragma unroll
                for (int ks = 0; ks < 2; ++ks) {
                    const bf16x8 br = *(const bf16x8*)(gwt + ((size_t)(((dir * 2 + 0) * 8 + n) * 64 + nt * 16 + fr)) * 64 + ks * 32 + fq * 8);
                    const bf16x8 bi = *(const bf16x8*)(gwt + ((size_t)(((dir * 2 + 1) * 8 + n) * 64 + nt * 16 + fr)) * 64 + ks * 32 + fq * 8);
#pragma unroll
                    for (int m = 0; m < 4; ++m) { accr[m] = __builtin_amdgcn_mfma_f32_16x16x32_bf16(afr[m][ks], br, accr[m], 0, 0, 0); acci[m] = __builtin_amdgcn_mfma_f32_16x16x32_bf16(afr[m][ks], bi, acci[m], 0, 0, 0); }
                }
                const float gbr = gate_b[(dir * 2 + 0) * 512 + ch], gbi = gate_b[(dir * 2 + 1) * 512 + ch];
                const float sp = softplusf_(-lam[dir * 512 + ch]);
                float av[4][4], uv[4][4];
#pragma unroll
                for (int m = 0; m < 4; ++m)
#pragma unroll
                    for (int j = 0; j < 4; ++j) {
                        const float r = sigmoidf_(accr[m][j] + gbr), ig = sigmoidf_(acci[m][j] + gbi);
                        const float la = -8.0f * r * sp, t2 = 2.0f * la;
                        av[m][j] = __expf(la);
                        float om = -t2 * (1.f + t2 * (0.5f + t2 * (0.16666667f + t2 * (0.041666668f + t2 * 0.0083333338f))));
                        if (__builtin_expect(__any(t2 <= -0.25f), 0)) om = (t2 > -0.25f) ? om : 1.f - __expf(t2);
                        uv[m][j] = __builtin_amdgcn_sqrtf(om) * ig * xcv[m][j];
                    }
                float carry = (MODE == 1) ? rgcarry[((size_t)unit * 2 + dir) * 512 + ch] : 0.f;
                float atot = 1.f;
#pragma unroll
                for (int mm = 0; mm < 4; ++mm) {
                    const int m = dir == 0 ? mm : 3 - mm;
                    float P, H;
                    if (dir == 0) { P = av[m][0]; H = uv[m][0];
#pragma unroll
                        for (int j = 1; j < 4; ++j) { H = av[m][j] * H + uv[m][j]; P *= av[m][j]; } }
                    else { P = av[m][3]; H = uv[m][3];
#pragma unroll
                        for (int j = 2; j >= 0; --j) { H = av[m][j] * H + uv[m][j]; P *= av[m][j]; } }
                    float Pn, Hn, Pe, He, Pt, Ht;
                    if (dir == 0) {
                        Pn = __shfl_up(P, 16); Hn = __shfl_up(H, 16); if (fq >= 1) { H = P * Hn + H; P = P * Pn; }
                        Pn = __shfl_up(P, 32); Hn = __shfl_up(H, 32); if (fq >= 2) { H = P * Hn + H; P = P * Pn; }
                        Pe = __shfl_up(P, 16); He = __shfl_up(H, 16); if (fq == 0) { Pe = 1.f; He = 0.f; }
                        Pt = __shfl(P, fr + 48); Ht = __shfl(H, fr + 48);
                    } else {
                        Pn = __shfl_down(P, 16); Hn = __shfl_down(H, 16); if (fq <= 2) { H = P * Hn + H; P = P * Pn; }
                        Pn = __shfl_down(P, 32); Hn = __shfl_down(H, 32); if (fq <= 1) { H = P * Hn + H; P = P * Pn; }
                        Pe = __shfl_down(P, 16); He = __shfl_down(H, 16); if (fq == 3) { Pe = 1.f; He = 0.f; }
                        Pt = __shfl(P, fr); Ht = __shfl(H, fr);
                    }
                    if (MODE == 1) {
                        float hp = Pe * carry + He;
                        if (dir == 0) {
#pragma unroll
                            for (int j = 0; j < 4; ++j) { hp = av[m][j] * hp + uv[m][j]; hsum[m][j] = hp; }
                        } else {
#pragma unroll
                            for (int j = 3; j >= 0; --j) { hp = av[m][j] * hp + uv[m][j]; hsum[m][j] += hp; }
                        }
                    }
                    carry = Pt * carry + Ht; atot *= Pt;
                }
                if (MODE == 0 && fq == 0) { rgagg[(((size_t)unit * 2 + dir) * 2 + 0) * 512 + ch] = atot; rgagg[(((size_t)unit * 2 + dir) * 2 + 1) * 512 + ch] = carry; }
            }
            if (MODE == 1) {
#pragma unroll
                for (int m = 0; m < 4; ++m)
#pragma unroll
                    for (int j = 0; j < 4; ++j) { const int t = 16 * m + 4 * fq + j;
                        const float gg = bf2f(proj[(size_t)(rowbase + p0 + t) * NIN + 512 + ch]);
                        *(LAS bf16_t*)(lds + RG_OUT + t * XC_STRIDE + ch * 2) = f2bf(hsum[m][j] * gg); }
            }
        }
    }
    lds_barrier();
    if (MODE == 1) {
        bf16_t* mixed = (bf16_t*)(a.ws + WS_MIXED);
        const int cgp = tid & 63, tg = tid >> 6, c0 = cgp * 8, i0 = tg * 8;
#pragma unroll
        for (int ii = 0; ii < 8; ++ii) { const u32x4 w = *(const LAS u32x4*)(lds + RG_OUT + (i0 + ii) * XC_STRIDE + c0 * 2);
            *(u32x4*)(mixed + (size_t)(rowbase + p0 + i0 + ii) * DM + c0) = w; }
    }
}

__device__ __forceinline__ void rg_carry_item(const Args& a, int item, int tid) {
    const float* rgagg = (const float*)(a.ws + WS_RGAGG); float* rgcarry = (float*)(a.ws + WS_RGCARRY);
    const int gidx = item * NTHREADS + tid;
    const int ch = gidx & 511, dir = (gidx >> 9) & 1, b = gidx >> 10;
    float h = 0.f;
#pragma unroll 1
    for (int s0 = 0; s0 < RG_UNITS_PER_B; s0 += 17) {
        float Av[17], Hv[17];
#pragma unroll
        for (int s1 = 0; s1 < 17; ++s1) { const int s = s0 + s1;
            const int k = dir == 0 ? s : (s < 4 ? 3 - s : 67 - (s - 4));
            const size_t unit = (size_t)b * RG_UNITS_PER_B + k;
            Av[s1] = rgagg[((unit * 2 + dir) * 2 + 0) * 512 + ch]; Hv[s1] = rgagg[((unit * 2 + dir) * 2 + 1) * 512 + ch]; }
#pragma unroll
        for (int s1 = 0; s1 < 17; ++s1) { const int s = s0 + s1;
            const int k = dir == 0 ? s : (s < 4 ? 3 - s : 67 - (s - 4));
            const size_t unit = (size_t)b * RG_UNITS_PER_B + k;
            rgcarry[(unit * 2 + dir) * 512 + ch] = h;
            h = Av[s1] * h + Hv[s1]; }
    }
}

constexpr int HG_RAWZ = 0, HG_RAWV = 16384, HG_RAWQ = 32768;
constexpr int HG_KHT = 49152, HG_VT = 67584;
constexpr int HG_QT = 86016, HG_KT = 103424;
constexpr int HG_AM = 120832;
constexpr int HG_DS = 130048, HG_QSUM = 130560, HG_PART = 132608;
constexpr int HG_OST = 0;
constexpr int TS = 144, QS = 272;

struct HgRaw { u32x4 z[2], v[2], q[2]; };
template <bool FULL>
__device__ __forceinline__ void hg_load_raw(HgRaw& r, const bf16_t* __restrict__ proj, int row0, int hd, int dir, int tid) {
#pragma unroll
    for (int i = 0; i < 2; ++i) { const bf16_t* p = proj + (size_t)(row0 + (tid >> 4) + 32 * i) * NIN + hd * 128 + (tid & 15) * 8;
        r.z[i] = *(const u32x4*)(p + (dir == 0 ? 1536 : 2048)); r.v[i] = *(const u32x4*)(p + 2560); if (FULL) r.q[i] = *(const u32x4*)(p + 1024); }
}
template <bool FULL>
__device__ __forceinline__ void hg_store_raw(LAS unsigned char* lds, const HgRaw& r, int tid) {
#pragma unroll
    for (int i = 0; i < 2; ++i) { const int off = ((tid >> 4) + 32 * i) * 256 + (tid & 15) * 16;
        *(LAS u32x4*)(lds + HG_RAWZ + off) = r.z[i]; *(LAS u32x4*)(lds + HG_RAWV + off) = r.v[i]; if (FULL) *(LAS u32x4*)(lds + HG_RAWQ + off) = r.q[i]; }
}

template <int DIR, bool FULL>
__device__ __forceinline__ void hg_chunk(LAS unsigned char* lds, f32x4 (&accS)[8], f32x4 (&o)[4], float lbv, float& dseg, int tid, int wave, int lane) {
    const int kc = tid & 127, tq = tid >> 7, fr = lane & 15, fq = lane >> 4;
    float Gc[16];
    float qt = 0.f;
#pragma unroll
    for (int i = 0; i < 16; ++i) { const float z = bf2f(*(const LAS bf16_t*)(lds + HG_RAWZ + (16 * tq + i) * 256 + kc * 2));
        const float f = lbv + (1.0f - lbv) * sigmoidf_(z); Gc[i] = __logf(f); qt += Gc[i]; }
    *(LAS float*)(lds + HG_QSUM + (tq * 128 + kc) * 4) = qt;
    lds_barrier();
    float offs = 0.f, gtot = 0.f;
#pragma unroll
    for (int q4 = 0; q4 < 4; ++q4) { const float v = *(const LAS float*)(lds + HG_QSUM + (q4 * 128 + kc) * 4); gtot += v; if (DIR == 0 ? (q4 < tq) : (q4 > tq)) offs += v; }
    if (DIR == 0) { float c = offs;
#pragma unroll
        for (int i = 0; i < 16; ++i) { c += Gc[i]; Gc[i] = c; } }
    else { float c = offs;
#pragma unroll
        for (int i = 15; i >= 0; --i) { c += Gc[i]; Gc[i] = c; } }
    {
#pragma unroll
        for (int h2 = 0; h2 < 2; ++h2) {
            unsigned kh[4], vt[4];
#pragma unroll
            for (int i2 = 0; i2 < 4; ++i2) { const int i = 4 * h2 + i2;
                const float z0 = bf2f(*(const LAS bf16_t*)(lds + HG_RAWZ + (16 * tq + 2 * i) * 256 + kc * 2)), z1 = bf2f(*(const LAS bf16_t*)(lds + HG_RAWZ + (16 * tq + 2 * i + 1) * 256 + kc * 2));
                const float k0 = (1.0f - lbv) * (1.0f - sigmoidf_(z0)), k1 = (1.0f - lbv) * (1.0f - sigmoidf_(z1));
                kh[i2] = cvt2(k0 * __expf(gtot - Gc[2 * i]), k1 * __expf(gtot - Gc[2 * i + 1]));
                const unsigned v0 = *(const LAS bf16_t*)(lds + HG_RAWV + (16 * tq + 2 * i) * 256 + kc * 2), v1 = *(const LAS bf16_t*)(lds + HG_RAWV + (16 * tq + 2 * i + 1) * 256 + kc * 2);
                vt[i2] = v0 | (v1 << 16);
                if (FULL) {
                    const float q0 = bf2f(*(const LAS bf16_t*)(lds + HG_RAWQ + (16 * tq + 2 * i) * 256 + kc * 2)), q1 = bf2f(*(const LAS bf16_t*)(lds + HG_RAWQ + (16 * tq + 2 * i + 1) * 256 + kc * 2));
                    *(LAS bf16_t*)(lds + HG_QT + (16 * tq + 2 * i) * QS + kc * 2) = f2bf(q0 * __expf(Gc[2 * i]));
                    *(LAS bf16_t*)(lds + HG_QT + (16 * tq + 2 * i + 1) * QS + kc * 2) = f2bf(q1 * __expf(Gc[2 * i + 1]));
                    *(LAS bf16_t*)(lds + HG_KT + (16 * tq + 2 * i) * QS + kc * 2) = f2bf(k0 * __expf(-Gc[2 * i]));
                    *(LAS bf16_t*)(lds + HG_KT + (16 * tq + 2 * i + 1) * QS + kc * 2) = f2bf(k1 * __expf(-Gc[2 * i + 1]));
                }
            }
            *(LAS u32x4*)(lds + HG_KHT + kc * TS + tq * 32 + 16 * h2) = (u32x4){kh[0], kh[1], kh[2], kh[3]};
            *(LAS u32x4*)(lds + HG_VT + kc * TS + tq * 32 + 16 * h2) = (u32x4){vt[0], vt[1], vt[2], vt[3]};
        }
        if (tq == 0) { const float dc = __expf(gtot); *(LAS float*)(lds + HG_DS + kc * 4) = dc; dseg *= dc; }
    }
    lds_barrier();
    if (FULL) {
#pragma unroll
        for (int tt = 0; tt < 2; ++tt) {
            const int tl = 2 * wave + tt, ti = tl >> 2, si = tl & 3;
            f32x4 accA = (f32x4){0.f, 0.f, 0.f, 0.f};
#pragma unroll
            for (int ks = 0; ks < 4; ++ks) {
                const bf16x8 af = *(const LAS bf16x8*)(lds + HG_QT + (16 * ti + fr) * QS + (ks * 32 + fq * 8) * 2);
                const bf16x8 bf = *(const LAS bf16x8*)(lds + HG_KT + (16 * si + fr) * QS + (ks * 32 + fq * 8) * 2);
                accA = __builtin_amdgcn_mfma_f32_16x16x32_bf16(af, bf, accA, 0, 0, 0);
            }
#pragma unroll
            for (int j = 0; j < 4; ++j) { const int t = 16 * ti + 4 * fq + j, s = 16 * si + fr;
                const bool keep = DIR == 0 ? (s <= t) : (s >= t);
                *(LAS bf16_t*)(lds + HG_AM + t * TS + s * 2) = f2bf(keep ? accA[j] : 0.f); }
        }
        lds_barrier();
#pragma unroll
        for (int m = 0; m < 4; ++m) o[m] = (f32x4){0.f, 0.f, 0.f, 0.f};
#pragma unroll
        for (int ks = 0; ks < 4; ++ks) {
            const u32x4 sw = (u32x4){cvt2(accS[2 * ks][0], accS[2 * ks][1]), cvt2(accS[2 * ks][2], accS[2 * ks][3]), cvt2(accS[2 * ks + 1][0], accS[2 * ks + 1][1]), cvt2(accS[2 * ks + 1][2], accS[2 * ks + 1][3])};
            const bf16x8 sf = mk_bf16x8(sw);
#pragma unroll
            for (int m = 0; m < 4; ++m) {
                const u32x2 qlo = *(const LAS u32x2*)(lds + HG_QT + (16 * m + fr) * QS + (32 * ks + 4 * fq) * 2), qhi = *(const LAS u32x2*)(lds + HG_QT + (16 * m + fr) * QS + (32 * ks + 16 + 4 * fq) * 2);
                const bf16x8 qf = mk_bf16x8((u32x4){qlo.x, qlo.y, qhi.x, qhi.y});
                o[m] = __builtin_amdgcn_mfma_f32_16x16x32_bf16(qf, sf, o[m], 0, 0, 0);
            }
        }
#pragma unroll
        for (int ks = 0; ks < 2; ++ks) {
            const bf16x8 vf = *(const LAS bf16x8*)(lds + HG_VT + (16 * wave + fr) * TS + (ks * 32 + fq * 8) * 2);
#pragma unroll
            for (int m = 0; m < 4; ++m) { const bf16x8 af = *(const LAS bf16x8*)(lds + HG_AM + (16 * m + fr) * TS + (ks * 32 + fq * 8) * 2);
                o[m] = __builtin_amdgcn_mfma_f32_16x16x32_bf16(af, vf, o[m], 0, 0, 0); }
        }
    }
#pragma unroll
    for (int i = 0; i < 8; ++i) { const f32x4 dv = *(const LAS f32x4*)(lds + HG_DS + (16 * i + 4 * fq) * 4); accS[i] = accS[i] * dv; }
#pragma unroll
    for (int ks = 0; ks < 2; ++ks) {
        const bf16x8 vf = *(const LAS bf16x8*)(lds + HG_VT + (16 * wave + fr) * TS + (ks * 32 + fq * 8) * 2);
#pragma unroll
        for (int i = 0; i < 8; ++i) { const bf16x8 af = *(const LAS bf16x8*)(lds + HG_KHT + (16 * i + fr) * TS + (ks * 32 + fq * 8) * 2);
            accS[i] = __builtin_amdgcn_mfma_f32_16x16x32_bf16(af, vf, accS[i], 0, 0, 0); }
    }
}

__device__ __forceinline__ float hg_lb(const float* __restrict__ lb_logits, int dir, int col) {
    const float l0 = lb_logits[(0 * 2 + dir) * 512 + col], l1 = lb_logits[(1 * 2 + dir) * 512 + col];
    return 1.0f / (1.0f + expf(l1 - l0));
}

template <int DIR>
__device__ __forceinline__ void hg_agg_unit(LAS unsigned char* lds, const Args& a, int b, int hd, int sidx, int unit, int tid, int wave, int lane) {
    const bf16_t* __restrict__ proj = (const bf16_t*)(a.ws + WS_PROJ);
    const int rowbase = sidx == 0 ? T + b * LC : b * SEQ + (sidx - 1) * 256;
    const float lbv = hg_lb(a.in[12], DIR, hd * 128 + (tid & 127));
    f32x4 accS[8], odummy[4];
#pragma unroll
    for (int i = 0; i < 8; ++i) accS[i] = (f32x4){0.f, 0.f, 0.f, 0.f};
    float dseg = 1.f;
    HgRaw raw;
    hg_load_raw<false>(raw, proj, rowbase + (DIR == 0 ? 0 : 3) * 64, hd, DIR, tid);
    lds_barrier();
    hg_store_raw<false>(lds, raw, tid);
    lds_barrier();
#pragma unroll 1
    for (int cc = 0; cc < 4; ++cc) {
        if (cc < 3) hg_load_raw<false>(raw, proj, rowbase + (DIR == 0 ? cc + 1 : 2 - cc) * 64, hd, DIR, tid);
        hg_chunk<DIR, false>(lds, accS, odummy, lbv, dseg, tid, wave, lane);
        lds_barrier();
        if (cc < 3) { hg_store_raw<false>(lds, raw, tid); lds_barrier(); }
    }
    float* K = (float*)(a.ws + WS_HGK) + (size_t)unit * 16384;
    const int fr = lane & 15, fq = lane >> 4;
#pragma unroll
    for (int i = 0; i < 8; ++i)
#pragma unroll
        for (int j = 0; j < 4; ++j) K[(16 * i + 4 * fq + j) * 128 + 16 * wave + fr] = accS[i][j];
    if (tid < 128) ((float*)(a.ws + WS_HGD))[(size_t)unit * 128 + tid] = dseg;
}

__device__ __forceinline__ void hg_carry_item(const Args& a, int item, int tid, bool dry = false) {
    const int chain = item >> 3, part = item & 7, dir = chain & 1;
    float* K = (float*)(a.ws + WS_HGK) + (size_t)chain * HG_SEGS * 16384; const float* D = (const float*)(a.ws + WS_HGD) + (size_t)chain * HG_SEGS * 128;
    const int e4 = part * 512 + tid, dk = e4 >> 5;
    f32x4 kv[HG_SEGS]; float dv[HG_SEGS];
#pragma unroll
    for (int s = 0; s < HG_SEGS; ++s) { const int sidx = s == 0 ? 0 : (dir == 0 ? s : HG_SEGS - s); kv[s] = *(const f32x4*)(K + (size_t)sidx * 16384 + e4 * 4); dv[s] = D[sidx * 128 + dk]; }
    f32x4 S = (f32x4){0.f, 0.f, 0.f, 0.f};
#pragma unroll
    for (int s = 0; s < HG_SEGS; ++s) { const int sidx = s == 0 ? 0 : (dir == 0 ? s : HG_SEGS - s); if (dry) { const size_t o = ((size_t)(chain * HG_SEGS + sidx) * 16384 + e4 * 4) % (size_t)(32 * MiB); *(f32x4*)((float*)(a.ws + WS_MIXED) + o) = S; } else *(f32x4*)(K + (size_t)sidx * 16384 + e4 * 4) = S; S = S * dv[s] + kv[s]; }
}

__device__ __forceinline__ void hg_final_unit(LAS unsigned char* lds, const Args& a, int b, int hd, int seg, int tid, int wave, int lane) {
    const bf16_t* __restrict__ proj = (const bf16_t*)(a.ws + WS_PROJ); bf16_t* mixed = (bf16_t*)(a.ws + WS_MIXED);
    const int rowbase = b * SEQ + seg * 256, fr = lane & 15, fq = lane >> 4;
    const float lbf = hg_lb(a.in[12], 0, hd * 128 + (tid & 127)), lbb = hg_lb(a.in[12], 1, hd * 128 + (tid & 127));
    const float ng = a.in[13][hd * 128 + 16 * wave + fr];
    f32x4 accS[8], o[4];
    float dseg = 1.f;
    HgRaw raw;
    f32x4* ofst = (f32x4*)(a.ws + WS_OFST) + (size_t)blockIdx.x * 8192 + wave * 256 + lane;
    {
        const float* Sin = (const float*)(a.ws + WS_HGK) + (size_t)((((b * 4 + hd) * 2 + 0) * HG_SEGS) + 1 + seg) * 16384;
#pragma unroll
        for (int i = 0; i < 8; ++i)
#pragma unroll
            for (int j = 0; j < 4; ++j) accS[i][j] = Sin[(16 * i + 4 * fq + j) * 128 + 16 * wave + fr];
    }
    hg_load_raw<true>(raw, proj, rowbase, hd, 0, tid);
    lds_barrier();
    hg_store_raw<true>(lds, raw, tid);
    lds_barrier();
#pragma unroll 1
    for (int cc = 0; cc < 4; ++cc) {
        if (cc < 3) hg_load_raw<true>(raw, proj, rowbase + (cc + 1) * 64, hd, 0, tid); else hg_load_raw<true>(raw, proj, rowbase + 3 * 64, hd, 1, tid);
        hg_chunk<0, true>(lds, accS, o, lbf, dseg, tid, wave, lane);
#pragma unroll
        for (int m = 0; m < 4; ++m) ofst[cc * 2048 + m * 64] = o[m];
        lds_barrier();
        hg_store_raw<true>(lds, raw, tid);
        lds_barrier();
    }
    {
        const float* Sin = (const float*)(a.ws + WS_HGK) + (size_t)((((b * 4 + hd) * 2 + 1) * HG_SEGS) + 1 + seg) * 16384;
#pragma unroll
        for (int i = 0; i < 8; ++i)
#pragma unroll
            for (int j = 0; j < 4; ++j) accS[i][j] = Sin[(16 * i + 4 * fq + j) * 128 + 16 * wave + fr];
    }
#pragma unroll 1
    for (int cc = 0; cc < 4; ++cc) {
        const int c = 3 - cc;
        if (cc < 3) hg_load_raw<true>(raw, proj, rowbase + (c - 1) * 64, hd, 1, tid);
        hg_chunk<1, true>(lds, accS, o, lbb, dseg, tid, wave, lane);
        float gate[4][4];
#pragma unroll
        for (int m = 0; m < 4; ++m) { o[m] = o[m] + ofst[c * 2048 + m * 64];
#pragma unroll
            for (int j = 0; j < 4; ++j) { float s = o[m][j] * o[m][j];
                s += __shfl_xor(s, 1); s += __shfl_xor(s, 2); s += __shfl_xor(s, 4); s += __shfl_xor(s, 8);
                if (fr == 0) *(LAS float*)(lds + HG_PART + ((16 * m + 4 * fq + j) * 8 + wave) * 4) = s;
                gate[m][j] = bf2f(proj[(size_t)(rowbase + c * 64 + 16 * m + 4 * fq + j) * NIN + 3072 + hd * 128 + 16 * wave + fr]); } }
        lds_barrier();
#pragma unroll
        for (int m = 0; m < 4; ++m)
#pragma unroll
            for (int j = 0; j < 4; ++j) { const int t = 16 * m + 4 * fq + j;
                const f32x4 p0 = *(const LAS f32x4*)(lds + HG_PART + t * 32), p1 = *(const LAS f32x4*)(lds + HG_PART + t * 32 + 16);
                const float ms = ((p0[0] + p0[1]) + (p0[2] + p0[3]) + (p1[0] + p1[1]) + (p1[2] + p1[3])) * (1.0f / 128.0f);
                *(LAS bf16_t*)(lds + HG_OST + t * QS + (16 * wave + fr) * 2) = f2bf(o[m][j] * rsqrtf(ms + LN_EPS) * ng * gate[m][j]); }
        lds_barrier();
#pragma unroll
        for (int i = 0; i < 2; ++i) { const int t = (tid >> 4) + 32 * i, c8 = (tid & 15) * 8;
            *(u32x4*)(mixed + (size_t)(rowbase + c * 64 + t) * DM + 512 + hd * 128 + c8) = *(const LAS u32x4*)(lds + HG_OST + t * QS + c8 * 2); }
        lds_barrier();
        if (cc < 3) { hg_store_raw<true>(lds, raw, tid); lds_barrier(); }
    }
}

__device__ __forceinline__ void p_scan_a(LAS unsigned char* lds, const Args& a, int bid, int G, int tid, int wave, int lane, int mask = 3) {
    constexpr int N_HG = NB * 4 * 2 * HG_SEGS, N_RG = NB * RG_UNITS_PER_B;
#pragma unroll 1
    for (int it = bid; it < N_HG + N_RG; it += G) {
        int t2 = tid; asm volatile("" : "+v"(t2)); const int tid = t2, lane = t2 & 63;
        if ((it < N_HG) ? !(mask & 1) : !(mask & 2)) continue;
        if (it < N_HG) { const int sidx = it % HG_SEGS, rest = it / HG_SEGS, dir = rest & 1, hd = (rest >> 1) & 3, b = rest >> 3;
            if (dir == 0) hg_agg_unit<0>(lds, a, b, hd, sidx, it, tid, wave, lane); else hg_agg_unit<1>(lds, a, b, hd, sidx, it, tid, wave, lane); }
        else { const int r = it - N_HG; __syncthreads(); rg_unit<0>(lds, a, r / RG_UNITS_PER_B, r % RG_UNITS_PER_B, tid, wave, lane); }
    }
}
__device__ __forceinline__ void p_scan_b(const Args& a, int bid, int G, int tid, bool dry = false) {
#pragma unroll 1
    for (int it = bid; it < 1024; it += G) hg_carry_item(a, it, tid, dry);
    if (bid >= G - 32) rg_carry_item(a, bid - (G - 32), tid);
}
__device__ __forceinline__ void p_scan_c(LAS unsigned char* lds, const Args& a, int bid, int G, int tid, int wave, int lane, int mask = 3) {
#pragma unroll 1
    for (int it = bid; it < ((mask & 1) ? 1024 : 0); it += G) { const int seg = it & 15, hd = (it >> 4) & 3, b = it >> 6; int t2 = tid; asm volatile("" : "+v"(t2)); hg_final_unit(lds, a, b, hd, seg, t2, wave, t2 & 63); }
#pragma unroll 1
    for (int r = bid; r < ((mask & 2) ? 1024 : 0); r += G) { __syncthreads(); int t2 = tid; asm volatile("" : "+v"(t2)); rg_unit<1>(lds, a, r >> 6, 4 + (r & 63), t2, wave, t2 & 63); }
}

#define GAS __attribute__((address_space(1)))
#define RLX_AGENT __ATOMIC_RELAXED, __HIP_MEMORY_SCOPE_AGENT
#define XB_TMO      128
#define XB_XCNT(j)  (256  + 64 * (j))
#define XB_XSUB(j)  (1280 + 64 * (j))
#define XB_XGEN(j)  (2304 + 64 * (j))
#define XB_TOP      3328
#define XB_TOPGEN   3392
#define XCD_BAR_WORDS 3456
#define XB_SPIN_CAP (1u << 18)

__device__ __forceinline__ unsigned xb_ld(unsigned* p)              { return __hip_atomic_load(p, __ATOMIC_RELAXED, __HIP_MEMORY_SCOPE_AGENT); }
__device__ __forceinline__ unsigned xb_add(unsigned* p, unsigned v) { return __hip_atomic_fetch_add(p, v, __ATOMIC_RELAXED, __HIP_MEMORY_SCOPE_AGENT); }
__device__ __forceinline__ unsigned xb_xcc_id() { return (unsigned)__builtin_amdgcn_s_getreg((3 << 11) | 20) & 0xFu; }
#define XB_SPIN(cond, bar) do { unsigned _sp = 0; while (cond) { __builtin_amdgcn_s_sleep(1); \
    if ((++_sp & 255u) == 0u) { if (xb_ld(&(bar)[XB_TMO])) break; if (_sp > XB_SPIN_CAP) { atomicAdd(&(bar)[XB_TMO], 1u); break; } } } } while (0)

struct XcdBarrier {
    unsigned* bar; unsigned x;
    volatile LAS unsigned* st;
};

__device__ __forceinline__ XcdBarrier xcd_barrier_post(unsigned* bar, volatile LAS unsigned* st) {
    XcdBarrier b; b.bar = bar; b.x = xb_xcc_id(); b.st = st;
    if (threadIdx.x == 0) (void)xb_add(&bar[XB_XCNT(b.x)], 1u);
    return b;
}
__device__ __forceinline__ void xcd_barrier_complete(unsigned* bar, unsigned x, unsigned& nloc, unsigned& nx) {
    const unsigned G = gridDim.x * gridDim.y * gridDim.z;
    unsigned sum, cnt, mine, sp = 0u;
    for (;;) {
        sum = 0u; cnt = 0u; mine = 0u;
#pragma unroll
        for (unsigned j = 0; j < 16; ++j) { const unsigned c = xb_ld(&bar[XB_XCNT(j)]); sum += c; cnt += (c > 0u) ? 1u : 0u; mine = (j == x) ? c : mine; }
        if (sum == G) break;
        __builtin_amdgcn_s_sleep(1);
        if ((++sp & 255u) == 0u) { if (xb_ld(&bar[XB_TMO])) break; if (sp > XB_SPIN_CAP) { atomicAdd(&bar[XB_TMO], 1u); break; } }
    }
    nloc = mine > 0u ? mine : 1u; nx = cnt > 0u ? cnt : 1u;
}

__device__ __forceinline__ void xcd_barrier(const XcdBarrier& b) {
    asm volatile("s_waitcnt vmcnt(0)" ::: "memory");
    __syncthreads();
    if (threadIdx.x == 0) {
        unsigned* bar = b.bar;
        __builtin_amdgcn_s_waitcnt(0);
        unsigned nloc = b.st[0], nx = b.st[1];
        if (nloc == 0u) { xcd_barrier_complete(bar, b.x, nloc, nx); b.st[0] = nloc; b.st[1] = nx; }
        const unsigned old = xb_add(&bar[XB_XSUB(b.x)], 1u);
        const unsigned gen = old / nloc;
        if (old + 1u == (gen + 1u) * nloc) {
            __builtin_amdgcn_fence(__ATOMIC_RELEASE, "agent");
            asm volatile("s_waitcnt vmcnt(0)" ::: "memory");
            const unsigned og = xb_add(&bar[XB_TOP], 1u);
            const unsigned tg = og / nx;
            if (og + 1u == (tg + 1u) * nx) xb_add(&bar[XB_TOPGEN], 1u);
            else XB_SPIN(xb_ld(&bar[XB_TOPGEN]) == tg, bar);
            __builtin_amdgcn_fence(__ATOMIC_ACQUIRE, "agent");
            xb_add(&bar[XB_XGEN(b.x)], 1u);
            asm volatile("s_waitcnt vmcnt(0)" ::: "memory");
        } else {
            XB_SPIN(xb_ld(&bar[XB_XGEN(b.x)]) == gen, bar);
            __builtin_amdgcn_fence(__ATOMIC_ACQUIRE, "agent");
            asm volatile("s_waitcnt vmcnt(0)" ::: "memory");
        }
    }
    __syncthreads();
}


__global__ void __launch_bounds__(NTHREADS, 2) mega(Args a) {
    extern __shared__ __attribute__((aligned(16))) unsigned char lds_raw[];
    LAS unsigned char* lds = (LAS unsigned char*)lds_raw;
    cg::grid_group grid = cg::this_grid();
    const int wave = __builtin_amdgcn_readfirstlane(threadIdx.x >> 6), bid = blockIdx.x, G = gridDim.x;
    int tid = threadIdx.x, lane = tid & 63;
#define FRESH_TID() do { tid = threadIdx.x; asm volatile("" : "+v"(tid)); lane = tid & 63; } while (0)
    unsigned char* ws = a.ws;
    volatile LAS unsigned* bst = (volatile LAS unsigned*)(lds + LDS_BYTES - 64);
    if (threadIdx.x < 2) bst[threadIdx.x] = 0u;
    __syncthreads();
    XcdBarrier xbar = xcd_barrier_post((unsigned*)(ws + WS_BAR), bst);
#define GRID_BAR() xcd_barrier(xbar)
    float* mod = (float*)(ws + WS_MOD);
    bf16_t* U = (bf16_t*)(ws + WS_U);
    bf16_t* PROJ = (bf16_t*)(ws + WS_PROJ); bf16_t* MIXED = (bf16_t*)(ws + WS_MIXED);

#ifndef SKIP_P0
    p_mod(lds, a.in[1], a.in[3], a.in[4], a.in[5], mod, bid, G, tid);
    p_transposes(lds, a, bid, G, tid);
    p_gwt(a.in[9], (bf16_t*)(ws + WS_GWT), bid, G, tid);
#endif
#ifdef REP_P0
    grid.sync();
    FRESH_TID();
    p_mod(lds, a.in[1], a.in[3], a.in[4], a.in[5], mod, bid, G, tid);
    p_transposes(lds, a, bid, G, tid);
    p_gwt(a.in[9], (bf16_t*)(ws + WS_GWT), bid, G, tid);
#endif
    GRID_BAR();
    FRESH_TID();
#ifdef REP_SYNC
    for (int r = 0; r < 10; ++r) GRID_BAR();
#endif
#ifndef SKIP_P1
    p_u(a.in[0], a.in[2], mod, U, bid, G, tid);
#endif
#ifdef REP_P1
    GRID_BAR();
    FRESH_TID();
    p_u(a.in[0], a.in[2], mod, U, bid, G, tid);
#endif
    GRID_BAR();
    FRESH_TID();
#ifndef SKIP_P2
    { pg8::Gemm g{U, (const bf16_t*)(ws + WS_WINT), TA, NIN, DM}; pg8::StaticOrder S; S.init(TA, NIN, G, bid);
      pg8::EpiInProj E{PROJ};
      pg8::gemm_phase<pg8::EpiInProj, pg8::StaticOrder, true, true>(lds, g, S, E); }
#endif
#ifdef REP_P2
    GRID_BAR();
    FRESH_TID();
    { pg8::Gemm g{U, (const bf16_t*)(ws + WS_WINT), TA, NIN, DM}; pg8::StaticOrder S; S.init(TA, NIN, G, bid);
      pg8::EpiInProj E{PROJ};
      pg8::gemm_phase<pg8::EpiInProj, pg8::StaticOrder, true, true>(lds, g, S, E); }
#endif
    GRID_BAR();
    FRESH_TID();
#ifndef SKIP_P3A
    p_scan_a(lds, a, bid, G, tid, wave, lane);
#endif
#ifdef REP_P3A
    GRID_BAR();
    FRESH_TID();
    p_scan_a(lds, a, bid, G, tid, wave, lane, REP_P3A);
#endif
    GRID_BAR();
    FRESH_TID();
#ifdef REP_P3B
    p_scan_b(a, bid, G, tid, true);
    GRID_BAR();
    FRESH_TID();
#endif
#ifndef SKIP_P3B
    p_scan_b(a, bid, G, tid);
#endif
    GRID_BAR();
    FRESH_TID();
#ifndef SKIP_P3C
    p_scan_c(lds, a, bid, G, tid, wave, lane);
#endif
#ifdef REP_P3C
    GRID_BAR();
    FRESH_TID();
    p_scan_c(lds, a, bid, G, tid, wave, lane, REP_P3C);
#endif
    GRID_BAR();
    FRESH_TID();
#ifndef SKIP_P5
    { pg8::Gemm g{MIXED, (const bf16_t*)(ws + WS_WOUTT), T, DM, DM}; pg8::StaticOrder S; S.init(T, DM, G, bid);
      pg8::EpiF32 E{a.out, DM, 0};
      pg8::gemm_phase<pg8::EpiF32, pg8::StaticOrder, true, true>(lds, g, S, E); }
#endif
#ifdef REP_P5
    GRID_BAR();
    FRESH_TID();
    { pg8::Gemm g{MIXED, (const bf16_t*)(ws + WS_WOUTT), T, DM, DM}; pg8::StaticOrder S; S.init(T, DM, G, bid);
      pg8::EpiF32 E{a.out, DM, 0};
      pg8::gemm_phase<pg8::EpiF32, pg8::StaticOrder, true, true>(lds, g, S, E); }
#endif
    GRID_BAR();
    FRESH_TID();
#ifdef REP_P6
#pragma unroll 1
    for (int rep = 0; rep < 2; ++rep) { p_ln1_router(lds, a, bid, G, tid, wave, lane, rep == 0); if (rep == 0) GRID_BAR(); }
#else
    p_ln1_router(lds, a, bid, G, tid, wave, lane);
#endif
    GRID_BAR();
    FRESH_TID();
#ifndef SKIP_P7
    p_gather(a, bid, G, wave, lane);
#endif
#ifdef REP_P7
    GRID_BAR();
    FRESH_TID();
    p_gather(a, bid, G, wave, lane);
#endif
    GRID_BAR();
    FRESH_TID();
#ifndef SKIP_P8
    { pg8::Gemm g{(const bf16_t*)(ws + WS_XG), (const bf16_t*)(ws + WS_W13T), MAXROWS, NE * DM, DM}; pg8::ExpertOrder S{(const int*)(ws + WS_CTL), G, bid};
      pg8::EpiExp1 E{(bf16_t*)(ws + WS_HID)};
      pg8::gemm_phase<pg8::EpiExp1, pg8::ExpertOrder, true, true>(lds, g, S, E); }
#endif
#ifdef REP_P8
    GRID_BAR();
    FRESH_TID();
    { pg8::Gemm g{(const bf16_t*)(ws + WS_XG), (const bf16_t*)(ws + WS_W13T), MAXROWS, NE * DM, DM}; pg8::ExpertOrder S{(const int*)(ws + WS_CTL), G, bid};
      pg8::EpiExp1 E{(bf16_t*)(ws + WS_HID)};
      pg8::gemm_phase<pg8::EpiExp1, pg8::ExpertOrder, true, true>(lds, g, S, E); }
#endif
    GRID_BAR();
    FRESH_TID();
#ifndef SKIP_P9
    { pg8::Gemm g{(const bf16_t*)(ws + WS_HID), (const bf16_t*)(ws + WS_W2T), MAXROWS, NE * DM, DE}; pg8::ExpertOrder S{(const int*)(ws + WS_CTL), G, bid};
      pg8::EpiY E{(bf16_t*)(ws + WS_Y)};
      pg8::gemm_phase<pg8::EpiY, pg8::ExpertOrder, true, true>(lds, g, S, E); }
#endif
#ifdef REP_P9
    GRID_BAR();
    FRESH_TID();
    { pg8::Gemm g{(const bf16_t*)(ws + WS_HID), (const bf16_t*)(ws + WS_W2T), MAXROWS, NE * DM, DE}; pg8::ExpertOrder S{(const int*)(ws + WS_CTL), G, bid};
      pg8::EpiY E{(bf16_t*)(ws + WS_Y)};
      pg8::gemm_phase<pg8::EpiY, pg8::ExpertOrder, true, true>(lds, g, S, E); }
#endif
    GRID_BAR();
    FRESH_TID();
#ifdef REP_P10
    p_combine_ln2(a, bid, G, wave, lane, true);
    GRID_BAR();
    FRESH_TID();
#endif
#ifndef SKIP_P10
    p_combine_ln2(a, bid, G, wave, lane);
#endif
}

extern "C" void kernel_launch(void* const* d_in, const int* in_sizes, int n_in, void* d_out, int out_size, void* d_ws, size_t ws_size, hipStream_t stream) {
    static int grid = 0;
    if (grid == 0) {
        if (n_in != 26 || ws_size < WS_END) { fprintf(stderr, "kernel_launch: unexpected n_in %d or workspace %zu < %zu\n", n_in, ws_size, (size_t)WS_END); grid = -1; return; }
        int dev = 0, cus = 0, per_cu = 0;
        if (hipGetDevice(&dev) != hipSuccess || hipDeviceGetAttribute(&cus, hipDeviceAttributeMultiprocessorCount, dev) != hipSuccess) { grid = -1; return; }
        if (hipFuncSetAttribute((const void*)mega, hipFuncAttributeMaxDynamicSharedMemorySize, LDS_BYTES) != hipSuccess) { fprintf(stderr, "kernel_launch: hipFuncSetAttribute failed\n"); grid = -1; return; }
        if (hipOccupancyMaxActiveBlocksPerMultiprocessor(&per_cu, (const void*)mega, NTHREADS, LDS_BYTES) != hipSuccess || per_cu < 1) { fprintf(stderr, "kernel_launch: occupancy query says %d\n", per_cu); per_cu = 1; }
        (void)hipGetLastError();
        grid = cus;
        fprintf(stderr, "kernel_launch: grid %d (cus %d, per_cu %d), ws %zu\n", grid, cus, per_cu, ws_size);
    }
    if (grid < 0) return;
    (void)hipMemsetAsync(d_ws, 0, 131072, stream);
    Args a{};
    for (int i = 0; i < 26; ++i) a.in[i] = (const float*)d_in[i];
    a.out = (float*)d_out; a.ws = (unsigned char*)d_ws;
    void* params[] = {&a};
    hipError_t e = hipLaunchCooperativeKernel((const void*)mega, dim3(grid), dim3(NTHREADS), params, LDS_BYTES, stream);
    if (e != hipSuccess) fprintf(stderr, "kernel_launch: cooperative launch failed: %s (grid %d)\n", hipGetErrorString(e), grid);
}
```

```cpp
#include <hip/hip_runtime.h>
#include <hip/hip_cooperative_groups.h>
#include <cstdio>
#include <cstdint>
namespace cg = cooperative_groups;

typedef unsigned short bf16_t;
typedef short bf16x8 __attribute__((ext_vector_type(8)));
typedef float f32x4 __attribute__((ext_vector_type(4)));
typedef float f32x2 __attribute__((ext_vector_type(2)));
typedef unsigned u32x4 __attribute__((ext_vector_type(4)));
typedef unsigned u32x2 __attribute__((ext_vector_type(2)));
typedef int i32x4 __attribute__((ext_vector_type(4)));
#define LAS __attribute__((address_space(3)))

constexpr int NB = 16, SEQ = 4096, LC = 256, DM = 1024;
constexpr int T = NB * SEQ;
constexpr int TC = NB * LC;
constexpr int TA = T + TC;
constexpr int NIN = 3584;
constexpr int NE = 32, DE = 512;
constexpr int MAXROWS = 2 * T + NE * 256;
constexpr float ALPHA = 1.189207115002721f;
constexpr float LN_EPS = 1e-6f;
constexpr int NTHREADS = 512;

constexpr size_t MiB = 1u << 20;
constexpr size_t WS_CTL = 0;
constexpr size_t WS_BAR = 65536;
constexpr size_t WS_MOD = 1 * MiB;
constexpr size_t WS_EIDX = 3 * MiB;
constexpr size_t WS_EPOS = 3 * MiB + 512 * 1024;
constexpr size_t WS_EW = 4 * MiB;
constexpr size_t WS_DEST = 4 * MiB + 512 * 1024;
constexpr size_t WS_WINT = 6 * MiB;
constexpr size_t WS_WOUTT = 13 * MiB;
constexpr size_t WS_W13T = 15 * MiB;
constexpr size_t WS_W2T = 79 * MiB;
constexpr size_t WS_U = 112 * MiB;
constexpr size_t WS_PROJ = 248 * MiB;
constexpr size_t WS_XG = 248 * MiB;
constexpr size_t WS_HID = 520 * MiB;
constexpr size_t WS_Y = 656 * MiB;
constexpr size_t WS_MIXED = 724 * MiB;
constexpr size_t WS_OSUM = 852 * MiB;
constexpr size_t WS_END = 980 * MiB;
constexpr int LDS_BYTES = 163840;

__device__ __forceinline__ float bf2f(bf16_t b) { return __uint_as_float(((unsigned)b) << 16); }
__device__ __forceinline__ bf16_t f2bf(float f) { unsigned u = __float_as_uint(f); return (bf16_t)((u + 0x7fffu + ((u >> 16) & 1u)) >> 16); }
__device__ __forceinline__ unsigned pk2(float lo, float hi) { return (unsigned)f2bf(lo) | ((unsigned)f2bf(hi) << 16); }
__device__ __forceinline__ float frcp(float x) { return __builtin_amdgcn_rcpf(x); }
__device__ __forceinline__ float sigmoidf_(float x) { return frcp(1.0f + __expf(-x)); }
__device__ __forceinline__ float siluf_(float x) { return x * frcp(1.0f + __expf(-x)); }
__device__ __forceinline__ float gelu_tanh(float x) {
    const float y = 0.7978845608028654f * (x + 0.044715f * x * x * x);
    return x * frcp(1.0f + __expf(-2.0f * y));
}
__device__ __forceinline__ float softplusf_(float x) { return fmaxf(x, 0.f) + log1pf(expf(-fabsf(x))); }
__device__ __forceinline__ float wave_sum(float v) {
#pragma unroll
    for (int o = 1; o < 64; o <<= 1) v += __shfl_xor(v, o);
    return v;
}
constexpr int CSTR = 64;
__device__ __forceinline__ int pstart_of(const int* __restrict__ counts, int e) {
    int acc = 0;
    for (int i = 0; i < NE; ++i) { const int p = ((counts[i * CSTR] + 255) >> 8) << 8; if (i < e) acc += p; }
    return acc;
}

namespace pg8 {
#define PG8_LAS __attribute__((address_space(3)))
typedef unsigned short bf16_t;
typedef short bf16x8 __attribute__((ext_vector_type(8)));
typedef float f32x4 __attribute__((ext_vector_type(4)));
typedef unsigned u32x4 __attribute__((ext_vector_type(4)));
constexpr int BM = 256, BK = 64, HALF = 128, HTB = HALF * BK * 2  , STAGE_BYTES = 8 * HTB, NXCD = 8, WGM = 8;

__host__ __device__ __forceinline__ int lds_byte(int r, int c) { const int st = (r >> 4) * 2 + (c >> 5), rr = r & 15, cc = c & 31, ob = rr * 64 + cc * 2; return st * 1024 + (ob ^ (((ob >> 9) & 1) << 5)); }
__host__ __device__ __forceinline__ void stage_rc(int b, int& R, int& C) { const int st = b / 1024, sb = b % 1024, swz = sb ^ (((sb >> 9) & 1) << 5); R = (st >> 1) * 16 + swz / 64; C = (st & 1) * 32 + (swz % 64) / 2; }
__host__ __device__ __forceinline__ int perm32(int rho) { const int n = rho >> 4, i = rho & 15; return 8 * (i >> 2) + 4 * n + (i & 3); }

struct Unit { int pm, pn; };
struct Gemm { const bf16_t* A; const bf16_t* Bt; int M, N, K; };

struct StaticOrder {
    static constexpr bool GATHER = false; const int* rowtok = nullptr;
    int nM, nN, nwg, G, c;
    __host__ __device__ void init(int M, int N, int G_, int c_) { nM = M / BM; nN = N / BM; nwg = nM * nN; G = G_; c = c_; }
    __host__ __device__ bool next(int i, Unit& u) const {
        const long L = (long)i * G + c; if (L >= nwg) return false;
        int wgid = (int)L; { const int q = nwg / NXCD, r = nwg % NXCD, xcd = wgid % NXCD, off = wgid / NXCD; wgid = (xcd < r ? xcd * (q + 1) : r * (q + 1) + (xcd - r) * q) + off; }
        const int nig = WGM * nN, gid = wgid / nig, fm = gid * WGM, gsz = (nM - fm) < WGM ? (nM - fm) : WGM;
        u.pm = fm + ((wgid % nig) % gsz); u.pn = (wgid % nig) / gsz; return true;
    }
    __device__ __forceinline__ void a_ready(const Unit&) const {}
    __device__ __forceinline__ void done(const Unit&) const {}
};

__device__ __forceinline__ unsigned cvt_pk_bf16(float lo, float hi) { unsigned r; asm volatile("v_cvt_pk_bf16_f32 %0, %1, %2" : "=v"(r) : "v"(lo), "v"(hi)); return r; }

struct EpiInProj {
    static constexpr bool PERM = true, AFTER_DRAIN = false;
    bf16_t* P;
    __device__ __forceinline__ void operator()(const f32x4 (&acc)[2][2][4][2], const Unit& u, int wr, int wc, int fr_, int fq_) const {
        int fr = fr_, fq = fq_; asm volatile("" : "+v"(fr), "+v"(fq));
        const int row0 = u.pm * BM + wr * 64 + fr, col0 = u.pn * BM + wc * 32 + 8 * fq, grp = u.pn >> 1;
#pragma unroll
        for (int ai = 0; ai < 2; ++ai)
#pragma unroll
            for (int m = 0; m < 4; ++m) { bf16_t* rowp = P + (size_t)(row0 + ai * HALF + m * 16) * NIN + col0;
#pragma unroll
                for (int bj = 0; bj < 2; ++bj) { f32x4 v0 = acc[ai][bj][m][0], v1 = acc[ai][bj][m][1];
                    if (grp == 1) {
#pragma unroll
                        for (int j = 0; j < 4; ++j) { v0[j] = gelu_tanh(v0[j]); v1[j] = gelu_tanh(v1[j]); } }
                    else if (grp == 2 || grp == 6) {
#pragma unroll
                        for (int j = 0; j < 4; ++j) { v0[j] = siluf_(v0[j]); v1[j] = siluf_(v1[j]); } }
                    u32x4 w; w.x = cvt_pk_bf16(v0[0], v0[1]); w.y = cvt_pk_bf16(v0[2], v0[3]); w.z = cvt_pk_bf16(v1[0], v1[1]); w.w = cvt_pk_bf16(v1[2], v1[3]);
                    *(u32x4*)(rowp + bj * HALF) = w; } }
    }
};
struct EpiF32 {
    static constexpr bool PERM = false, AFTER_DRAIN = false;
    float* C; int ldc; int pad;
    __device__ __forceinline__ void operator()(const f32x4 (&acc)[2][2][4][2], const Unit& u, int wr, int wc, int fr_, int fq_) const {
        int fr = fr_, fq = fq_; asm volatile("" : "+v"(fr), "+v"(fq));
        const int row0 = u.pm * BM + wr * 64 + fr, col0 = u.pn * BM + wc * 32 + 4 * fq;
#pragma unroll
        for (int ai = 0; ai < 2; ++ai)
#pragma unroll
            for (int m = 0; m < 4; ++m) { float* rowp = C + (size_t)(row0 + ai * HALF + m * 16) * ldc + col0;
#pragma unroll
                for (int bj = 0; bj < 2; ++bj)
#pragma unroll
                    for (int n = 0; n < 2; ++n) *(f32x4*)(rowp + bj * HALF + n * 16) = acc[ai][bj][m][n]; }
    }
};
struct EpiExp1 {
    static constexpr bool PERM = false, AFTER_DRAIN = false;
    bf16_t* H;
    __device__ __forceinline__ void operator()(const f32x4 (&acc)[2][2][4][2], const Unit& u, int wr, int wc, int fr_, int fq_) const {
        int fr = fr_, fq = fq_; asm volatile("" : "+v"(fr), "+v"(fq));
        const int row0 = u.pm * BM + wr * 64 + fr, hc0 = (((u.pn & 3) * BM + wc * 32) >> 1) + 4 * fq;
#pragma unroll
        for (int ai = 0; ai < 2; ++ai)
#pragma unroll
            for (int m = 0; m < 4; ++m) { bf16_t* rowp = H + (size_t)(row0 + ai * HALF + m * 16) * DE + hc0;
#pragma unroll
                for (int bj = 0; bj < 2; ++bj) { const f32x4 a = acc[ai][bj][m][0], b = acc[ai][bj][m][1];
                    u32x2 w; w.x = cvt_pk_bf16(siluf_(a[0]) * b[0], siluf_(a[1]) * b[1]); w.y = cvt_pk_bf16(siluf_(a[2]) * b[2], siluf_(a[3]) * b[3]);
                    *(u32x2*)(rowp + bj * 64) = w; } }
    }
};
struct EpiY {
    static constexpr bool PERM = true, AFTER_DRAIN = false;
    bf16_t* Y;
    __device__ __forceinline__ void operator()(const f32x4 (&acc)[2][2][4][2], const Unit& u, int wr, int wc, int fr_, int fq_) const {
        int fr = fr_, fq = fq_; asm volatile("" : "+v"(fr), "+v"(fq));
        const int row0 = u.pm * BM + wr * 64 + fr, col0 = (u.pn & 3) * BM + wc * 32 + 8 * fq;
#pragma unroll
        for (int ai = 0; ai < 2; ++ai)
#pragma unroll
            for (int m = 0; m < 4; ++m) { bf16_t* rowp = Y + (size_t)(row0 + ai * HALF + m * 16) * DM + col0;
#pragma unroll
                for (int bj = 0; bj < 2; ++bj) { const f32x4 v0 = acc[ai][bj][m][0], v1 = acc[ai][bj][m][1];
                    u32x4 w; w.x = cvt_pk_bf16(v0[0], v0[1]); w.y = cvt_pk_bf16(v0[2], v0[3]); w.z = cvt_pk_bf16(v1[0], v1[1]); w.w = cvt_pk_bf16(v1[2], v1[3]);
                    *(u32x4*)(rowp + bj * HALF) = w; } }
    }
};
template <bool GATHER_>
struct ExpertOrderT {
    static constexpr bool GATHER = GATHER_;
    const int* counts; const int* rowtok; int G, c;
    __device__ __forceinline__ bool next(int i, Unit& u) const {
        const int L = i * G + c, rb = L >> 2; int acc = 0, ef = -1;
        for (int e = 0; e < NE; ++e) { const int nb = (counts[e * CSTR] + 255) >> 8; if (rb >= acc && rb < acc + nb) ef = e; acc += nb; }
        if (ef < 0) return false;
        u.pm = rb; u.pn = ef * 4 + (L & 3); return true;
    }
    __device__ __forceinline__ void a_ready(const Unit&) const {}
    __device__ __forceinline__ void done(const Unit&) const {}
};
typedef ExpertOrderT<false> ExpertOrder;
typedef ExpertOrderT<true> ExpertOrderG;

template <class Epi, class Sched, bool ALIGN_EPI = false, bool SP2 = false>
__device__ __forceinline__ void gemm_phase(PG8_LAS unsigned char* lds, const Gemm g, const Sched& S, const Epi& E) {
    int tid_o = threadIdx.x; asm volatile("" : "+v"(tid_o));
    const int tid = tid_o, wid = __builtin_amdgcn_readfirstlane(tid >> 6), lane = tid & 63, wr = wid >> 2, wc = wid & 3, fr = lane & 15, fq = lane >> 4;
    static_assert(SP2 || !Sched::GATHER, "the gathered A operand is wired into the SP2 loop only");
    const int K = g.K, nt = K / BK;
    unsigned voffA[2], voffB[2];
    unsigned gAc[2][2], gAn[2][2]; int gR[2], gC[2];
#pragma unroll
    for (int i = 0; i < 2; ++i) { int R, C; stage_rc(tid * 16 + i * 8192, R, C); const int Rb = Epi::PERM ? ((R & ~31) + perm32(R & 31)) : R;
        voffA[i] = (unsigned)(R * K + C) * 2u; voffB[i] = (unsigned)(Rb * K + C) * 2u; gR[i] = R; gC[i] = C; }
    const size_t kstep = (size_t)(BK * 2);
    const size_t hstep = (size_t)HALF * K * 2;
    const size_t tstep = 2 * hstep;
    const unsigned ldsw = (unsigned)wid * 1024u;
    const int aoff = lds_byte(wr * 64 + fr, fq * 8), boff = lds_byte(wc * 32 + fr, fq * 8);
#define PG8_SA(b, h) (((b) * 2 + (h)) * HTB)
#define PG8_SB(b, h) ((4 + (b) * 2 + (h)) * HTB)
#define PG8_STAGE(bufoff, gbase, voff) do { _Pragma("unroll") for (int _i = 0; _i < 2; ++_i) \
        __builtin_amdgcn_global_load_lds((const unsigned*)((const char*)(gbase) + (voff)[_i]), (PG8_LAS unsigned*)(lds + (bufoff) + ldsw + _i * 8192), 16, 0, 0); } while (0)
#define PG8_STAGE_A(bufoff, ptr, h, goff) do { if constexpr (Sched::GATHER) { PG8_STAGE(bufoff, ptr, (goff)[h]); } else { PG8_STAGE(bufoff, (ptr) + (h) * hstep, voffA); } } while (0)
#define PG8_GLOAD(dst, u) do { _Pragma("unroll") for (int _h = 0; _h < 2; ++_h) _Pragma("unroll") for (int _i = 0; _i < 2; ++_i) \
        dst[_h][_i] = (unsigned)S.rowtok[(u).pm * BM + _h * HALF + gR[_i]] * (unsigned)(K * 2) + (unsigned)(gC[_i] * 2); } while (0)
#define PG8_LDA(dst, b, h) do { _Pragma("unroll") for (int m = 0; m < 4; ++m) _Pragma("unroll") for (int k = 0; k < 2; ++k) dst[m][k] = *(const PG8_LAS bf16x8*)(lds + PG8_SA(b, h) + aoff + m * 2048 + k * 1024); } while (0)
#define PG8_LDB(dst, b, h) do { _Pragma("unroll") for (int n = 0; n < 2; ++n) _Pragma("unroll") for (int k = 0; k < 2; ++k) dst[n][k] = *(const PG8_LAS bf16x8*)(lds + PG8_SB(b, h) + boff + n * 2048 + k * 1024); } while (0)
#define PG8_MMA(ai, bj, At, Bt) do { __builtin_amdgcn_s_setprio(1); _Pragma("unroll") for (int m = 0; m < 4; ++m) _Pragma("unroll") for (int n = 0; n < 2; ++n) _Pragma("unroll") for (int k = 0; k < 2; ++k) \
        acc[ai][bj][m][n] = __builtin_amdgcn_mfma_f32_16x16x32_bf16(Bt[n][k], At[m][k], acc[ai][bj][m][n], 0, 0, 0); __builtin_amdgcn_s_setprio(0); } while (0)
#define PG8_WAIT_V(n) asm volatile("s_waitcnt vmcnt(" #n ")" ::: "memory")
#define PG8_WAIT_L(n) asm volatile("s_waitcnt lgkmcnt(" #n ")" ::: "memory")
#define PG8_BAR __builtin_amdgcn_s_barrier()
#define PG8_SCHED __builtin_amdgcn_sched_barrier(0)
    Unit cur, nxt; int ui = 0;
    if (!S.next(0, cur)) return;
    f32x4 acc[2][2][4][2];
#pragma unroll
    for (int a = 0; a < 2; ++a)
#pragma unroll
        for (int b = 0; b < 2; ++b)
#pragma unroll
            for (int m = 0; m < 4; ++m)
#pragma unroll
                for (int n = 0; n < 2; ++n) acc[a][b][m][n] = (f32x4){0.f, 0.f, 0.f, 0.f};
    bf16x8 At[4][2], B0[2][2], B1[2][2];
    const char* cA = (const char*)g.A + (Sched::GATHER ? (size_t)0 : (size_t)cur.pm * tstep); const char* cB = (const char*)g.Bt + (size_t)cur.pn * tstep;
    if constexpr (Sched::GATHER) { PG8_GLOAD(gAc, cur); }
    S.a_ready(cur);
    if constexpr (SP2) {
        PG8_STAGE(PG8_SB(0, 0), cB, voffB); PG8_STAGE(PG8_SB(0, 1), cB + hstep, voffB); PG8_STAGE_A(PG8_SA(0, 0), cA, 0, gAc); PG8_STAGE_A(PG8_SA(0, 1), cA, 1, gAc);
        if (wr == 1) PG8_BAR;
        PG8_WAIT_V(2); PG8_BAR;
        PG8_STAGE(PG8_SB(1, 0), cB + kstep, voffB); PG8_STAGE_A(PG8_SA(1, 0), cA + kstep, 0, gAc); PG8_STAGE(PG8_SB(1, 1), cB + hstep + kstep, voffB);
        PG8_WAIT_V(6); PG8_BAR;
    } else {
        PG8_STAGE(PG8_SB(0, 0), cB, voffB); PG8_STAGE(PG8_SA(0, 0), cA, voffA); PG8_STAGE(PG8_SB(0, 1), cB + hstep, voffB); PG8_STAGE(PG8_SA(0, 1), cA + hstep, voffA);
        if (wr == 1) PG8_BAR;
        PG8_WAIT_V(4); PG8_BAR;
        PG8_STAGE(PG8_SB(1, 0), cB + kstep, voffB); PG8_STAGE(PG8_SA(1, 0), cA + kstep, voffA); PG8_STAGE(PG8_SB(1, 1), cB + hstep + kstep, voffB);
        PG8_WAIT_V(6); PG8_BAR;
    }
    for (;;) {
        const bool has_next = S.next(ui + 1, nxt);
        const char* nA = (has_next && !Sched::GATHER) ? (const char*)g.A + (size_t)nxt.pm * tstep : cA;
        if constexpr (Sched::GATHER) { if (has_next) { PG8_GLOAD(gAn, nxt); } else { _Pragma("unroll") for (int _h = 0; _h < 2; ++_h) _Pragma("unroll") for (int _i = 0; _i < 2; ++_i) gAn[_h][_i] = gAc[_h][_i]; } }
        const char* nB = has_next ? (const char*)g.Bt + (size_t)nxt.pn * tstep : cB;
        for (int t = 0; t < nt; t += 2) {
            const bool last = (t == nt - 2);
            const char* a1 = cA + (size_t)(t + 1) * kstep;
            const char* a2 = last ? nA : cA + (size_t)(t + 2) * kstep; const char* b2 = last ? nB : cB + (size_t)(t + 2) * kstep;
            const char* a3 = a2 + kstep; const char* b3 = b2 + kstep;
            if (last && has_next) S.a_ready(nxt);
            unsigned g2[2][2];
            if constexpr (Sched::GATHER) { _Pragma("unroll") for (int _h = 0; _h < 2; ++_h) _Pragma("unroll") for (int _i = 0; _i < 2; ++_i) g2[_h][_i] = last ? gAn[_h][_i] : gAc[_h][_i]; }
            if constexpr (SP2) {
            PG8_LDB(B0, 0, 0); PG8_LDB(B1, 0, 1); PG8_SCHED; PG8_LDA(At, 0, 0); PG8_STAGE_A(PG8_SA(1, 1), a1, 1, gAc);
            PG8_WAIT_V(8); PG8_WAIT_L(0); PG8_BAR; PG8_MMA(0, 0, At, B0); PG8_MMA(0, 1, At, B1); PG8_BAR; PG8_SCHED;
            PG8_LDA(At, 0, 1); PG8_STAGE(PG8_SB(0, 0), b2, voffB); PG8_STAGE(PG8_SB(0, 1), b2 + hstep, voffB); PG8_STAGE_A(PG8_SA(0, 0), a2, 0, g2);
            PG8_WAIT_V(8); PG8_WAIT_L(0); PG8_BAR; PG8_MMA(1, 0, At, B0); PG8_MMA(1, 1, At, B1); PG8_BAR; PG8_SCHED;
            PG8_LDB(B0, 1, 0); PG8_LDB(B1, 1, 1); PG8_SCHED; PG8_LDA(At, 1, 0); PG8_STAGE_A(PG8_SA(0, 1), a2, 1, g2);
            PG8_WAIT_V(8); PG8_WAIT_L(0); PG8_BAR; PG8_MMA(0, 0, At, B0); PG8_MMA(0, 1, At, B1); PG8_BAR; PG8_SCHED;
            PG8_LDA(At, 1, 1); PG8_STAGE(PG8_SB(1, 0), b3, voffB); PG8_STAGE(PG8_SB(1, 1), b3 + hstep, voffB); PG8_STAGE_A(PG8_SA(1, 0), a3, 0, g2);
            PG8_WAIT_V(8); PG8_WAIT_L(0); PG8_BAR; PG8_MMA(1, 0, At, B0); PG8_MMA(1, 1, At, B1); PG8_BAR; PG8_SCHED;
            } else {
            PG8_LDB(B0, 0, 0); PG8_SCHED; PG8_LDA(At, 0, 0); PG8_STAGE(PG8_SA(1, 1), a1 + hstep, voffA);
            PG8_WAIT_L(8); PG8_BAR; PG8_WAIT_L(0); PG8_MMA(0, 0, At, B0); PG8_BAR; PG8_SCHED;
            PG8_LDB(B1, 0, 1); PG8_STAGE(PG8_SB(0, 0), b2, voffB);
            PG8_BAR; PG8_WAIT_L(0); PG8_MMA(0, 1, At, B1); PG8_BAR;
            PG8_LDA(At, 0, 1); PG8_STAGE(PG8_SA(0, 0), a2, voffA);
            PG8_BAR; PG8_WAIT_L(0); PG8_MMA(1, 0, At, B0); PG8_BAR; PG8_SCHED;
            PG8_STAGE(PG8_SB(0, 1), b2 + hstep, voffB);
            PG8_WAIT_V(6); PG8_BAR; PG8_MMA(1, 1, At, B1); PG8_BAR;
            PG8_LDB(B0, 1, 0); PG8_SCHED; PG8_LDA(At, 1, 0); PG8_STAGE(PG8_SA(0, 1), a2 + hstep, voffA);
            PG8_WAIT_L(8); PG8_BAR; PG8_WAIT_L(0); PG8_MMA(0, 0, At, B0); PG8_BAR; PG8_SCHED;
            PG8_LDB(B1, 1, 1); PG8_STAGE(PG8_SB(1, 0), b3, voffB);
            PG8_BAR; PG8_WAIT_L(0); PG8_MMA(0, 1, At, B1); PG8_BAR;
            PG8_LDA(At, 1, 1); PG8_STAGE(PG8_SA(1, 0), a3, voffA);
            PG8_BAR; PG8_WAIT_L(0); PG8_MMA(1, 0, At, B0); PG8_BAR; PG8_SCHED;
            PG8_STAGE(PG8_SB(1, 1), b3 + hstep, voffB);
            PG8_WAIT_V(6); PG8_BAR; PG8_MMA(1, 1, At, B1); PG8_BAR;
            }
        }
        if constexpr (ALIGN_EPI) { if (wr == 0) PG8_BAR; }
        if constexpr (!Epi::AFTER_DRAIN) { E(acc, cur, wr, wc, fr, fq); S.done(cur); }
        if (!has_next) break;
#pragma unroll
        for (int a = 0; a < 2; ++a)
#pragma unroll
            for (int b = 0; b < 2; ++b)
#pragma unroll
                for (int m = 0; m < 4; ++m)
#pragma unroll
                    for (int n = 0; n < 2; ++n) acc[a][b][m][n] = (f32x4){0.f, 0.f, 0.f, 0.f};
        cur = nxt; cA = nA; cB = nB; ++ui;
        if constexpr (Sched::GATHER) { _Pragma("unroll") for (int _h = 0; _h < 2; ++_h) _Pragma("unroll") for (int _i = 0; _i < 2; ++_i) gAc[_h][_i] = gAn[_h][_i]; }
        if constexpr (ALIGN_EPI) { if (wr == 1) PG8_BAR; }
    }
    PG8_WAIT_V(0);
    if constexpr (!ALIGN_EPI) { if (wr == 0) PG8_BAR; }
    PG8_BAR;
    if constexpr (Epi::AFTER_DRAIN) { E.fused(acc, cur, wr, wc, fr, fq, lds, wid, lane); S.done(cur); }
#undef PG8_SA
#undef PG8_SB
#undef PG8_STAGE
#undef PG8_STAGE_A
#undef PG8_GLOAD
#undef PG8_LDA
#undef PG8_LDB
#undef PG8_MMA
#undef PG8_WAIT_V
#undef PG8_WAIT_L
#undef PG8_BAR
#undef PG8_SCHED
}
}

struct Args { const float* in[26]; float* out; unsigned char* ws; };

__device__ __forceinline__ void p_mod(LAS unsigned char* lds, const float* __restrict__ c, const float* __restrict__ c_ctx, const float* __restrict__ ada_w,
                                      const float* __restrict__ ada_b, float* __restrict__ mod, int bid, int G, int tid) {
    if (bid >= 96) return;
    LAS float* s = (LAS float*)lds;
    LAS float* red = s + 17 * 1024;
    for (int i = tid; i < 17 * 1024; i += NTHREADS) { const int r = i >> 10, k = i & 1023; const float v = r < NB ? c[r * DM + k] : c_ctx[k]; s[i] = v / (1.0f + expf(-v)); }
    __syncthreads();
    for (int it = bid; it < 96; it += G) {
        const int cc = tid & 63, kg = tid >> 6, col = it * 64 + cc;
        float acc[17];
#pragma unroll
        for (int r = 0; r < 17; ++r) acc[r] = 0.f;
        for (int k = kg * 128; k < kg * 128 + 128; ++k) {
            const float w = ada_w[(size_t)k * 6144 + col];
#pragma unroll
            for (int r = 0; r < 17; ++r) acc[r] += s[r * 1024 + k] * w;
        }
#pragma unroll
        for (int r = 0; r < 17; ++r) red[(kg * 17 + r) * 64 + cc] = acc[r];
        __syncthreads();
        for (int i = tid; i < 17 * 64; i += NTHREADS) {
            const int r = i >> 6, c2 = i & 63; float sum = 0.f;
#pragma unroll
            for (int g = 0; g < 8; ++g) sum += red[(g * 17 + r) * 64 + c2];
            mod[(size_t)r * 6144 + it * 64 + c2] = sum + ada_b[it * 64 + c2];
        }
        __syncthreads();
    }
}

__device__ __forceinline__ void transpose_tile(LAS float* tile, const float* __restrict__ W, int K, int N, bf16_t* __restrict__ O, int mode, int k0, int n0, int tid) {
    for (int i = tid; i < 64 * 64; i += NTHREADS) { const int kk = i >> 6, nn = i & 63; tile[kk * 65 + nn] = W[(size_t)(k0 + kk) * N + n0 + nn]; }
    __syncthreads();
    for (int i = tid; i < 64 * 32; i += NTHREADS) {
        const int nn = i >> 5, kp = i & 31, n = n0 + nn;
        const int orow = mode == 0 ? n : ((n >> 4) * 32 + (mode == 2 ? 16 : 0) + (n & 15));
        *(unsigned*)(O + (size_t)orow * K + k0 + 2 * kp) = pk2(tile[(2 * kp) * 65 + nn], tile[(2 * kp + 1) * 65 + nn]);
    }
    __syncthreads();
}
__device__ __forceinline__ void p_transposes(LAS unsigned char* lds, const Args& a, int bid, int G, int tid) {
    LAS float* tile = (LAS float*)lds;
    unsigned char* ws = a.ws;
    constexpr int I_IN = 16 * 56, I_OUT = 16 * 16, I_E = 32 * 128;
    constexpr int NITEMS = I_IN + I_OUT + 3 * I_E;
    for (int it = bid; it < NITEMS; it += G) {
        int r = it;
        if (r < I_IN) { transpose_tile(tile, a.in[6], DM, NIN, (bf16_t*)(ws + WS_WINT), 0, (r & 15) * 64, (r >> 4) * 64, tid); continue; } r -= I_IN;
        if (r < I_OUT) { transpose_tile(tile, a.in[14], DM, DM, (bf16_t*)(ws + WS_WOUTT), 0, (r & 15) * 64, (r >> 4) * 64, tid); continue; } r -= I_OUT;
        if (r < I_E) { const int e = r >> 7, q = r & 127; transpose_tile(tile, a.in[21] + (size_t)e * DM * DE, DM, DE, (bf16_t*)(ws + WS_W13T) + (size_t)e * DM * DM, 1, (q & 15) * 64, (q >> 4) * 64, tid); continue; } r -= I_E;
        if (r < I_E) { const int e = r >> 7, q = r & 127; transpose_tile(tile, a.in[22] + (size_t)e * DM * DE, DM, DE, (bf16_t*)(ws + WS_W13T) + (size_t)e * DM * DM, 2, (q & 15) * 64, (q >> 4) * 64, tid); continue; } r -= I_E;
        { const int e = r >> 7, q = r & 127; transpose_tile(tile, a.in[23] + (size_t)e * DE * DM, DE, DM, (bf16_t*)(ws + WS_W2T) + (size_t)e * DM * DE, 0, (q & 7) * 64, (q >> 3) * 64, tid); }
    }
}

__device__ __forceinline__ void p_u(const float* __restrict__ x, const float* __restrict__ ctx, const float* __restrict__ mod, bf16_t* __restrict__ U, int bid, int G, int tid) {
    for (size_t i4 = (size_t)bid * NTHREADS + tid; i4 < (size_t)TA * 256; i4 += (size_t)G * NTHREADS) {
        const int row = (int)(i4 >> 8), c4 = (int)(i4 & 255) * 4;
        const float* src; const float* m;
        if (row < T) { src = x + (size_t)row * DM; m = mod + (size_t)(row / SEQ) * 6144; }
        else { src = ctx + (size_t)(row - T) * DM; m = mod + (size_t)16 * 6144; }
        const f32x4 v = *(const f32x4*)(src + c4), sh = *(const f32x4*)(m + c4), sc = *(const f32x4*)(m + 1024 + c4);
        u32x2 w; w.x = pk2(v[0] * (1.f + sc[0]) + sh[0], v[1] * (1.f + sc[1]) + sh[1]); w.y = pk2(v[2] * (1.f + sc[2]) + sh[2], v[3] * (1.f + sc[3]) + sh[3]);
        *(u32x2*)(U + (size_t)row * DM + c4) = w;
    }
}

__device__ __forceinline__ void router_decide(const float (&pl)[36], int slot, int lane, LAS int* lcnt, LAS i32x4* tinfo, LAS f32x2* tw) {
    int gi = 0; float gm = pl[0];
#pragma unroll
    for (int g = 1; g < 4; ++g) if (pl[g] > gm) { gm = pl[g]; gi = g; }
    float den = 0.f;
#pragma unroll
    for (int g = 0; g < 4; ++g) den += __expf(pl[g] - gm);
    const float gval = frcp(den);
    int j0 = -1; float v0 = -3.0e38f;
#pragma unroll
    for (int j = 0; j < 32; ++j) { const bool in = (j >> 3) == gi; if (in && (j0 < 0 || pl[4 + j] > v0)) { v0 = pl[4 + j]; j0 = j; } }
    int j1 = -1; float v1 = -3.0e38f;
#pragma unroll
    for (int j = 0; j < 32; ++j) { const bool in = (j >> 3) == gi; if (in && j != j0 && (j1 < 0 || pl[4 + j] > v1)) { v1 = pl[4 + j]; j1 = j; } }
    if (lane == 0) {
        const float t = __expf(v1 - v0), w0 = frcp(1.0f + t), w1 = t * w0;
        const int p0 = __hip_atomic_fetch_add(lcnt + j0, 1, __ATOMIC_RELAXED, __HIP_MEMORY_SCOPE_WORKGROUP), p1 = __hip_atomic_fetch_add(lcnt + j1, 1, __ATOMIC_RELAXED, __HIP_MEMORY_SCOPE_WORKGROUP);
        tinfo[slot] = (i32x4){j0, j1, p0, p1}; tw[slot] = (f32x2){gval * w0, gval * w1};
    }
}
__device__ __forceinline__ void p_ln1_router(LAS unsigned char* lds, const Args& a, int bid, int G, int tid, int wave, int lane, bool dry = false) {
    const float* __restrict__ x = a.in[0]; const float* yo = a.out; float* h1o = dry ? (float*)(a.ws + WS_XG) : a.out; const float* mod = (const float*)(a.ws + WS_MOD);
    const float* __restrict__ ln_g = a.in[15]; const float* __restrict__ ln_b = a.in[16];
    const float* __restrict__ rgw = a.in[17]; const float* __restrict__ rgb = a.in[18]; const float* __restrict__ rew = a.in[19]; const float* __restrict__ reb = a.in[20];
    bf16_t* U2 = (bf16_t*)(a.ws + (dry ? WS_HID : WS_U)); int* counts = (int*)(a.ws + WS_CTL) + (dry ? 32 * CSTR : 0);
    int2* eidx = (int2*)(a.ws + (dry ? WS_Y : WS_EIDX)); int2* epos = (int2*)(a.ws + (dry ? WS_Y + 4 * MiB : WS_EPOS)); float2* ew = (float2*)(a.ws + (dry ? WS_Y + 8 * MiB : WS_EW));
    LAS float* WT = (LAS float*)lds;
    for (int i = tid; i < 1024 * 4; i += NTHREADS) WT[(i & 3) * 1024 + (i >> 2)] = rgw[i];
    for (int i = tid; i < 1024 * 32; i += NTHREADS) WT[(4 + (i & 31)) * 1024 + (i >> 5)] = rew[i];
    LAS float* BIAS = WT + 36 * 1024;
    LAS int* lcnt = (LAS int*)(BIAS + 64);
    LAS int* lbase = lcnt + 32;
    LAS i32x4* tinfo = (LAS i32x4*)(lbase + 32);
    LAS f32x2* tw = (LAS f32x2*)(tinfo + 256);
    if (tid < 36) BIAS[tid] = tid < 4 ? rgb[tid] : reb[tid - 4];
    if (tid < 32) lcnt[tid] = 0;
    __syncthreads();
    int nslot = 0;
#pragma unroll 1
    for (int pr = bid * 8 + wave; pr < T / 2; pr += G * 8) {
        int l2 = lane; asm volatile("" : "+v"(l2)); const int lane = l2;
        const int tok0 = 2 * pr;
        const float* m = mod + (size_t)(tok0 / SEQ) * 6144;
        f32x4 v[2][4]; float s[2] = {0.f, 0.f};
#pragma unroll
        for (int t = 0; t < 2; ++t)
#pragma unroll
            for (int j = 0; j < 4; ++j) { const int c4 = 4 * lane + 256 * j;
                const f32x4 xv = *(const f32x4*)(x + (size_t)(tok0 + t) * DM + c4), yv = *(const f32x4*)(yo + (size_t)(tok0 + t) * DM + c4), g1 = *(const f32x4*)(m + 2048 + c4);
                v[t][j] = ALPHA * xv + g1 * yv; s[t] += (v[t][j][0] + v[t][j][1]) + (v[t][j][2] + v[t][j][3]); }
        float rstd[2];
#pragma unroll
        for (int t = 0; t < 2; ++t) { const float mean = wave_sum(s[t]) * (1.0f / DM); float s2 = 0.f;
#pragma unroll
            for (int j = 0; j < 4; ++j) { v[t][j] = v[t][j] - mean; s2 += (v[t][j][0] * v[t][j][0] + v[t][j][1] * v[t][j][1]) + (v[t][j][2] * v[t][j][2] + v[t][j][3] * v[t][j][3]); }
            rstd[t] = rsqrtf(wave_sum(s2) * (1.0f / DM) + LN_EPS); }
        float plA[36], plB[36];
#pragma unroll
        for (int e = 0; e < 36; ++e) { plA[e] = 0.f; plB[e] = 0.f; }
#pragma unroll
        for (int j = 0; j < 4; ++j) { const int c4 = 4 * lane + 256 * j;
            const f32x4 lg = *(const f32x4*)(ln_g + c4), lb = *(const f32x4*)(ln_b + c4), sc2 = *(const f32x4*)(m + 4096 + c4), sh2 = *(const f32x4*)(m + 3072 + c4);
            f32x4 u2[2];
#pragma unroll
            for (int t = 0; t < 2; ++t) { const f32x4 h1 = v[t][j] * rstd[t] * lg + lb;
                *(f32x4*)(h1o + (size_t)(tok0 + t) * DM + c4) = h1;
                u2[t] = h1 * (1.0f + sc2) + sh2;
                u32x2 w; w.x = pk2(u2[t][0], u2[t][1]); w.y = pk2(u2[t][2], u2[t][3]);
                *(u32x2*)(U2 + (size_t)(tok0 + t) * DM + c4) = w; }
#pragma unroll
            for (int e = 0; e < 36; ++e) { const f32x4 w4 = *(const LAS f32x4*)(WT + e * 1024 + c4);
                plA[e] += (u2[0][0] * w4[0] + u2[0][1] * w4[1]) + (u2[0][2] * w4[2] + u2[0][3] * w4[3]);
                plB[e] += (u2[1][0] * w4[0] + u2[1][1] * w4[1]) + (u2[1][2] * w4[2] + u2[1][3] * w4[3]);
                if ((e % 6) == 5) __builtin_amdgcn_sched_barrier(0); }
        }
#pragma unroll
        for (int e = 0; e < 36; ++e) { const float be = BIAS[e]; plA[e] = wave_sum(plA[e]) + be; plB[e] = wave_sum(plB[e]) + be; if ((e & 3) == 3) __builtin_amdgcn_sched_barrier(0); }
        router_decide(plA, wave * 32 + nslot, lane, lcnt, tinfo, tw);
        router_decide(plB, wave * 32 + nslot + 1, lane, lcnt, tinfo, tw);
        nslot += 2;
    }
    __syncthreads();
    if (tid < 32) lbase[tid] = atomicAdd(&counts[tid * CSTR], lcnt[tid]);
    __syncthreads();
    if (lane < nslot) {
        const int pr = bid * 8 + wave + (lane >> 1) * (G * 8), tok = 2 * pr + (lane & 1);
        const i32x4 ti = tinfo[wave * 32 + lane]; const f32x2 wv = tw[wave * 32 + lane];
        eidx[tok] = make_int2(ti[0], ti[1]); epos[tok] = make_int2(lbase[ti[0]] + ti[2], lbase[ti[1]] + ti[3]); ew[tok] = make_float2(wv[0], wv[1]);
    }
    __syncthreads();
}

constexpr size_t WS_ROWTOK = 5 * MiB;
__device__ __forceinline__ void p_assign(LAS unsigned char* lds, const Args& a, int bid, int G, int tid) {
    const int* counts = (const int*)(a.ws + WS_CTL);
    const int2* eidx = (const int2*)(a.ws + WS_EIDX); const int2* epos = (const int2*)(a.ws + WS_EPOS); int2* dest = (int2*)(a.ws + WS_DEST); int* rowtok = (int*)(a.ws + WS_ROWTOK);
    LAS int* ps = (LAS int*)lds;
    if (tid == 0) { int acc = 0; for (int e = 0; e < NE; ++e) { const int c = counts[e * CSTR]; ps[e] = acc; ps[32 + e] = c; acc += ((c + 255) >> 8) << 8; } }
    __syncthreads();
    for (int tok = bid * NTHREADS + tid; tok < T; tok += G * NTHREADS) {
        const int2 ei = eidx[tok], ep = epos[tok];
        const int d0 = ps[ei.x] + ep.x, d1 = ps[ei.y] + ep.y;
        rowtok[d0] = tok; rowtok[d1] = tok; dest[tok] = make_int2(d0, d1);
    }
    for (int i = bid * NTHREADS + tid; i < NE * 256; i += G * NTHREADS) {
        const int e = i >> 8, r = i & 255, c = ps[32 + e];
        if (c + r < (((c + 255) >> 8) << 8)) rowtok[ps[e] + c + r] = 0;
    }
    __syncthreads();
}

__device__ __forceinline__ void p_combine_ln2(const Args& a, int bid, int G, int wave, int lane, bool dry = false) {
    const float* out = a.out; float* outw = dry ? (float*)(a.ws + WS_XG) : a.out; const bf16_t* Y = (const bf16_t*)(a.ws + WS_Y); const int2* dest = (const int2*)(a.ws + WS_DEST); const float2* ew = (const float2*)(a.ws + WS_EW);
    const float* mod = (const float*)(a.ws + WS_MOD); const float* __restrict__ ln_g = a.in[24]; const float* __restrict__ ln_b = a.in[25];
    for (int tok = bid * 8 + wave; tok < T; tok += G * 8) {
        const float* m = mod + (size_t)(tok / SEQ) * 6144;
        const int2 d = dest[tok]; const float2 w = ew[tok];
        f32x4 v[4]; float s = 0.f;
#pragma unroll
        for (int j = 0; j < 4; ++j) { const int c4 = 4 * lane + 256 * j;
            const u32x2 ya = *(const u32x2*)(Y + (size_t)d.x * DM + c4), yb = *(const u32x2*)(Y + (size_t)d.y * DM + c4);
            f32x4 f;
            f[0] = w.x * __uint_as_float(ya.x << 16) + w.y * __uint_as_float(yb.x << 16);
            f[1] = w.x * __uint_as_float(ya.x & 0xffff0000u) + w.y * __uint_as_float(yb.x & 0xffff0000u);
            f[2] = w.x * __uint_as_float(ya.y << 16) + w.y * __uint_as_float(yb.y << 16);
            f[3] = w.x * __uint_as_float(ya.y & 0xffff0000u) + w.y * __uint_as_float(yb.y & 0xffff0000u);
            const f32x4 h1 = *(const f32x4*)(out + (size_t)tok * DM + c4), g2 = *(const f32x4*)(m + 5120 + c4);
            v[j] = ALPHA * h1 + g2 * f; s += (v[j][0] + v[j][1]) + (v[j][2] + v[j][3]); }
        const float mean = wave_sum(s) * (1.0f / DM); float s2 = 0.f;
#pragma unroll
        for (int j = 0; j < 4; ++j) { v[j] = v[j] - mean; s2 += (v[j][0] * v[j][0] + v[j][1] * v[j][1]) + (v[j][2] * v[j][2] + v[j][3] * v[j][3]); }
        const float rstd = rsqrtf(wave_sum(s2) * (1.0f / DM) + LN_EPS);
#pragma unroll
        for (int j = 0; j < 4; ++j) { const int c4 = 4 * lane + 256 * j;
            *(f32x4*)(outw + (size_t)tok * DM + c4) = v[j] * rstd * *(const f32x4*)(ln_g + c4) + *(const f32x4*)(ln_b + c4); }
    }
}

constexpr size_t WS_HGK = WS_U;
constexpr size_t WS_HGD = 852 * MiB;
constexpr size_t WS_RGAGG = 854 * MiB;
constexpr size_t WS_RGCARRY = 864 * MiB;
constexpr size_t WS_GWT = 870 * MiB;
constexpr size_t WS_OFST = 880 * MiB;
constexpr int RG_UNITS_PER_B = 68, HG_SEGS = 17;

__device__ __forceinline__ void lds_barrier() { asm volatile("s_waitcnt lgkmcnt(0)" ::: "memory"); __builtin_amdgcn_s_barrier(); asm volatile("" ::: "memory"); }
__device__ __forceinline__ bf16x8 mk_bf16x8(u32x4 v) { return __builtin_bit_cast(bf16x8, v); }
__device__ __forceinline__ float bf_lo(unsigned w) { return __uint_as_float(w << 16); }
__device__ __forceinline__ float bf_hi(unsigned w) { return __uint_as_float(w & 0xffff0000u); }
__device__ __forceinline__ unsigned cvt2(float lo, float hi) { unsigned r; asm volatile("v_cvt_pk_bf16_f32 %0, %1, %2" : "=v"(r) : "v"(lo), "v"(hi)); return r; }

__device__ __forceinline__ void p_gwt(const float* __restrict__ gate_w, bf16_t* __restrict__ gwt, int bid, int G, int tid) {
    for (int o = bid * NTHREADS + tid; o < 32 * 4096; o += G * NTHREADS) { const int mat = o >> 12, d = (o >> 6) & 63, c = o & 63; gwt[o] = f2bf(gate_w[mat * 4096 + c * 64 + d]); }
}

constexpr int XC_STRIDE = 1040;
constexpr int RG_XC = 0, RG_OUT = 64 * XC_STRIDE;
constexpr size_t WS_RGPAR = 876 * MiB;

__device__ __forceinline__ void p_rgpar(const float* __restrict__ gate_b, const float* __restrict__ lam, float* __restrict__ par, int bid, int G, int tid) {
    for (int o = bid * NTHREADS + tid; o < 2 * 512; o += G * NTHREADS) { const int dir = o >> 9, ch = o & 511;
        par[(dir * 3 + 0) * 512 + ch] = gate_b[(dir * 2 + 0) * 512 + ch]; par[(dir * 3 + 1) * 512 + ch] = gate_b[(dir * 2 + 1) * 512 + ch]; par[(dir * 3 + 2) * 512 + ch] = softplusf_(-lam[dir * 512 + ch]); }
}

template <int DIR, bool OUT>
__device__ __forceinline__ void rg_scan64(const float (&av)[4][4], const float (&uv)[4][4], float& carry, float& atot, float (&hsum)[4][4], int fr, int fq) {
#pragma unroll
    for (int mm = 0; mm < 4; ++mm) {
        const int m = DIR == 0 ? mm : 3 - mm;
        float P, H;
        if (DIR == 0) { P = av[m][0]; H = uv[m][0];
#pragma unroll
            for (int j = 1; j < 4; ++j) { H = av[m][j] * H + uv[m][j]; P *= av[m][j]; } }
        else { P = av[m][3]; H = uv[m][3];
#pragma unroll
            for (int j = 2; j >= 0; --j) { H = av[m][j] * H + uv[m][j]; P *= av[m][j]; } }
        float Pn, Hn, Pe, He, Pt, Ht;
        if (DIR == 0) {
            Pn = __shfl_up(P, 16); Hn = __shfl_up(H, 16); if (fq >= 1) { H = P * Hn + H; P = P * Pn; }
            Pn = __shfl_up(P, 32); Hn = __shfl_up(H, 32); if (fq >= 2) { H = P * Hn + H; P = P * Pn; }
            Pe = __shfl_up(P, 16); He = __shfl_up(H, 16); if (fq == 0) { Pe = 1.f; He = 0.f; }
            Pt = __shfl(P, fr + 48); Ht = __shfl(H, fr + 48);
        } else {
            Pn = __shfl_down(P, 16); Hn = __shfl_down(H, 16); if (fq <= 2) { H = P * Hn + H; P = P * Pn; }
            Pn = __shfl_down(P, 32); Hn = __shfl_down(H, 32); if (fq <= 1) { H = P * Hn + H; P = P * Pn; }
            Pe = __shfl_down(P, 16); He = __shfl_down(H, 16); if (fq == 3) { Pe = 1.f; He = 0.f; }
            Pt = __shfl(P, fr); Ht = __shfl(H, fr);
        }
        if (OUT) {
            float hp = Pe * carry + He;
            if (DIR == 0) {
#pragma unroll
                for (int j = 0; j < 4; ++j) { hp = av[m][j] * hp + uv[m][j]; hsum[m][j] = hp; }
            } else {
#pragma unroll
                for (int j = 3; j >= 0; --j) { hp = av[m][j] * hp + uv[m][j]; hsum[m][j] += hp; }
            }
        }
        carry = Pt * carry + Ht; atot *= Pt;
    }
}

__device__ __forceinline__ void rg_agg_unit(LAS unsigned char* lds, const Args& a, int b, int k, int tid, int wave, int lane) {
    const bf16_t* __restrict__ proj = (const bf16_t*)(a.ws + WS_PROJ);
    const float* __restrict__ conv_w = a.in[7]; const float* __restrict__ conv_b = a.in[8];
    const bf16_t* __restrict__ gwt = (const bf16_t*)(a.ws + WS_GWT); const float* __restrict__ par = (const float*)(a.ws + WS_RGPAR);
    float* rgagg = (float*)(a.ws + WS_RGAGG);
    int rowbase, p0, lo, hi;
    if (k < 4) { rowbase = T + b * LC; p0 = k * 64; lo = 0; hi = LC; } else { rowbase = b * SEQ; p0 = (k - 4) * 64; lo = p0; hi = p0 + 64; }
    const int unit = b * RG_UNITS_PER_B + k;
    const int n = wave, fr = lane & 15, fq = lane >> 4;
    float pgr[4][2], pgi[4][2], psp[4][2];
#pragma unroll
    for (int nt = 0; nt < 4; ++nt)
#pragma unroll
        for (int dir = 0; dir < 2; ++dir) { const int ch = n * 64 + nt * 16 + fr;
            pgr[nt][dir] = par[(dir * 3 + 0) * 512 + ch]; pgi[nt][dir] = par[(dir * 3 + 1) * 512 + ch]; psp[nt][dir] = par[(dir * 3 + 2) * 512 + ch]; }
    {
        const int cgp = tid & 63, tg = tid >> 6, c0 = cgp * 8, i0 = tg * 8;
        u32x4 raw[11];
#pragma unroll
        for (int r = 0; r < 11; ++r) { const int p = p0 + i0 - 1 + r;
            raw[r] = (p >= lo && p < hi) ? *(const u32x4*)(proj + (size_t)(rowbase + p) * NIN + c0) : (u32x4){0u, 0u, 0u, 0u}; }
        float cw[4][8], cb[8];
#pragma unroll
        for (int t4 = 0; t4 < 4; ++t4) { const f32x4 w0 = *(const f32x4*)(conv_w + t4 * 512 + c0), w1 = *(const f32x4*)(conv_w + t4 * 512 + c0 + 4);
#pragma unroll
            for (int q = 0; q < 4; ++q) { cw[t4][q] = w0[q]; cw[t4][4 + q] = w1[q]; } }
        { const f32x4 b0 = *(const f32x4*)(conv_b + c0), b1 = *(const f32x4*)(conv_b + c0 + 4);
#pragma unroll
            for (int q = 0; q < 4; ++q) { cb[q] = b0[q]; cb[4 + q] = b1[q]; } }
#pragma unroll
        for (int ii = 0; ii < 8; ++ii) {
            float xc[8];
#pragma unroll
            for (int c = 0; c < 8; ++c) xc[c] = cb[c];
#pragma unroll
            for (int t4 = 0; t4 < 4; ++t4) { const u32x4 rw = raw[ii + t4];
#pragma unroll
                for (int q = 0; q < 4; ++q) { xc[2 * q] += cw[t4][2 * q] * bf_lo(rw[q]); xc[2 * q + 1] += cw[t4][2 * q + 1] * bf_hi(rw[q]); } }
            u32x4 w; w.x = cvt2(xc[0], xc[1]); w.y = cvt2(xc[2], xc[3]); w.z = cvt2(xc[4], xc[5]); w.w = cvt2(xc[6], xc[7]);
            *(LAS u32x4*)(lds + RG_XC + (i0 + ii) * XC_STRIDE + c0 * 2) = w;
        }
    }
    lds_barrier();
    {
        bf16x8 afr[4][2];
#pragma unroll
        for (int m = 0; m < 4; ++m)
#pragma unroll
            for (int ks = 0; ks < 2; ++ks) afr[m][ks] = *(const LAS bf16x8*)(lds + RG_XC + (16 * m + fr) * XC_STRIDE + (n * 64 + ks * 32 + fq * 8) * 2);
        u32x4* stash = (k >= 4) ? (u32x4*)a.out + ((size_t)(b * 64 + (k - 4)) * 16384 + (size_t)wave * 2048 + lane) : nullptr;
        bf16x8 wfr[2][2][2];
#pragma unroll
        for (int dir = 0; dir < 2; ++dir)
#pragma unroll
            for (int g = 0; g < 2; ++g)
#pragma unroll
                for (int ks = 0; ks < 2; ++ks) wfr[dir][g][ks] = *(const bf16x8*)(gwt + ((size_t)(((dir * 2 + g) * 8 + n) * 64 + fr)) * 64 + ks * 32 + fq * 8);
#pragma unroll
        for (int nt = 0; nt < 4; ++nt) {
            const int ch = n * 64 + nt * 16 + fr;
            bf16x8 wnx[2][2][2];
            if (nt < 3) {
#pragma unroll
                for (int dir = 0; dir < 2; ++dir)
#pragma unroll
                    for (int g = 0; g < 2; ++g)
#pragma unroll
                        for (int ks = 0; ks < 2; ++ks) wnx[dir][g][ks] = *(const bf16x8*)(gwt + ((size_t)(((dir * 2 + g) * 8 + n) * 64 + (nt + 1) * 16 + fr)) * 64 + ks * 32 + fq * 8);
            }
            float xcv[4][4];
#pragma unroll
            for (int m = 0; m < 4; ++m)
#pragma unroll
                for (int j = 0; j < 4; ++j) xcv[m][j] = bf2f(*(const LAS bf16_t*)(lds + RG_XC + (16 * m + 4 * fq + j) * XC_STRIDE + ch * 2));
#pragma unroll
            for (int dir = 0; dir < 2; ++dir) {
                f32x4 accr[4], acci[4];
#pragma unroll
                for (int m = 0; m < 4; ++m) { accr[m] = (f32x4){0.f, 0.f, 0.f, 0.f}; acci[m] = (f32x4){0.f, 0.f, 0.f, 0.f}; }
#pragma unroll
                for (int ks = 0; ks < 2; ++ks)
#pragma unroll
                    for (int m = 0; m < 4; ++m) { accr[m] = __builtin_amdgcn_mfma_f32_16x16x32_bf16(afr[m][ks], wfr[dir][0][ks], accr[m], 0, 0, 0); acci[m] = __builtin_amdgcn_mfma_f32_16x16x32_bf16(afr[m][ks], wfr[dir][1][ks], acci[m], 0, 0, 0); }
                const float gbr = pgr[nt][dir], gbi = pgi[nt][dir], sp = psp[nt][dir];
                float av[4][4], uv[4][4];
                const bool exact = __any(8.0f * sp >= 0.25f);
#pragma unroll
                for (int m = 0; m < 4; ++m) {
                    unsigned pk[4];
                    if (!exact) {
#pragma unroll
                        for (int j = 0; j < 4; ++j) {
                            const float r = sigmoidf_(accr[m][j] + gbr), ig = sigmoidf_(acci[m][j] + gbi);
                            const float la = -8.0f * r * sp;
                            const float oma = -la * (1.f + la * (0.5f + la * (0.16666667f + la * (0.041666668f + la * 0.0083333338f))));
                            pk[j] = cvt2(oma, __builtin_amdgcn_sqrtf(oma * (2.0f - oma)) * ig * xcv[m][j]);
                        }
                    } else {
#pragma unroll
                        for (int j = 0; j < 4; ++j) {
                            const float r = sigmoidf_(accr[m][j] + gbr), ig = sigmoidf_(acci[m][j] + gbi);
                            const float la = -8.0f * r * sp;
                            const float ser = -la * (1.f + la * (0.5f + la * (0.16666667f + la * (0.041666668f + la * 0.0083333338f))));
                            const float oma = (la > -0.25f) ? ser : 1.f - __expf(la);
                            pk[j] = cvt2(oma, __builtin_amdgcn_sqrtf(oma * (2.0f - oma)) * ig * xcv[m][j]);
                        }
                    }
#pragma unroll
                    for (int j = 0; j < 4; ++j) { av[m][j] = 1.0f - bf_lo(pk[j]); uv[m][j] = bf_hi(pk[j]); }
                    if (stash) stash[((nt * 2 + dir) * 4 + m) * 64] = (u32x4){pk[0], pk[1], pk[2], pk[3]};
                }
                float carry = 0.f, atot = 1.f, hdummy[4][4];
                if (dir == 0) rg_scan64<0, false>(av, uv, carry, atot, hdummy, fr, fq); else rg_scan64<1, false>(av, uv, carry, atot, hdummy, fr, fq);
                if (fq == 0) { rgagg[(((size_t)unit * 2 + dir) * 2 + 0) * 512 + ch] = atot; rgagg[(((size_t)unit * 2 + dir) * 2 + 1) * 512 + ch] = carry; }
            }
            if (nt < 3) {
#pragma unroll
                for (int dir = 0; dir < 2; ++dir)
#pragma unroll
                    for (int g = 0; g < 2; ++g)
#pragma unroll
                        for (int ks = 0; ks < 2; ++ks) wfr[dir][g][ks] = wnx[dir][g][ks];
            }
        }
    }
    lds_barrier();
}

__device__ __forceinline__ void rg_final_unit(LAS unsigned char* lds, const Args& a, int b, int kl, int tid, int wave, int lane) {
    const bf16_t* __restrict__ proj = (const bf16_t*)(a.ws + WS_PROJ); const float* rgcarry = (const float*)(a.ws + WS_RGCARRY); bf16_t* mixed = (bf16_t*)(a.ws + WS_MIXED);
    const int rowbase = b * SEQ + kl * 64, unit = b * RG_UNITS_PER_B + 4 + kl;
    const int n = wave, fr = lane & 15, fq = lane >> 4;
    const u32x4* stash = (const u32x4*)a.out + ((size_t)(b * 64 + kl) * 16384 + (size_t)wave * 2048 + lane);
    u32x4 st[2][4];
#pragma unroll
    for (int dir = 0; dir < 2; ++dir)
#pragma unroll
        for (int m = 0; m < 4; ++m) st[dir][m] = stash[((0 * 2 + dir) * 4 + m) * 64];
    float cin[4][2];
#pragma unroll
    for (int nt = 0; nt < 4; ++nt)
#pragma unroll
        for (int dir = 0; dir < 2; ++dir) cin[nt][dir] = rgcarry[((size_t)unit * 2 + dir) * 512 + n * 64 + nt * 16 + fr];
    {
        const int cgp = tid & 63, tg = tid >> 6, c0 = cgp * 8, i0 = tg * 8;
        u32x4 g[8];
#pragma unroll
        for (int ii = 0; ii < 8; ++ii) g[ii] = *(const u32x4*)(proj + (size_t)(rowbase + i0 + ii) * NIN + 512 + c0);
#pragma unroll
        for (int ii = 0; ii < 8; ++ii) *(LAS u32x4*)(lds + RG_XC + (i0 + ii) * XC_STRIDE + c0 * 2) = g[ii];
    }
    lds_barrier();
#pragma unroll
    for (int nt = 0; nt < 4; ++nt) {
        const int ch = n * 64 + nt * 16 + fr;
        u32x4 sn[2][4];
        if (nt < 3) {
#pragma unroll
            for (int dir = 0; dir < 2; ++dir)
#pragma unroll
                for (int m = 0; m < 4; ++m) sn[dir][m] = stash[(((nt + 1) * 2 + dir) * 4 + m) * 64];
        }
        float hsum[4][4];
#pragma unroll
        for (int dir = 0; dir < 2; ++dir) {
            float av[4][4], uv[4][4];
#pragma unroll
            for (int m = 0; m < 4; ++m)
#pragma unroll
                for (int j = 0; j < 4; ++j) { av[m][j] = 1.0f - bf_lo(st[dir][m][j]); uv[m][j] = bf_hi(st[dir][m][j]); }
            float carry = cin[nt][dir], atot = 1.f;
            if (dir == 0) rg_scan64<0, true>(av, uv, carry, atot, hsum, fr, fq); else rg_scan64<1, true>(av, uv, carry, atot, hsum, fr, fq);
        }
#pragma unroll
        for (int m = 0; m < 4; ++m)
#pragma unroll
            for (int j = 0; j < 4; ++j) { const int t = 16 * m + 4 * fq + j;
                const float gg = bf2f(*(const LAS bf16_t*)(lds + RG_XC + t * XC_STRIDE + ch * 2));
                *(LAS bf16_t*)(lds + RG_OUT + t * XC_STRIDE + ch * 2) = (bf16_t)(cvt2(hsum[m][j] * gg, 0.f) & 0xffffu); }
        if (nt < 3) {
#pragma unroll
            for (int dir = 0; dir < 2; ++dir)
#pragma unroll
                for (int m = 0; m < 4; ++m) st[dir][m] = sn[dir][m];
        }
    }
    lds_barrier();
    {
        const int cgp = tid & 63, tg = tid >> 6, c0 = cgp * 8, i0 = tg * 8;
#pragma unroll
        for (int ii = 0; ii < 8; ++ii) { const u32x4 w = *(const LAS u32x4*)(lds + RG_OUT + (i0 + ii) * XC_STRIDE + c0 * 2);
            *(u32x4*)(mixed + (size_t)(rowbase + i0 + ii) * DM + c0) = w; }
    }
}

__device__ __forceinline__ void rg_carry_item(const Args& a, int item, int tid) {
    const float* rgagg = (const float*)(a.ws + WS_RGAGG); float* rgcarry = (float*)(a.ws + WS_RGCARRY);
    const int gidx = item * NTHREADS + tid;
    const int ch = gidx & 511, dir = (gidx >> 9) & 1, b = gidx >> 10;
    float h = 0.f;
#pragma unroll 1
    for (int s0 = 0; s0 < RG_UNITS_PER_B; s0 += 17) {
        float Av[17], Hv[17];
#pragma unroll
        for (int s1 = 0; s1 < 17; ++s1) { const int s = s0 + s1;
            const int k = dir == 0 ? s : (s < 4 ? 3 - s : 67 - (s - 4));
            const size_t unit = (size_t)b * RG_UNITS_PER_B + k;
            Av[s1] = rgagg[((unit * 2 + dir) * 2 + 0) * 512 + ch]; Hv[s1] = rgagg[((unit * 2 + dir) * 2 + 1) * 512 + ch]; }
#pragma unroll
        for (int s1 = 0; s1 < 17; ++s1) { const int s = s0 + s1;
            const int k = dir == 0 ? s : (s < 4 ? 3 - s : 67 - (s - 4));
            const size_t unit = (size_t)b * RG_UNITS_PER_B + k;
            rgcarry[(unit * 2 + dir) * 512 + ch] = h;
            h = Av[s1] * h + Hv[s1]; }
    }
}

constexpr int HG_RAWZ = 0, HG_RAWV = 16384, HG_RAWQ = 32768;
constexpr int HG_KHT = 49152, HG_VT = 67584;
constexpr int HG_QT = 86016, HG_KT = 103424;
constexpr int HG_AM = 120832;
constexpr int HG_DS = 130048, HG_QSUM = 130560, HG_PART = 134656;
constexpr int HG_RAWG = 136704;
constexpr int HG_OST = HG_QT;
constexpr int TS = 144, QS = 272;

struct HgRaw { u32x4 z[2], v[2], q[2], g[2]; };
template <bool FULL, bool GATE>
__device__ __forceinline__ void hg_load_raw(HgRaw& r, const bf16_t* __restrict__ proj, int row0, int hd, int dir, int tid) {
#pragma unroll
    for (int i = 0; i < 2; ++i) { const bf16_t* p = proj + (size_t)(row0 + (tid >> 4) + 32 * i) * NIN + hd * 128 + (tid & 15) * 8;
        r.z[i] = *(const u32x4*)(p + (dir == 0 ? 1536 : 2048)); r.v[i] = *(const u32x4*)(p + 2560); if (FULL) r.q[i] = *(const u32x4*)(p + 1024); if (GATE) r.g[i] = *(const u32x4*)(p + 3072); }
}
template <bool FULL, bool GATE>
__device__ __forceinline__ void hg_store_raw(LAS unsigned char* lds, const HgRaw& r, int tid) {
#pragma unroll
    for (int i = 0; i < 2; ++i) { const int off = ((tid >> 4) + 32 * i) * 256 + (tid & 15) * 16;
        *(LAS u32x4*)(lds + HG_RAWZ + off) = r.z[i]; *(LAS u32x4*)(lds + HG_RAWV + off) = r.v[i]; if (FULL) *(LAS u32x4*)(lds + HG_RAWQ + off) = r.q[i]; if (GATE) *(LAS u32x4*)(lds + HG_RAWG + off) = r.g[i]; }
}

template <int DIR, bool FULL, bool STORE_NEXT, bool NEXT_GATE>
__device__ __forceinline__ void hg_chunk(LAS unsigned char* lds, f32x4 (&accS)[8], f32x4 (&o)[4], float lb0, float lb1, float& dseg0, float& dseg1, const HgRaw& nxt, int tid, int wave, int lane) {
    const int cp = lane, tg = wave, fr = lane & 15, fq = lane >> 4;
    float c0[8], c1[8], k0[8], k1[8];
    {
        float p0 = 1.f, p1 = 1.f;
#pragma unroll
        for (int ii = 0; ii < 8; ++ii) { const int i = DIR == 0 ? ii : 7 - ii;
            const unsigned zz = *(const LAS unsigned*)(lds + HG_RAWZ + (8 * tg + i) * 256 + cp * 4);
            const float e0 = __expf(-bf_lo(zz)), e1 = __expf(-bf_hi(zz)); const float s0 = frcp(1.0f + e0), s1 = frcp(1.0f + e1);
            k0[i] = (1.0f - lb0) * e0 * s0; k1[i] = (1.0f - lb1) * e1 * s1;
            p0 *= lb0 + (1.0f - lb0) * s0; p1 *= lb1 + (1.0f - lb1) * s1; c0[i] = p0; c1[i] = p1; }
        *(LAS f32x2*)(lds + HG_QSUM + (tg * 128 + 2 * cp) * 4) = (f32x2){p0, p1};
    }
    lds_barrier();
    float pre0 = 1.f, pre1 = 1.f, tot0 = 1.f, tot1 = 1.f;
#pragma unroll
    for (int g = 0; g < 8; ++g) { const f32x2 v = *(const LAS f32x2*)(lds + HG_QSUM + (g * 128 + 2 * cp) * 4); tot0 *= v[0]; tot1 *= v[1]; if (DIR == 0 ? (g < tg) : (g > tg)) { pre0 *= v[0]; pre1 *= v[1]; } }
    {
        unsigned kh0[4], kh1[4], vt0[4], vt1[4];
#pragma unroll
        for (int i2 = 0; i2 < 4; ++i2) {
            const float Pa0 = pre0 * c0[2 * i2], Pb0 = pre0 * c0[2 * i2 + 1], Pa1 = pre1 * c1[2 * i2], Pb1 = pre1 * c1[2 * i2 + 1];
            const float ra0 = frcp(Pa0), rb0 = frcp(Pb0), ra1 = frcp(Pa1), rb1 = frcp(Pb1);
            const float kta0 = k0[2 * i2] * ra0, ktb0 = k0[2 * i2 + 1] * rb0, kta1 = k1[2 * i2] * ra1, ktb1 = k1[2 * i2 + 1] * rb1;
            kh0[i2] = cvt2(kta0 * tot0, ktb0 * tot0); kh1[i2] = cvt2(kta1 * tot1, ktb1 * tot1);
            const unsigned va = *(const LAS unsigned*)(lds + HG_RAWV + (8 * tg + 2 * i2) * 256 + cp * 4), vb = *(const LAS unsigned*)(lds + HG_RAWV + (8 * tg + 2 * i2 + 1) * 256 + cp * 4);
            vt0[i2] = __builtin_amdgcn_perm(vb, va, 0x05040100u); vt1[i2] = __builtin_amdgcn_perm(vb, va, 0x07060302u);
            if (FULL) {
                const unsigned qa = *(const LAS unsigned*)(lds + HG_RAWQ + (8 * tg + 2 * i2) * 256 + cp * 4), qb = *(const LAS unsigned*)(lds + HG_RAWQ + (8 * tg + 2 * i2 + 1) * 256 + cp * 4);
                *(LAS unsigned*)(lds + HG_QT + (8 * tg + 2 * i2) * QS + cp * 4) = cvt2(bf_lo(qa) * Pa0, bf_hi(qa) * Pa1);
                *(LAS unsigned*)(lds + HG_QT + (8 * tg + 2 * i2 + 1) * QS + cp * 4) = cvt2(bf_lo(qb) * Pb0, bf_hi(qb) * Pb1);
                *(LAS unsigned*)(lds + HG_KT + (8 * tg + 2 * i2) * QS + cp * 4) = cvt2(kta0, kta1);
                *(LAS unsigned*)(lds + HG_KT + (8 * tg + 2 * i2 + 1) * QS + cp * 4) = cvt2(ktb0, ktb1);
            }
        }
        *(LAS u32x4*)(lds + HG_KHT + (2 * cp) * TS + tg * 16) = (u32x4){kh0[0], kh0[1], kh0[2], kh0[3]}; *(LAS u32x4*)(lds + HG_KHT + (2 * cp + 1) * TS + tg * 16) = (u32x4){kh1[0], kh1[1], kh1[2], kh1[3]};
        *(LAS u32x4*)(lds + HG_VT + (2 * cp) * TS + tg * 16) = (u32x4){vt0[0], vt0[1], vt0[2], vt0[3]}; *(LAS u32x4*)(lds + HG_VT + (2 * cp + 1) * TS + tg * 16) = (u32x4){vt1[0], vt1[1], vt1[2], vt1[3]};
        if (tg == 0) { *(LAS f32x2*)(lds + HG_DS + 2 * cp * 4) = (f32x2){tot0, tot1}; dseg0 *= tot0; dseg1 *= tot1; }
    }
    lds_barrier();
    if (FULL) {
#pragma unroll
        for (int tt = 0; tt < 2; ++tt) {
            const int tl = 2 * wave + tt, ti = tl >> 2, si = tl & 3;
            f32x4 accA = (f32x4){0.f, 0.f, 0.f, 0.f};
#pragma unroll
            for (int ks = 0; ks < 4; ++ks) {
                const bf16x8 af = *(const LAS bf16x8*)(lds + HG_QT + (16 * ti + fr) * QS + (ks * 32 + fq * 8) * 2);
                const bf16x8 bf = *(const LAS bf16x8*)(lds + HG_KT + (16 * si + fr) * QS + (ks * 32 + fq * 8) * 2);
                accA = __builtin_amdgcn_mfma_f32_16x16x32_bf16(af, bf, accA, 0, 0, 0);
            }
#pragma unroll
            for (int j = 0; j < 4; ++j) { const int t = 16 * ti + 4 * fq + j, s = 16 * si + fr;
                const bool keep = DIR == 0 ? (s <= t) : (s >= t);
                *(LAS bf16_t*)(lds + HG_AM + t * TS + s * 2) = (bf16_t)(cvt2(keep ? accA[j] : 0.f, 0.f) & 0xffffu); }
        }
        lds_barrier();
#pragma unroll
        for (int m = 0; m < 4; ++m) o[m] = (f32x4){0.f, 0.f, 0.f, 0.f};
#pragma unroll
        for (int ks = 0; ks < 4; ++ks) {
            const u32x4 sw = (u32x4){cvt2(accS[2 * ks][0], accS[2 * ks][1]), cvt2(accS[2 * ks][2], accS[2 * ks][3]), cvt2(accS[2 * ks + 1][0], accS[2 * ks + 1][1]), cvt2(accS[2 * ks + 1][2], accS[2 * ks + 1][3])};
            const bf16x8 sf = mk_bf16x8(sw);
#pragma unroll
            for (int m = 0; m < 4; ++m) {
                const u32x2 qlo = *(const LAS u32x2*)(lds + HG_QT + (16 * m + fr) * QS + (32 * ks + 4 * fq) * 2), qhi = *(const LAS u32x2*)(lds + HG_QT + (16 * m + fr) * QS + (32 * ks + 16 + 4 * fq) * 2);
                const bf16x8 qf = mk_bf16x8((u32x4){qlo.x, qlo.y, qhi.x, qhi.y});
                o[m] = __builtin_amdgcn_mfma_f32_16x16x32_bf16(qf, sf, o[m], 0, 0, 0);
            }
        }
#pragma unroll
        for (int ks = 0; ks < 2; ++ks) {
            const bf16x8 vf = *(const LAS bf16x8*)(lds + HG_VT + (16 * wave + fr) * TS + (ks * 32 + fq * 8) * 2);
#pragma unroll
            for (int m = 0; m < 4; ++m) { const bf16x8 af = *(const LAS bf16x8*)(lds + HG_AM + (16 * m + fr) * TS + (ks * 32 + fq * 8) * 2);
                o[m] = __builtin_amdgcn_mfma_f32_16x16x32_bf16(af, vf, o[m], 0, 0, 0); }
        }
    }
#pragma unroll
    for (int i = 0; i < 8; ++i) { const f32x4 dv = *(const LAS f32x4*)(lds + HG_DS + (16 * i + 4 * fq) * 4); accS[i] = accS[i] * dv; }
#pragma unroll
    for (int ks = 0; ks < 2; ++ks) {
        const bf16x8 vf = *(const LAS bf16x8*)(lds + HG_VT + (16 * wave + fr) * TS + (ks * 32 + fq * 8) * 2);
#pragma unroll
        for (int i = 0; i < 8; ++i) { const bf16x8 af = *(const LAS bf16x8*)(lds + HG_KHT + (16 * i + fr) * TS + (ks * 32 + fq * 8) * 2);
            accS[i] = __builtin_amdgcn_mfma_f32_16x16x32_bf16(af, vf, accS[i], 0, 0, 0); }
    }
    if (STORE_NEXT) hg_store_raw<FULL, NEXT_GATE>(lds, nxt, tid);
}

__device__ __forceinline__ float hg_lb(const float* __restrict__ lb_logits, int dir, int col) {
    const float l0 = lb_logits[(0 * 2 + dir) * 512 + col], l1 = lb_logits[(1 * 2 + dir) * 512 + col];
    return 1.0f / (1.0f + expf(l1 - l0));
}

template <int DIR>
__device__ __forceinline__ void hg_agg_unit(LAS unsigned char* lds, const Args& a, int b, int hd, int sidx, int unit, int tid, int wave, int lane) {
    const bf16_t* __restrict__ proj = (const bf16_t*)(a.ws + WS_PROJ);
    const int rowbase = sidx == 0 ? T + b * LC : b * SEQ + (sidx - 1) * 256;
    const float lb0 = hg_lb(a.in[12], DIR, hd * 128 + 2 * lane), lb1 = hg_lb(a.in[12], DIR, hd * 128 + 2 * lane + 1);
    f32x4 accS[8], odummy[4];
#pragma unroll
    for (int i = 0; i < 8; ++i) accS[i] = (f32x4){0.f, 0.f, 0.f, 0.f};
    float dseg0 = 1.f, dseg1 = 1.f;
    HgRaw raw;
    hg_load_raw<false, false>(raw, proj, rowbase + (DIR == 0 ? 0 : 3) * 64, hd, DIR, tid);
    lds_barrier();
    hg_store_raw<false, false>(lds, raw, tid);
    lds_barrier();
#pragma unroll 1
    for (int cc = 0; cc < 3; ++cc) {
        hg_load_raw<false, false>(raw, proj, rowbase + (DIR == 0 ? cc + 1 : 2 - cc) * 64, hd, DIR, tid);
        hg_chunk<DIR, false, true, false>(lds, accS, odummy, lb0, lb1, dseg0, dseg1, raw, tid, wave, lane);
        lds_barrier();
    }
    hg_chunk<DIR, false, false, false>(lds, accS, odummy, lb0, lb1, dseg0, dseg1, raw, tid, wave, lane);
    float* K = (float*)(a.ws + WS_HGK) + (size_t)unit * 16384;
    const int fr = lane & 15, fq = lane >> 4;
#pragma unroll
    for (int i = 0; i < 8; ++i)
#pragma unroll
        for (int j = 0; j < 4; ++j) K[(16 * i + 4 * fq + j) * 128 + 16 * wave + fr] = accS[i][j];
    if (wave == 0) *(f32x2*)((float*)(a.ws + WS_HGD) + (size_t)unit * 128 + 2 * lane) = (f32x2){dseg0, dseg1};
}

__device__ __forceinline__ void hg_carry_item(const Args& a, int item, int tid, bool dry = false) {
    const int chain = item >> 3, part = item & 7, dir = chain & 1;
    float* K = (float*)(a.ws + WS_HGK) + (size_t)chain * HG_SEGS * 16384; const float* D = (const float*)(a.ws + WS_HGD) + (size_t)chain * HG_SEGS * 128;
    const int e4 = part * 512 + tid, dk = e4 >> 5;
    f32x4 kv[HG_SEGS]; float dv[HG_SEGS];
#pragma unroll
    for (int s = 0; s < HG_SEGS; ++s) { const int sidx = s == 0 ? 0 : (dir == 0 ? s : HG_SEGS - s); kv[s] = *(const f32x4*)(K + (size_t)sidx * 16384 + e4 * 4); dv[s] = D[sidx * 128 + dk]; }
    f32x4 S = (f32x4){0.f, 0.f, 0.f, 0.f};
#pragma unroll
    for (int s = 0; s < HG_SEGS; ++s) { const int sidx = s == 0 ? 0 : (dir == 0 ? s : HG_SEGS - s);
        if (dry) { const size_t o = ((size_t)(chain * HG_SEGS + sidx) * 16384 + e4 * 4) % (size_t)(32 * MiB); *(f32x4*)((float*)(a.ws + WS_MIXED) + o) = S; } else *(f32x4*)(K + (size_t)sidx * 16384 + e4 * 4) = S;
        S = S * dv[s] + kv[s]; }
}

__device__ __forceinline__ void hg_final_unit(LAS unsigned char* lds, const Args& a, int b, int hd, int seg, int tid, int wave, int lane) {
    const bf16_t* __restrict__ proj = (const bf16_t*)(a.ws + WS_PROJ); bf16_t* mixed = (bf16_t*)(a.ws + WS_MIXED);
    const int rowbase = b * SEQ + seg * 256, fr = lane & 15, fq = lane >> 4;
    const float lbf0 = hg_lb(a.in[12], 0, hd * 128 + 2 * lane), lbf1 = hg_lb(a.in[12], 0, hd * 128 + 2 * lane + 1);
    const float lbb0 = hg_lb(a.in[12], 1, hd * 128 + 2 * lane), lbb1 = hg_lb(a.in[12], 1, hd * 128 + 2 * lane + 1);
    const float ng = a.in[13][hd * 128 + 16 * wave + fr];
    f32x4 accS[8], o[4];
    float dseg0 = 1.f, dseg1 = 1.f;
    HgRaw raw;
    f32x4* ofst = (f32x4*)(a.ws + WS_OFST) + (size_t)blockIdx.x * 8192 + wave * 256 + lane;
    hg_load_raw<true, false>(raw, proj, rowbase, hd, 0, tid);
    {
        const float* Sin = (const float*)(a.ws + WS_HGK) + (size_t)((((b * 4 + hd) * 2 + 0) * HG_SEGS) + 1 + seg) * 16384;
#pragma unroll
        for (int i = 0; i < 8; ++i)
#pragma unroll
            for (int j = 0; j < 4; ++j) accS[i][j] = Sin[(16 * i + 4 * fq + j) * 128 + 16 * wave + fr];
    }
    lds_barrier();
    hg_store_raw<true, false>(lds, raw, tid);
    lds_barrier();
#pragma unroll 1
    for (int cc = 0; cc < 3; ++cc) {
        hg_load_raw<true, false>(raw, proj, rowbase + (cc + 1) * 64, hd, 0, tid);
        hg_chunk<0, true, true, false>(lds, accS, o, lbf0, lbf1, dseg0, dseg1, raw, tid, wave, lane);
#pragma unroll
        for (int m = 0; m < 4; ++m) ofst[cc * 2048 + m * 64] = o[m];
        lds_barrier();
    }
    hg_load_raw<true, true>(raw, proj, rowbase + 3 * 64, hd, 1, tid);
    hg_chunk<0, true, true, true>(lds, accS, o, lbf0, lbf1, dseg0, dseg1, raw, tid, wave, lane);
#pragma unroll
    for (int m = 0; m < 4; ++m) ofst[3 * 2048 + m * 64] = o[m];
    {
        const float* Sin = (const float*)(a.ws + WS_HGK) + (size_t)((((b * 4 + hd) * 2 + 1) * HG_SEGS) + 1 + seg) * 16384;
#pragma unroll
        for (int i = 0; i < 8; ++i)
#pragma unroll
            for (int j = 0; j < 4; ++j) accS[i][j] = Sin[(16 * i + 4 * fq + j) * 128 + 16 * wave + fr];
    }
    lds_barrier();
#pragma unroll 1
    for (int cc = 0; cc < 4; ++cc) {
        const int c = 3 - cc;
        float gate[4][4];
#pragma unroll
        for (int m = 0; m < 4; ++m)
#pragma unroll
            for (int j = 0; j < 4; ++j) gate[m][j] = bf2f(*(const LAS bf16_t*)(lds + HG_RAWG + (16 * m + 4 * fq + j) * 256 + (16 * wave + fr) * 2));
        if (cc < 3) hg_load_raw<true, true>(raw, proj, rowbase + (c - 1) * 64, hd, 1, tid);
        if (cc < 3) hg_chunk<1, true, true, true>(lds, accS, o, lbb0, lbb1, dseg0, dseg1, raw, tid, wave, lane);
        else hg_chunk<1, true, false, false>(lds, accS, o, lbb0, lbb1, dseg0, dseg1, raw, tid, wave, lane);
#pragma unroll
        for (int m = 0; m < 4; ++m) { o[m] = o[m] + ofst[c * 2048 + m * 64];
#pragma unroll
            for (int j = 0; j < 4; ++j) { float s = o[m][j] * o[m][j];
                s += __shfl_xor(s, 1); s += __shfl_xor(s, 2); s += __shfl_xor(s, 4); s += __shfl_xor(s, 8);
                if (fr == 0) *(LAS float*)(lds + HG_PART + ((16 * m + 4 * fq + j) * 8 + wave) * 4) = s; } }
        lds_barrier();
#pragma unroll
        for (int m = 0; m < 4; ++m)
#pragma unroll
            for (int j = 0; j < 4; ++j) { const int t = 16 * m + 4 * fq + j;
                const f32x4 p0 = *(const LAS f32x4*)(lds + HG_PART + t * 32), p1 = *(const LAS f32x4*)(lds + HG_PART + t * 32 + 16);
                const float ms = ((p0[0] + p0[1]) + (p0[2] + p0[3]) + (p1[0] + p1[1]) + (p1[2] + p1[3])) * (1.0f / 128.0f);
                *(LAS bf16_t*)(lds + HG_OST + t * QS + (16 * wave + fr) * 2) = (bf16_t)(cvt2(o[m][j] * __builtin_amdgcn_rsqf(ms + LN_EPS) * ng * gate[m][j], 0.f) & 0xffffu); }
        lds_barrier();
#pragma unroll
        for (int i = 0; i < 2; ++i) { const int t = (tid >> 4) + 32 * i, c8 = (tid & 15) * 8;
            *(u32x4*)(mixed + (size_t)(rowbase + c * 64 + t) * DM + 512 + hd * 128 + c8) = *(const LAS u32x4*)(lds + HG_OST + t * QS + c8 * 2); }
    }
}

__device__ __forceinline__ void p_scan_a(LAS unsigned char* lds, const Args& a, int bid, int G, int tid, int wave, int lane, int mask = 3) {
    constexpr int N_HG = NB * 4 * 2 * HG_SEGS, N_RG = NB * RG_UNITS_PER_B;
#pragma unroll 1
    for (int it = bid; it < N_HG + N_RG; it += G) {
        int t2 = tid; asm volatile("" : "+v"(t2)); const int tid = t2, lane = t2 & 63;
        if ((it < N_HG) ? !(mask & 1) : !(mask & 2)) continue;
        if (it < N_HG) { const int sidx = it % HG_SEGS, rest = it / HG_SEGS, dir = rest & 1, hd = (rest >> 1) & 3, b = rest >> 3;
            if (dir == 0) hg_agg_unit<0>(lds, a, b, hd, sidx, it, tid, wave, lane); else hg_agg_unit<1>(lds, a, b, hd, sidx, it, tid, wave, lane); }
        else { const int r = it - N_HG; __syncthreads(); rg_agg_unit(lds, a, r / RG_UNITS_PER_B, r % RG_UNITS_PER_B, tid, wave, lane); }
    }
}
__device__ __forceinline__ void p_scan_b(const Args& a, int bid, int G, int tid, bool dry = false) {
#pragma unroll 1
    for (int it = bid; it < 1024; it += G) hg_carry_item(a, it, tid, dry);
    if (bid >= G - 32) rg_carry_item(a, bid - (G - 32), tid);
}
__device__ __forceinline__ void p_scan_c(LAS unsigned char* lds, const Args& a, int bid, int G, int tid, int wave, int lane, int mask = 3) {
#pragma unroll 1
    for (int it = bid; it < ((mask & 1) ? 1024 : 0); it += G) { const int seg = it & 15, hd = (it >> 4) & 3, b = it >> 6; int t2 = tid; asm volatile("" : "+v"(t2)); hg_final_unit(lds, a, b, hd, seg, t2, wave, t2 & 63); }
#pragma unroll 1
    for (int r = bid; r < ((mask & 2) ? 1024 : 0); r += G) { __syncthreads(); int t2 = tid; asm volatile("" : "+v"(t2)); rg_final_unit(lds, a, r >> 6, r & 63, t2, wave, t2 & 63); }
}

#define GAS __attribute__((address_space(1)))
#define RLX_AGENT __ATOMIC_RELAXED, __HIP_MEMORY_SCOPE_AGENT
#define XB_TMO      128
#define XB_XCNT(j)  (256  + 64 * (j))
#define XB_XSUB(j)  (1280 + 64 * (j))
#define XB_XGEN(j)  (2304 + 64 * (j))
#define XB_TOP      3328
#define XB_TOPGEN   3392
#define XCD_BAR_WORDS 3456
#define XB_SPIN_CAP (1u << 18)

__device__ __forceinline__ unsigned xb_ld(unsigned* p)              { return __hip_atomic_load(p, __ATOMIC_RELAXED, __HIP_MEMORY_SCOPE_AGENT); }
__device__ __forceinline__ unsigned xb_add(unsigned* p, unsigned v) { return __hip_atomic_fetch_add(p, v, __ATOMIC_RELAXED, __HIP_MEMORY_SCOPE_AGENT); }
__device__ __forceinline__ unsigned xb_xcc_id() { return (unsigned)__builtin_amdgcn_s_getreg((3 << 11) | 20) & 0xFu; }
#define XB_SPIN(cond, bar) do { unsigned _sp = 0; while (cond) { __builtin_amdgcn_s_sleep(1); \
    if ((++_sp & 255u) == 0u) { if (xb_ld(&(bar)[XB_TMO])) break; if (_sp > XB_SPIN_CAP) { atomicAdd(&(bar)[XB_TMO], 1u); break; } } } } while (0)

struct XcdBarrier {
    unsigned* bar; unsigned x;
    volatile LAS unsigned* st;
};

__device__ __forceinline__ XcdBarrier xcd_barrier_post(unsigned* bar, volatile LAS unsigned* st) {
    XcdBarrier b; b.bar = bar; b.x = xb_xcc_id(); b.st = st;
    if (threadIdx.x == 0) (void)xb_add(&bar[XB_XCNT(b.x)], 1u);
    return b;
}
__device__ __forceinline__ void xcd_barrier_complete(unsigned* bar, unsigned x, unsigned& nloc, unsigned& nx) {
    const unsigned G = gridDim.x * gridDim.y * gridDim.z;
    unsigned sum, cnt, mine, sp = 0u;
    for (;;) {
        sum = 0u; cnt = 0u; mine = 0u;
#pragma unroll
        for (unsigned j = 0; j < 16; ++j) { const unsigned c = xb_ld(&bar[XB_XCNT(j)]); sum += c; cnt += (c > 0u) ? 1u : 0u; mine = (j == x) ? c : mine; }
        if (sum == G) break;
        __builtin_amdgcn_s_sleep(1);
        if ((++sp & 255u) == 0u) { if (xb_ld(&bar[XB_TMO])) break; if (sp > XB_SPIN_CAP) { atomicAdd(&bar[XB_TMO], 1u); break; } }
    }
    nloc = mine > 0u ? mine : 1u; nx = cnt > 0u ? cnt : 1u;
}

__device__ __forceinline__ void xcd_barrier(const XcdBarrier& b) {
    asm volatile("s_waitcnt vmcnt(0)" ::: "memory");
    __syncthreads();
    if (threadIdx.x == 0) {
        unsigned* bar = b.bar;
        __builtin_amdgcn_s_waitcnt(0);
        unsigned nloc = b.st[0], nx = b.st[1];
        if (nloc == 0u) { xcd_barrier_complete(bar, b.x, nloc, nx); b.st[0] = nloc; b.st[1] = nx; }
        const unsigned old = xb_add(&bar[XB_XSUB(b.x)], 1u);
        const unsigned gen = old / nloc;
        if (old + 1u == (gen + 1u) * nloc) {
            __builtin_amdgcn_fence(__ATOMIC_RELEASE, "agent");
            asm volatile("s_waitcnt vmcnt(0)" ::: "memory");
            const unsigned og = xb_add(&bar[XB_TOP], 1u);
            const unsigned tg = og / nx;
            if (og + 1u == (tg + 1u) * nx) xb_add(&bar[XB_TOPGEN], 1u);
            else XB_SPIN(xb_ld(&bar[XB_TOPGEN]) == tg, bar);
            __builtin_amdgcn_fence(__ATOMIC_ACQUIRE, "agent");
            xb_add(&bar[XB_XGEN(b.x)], 1u);
            asm volatile("s_waitcnt vmcnt(0)" ::: "memory");
        } else {
            XB_SPIN(xb_ld(&bar[XB_XGEN(b.x)]) == gen, bar);
            __builtin_amdgcn_fence(__ATOMIC_ACQUIRE, "agent");
            asm volatile("s_waitcnt vmcnt(0)" ::: "memory");
        }
    }
    __syncthreads();
}


__global__ void __launch_bounds__(NTHREADS, 2) mega(Args a) {
    extern __shared__ __attribute__((aligned(16))) unsigned char lds_raw[];
    LAS unsigned char* lds = (LAS unsigned char*)lds_raw;
    cg::grid_group grid = cg::this_grid();
    const int wave = __builtin_amdgcn_readfirstlane(threadIdx.x >> 6), bid = blockIdx.x, G = gridDim.x;
    int tid = threadIdx.x, lane = tid & 63;
#define FRESH_TID() do { tid = threadIdx.x; asm volatile("" : "+v"(tid)); lane = tid & 63; } while (0)
    unsigned char* ws = a.ws;
    volatile LAS unsigned* bst = (volatile LAS unsigned*)(lds + LDS_BYTES - 64);
    if (threadIdx.x < 2) bst[threadIdx.x] = 0u;
    __syncthreads();
    XcdBarrier xbar = xcd_barrier_post((unsigned*)(ws + WS_BAR), bst);
#define GRID_BAR() xcd_barrier(xbar)
    float* mod = (float*)(ws + WS_MOD);
    bf16_t* U = (bf16_t*)(ws + WS_U);
    bf16_t* PROJ = (bf16_t*)(ws + WS_PROJ); bf16_t* MIXED = (bf16_t*)(ws + WS_MIXED);

#ifndef SKIP_P0
    p_mod(lds, a.in[1], a.in[3], a.in[4], a.in[5], mod, bid, G, tid);
    p_transposes(lds, a, bid, G, tid);
    p_gwt(a.in[9], (bf16_t*)(ws + WS_GWT), bid, G, tid);
    p_rgpar(a.in[10], a.in[11], (float*)(ws + WS_RGPAR), bid, G, tid);
#endif
#ifdef REP_P0
    grid.sync();
    FRESH_TID();
    p_mod(lds, a.in[1], a.in[3], a.in[4], a.in[5], mod, bid, G, tid);
    p_transposes(lds, a, bid, G, tid);
    p_gwt(a.in[9], (bf16_t*)(ws + WS_GWT), bid, G, tid);
    p_rgpar(a.in[10], a.in[11], (float*)(ws + WS_RGPAR), bid, G, tid);
#endif
    GRID_BAR();
    FRESH_TID();
#ifdef REP_SYNC
    for (int r = 0; r < 10; ++r) GRID_BAR();
#endif
#ifndef SKIP_P1
    p_u(a.in[0], a.in[2], mod, U, bid, G, tid);
#endif
#ifdef REP_P1
    GRID_BAR();
    FRESH_TID();
    p_u(a.in[0], a.in[2], mod, U, bid, G, tid);
#endif
    GRID_BAR();
    FRESH_TID();
#ifndef SKIP_P2
    { pg8::Gemm g{U, (const bf16_t*)(ws + WS_WINT), TA, NIN, DM}; pg8::StaticOrder S; S.init(TA, NIN, G, bid);
      pg8::EpiInProj E{PROJ};
      pg8::gemm_phase<pg8::EpiInProj, pg8::StaticOrder, true, true>(lds, g, S, E); }
#endif
#ifdef REP_P2
    GRID_BAR();
    FRESH_TID();
    { pg8::Gemm g{U, (const bf16_t*)(ws + WS_WINT), TA, NIN, DM}; pg8::StaticOrder S; S.init(TA, NIN, G, bid);
      pg8::EpiInProj E{PROJ};
      pg8::gemm_phase<pg8::EpiInProj, pg8::StaticOrder, true, true>(lds, g, S, E); }
#endif
    GRID_BAR();
    FRESH_TID();
#ifndef SKIP_P3A
    p_scan_a(lds, a, bid, G, tid, wave, lane);
#endif
#ifdef REP_P3A
    GRID_BAR();
    FRESH_TID();
    p_scan_a(lds, a, bid, G, tid, wave, lane, REP_P3A);
#endif
    GRID_BAR();
    FRESH_TID();
#ifdef REP_P3B
    p_scan_b(a, bid, G, tid, true);
    GRID_BAR();
    FRESH_TID();
#endif
#ifndef SKIP_P3B
    p_scan_b(a, bid, G, tid);
#endif
    GRID_BAR();
    FRESH_TID();
#ifndef SKIP_P3C
    p_scan_c(lds, a, bid, G, tid, wave, lane);
#endif
#ifdef REP_P3C
    GRID_BAR();
    FRESH_TID();
    p_scan_c(lds, a, bid, G, tid, wave, lane, REP_P3C);
#endif
    GRID_BAR();
    FRESH_TID();
#ifndef SKIP_P5
    { pg8::Gemm g{MIXED, (const bf16_t*)(ws + WS_WOUTT), T, DM, DM}; pg8::StaticOrder S; S.init(T, DM, G, bid);
      pg8::EpiF32 E{a.out, DM, 0};
      pg8::gemm_phase<pg8::EpiF32, pg8::StaticOrder, true, true>(lds, g, S, E); }
#endif
#ifdef REP_P5
    GRID_BAR();
    FRESH_TID();
    { pg8::Gemm g{MIXED, (const bf16_t*)(ws + WS_WOUTT), T, DM, DM}; pg8::StaticOrder S; S.init(T, DM, G, bid);
      pg8::EpiF32 E{a.out, DM, 0};
      pg8::gemm_phase<pg8::EpiF32, pg8::StaticOrder, true, true>(lds, g, S, E); }
#endif
    GRID_BAR();
    FRESH_TID();
#ifdef REP_P6
#pragma unroll 1
    for (int rep = 0; rep < 2; ++rep) { p_ln1_router(lds, a, bid, G, tid, wave, lane, rep == 0); if (rep == 0) GRID_BAR(); }
#else
    p_ln1_router(lds, a, bid, G, tid, wave, lane);
#endif
    GRID_BAR();
    FRESH_TID();
#ifndef SKIP_P7
    p_assign(lds, a, bid, G, tid);
#endif
#ifdef REP_P7
    GRID_BAR();
    FRESH_TID();
    p_assign(lds, a, bid, G, tid);
#endif
    GRID_BAR();
    FRESH_TID();
#ifndef SKIP_P8
    { pg8::Gemm g{(const bf16_t*)(ws + WS_U), (const bf16_t*)(ws + WS_W13T), MAXROWS, NE * DM, DM}; pg8::ExpertOrderG S{(const int*)(ws + WS_CTL), (const int*)(ws + WS_ROWTOK), G, bid};
      pg8::EpiExp1 E{(bf16_t*)(ws + WS_HID)};
      pg8::gemm_phase<pg8::EpiExp1, pg8::ExpertOrderG, true, true>(lds, g, S, E); }
#endif
#ifdef REP_P8
    GRID_BAR();
    FRESH_TID();
    { pg8::Gemm g{(const bf16_t*)(ws + WS_U), (const bf16_t*)(ws + WS_W13T), MAXROWS, NE * DM, DM}; pg8::ExpertOrderG S{(const int*)(ws + WS_CTL), (const int*)(ws + WS_ROWTOK), G, bid};
      pg8::EpiExp1 E{(bf16_t*)(ws + WS_HID)};
      pg8::gemm_phase<pg8::EpiExp1, pg8::ExpertOrderG, true, true>(lds, g, S, E); }
#endif
    GRID_BAR();
    FRESH_TID();
#ifndef SKIP_P9
    { pg8::Gemm g{(const bf16_t*)(ws + WS_HID), (const bf16_t*)(ws + WS_W2T), MAXROWS, NE * DM, DE}; pg8::ExpertOrder S{(const int*)(ws + WS_CTL), nullptr, G, bid};
      pg8::EpiY E{(bf16_t*)(ws + WS_Y)};
      pg8::gemm_phase<pg8::EpiY, pg8::ExpertOrder, true, true>(lds, g, S, E); }
#endif
#ifdef REP_P9
    GRID_BAR();
    FRESH_TID();
    { pg8::Gemm g{(const bf16_t*)(ws + WS_HID), (const bf16_t*)(ws + WS_W2T), MAXROWS, NE * DM, DE}; pg8::ExpertOrder S{(const int*)(ws + WS_CTL), nullptr, G, bid};
      pg8::EpiY E{(bf16_t*)(ws + WS_Y)};
      pg8::gemm_phase<pg8::EpiY, pg8::ExpertOrder, true, true>(lds, g, S, E); }
#endif
    GRID_BAR();
    FRESH_TID();
#ifdef REP_P10
    p_combine_ln2(a, bid, G, wave, lane, true);
    GRID_BAR();
    FRESH_TID();
#endif
#ifndef SKIP_P10
    p_combine_ln2(a, bid, G, wave, lane);
#endif
}

extern "C" void kernel_launch(void* const* d_in, const int* in_sizes, int n_in, void* d_out, int out_size, void* d_ws, size_t ws_size, hipStream_t stream) {
    static int grid = 0;
    if (grid == 0) {
        if (n_in != 26 || ws_size < WS_END) { fprintf(stderr, "kernel_launch: unexpected n_in %d or workspace %zu < %zu\n", n_in, ws_size, (size_t)WS_END); grid = -1; return; }
        int dev = 0, cus = 0, per_cu = 0;
        if (hipGetDevice(&dev) != hipSuccess || hipDeviceGetAttribute(&cus, hipDeviceAttributeMultiprocessorCount, dev) != hipSuccess) { grid = -1; return; }
        if (hipFuncSetAttribute((const void*)mega, hipFuncAttributeMaxDynamicSharedMemorySize, LDS_BYTES) != hipSuccess) { fprintf(stderr, "kernel_launch: hipFuncSetAttribute failed\n"); grid = -1; return; }
        if (hipOccupancyMaxActiveBlocksPerMultiprocessor(&per_cu, (const void*)mega, NTHREADS, LDS_BYTES) != hipSuccess || per_cu < 1) { fprintf(stderr, "kernel_launch: occupancy query says %d\n", per_cu); per_cu = 1; }
        (void)hipGetLastError();
        grid = cus;
        fprintf(stderr, "kernel_launch: grid %d (cus %d, per_cu %d), ws %zu\n", grid, cus, per_cu, ws_size);
    }
    if (grid < 0) return;
    (void)hipMemsetAsync(d_ws, 0, 131072, stream);
    Args a{};
    for (int i = 0; i < 26; ++i) a.in[i] = (const float*)d_in[i];
    a.out = (float*)d_out; a.ws = (unsigned char*)d_ws;
    void* params[] = {&a};
    hipError_t e = hipLaunchCooperativeKernel((const void*)mega, dim3(grid), dim3(NTHREADS), params, LDS_BYTES, stream);
    if (e != hipSuccess) fprintf(stderr, "kernel_launch: cooperative launch failed: %s (grid %d)\n", hipGetErrorString(e), grid);
}
```

```cpp
#include <hip/hip_runtime.h>
#include <hip/hip_cooperative_groups.h>
#include <cstdio>
#include <cstdint>
namespace cg = cooperative_groups;

typedef unsigned short bf16_t;
typedef short bf16x8 __attribute__((ext_vector_type(8)));
typedef float f32x4 __attribute__((ext_vector_type(4)));
typedef float f32x2 __attribute__((ext_vector_type(2)));
typedef unsigned u32x4 __attribute__((ext_vector_type(4)));
typedef unsigned u32x2 __attribute__((ext_vector_type(2)));
typedef int i32x4 __attribute__((ext_vector_type(4)));
#define LAS __attribute__((address_space(3)))

constexpr int NB = 16, SEQ = 4096, LC = 256, DM = 1024;
constexpr int T = NB * SEQ;
constexpr int TC = NB * LC;
constexpr int TA = T + TC;
constexpr int NIN = 3584;
constexpr int NE = 32, DE = 512;
constexpr int MAXROWS = 2 * T + NE * 256;
constexpr float ALPHA = 1.189207115002721f;
constexpr float LN_EPS = 1e-6f;
constexpr int NTHREADS = 512;

constexpr size_t MiB = 1u << 20;
constexpr size_t WS_CTL = 0;
constexpr size_t WS_BAR = 65536;
constexpr size_t WS_MOD = 1 * MiB;
constexpr size_t WS_EIDX = 3 * MiB;
constexpr size_t WS_EPOS = 3 * MiB + 512 * 1024;
constexpr size_t WS_EW = 4 * MiB;
constexpr size_t WS_DEST = 4 * MiB + 512 * 1024;
constexpr size_t WS_WINT = 6 * MiB;
constexpr size_t WS_WOUTT = 13 * MiB;
constexpr size_t WS_W13T = 15 * MiB;
constexpr size_t WS_W2T = 79 * MiB;
constexpr size_t WS_U = 112 * MiB;
constexpr size_t WS_PROJ = 248 * MiB;
constexpr size_t WS_XG = 248 * MiB;
constexpr size_t WS_HID = 520 * MiB;
constexpr size_t WS_Y = 656 * MiB;
constexpr size_t WS_MIXED = 724 * MiB;
constexpr size_t WS_OSUM = 852 * MiB;
constexpr size_t WS_END = 980 * MiB;
constexpr int LDS_BYTES = 163840;

__device__ __forceinline__ float bf2f(bf16_t b) { return __uint_as_float(((unsigned)b) << 16); }
__device__ __forceinline__ bf16_t f2bf(float f) { unsigned u = __float_as_uint(f); return (bf16_t)((u + 0x7fffu + ((u >> 16) & 1u)) >> 16); }
__device__ __forceinline__ unsigned pk2(float lo, float hi) { return (unsigned)f2bf(lo) | ((unsigned)f2bf(hi) << 16); }
__device__ __forceinline__ float frcp(float x) { return __builtin_amdgcn_rcpf(x); }
__device__ __forceinline__ float sigmoidf_(float x) { return frcp(1.0f + __expf(-x)); }
__device__ __forceinline__ float siluf_(float x) { return x * frcp(1.0f + __expf(-x)); }
__device__ __forceinline__ float gelu_tanh(float x) {
    const float y = 0.7978845608028654f * (x + 0.044715f * x * x * x);
    return x * frcp(1.0f + __expf(-2.0f * y));
}
__device__ __forceinline__ float softplusf_(float x) { return fmaxf(x, 0.f) + log1pf(expf(-fabsf(x))); }
__device__ __forceinline__ float wave_sum(float v) {
#pragma unroll
    for (int o = 1; o < 64; o <<= 1) v += __shfl_xor(v, o);
    return v;
}
constexpr int CSTR = 64;
__device__ __forceinline__ int pstart_of(const int* __restrict__ counts, int e) {
    int acc = 0;
    for (int i = 0; i < NE; ++i) { const int p = ((counts[i * CSTR] + 255) >> 8) << 8; if (i < e) acc += p; }
    return acc;
}

namespace pg8 {
#define PG8_LAS __attribute__((address_space(3)))
typedef unsigned short bf16_t;
typedef short bf16x8 __attribute__((ext_vector_type(8)));
typedef float f32x4 __attribute__((ext_vector_type(4)));
typedef unsigned u32x4 __attribute__((ext_vector_type(4)));
constexpr int BM = 256, BK = 64, HALF = 128, HTB = HALF * BK * 2  , STAGE_BYTES = 8 * HTB, NXCD = 8, WGM = 8;

__host__ __device__ __forceinline__ int lds_byte(int r, int c) { const int st = (r >> 4) * 2 + (c >> 5), rr = r & 15, cc = c & 31, ob = rr * 64 + cc * 2; return st * 1024 + (ob ^ (((ob >> 9) & 1) << 5)); }
__host__ __device__ __forceinline__ void stage_rc(int b, int& R, int& C) { const int st = b / 1024, sb = b % 1024, swz = sb ^ (((sb >> 9) & 1) << 5); R = (st >> 1) * 16 + swz / 64; C = (st & 1) * 32 + (swz % 64) / 2; }
__host__ __device__ __forceinline__ int perm32(int rho) { const int n = rho >> 4, i = rho & 15; return 8 * (i >> 2) + 4 * n + (i & 3); }

struct Unit { int pm, pn; };
struct Gemm { const bf16_t* A; const bf16_t* Bt; int M, N, K; };

struct StaticOrder {
    static constexpr bool GATHER = false; const int* rowtok = nullptr;
    int nM, nN, nwg, G, c;
    __host__ __device__ void init(int M, int N, int G_, int c_) { nM = M / BM; nN = N / BM; nwg = nM * nN; G = G_; c = c_; }
    __host__ __device__ bool next(int i, Unit& u) const {
        const long L = (long)i * G + c; if (L >= nwg) return false;
        int wgid = (int)L; { const int q = nwg / NXCD, r = nwg % NXCD, xcd = wgid % NXCD, off = wgid / NXCD; wgid = (xcd < r ? xcd * (q + 1) : r * (q + 1) + (xcd - r) * q) + off; }
        const int nig = WGM * nN, gid = wgid / nig, fm = gid * WGM, gsz = (nM - fm) < WGM ? (nM - fm) : WGM;
        u.pm = fm + ((wgid % nig) % gsz); u.pn = (wgid % nig) / gsz; return true;
    }
    __device__ __forceinline__ void a_ready(const Unit&) const {}
    __device__ __forceinline__ void done(const Unit&) const {}
};

__device__ __forceinline__ unsigned cvt_pk_bf16(float lo, float hi) { unsigned r; asm volatile("v_cvt_pk_bf16_f32 %0, %1, %2" : "=v"(r) : "v"(lo), "v"(hi)); return r; }

struct EpiInProj {
    static constexpr bool PERM = true, AFTER_DRAIN = false;
    bf16_t* P;
    __device__ __forceinline__ void operator()(const f32x4 (&acc)[2][2][4][2], const Unit& u, int wr, int wc, int fr_, int fq_) const {
        int fr = fr_, fq = fq_; asm volatile("" : "+v"(fr), "+v"(fq));
        const int row0 = u.pm * BM + wr * 64 + fr, col0 = u.pn * BM + wc * 32 + 8 * fq, grp = u.pn >> 1;
#pragma unroll
        for (int ai = 0; ai < 2; ++ai)
#pragma unroll
            for (int m = 0; m < 4; ++m) { bf16_t* rowp = P + (size_t)(row0 + ai * HALF + m * 16) * NIN + col0;
#pragma unroll
                for (int bj = 0; bj < 2; ++bj) { f32x4 v0 = acc[ai][bj][m][0], v1 = acc[ai][bj][m][1];
                    if (grp == 1) {
#pragma unroll
                        for (int j = 0; j < 4; ++j) { v0[j] = gelu_tanh(v0[j]); v1[j] = gelu_tanh(v1[j]); } }
                    else if (grp == 2 || grp == 6) {
#pragma unroll
                        for (int j = 0; j < 4; ++j) { v0[j] = siluf_(v0[j]); v1[j] = siluf_(v1[j]); } }
                    u32x4 w; w.x = cvt_pk_bf16(v0[0], v0[1]); w.y = cvt_pk_bf16(v0[2], v0[3]); w.z = cvt_pk_bf16(v1[0], v1[1]); w.w = cvt_pk_bf16(v1[2], v1[3]);
                    *(u32x4*)(rowp + bj * HALF) = w; } }
    }
};
struct EpiF32 {
    static constexpr bool PERM = false, AFTER_DRAIN = false;
    float* C; int ldc; int pad;
    __device__ __forceinline__ void operator()(const f32x4 (&acc)[2][2][4][2], const Unit& u, int wr, int wc, int fr_, int fq_) const {
        int fr = fr_, fq = fq_; asm volatile("" : "+v"(fr), "+v"(fq));
        const int row0 = u.pm * BM + wr * 64 + fr, col0 = u.pn * BM + wc * 32 + 4 * fq;
#pragma unroll
        for (int ai = 0; ai < 2; ++ai)
#pragma unroll
            for (int m = 0; m < 4; ++m) { float* rowp = C + (size_t)(row0 + ai * HALF + m * 16) * ldc + col0;
#pragma unroll
                for (int bj = 0; bj < 2; ++bj)
#pragma unroll
                    for (int n = 0; n < 2; ++n) *(f32x4*)(rowp + bj * HALF + n * 16) = acc[ai][bj][m][n]; }
    }
};
struct EpiExp1 {
    static constexpr bool PERM = false, AFTER_DRAIN = false;
    bf16_t* H;
    __device__ __forceinline__ void operator()(const f32x4 (&acc)[2][2][4][2], const Unit& u, int wr, int wc, int fr_, int fq_) const {
        int fr = fr_, fq = fq_; asm volatile("" : "+v"(fr), "+v"(fq));
        const int row0 = u.pm * BM + wr * 64 + fr, hc0 = (((u.pn & 3) * BM + wc * 32) >> 1) + 4 * fq;
#pragma unroll
        for (int ai = 0; ai < 2; ++ai)
#pragma unroll
            for (int m = 0; m < 4; ++m) { bf16_t* rowp = H + (size_t)(row0 + ai * HALF + m * 16) * DE + hc0;
#pragma unroll
                for (int bj = 0; bj < 2; ++bj) { const f32x4 a = acc[ai][bj][m][0], b = acc[ai][bj][m][1];
                    u32x2 w; w.x = cvt_pk_bf16(siluf_(a[0]) * b[0], siluf_(a[1]) * b[1]); w.y = cvt_pk_bf16(siluf_(a[2]) * b[2], siluf_(a[3]) * b[3]);
                    *(u32x2*)(rowp + bj * 64) = w; } }
    }
};
struct EpiY {
    static constexpr bool PERM = true, AFTER_DRAIN = false;
    bf16_t* Y;
    __device__ __forceinline__ void operator()(const f32x4 (&acc)[2][2][4][2], const Unit& u, int wr, int wc, int fr_, int fq_) const {
        int fr = fr_, fq = fq_; asm volatile("" : "+v"(fr), "+v"(fq));
        const int row0 = u.pm * BM + wr * 64 + fr, col0 = (u.pn & 3) * BM + wc * 32 + 8 * fq;
#pragma unroll
        for (int ai = 0; ai < 2; ++ai)
#pragma unroll
            for (int m = 0; m < 4; ++m) { bf16_t* rowp = Y + (size_t)(row0 + ai * HALF + m * 16) * DM + col0;
#pragma unroll
                for (int bj = 0; bj < 2; ++bj) { const f32x4 v0 = acc[ai][bj][m][0], v1 = acc[ai][bj][m][1];
                    u32x4 w; w.x = cvt_pk_bf16(v0[0], v0[1]); w.y = cvt_pk_bf16(v0[2], v0[3]); w.z = cvt_pk_bf16(v1[0], v1[1]); w.w = cvt_pk_bf16(v1[2], v1[3]);
                    *(u32x4*)(rowp + bj * HALF) = w; } }
    }
};
template <bool GATHER_>
struct ExpertOrderT {
    static constexpr bool GATHER = GATHER_;
    const int* counts; const int* rowtok; int G, c;
    __device__ __forceinline__ bool next(int i, Unit& u) const {
        const int L = i * G + c, rb = L >> 2; int acc = 0, ef = -1;
        for (int e = 0; e < NE; ++e) { const int nb = (counts[e * CSTR] + 255) >> 8; if (rb >= acc && rb < acc + nb) ef = e; acc += nb; }
        if (ef < 0) return false;
        u.pm = rb; u.pn = ef * 4 + (L & 3); return true;
    }
    __device__ __forceinline__ void a_ready(const Unit&) const {}
    __device__ __forceinline__ void done(const Unit&) const {}
};
typedef ExpertOrderT<false> ExpertOrder;
typedef ExpertOrderT<true> ExpertOrderG;

template <class Epi, class Sched, bool ALIGN_EPI = false, bool SP2 = false>
__device__ __forceinline__ void gemm_phase(PG8_LAS unsigned char* lds, const Gemm g, const Sched& S, const Epi& E) {
    int tid_o = threadIdx.x; asm volatile("" : "+v"(tid_o));
    const int tid = tid_o, wid = __builtin_amdgcn_readfirstlane(tid >> 6), lane = tid & 63, wr = wid >> 2, wc = wid & 3, fr = lane & 15, fq = lane >> 4;
    static_assert(SP2 || !Sched::GATHER, "the gathered A operand is wired into the SP2 loop only");
    const int K = g.K, nt = K / BK;
    unsigned voffA[2], voffB[2];
    unsigned gAc[2][2], gAn[2][2]; int gR[2], gC[2];
#pragma unroll
    for (int i = 0; i < 2; ++i) { int R, C; stage_rc(tid * 16 + i * 8192, R, C); const int Rb = Epi::PERM ? ((R & ~31) + perm32(R & 31)) : R;
        voffA[i] = (unsigned)(R * K + C) * 2u; voffB[i] = (unsigned)(Rb * K + C) * 2u; gR[i] = R; gC[i] = C; }
    const size_t kstep = (size_t)(BK * 2);
    const size_t hstep = (size_t)HALF * K * 2;
    const size_t tstep = 2 * hstep;
    const unsigned ldsw = (unsigned)wid * 1024u;
    const int aoff = lds_byte(wr * 64 + fr, fq * 8), boff = lds_byte(wc * 32 + fr, fq * 8);
#define PG8_SA(b, h) (((b) * 2 + (h)) * HTB)
#define PG8_SB(b, h) ((4 + (b) * 2 + (h)) * HTB)
#define PG8_STAGE(bufoff, gbase, voff) do { _Pragma("unroll") for (int _i = 0; _i < 2; ++_i) \
        __builtin_amdgcn_global_load_lds((const unsigned*)((const char*)(gbase) + (voff)[_i]), (PG8_LAS unsigned*)(lds + (bufoff) + ldsw + _i * 8192), 16, 0, 0); } while (0)
#define PG8_STAGE_A(bufoff, ptr, h, goff) do { if constexpr (Sched::GATHER) { PG8_STAGE(bufoff, ptr, (goff)[h]); } else { PG8_STAGE(bufoff, (ptr) + (h) * hstep, voffA); } } while (0)
#define PG8_GLOAD(dst, u) do { _Pragma("unroll") for (int _h = 0; _h < 2; ++_h) _Pragma("unroll") for (int _i = 0; _i < 2; ++_i) \
        dst[_h][_i] = (unsigned)S.rowtok[(u).pm * BM + _h * HALF + gR[_i]] * (unsigned)(K * 2) + (unsigned)(gC[_i] * 2); } while (0)
#define PG8_LDA(dst, b, h) do { _Pragma("unroll") for (int m = 0; m < 4; ++m) _Pragma("unroll") for (int k = 0; k < 2; ++k) dst[m][k] = *(const PG8_LAS bf16x8*)(lds + PG8_SA(b, h) + aoff + m * 2048 + k * 1024); } while (0)
#define PG8_LDB(dst, b, h) do { _Pragma("unroll") for (int n = 0; n < 2; ++n) _Pragma("unroll") for (int k = 0; k < 2; ++k) dst[n][k] = *(const PG8_LAS bf16x8*)(lds + PG8_SB(b, h) + boff + n * 2048 + k * 1024); } while (0)
#define PG8_MMA(ai, bj, At, Bt) do { __builtin_amdgcn_s_setprio(1); _Pragma("unroll") for (int m = 0; m < 4; ++m) _Pragma("unroll") for (int n = 0; n < 2; ++n) _Pragma("unroll") for (int k = 0; k < 2; ++k) \
        acc[ai][bj][m][n] = __builtin_amdgcn_mfma_f32_16x16x32_bf16(Bt[n][k], At[m][k], acc[ai][bj][m][n], 0, 0, 0); __builtin_amdgcn_s_setprio(0); } while (0)
#define PG8_WAIT_V(n) asm volatile("s_waitcnt vmcnt(" #n ")" ::: "memory")
#define PG8_WAIT_L(n) asm volatile("s_waitcnt lgkmcnt(" #n ")" ::: "memory")
#define PG8_BAR __builtin_amdgcn_s_barrier()
#define PG8_SCHED __builtin_amdgcn_sched_barrier(0)
    Unit cur, nxt; int ui = 0;
    if (!S.next(0, cur)) return;
    f32x4 acc[2][2][4][2];
#pragma unroll
    for (int a = 0; a < 2; ++a)
#pragma unroll
        for (int b = 0; b < 2; ++b)
#pragma unroll
            for (int m = 0; m < 4; ++m)
#pragma unroll
                for (int n = 0; n < 2; ++n) acc[a][b][m][n] = (f32x4){0.f, 0.f, 0.f, 0.f};
    bf16x8 At[4][2], B0[2][2], B1[2][2];
    const char* cA = (const char*)g.A + (Sched::GATHER ? (size_t)0 : (size_t)cur.pm * tstep); const char* cB = (const char*)g.Bt + (size_t)cur.pn * tstep;
    if constexpr (Sched::GATHER) { PG8_GLOAD(gAc, cur); }
    S.a_ready(cur);
    if constexpr (SP2) {
        PG8_STAGE(PG8_SB(0, 0), cB, voffB); PG8_STAGE(PG8_SB(0, 1), cB + hstep, voffB); PG8_STAGE_A(PG8_SA(0, 0), cA, 0, gAc); PG8_STAGE_A(PG8_SA(0, 1), cA, 1, gAc);
        if (wr == 1) PG8_BAR;
        PG8_WAIT_V(2); PG8_BAR;
        PG8_STAGE(PG8_SB(1, 0), cB + kstep, voffB); PG8_STAGE_A(PG8_SA(1, 0), cA + kstep, 0, gAc); PG8_STAGE(PG8_SB(1, 1), cB + hstep + kstep, voffB);
        PG8_WAIT_V(6); PG8_BAR;
    } else {
        PG8_STAGE(PG8_SB(0, 0), cB, voffB); PG8_STAGE(PG8_SA(0, 0), cA, voffA); PG8_STAGE(PG8_SB(0, 1), cB + hstep, voffB); PG8_STAGE(PG8_SA(0, 1), cA + hstep, voffA);
        if (wr == 1) PG8_BAR;
        PG8_WAIT_V(4); PG8_BAR;
        PG8_STAGE(PG8_SB(1, 0), cB + kstep, voffB); PG8_STAGE(PG8_SA(1, 0), cA + kstep, voffA); PG8_STAGE(PG8_SB(1, 1), cB + hstep + kstep, voffB);
        PG8_WAIT_V(6); PG8_BAR;
    }
    for (;;) {
        const bool has_next = S.next(ui + 1, nxt);
        const char* nA = (has_next && !Sched::GATHER) ? (const char*)g.A + (size_t)nxt.pm * tstep : cA;
        if constexpr (Sched::GATHER) { if (has_next) { PG8_GLOAD(gAn, nxt); } else { _Pragma("unroll") for (int _h = 0; _h < 2; ++_h) _Pragma("unroll") for (int _i = 0; _i < 2; ++_i) gAn[_h][_i] = gAc[_h][_i]; } }
        const char* nB = has_next ? (const char*)g.Bt + (size_t)nxt.pn * tstep : cB;
        for (int t = 0; t < nt; t += 2) {
            const bool last = (t == nt - 2);
            const char* a1 = cA + (size_t)(t + 1) * kstep;
            const char* a2 = last ? nA : cA + (size_t)(t + 2) * kstep; const char* b2 = last ? nB : cB + (size_t)(t + 2) * kstep;
            const char* a3 = a2 + kstep; const char* b3 = b2 + kstep;
            if (last && has_next) S.a_ready(nxt);
            unsigned g2[2][2];
            if constexpr (Sched::GATHER) { _Pragma("unroll") for (int _h = 0; _h < 2; ++_h) _Pragma("unroll") for (int _i = 0; _i < 2; ++_i) g2[_h][_i] = last ? gAn[_h][_i] : gAc[_h][_i]; }
            if constexpr (SP2) {
            PG8_LDB(B0, 0, 0); PG8_LDB(B1, 0, 1); PG8_SCHED; PG8_LDA(At, 0, 0); PG8_STAGE_A(PG8_SA(1, 1), a1, 1, gAc);
            PG8_WAIT_V(8); PG8_WAIT_L(0); PG8_BAR; PG8_MMA(0, 0, At, B0); PG8_MMA(0, 1, At, B1); PG8_BAR; PG8_SCHED;
            PG8_LDA(At, 0, 1); PG8_STAGE(PG8_SB(0, 0), b2, voffB); PG8_STAGE(PG8_SB(0, 1), b2 + hstep, voffB); PG8_STAGE_A(PG8_SA(0, 0), a2, 0, g2);
            PG8_WAIT_V(8); PG8_WAIT_L(0); PG8_BAR; PG8_MMA(1, 0, At, B0); PG8_MMA(1, 1, At, B1); PG8_BAR; PG8_SCHED;
            PG8_LDB(B0, 1, 0); PG8_LDB(B1, 1, 1); PG8_SCHED; PG8_LDA(At, 1, 0); PG8_STAGE_A(PG8_SA(0, 1), a2, 1, g2);
            PG8_WAIT_V(8); PG8_WAIT_L(0); PG8_BAR; PG8_MMA(0, 0, At, B0); PG8_MMA(0, 1, At, B1); PG8_BAR; PG8_SCHED;
            PG8_LDA(At, 1, 1); PG8_STAGE(PG8_SB(1, 0), b3, voffB); PG8_STAGE(PG8_SB(1, 1), b3 + hstep, voffB); PG8_STAGE_A(PG8_SA(1, 0), a3, 0, g2);
            PG8_WAIT_V(8); PG8_WAIT_L(0); PG8_BAR; PG8_MMA(1, 0, At, B0); PG8_MMA(1, 1, At, B1); PG8_BAR; PG8_SCHED;
            } else {
            PG8_LDB(B0, 0, 0); PG8_SCHED; PG8_LDA(At, 0, 0); PG8_STAGE(PG8_SA(1, 1), a1 + hstep, voffA);
            PG8_WAIT_L(8); PG8_BAR; PG8_WAIT_L(0); PG8_MMA(0, 0, At, B0); PG8_BAR; PG8_SCHED;
            PG8_LDB(B1, 0, 1); PG8_STAGE(PG8_SB(0, 0), b2, voffB);
            PG8_BAR; PG8_WAIT_L(0); PG8_MMA(0, 1, At, B1); PG8_BAR;
            PG8_LDA(At, 0, 1); PG8_STAGE(PG8_SA(0, 0), a2, voffA);
            PG8_BAR; PG8_WAIT_L(0); PG8_MMA(1, 0, At, B0); PG8_BAR; PG8_SCHED;
            PG8_STAGE(PG8_SB(0, 1), b2 + hstep, voffB);
            PG8_WAIT_V(6); PG8_BAR; PG8_MMA(1, 1, At, B1); PG8_BAR;
            PG8_LDB(B0, 1, 0); PG8_SCHED; PG8_LDA(At, 1, 0); PG8_STAGE(PG8_SA(0, 1), a2 + hstep, voffA);
            PG8_WAIT_L(8); PG8_BAR; PG8_WAIT_L(0); PG8_MMA(0, 0, At, B0); PG8_BAR; PG8_SCHED;
            PG8_LDB(B1, 1, 1); PG8_STAGE(PG8_SB(1, 0), b3, voffB);
            PG8_BAR; PG8_WAIT_L(0); PG8_MMA(0, 1, At, B1); PG8_BAR;
            PG8_LDA(At, 1, 1); PG8_STAGE(PG8_SA(1, 0), a3, voffA);
            PG8_BAR; PG8_WAIT_L(0); PG8_MMA(1, 0, At, B0); PG8_BAR; PG8_SCHED;
            PG8_STAGE(PG8_SB(1, 1), b3 + hstep, voffB);
            PG8_WAIT_V(6); PG8_BAR; PG8_MMA(1, 1, At, B1); PG8_BAR;
            }
        }
        if constexpr (ALIGN_EPI) { if (wr == 0) PG8_BAR; }
        if constexpr (!Epi::AFTER_DRAIN) { E(acc, cur, wr, wc, fr, fq); S.done(cur); }
        if (!has_next) break;
#pragma unroll
        for (int a = 0; a < 2; ++a)
#pragma unroll
            for (int b = 0; b < 2; ++b)
#pragma unroll
                for (int m = 0; m < 4; ++m)
#pragma unroll
                    for (int n = 0; n < 2; ++n) acc[a][b][m][n] = (f32x4){0.f, 0.f, 0.f, 0.f};
        cur = nxt; cA = nA; cB = nB; ++ui;
        if constexpr (Sched::GATHER) { _Pragma("unroll") for (int _h = 0; _h < 2; ++_h) _Pragma("unroll") for (int _i = 0; _i < 2; ++_i) gAc[_h][_i] = gAn[_h][_i]; }
        if constexpr (ALIGN_EPI) { if (wr == 1) PG8_BAR; }
    }
    PG8_WAIT_V(0);
    if constexpr (!ALIGN_EPI) { if (wr == 0) PG8_BAR; }
    PG8_BAR;
    if constexpr (Epi::AFTER_DRAIN) { E.fused(acc, cur, wr, wc, fr, fq, lds, wid, lane); S.done(cur); }
#undef PG8_SA
#undef PG8_SB
#undef PG8_STAGE
#undef PG8_STAGE_A
#undef PG8_GLOAD
#undef PG8_LDA
#undef PG8_LDB
#undef PG8_MMA
#undef PG8_WAIT_V
#undef PG8_WAIT_L
#undef PG8_BAR
#undef PG8_SCHED
}
}

struct Args { const float* in[26]; float* out; unsigned char* ws; };

__device__ __forceinline__ void p_mod(LAS unsigned char* lds, const float* __restrict__ c, const float* __restrict__ c_ctx, const float* __restrict__ ada_w,
                                      const float* __restrict__ ada_b, float* __restrict__ mod, int bid, int G, int tid) {
    if (bid >= 96) return;
    LAS float* s = (LAS float*)lds;
    LAS float* red = s + 17 * 1024;
    for (int i = tid; i < 17 * 1024; i += NTHREADS) { const int r = i >> 10, k = i & 1023; const float v = r < NB ? c[r * DM + k] : c_ctx[k]; s[i] = v / (1.0f + expf(-v)); }
    __syncthreads();
    for (int it = bid; it < 96; it += G) {
        const int cc = tid & 63, kg = tid >> 6, col = it * 64 + cc;
        float acc[17];
#pragma unroll
        for (int r = 0; r < 17; ++r) acc[r] = 0.f;
        for (int k = kg * 128; k < kg * 128 + 128; ++k) {
            const float w = ada_w[(size_t)k * 6144 + col];
#pragma unroll
            for (int r = 0; r < 17; ++r) acc[r] += s[r * 1024 + k] * w;
        }
#pragma unroll
        for (int r = 0; r < 17; ++r) red[(kg * 17 + r) * 64 + cc] = acc[r];
        __syncthreads();
        for (int i = tid; i < 17 * 64; i += NTHREADS) {
            const int r = i >> 6, c2 = i & 63; float sum = 0.f;
#pragma unroll
            for (int g = 0; g < 8; ++g) sum += red[(g * 17 + r) * 64 + c2];
            mod[(size_t)r * 6144 + it * 64 + c2] = sum + ada_b[it * 64 + c2];
        }
        __syncthreads();
    }
}

struct TrTile { const float* W; bf16_t* O; int K, N, mode, k0, n0; };
__device__ __forceinline__ TrTile tr_decode(const Args& a, int r) {
    unsigned char* ws = a.ws;
    constexpr int I_IN = 16 * 56, I_OUT = 16 * 16, I_E = 32 * 128;
    TrTile t;
    if (r < I_IN) { t = TrTile{a.in[6], (bf16_t*)(ws + WS_WINT), DM, NIN, 0, (r & 15) * 64, (r >> 4) * 64}; return t; } r -= I_IN;
    if (r < I_OUT) { t = TrTile{a.in[14], (bf16_t*)(ws + WS_WOUTT), DM, DM, 0, (r & 15) * 64, (r >> 4) * 64}; return t; } r -= I_OUT;
    if (r < I_E) { const int e = r >> 7, q = r & 127; t = TrTile{a.in[21] + (size_t)e * DM * DE, (bf16_t*)(ws + WS_W13T) + (size_t)e * DM * DM, DM, DE, 1, (q & 15) * 64, (q >> 4) * 64}; return t; } r -= I_E;
    if (r < I_E) { const int e = r >> 7, q = r & 127; t = TrTile{a.in[22] + (size_t)e * DM * DE, (bf16_t*)(ws + WS_W13T) + (size_t)e * DM * DM, DM, DE, 2, (q & 15) * 64, (q >> 4) * 64}; return t; } r -= I_E;
    { const int e = r >> 7, q = r & 127; t = TrTile{a.in[23] + (size_t)e * DE * DM, (bf16_t*)(ws + WS_W2T) + (size_t)e * DM * DE, DE, DM, 0, (q & 7) * 64, (q >> 3) * 64}; return t; }
}
__device__ __forceinline__ void p_transposes(LAS unsigned char* lds, const Args& a, int bid, int G, int tid) {
    constexpr int NITEMS = (16 * 56 + 16 * 16 + 3 * 32 * 128) / 4;
    const int lrow = tid >> 4, lc4 = (tid & 15) * 4;
    const int sc = tid & 7, sn = tid >> 3;
    for (int it = bid; it < NITEMS; it += G) {
        f32x4 v[4][2]; TrTile t[4];
#pragma unroll
        for (int q = 0; q < 4; ++q) { t[q] = tr_decode(a, it * 4 + q);
#pragma unroll
            for (int h = 0; h < 2; ++h) v[q][h] = *(const f32x4*)(t[q].W + (size_t)(t[q].k0 + lrow + 32 * h) * t[q].N + t[q].n0 + lc4); }
        __syncthreads();
#pragma unroll
        for (int q = 0; q < 4; ++q) { LAS float* tile = (LAS float*)lds + q * (64 * 65);
#pragma unroll
            for (int h = 0; h < 2; ++h)
#pragma unroll
                for (int j = 0; j < 4; ++j) tile[(lrow + 32 * h) * 65 + lc4 + j] = v[q][h][j]; }
        __syncthreads();
#pragma unroll
        for (int q = 0; q < 4; ++q) { const LAS float* tile = (const LAS float*)lds + q * (64 * 65) + (8 * sc) * 65 + sn;
            const int n = t[q].n0 + sn, mode = t[q].mode;
            const int orow = mode == 0 ? n : ((n >> 4) * 32 + (mode == 2 ? 16 : 0) + (n & 15));
            u32x4 w; w.x = pk2(tile[0 * 65], tile[1 * 65]); w.y = pk2(tile[2 * 65], tile[3 * 65]); w.z = pk2(tile[4 * 65], tile[5 * 65]); w.w = pk2(tile[6 * 65], tile[7 * 65]);
            *(u32x4*)(t[q].O + (size_t)orow * t[q].K + t[q].k0 + 8 * sc) = w; }
    }
    __syncthreads();
}

__device__ __forceinline__ void p_u(const float* __restrict__ x, const float* __restrict__ ctx, const float* __restrict__ mod, bf16_t* __restrict__ U, int bid, int G, int tid) {
    const int c8 = (tid & 127) * 8, rsub = tid >> 7;
    for (int row0 = bid * 16; row0 < TA; row0 += G * 16) {
        f32x4 v[4][2];
#pragma unroll
        for (int q = 0; q < 4; ++q) { const int row = row0 + q * 4 + rsub; const float* src = row < T ? x + (size_t)row * DM : ctx + (size_t)(row - T) * DM;
            v[q][0] = *(const f32x4*)(src + c8); v[q][1] = *(const f32x4*)(src + c8 + 4); }
#pragma unroll
        for (int q = 0; q < 4; ++q) { const int row = row0 + q * 4 + rsub; const float* m = mod + (size_t)(row < T ? row / SEQ : 16) * 6144;
            const f32x4 sh0 = *(const f32x4*)(m + c8), sh1 = *(const f32x4*)(m + c8 + 4), sc0 = *(const f32x4*)(m + 1024 + c8), sc1 = *(const f32x4*)(m + 1024 + c8 + 4);
            const f32x4 u0 = v[q][0] * (1.0f + sc0) + sh0, u1 = v[q][1] * (1.0f + sc1) + sh1;
            u32x4 w; w.x = pk2(u0[0], u0[1]); w.y = pk2(u0[2], u0[3]); w.z = pk2(u1[0], u1[1]); w.w = pk2(u1[2], u1[3]);
            *(u32x4*)(U + (size_t)row * DM + c8) = w; }
    }
}

__device__ __forceinline__ void router_decide(const float (&pl)[36], int slot, int lane, LAS int* lcnt, LAS i32x4* tinfo, LAS f32x2* tw) {
    int gi = 0; float gm = pl[0];
#pragma unroll
    for (int g = 1; g < 4; ++g) if (pl[g] > gm) { gm = pl[g]; gi = g; }
    float den = 0.f;
#pragma unroll
    for (int g = 0; g < 4; ++g) den += __expf(pl[g] - gm);
    const float gval = frcp(den);
    int j0 = -1; float v0 = -3.0e38f;
#pragma unroll
    for (int j = 0; j < 32; ++j) { const bool in = (j >> 3) == gi; if (in && (j0 < 0 || pl[4 + j] > v0)) { v0 = pl[4 + j]; j0 = j; } }
    int j1 = -1; float v1 = -3.0e38f;
#pragma unroll
    for (int j = 0; j < 32; ++j) { const bool in = (j >> 3) == gi; if (in && j != j0 && (j1 < 0 || pl[4 + j] > v1)) { v1 = pl[4 + j]; j1 = j; } }
    if (lane == 0) {
        const float t = __expf(v1 - v0), w0 = frcp(1.0f + t), w1 = t * w0;
        const int p0 = __hip_atomic_fetch_add(lcnt + j0, 1, __ATOMIC_RELAXED, __HIP_MEMORY_SCOPE_WORKGROUP), p1 = __hip_atomic_fetch_add(lcnt + j1, 1, __ATOMIC_RELAXED, __HIP_MEMORY_SCOPE_WORKGROUP);
        tinfo[slot] = (i32x4){j0, j1, p0, p1}; tw[slot] = (f32x2){gval * w0, gval * w1};
    }
}
__device__ __forceinline__ void p_ln1_router(LAS unsigned char* lds, const Args& a, int bid, int G, int tid, int wave, int lane, bool dry = false) {
    const float* __restrict__ x = a.in[0]; const bf16_t* yb = (const bf16_t*)(a.ws + WS_XG); float* h1o = dry ? (float*)(a.ws + WS_HID) : a.out; const float* mod = (const float*)(a.ws + WS_MOD);
    const float* __restrict__ ln_g = a.in[15]; const float* __restrict__ ln_b = a.in[16];
    const float* __restrict__ rgw = a.in[17]; const float* __restrict__ rgb = a.in[18]; const float* __restrict__ rew = a.in[19]; const float* __restrict__ reb = a.in[20];
    bf16_t* U2 = (bf16_t*)(a.ws + (dry ? WS_Y + 16 * MiB : WS_U)); int* counts = (int*)(a.ws + WS_CTL) + (dry ? 32 * CSTR : 0);
    int2* eidx = (int2*)(a.ws + (dry ? WS_Y : WS_EIDX)); int2* epos = (int2*)(a.ws + (dry ? WS_Y + 4 * MiB : WS_EPOS)); float2* ew = (float2*)(a.ws + (dry ? WS_Y + 8 * MiB : WS_EW));
    LAS float* WT = (LAS float*)lds;
    for (int i = tid; i < 1024 * 4; i += NTHREADS) WT[(i & 3) * 1024 + (i >> 2)] = rgw[i];
    for (int i = tid; i < 1024 * 32; i += NTHREADS) WT[(4 + (i & 31)) * 1024 + (i >> 5)] = rew[i];
    LAS float* BIAS = WT + 36 * 1024;
    LAS int* lcnt = (LAS int*)(BIAS + 64);
    LAS int* lbase = lcnt + 32;
    LAS i32x4* tinfo = (LAS i32x4*)(lbase + 32);
    LAS f32x2* tw = (LAS f32x2*)(tinfo + 256);
    if (tid < 36) BIAS[tid] = tid < 4 ? rgb[tid] : reb[tid - 4];
    if (tid < 32) lcnt[tid] = 0;
    __syncthreads();
    int nslot = 0;
#pragma unroll 1
    for (int pr = bid * 8 + wave; pr < T / 2; pr += G * 8) {
        int l2 = lane; asm volatile("" : "+v"(l2)); const int lane = l2;
        const int tok0 = 2 * pr;
        const float* m = mod + (size_t)(tok0 / SEQ) * 6144;
        f32x4 v[2][4]; float s[2] = {0.f, 0.f};
#pragma unroll
        for (int t = 0; t < 2; ++t)
#pragma unroll
            for (int j = 0; j < 4; ++j) { const int c4 = 4 * lane + 256 * j;
                const f32x4 xv = *(const f32x4*)(x + (size_t)(tok0 + t) * DM + c4), g1 = *(const f32x4*)(m + 2048 + c4);
                const u32x2 yw = *(const u32x2*)(yb + (size_t)(tok0 + t) * DM + c4);
                const f32x4 yv = (f32x4){__uint_as_float(yw.x << 16), __uint_as_float(yw.x & 0xffff0000u), __uint_as_float(yw.y << 16), __uint_as_float(yw.y & 0xffff0000u)};
                v[t][j] = ALPHA * xv + g1 * yv; s[t] += (v[t][j][0] + v[t][j][1]) + (v[t][j][2] + v[t][j][3]); }
        float rstd[2];
#pragma unroll
        for (int t = 0; t < 2; ++t) { const float mean = wave_sum(s[t]) * (1.0f / DM); float s2 = 0.f;
#pragma unroll
            for (int j = 0; j < 4; ++j) { v[t][j] = v[t][j] - mean; s2 += (v[t][j][0] * v[t][j][0] + v[t][j][1] * v[t][j][1]) + (v[t][j][2] * v[t][j][2] + v[t][j][3] * v[t][j][3]); }
            rstd[t] = rsqrtf(wave_sum(s2) * (1.0f / DM) + LN_EPS); }
        float plA[36], plB[36];
#pragma unroll
        for (int e = 0; e < 36; ++e) { plA[e] = 0.f; plB[e] = 0.f; }
#pragma unroll
        for (int j = 0; j < 4; ++j) { const int c4 = 4 * lane + 256 * j;
            const f32x4 lg = *(const f32x4*)(ln_g + c4), lb = *(const f32x4*)(ln_b + c4), sc2 = *(const f32x4*)(m + 4096 + c4), sh2 = *(const f32x4*)(m + 3072 + c4);
            f32x4 u2[2];
#pragma unroll
            for (int t = 0; t < 2; ++t) { const f32x4 h1 = v[t][j] * rstd[t] * lg + lb;
                *(f32x4*)(h1o + (size_t)(tok0 + t) * DM + c4) = h1;
                u2[t] = h1 * (1.0f + sc2) + sh2;
                u32x2 w; w.x = pk2(u2[t][0], u2[t][1]); w.y = pk2(u2[t][2], u2[t][3]);
                *(u32x2*)(U2 + (size_t)(tok0 + t) * DM + c4) = w; }
#pragma unroll
            for (int e = 0; e < 36; ++e) { const f32x4 w4 = *(const LAS f32x4*)(WT + e * 1024 + c4);
                plA[e] += (u2[0][0] * w4[0] + u2[0][1] * w4[1]) + (u2[0][2] * w4[2] + u2[0][3] * w4[3]);
                plB[e] += (u2[1][0] * w4[0] + u2[1][1] * w4[1]) + (u2[1][2] * w4[2] + u2[1][3] * w4[3]);
                if ((e % 6) == 5) __builtin_amdgcn_sched_barrier(0); }
        }
#pragma unroll
        for (int e = 0; e < 36; ++e) { const float be = BIAS[e]; plA[e] = wave_sum(plA[e]) + be; plB[e] = wave_sum(plB[e]) + be; if ((e & 3) == 3) __builtin_amdgcn_sched_barrier(0); }
        router_decide(plA, wave * 32 + nslot, lane, lcnt, tinfo, tw);
        router_decide(plB, wave * 32 + nslot + 1, lane, lcnt, tinfo, tw);
        nslot += 2;
    }
    __syncthreads();
    if (tid < 32) lbase[tid] = atomicAdd(&counts[tid * CSTR], lcnt[tid]);
    __syncthreads();
    if (lane < nslot) {
        const int pr = bid * 8 + wave + (lane >> 1) * (G * 8), tok = 2 * pr + (lane & 1);
        const i32x4 ti = tinfo[wave * 32 + lane]; const f32x2 wv = tw[wave * 32 + lane];
        eidx[tok] = make_int2(ti[0], ti[1]); epos[tok] = make_int2(lbase[ti[0]] + ti[2], lbase[ti[1]] + ti[3]); ew[tok] = make_float2(wv[0], wv[1]);
    }
    __syncthreads();
}

constexpr size_t WS_ROWTOK = 5 * MiB;
__device__ __forceinline__ void p_assign(LAS unsigned char* lds, const Args& a, int bid, int G, int tid) {
    const int* counts = (const int*)(a.ws + WS_CTL);
    const int2* eidx = (const int2*)(a.ws + WS_EIDX); const int2* epos = (const int2*)(a.ws + WS_EPOS); int2* dest = (int2*)(a.ws + WS_DEST); int* rowtok = (int*)(a.ws + WS_ROWTOK);
    LAS int* ps = (LAS int*)lds;
    if (tid == 0) { int acc = 0; for (int e = 0; e < NE; ++e) { const int c = counts[e * CSTR]; ps[e] = acc; ps[32 + e] = c; acc += ((c + 255) >> 8) << 8; } }
    __syncthreads();
    for (int tok = bid * NTHREADS + tid; tok < T; tok += G * NTHREADS) {
        const int2 ei = eidx[tok], ep = epos[tok];
        const int d0 = ps[ei.x] + ep.x, d1 = ps[ei.y] + ep.y;
        rowtok[d0] = tok; rowtok[d1] = tok; dest[tok] = make_int2(d0, d1);
    }
    for (int i = bid * NTHREADS + tid; i < NE * 256; i += G * NTHREADS) {
        const int e = i >> 8, r = i & 255, c = ps[32 + e];
        if (c + r < (((c + 255) >> 8) << 8)) rowtok[ps[e] + c + r] = 0;
    }
    __syncthreads();
}

__device__ __forceinline__ void p_combine_ln2(const Args& a, int bid, int G, int wave, int lane, bool dry = false) {
    const float* out = a.out; float* outw = dry ? (float*)(a.ws + WS_XG) : a.out; const bf16_t* Y = (const bf16_t*)(a.ws + WS_Y); const int2* dest = (const int2*)(a.ws + WS_DEST); const float2* ew = (const float2*)(a.ws + WS_EW);
    const float* mod = (const float*)(a.ws + WS_MOD); const float* __restrict__ ln_g = a.in[24]; const float* __restrict__ ln_b = a.in[25];
    for (int tok = bid * 8 + wave; tok < T; tok += G * 8) {
        const float* m = mod + (size_t)(tok / SEQ) * 6144;
        const int2 d = dest[tok]; const float2 w = ew[tok];
        f32x4 v[4]; float s = 0.f;
#pragma unroll
        for (int j = 0; j < 4; ++j) { const int c4 = 4 * lane + 256 * j;
            const u32x2 ya = *(const u32x2*)(Y + (size_t)d.x * DM + c4), yb = *(const u32x2*)(Y + (size_t)d.y * DM + c4);
            f32x4 f;
            f[0] = w.x * __uint_as_float(ya.x << 16) + w.y * __uint_as_float(yb.x << 16);
            f[1] = w.x * __uint_as_float(ya.x & 0xffff0000u) + w.y * __uint_as_float(yb.x & 0xffff0000u);
            f[2] = w.x * __uint_as_float(ya.y << 16) + w.y * __uint_as_float(yb.y << 16);
            f[3] = w.x * __uint_as_float(ya.y & 0xffff0000u) + w.y * __uint_as_float(yb.y & 0xffff0000u);
            const f32x4 h1 = *(const f32x4*)(out + (size_t)tok * DM + c4), g2 = *(const f32x4*)(m + 5120 + c4);
            v[j] = ALPHA * h1 + g2 * f; s += (v[j][0] + v[j][1]) + (v[j][2] + v[j][3]); }
        const float mean = wave_sum(s) * (1.0f / DM); float s2 = 0.f;
#pragma unroll
        for (int j = 0; j < 4; ++j) { v[j] = v[j] - mean; s2 += (v[j][0] * v[j][0] + v[j][1] * v[j][1]) + (v[j][2] * v[j][2] + v[j][3] * v[j][3]); }
        const float rstd = rsqrtf(wave_sum(s2) * (1.0f / DM) + LN_EPS);
#pragma unroll
        for (int j = 0; j < 4; ++j) { const int c4 = 4 * lane + 256 * j;
            *(f32x4*)(outw + (size_t)tok * DM + c4) = v[j] * rstd * *(const f32x4*)(ln_g + c4) + *(const f32x4*)(ln_b + c4); }
    }
}

constexpr size_t WS_HGK = WS_U;
constexpr size_t WS_HGD = 852 * MiB;
constexpr size_t WS_RGAGG = 854 * MiB;
constexpr size_t WS_RGCARRY = 864 * MiB;
constexpr size_t WS_GWT = 870 * MiB;
constexpr size_t WS_OFST = 880 * MiB;
constexpr int RG_UNITS_PER_B = 68, HG_SEGS = 17;

__device__ __forceinline__ void lds_barrier() { asm volatile("s_waitcnt lgkmcnt(0)" ::: "memory"); __builtin_amdgcn_s_barrier(); asm volatile("" ::: "memory"); }
__device__ __forceinline__ bf16x8 mk_bf16x8(u32x4 v) { return __builtin_bit_cast(bf16x8, v); }
__device__ __forceinline__ float bf_lo(unsigned w) { return __uint_as_float(w << 16); }
__device__ __forceinline__ float bf_hi(unsigned w) { return __uint_as_float(w & 0xffff0000u); }
__device__ __forceinline__ unsigned cvt2(float lo, float hi) { unsigned r; asm volatile("v_cvt_pk_bf16_f32 %0, %1, %2" : "=v"(r) : "v"(lo), "v"(hi)); return r; }

__device__ __forceinline__ void p_gwt(const float* __restrict__ gate_w, bf16_t* __restrict__ gwt, int bid, int G, int tid) {
    for (int o = bid * NTHREADS + tid; o < 32 * 4096; o += G * NTHREADS) { const int mat = o >> 12, d = (o >> 6) & 63, c = o & 63; gwt[o] = f2bf(gate_w[mat * 4096 + c * 64 + d]); }
}

constexpr int XC_STRIDE = 1040;
constexpr int RG_XC = 0, RG_OUT = 64 * XC_STRIDE;
constexpr size_t WS_RGPAR = 876 * MiB;

__device__ __forceinline__ void p_rgpar(const float* __restrict__ gate_b, const float* __restrict__ lam, float* __restrict__ par, int bid, int G, int tid) {
    for (int o = bid * NTHREADS + tid; o < 2 * 512; o += G * NTHREADS) { const int dir = o >> 9, ch = o & 511;
        par[(dir * 3 + 0) * 512 + ch] = gate_b[(dir * 2 + 0) * 512 + ch]; par[(dir * 3 + 1) * 512 + ch] = gate_b[(dir * 2 + 1) * 512 + ch]; par[(dir * 3 + 2) * 512 + ch] = softplusf_(-lam[dir * 512 + ch]); }
}

template <int DIR, bool OUT>
__device__ __forceinline__ void rg_scan64(const float (&av)[4][4], const float (&uv)[4][4], float& carry, float& atot, float (&hsum)[4][4], int fr, int fq) {
#pragma unroll
    for (int mm = 0; mm < 4; ++mm) {
        const int m = DIR == 0 ? mm : 3 - mm;
        float P, H;
        if (DIR == 0) { P = av[m][0]; H = uv[m][0];
#pragma unroll
            for (int j = 1; j < 4; ++j) { H = av[m][j] * H + uv[m][j]; P *= av[m][j]; } }
        else { P = av[m][3]; H = uv[m][3];
#pragma unroll
            for (int j = 2; j >= 0; --j) { H = av[m][j] * H + uv[m][j]; P *= av[m][j]; } }
        float Pn, Hn, Pe, He, Pt, Ht;
        if (DIR == 0) {
            Pn = __shfl_up(P, 16); Hn = __shfl_up(H, 16); if (fq >= 1) { H = P * Hn + H; P = P * Pn; }
            Pn = __shfl_up(P, 32); Hn = __shfl_up(H, 32); if (fq >= 2) { H = P * Hn + H; P = P * Pn; }
            Pe = __shfl_up(P, 16); He = __shfl_up(H, 16); if (fq == 0) { Pe = 1.f; He = 0.f; }
            Pt = __shfl(P, fr + 48); Ht = __shfl(H, fr + 48);
        } else {
            Pn = __shfl_down(P, 16); Hn = __shfl_down(H, 16); if (fq <= 2) { H = P * Hn + H; P = P * Pn; }
            Pn = __shfl_down(P, 32); Hn = __shfl_down(H, 32); if (fq <= 1) { H = P * Hn + H; P = P * Pn; }
            Pe = __shfl_down(P, 16); He = __shfl_down(H, 16); if (fq == 3) { Pe = 1.f; He = 0.f; }
            Pt = __shfl(P, fr); Ht = __shfl(H, fr);
        }
        if (OUT) {
            float hp = Pe * carry + He;
            if (DIR == 0) {
#pragma unroll
                for (int j = 0; j < 4; ++j) { hp = av[m][j] * hp + uv[m][j]; hsum[m][j] = hp; }
            } else {
#pragma unroll
                for (int j = 3; j >= 0; --j) { hp = av[m][j] * hp + uv[m][j]; hsum[m][j] += hp; }
            }
        }
        carry = Pt * carry + Ht; atot *= Pt;
    }
}

__device__ __forceinline__ void rg_agg_unit(LAS unsigned char* lds, const Args& a, int b, int k, int tid, int wave, int lane) {
    const bf16_t* __restrict__ proj = (const bf16_t*)(a.ws + WS_PROJ);
    const float* __restrict__ conv_w = a.in[7]; const float* __restrict__ conv_b = a.in[8];
    const bf16_t* __restrict__ gwt = (const bf16_t*)(a.ws + WS_GWT); const float* __restrict__ par = (const float*)(a.ws + WS_RGPAR);
    float* rgagg = (float*)(a.ws + WS_RGAGG);
    int rowbase, p0, lo, hi;
    if (k < 4) { rowbase = T + b * LC; p0 = k * 64; lo = 0; hi = LC; } else { rowbase = b * SEQ; p0 = (k - 4) * 64; lo = p0; hi = p0 + 64; }
    const int unit = b * RG_UNITS_PER_B + k;
    const int n = wave, fr = lane & 15, fq = lane >> 4;
    float pgr[4][2], pgi[4][2], psp[4][2];
#pragma unroll
    for (int nt = 0; nt < 4; ++nt)
#pragma unroll
        for (int dir = 0; dir < 2; ++dir) { const int ch = n * 64 + nt * 16 + fr;
            pgr[nt][dir] = par[(dir * 3 + 0) * 512 + ch]; pgi[nt][dir] = par[(dir * 3 + 1) * 512 + ch]; psp[nt][dir] = par[(dir * 3 + 2) * 512 + ch]; }
    {
        const int cgp = tid & 63, tg = tid >> 6, c0 = cgp * 8, i0 = tg * 8;
        u32x4 raw[11];
#pragma unroll
        for (int r = 0; r < 11; ++r) { const int p = p0 + i0 - 1 + r;
            raw[r] = (p >= lo && p < hi) ? *(const u32x4*)(proj + (size_t)(rowbase + p) * NIN + c0) : (u32x4){0u, 0u, 0u, 0u}; }
        float cw[4][8], cb[8];
#pragma unroll
        for (int t4 = 0; t4 < 4; ++t4) { const f32x4 w0 = *(const f32x4*)(conv_w + t4 * 512 + c0), w1 = *(const f32x4*)(conv_w + t4 * 512 + c0 + 4);
#pragma unroll
            for (int q = 0; q < 4; ++q) { cw[t4][q] = w0[q]; cw[t4][4 + q] = w1[q]; } }
        { const f32x4 b0 = *(const f32x4*)(conv_b + c0), b1 = *(const f32x4*)(conv_b + c0 + 4);
#pragma unroll
            for (int q = 0; q < 4; ++q) { cb[q] = b0[q]; cb[4 + q] = b1[q]; } }
#pragma unroll
        for (int ii = 0; ii < 8; ++ii) {
            float xc[8];
#pragma unroll
            for (int c = 0; c < 8; ++c) xc[c] = cb[c];
#pragma unroll
            for (int t4 = 0; t4 < 4; ++t4) { const u32x4 rw = raw[ii + t4];
#pragma unroll
                for (int q = 0; q < 4; ++q) { xc[2 * q] += cw[t4][2 * q] * bf_lo(rw[q]); xc[2 * q + 1] += cw[t4][2 * q + 1] * bf_hi(rw[q]); } }
            u32x4 w; w.x = cvt2(xc[0], xc[1]); w.y = cvt2(xc[2], xc[3]); w.z = cvt2(xc[4], xc[5]); w.w = cvt2(xc[6], xc[7]);
            *(LAS u32x4*)(lds + RG_XC + (i0 + ii) * XC_STRIDE + c0 * 2) = w;
        }
    }
    lds_barrier();
    {
        bf16x8 afr[4][2];
#pragma unroll
        for (int m = 0; m < 4; ++m)
#pragma unroll
            for (int ks = 0; ks < 2; ++ks) afr[m][ks] = *(const LAS bf16x8*)(lds + RG_XC + (16 * m + fr) * XC_STRIDE + (n * 64 + ks * 32 + fq * 8) * 2);
        u32x4* stash = (k >= 4) ? (u32x4*)a.out + ((size_t)(b * 64 + (k - 4)) * 16384 + (size_t)wave * 2048 + lane) : nullptr;
        bf16x8 wfr[2][2][2];
#pragma unroll
        for (int dir = 0; dir < 2; ++dir)
#pragma unroll
            for (int g = 0; g < 2; ++g)
#pragma unroll
                for (int ks = 0; ks < 2; ++ks) wfr[dir][g][ks] = *(const bf16x8*)(gwt + ((size_t)(((dir * 2 + g) * 8 + n) * 64 + fr)) * 64 + ks * 32 + fq * 8);
#pragma unroll
        for (int nt = 0; nt < 4; ++nt) {
            const int ch = n * 64 + nt * 16 + fr;
            bf16x8 wnx[2][2][2];
            if (nt < 3) {
#pragma unroll
                for (int dir = 0; dir < 2; ++dir)
#pragma unroll
                    for (int g = 0; g < 2; ++g)
#pragma unroll
                        for (int ks = 0; ks < 2; ++ks) wnx[dir][g][ks] = *(const bf16x8*)(gwt + ((size_t)(((dir * 2 + g) * 8 + n) * 64 + (nt + 1) * 16 + fr)) * 64 + ks * 32 + fq * 8);
            }
            float xcv[4][4];
#pragma unroll
            for (int m = 0; m < 4; ++m)
#pragma unroll
                for (int j = 0; j < 4; ++j) xcv[m][j] = bf2f(*(const LAS bf16_t*)(lds + RG_XC + (16 * m + 4 * fq + j) * XC_STRIDE + ch * 2));
#pragma unroll
            for (int dir = 0; dir < 2; ++dir) {
                f32x4 accr[4], acci[4];
#pragma unroll
                for (int m = 0; m < 4; ++m) { accr[m] = (f32x4){0.f, 0.f, 0.f, 0.f}; acci[m] = (f32x4){0.f, 0.f, 0.f, 0.f}; }
#pragma unroll
                for (int ks = 0; ks < 2; ++ks)
#pragma unroll
                    for (int m = 0; m < 4; ++m) { accr[m] = __builtin_amdgcn_mfma_f32_16x16x32_bf16(afr[m][ks], wfr[dir][0][ks], accr[m], 0, 0, 0); acci[m] = __builtin_amdgcn_mfma_f32_16x16x32_bf16(afr[m][ks], wfr[dir][1][ks], acci[m], 0, 0, 0); }
                const float gbr = pgr[nt][dir], gbi = pgi[nt][dir], sp = psp[nt][dir];
                float av[4][4], uv[4][4];
                const bool exact = __any(8.0f * sp >= 0.25f);
#pragma unroll
                for (int m = 0; m < 4; ++m) {
                    unsigned pk[4];
                    if (!exact) {
#pragma unroll
                        for (int j = 0; j < 4; ++j) {
                            const float r = sigmoidf_(accr[m][j] + gbr), ig = sigmoidf_(acci[m][j] + gbi);
                            const float la = -8.0f * r * sp;
                            const float oma = -la * (1.f + la * (0.5f + la * (0.16666667f + la * (0.041666668f + la * 0.0083333338f))));
                            pk[j] = cvt2(oma, __builtin_amdgcn_sqrtf(oma * (2.0f - oma)) * ig * xcv[m][j]);
                        }
                    } else {
#pragma unroll
                        for (int j = 0; j < 4; ++j) {
                            const float r = sigmoidf_(accr[m][j] + gbr), ig = sigmoidf_(acci[m][j] + gbi);
                            const float la = -8.0f * r * sp;
                            const float ser = -la * (1.f + la * (0.5f + la * (0.16666667f + la * (0.041666668f + la * 0.0083333338f))));
                            const float oma = (la > -0.25f) ? ser : 1.f - __expf(la);
                            pk[j] = cvt2(oma, __builtin_amdgcn_sqrtf(oma * (2.0f - oma)) * ig * xcv[m][j]);
                        }
                    }
#pragma unroll
                    for (int j = 0; j < 4; ++j) { av[m][j] = 1.0f - bf_lo(pk[j]); uv[m][j] = bf_hi(pk[j]); }
                    if (stash) stash[((nt * 2 + dir) * 4 + m) * 64] = (u32x4){pk[0], pk[1], pk[2], pk[3]};
                }
                float carry = 0.f, atot = 1.f, hdummy[4][4];
                if (dir == 0) rg_scan64<0, false>(av, uv, carry, atot, hdummy, fr, fq); else rg_scan64<1, false>(av, uv, carry, atot, hdummy, fr, fq);
                if (fq == 0) { rgagg[(((size_t)unit * 2 + dir) * 2 + 0) * 512 + ch] = atot; rgagg[(((size_t)unit * 2 + dir) * 2 + 1) * 512 + ch] = carry; }
            }
            if (nt < 3) {
#pragma unroll
                for (int dir = 0; dir < 2; ++dir)
#pragma unroll
                    for (int g = 0; g < 2; ++g)
#pragma unroll
                        for (int ks = 0; ks < 2; ++ks) wfr[dir][g][ks] = wnx[dir][g][ks];
            }
        }
    }
    lds_barrier();
}

__device__ __forceinline__ void rg_final_unit(LAS unsigned char* lds, const Args& a, int b, int kl, int tid, int wave, int lane) {
    const bf16_t* __restrict__ proj = (const bf16_t*)(a.ws + WS_PROJ); const float* rgcarry = (const float*)(a.ws + WS_RGCARRY); bf16_t* mixed = (bf16_t*)(a.ws + WS_MIXED);
    const int rowbase = b * SEQ + kl * 64, unit = b * RG_UNITS_PER_B + 4 + kl;
    const int n = wave, fr = lane & 15, fq = lane >> 4;
    const u32x4* stash = (const u32x4*)a.out + ((size_t)(b * 64 + kl) * 16384 + (size_t)wave * 2048 + lane);
    u32x4 st[2][4];
#pragma unroll
    for (int dir = 0; dir < 2; ++dir)
#pragma unroll
        for (int m = 0; m < 4; ++m) st[dir][m] = stash[((0 * 2 + dir) * 4 + m) * 64];
    float cin[4][2];
#pragma unroll
    for (int nt = 0; nt < 4; ++nt)
#pragma unroll
        for (int dir = 0; dir < 2; ++dir) cin[nt][dir] = rgcarry[((size_t)unit * 2 + dir) * 512 + n * 64 + nt * 16 + fr];
    {
        const int cgp = tid & 63, tg = tid >> 6, c0 = cgp * 8, i0 = tg * 8;
        u32x4 g[8];
#pragma unroll
        for (int ii = 0; ii < 8; ++ii) g[ii] = *(const u32x4*)(proj + (size_t)(rowbase + i0 + ii) * NIN + 512 + c0);
#pragma unroll
        for (int ii = 0; ii < 8; ++ii) *(LAS u32x4*)(lds + RG_XC + (i0 + ii) * XC_STRIDE + c0 * 2) = g[ii];
    }
    lds_barrier();
#pragma unroll
    for (int nt = 0; nt < 4; ++nt) {
        const int ch = n * 64 + nt * 16 + fr;
        u32x4 sn[2][4];
        if (nt < 3) {
#pragma unroll
            for (int dir = 0; dir < 2; ++dir)
#pragma unroll
                for (int m = 0; m < 4; ++m) sn[dir][m] = stash[(((nt + 1) * 2 + dir) * 4 + m) * 64];
        }
        float hsum[4][4];
#pragma unroll
        for (int dir = 0; dir < 2; ++dir) {
            float av[4][4], uv[4][4];
#pragma unroll
            for (int m = 0; m < 4; ++m)
#pragma unroll
                for (int j = 0; j < 4; ++j) { av[m][j] = 1.0f - bf_lo(st[dir][m][j]); uv[m][j] = bf_hi(st[dir][m][j]); }
            float carry = cin[nt][dir], atot = 1.f;
            if (dir == 0) rg_scan64<0, true>(av, uv, carry, atot, hsum, fr, fq); else rg_scan64<1, true>(av, uv, carry, atot, hsum, fr, fq);
        }
#pragma unroll
        for (int m = 0; m < 4; ++m)
#pragma unroll
            for (int j = 0; j < 4; ++j) { const int t = 16 * m + 4 * fq + j;
                const float gg = bf2f(*(const LAS bf16_t*)(lds + RG_XC + t * XC_STRIDE + ch * 2));
                *(LAS bf16_t*)(lds + RG_OUT + t * XC_STRIDE + ch * 2) = (bf16_t)(cvt2(hsum[m][j] * gg, 0.f) & 0xffffu); }
        if (nt < 3) {
#pragma unroll
            for (int dir = 0; dir < 2; ++dir)
#pragma unroll
                for (int m = 0; m < 4; ++m) st[dir][m] = sn[dir][m];
        }
    }
    lds_barrier();
    {
        const int cgp = tid & 63, tg = tid >> 6, c0 = cgp * 8, i0 = tg * 8;
#pragma unroll
        for (int ii = 0; ii < 8; ++ii) { const u32x4 w = *(const LAS u32x4*)(lds + RG_OUT + (i0 + ii) * XC_STRIDE + c0 * 2);
            *(u32x4*)(mixed + (size_t)(rowbase + i0 + ii) * DM + c0) = w; }
    }
}

__device__ __forceinline__ void rg_carry_item(const Args& a, int item, int tid) {
    const float* rgagg = (const float*)(a.ws + WS_RGAGG); float* rgcarry = (float*)(a.ws + WS_RGCARRY);
    const int gidx = item * NTHREADS + tid;
    const int ch = gidx & 511, dir = (gidx >> 9) & 1, b = gidx >> 10;
    float h = 0.f;
#pragma unroll 1
    for (int s0 = 0; s0 < RG_UNITS_PER_B; s0 += 17) {
        float Av[17], Hv[17];
#pragma unroll
        for (int s1 = 0; s1 < 17; ++s1) { const int s = s0 + s1;
            const int k = dir == 0 ? s : (s < 4 ? 3 - s : 67 - (s - 4));
            const size_t unit = (size_t)b * RG_UNITS_PER_B + k;
            Av[s1] = rgagg[((unit * 2 + dir) * 2 + 0) * 512 + ch]; Hv[s1] = rgagg[((unit * 2 + dir) * 2 + 1) * 512 + ch]; }
#pragma unroll
        for (int s1 = 0; s1 < 17; ++s1) { const int s = s0 + s1;
            const int k = dir == 0 ? s : (s < 4 ? 3 - s : 67 - (s - 4));
            const size_t unit = (size_t)b * RG_UNITS_PER_B + k;
            rgcarry[(unit * 2 + dir) * 512 + ch] = h;
            h = Av[s1] * h + Hv[s1]; }
    }
}

constexpr int HG_RAWZ = 0, HG_RAWV = 16384, HG_RAWQ = 32768;
constexpr int HG_KHT = 49152, HG_VT = 67584;
constexpr int HG_QT = 86016, HG_KT = 103424;
constexpr int HG_AM = 120832;
constexpr int HG_DS = 130048, HG_QSUM = 130560, HG_PART = 134656;
constexpr int HG_RAWG = 136704;
constexpr int HG_OST = HG_QT;
constexpr int TS = 144, QS = 272;

struct HgRaw { u32x4 z[2], v[2], q[2], g[2]; };
template <bool FULL, bool GATE>
__device__ __forceinline__ void hg_load_raw(HgRaw& r, const bf16_t* __restrict__ proj, int row0, int hd, int dir, int tid) {
#pragma unroll
    for (int i = 0; i < 2; ++i) { const bf16_t* p = proj + (size_t)(row0 + (tid >> 4) + 32 * i) * NIN + hd * 128 + (tid & 15) * 8;
        r.z[i] = *(const u32x4*)(p + (dir == 0 ? 1536 : 2048)); r.v[i] = *(const u32x4*)(p + 2560); if (FULL) r.q[i] = *(const u32x4*)(p + 1024); if (GATE) r.g[i] = *(const u32x4*)(p + 3072); }
}
template <bool FULL, bool GATE>
__device__ __forceinline__ void hg_store_raw(LAS unsigned char* lds, const HgRaw& r, int tid) {
#pragma unroll
    for (int i = 0; i < 2; ++i) { const int off = ((tid >> 4) + 32 * i) * 256 + (tid & 15) * 16;
        *(LAS u32x4*)(lds + HG_RAWZ + off) = r.z[i]; *(LAS u32x4*)(lds + HG_RAWV + off) = r.v[i]; if (FULL) *(LAS u32x4*)(lds + HG_RAWQ + off) = r.q[i]; if (GATE) *(LAS u32x4*)(lds + HG_RAWG + off) = r.g[i]; }
}

template <int DIR, bool FULL, bool STORE_NEXT, bool NEXT_GATE>
__device__ __forceinline__ void hg_chunk(LAS unsigned char* lds, f32x4 (&accS)[8], f32x4 (&o)[4], float lb0, float lb1, float& dseg0, float& dseg1, const HgRaw& nxt, int tid, int wave, int lane) {
    const int cp = lane, tg = wave, fr = lane & 15, fq = lane >> 4;
    float c0[8], c1[8], k0[8], k1[8];
    {
        float p0 = 1.f, p1 = 1.f;
#pragma unroll
        for (int ii = 0; ii < 8; ++ii) { const int i = DIR == 0 ? ii : 7 - ii;
            const unsigned zz = *(const LAS unsigned*)(lds + HG_RAWZ + (8 * tg + i) * 256 + cp * 4);
            const float e0 = __expf(-bf_lo(zz)), e1 = __expf(-bf_hi(zz)); const float s0 = frcp(1.0f + e0), s1 = frcp(1.0f + e1);
            k0[i] = (1.0f - lb0) * e0 * s0; k1[i] = (1.0f - lb1) * e1 * s1;
            p0 *= lb0 + (1.0f - lb0) * s0; p1 *= lb1 + (1.0f - lb1) * s1; c0[i] = p0; c1[i] = p1; }
        *(LAS f32x2*)(lds + HG_QSUM + (tg * 128 + 2 * cp) * 4) = (f32x2){p0, p1};
    }
    lds_barrier();
    float pre0 = 1.f, pre1 = 1.f, tot0 = 1.f, tot1 = 1.f;
#pragma unroll
    for (int g = 0; g < 8; ++g) { const f32x2 v = *(const LAS f32x2*)(lds + HG_QSUM + (g * 128 + 2 * cp) * 4); tot0 *= v[0]; tot1 *= v[1]; if (DIR == 0 ? (g < tg) : (g > tg)) { pre0 *= v[0]; pre1 *= v[1]; } }
    {
        unsigned kh0[4], kh1[4], vt0[4], vt1[4];
#pragma unroll
        for (int i2 = 0; i2 < 4; ++i2) {
            const float Pa0 = pre0 * c0[2 * i2], Pb0 = pre0 * c0[2 * i2 + 1], Pa1 = pre1 * c1[2 * i2], Pb1 = pre1 * c1[2 * i2 + 1];
            const float ra0 = frcp(Pa0), rb0 = frcp(Pb0), ra1 = frcp(Pa1), rb1 = frcp(Pb1);
            const float kta0 = k0[2 * i2] * ra0, ktb0 = k0[2 * i2 + 1] * rb0, kta1 = k1[2 * i2] * ra1, ktb1 = k1[2 * i2 + 1] * rb1;
            kh0[i2] = cvt2(kta0 * tot0, ktb0 * tot0); kh1[i2] = cvt2(kta1 * tot1, ktb1 * tot1);
            const unsigned va = *(const LAS unsigned*)(lds + HG_RAWV + (8 * tg + 2 * i2) * 256 + cp * 4), vb = *(const LAS unsigned*)(lds + HG_RAWV + (8 * tg + 2 * i2 + 1) * 256 + cp * 4);
            vt0[i2] = __builtin_amdgcn_perm(vb, va, 0x05040100u); vt1[i2] = __builtin_amdgcn_perm(vb, va, 0x07060302u);
            if (FULL) {
                const unsigned qa = *(const LAS unsigned*)(lds + HG_RAWQ + (8 * tg + 2 * i2) * 256 + cp * 4), qb = *(const LAS unsigned*)(lds + HG_RAWQ + (8 * tg + 2 * i2 + 1) * 256 + cp * 4);
                *(LAS unsigned*)(lds + HG_QT + (8 * tg + 2 * i2) * QS + cp * 4) = cvt2(bf_lo(qa) * Pa0, bf_hi(qa) * Pa1);
                *(LAS unsigned*)(lds + HG_QT + (8 * tg + 2 * i2 + 1) * QS + cp * 4) = cvt2(bf_lo(qb) * Pb0, bf_hi(qb) * Pb1);
                *(LAS unsigned*)(lds + HG_KT + (8 * tg + 2 * i2) * QS + cp * 4) = cvt2(kta0, kta1);
                *(LAS unsigned*)(lds + HG_KT + (8 * tg + 2 * i2 + 1) * QS + cp * 4) = cvt2(ktb0, ktb1);
            }
        }
        *(LAS u32x4*)(lds + HG_KHT + (2 * cp) * TS + tg * 16) = (u32x4){kh0[0], kh0[1], kh0[2], kh0[3]}; *(LAS u32x4*)(lds + HG_KHT + (2 * cp + 1) * TS + tg * 16) = (u32x4){kh1[0], kh1[1], kh1[2], kh1[3]};
        *(LAS u32x4*)(lds + HG_VT + (2 * cp) * TS + tg * 16) = (u32x4){vt0[0], vt0[1], vt0[2], vt0[3]}; *(LAS u32x4*)(lds + HG_VT + (2 * cp + 1) * TS + tg * 16) = (u32x4){vt1[0], vt1[1], vt1[2], vt1[3]};
        if (tg == 0) { *(LAS f32x2*)(lds + HG_DS + 2 * cp * 4) = (f32x2){tot0, tot1}; dseg0 *= tot0; dseg1 *= tot1; }
    }
    lds_barrier();
    if (FULL) {
#pragma unroll
        for (int tt = 0; tt < 2; ++tt) {
            const int tl = 2 * wave + tt, ti = tl >> 2, si = tl & 3;
            f32x4 accA = (f32x4){0.f, 0.f, 0.f, 0.f};
#pragma unroll
            for (int ks = 0; ks < 4; ++ks) {
                const bf16x8 af = *(const LAS bf16x8*)(lds + HG_QT + (16 * ti + fr) * QS + (ks * 32 + fq * 8) * 2);
                const bf16x8 bf = *(const LAS bf16x8*)(lds + HG_KT + (16 * si + fr) * QS + (ks * 32 + fq * 8) * 2);
                accA = __builtin_amdgcn_mfma_f32_16x16x32_bf16(af, bf, accA, 0, 0, 0);
            }
#pragma unroll
            for (int j = 0; j < 4; ++j) { const int t = 16 * ti + 4 * fq + j, s = 16 * si + fr;
                const bool keep = DIR == 0 ? (s <= t) : (s >= t);
                *(LAS bf16_t*)(lds + HG_AM + t * TS + s * 2) = (bf16_t)(cvt2(keep ? accA[j] : 0.f, 0.f) & 0xffffu); }
        }
        lds_barrier();
#pragma unroll
        for (int m = 0; m < 4; ++m) o[m] = (f32x4){0.f, 0.f, 0.f, 0.f};
#pragma unroll
        for (int ks = 0; ks < 4; ++ks) {
            const u32x4 sw = (u32x4){cvt2(accS[2 * ks][0], accS[2 * ks][1]), cvt2(accS[2 * ks][2], accS[2 * ks][3]), cvt2(accS[2 * ks + 1][0], accS[2 * ks + 1][1]), cvt2(accS[2 * ks + 1][2], accS[2 * ks + 1][3])};
            const bf16x8 sf = mk_bf16x8(sw);
#pragma unroll
            for (int m = 0; m < 4; ++m) {
                const u32x2 qlo = *(const LAS u32x2*)(lds + HG_QT + (16 * m + fr) * QS + (32 * ks + 4 * fq) * 2), qhi = *(const LAS u32x2*)(lds + HG_QT + (16 * m + fr) * QS + (32 * ks + 16 + 4 * fq) * 2);
                const bf16x8 qf = mk_bf16x8((u32x4){qlo.x, qlo.y, qhi.x, qhi.y});
                o[m] = __builtin_amdgcn_mfma_f32_16x16x32_bf16(qf, sf, o[m], 0, 0, 0);
            }
        }
#pragma unroll
        for (int ks = 0; ks < 2; ++ks) {
            const bf16x8 vf = *(const LAS bf16x8*)(lds + HG_VT + (16 * wave + fr) * TS + (ks * 32 + fq * 8) * 2);
#pragma unroll
            for (int m = 0; m < 4; ++m) { const bf16x8 af = *(const LAS bf16x8*)(lds + HG_AM + (16 * m + fr) * TS + (ks * 32 + fq * 8) * 2);
                o[m] = __builtin_amdgcn_mfma_f32_16x16x32_bf16(af, vf, o[m], 0, 0, 0); }
        }
    }
#pragma unroll
    for (int i = 0; i < 8; ++i) { const f32x4 dv = *(const LAS f32x4*)(lds + HG_DS + (16 * i + 4 * fq) * 4); accS[i] = accS[i] * dv; }
#pragma unroll
    for (int ks = 0; ks < 2; ++ks) {
        const bf16x8 vf = *(const LAS bf16x8*)(lds + HG_VT + (16 * wave + fr) * TS + (ks * 32 + fq * 8) * 2);
#pragma unroll
        for (int i = 0; i < 8; ++i) { const bf16x8 af = *(const LAS bf16x8*)(lds + HG_KHT + (16 * i + fr) * TS + (ks * 32 + fq * 8) * 2);
            accS[i] = __builtin_amdgcn_mfma_f32_16x16x32_bf16(af, vf, accS[i], 0, 0, 0); }
    }
    if (STORE_NEXT) hg_store_raw<FULL, NEXT_GATE>(lds, nxt, tid);
}

__device__ __forceinline__ float hg_lb(const float* __restrict__ lb_logits, int dir, int col) {
    const float l0 = lb_logits[(0 * 2 + dir) * 512 + col], l1 = lb_logits[(1 * 2 + dir) * 512 + col];
    return 1.0f / (1.0f + expf(l1 - l0));
}

template <int DIR>
__device__ __forceinline__ void hg_agg_unit(LAS unsigned char* lds, const Args& a, int b, int hd, int sidx, int unit, int tid, int wave, int lane) {
    const bf16_t* __restrict__ proj = (const bf16_t*)(a.ws + WS_PROJ);
    const int rowbase = sidx == 0 ? T + b * LC : b * SEQ + (sidx - 1) * 256;
    const float lb0 = hg_lb(a.in[12], DIR, hd * 128 + 2 * lane), lb1 = hg_lb(a.in[12], DIR, hd * 128 + 2 * lane + 1);
    f32x4 accS[8], odummy[4];
#pragma unroll
    for (int i = 0; i < 8; ++i) accS[i] = (f32x4){0.f, 0.f, 0.f, 0.f};
    float dseg0 = 1.f, dseg1 = 1.f;
    HgRaw raw;
    hg_load_raw<false, false>(raw, proj, rowbase + (DIR == 0 ? 0 : 3) * 64, hd, DIR, tid);
    lds_barrier();
    hg_store_raw<false, false>(lds, raw, tid);
    lds_barrier();
#pragma unroll 1
    for (int cc = 0; cc < 3; ++cc) {
        hg_load_raw<false, false>(raw, proj, rowbase + (DIR == 0 ? cc + 1 : 2 - cc) * 64, hd, DIR, tid);
        hg_chunk<DIR, false, true, false>(lds, accS, odummy, lb0, lb1, dseg0, dseg1, raw, tid, wave, lane);
        lds_barrier();
    }
    hg_chunk<DIR, false, false, false>(lds, accS, odummy, lb0, lb1, dseg0, dseg1, raw, tid, wave, lane);
    float* K = (float*)(a.ws + WS_HGK) + (size_t)unit * 16384;
    const int fr = lane & 15, fq = lane >> 4;
#pragma unroll
    for (int i = 0; i < 8; ++i)
#pragma unroll
        for (int j = 0; j < 4; ++j) K[(16 * i + 4 * fq + j) * 128 + 16 * wave + fr] = accS[i][j];
    if (wave == 0) *(f32x2*)((float*)(a.ws + WS_HGD) + (size_t)unit * 128 + 2 * lane) = (f32x2){dseg0, dseg1};
}

__device__ __forceinline__ void hg_carry_item(const Args& a, int item, int tid, bool dry = false) {
    const int chain = item >> 3, part = item & 7, dir = chain & 1;
    float* K = (float*)(a.ws + WS_HGK) + (size_t)chain * HG_SEGS * 16384; const float* D = (const float*)(a.ws + WS_HGD) + (size_t)chain * HG_SEGS * 128;
    const int e4 = part * 512 + tid, dk = e4 >> 5;
    f32x4 kv[HG_SEGS]; float dv[HG_SEGS];
#pragma unroll
    for (int s = 0; s < HG_SEGS; ++s) { const int sidx = s == 0 ? 0 : (dir == 0 ? s : HG_SEGS - s); kv[s] = *(const f32x4*)(K + (size_t)sidx * 16384 + e4 * 4); dv[s] = D[sidx * 128 + dk]; }
    f32x4 S = (f32x4){0.f, 0.f, 0.f, 0.f};
#pragma unroll
    for (int s = 0; s < HG_SEGS; ++s) { const int sidx = s == 0 ? 0 : (dir == 0 ? s : HG_SEGS - s);
        if (dry) { const size_t o = ((size_t)(chain * HG_SEGS + sidx) * 16384 + e4 * 4) % (size_t)(32 * MiB); *(f32x4*)((float*)(a.ws + WS_MIXED) + o) = S; } else *(f32x4*)(K + (size_t)sidx * 16384 + e4 * 4) = S;
        S = S * dv[s] + kv[s]; }
}

__device__ __forceinline__ void hg_final_unit(LAS unsigned char* lds, const Args& a, int b, int hd, int seg, int tid, int wave, int lane) {
    const bf16_t* __restrict__ proj = (const bf16_t*)(a.ws + WS_PROJ); bf16_t* mixed = (bf16_t*)(a.ws + WS_MIXED);
    const int rowbase = b * SEQ + seg * 256, fr = lane & 15, fq = lane >> 4;
    const float lbf0 = hg_lb(a.in[12], 0, hd * 128 + 2 * lane), lbf1 = hg_lb(a.in[12], 0, hd * 128 + 2 * lane + 1);
    const float lbb0 = hg_lb(a.in[12], 1, hd * 128 + 2 * lane), lbb1 = hg_lb(a.in[12], 1, hd * 128 + 2 * lane + 1);
    const float ng = a.in[13][hd * 128 + 16 * wave + fr];
    f32x4 accS[8], o[4];
    float dseg0 = 1.f, dseg1 = 1.f;
    HgRaw raw;
    f32x4* ofst = (f32x4*)(a.ws + WS_OFST) + (size_t)blockIdx.x * 8192 + wave * 256 + lane;
    hg_load_raw<true, false>(raw, proj, rowbase, hd, 0, tid);
    {
        const float* Sin = (const float*)(a.ws + WS_HGK) + (size_t)((((b * 4 + hd) * 2 + 0) * HG_SEGS) + 1 + seg) * 16384;
#pragma unroll
        for (int i = 0; i < 8; ++i)
#pragma unroll
            for (int j = 0; j < 4; ++j) accS[i][j] = Sin[(16 * i + 4 * fq + j) * 128 + 16 * wave + fr];
    }
    lds_barrier();
    hg_store_raw<true, false>(lds, raw, tid);
    lds_barrier();
#pragma unroll 1
    for (int cc = 0; cc < 3; ++cc) {
        hg_load_raw<true, false>(raw, proj, rowbase + (cc + 1) * 64, hd, 0, tid);
        hg_chunk<0, true, true, false>(lds, accS, o, lbf0, lbf1, dseg0, dseg1, raw, tid, wave, lane);
#pragma unroll
        for (int m = 0; m < 4; ++m) ofst[cc * 2048 + m * 64] = o[m];
        lds_barrier();
    }
    hg_load_raw<true, true>(raw, proj, rowbase + 3 * 64, hd, 1, tid);
    hg_chunk<0, true, true, true>(lds, accS, o, lbf0, lbf1, dseg0, dseg1, raw, tid, wave, lane);
#pragma unroll
    for (int m = 0; m < 4; ++m) ofst[3 * 2048 + m * 64] = o[m];
    {
        const float* Sin = (const float*)(a.ws + WS_HGK) + (size_t)((((b * 4 + hd) * 2 + 1) * HG_SEGS) + 1 + seg) * 16384;
#pragma unroll
        for (int i = 0; i < 8; ++i)
#pragma unroll
            for (int j = 0; j < 4; ++j) accS[i][j] = Sin[(16 * i + 4 * fq + j) * 128 + 16 * wave + fr];
    }
    lds_barrier();
#pragma unroll 1
    for (int cc = 0; cc < 4; ++cc) {
        const int c = 3 - cc;
        float gate[4][4];
#pragma unroll
        for (int m = 0; m < 4; ++m)
#pragma unroll
            for (int j = 0; j < 4; ++j) gate[m][j] = bf2f(*(const LAS bf16_t*)(lds + HG_RAWG + (16 * m + 4 * fq + j) * 256 + (16 * wave + fr) * 2));
        if (cc < 3) hg_load_raw<true, true>(raw, proj, rowbase + (c - 1) * 64, hd, 1, tid);
        if (cc < 3) hg_chunk<1, true, true, true>(lds, accS, o, lbb0, lbb1, dseg0, dseg1, raw, tid, wave, lane);
        else hg_chunk<1, true, false, false>(lds, accS, o, lbb0, lbb1, dseg0, dseg1, raw, tid, wave, lane);
#pragma unroll
        for (int m = 0; m < 4; ++m) { o[m] = o[m] + ofst[c * 2048 + m * 64];
#pragma unroll
            for (int j = 0; j < 4; ++j) { float s = o[m][j] * o[m][j];
                s += __shfl_xor(s, 1); s += __shfl_xor(s, 2); s += __shfl_xor(s, 4); s += __shfl_xor(s, 8);
                if (fr == 0) *(LAS float*)(lds + HG_PART + ((16 * m + 4 * fq + j) * 8 + wave) * 4) = s; } }
        lds_barrier();
#pragma unroll
        for (int m = 0; m < 4; ++m)
#pragma unroll
            for (int j = 0; j < 4; ++j) { const int t = 16 * m + 4 * fq + j;
                const f32x4 p0 = *(const LAS f32x4*)(lds + HG_PART + t * 32), p1 = *(const LAS f32x4*)(lds + HG_PART + t * 32 + 16);
                const float ms = ((p0[0] + p0[1]) + (p0[2] + p0[3]) + (p1[0] + p1[1]) + (p1[2] + p1[3])) * (1.0f / 128.0f);
                *(LAS bf16_t*)(lds + HG_OST + t * QS + (16 * wave + fr) * 2) = (bf16_t)(cvt2(o[m][j] * __builtin_amdgcn_rsqf(ms + LN_EPS) * ng * gate[m][j], 0.f) & 0xffffu); }
        lds_barrier();
#pragma unroll
        for (int i = 0; i < 2; ++i) { const int t = (tid >> 4) + 32 * i, c8 = (tid & 15) * 8;
            *(u32x4*)(mixed + (size_t)(rowbase + c * 64 + t) * DM + 512 + hd * 128 + c8) = *(const LAS u32x4*)(lds + HG_OST + t * QS + c8 * 2); }
    }
}

__device__ __forceinline__ void p_scan_a(LAS unsigned char* lds, const Args& a, int bid, int G, int tid, int wave, int lane, int mask = 3) {
    constexpr int N_HG = NB * 4 * 2 * HG_SEGS, N_RG = NB * RG_UNITS_PER_B;
#pragma unroll 1
    for (int it = bid; it < N_HG + N_RG; it += G) {
        int t2 = tid; asm volatile("" : "+v"(t2)); const int tid = t2, lane = t2 & 63;
        if ((it < N_HG) ? !(mask & 1) : !(mask & 2)) continue;
        if (it < N_HG) { const int sidx = it % HG_SEGS, rest = it / HG_SEGS, dir = rest & 1, hd = (rest >> 1) & 3, b = rest >> 3;
            if (dir == 0) hg_agg_unit<0>(lds, a, b, hd, sidx, it, tid, wave, lane); else hg_agg_unit<1>(lds, a, b, hd, sidx, it, tid, wave, lane); }
        else { const int r = it - N_HG; __syncthreads(); rg_agg_unit(lds, a, r / RG_UNITS_PER_B, r % RG_UNITS_PER_B, tid, wave, lane); }
    }
}
__device__ __forceinline__ void p_scan_b(const Args& a, int bid, int G, int tid, bool dry = false) {
#pragma unroll 1
    for (int it = bid; it < 1024; it += G) hg_carry_item(a, it, tid, dry);
    if (bid >= G - 32) rg_carry_item(a, bid - (G - 32), tid);
}
__device__ __forceinline__ void p_scan_c(LAS unsigned char* lds, const Args& a, int bid, int G, int tid, int wave, int lane, int mask = 3) {
#pragma unroll 1
    for (int it = bid; it < ((mask & 1) ? 1024 : 0); it += G) { const int seg = it & 15, hd = (it >> 4) & 3, b = it >> 6; int t2 = tid; asm volatile("" : "+v"(t2)); hg_final_unit(lds, a, b, hd, seg, t2, wave, t2 & 63); }
#pragma unroll 1
    for (int r = bid; r < ((mask & 2) ? 1024 : 0); r += G) { __syncthreads(); int t2 = tid; asm volatile("" : "+v"(t2)); rg_final_unit(lds, a, r >> 6, r & 63, t2, wave, t2 & 63); }
}

#define GAS __attribute__((address_space(1)))
#define RLX_AGENT __ATOMIC_RELAXED, __HIP_MEMORY_SCOPE_AGENT
#define XB_TMO      128
#define XB_XCNT(j)  (256  + 64 * (j))
#define XB_XSUB(j)  (1280 + 64 * (j))
#define XB_XGEN(j)  (2304 + 64 * (j))
#define XB_TOP      3328
#define XB_TOPGEN   3392
#define XCD_BAR_WORDS 3456
#define XB_SPIN_CAP (1u << 18)

__device__ __forceinline__ unsigned xb_ld(unsigned* p)              { return __hip_atomic_load(p, __ATOMIC_RELAXED, __HIP_MEMORY_SCOPE_AGENT); }
__device__ __forceinline__ unsigned xb_add(unsigned* p, unsigned v) { return __hip_atomic_fetch_add(p, v, __ATOMIC_RELAXED, __HIP_MEMORY_SCOPE_AGENT); }
__device__ __forceinline__ unsigned xb_xcc_id() { return (unsigned)__builtin_amdgcn_s_getreg((3 << 11) | 20) & 0xFu; }
#define XB_SPIN(cond, bar) do { unsigned _sp = 0; while (cond) { __builtin_amdgcn_s_sleep(1); \
    if ((++_sp & 255u) == 0u) { if (xb_ld(&(bar)[XB_TMO])) break; if (_sp > XB_SPIN_CAP) { atomicAdd(&(bar)[XB_TMO], 1u); break; } } } } while (0)

struct XcdBarrier {
    unsigned* bar; unsigned x;
    volatile LAS unsigned* st;
};

__device__ __forceinline__ XcdBarrier xcd_barrier_post(unsigned* bar, volatile LAS unsigned* st) {
    XcdBarrier b; b.bar = bar; b.x = xb_xcc_id(); b.st = st;
    if (threadIdx.x == 0) (void)xb_add(&bar[XB_XCNT(b.x)], 1u);
    return b;
}
__device__ __forceinline__ void xcd_barrier_complete(unsigned* bar, unsigned x, unsigned& nloc, unsigned& nx) {
    const unsigned G = gridDim.x * gridDim.y * gridDim.z;
    unsigned sum, cnt, mine, sp = 0u;
    for (;;) {
        sum = 0u; cnt = 0u; mine = 0u;
#pragma unroll
        for (unsigned j = 0; j < 16; ++j) { const unsigned c = xb_ld(&bar[XB_XCNT(j)]); sum += c; cnt += (c > 0u) ? 1u : 0u; mine = (j == x) ? c : mine; }
        if (sum == G) break;
        __builtin_amdgcn_s_sleep(1);
        if ((++sp & 255u) == 0u) { if (xb_ld(&bar[XB_TMO])) break; if (sp > XB_SPIN_CAP) { atomicAdd(&bar[XB_TMO], 1u); break; } }
    }
    nloc = mine > 0u ? mine : 1u; nx = cnt > 0u ? cnt : 1u;
}

__device__ __forceinline__ void xcd_barrier(const XcdBarrier& b) {
    asm volatile("s_waitcnt vmcnt(0)" ::: "memory");
    __syncthreads();
    if (threadIdx.x == 0) {
        unsigned* bar = b.bar;
        __builtin_amdgcn_s_waitcnt(0);
        unsigned nloc = b.st[0], nx = b.st[1];
        if (nloc == 0u) { xcd_barrier_complete(bar, b.x, nloc, nx); b.st[0] = nloc; b.st[1] = nx; }
        const unsigned old = xb_add(&bar[XB_XSUB(b.x)], 1u);
        const unsigned gen = old / nloc;
        if (old + 1u == (gen + 1u) * nloc) {
            __builtin_amdgcn_fence(__ATOMIC_RELEASE, "agent");
            asm volatile("s_waitcnt vmcnt(0)" ::: "memory");
            const unsigned og = xb_add(&bar[XB_TOP], 1u);
            const unsigned tg = og / nx;
            if (og + 1u == (tg + 1u) * nx) xb_add(&bar[XB_TOPGEN], 1u);
            else XB_SPIN(xb_ld(&bar[XB_TOPGEN]) == tg, bar);
            __builtin_amdgcn_fence(__ATOMIC_ACQUIRE, "agent");
            xb_add(&bar[XB_XGEN(b.x)], 1u);
            asm volatile("s_waitcnt vmcnt(0)" ::: "memory");
        } else {
            XB_SPIN(xb_ld(&bar[XB_XGEN(b.x)]) == gen, bar);
            __builtin_amdgcn_fence(__ATOMIC_ACQUIRE, "agent");
            asm volatile("s_waitcnt vmcnt(0)" ::: "memory");
        }
    }
    __syncthreads();
}


__global__ void __launch_bounds__(NTHREADS, 2) mega(Args a) {
    extern __shared__ __attribute__((aligned(16))) unsigned char lds_raw[];
    LAS unsigned char* lds = (LAS unsigned char*)lds_raw;
    cg::grid_group grid = cg::this_grid();
    const int wave = __builtin_amdgcn_readfirstlane(threadIdx.x >> 6), bid = blockIdx.x, G = gridDim.x;
    int tid = threadIdx.x, lane = tid & 63;
#define FRESH_TID() do { tid = threadIdx.x; asm volatile("" : "+v"(tid)); lane = tid & 63; } while (0)
    unsigned char* ws = a.ws;
    volatile LAS unsigned* bst = (volatile LAS unsigned*)(lds + LDS_BYTES - 64);
    if (threadIdx.x < 2) bst[threadIdx.x] = 0u;
    __syncthreads();
    XcdBarrier xbar = xcd_barrier_post((unsigned*)(ws + WS_BAR), bst);
#define GRID_BAR() xcd_barrier(xbar)
    float* mod = (float*)(ws + WS_MOD);
    bf16_t* U = (bf16_t*)(ws + WS_U);
    bf16_t* PROJ = (bf16_t*)(ws + WS_PROJ); bf16_t* MIXED = (bf16_t*)(ws + WS_MIXED);

#ifndef SKIP_P0
    p_mod(lds, a.in[1], a.in[3], a.in[4], a.in[5], mod, bid, G, tid);
    p_transposes(lds, a, bid, G, tid);
    p_gwt(a.in[9], (bf16_t*)(ws + WS_GWT), bid, G, tid);
    p_rgpar(a.in[10], a.in[11], (float*)(ws + WS_RGPAR), bid, G, tid);
#endif
#ifdef REP_P0
    grid.sync();
    FRESH_TID();
    p_mod(lds, a.in[1], a.in[3], a.in[4], a.in[5], mod, bid, G, tid);
    p_transposes(lds, a, bid, G, tid);
    p_gwt(a.in[9], (bf16_t*)(ws + WS_GWT), bid, G, tid);
    p_rgpar(a.in[10], a.in[11], (float*)(ws + WS_RGPAR), bid, G, tid);
#endif
    GRID_BAR();
    FRESH_TID();
#ifdef REP_SYNC
    for (int r = 0; r < 10; ++r) GRID_BAR();
#endif
#ifndef SKIP_P1
    p_u(a.in[0], a.in[2], mod, U, bid, G, tid);
#endif
#ifdef REP_P1
    GRID_BAR();
    FRESH_TID();
    p_u(a.in[0], a.in[2], mod, U, bid, G, tid);
#endif
    GRID_BAR();
    FRESH_TID();
#ifndef SKIP_P2
    { pg8::Gemm g{U, (const bf16_t*)(ws + WS_WINT), TA, NIN, DM}; pg8::StaticOrder S; S.init(TA, NIN, G, bid);
      pg8::EpiInProj E{PROJ};
      pg8::gemm_phase<pg8::EpiInProj, pg8::StaticOrder, true, true>(lds, g, S, E); }
#endif
#ifdef REP_P2
    GRID_BAR();
    FRESH_TID();
    { pg8::Gemm g{U, (const bf16_t*)(ws + WS_WINT), TA, NIN, DM}; pg8::StaticOrder S; S.init(TA, NIN, G, bid);
      pg8::EpiInProj E{PROJ};
      pg8::gemm_phase<pg8::EpiInProj, pg8::StaticOrder, true, true>(lds, g, S, E); }
#endif
    GRID_BAR();
    FRESH_TID();
#ifndef SKIP_P3A
    p_scan_a(lds, a, bid, G, tid, wave, lane);
#endif
#ifdef REP_P3A
    GRID_BAR();
    FRESH_TID();
    p_scan_a(lds, a, bid, G, tid, wave, lane, REP_P3A);
#endif
    GRID_BAR();
    FRESH_TID();
#ifdef REP_P3B
    p_scan_b(a, bid, G, tid, true);
    GRID_BAR();
    FRESH_TID();
#endif
#ifndef SKIP_P3B
    p_scan_b(a, bid, G, tid);
#endif
    GRID_BAR();
    FRESH_TID();
#ifndef SKIP_P3C
    p_scan_c(lds, a, bid, G, tid, wave, lane);
#endif
#ifdef REP_P3C
    GRID_BAR();
    FRESH_TID();
    p_scan_c(lds, a, bid, G, tid, wave, lane, REP_P3C);
#endif
    GRID_BAR();
    FRESH_TID();
#ifndef SKIP_P5
    { pg8::Gemm g{MIXED, (const bf16_t*)(ws + WS_WOUTT), T, DM, DM}; pg8::StaticOrder S; S.init(T, DM, G, bid);
      pg8::EpiY E{(bf16_t*)(ws + WS_XG)};
      pg8::gemm_phase<pg8::EpiY, pg8::StaticOrder, true, true>(lds, g, S, E); }
#endif
#ifdef REP_P5
    GRID_BAR();
    FRESH_TID();
    { pg8::Gemm g{MIXED, (const bf16_t*)(ws + WS_WOUTT), T, DM, DM}; pg8::StaticOrder S; S.init(T, DM, G, bid);
      pg8::EpiY E{(bf16_t*)(ws + WS_XG)};
      pg8::gemm_phase<pg8::EpiY, pg8::StaticOrder, true, true>(lds, g, S, E); }
#endif
    GRID_BAR();
    FRESH_TID();
#ifdef REP_P6
#pragma unroll 1
    for (int rep = 0; rep < 2; ++rep) { p_ln1_router(lds, a, bid, G, tid, wave, lane, rep == 0); if (rep == 0) GRID_BAR(); }
#else
    p_ln1_router(lds, a, bid, G, tid, wave, lane);
#endif
    GRID_BAR();
    FRESH_TID();
#ifndef SKIP_P7
    p_assign(lds, a, bid, G, tid);
#endif
#ifdef REP_P7
    GRID_BAR();
    FRESH_TID();
    p_assign(lds, a, bid, G, tid);
#endif
    GRID_BAR();
    FRESH_TID();
#ifndef SKIP_P8
    { pg8::Gemm g{(const bf16_t*)(ws + WS_U), (const bf16_t*)(ws + WS_W13T), MAXROWS, NE * DM, DM}; pg8::ExpertOrderG S{(const int*)(ws + WS_CTL), (const int*)(ws + WS_ROWTOK), G, bid};
      pg8::EpiExp1 E{(bf16_t*)(ws + WS_HID)};
      pg8::gemm_phase<pg8::EpiExp1, pg8::ExpertOrderG, true, true>(lds, g, S, E); }
#endif
#ifdef REP_P8
    GRID_BAR();
    FRESH_TID();
    { pg8::Gemm g{(const bf16_t*)(ws + WS_U), (const bf16_t*)(ws + WS_W13T), MAXROWS, NE * DM, DM}; pg8::ExpertOrderG S{(const int*)(ws + WS_CTL), (const int*)(ws + WS_ROWTOK), G, bid};
      pg8::EpiExp1 E{(bf16_t*)(ws + WS_HID)};
      pg8::gemm_phase<pg8::EpiExp1, pg8::ExpertOrderG, true, true>(lds, g, S, E); }
#endif
    GRID_BAR();
    FRESH_TID();
#ifndef SKIP_P9
    { pg8::Gemm g{(const bf16_t*)(ws + WS_HID), (const bf16_t*)(ws + WS_W2T), MAXROWS, NE * DM, DE}; pg8::ExpertOrder S{(const int*)(ws + WS_CTL), nullptr, G, bid};
      pg8::EpiY E{(bf16_t*)(ws + WS_Y)};
      pg8::gemm_phase<pg8::EpiY, pg8::ExpertOrder, true, true>(lds, g, S, E); }
#endif
#ifdef REP_P9
    GRID_BAR();
    FRESH_TID();
    { pg8::Gemm g{(const bf16_t*)(ws + WS_HID), (const bf16_t*)(ws + WS_W2T), MAXROWS, NE * DM, DE}; pg8::ExpertOrder S{(const int*)(ws + WS_CTL), nullptr, G, bid};
      pg8::EpiY E{(bf16_t*)(ws + WS_Y)};
      pg8::gemm_phase<pg8::EpiY, pg8::ExpertOrder, true, true>(lds, g, S, E); }
#endif
    GRID_BAR();
    FRESH_TID();
#ifdef REP_P10
    p_combine_ln2(a, bid, G, wave, lane, true);
    GRID_BAR();
    FRESH_TID();
#endif
#ifndef SKIP_P10
    p_combine_ln2(a, bid, G, wave, lane);
#endif
}

extern "C" void kernel_launch(void* const* d_in, const int* in_sizes, int n_in, void* d_out, int out_size, void* d_ws, size_t ws_size, hipStream_t stream) {
    static int grid = 0;
    if (grid == 0) {
        if (n_in != 26 || ws_size < WS_END) { fprintf(stderr, "kernel_launch: unexpected n_in %d or workspace %zu < %zu\n", n_in, ws_size, (size_t)WS_END); grid = -1; return; }
        int dev = 0, cus = 0, per_cu = 0;
        if (hipGetDevice(&dev) != hipSuccess || hipDeviceGetAttribute(&cus, hipDeviceAttributeMultiprocessorCount, dev) != hipSuccess) { grid = -1; return; }
        if (hipFuncSetAttribute((const void*)mega, hipFuncAttributeMaxDynamicSharedMemorySize, LDS_BYTES) != hipSuccess) { fprintf(stderr, "kernel_launch: hipFuncSetAttribute failed\n"); grid = -1; return; }
        if (hipOccupancyMaxActiveBlocksPerMultiprocessor(&per_cu, (const void*)mega, NTHREADS, LDS_BYTES) != hipSuccess || per_cu < 1) { fprintf(stderr, "kernel_launch: occupancy query says %d\n", per_cu); per_cu = 1; }
        (void)hipGetLastError();
        grid = cus;
        fprintf(stderr, "kernel_launch: grid %d (cus %d, per_cu %d), ws %zu\n", grid, cus, per_cu, ws_size);
    }
    if (grid < 0) return;
    (void)hipMemsetAsync(d_ws, 0, 131072, stream);
    Args a{};
    for (int i = 0; i < 26; ++i) a.in[i] = (const float*)d_in[i];
    a.out = (float*)d_out; a.ws = (unsigned char*)d_ws;
    void* params[] = {&a};
    hipError_t e = hipLaunchCooperativeKernel((const void*)mega, dim3(grid), dim3(NTHREADS), params, LDS_BYTES, stream);
    if (e != hipSuccess) fprintf(stderr, "kernel_launch: cooperative launch failed: %s (grid %d)\n", hipGetErrorString(e), grid);
}
```

```cpp
#include <hip/hip_runtime.h>
#include <hip/hip_cooperative_groups.h>
#include <cstdio>
#include <cstdint>
namespace cg = cooperative_groups;

typedef unsigned short bf16_t;
typedef short bf16x8 __attribute__((ext_vector_type(8)));
typedef float f32x4 __attribute__((ext_vector_type(4)));
typedef float f32x2 __attribute__((ext_vector_type(2)));
typedef unsigned u32x4 __attribute__((ext_vector_type(4)));
typedef unsigned u32x2 __attribute__((ext_vector_type(2)));
typedef int i32x4 __attribute__((ext_vector_type(4)));
#define LAS __attribute__((address_space(3)))

constexpr int NB = 16, SEQ = 4096, LC = 256, DM = 1024;
constexpr int T = NB * SEQ;
constexpr int TC = NB * LC;
constexpr int TA = T + TC;
constexpr int NIN = 3584;
constexpr int NE = 32, DE = 512;
constexpr int MAXROWS = 2 * T + NE * 256;
constexpr float ALPHA = 1.189207115002721f;
constexpr float LN_EPS = 1e-6f;
constexpr int NTHREADS = 512;

constexpr size_t MiB = 1u << 20;
constexpr size_t WS_CTL = 0;
constexpr size_t WS_BAR = 65536;
constexpr size_t WS_MOD = 1 * MiB;
constexpr size_t WS_EIDX = 3 * MiB;
constexpr size_t WS_EPOS = 3 * MiB + 512 * 1024;
constexpr size_t WS_EW = 4 * MiB;
constexpr size_t WS_DEST = 4 * MiB + 512 * 1024;
constexpr size_t WS_WINT = 6 * MiB;
constexpr size_t WS_WOUTT = 13 * MiB;
constexpr size_t WS_W13T = 15 * MiB;
constexpr size_t WS_W2T = 79 * MiB;
constexpr size_t WS_U = 112 * MiB;
constexpr size_t WS_PROJ = 248 * MiB;
constexpr size_t WS_XG = 248 * MiB;
constexpr size_t WS_HID = 520 * MiB;
constexpr size_t WS_Y = 656 * MiB;
constexpr size_t WS_MIXED = 724 * MiB;
constexpr size_t WS_OSUM = 852 * MiB;
constexpr size_t WS_END = 980 * MiB;
constexpr int LDS_BYTES = 163840;

__device__ __forceinline__ const bf16_t* proj_at(const bf16_t* P, int row, int col) { return P + (((size_t)(col >> 5) * TA + row) << 5) + (col & 31); }

__device__ __forceinline__ float bf2f(bf16_t b) { return __uint_as_float(((unsigned)b) << 16); }
__device__ __forceinline__ bf16_t f2bf(float f) { unsigned u = __float_as_uint(f); return (bf16_t)((u + 0x7fffu + ((u >> 16) & 1u)) >> 16); }
__device__ __forceinline__ unsigned pk2(float lo, float hi) { return (unsigned)f2bf(lo) | ((unsigned)f2bf(hi) << 16); }
__device__ __forceinline__ float frcp(float x) { return __builtin_amdgcn_rcpf(x); }
__device__ __forceinline__ float sigmoidf_(float x) { return frcp(1.0f + __expf(-x)); }
__device__ __forceinline__ float siluf_(float x) { return x * frcp(1.0f + __expf(-x)); }
__device__ __forceinline__ float gelu_tanh(float x) {
    const float y = 0.7978845608028654f * (x + 0.044715f * x * x * x);
    return x * frcp(1.0f + __expf(-2.0f * y));
}
__device__ __forceinline__ float softplusf_(float x) { return fmaxf(x, 0.f) + log1pf(expf(-fabsf(x))); }
__device__ __forceinline__ float wave_sum(float v) {
#pragma unroll
    for (int o = 1; o < 64; o <<= 1) v += __shfl_xor(v, o);
    return v;
}
constexpr int CSTR = 64;
__device__ __forceinline__ int pstart_of(const int* __restrict__ counts, int e) {
    int acc = 0;
    for (int i = 0; i < NE; ++i) { const int p = ((counts[i * CSTR] + 255) >> 8) << 8; if (i < e) acc += p; }
    return acc;
}

namespace pg8 {
#define PG8_LAS __attribute__((address_space(3)))
typedef unsigned short bf16_t;
typedef short bf16x8 __attribute__((ext_vector_type(8)));
typedef float f32x4 __attribute__((ext_vector_type(4)));
typedef unsigned u32x4 __attribute__((ext_vector_type(4)));
constexpr int BM = 256, BK = 64, HALF = 128, HTB = HALF * BK * 2  , STAGE_BYTES = 8 * HTB, NXCD = 8, WGM = 8;

__host__ __device__ __forceinline__ int lds_byte(int r, int c) { const int st = (r >> 4) * 2 + (c >> 5), rr = r & 15, cc = c & 31, ob = rr * 64 + cc * 2; return st * 1024 + (ob ^ (((ob >> 9) & 1) << 5)); }
__host__ __device__ __forceinline__ void stage_rc(int b, int& R, int& C) { const int st = b / 1024, sb = b % 1024, swz = sb ^ (((sb >> 9) & 1) << 5); R = (st >> 1) * 16 + swz / 64; C = (st & 1) * 32 + (swz % 64) / 2; }
__host__ __device__ __forceinline__ int perm32(int rho) { const int n = rho >> 4, i = rho & 15; return 8 * (i >> 2) + 4 * n + (i & 3); }

struct Unit { int pm, pn; };
struct Gemm { const bf16_t* A; const bf16_t* Bt; int M, N, K; };

struct StaticOrder {
    static constexpr bool GATHER = false; const int* rowtok = nullptr;
    int nM, nN, nwg, G, c;
    __host__ __device__ void init(int M, int N, int G_, int c_) { nM = M / BM; nN = N / BM; nwg = nM * nN; G = G_; c = c_; }
    __host__ __device__ bool next(int i, Unit& u) const {
        const long L = (long)i * G + c; if (L >= nwg) return false;
        int wgid = (int)L; { const int q = nwg / NXCD, r = nwg % NXCD, xcd = wgid % NXCD, off = wgid / NXCD; wgid = (xcd < r ? xcd * (q + 1) : r * (q + 1) + (xcd - r) * q) + off; }
        const int nig = WGM * nN, gid = wgid / nig, fm = gid * WGM, gsz = (nM - fm) < WGM ? (nM - fm) : WGM;
        u.pm = fm + ((wgid % nig) % gsz); u.pn = (wgid % nig) / gsz; return true;
    }
    __device__ __forceinline__ void a_ready(const Unit&) const {}
    __device__ __forceinline__ void done(const Unit&) const {}
};

__device__ __forceinline__ unsigned cvt_pk_bf16(float lo, float hi) { unsigned r; asm volatile("v_cvt_pk_bf16_f32 %0, %1, %2" : "=v"(r) : "v"(lo), "v"(hi)); return r; }

struct EpiInProj {
    static constexpr bool PERM = true, AFTER_DRAIN = false;
    bf16_t* P; int variant; int pad;
    __device__ __forceinline__ void operator()(const f32x4 (&acc)[2][2][4][2], const Unit& u, int wr, int wc, int fr_, int fq_) const {
        int fr = fr_, fq = fq_; asm volatile("" : "+v"(fr), "+v"(fq));
        const int row0 = u.pm * BM + wr * 64 + fr, col0 = u.pn * BM + wc * 32 + 8 * fq, grp = variant == 1 ? 0 : (u.pn >> 1);
#pragma unroll
        for (int ai = 0; ai < 2; ++ai)
#pragma unroll
            for (int m = 0; m < 4; ++m) { bf16_t* rowp = P + (((size_t)(8 * u.pn + wc) * TA + (row0 + ai * HALF + m * 16)) << 5) + 8 * fq;
#pragma unroll
                for (int bj = 0; bj < 2; ++bj) { f32x4 v0 = acc[ai][bj][m][0], v1 = acc[ai][bj][m][1];
                    if (grp == 1) {
#pragma unroll
                        for (int j = 0; j < 4; ++j) { v0[j] = gelu_tanh(v0[j]); v1[j] = gelu_tanh(v1[j]); } }
                    else if (grp == 2 || grp == 6) {
#pragma unroll
                        for (int j = 0; j < 4; ++j) { v0[j] = siluf_(v0[j]); v1[j] = siluf_(v1[j]); } }
                    u32x4 w; w.x = cvt_pk_bf16(v0[0], v0[1]); w.y = cvt_pk_bf16(v0[2], v0[3]); w.z = cvt_pk_bf16(v1[0], v1[1]); w.w = cvt_pk_bf16(v1[2], v1[3]);
                    if (variant == 3) { const int wv = __builtin_amdgcn_readfirstlane(threadIdx.x >> 6); *(u32x4*)(P + ((size_t)((u.pm * 14 + u.pn) * 8 + wv) * 16 + (ai * 4 + m) * 2 + bj) * 512 + (threadIdx.x & 63) * 8) = w; }
                    else if (variant != 2 || w.x == 0x12345678u) *(u32x4*)(rowp + (size_t)bj * 4 * TA * 32) = w; } }
    }
};
struct EpiNull {
    static constexpr bool PERM = true, AFTER_DRAIN = false;
    float* sink;
    __device__ __forceinline__ void operator()(const f32x4 (&acc)[2][2][4][2], const Unit& u, int wr, int wc, int fr_, int fq_) const {
        float s = 0.f;
#pragma unroll
        for (int ai = 0; ai < 2; ++ai)
#pragma unroll
            for (int bj = 0; bj < 2; ++bj)
#pragma unroll
                for (int m = 0; m < 4; ++m)
#pragma unroll
                    for (int n = 0; n < 2; ++n) s += acc[ai][bj][m][n][0] + acc[ai][bj][m][n][1] + acc[ai][bj][m][n][2] + acc[ai][bj][m][n][3];
        if (s == 123.456f) sink[0] = s;
    }
};
struct EpiF32 {
    static constexpr bool PERM = false, AFTER_DRAIN = false;
    float* C; int ldc; int pad;
    __device__ __forceinline__ void operator()(const f32x4 (&acc)[2][2][4][2], const Unit& u, int wr, int wc, int fr_, int fq_) const {
        int fr = fr_, fq = fq_; asm volatile("" : "+v"(fr), "+v"(fq));
        const int row0 = u.pm * BM + wr * 64 + fr, col0 = u.pn * BM + wc * 32 + 4 * fq;
#pragma unroll
        for (int ai = 0; ai < 2; ++ai)
#pragma unroll
            for (int m = 0; m < 4; ++m) { float* rowp = C + (size_t)(row0 + ai * HALF + m * 16) * ldc + col0;
#pragma unroll
                for (int bj = 0; bj < 2; ++bj)
#pragma unroll
                    for (int n = 0; n < 2; ++n) *(f32x4*)(rowp + bj * HALF + n * 16) = acc[ai][bj][m][n]; }
    }
};
struct EpiExp1 {
    static constexpr bool PERM = false, AFTER_DRAIN = false;
    bf16_t* H;
    __device__ __forceinline__ void operator()(const f32x4 (&acc)[2][2][4][2], const Unit& u, int wr, int wc, int fr_, int fq_) const {
        int fr = fr_, fq = fq_; asm volatile("" : "+v"(fr), "+v"(fq));
        const int row0 = u.pm * BM + wr * 64 + fr, hc0 = (((u.pn & 3) * BM + wc * 32) >> 1) + 4 * fq;
#pragma unroll
        for (int ai = 0; ai < 2; ++ai)
#pragma unroll
            for (int m = 0; m < 4; ++m) { bf16_t* rowp = H + (size_t)(row0 + ai * HALF + m * 16) * DE + hc0;
#pragma unroll
                for (int bj = 0; bj < 2; ++bj) { const f32x4 a = acc[ai][bj][m][0], b = acc[ai][bj][m][1];
                    u32x2 w; w.x = cvt_pk_bf16(siluf_(a[0]) * b[0], siluf_(a[1]) * b[1]); w.y = cvt_pk_bf16(siluf_(a[2]) * b[2], siluf_(a[3]) * b[3]);
                    *(u32x2*)(rowp + bj * 64) = w; } }
    }
};
struct EpiY {
    static constexpr bool PERM = true, AFTER_DRAIN = false;
    bf16_t* Y;
    __device__ __forceinline__ void operator()(const f32x4 (&acc)[2][2][4][2], const Unit& u, int wr, int wc, int fr_, int fq_) const {
        int fr = fr_, fq = fq_; asm volatile("" : "+v"(fr), "+v"(fq));
        const int row0 = u.pm * BM + wr * 64 + fr, col0 = (u.pn & 3) * BM + wc * 32 + 8 * fq;
#pragma unroll
        for (int ai = 0; ai < 2; ++ai)
#pragma unroll
            for (int m = 0; m < 4; ++m) { bf16_t* rowp = Y + (size_t)(row0 + ai * HALF + m * 16) * DM + col0;
#pragma unroll
                for (int bj = 0; bj < 2; ++bj) { const f32x4 v0 = acc[ai][bj][m][0], v1 = acc[ai][bj][m][1];
                    u32x4 w; w.x = cvt_pk_bf16(v0[0], v0[1]); w.y = cvt_pk_bf16(v0[2], v0[3]); w.z = cvt_pk_bf16(v1[0], v1[1]); w.w = cvt_pk_bf16(v1[2], v1[3]);
                    *(u32x4*)(rowp + bj * HALF) = w; } }
    }
};
template <bool GATHER_>
struct ExpertOrderT {
    static constexpr bool GATHER = GATHER_;
    const int* counts; const int* rowtok; int G, c;
    __device__ __forceinline__ bool next(int i, Unit& u) const {
        const int L = i * G + c, rb = L >> 2; int acc = 0, ef = -1;
        for (int e = 0; e < NE; ++e) { const int nb = (counts[e * CSTR] + 255) >> 8; if (rb >= acc && rb < acc + nb) ef = e; acc += nb; }
        if (ef < 0) return false;
        u.pm = rb; u.pn = ef * 4 + (L & 3); return true;
    }
    __device__ __forceinline__ void a_ready(const Unit&) const {}
    __device__ __forceinline__ void done(const Unit&) const {}
};
typedef ExpertOrderT<false> ExpertOrder;
typedef ExpertOrderT<true> ExpertOrderG;

template <class Epi, class Sched, bool ALIGN_EPI = false, bool SP2 = false>
__device__ __forceinline__ void gemm_phase(PG8_LAS unsigned char* lds, const Gemm g, const Sched& S, const Epi& E) {
    int tid_o = threadIdx.x; asm volatile("" : "+v"(tid_o));
    const int tid = tid_o, wid = __builtin_amdgcn_readfirstlane(tid >> 6), lane = tid & 63, wr = wid >> 2, wc = wid & 3, fr = lane & 15, fq = lane >> 4;
    static_assert(SP2 || !Sched::GATHER, "the gathered A operand is wired into the SP2 loop only");
    const int K = g.K, nt = K / BK;
    unsigned voffA[2], voffB[2];
    unsigned gAc[2][2], gAn[2][2]; int gR[2], gC[2];
#pragma unroll
    for (int i = 0; i < 2; ++i) { int R, C; stage_rc(tid * 16 + i * 8192, R, C); const int Rb = Epi::PERM ? ((R & ~31) + perm32(R & 31)) : R;
        voffA[i] = (unsigned)(R * K + C) * 2u; voffB[i] = (unsigned)(Rb * K + C) * 2u; gR[i] = R; gC[i] = C; }
    const size_t kstep = (size_t)(BK * 2);
    const size_t hstep = (size_t)HALF * K * 2;
    const size_t tstep = 2 * hstep;
    const unsigned ldsw = (unsigned)wid * 1024u;
    const int aoff = lds_byte(wr * 64 + fr, fq * 8), boff = lds_byte(wc * 32 + fr, fq * 8);
#define PG8_SA(b, h) (((b) * 2 + (h)) * HTB)
#define PG8_SB(b, h) ((4 + (b) * 2 + (h)) * HTB)
#define PG8_STAGE(bufoff, gbase, voff) do { _Pragma("unroll") for (int _i = 0; _i < 2; ++_i) \
        __builtin_amdgcn_global_load_lds((const unsigned*)((const char*)(gbase) + (voff)[_i]), (PG8_LAS unsigned*)(lds + (bufoff) + ldsw + _i * 8192), 16, 0, 0); } while (0)
#define PG8_STAGE_A(bufoff, ptr, h, goff) do { if constexpr (Sched::GATHER) { PG8_STAGE(bufoff, ptr, (goff)[h]); } else { PG8_STAGE(bufoff, (ptr) + (h) * hstep, voffA); } } while (0)
#define PG8_GLOAD(dst, u) do { _Pragma("unroll") for (int _h = 0; _h < 2; ++_h) _Pragma("unroll") for (int _i = 0; _i < 2; ++_i) \
        dst[_h][_i] = (unsigned)S.rowtok[(u).pm * BM + _h * HALF + gR[_i]] * (unsigned)(K * 2) + (unsigned)(gC[_i] * 2); } while (0)
#define PG8_LDA(dst, b, h) do { _Pragma("unroll") for (int m = 0; m < 4; ++m) _Pragma("unroll") for (int k = 0; k < 2; ++k) dst[m][k] = *(const PG8_LAS bf16x8*)(lds + PG8_SA(b, h) + aoff + m * 2048 + k * 1024); } while (0)
#define PG8_LDB(dst, b, h) do { _Pragma("unroll") for (int n = 0; n < 2; ++n) _Pragma("unroll") for (int k = 0; k < 2; ++k) dst[n][k] = *(const PG8_LAS bf16x8*)(lds + PG8_SB(b, h) + boff + n * 2048 + k * 1024); } while (0)
#define PG8_MMA(ai, bj, At, Bt) do { __builtin_amdgcn_s_setprio(1); _Pragma("unroll") for (int m = 0; m < 4; ++m) _Pragma("unroll") for (int n = 0; n < 2; ++n) _Pragma("unroll") for (int k = 0; k < 2; ++k) \
        acc[ai][bj][m][n] = __builtin_amdgcn_mfma_f32_16x16x32_bf16(Bt[n][k], At[m][k], acc[ai][bj][m][n], 0, 0, 0); __builtin_amdgcn_s_setprio(0); } while (0)
#define PG8_WAIT_V(n) asm volatile("s_waitcnt vmcnt(" #n ")" ::: "memory")
#define PG8_WAIT_L(n) asm volatile("s_waitcnt lgkmcnt(" #n ")" ::: "memory")
#define PG8_BAR __builtin_amdgcn_s_barrier()
#define PG8_SCHED __builtin_amdgcn_sched_barrier(0)
    Unit cur, nxt; int ui = 0;
    if (!S.next(0, cur)) return;
    f32x4 acc[2][2][4][2];
#pragma unroll
    for (int a = 0; a < 2; ++a)
#pragma unroll
        for (int b = 0; b < 2; ++b)
#pragma unroll
            for (int m = 0; m < 4; ++m)
#pragma unroll
                for (int n = 0; n < 2; ++n) acc[a][b][m][n] = (f32x4){0.f, 0.f, 0.f, 0.f};
    bf16x8 At[4][2], B0[2][2], B1[2][2];
    const char* cA = (const char*)g.A + (Sched::GATHER ? (size_t)0 : (size_t)cur.pm * tstep); const char* cB = (const char*)g.Bt + (size_t)cur.pn * tstep;
    if constexpr (Sched::GATHER) { PG8_GLOAD(gAc, cur); }
    S.a_ready(cur);
    if constexpr (SP2) {
        PG8_STAGE(PG8_SB(0, 0), cB, voffB); PG8_STAGE(PG8_SB(0, 1), cB + hstep, voffB); PG8_STAGE_A(PG8_SA(0, 0), cA, 0, gAc); PG8_STAGE_A(PG8_SA(0, 1), cA, 1, gAc);
        if (wr == 1) PG8_BAR;
        PG8_WAIT_V(2); PG8_BAR;
        PG8_STAGE(PG8_SB(1, 0), cB + kstep, voffB); PG8_STAGE_A(PG8_SA(1, 0), cA + kstep, 0, gAc); PG8_STAGE(PG8_SB(1, 1), cB + hstep + kstep, voffB);
        PG8_WAIT_V(6); PG8_BAR;
    } else {
        PG8_STAGE(PG8_SB(0, 0), cB, voffB); PG8_STAGE(PG8_SA(0, 0), cA, voffA); PG8_STAGE(PG8_SB(0, 1), cB + hstep, voffB); PG8_STAGE(PG8_SA(0, 1), cA + hstep, voffA);
        if (wr == 1) PG8_BAR;
        PG8_WAIT_V(4); PG8_BAR;
        PG8_STAGE(PG8_SB(1, 0), cB + kstep, voffB); PG8_STAGE(PG8_SA(1, 0), cA + kstep, voffA); PG8_STAGE(PG8_SB(1, 1), cB + hstep + kstep, voffB);
        PG8_WAIT_V(6); PG8_BAR;
    }
    for (;;) {
        const bool has_next = S.next(ui + 1, nxt);
        const char* nA = (has_next && !Sched::GATHER) ? (const char*)g.A + (size_t)nxt.pm * tstep : cA;
        if constexpr (Sched::GATHER) { if (has_next) { PG8_GLOAD(gAn, nxt); } else { _Pragma("unroll") for (int _h = 0; _h < 2; ++_h) _Pragma("unroll") for (int _i = 0; _i < 2; ++_i) gAn[_h][_i] = gAc[_h][_i]; } }
        const char* nB = has_next ? (const char*)g.Bt + (size_t)nxt.pn * tstep : cB;
        for (int t = 0; t < nt; t += 2) {
            const bool last = (t == nt - 2);
            const char* a1 = cA + (size_t)(t + 1) * kstep;
            const char* a2 = last ? nA : cA + (size_t)(t + 2) * kstep; const char* b2 = last ? nB : cB + (size_t)(t + 2) * kstep;
            const char* a3 = a2 + kstep; const char* b3 = b2 + kstep;
            if (last && has_next) S.a_ready(nxt);
            unsigned g2[2][2];
            if constexpr (Sched::GATHER) { _Pragma("unroll") for (int _h = 0; _h < 2; ++_h) _Pragma("unroll") for (int _i = 0; _i < 2; ++_i) g2[_h][_i] = last ? gAn[_h][_i] : gAc[_h][_i]; }
            if constexpr (SP2) {
            PG8_LDB(B0, 0, 0); PG8_LDB(B1, 0, 1); PG8_SCHED; PG8_LDA(At, 0, 0); PG8_STAGE_A(PG8_SA(1, 1), a1, 1, gAc);
            PG8_WAIT_V(8); PG8_WAIT_L(0); PG8_BAR; PG8_MMA(0, 0, At, B0); PG8_MMA(0, 1, At, B1); PG8_BAR; PG8_SCHED;
            PG8_LDA(At, 0, 1); PG8_STAGE(PG8_SB(0, 0), b2, voffB); PG8_STAGE(PG8_SB(0, 1), b2 + hstep, voffB); PG8_STAGE_A(PG8_SA(0, 0), a2, 0, g2);
            PG8_WAIT_V(8); PG8_WAIT_L(0); PG8_BAR; PG8_MMA(1, 0, At, B0); PG8_MMA(1, 1, At, B1); PG8_BAR; PG8_SCHED;
            PG8_LDB(B0, 1, 0); PG8_LDB(B1, 1, 1); PG8_SCHED; PG8_LDA(At, 1, 0); PG8_STAGE_A(PG8_SA(0, 1), a2, 1, g2);
            PG8_WAIT_V(8); PG8_WAIT_L(0); PG8_BAR; PG8_MMA(0, 0, At, B0); PG8_MMA(0, 1, At, B1); PG8_BAR; PG8_SCHED;
            PG8_LDA(At, 1, 1); PG8_STAGE(PG8_SB(1, 0), b3, voffB); PG8_STAGE(PG8_SB(1, 1), b3 + hstep, voffB); PG8_STAGE_A(PG8_SA(1, 0), a3, 0, g2);
            PG8_WAIT_V(8); PG8_WAIT_L(0); PG8_BAR; PG8_MMA(1, 0, At, B0); PG8_MMA(1, 1, At, B1); PG8_BAR; PG8_SCHED;
            } else {
            PG8_LDB(B0, 0, 0); PG8_SCHED; PG8_LDA(At, 0, 0); PG8_STAGE(PG8_SA(1, 1), a1 + hstep, voffA);
            PG8_WAIT_L(8); PG8_BAR; PG8_WAIT_L(0); PG8_MMA(0, 0, At, B0); PG8_BAR; PG8_SCHED;
            PG8_LDB(B1, 0, 1); PG8_STAGE(PG8_SB(0, 0), b2, voffB);
            PG8_BAR; PG8_WAIT_L(0); PG8_MMA(0, 1, At, B1); PG8_BAR;
            PG8_LDA(At, 0, 1); PG8_STAGE(PG8_SA(0, 0), a2, voffA);
            PG8_BAR; PG8_WAIT_L(0); PG8_MMA(1, 0, At, B0); PG8_BAR; PG8_SCHED;
            PG8_STAGE(PG8_SB(0, 1), b2 + hstep, voffB);
            PG8_WAIT_V(6); PG8_BAR; PG8_MMA(1, 1, At, B1); PG8_BAR;
            PG8_LDB(B0, 1, 0); PG8_SCHED; PG8_LDA(At, 1, 0); PG8_STAGE(PG8_SA(0, 1), a2 + hstep, voffA);
            PG8_WAIT_L(8); PG8_BAR; PG8_WAIT_L(0); PG8_MMA(0, 0, At, B0); PG8_BAR; PG8_SCHED;
            PG8_LDB(B1, 1, 1); PG8_STAGE(PG8_SB(1, 0), b3, voffB);
            PG8_BAR; PG8_WAIT_L(0); PG8_MMA(0, 1, At, B1); PG8_BAR;
            PG8_LDA(At, 1, 1); PG8_STAGE(PG8_SA(1, 0), a3, voffA);
            PG8_BAR; PG8_WAIT_L(0); PG8_MMA(1, 0, At, B0); PG8_BAR; PG8_SCHED;
            PG8_STAGE(PG8_SB(1, 1), b3 + hstep, voffB);
            PG8_WAIT_V(6); PG8_BAR; PG8_MMA(1, 1, At, B1); PG8_BAR;
            }
        }
        if constexpr (ALIGN_EPI) { if (wr == 0) PG8_BAR; }
        if constexpr (!Epi::AFTER_DRAIN) { E(acc, cur, wr, wc, fr, fq); S.done(cur); }
        if (!has_next) break;
#pragma unroll
        for (int a = 0; a < 2; ++a)
#pragma unroll
            for (int b = 0; b < 2; ++b)
#pragma unroll
                for (int m = 0; m < 4; ++m)
#pragma unroll
                    for (int n = 0; n < 2; ++n) acc[a][b][m][n] = (f32x4){0.f, 0.f, 0.f, 0.f};
        cur = nxt; cA = nA; cB = nB; ++ui;
        if constexpr (Sched::GATHER) { _Pragma("unroll") for (int _h = 0; _h < 2; ++_h) _Pragma("unroll") for (int _i = 0; _i < 2; ++_i) gAc[_h][_i] = gAn[_h][_i]; }
        if constexpr (ALIGN_EPI) { if (wr == 1) PG8_BAR; }
    }
    PG8_WAIT_V(0);
    if constexpr (!ALIGN_EPI) { if (wr == 0) PG8_BAR; }
    PG8_BAR;
    if constexpr (Epi::AFTER_DRAIN) { E.fused(acc, cur, wr, wc, fr, fq, lds, wid, lane); S.done(cur); }
#undef PG8_SA
#undef PG8_SB
#undef PG8_STAGE
#undef PG8_STAGE_A
#undef PG8_GLOAD
#undef PG8_LDA
#undef PG8_LDB
#undef PG8_MMA
#undef PG8_WAIT_V
#undef PG8_WAIT_L
#undef PG8_BAR
#undef PG8_SCHED
}
}

struct Args { const float* in[26]; float* out; unsigned char* ws; };

__device__ __forceinline__ void p_mod(LAS unsigned char* lds, const float* __restrict__ c, const float* __restrict__ c_ctx, const float* __restrict__ ada_w,
                                      const float* __restrict__ ada_b, float* __restrict__ mod, int bid, int G, int tid) {
    if (bid >= 96) return;
    LAS float* s = (LAS float*)lds;
    LAS float* red = s + 17 * 1024;
    for (int i = tid; i < 17 * 1024; i += NTHREADS) { const int r = i >> 10, k = i & 1023; const float v = r < NB ? c[r * DM + k] : c_ctx[k]; s[i] = v / (1.0f + expf(-v)); }
    __syncthreads();
    for (int it = bid; it < 96; it += G) {
        const int cc = tid & 63, kg = tid >> 6, col = it * 64 + cc;
        float acc[17];
#pragma unroll
        for (int r = 0; r < 17; ++r) acc[r] = 0.f;
        for (int k = kg * 128; k < kg * 128 + 128; ++k) {
            const float w = ada_w[(size_t)k * 6144 + col];
#pragma unroll
            for (int r = 0; r < 17; ++r) acc[r] += s[r * 1024 + k] * w;
        }
#pragma unroll
        for (int r = 0; r < 17; ++r) red[(kg * 17 + r) * 64 + cc] = acc[r];
        __syncthreads();
        for (int i = tid; i < 17 * 64; i += NTHREADS) {
            const int r = i >> 6, c2 = i & 63; float sum = 0.f;
#pragma unroll
            for (int g = 0; g < 8; ++g) sum += red[(g * 17 + r) * 64 + c2];
            mod[(size_t)r * 6144 + it * 64 + c2] = sum + ada_b[it * 64 + c2];
        }
        __syncthreads();
    }
}

struct TrTile { const float* W; bf16_t* O; int K, N, mode, k0, n0; };
__device__ __forceinline__ TrTile tr_decode(const Args& a, int r) {
    unsigned char* ws = a.ws;
    constexpr int I_IN = 16 * 56, I_OUT = 16 * 16, I_E = 32 * 128;
    TrTile t;
    if (r < I_IN) { t = TrTile{a.in[6], (bf16_t*)(ws + WS_WINT), DM, NIN, 0, (r & 15) * 64, (r >> 4) * 64}; return t; } r -= I_IN;
    if (r < I_OUT) { t = TrTile{a.in[14], (bf16_t*)(ws + WS_WOUTT), DM, DM, 0, (r & 15) * 64, (r >> 4) * 64}; return t; } r -= I_OUT;
    if (r < I_E) { const int e = r >> 7, q = r & 127; t = TrTile{a.in[21] + (size_t)e * DM * DE, (bf16_t*)(ws + WS_W13T) + (size_t)e * DM * DM, DM, DE, 1, (q & 15) * 64, (q >> 4) * 64}; return t; } r -= I_E;
    if (r < I_E) { const int e = r >> 7, q = r & 127; t = TrTile{a.in[22] + (size_t)e * DM * DE, (bf16_t*)(ws + WS_W13T) + (size_t)e * DM * DM, DM, DE, 2, (q & 15) * 64, (q >> 4) * 64}; return t; } r -= I_E;
    { const int e = r >> 7, q = r & 127; t = TrTile{a.in[23] + (size_t)e * DE * DM, (bf16_t*)(ws + WS_W2T) + (size_t)e * DM * DE, DE, DM, 0, (q & 7) * 64, (q >> 3) * 64}; return t; }
}
__device__ __forceinline__ void p_transposes(LAS unsigned char* lds, const Args& a, int bid, int G, int tid) {
    constexpr int NITEMS = (16 * 56 + 16 * 16 + 3 * 32 * 128) / 4;
    const int lrow = tid >> 4, lc4 = (tid & 15) * 4;
    const int sc = tid & 7, sn = tid >> 3;
    for (int it = bid; it < NITEMS; it += G) {
        f32x4 v[4][2]; TrTile t[4];
#pragma unroll
        for (int q = 0; q < 4; ++q) { t[q] = tr_decode(a, it * 4 + q);
#pragma unroll
            for (int h = 0; h < 2; ++h) v[q][h] = *(const f32x4*)(t[q].W + (size_t)(t[q].k0 + lrow + 32 * h) * t[q].N + t[q].n0 + lc4); }
        __syncthreads();
#pragma unroll
        for (int q = 0; q < 4; ++q) { LAS float* tile = (LAS float*)lds + q * (64 * 65);
#pragma unroll
            for (int h = 0; h < 2; ++h)
#pragma unroll
                for (int j = 0; j < 4; ++j) tile[(lrow + 32 * h) * 65 + lc4 + j] = v[q][h][j]; }
        __syncthreads();
#pragma unroll
        for (int q = 0; q < 4; ++q) { const LAS float* tile = (const LAS float*)lds + q * (64 * 65) + (8 * sc) * 65 + sn;
            const int n = t[q].n0 + sn, mode = t[q].mode;
            const int orow = mode == 0 ? n : ((n >> 4) * 32 + (mode == 2 ? 16 : 0) + (n & 15));
            u32x4 w; w.x = pk2(tile[0 * 65], tile[1 * 65]); w.y = pk2(tile[2 * 65], tile[3 * 65]); w.z = pk2(tile[4 * 65], tile[5 * 65]); w.w = pk2(tile[6 * 65], tile[7 * 65]);
            *(u32x4*)(t[q].O + (size_t)orow * t[q].K + t[q].k0 + 8 * sc) = w; }
    }
    __syncthreads();
}

__device__ __forceinline__ void p_u(const float* __restrict__ x, const float* __restrict__ ctx, const float* __restrict__ mod, bf16_t* __restrict__ U, int bid, int G, int tid) {
    const int c8 = (tid & 127) * 8, rsub = tid >> 7;
    for (int row0 = bid * 16; row0 < TA; row0 += G * 16) {
        f32x4 v[4][2];
#pragma unroll
        for (int q = 0; q < 4; ++q) { const int row = row0 + q * 4 + rsub; const float* src = row < T ? x + (size_t)row * DM : ctx + (size_t)(row - T) * DM;
            v[q][0] = *(const f32x4*)(src + c8); v[q][1] = *(const f32x4*)(src + c8 + 4); }
#pragma unroll
        for (int q = 0; q < 4; ++q) { const int row = row0 + q * 4 + rsub; const float* m = mod + (size_t)(row < T ? row / SEQ : 16) * 6144;
            const f32x4 sh0 = *(const f32x4*)(m + c8), sh1 = *(const f32x4*)(m + c8 + 4), sc0 = *(const f32x4*)(m + 1024 + c8), sc1 = *(const f32x4*)(m + 1024 + c8 + 4);
            const f32x4 u0 = v[q][0] * (1.0f + sc0) + sh0, u1 = v[q][1] * (1.0f + sc1) + sh1;
            u32x4 w; w.x = pk2(u0[0], u0[1]); w.y = pk2(u0[2], u0[3]); w.z = pk2(u1[0], u1[1]); w.w = pk2(u1[2], u1[3]);
            *(u32x4*)(U + (size_t)row * DM + c8) = w; }
    }
}

constexpr size_t WS_H1 = WS_XG + 128 * MiB;
constexpr size_t WS_WRT = 878 * MiB;
__device__ __forceinline__ void p_wrt(const float* __restrict__ rgw, const float* __restrict__ rew, bf16_t* __restrict__ wrt, int bid, int G, int tid) {
    for (int o = bid * NTHREADS + tid; o < 48 * 1024; o += G * NTHREADS) { const int e = o >> 10, k = o & 1023;
        const float w = e < 4 ? rgw[k * 4 + e] : (e < 36 ? rew[k * 32 + (e - 4)] : 0.f);
        const bf16_t hi = f2bf(w); wrt[o] = hi; wrt[48 * 1024 + o] = f2bf(w - bf2f(hi)); }
}
__device__ __forceinline__ void p_ln1_router(LAS unsigned char* lds, const Args& a, int bid, int G, int tid, int wave, int lane, bool dry = false, int parts = 3) {
    const float* __restrict__ x = a.in[0]; const bf16_t* yb = (const bf16_t*)(a.ws + WS_XG); bf16_t* h1o = (bf16_t*)(a.ws + (dry ? WS_HID : WS_H1)); const float* mod = (const float*)(a.ws + WS_MOD);
    const float* __restrict__ ln_g = a.in[15]; const float* __restrict__ ln_b = a.in[16]; const float* __restrict__ rgb = a.in[18]; const float* __restrict__ reb = a.in[20];
    bf16_t* U2 = (bf16_t*)(a.ws + (dry ? WS_Y + 16 * MiB : WS_U)); int* counts = (int*)(a.ws + WS_CTL) + (dry ? 32 * CSTR : 0);
    int2* eidx = (int2*)(a.ws + (dry ? WS_Y : WS_EIDX)); int2* epos = (int2*)(a.ws + (dry ? WS_Y + 4 * MiB : WS_EPOS)); float2* ew = (float2*)(a.ws + (dry ? WS_Y + 8 * MiB : WS_EW));
    const bf16_t* __restrict__ wrt = (const bf16_t*)(a.ws + WS_WRT);
    constexpr int WB_STRIDE = 528;
    LAS unsigned char* WB = lds;
    LAS float* LG = (LAS float*)(lds + 51200);
    LAS int* lcnt = (LAS int*)(lds + 102400);
    LAS int* lbase = lcnt + 32;
    LAS i32x4* tinfo = (LAS i32x4*)(lbase + 32);
    LAS f32x2* tw = (LAS f32x2*)(tinfo + 256);
    if (tid < 32) lcnt[tid] = 0;
    for (int blk = bid; blk < T / 256; blk += G) {
        const int tokb = blk * 256;
        const float* m = mod + (size_t)(tokb / SEQ) * 6144;
        if (parts & 1) {
            f32x4 xr[2][4]; u32x2 yr[2][4];
#pragma unroll
            for (int t = 0; t < 2; ++t)
#pragma unroll
                for (int j = 0; j < 4; ++j) { const int c4 = 4 * lane + 256 * j; const int tok = tokb + wave * 32 + t;
                    xr[t][j] = *(const f32x4*)(x + (size_t)tok * DM + c4); yr[t][j] = *(const u32x2*)(yb + (size_t)tok * DM + c4); }
#pragma unroll 1
            for (int it = 0; it < 16; ++it) {
                int l2 = lane; asm volatile("" : "+v"(l2)); const int lane = l2;
                const int tok0 = tokb + wave * 32 + 2 * it;
                f32x4 v[2][4]; float s[2] = {0.f, 0.f};
#pragma unroll
                for (int t = 0; t < 2; ++t)
#pragma unroll
                    for (int j = 0; j < 4; ++j) { const int c4 = 4 * lane + 256 * j;
                        const f32x4 g1 = *(const f32x4*)(m + 2048 + c4); const u32x2 yw = yr[t][j];
                        const f32x4 yv = (f32x4){__uint_as_float(yw.x << 16), __uint_as_float(yw.x & 0xffff0000u), __uint_as_float(yw.y << 16), __uint_as_float(yw.y & 0xffff0000u)};
                        v[t][j] = ALPHA * xr[t][j] + g1 * yv; s[t] += (v[t][j][0] + v[t][j][1]) + (v[t][j][2] + v[t][j][3]); }
                if (it < 15) {
#pragma unroll
                    for (int t = 0; t < 2; ++t)
#pragma unroll
                        for (int j = 0; j < 4; ++j) { const int c4 = 4 * lane + 256 * j; const int tok = tok0 + 2 + t;
                            xr[t][j] = *(const f32x4*)(x + (size_t)tok * DM + c4); yr[t][j] = *(const u32x2*)(yb + (size_t)tok * DM + c4); }
                }
                float rstd[2];
#pragma unroll
                for (int t = 0; t < 2; ++t) { const float mean = wave_sum(s[t]) * (1.0f / DM); float s2 = 0.f;
#pragma unroll
                    for (int j = 0; j < 4; ++j) { v[t][j] = v[t][j] - mean; s2 += (v[t][j][0] * v[t][j][0] + v[t][j][1] * v[t][j][1]) + (v[t][j][2] * v[t][j][2] + v[t][j][3] * v[t][j][3]); }
                    rstd[t] = rsqrtf(wave_sum(s2) * (1.0f / DM) + LN_EPS); }
#pragma unroll
                for (int j = 0; j < 4; ++j) { const int c4 = 4 * lane + 256 * j;
                    const f32x4 lg = *(const f32x4*)(ln_g + c4), lb = *(const f32x4*)(ln_b + c4), sc2 = *(const f32x4*)(m + 4096 + c4), sh2 = *(const f32x4*)(m + 3072 + c4);
#pragma unroll
                    for (int t = 0; t < 2; ++t) { const f32x4 h1 = v[t][j] * rstd[t] * lg + lb;
                        u32x2 hw; hw.x = pk2(h1[0], h1[1]); hw.y = pk2(h1[2], h1[3]);
                        *(u32x2*)(h1o + (size_t)(tok0 + t) * DM + c4) = hw;
                        const f32x4 u2 = h1 * (1.0f + sc2) + sh2;
                        u32x2 w; w.x = pk2(u2[0], u2[1]); w.y = pk2(u2[2], u2[3]);
                        *(u32x2*)(U2 + (size_t)(tok0 + t) * DM + c4) = w; }
                }
            }
        }
        __syncthreads();
        __builtin_amdgcn_fence(__ATOMIC_ACQUIRE, "agent");
        asm volatile("s_waitcnt vmcnt(0)" ::: "memory");
        const int fr = lane & 15, fq = lane >> 4;
        if (parts & 2) {
            f32x4 acc[2][3];
#pragma unroll
            for (int gi = 0; gi < 2; ++gi)
#pragma unroll
                for (int nt = 0; nt < 3; ++nt) acc[gi][nt] = (f32x4){0.f, 0.f, 0.f, 0.f};
            const bf16_t* arow0 = U2 + (size_t)(tokb + (wave * 2 + 0) * 16 + fr) * DM + fq * 8;
            const bf16_t* arow1 = arow0 + (size_t)16 * DM;
#pragma unroll 1
            for (int ch = 0; ch < 4; ++ch) {
                u32x4 wreg[6];
#pragma unroll
                for (int p = 0; p < 6; ++p) { const int idx = p * NTHREADS + tid, row = idx >> 5, piece = idx & 31;
                    wreg[p] = *(const u32x4*)(wrt + (size_t)row * 1024 + ch * 256 + piece * 8); }
                __syncthreads();
#pragma unroll
                for (int p = 0; p < 6; ++p) { const int idx = p * NTHREADS + tid, row = idx >> 5, piece = idx & 31;
                    *(LAS u32x4*)(WB + row * WB_STRIDE + piece * 16) = wreg[p]; }
                __syncthreads();
#pragma unroll 2
                for (int ks = 0; ks < 8; ++ks) {
                    const bf16x8 af0 = *(const bf16x8*)(arow0 + ch * 256 + ks * 32), af1 = *(const bf16x8*)(arow1 + ch * 256 + ks * 32);
#pragma unroll
                    for (int nt = 0; nt < 3; ++nt) {
                        const bf16x8 bh = *(const LAS bf16x8*)(WB + (nt * 16 + fr) * WB_STRIDE + (ks * 32 + fq * 8) * 2), bl = *(const LAS bf16x8*)(WB + (48 + nt * 16 + fr) * WB_STRIDE + (ks * 32 + fq * 8) * 2);
                        acc[0][nt] = __builtin_amdgcn_mfma_f32_16x16x32_bf16(af0, bh, acc[0][nt], 0, 0, 0);
                        acc[1][nt] = __builtin_amdgcn_mfma_f32_16x16x32_bf16(af1, bh, acc[1][nt], 0, 0, 0);
                        acc[0][nt] = __builtin_amdgcn_mfma_f32_16x16x32_bf16(af0, bl, acc[0][nt], 0, 0, 0);
                        acc[1][nt] = __builtin_amdgcn_mfma_f32_16x16x32_bf16(af1, bl, acc[1][nt], 0, 0, 0);
                    }
                }
            }
            LAS float* lg = LG + wave * (2 * 16 * 48);
#pragma unroll
            for (int gi = 0; gi < 2; ++gi)
#pragma unroll
                for (int nt = 0; nt < 3; ++nt)
#pragma unroll
                    for (int j = 0; j < 4; ++j) lg[(gi * 16 + 4 * fq + j) * 48 + 16 * nt + fr] = acc[gi][nt][j];
            asm volatile("s_waitcnt lgkmcnt(0)" ::: "memory");
            if (lane < 32) {
                float pl[36];
#pragma unroll
                for (int e4 = 0; e4 < 9; ++e4) { const f32x4 q = *(const LAS f32x4*)(lg + lane * 48 + 4 * e4);
#pragma unroll
                    for (int r = 0; r < 4; ++r) pl[4 * e4 + r] = q[r]; }
#pragma unroll
                for (int e = 0; e < 36; ++e) pl[e] += e < 4 ? rgb[e] : reb[e - 4];
                int gsel = 0; float gm = pl[0];
#pragma unroll
                for (int g = 1; g < 4; ++g) if (pl[g] > gm) { gm = pl[g]; gsel = g; }
                float den = 0.f;
#pragma unroll
                for (int g = 0; g < 4; ++g) den += __expf(pl[g] - gm);
                const float gval = frcp(den);
                int j0 = -1; float v0 = -3.0e38f;
#pragma unroll
                for (int j = 0; j < 32; ++j) { const bool in = (j >> 3) == gsel; if (in && (j0 < 0 || pl[4 + j] > v0)) { v0 = pl[4 + j]; j0 = j; } }
                int j1 = -1; float v1 = -3.0e38f;
#pragma unroll
                for (int j = 0; j < 32; ++j) { const bool in = (j >> 3) == gsel; if (in && j != j0 && (j1 < 0 || pl[4 + j] > v1)) { v1 = pl[4 + j]; j1 = j; } }
                const float tt = __expf(v1 - v0), w0 = frcp(1.0f + tt), w1 = tt * w0;
                const int p0 = __hip_atomic_fetch_add(lcnt + j0, 1, __ATOMIC_RELAXED, __HIP_MEMORY_SCOPE_WORKGROUP), p1 = __hip_atomic_fetch_add(lcnt + j1, 1, __ATOMIC_RELAXED, __HIP_MEMORY_SCOPE_WORKGROUP);
                const int slot = wave * 32 + lane;
                tinfo[slot] = (i32x4){j0, j1, p0, p1}; tw[slot] = (f32x2){gval * w0, gval * w1};
            }
        }
        __syncthreads();
        if (tid < 32) lbase[tid] = atomicAdd(&counts[tid * CSTR], lcnt[tid]);
        __syncthreads();
        if (tid < 256) {
            const int tok = tokb + tid; const i32x4 ti = tinfo[tid]; const f32x2 wv = tw[tid];
            eidx[tok] = make_int2(ti[0], ti[1]); epos[tok] = make_int2(lbase[ti[0]] + ti[2], lbase[ti[1]] + ti[3]); ew[tok] = make_float2(wv[0], wv[1]);
        }
        if (tid < 32) lcnt[tid] = 0;
        __syncthreads();
    }
}

constexpr size_t WS_ROWTOK = 5 * MiB;
__device__ __forceinline__ void p_assign(LAS unsigned char* lds, const Args& a, int bid, int G, int tid) {
    const int* counts = (const int*)(a.ws + WS_CTL);
    const int2* eidx = (const int2*)(a.ws + WS_EIDX); const int2* epos = (const int2*)(a.ws + WS_EPOS); int2* dest = (int2*)(a.ws + WS_DEST); int* rowtok = (int*)(a.ws + WS_ROWTOK);
    LAS int* ps = (LAS int*)lds;
    if (tid == 0) { int acc = 0; for (int e = 0; e < NE; ++e) { const int c = counts[e * CSTR]; ps[e] = acc; ps[32 + e] = c; acc += ((c + 255) >> 8) << 8; } }
    __syncthreads();
    for (int tok = bid * NTHREADS + tid; tok < T; tok += G * NTHREADS) {
        const int2 ei = eidx[tok], ep = epos[tok];
        const int d0 = ps[ei.x] + ep.x, d1 = ps[ei.y] + ep.y;
        rowtok[d0] = tok; rowtok[d1] = tok; dest[tok] = make_int2(d0, d1);
    }
    for (int i = bid * NTHREADS + tid; i < NE * 256; i += G * NTHREADS) {
        const int e = i >> 8, r = i & 255, c = ps[32 + e];
        if (c + r < (((c + 255) >> 8) << 8)) rowtok[ps[e] + c + r] = 0;
    }
    __syncthreads();
}

__device__ __forceinline__ void p_combine_ln2(const Args& a, int bid, int G, int wave, int lane, bool dry = false) {
    const bf16_t* h1b = (const bf16_t*)(a.ws + WS_H1); float* outw = dry ? (float*)(a.ws + WS_HID) : a.out; const bf16_t* Y = (const bf16_t*)(a.ws + WS_Y); const int2* dest = (const int2*)(a.ws + WS_DEST); const float2* ew = (const float2*)(a.ws + WS_EW);
    const float* mod = (const float*)(a.ws + WS_MOD); const float* __restrict__ ln_g = a.in[24]; const float* __restrict__ ln_b = a.in[25];
    int pr = bid * 8 + wave;
    int2 dn[2]; float2 wn[2];
#pragma unroll
    for (int t = 0; t < 2; ++t) { dn[t] = dest[2 * pr + t]; wn[t] = ew[2 * pr + t]; }
#pragma unroll 1
    for (; pr < T / 2; pr += G * 8) {
        int l2 = lane; asm volatile("" : "+v"(l2)); const int lane = l2;
        const int tok0 = 2 * pr;
        const float* m = mod + (size_t)(tok0 / SEQ) * 6144;
        int2 d[2]; float2 w[2];
#pragma unroll
        for (int t = 0; t < 2; ++t) { d[t] = dn[t]; w[t] = wn[t]; }
        f32x4 v[2][4]; float s[2] = {0.f, 0.f};
#pragma unroll
        for (int t = 0; t < 2; ++t)
#pragma unroll
            for (int j = 0; j < 4; ++j) { const int c4 = 4 * lane + 256 * j;
                const u32x2 ya = *(const u32x2*)(Y + (size_t)d[t].x * DM + c4), yb = *(const u32x2*)(Y + (size_t)d[t].y * DM + c4);
                const u32x2 hw = *(const u32x2*)(h1b + (size_t)(tok0 + t) * DM + c4); const f32x4 g2 = *(const f32x4*)(m + 5120 + c4);
                f32x4 f;
                f[0] = w[t].x * __uint_as_float(ya.x << 16) + w[t].y * __uint_as_float(yb.x << 16);
                f[1] = w[t].x * __uint_as_float(ya.x & 0xffff0000u) + w[t].y * __uint_as_float(yb.x & 0xffff0000u);
                f[2] = w[t].x * __uint_as_float(ya.y << 16) + w[t].y * __uint_as_float(yb.y << 16);
                f[3] = w[t].x * __uint_as_float(ya.y & 0xffff0000u) + w[t].y * __uint_as_float(yb.y & 0xffff0000u);
                const f32x4 h1 = (f32x4){__uint_as_float(hw.x << 16), __uint_as_float(hw.x & 0xffff0000u), __uint_as_float(hw.y << 16), __uint_as_float(hw.y & 0xffff0000u)};
                v[t][j] = ALPHA * h1 + g2 * f; s[t] += (v[t][j][0] + v[t][j][1]) + (v[t][j][2] + v[t][j][3]); }
        { const int pn = pr + G * 8; if (pn < T / 2) {
#pragma unroll
            for (int t = 0; t < 2; ++t) { dn[t] = dest[2 * pn + t]; wn[t] = ew[2 * pn + t]; } } }
#pragma unroll
        for (int t = 0; t < 2; ++t) { const float mean = wave_sum(s[t]) * (1.0f / DM); float s2 = 0.f;
#pragma unroll
            for (int j = 0; j < 4; ++j) { v[t][j] = v[t][j] - mean; s2 += (v[t][j][0] * v[t][j][0] + v[t][j][1] * v[t][j][1]) + (v[t][j][2] * v[t][j][2] + v[t][j][3] * v[t][j][3]); }
            const float rstd = rsqrtf(wave_sum(s2) * (1.0f / DM) + LN_EPS);
#pragma unroll
            for (int j = 0; j < 4; ++j) { const int c4 = 4 * lane + 256 * j;
                *(f32x4*)(outw + (size_t)(tok0 + t) * DM + c4) = v[t][j] * rstd * *(const f32x4*)(ln_g + c4) + *(const f32x4*)(ln_b + c4); } }
    }
}

constexpr size_t WS_HGK = WS_U;
constexpr size_t WS_HGD = 852 * MiB;
constexpr size_t WS_RGAGG = 854 * MiB;
constexpr size_t WS_RGCARRY = 864 * MiB;
constexpr size_t WS_GWT = 870 * MiB;
constexpr size_t WS_OFST = 880 * MiB;
constexpr int RG_UNITS_PER_B = 68, HG_SEGS = 17;

__device__ __forceinline__ void lds_barrier() { asm volatile("s_waitcnt lgkmcnt(0)" ::: "memory"); __builtin_amdgcn_s_barrier(); asm volatile("" ::: "memory"); }
__device__ __forceinline__ bf16x8 mk_bf16x8(u32x4 v) { return __builtin_bit_cast(bf16x8, v); }
__device__ __forceinline__ float bf_lo(unsigned w) { return __uint_as_float(w << 16); }
__device__ __forceinline__ float bf_hi(unsigned w) { return __uint_as_float(w & 0xffff0000u); }
__device__ __forceinline__ unsigned cvt2(float lo, float hi) { unsigned r; asm volatile("v_cvt_pk_bf16_f32 %0, %1, %2" : "=v"(r) : "v"(lo), "v"(hi)); return r; }

__device__ __forceinline__ void p_gwt(const float* __restrict__ gate_w, bf16_t* __restrict__ gwt, int bid, int G, int tid) {
    for (int o = bid * NTHREADS + tid; o < 32 * 4096; o += G * NTHREADS) { const int mat = o >> 12, d = (o >> 6) & 63, c = o & 63; gwt[o] = f2bf(gate_w[mat * 4096 + c * 64 + d]); }
}

constexpr int XC_STRIDE = 1040;
constexpr int RG_XC = 0, RG_OUT = 64 * XC_STRIDE;
constexpr size_t WS_RGPAR = 876 * MiB;

__device__ __forceinline__ void p_rgpar(const float* __restrict__ gate_b, const float* __restrict__ lam, float* __restrict__ par, int bid, int G, int tid) {
    for (int o = bid * NTHREADS + tid; o < 2 * 512; o += G * NTHREADS) { const int dir = o >> 9, ch = o & 511;
        par[(dir * 3 + 0) * 512 + ch] = gate_b[(dir * 2 + 0) * 512 + ch]; par[(dir * 3 + 1) * 512 + ch] = gate_b[(dir * 2 + 1) * 512 + ch]; par[(dir * 3 + 2) * 512 + ch] = softplusf_(-lam[dir * 512 + ch]); }
}

template <int DIR, bool OUT>
__device__ __forceinline__ void rg_scan64(const float (&av)[4][4], const float (&uv)[4][4], float& carry, float& atot, float (&hsum)[4][4], int fr, int fq) {
#pragma unroll
    for (int mm = 0; mm < 4; ++mm) {
        const int m = DIR == 0 ? mm : 3 - mm;
        float P, H;
        if (DIR == 0) { P = av[m][0]; H = uv[m][0];
#pragma unroll
            for (int j = 1; j < 4; ++j) { H = av[m][j] * H + uv[m][j]; P *= av[m][j]; } }
        else { P = av[m][3]; H = uv[m][3];
#pragma unroll
            for (int j = 2; j >= 0; --j) { H = av[m][j] * H + uv[m][j]; P *= av[m][j]; } }
        float Pn, Hn, Pe, He, Pt, Ht;
        if (DIR == 0) {
            Pn = __shfl_up(P, 16); Hn = __shfl_up(H, 16); if (fq >= 1) { H = P * Hn + H; P = P * Pn; }
            Pn = __shfl_up(P, 32); Hn = __shfl_up(H, 32); if (fq >= 2) { H = P * Hn + H; P = P * Pn; }
            Pe = __shfl_up(P, 16); He = __shfl_up(H, 16); if (fq == 0) { Pe = 1.f; He = 0.f; }
            Pt = __shfl(P, fr + 48); Ht = __shfl(H, fr + 48);
        } else {
            Pn = __shfl_down(P, 16); Hn = __shfl_down(H, 16); if (fq <= 2) { H = P * Hn + H; P = P * Pn; }
            Pn = __shfl_down(P, 32); Hn = __shfl_down(H, 32); if (fq <= 1) { H = P * Hn + H; P = P * Pn; }
            Pe = __shfl_down(P, 16); He = __shfl_down(H, 16); if (fq == 3) { Pe = 1.f; He = 0.f; }
            Pt = __shfl(P, fr); Ht = __shfl(H, fr);
        }
        if (OUT) {
            float hp = Pe * carry + He;
            if (DIR == 0) {
#pragma unroll
                for (int j = 0; j < 4; ++j) { hp = av[m][j] * hp + uv[m][j]; hsum[m][j] = hp; }
            } else {
#pragma unroll
                for (int j = 3; j >= 0; --j) { hp = av[m][j] * hp + uv[m][j]; hsum[m][j] += hp; }
            }
        }
        carry = Pt * carry + Ht; atot *= Pt;
    }
}

__device__ __forceinline__ void rg_agg_unit(LAS unsigned char* lds, const Args& a, int b, int k, int tid, int wave, int lane) {
    const bf16_t* __restrict__ proj = (const bf16_t*)(a.ws + WS_PROJ);
    const float* __restrict__ conv_w = a.in[7]; const float* __restrict__ conv_b = a.in[8];
    const bf16_t* __restrict__ gwt = (const bf16_t*)(a.ws + WS_GWT); const float* __restrict__ par = (const float*)(a.ws + WS_RGPAR);
    float* rgagg = (float*)(a.ws + WS_RGAGG);
    int rowbase, p0, lo, hi;
    if (k < 4) { rowbase = T + b * LC; p0 = k * 64; lo = 0; hi = LC; } else { rowbase = b * SEQ; p0 = (k - 4) * 64; lo = p0; hi = p0 + 64; }
    const int unit = b * RG_UNITS_PER_B + k;
    const int n = wave, fr = lane & 15, fq = lane >> 4;
    float pgr[4][2], pgi[4][2], psp[4][2];
#pragma unroll
    for (int nt = 0; nt < 4; ++nt)
#pragma unroll
        for (int dir = 0; dir < 2; ++dir) { const int ch = n * 64 + nt * 16 + fr;
            pgr[nt][dir] = par[(dir * 3 + 0) * 512 + ch]; pgi[nt][dir] = par[(dir * 3 + 1) * 512 + ch]; psp[nt][dir] = par[(dir * 3 + 2) * 512 + ch]; }
    {
        const int cgp = tid & 63, tg = tid >> 6, c0 = cgp * 8, i0 = tg * 8;
        u32x4 raw[11];
#pragma unroll
        for (int r = 0; r < 11; ++r) { const int p = p0 + i0 - 1 + r;
            raw[r] = (p >= lo && p < hi) ? *(const u32x4*)proj_at(proj, rowbase + p, c0) : (u32x4){0u, 0u, 0u, 0u}; }
        float cw[4][8], cb[8];
#pragma unroll
        for (int t4 = 0; t4 < 4; ++t4) { const f32x4 w0 = *(const f32x4*)(conv_w + t4 * 512 + c0), w1 = *(const f32x4*)(conv_w + t4 * 512 + c0 + 4);
#pragma unroll
            for (int q = 0; q < 4; ++q) { cw[t4][q] = w0[q]; cw[t4][4 + q] = w1[q]; } }
        { const f32x4 b0 = *(const f32x4*)(conv_b + c0), b1 = *(const f32x4*)(conv_b + c0 + 4);
#pragma unroll
            for (int q = 0; q < 4; ++q) { cb[q] = b0[q]; cb[4 + q] = b1[q]; } }
#pragma unroll
        for (int ii = 0; ii < 8; ++ii) {
            float xc[8];
#pragma unroll
            for (int c = 0; c < 8; ++c) xc[c] = cb[c];
#pragma unroll
            for (int t4 = 0; t4 < 4; ++t4) { const u32x4 rw = raw[ii + t4];
#pragma unroll
                for (int q = 0; q < 4; ++q) { xc[2 * q] += cw[t4][2 * q] * bf_lo(rw[q]); xc[2 * q + 1] += cw[t4][2 * q + 1] * bf_hi(rw[q]); } }
            u32x4 w; w.x = cvt2(xc[0], xc[1]); w.y = cvt2(xc[2], xc[3]); w.z = cvt2(xc[4], xc[5]); w.w = cvt2(xc[6], xc[7]);
            *(LAS u32x4*)(lds + RG_XC + (i0 + ii) * XC_STRIDE + c0 * 2) = w;
        }
    }
    lds_barrier();
    {
        bf16x8 afr[4][2];
#pragma unroll
        for (int m = 0; m < 4; ++m)
#pragma unroll
            for (int ks = 0; ks < 2; ++ks) afr[m][ks] = *(const LAS bf16x8*)(lds + RG_XC + (16 * m + fr) * XC_STRIDE + (n * 64 + ks * 32 + fq * 8) * 2);
        u32x4* stash = (k >= 4) ? (u32x4*)a.out + ((size_t)(b * 64 + (k - 4)) * 16384 + (size_t)wave * 2048 + lane) : nullptr;
        bf16x8 wfr[2][2][2];
#pragma unroll
        for (int dir = 0; dir < 2; ++dir)
#pragma unroll
            for (int g = 0; g < 2; ++g)
#pragma unroll
                for (int ks = 0; ks < 2; ++ks) wfr[dir][g][ks] = *(const bf16x8*)(gwt + ((size_t)(((dir * 2 + g) * 8 + n) * 64 + fr)) * 64 + ks * 32 + fq * 8);
#pragma unroll
        for (int nt = 0; nt < 4; ++nt) {
            const int ch = n * 64 + nt * 16 + fr;
            bf16x8 wnx[2][2][2];
            if (nt < 3) {
#pragma unroll
                for (int dir = 0; dir < 2; ++dir)
#pragma unroll
                    for (int g = 0; g < 2; ++g)
#pragma unroll
                        for (int ks = 0; ks < 2; ++ks) wnx[dir][g][ks] = *(const bf16x8*)(gwt + ((size_t)(((dir * 2 + g) * 8 + n) * 64 + (nt + 1) * 16 + fr)) * 64 + ks * 32 + fq * 8);
            }
            float xcv[4][4];
#pragma unroll
            for (int m = 0; m < 4; ++m)
#pragma unroll
                for (int j = 0; j < 4; ++j) xcv[m][j] = bf2f(*(const LAS bf16_t*)(lds + RG_XC + (16 * m + 4 * fq + j) * XC_STRIDE + ch * 2));
#pragma unroll
            for (int dir = 0; dir < 2; ++dir) {
                f32x4 accr[4], acci[4];
#pragma unroll
                for (int m = 0; m < 4; ++m) { accr[m] = (f32x4){0.f, 0.f, 0.f, 0.f}; acci[m] = (f32x4){0.f, 0.f, 0.f, 0.f}; }
#pragma unroll
                for (int ks = 0; ks < 2; ++ks)
#pragma unroll
                    for (int m = 0; m < 4; ++m) { accr[m] = __builtin_amdgcn_mfma_f32_16x16x32_bf16(afr[m][ks], wfr[dir][0][ks], accr[m], 0, 0, 0); acci[m] = __builtin_amdgcn_mfma_f32_16x16x32_bf16(afr[m][ks], wfr[dir][1][ks], acci[m], 0, 0, 0); }
                const float gbr = pgr[nt][dir], gbi = pgi[nt][dir], sp = psp[nt][dir];
                float av[4][4], uv[4][4];
                const bool exact = __any(8.0f * sp >= 0.25f);
#pragma unroll
                for (int m = 0; m < 4; ++m) {
                    unsigned pk[4];
                    if (!exact) {
#pragma unroll
                        for (int j = 0; j < 4; ++j) {
                            const float r = sigmoidf_(accr[m][j] + gbr), ig = sigmoidf_(acci[m][j] + gbi);
                            const float la = -8.0f * r * sp;
                            const float oma = -la * (1.f + la * (0.5f + la * (0.16666667f + la * (0.041666668f + la * 0.0083333338f))));
                            pk[j] = cvt2(oma, __builtin_amdgcn_sqrtf(oma * (2.0f - oma)) * ig * xcv[m][j]);
                        }
                    } else {
#pragma unroll
                        for (int j = 0; j < 4; ++j) {
                            const float r = sigmoidf_(accr[m][j] + gbr), ig = sigmoidf_(acci[m][j] + gbi);
                            const float la = -8.0f * r * sp;
                            const float ser = -la * (1.f + la * (0.5f + la * (0.16666667f + la * (0.041666668f + la * 0.0083333338f))));
                            const float oma = (la > -0.25f) ? ser : 1.f - __expf(la);
                            pk[j] = cvt2(oma, __builtin_amdgcn_sqrtf(oma * (2.0f - oma)) * ig * xcv[m][j]);
                        }
                    }
#pragma unroll
                    for (int j = 0; j < 4; ++j) { av[m][j] = 1.0f - bf_lo(pk[j]); uv[m][j] = bf_hi(pk[j]); }
                    if (stash) stash[((nt * 2 + dir) * 4 + m) * 64] = (u32x4){pk[0], pk[1], pk[2], pk[3]};
                }
                float carry = 0.f, atot = 1.f, hdummy[4][4];
                if (dir == 0) rg_scan64<0, false>(av, uv, carry, atot, hdummy, fr, fq); else rg_scan64<1, false>(av, uv, carry, atot, hdummy, fr, fq);
                if (fq == 0) { rgagg[(((size_t)unit * 2 + dir) * 2 + 0) * 512 + ch] = atot; rgagg[(((size_t)unit * 2 + dir) * 2 + 1) * 512 + ch] = carry; }
            }
            if (nt < 3) {
#pragma unroll
                for (int dir = 0; dir < 2; ++dir)
#pragma unroll
                    for (int g = 0; g < 2; ++g)
#pragma unroll
                        for (int ks = 0; ks < 2; ++ks) wfr[dir][g][ks] = wnx[dir][g][ks];
            }
        }
    }
    lds_barrier();
}

__device__ __forceinline__ void rg_final_unit(LAS unsigned char* lds, const Args& a, int b, int kl, int tid, int wave, int lane) {
    const bf16_t* __restrict__ proj = (const bf16_t*)(a.ws + WS_PROJ); const float* rgcarry = (const float*)(a.ws + WS_RGCARRY); bf16_t* mixed = (bf16_t*)(a.ws + WS_MIXED);
    const int rowbase = b * SEQ + kl * 64, unit = b * RG_UNITS_PER_B + 4 + kl;
    const int n = wave, fr = lane & 15, fq = lane >> 4;
    const u32x4* stash = (const u32x4*)a.out + ((size_t)(b * 64 + kl) * 16384 + (size_t)wave * 2048 + lane);
    u32x4 st[2][4];
#pragma unroll
    for (int dir = 0; dir < 2; ++dir)
#pragma unroll
        for (int m = 0; m < 4; ++m) st[dir][m] = stash[((0 * 2 + dir) * 4 + m) * 64];
    float cin[4][2];
#pragma unroll
    for (int nt = 0; nt < 4; ++nt)
#pragma unroll
        for (int dir = 0; dir < 2; ++dir) cin[nt][dir] = rgcarry[((size_t)unit * 2 + dir) * 512 + n * 64 + nt * 16 + fr];
    {
        const int cgp = tid & 63, tg = tid >> 6, c0 = cgp * 8, i0 = tg * 8;
        u32x4 g[8];
#pragma unroll
        for (int ii = 0; ii < 8; ++ii) g[ii] = *(const u32x4*)proj_at(proj, rowbase + i0 + ii, 512 + c0);
#pragma unroll
        for (int ii = 0; ii < 8; ++ii) *(LAS u32x4*)(lds + RG_XC + (i0 + ii) * XC_STRIDE + c0 * 2) = g[ii];
    }
    lds_barrier();
#pragma unroll
    for (int nt = 0; nt < 4; ++nt) {
        const int ch = n * 64 + nt * 16 + fr;
        u32x4 sn[2][4];
        if (nt < 3) {
#pragma unroll
            for (int dir = 0; dir < 2; ++dir)
#pragma unroll
                for (int m = 0; m < 4; ++m) sn[dir][m] = stash[(((nt + 1) * 2 + dir) * 4 + m) * 64];
        }
        float hsum[4][4];
#pragma unroll
        for (int dir = 0; dir < 2; ++dir) {
            float av[4][4], uv[4][4];
#pragma unroll
            for (int m = 0; m < 4; ++m)
#pragma unroll
                for (int j = 0; j < 4; ++j) { av[m][j] = 1.0f - bf_lo(st[dir][m][j]); uv[m][j] = bf_hi(st[dir][m][j]); }
            float carry = cin[nt][dir], atot = 1.f;
            if (dir == 0) rg_scan64<0, true>(av, uv, carry, atot, hsum, fr, fq); else rg_scan64<1, true>(av, uv, carry, atot, hsum, fr, fq);
        }
#pragma unroll
        for (int m = 0; m < 4; ++m)
#pragma unroll
            for (int j = 0; j < 4; ++j) { const int t = 16 * m + 4 * fq + j;
                const float gg = bf2f(*(const LAS bf16_t*)(lds + RG_XC + t * XC_STRIDE + ch * 2));
                *(LAS bf16_t*)(lds + RG_OUT + t * XC_STRIDE + ch * 2) = (bf16_t)(cvt2(hsum[m][j] * gg, 0.f) & 0xffffu); }
        if (nt < 3) {
#pragma unroll
            for (int dir = 0; dir < 2; ++dir)
#pragma unroll
                for (int m = 0; m < 4; ++m) st[dir][m] = sn[dir][m];
        }
    }
    lds_barrier();
    {
        const int cgp = tid & 63, tg = tid >> 6, c0 = cgp * 8, i0 = tg * 8;
#pragma unroll
        for (int ii = 0; ii < 8; ++ii) { const u32x4 w = *(const LAS u32x4*)(lds + RG_OUT + (i0 + ii) * XC_STRIDE + c0 * 2);
            *(u32x4*)(mixed + (size_t)(rowbase + i0 + ii) * DM + c0) = w; }
    }
}

__device__ __forceinline__ void rg_carry_item(const Args& a, int item, int tid) {
    const float* rgagg = (const float*)(a.ws + WS_RGAGG); float* rgcarry = (float*)(a.ws + WS_RGCARRY);
    const int gidx = item * NTHREADS + tid;
    const int ch = gidx & 511, dir = (gidx >> 9) & 1, b = gidx >> 10;
    float h = 0.f;
#pragma unroll 1
    for (int s0 = 0; s0 < RG_UNITS_PER_B; s0 += 17) {
        float Av[17], Hv[17];
#pragma unroll
        for (int s1 = 0; s1 < 17; ++s1) { const int s = s0 + s1;
            const int k = dir == 0 ? s : (s < 4 ? 3 - s : 67 - (s - 4));
            const size_t unit = (size_t)b * RG_UNITS_PER_B + k;
            Av[s1] = rgagg[((unit * 2 + dir) * 2 + 0) * 512 + ch]; Hv[s1] = rgagg[((unit * 2 + dir) * 2 + 1) * 512 + ch]; }
#pragma unroll
        for (int s1 = 0; s1 < 17; ++s1) { const int s = s0 + s1;
            const int k = dir == 0 ? s : (s < 4 ? 3 - s : 67 - (s - 4));
            const size_t unit = (size_t)b * RG_UNITS_PER_B + k;
            rgcarry[(unit * 2 + dir) * 512 + ch] = h;
            h = Av[s1] * h + Hv[s1]; }
    }
}

constexpr int HG_RAWZ = 0, HG_RAWV = 16384, HG_RAWQ = 32768;
constexpr int HG_KHT = 49152, HG_VT = 67584;
constexpr int HG_QT = 86016, HG_KT = 103424;
constexpr int HG_AM = 120832;
constexpr int HG_DS = 130048, HG_QSUM = 130560, HG_PART = 134656;
constexpr int HG_RAWG = 136704;
constexpr int HG_OST = HG_QT;
constexpr int TS = 144, QS = 272;

struct HgRaw { u32x4 z[2], v[2], q[2], g[2]; };
template <bool FULL, bool GATE>
__device__ __forceinline__ void hg_load_raw(HgRaw& r, const bf16_t* __restrict__ proj, int row0, int hd, int dir, int tid) {
#pragma unroll
    for (int i = 0; i < 2; ++i) { const int row = row0 + (tid >> 4) + 32 * i, col = hd * 128 + (tid & 15) * 8;
        r.z[i] = *(const u32x4*)proj_at(proj, row, col + (dir == 0 ? 1536 : 2048)); r.v[i] = *(const u32x4*)proj_at(proj, row, col + 2560);
        if (FULL) r.q[i] = *(const u32x4*)proj_at(proj, row, col + 1024); if (GATE) r.g[i] = *(const u32x4*)proj_at(proj, row, col + 3072); }
}
template <bool FULL, bool GATE>
__device__ __forceinline__ void hg_store_raw(LAS unsigned char* lds, const HgRaw& r, int tid) {
#pragma unroll
    for (int i = 0; i < 2; ++i) { const int off = ((tid >> 4) + 32 * i) * 256 + (tid & 15) * 16;
        *(LAS u32x4*)(lds + HG_RAWZ + off) = r.z[i]; *(LAS u32x4*)(lds + HG_RAWV + off) = r.v[i]; if (FULL) *(LAS u32x4*)(lds + HG_RAWQ + off) = r.q[i]; if (GATE) *(LAS u32x4*)(lds + HG_RAWG + off) = r.g[i]; }
}

template <int DIR, bool FULL, bool STORE_NEXT, bool NEXT_GATE>
__device__ __forceinline__ void hg_chunk(LAS unsigned char* lds, f32x4 (&accS)[8], f32x4 (&o)[4], float lb0, float lb1, float& dseg0, float& dseg1, const HgRaw& nxt, int tid, int wave, int lane) {
    const int cp = lane, tg = wave, fr = lane & 15, fq = lane >> 4;
    float c0[8], c1[8], k0[8], k1[8];
    {
        float p0 = 1.f, p1 = 1.f;
#pragma unroll
        for (int ii = 0; ii < 8; ++ii) { const int i = DIR == 0 ? ii : 7 - ii;
            const unsigned zz = *(const LAS unsigned*)(lds + HG_RAWZ + (8 * tg + i) * 256 + cp * 4);
            const float e0 = __expf(-bf_lo(zz)), e1 = __expf(-bf_hi(zz)); const float s0 = frcp(1.0f + e0), s1 = frcp(1.0f + e1);
            k0[i] = (1.0f - lb0) * e0 * s0; k1[i] = (1.0f - lb1) * e1 * s1;
            p0 *= lb0 + (1.0f - lb0) * s0; p1 *= lb1 + (1.0f - lb1) * s1; c0[i] = p0; c1[i] = p1; }
        *(LAS f32x2*)(lds + HG_QSUM + (tg * 128 + 2 * cp) * 4) = (f32x2){p0, p1};
    }
    lds_barrier();
    float pre0 = 1.f, pre1 = 1.f, tot0 = 1.f, tot1 = 1.f;
#pragma unroll
    for (int g = 0; g < 8; ++g) { const f32x2 v = *(const LAS f32x2*)(lds + HG_QSUM + (g * 128 + 2 * cp) * 4); tot0 *= v[0]; tot1 *= v[1]; if (DIR == 0 ? (g < tg) : (g > tg)) { pre0 *= v[0]; pre1 *= v[1]; } }
    {
        unsigned kh0[4], kh1[4], vt0[4], vt1[4];
#pragma unroll
        for (int i2 = 0; i2 < 4; ++i2) {
            const float Pa0 = pre0 * c0[2 * i2], Pb0 = pre0 * c0[2 * i2 + 1], Pa1 = pre1 * c1[2 * i2], Pb1 = pre1 * c1[2 * i2 + 1];
            const float ra0 = frcp(Pa0), rb0 = frcp(Pb0), ra1 = frcp(Pa1), rb1 = frcp(Pb1);
            const float kta0 = k0[2 * i2] * ra0, ktb0 = k0[2 * i2 + 1] * rb0, kta1 = k1[2 * i2] * ra1, ktb1 = k1[2 * i2 + 1] * rb1;
            kh0[i2] = cvt2(kta0 * tot0, ktb0 * tot0); kh1[i2] = cvt2(kta1 * tot1, ktb1 * tot1);
            const unsigned va = *(const LAS unsigned*)(lds + HG_RAWV + (8 * tg + 2 * i2) * 256 + cp * 4), vb = *(const LAS unsigned*)(lds + HG_RAWV + (8 * tg + 2 * i2 + 1) * 256 + cp * 4);
            vt0[i2] = __builtin_amdgcn_perm(vb, va, 0x05040100u); vt1[i2] = __builtin_amdgcn_perm(vb, va, 0x07060302u);
            if (FULL) {
                const unsigned qa = *(const LAS unsigned*)(lds + HG_RAWQ + (8 * tg + 2 * i2) * 256 + cp * 4), qb = *(const LAS unsigned*)(lds + HG_RAWQ + (8 * tg + 2 * i2 + 1) * 256 + cp * 4);
                *(LAS unsigned*)(lds + HG_QT + (8 * tg + 2 * i2) * QS + cp * 4) = cvt2(bf_lo(qa) * Pa0, bf_hi(qa) * Pa1);
                *(LAS unsigned*)(lds + HG_QT + (8 * tg + 2 * i2 + 1) * QS + cp * 4) = cvt2(bf_lo(qb) * Pb0, bf_hi(qb) * Pb1);
                *(LAS unsigned*)(lds + HG_KT + (8 * tg + 2 * i2) * QS + cp * 4) = cvt2(kta0, kta1);
                *(LAS unsigned*)(lds + HG_KT + (8 * tg + 2 * i2 + 1) * QS + cp * 4) = cvt2(ktb0, ktb1);
            }
        }
        *(LAS u32x4*)(lds + HG_KHT + (2 * cp) * TS + tg * 16) = (u32x4){kh0[0], kh0[1], kh0[2], kh0[3]}; *(LAS u32x4*)(lds + HG_KHT + (2 * cp + 1) * TS + tg * 16) = (u32x4){kh1[0], kh1[1], kh1[2], kh1[3]};
        *(LAS u32x4*)(lds + HG_VT + (2 * cp) * TS + tg * 16) = (u32x4){vt0[0], vt0[1], vt0[2], vt0[3]}; *(LAS u32x4*)(lds + HG_VT + (2 * cp + 1) * TS + tg * 16) = (u32x4){vt1[0], vt1[1], vt1[2], vt1[3]};
        if (tg == 0) { *(LAS f32x2*)(lds + HG_DS + 2 * cp * 4) = (f32x2){tot0, tot1}; dseg0 *= tot0; dseg1 *= tot1; }
    }
    lds_barrier();
    if (FULL) {
#pragma unroll
        for (int tt = 0; tt < 2; ++tt) {
            const int tl = 2 * wave + tt, ti = tl >> 2, si = tl & 3;
            f32x4 accA = (f32x4){0.f, 0.f, 0.f, 0.f};
#pragma unroll
            for (int ks = 0; ks < 4; ++ks) {
                const bf16x8 af = *(const LAS bf16x8*)(lds + HG_QT + (16 * ti + fr) * QS + (ks * 32 + fq * 8) * 2);
                const bf16x8 bf = *(const LAS bf16x8*)(lds + HG_KT + (16 * si + fr) * QS + (ks * 32 + fq * 8) * 2);
                accA = __builtin_amdgcn_mfma_f32_16x16x32_bf16(af, bf, accA, 0, 0, 0);
            }
#pragma unroll
            for (int j = 0; j < 4; ++j) { const int t = 16 * ti + 4 * fq + j, s = 16 * si + fr;
                const bool keep = DIR == 0 ? (s <= t) : (s >= t);
                *(LAS bf16_t*)(lds + HG_AM + t * TS + s * 2) = (bf16_t)(cvt2(keep ? accA[j] : 0.f, 0.f) & 0xffffu); }
        }
        lds_barrier();
#pragma unroll
        for (int m = 0; m < 4; ++m) o[m] = (f32x4){0.f, 0.f, 0.f, 0.f};
#pragma unroll
        for (int ks = 0; ks < 4; ++ks) {
            const u32x4 sw = (u32x4){cvt2(accS[2 * ks][0], accS[2 * ks][1]), cvt2(accS[2 * ks][2], accS[2 * ks][3]), cvt2(accS[2 * ks + 1][0], accS[2 * ks + 1][1]), cvt2(accS[2 * ks + 1][2], accS[2 * ks + 1][3])};
            const bf16x8 sf = mk_bf16x8(sw);
#pragma unroll
            for (int m = 0; m < 4; ++m) {
                const u32x2 qlo = *(const LAS u32x2*)(lds + HG_QT + (16 * m + fr) * QS + (32 * ks + 4 * fq) * 2), qhi = *(const LAS u32x2*)(lds + HG_QT + (16 * m + fr) * QS + (32 * ks + 16 + 4 * fq) * 2);
                const bf16x8 qf = mk_bf16x8((u32x4){qlo.x, qlo.y, qhi.x, qhi.y});
                o[m] = __builtin_amdgcn_mfma_f32_16x16x32_bf16(qf, sf, o[m], 0, 0, 0);
            }
        }
#pragma unroll
        for (int ks = 0; ks < 2; ++ks) {
            const bf16x8 vf = *(const LAS bf16x8*)(lds + HG_VT + (16 * wave + fr) * TS + (ks * 32 + fq * 8) * 2);
#pragma unroll
            for (int m = 0; m < 4; ++m) { const bf16x8 af = *(const LAS bf16x8*)(lds + HG_AM + (16 * m + fr) * TS + (ks * 32 + fq * 8) * 2);
                o[m] = __builtin_amdgcn_mfma_f32_16x16x32_bf16(af, vf, o[m], 0, 0, 0); }
        }
    }
#pragma unroll
    for (int i = 0; i < 8; ++i) { const f32x4 dv = *(const LAS f32x4*)(lds + HG_DS + (16 * i + 4 * fq) * 4); accS[i] = accS[i] * dv; }
#pragma unroll
    for (int ks = 0; ks < 2; ++ks) {
        const bf16x8 vf = *(const LAS bf16x8*)(lds + HG_VT + (16 * wave + fr) * TS + (ks * 32 + fq * 8) * 2);
#pragma unroll
        for (int i = 0; i < 8; ++i) { const bf16x8 af = *(const LAS bf16x8*)(lds + HG_KHT + (16 * i + fr) * TS + (ks * 32 + fq * 8) * 2);
            accS[i] = __builtin_amdgcn_mfma_f32_16x16x32_bf16(af, vf, accS[i], 0, 0, 0); }
    }
    if (STORE_NEXT) hg_store_raw<FULL, NEXT_GATE>(lds, nxt, tid);
}

__device__ __forceinline__ float hg_lb(const float* __restrict__ lb_logits, int dir, int col) {
    const float l0 = lb_logits[(0 * 2 + dir) * 512 + col], l1 = lb_logits[(1 * 2 + dir) * 512 + col];
    return 1.0f / (1.0f + expf(l1 - l0));
}

template <int DIR>
__device__ __forceinline__ void hg_agg_unit(LAS unsigned char* lds, const Args& a, int b, int hd, int sidx, int unit, int tid, int wave, int lane) {
    const bf16_t* __restrict__ proj = (const bf16_t*)(a.ws + WS_PROJ);
    const int rowbase = sidx == 0 ? T + b * LC : b * SEQ + (sidx - 1) * 256;
    const float lb0 = hg_lb(a.in[12], DIR, hd * 128 + 2 * lane), lb1 = hg_lb(a.in[12], DIR, hd * 128 + 2 * lane + 1);
    f32x4 accS[8], odummy[4];
#pragma unroll
    for (int i = 0; i < 8; ++i) accS[i] = (f32x4){0.f, 0.f, 0.f, 0.f};
    float dseg0 = 1.f, dseg1 = 1.f;
    HgRaw raw;
    hg_load_raw<false, false>(raw, proj, rowbase + (DIR == 0 ? 0 : 3) * 64, hd, DIR, tid);
    lds_barrier();
    hg_store_raw<false, false>(lds, raw, tid);
    lds_barrier();
#pragma unroll 1
    for (int cc = 0; cc < 3; ++cc) {
        hg_load_raw<false, false>(raw, proj, rowbase + (DIR == 0 ? cc + 1 : 2 - cc) * 64, hd, DIR, tid);
        hg_chunk<DIR, false, true, false>(lds, accS, odummy, lb0, lb1, dseg0, dseg1, raw, tid, wave, lane);
        lds_barrier();
    }
    hg_chunk<DIR, false, false, false>(lds, accS, odummy, lb0, lb1, dseg0, dseg1, raw, tid, wave, lane);
    float* K = (float*)(a.ws + WS_HGK) + (size_t)unit * 16384;
    const int fr = lane & 15, fq = lane >> 4;
#pragma unroll
    for (int i = 0; i < 8; ++i)
#pragma unroll
        for (int j = 0; j < 4; ++j) K[(16 * i + 4 * fq + j) * 128 + 16 * wave + fr] = accS[i][j];
    if (wave == 0) *(f32x2*)((float*)(a.ws + WS_HGD) + (size_t)unit * 128 + 2 * lane) = (f32x2){dseg0, dseg1};
}

__device__ __forceinline__ void hg_carry_item(const Args& a, int item, int tid, bool dry = false) {
    const int chain = item >> 3, part = item & 7, dir = chain & 1;
    float* K = (float*)(a.ws + WS_HGK) + (size_t)chain * HG_SEGS * 16384; const float* D = (const float*)(a.ws + WS_HGD) + (size_t)chain * HG_SEGS * 128;
    const int e4 = part * 512 + tid, dk = e4 >> 5;
    f32x4 kv[HG_SEGS]; float dv[HG_SEGS];
#pragma unroll
    for (int s = 0; s < HG_SEGS; ++s) { const int sidx = s == 0 ? 0 : (dir == 0 ? s : HG_SEGS - s); kv[s] = *(const f32x4*)(K + (size_t)sidx * 16384 + e4 * 4); dv[s] = D[sidx * 128 + dk]; }
    f32x4 S = (f32x4){0.f, 0.f, 0.f, 0.f};
#pragma unroll
    for (int s = 0; s < HG_SEGS; ++s) { const int sidx = s == 0 ? 0 : (dir == 0 ? s : HG_SEGS - s);
        if (dry) { const size_t o = ((size_t)(chain * HG_SEGS + sidx) * 16384 + e4 * 4) % (size_t)(32 * MiB); *(f32x4*)((float*)(a.ws + WS_MIXED) + o) = S; } else *(f32x4*)(K + (size_t)sidx * 16384 + e4 * 4) = S;
        S = S * dv[s] + kv[s]; }
}

__device__ __forceinline__ void hg_final_unit(LAS unsigned char* lds, const Args& a, int b, int hd, int seg, int tid, int wave, int lane) {
    const bf16_t* __restrict__ proj = (const bf16_t*)(a.ws + WS_PROJ); bf16_t* mixed = (bf16_t*)(a.ws + WS_MIXED);
    const int rowbase = b * SEQ + seg * 256, fr = lane & 15, fq = lane >> 4;
    const float lbf0 = hg_lb(a.in[12], 0, hd * 128 + 2 * lane), lbf1 = hg_lb(a.in[12], 0, hd * 128 + 2 * lane + 1);
    const float lbb0 = hg_lb(a.in[12], 1, hd * 128 + 2 * lane), lbb1 = hg_lb(a.in[12], 1, hd * 128 + 2 * lane + 1);
    const float ng = a.in[13][hd * 128 + 16 * wave + fr];
    f32x4 accS[8], o[4];
    float dseg0 = 1.f, dseg1 = 1.f;
    HgRaw raw;
    f32x4* ofst = (f32x4*)(a.ws + WS_OFST) + (size_t)blockIdx.x * 8192 + wave * 256 + lane;
    hg_load_raw<true, false>(raw, proj, rowbase, hd, 0, tid);
    {
        const float* Sin = (const float*)(a.ws + WS_HGK) + (size_t)((((b * 4 + hd) * 2 + 0) * HG_SEGS) + 1 + seg) * 16384;
#pragma unroll
        for (int i = 0; i < 8; ++i)
#pragma unroll
            for (int j = 0; j < 4; ++j) accS[i][j] = Sin[(16 * i + 4 * fq + j) * 128 + 16 * wave + fr];
    }
    lds_barrier();
    hg_store_raw<true, false>(lds, raw, tid);
    lds_barrier();
#pragma unroll 1
    for (int cc = 0; cc < 3; ++cc) {
        hg_load_raw<true, false>(raw, proj, rowbase + (cc + 1) * 64, hd, 0, tid);
        hg_chunk<0, true, true, false>(lds, accS, o, lbf0, lbf1, dseg0, dseg1, raw, tid, wave, lane);
#pragma unroll
        for (int m = 0; m < 4; ++m) ofst[cc * 2048 + m * 64] = o[m];
        lds_barrier();
    }
    hg_load_raw<true, true>(raw, proj, rowbase + 3 * 64, hd, 1, tid);
    hg_chunk<0, true, true, true>(lds, accS, o, lbf0, lbf1, dseg0, dseg1, raw, tid, wave, lane);
#pragma unroll
    for (int m = 0; m < 4; ++m) ofst[3 * 2048 + m * 64] = o[m];
    {
        const float* Sin = (const float*)(a.ws + WS_HGK) + (size_t)((((b * 4 + hd) * 2 + 1) * HG_SEGS) + 1 + seg) * 16384;
#pragma unroll
        for (int i = 0; i < 8; ++i)
#pragma unroll
            for (int j = 0; j < 4; ++j) accS[i][j] = Sin[(16 * i + 4 * fq + j) * 128 + 16 * wave + fr];
    }
    lds_barrier();
#pragma unroll 1
    for (int cc = 0; cc < 4; ++cc) {
        const int c = 3 - cc;
        float gate[4][4];
#pragma unroll
        for (int m = 0; m < 4; ++m)
#pragma unroll
            for (int j = 0; j < 4; ++j) gate[m][j] = bf2f(*(const LAS bf16_t*)(lds + HG_RAWG + (16 * m + 4 * fq + j) * 256 + (16 * wave + fr) * 2));
        if (cc < 3) hg_load_raw<true, true>(raw, proj, rowbase + (c - 1) * 64, hd, 1, tid);
        if (cc < 3) hg_chunk<1, true, true, true>(lds, accS, o, lbb0, lbb1, dseg0, dseg1, raw, tid, wave, lane);
        else hg_chunk<1, true, false, false>(lds, accS, o, lbb0, lbb1, dseg0, dseg1, raw, tid, wave, lane);
#pragma unroll
        for (int m = 0; m < 4; ++m) { o[m] = o[m] + ofst[c * 2048 + m * 64];
#pragma unroll
            for (int j = 0; j < 4; ++j) { float s = o[m][j] * o[m][j];
                s += __shfl_xor(s, 1); s += __shfl_xor(s, 2); s += __shfl_xor(s, 4); s += __shfl_xor(s, 8);
                if (fr == 0) *(LAS float*)(lds + HG_PART + ((16 * m + 4 * fq + j) * 8 + wave) * 4) = s; } }
        lds_barrier();
#pragma unroll
        for (int m = 0; m < 4; ++m)
#pragma unroll
            for (int j = 0; j < 4; ++j) { const int t = 16 * m + 4 * fq + j;
                const f32x4 p0 = *(const LAS f32x4*)(lds + HG_PART + t * 32), p1 = *(const LAS f32x4*)(lds + HG_PART + t * 32 + 16);
                const float ms = ((p0[0] + p0[1]) + (p0[2] + p0[3]) + (p1[0] + p1[1]) + (p1[2] + p1[3])) * (1.0f / 128.0f);
                *(LAS bf16_t*)(lds + HG_OST + t * QS + (16 * wave + fr) * 2) = (bf16_t)(cvt2(o[m][j] * __builtin_amdgcn_rsqf(ms + LN_EPS) * ng * gate[m][j], 0.f) & 0xffffu); }
        lds_barrier();
#pragma unroll
        for (int i = 0; i < 2; ++i) { const int t = (tid >> 4) + 32 * i, c8 = (tid & 15) * 8;
            *(u32x4*)(mixed + (size_t)(rowbase + c * 64 + t) * DM + 512 + hd * 128 + c8) = *(const LAS u32x4*)(lds + HG_OST + t * QS + c8 * 2); }
    }
}

__device__ __forceinline__ void p_scan_a(LAS unsigned char* lds, const Args& a, int bid, int G, int tid, int wave, int lane, int mask = 3) {
    constexpr int N_HG = NB * 4 * 2 * HG_SEGS, N_RG = NB * RG_UNITS_PER_B;
#pragma unroll 1
    for (int it = bid; it < N_HG + N_RG; it += G) {
        int t2 = tid; asm volatile("" : "+v"(t2)); const int tid = t2, lane = t2 & 63;
        if ((it < N_HG) ? !(mask & 1) : !(mask & 2)) continue;
        if (it < N_HG) { const int sidx = it % HG_SEGS, rest = it / HG_SEGS, dir = rest & 1, hd = (rest >> 1) & 3, b = rest >> 3;
            if (dir == 0) hg_agg_unit<0>(lds, a, b, hd, sidx, it, tid, wave, lane); else hg_agg_unit<1>(lds, a, b, hd, sidx, it, tid, wave, lane); }
        else { const int r = it - N_HG; __syncthreads(); rg_agg_unit(lds, a, r / RG_UNITS_PER_B, r % RG_UNITS_PER_B, tid, wave, lane); }
    }
}
__device__ __forceinline__ void p_scan_b(const Args& a, int bid, int G, int tid, bool dry = false) {
#pragma unroll 1
    for (int it = bid; it < 1024; it += G) hg_carry_item(a, it, tid, dry);
    if (bid >= G - 32) rg_carry_item(a, bid - (G - 32), tid);
}
__device__ __forceinline__ void p_scan_c(LAS unsigned char* lds, const Args& a, int bid, int G, int tid, int wave, int lane, int mask = 3) {
#pragma unroll 1
    for (int it = bid; it < ((mask & 1) ? 1024 : 0); it += G) { const int seg = it & 15, hd = (it >> 4) & 3, b = it >> 6; int t2 = tid; asm volatile("" : "+v"(t2)); hg_final_unit(lds, a, b, hd, seg, t2, wave, t2 & 63); }
#pragma unroll 1
    for (int r = bid; r < ((mask & 2) ? 1024 : 0); r += G) { __syncthreads(); int t2 = tid; asm volatile("" : "+v"(t2)); rg_final_unit(lds, a, r >> 6, r & 63, t2, wave, t2 & 63); }
}

#define GAS __attribute__((address_space(1)))
#define RLX_AGENT __ATOMIC_RELAXED, __HIP_MEMORY_SCOPE_AGENT
#define XB_TMO      128
#define XB_XCNT(j)  (256  + 64 * (j))
#define XB_XSUB(j)  (1280 + 64 * (j))
#define XB_XGEN(j)  (2304 + 64 * (j))
#define XB_TOP      3328
#define XB_TOPGEN   3392
#define XCD_BAR_WORDS 3456
#define XB_SPIN_CAP (1u << 18)

__device__ __forceinline__ unsigned xb_ld(unsigned* p)              { return __hip_atomic_load(p, __ATOMIC_RELAXED, __HIP_MEMORY_SCOPE_AGENT); }
__device__ __forceinline__ unsigned xb_add(unsigned* p, unsigned v) { return __hip_atomic_fetch_add(p, v, __ATOMIC_RELAXED, __HIP_MEMORY_SCOPE_AGENT); }
__device__ __forceinline__ unsigned xb_xcc_id() { return (unsigned)__builtin_amdgcn_s_getreg((3 << 11) | 20) & 0xFu; }
#define XB_SPIN(cond, bar) do { unsigned _sp = 0; while (cond) { __builtin_amdgcn_s_sleep(1); \
    if ((++_sp & 255u) == 0u) { if (xb_ld(&(bar)[XB_TMO])) break; if (_sp > XB_SPIN_CAP) { atomicAdd(&(bar)[XB_TMO], 1u); break; } } } } while (0)

struct XcdBarrier {
    unsigned* bar; unsigned x;
    volatile LAS unsigned* st;
};

__device__ __forceinline__ XcdBarrier xcd_barrier_post(unsigned* bar, volatile LAS unsigned* st) {
    XcdBarrier b; b.bar = bar; b.x = xb_xcc_id(); b.st = st;
    if (threadIdx.x == 0) (void)xb_add(&bar[XB_XCNT(b.x)], 1u);
    return b;
}
__device__ __forceinline__ void xcd_barrier_complete(unsigned* bar, unsigned x, unsigned& nloc, unsigned& nx) {
    const unsigned G = gridDim.x * gridDim.y * gridDim.z;
    unsigned sum, cnt, mine, sp = 0u;
    for (;;) {
        sum = 0u; cnt = 0u; mine = 0u;
#pragma unroll
        for (unsigned j = 0; j < 16; ++j) { const unsigned c = xb_ld(&bar[XB_XCNT(j)]); sum += c; cnt += (c > 0u) ? 1u : 0u; mine = (j == x) ? c : mine; }
        if (sum == G) break;
        __builtin_amdgcn_s_sleep(1);
        if ((++sp & 255u) == 0u) { if (xb_ld(&bar[XB_TMO])) break; if (sp > XB_SPIN_CAP) { atomicAdd(&bar[XB_TMO], 1u); break; } }
    }
    nloc = mine > 0u ? mine : 1u; nx = cnt > 0u ? cnt : 1u;
}

__device__ __forceinline__ void xcd_barrier(const XcdBarrier& b) {
    asm volatile("s_waitcnt vmcnt(0)" ::: "memory");
    __syncthreads();
    if (threadIdx.x == 0) {
        unsigned* bar = b.bar;
        __builtin_amdgcn_s_waitcnt(0);
        unsigned nloc = b.st[0], nx = b.st[1];
        if (nloc == 0u) { xcd_barrier_complete(bar, b.x, nloc, nx); b.st[0] = nloc; b.st[1] = nx; }
        const unsigned old = xb_add(&bar[XB_XSUB(b.x)], 1u);
        const unsigned gen = old / nloc;
        if (old + 1u == (gen + 1u) * nloc) {
            __builtin_amdgcn_fence(__ATOMIC_RELEASE, "agent");
            asm volatile("s_waitcnt vmcnt(0)" ::: "memory");
            const unsigned og = xb_add(&bar[XB_TOP], 1u);
            const unsigned tg = og / nx;
            if (og + 1u == (tg + 1u) * nx) xb_add(&bar[XB_TOPGEN], 1u);
            else XB_SPIN(xb_ld(&bar[XB_TOPGEN]) == tg, bar);
            __builtin_amdgcn_fence(__ATOMIC_ACQUIRE, "agent");
            xb_add(&bar[XB_XGEN(b.x)], 1u);
            asm volatile("s_waitcnt vmcnt(0)" ::: "memory");
        } else {
            XB_SPIN(xb_ld(&bar[XB_XGEN(b.x)]) == gen, bar);
            __builtin_amdgcn_fence(__ATOMIC_ACQUIRE, "agent");
            asm volatile("s_waitcnt vmcnt(0)" ::: "memory");
        }
    }
    __syncthreads();
}


__device__ __forceinline__ void stagger_wait(unsigned ticks) {
    if (ticks == 0u) return;
    const unsigned long long t0 = __builtin_amdgcn_s_memrealtime();
    while (__builtin_amdgcn_s_memrealtime() - t0 < ticks) __builtin_amdgcn_s_sleep(16);
}
#ifndef STAG_P2
#define STAG_P2 0
#endif

__global__ void __launch_bounds__(NTHREADS, 2) mega(Args a) {
    extern __shared__ __attribute__((aligned(16))) unsigned char lds_raw[];
    LAS unsigned char* lds = (LAS unsigned char*)lds_raw;
    cg::grid_group grid = cg::this_grid();
    const int wave = __builtin_amdgcn_readfirstlane(threadIdx.x >> 6), bid = blockIdx.x, G = gridDim.x;
    int tid = threadIdx.x, lane = tid & 63;
#define FRESH_TID() do { tid = threadIdx.x; asm volatile("" : "+v"(tid)); lane = tid & 63; } while (0)
    unsigned char* ws = a.ws;
    volatile LAS unsigned* bst = (volatile LAS unsigned*)(lds + LDS_BYTES - 64);
    if (threadIdx.x < 2) bst[threadIdx.x] = 0u;
    __syncthreads();
    XcdBarrier xbar = xcd_barrier_post((unsigned*)(ws + WS_BAR), bst);
#define GRID_BAR() xcd_barrier(xbar)
    float* mod = (float*)(ws + WS_MOD);
    bf16_t* U = (bf16_t*)(ws + WS_U);
    bf16_t* PROJ = (bf16_t*)(ws + WS_PROJ); bf16_t* MIXED = (bf16_t*)(ws + WS_MIXED);

#ifndef SKIP_P0
    p_mod(lds, a.in[1], a.in[3], a.in[4], a.in[5], mod, bid, G, tid);
    p_transposes(lds, a, bid, G, tid);
    p_gwt(a.in[9], (bf16_t*)(ws + WS_GWT), bid, G, tid);
    p_rgpar(a.in[10], a.in[11], (float*)(ws + WS_RGPAR), bid, G, tid);
    p_wrt(a.in[17], a.in[19], (bf16_t*)(ws + WS_WRT), bid, G, tid);
#endif
#ifdef REP_P0
    grid.sync();
    FRESH_TID();
    p_mod(lds, a.in[1], a.in[3], a.in[4], a.in[5], mod, bid, G, tid);
    p_transposes(lds, a, bid, G, tid);
    p_gwt(a.in[9], (bf16_t*)(ws + WS_GWT), bid, G, tid);
    p_rgpar(a.in[10], a.in[11], (float*)(ws + WS_RGPAR), bid, G, tid);
    p_wrt(a.in[17], a.in[19], (bf16_t*)(ws + WS_WRT), bid, G, tid);
#endif
    GRID_BAR();
    FRESH_TID();
#ifdef REP_SYNC
    for (int r = 0; r < 10; ++r) GRID_BAR();
#endif
#ifndef SKIP_P1
    p_u(a.in[0], a.in[2], mod, U, bid, G, tid);
#endif
#ifdef REP_P1
    GRID_BAR();
    FRESH_TID();
    p_u(a.in[0], a.in[2], mod, U, bid, G, tid);
#endif
    GRID_BAR();
    FRESH_TID();
#ifdef REP_P2X
    { pg8::Gemm g{U, (const bf16_t*)(ws + WS_WINT), TA, NIN, DM}; pg8::StaticOrder S; S.init(TA, NIN, G, bid);
#if REP_P2X == 1
      pg8::EpiNull E{(float*)(ws + WS_OFST)};
      pg8::gemm_phase<pg8::EpiNull, pg8::StaticOrder, true, true>(lds, g, S, E); }
#else
      pg8::EpiInProj E{PROJ, REP_P2X - 1, 0};
      pg8::gemm_phase<pg8::EpiInProj, pg8::StaticOrder, true, true>(lds, g, S, E); }
#endif
    GRID_BAR();
    FRESH_TID();
#endif
#ifndef SKIP_P2
    stagger_wait((unsigned)((bid >> 3) & 7) * STAG_P2);
    { pg8::Gemm g{U, (const bf16_t*)(ws + WS_WINT), TA, NIN, DM}; pg8::StaticOrder S; S.init(TA, NIN, G, bid);
      pg8::EpiInProj E{PROJ, 0, 0};
      pg8::gemm_phase<pg8::EpiInProj, pg8::StaticOrder, true, true>(lds, g, S, E); }
#endif
#ifdef REP_P2
    GRID_BAR();
    FRESH_TID();
    { pg8::Gemm g{U, (const bf16_t*)(ws + WS_WINT), TA, NIN, DM}; pg8::StaticOrder S; S.init(TA, NIN, G, bid);
      pg8::EpiInProj E{PROJ, 0, 0};
      pg8::gemm_phase<pg8::EpiInProj, pg8::StaticOrder, true, true>(lds, g, S, E); }
#endif
    GRID_BAR();
    FRESH_TID();
#ifndef SKIP_P3A
    p_scan_a(lds, a, bid, G, tid, wave, lane);
#endif
#ifdef REP_P3A
    GRID_BAR();
    FRESH_TID();
    p_scan_a(lds, a, bid, G, tid, wave, lane, REP_P3A);
#endif
    GRID_BAR();
    FRESH_TID();
#ifdef REP_P3B
    p_scan_b(a, bid, G, tid, true);
    GRID_BAR();
    FRESH_TID();
#endif
#ifndef SKIP_P3B
    p_scan_b(a, bid, G, tid);
#endif
    GRID_BAR();
    FRESH_TID();
#ifndef SKIP_P3C
    p_scan_c(lds, a, bid, G, tid, wave, lane);
#endif
#ifdef REP_P3C
    GRID_BAR();
    FRESH_TID();
    p_scan_c(lds, a, bid, G, tid, wave, lane, REP_P3C);
#endif
    GRID_BAR();
    FRESH_TID();
#ifndef SKIP_P5
    { pg8::Gemm g{MIXED, (const bf16_t*)(ws + WS_WOUTT), T, DM, DM}; pg8::StaticOrder S; S.init(T, DM, G, bid);
      pg8::EpiY E{(bf16_t*)(ws + WS_XG)};
      pg8::gemm_phase<pg8::EpiY, pg8::StaticOrder, true, true>(lds, g, S, E); }
#endif
#ifdef REP_P5
    GRID_BAR();
    FRESH_TID();
    { pg8::Gemm g{MIXED, (const bf16_t*)(ws + WS_WOUTT), T, DM, DM}; pg8::StaticOrder S; S.init(T, DM, G, bid);
      pg8::EpiY E{(bf16_t*)(ws + WS_XG)};
      pg8::gemm_phase<pg8::EpiY, pg8::StaticOrder, true, true>(lds, g, S, E); }
#endif
    GRID_BAR();
    FRESH_TID();
#ifdef REP_P6
#pragma unroll 1
    for (int rep = 0; rep < 2; ++rep) { p_ln1_router(lds, a, bid, G, tid, wave, lane, rep == 0, rep == 0 ? REP_P6 : 3); if (rep == 0) GRID_BAR(); }
#else
    p_ln1_router(lds, a, bid, G, tid, wave, lane);
#endif
    GRID_BAR();
    FRESH_TID();
#ifndef SKIP_P7
    p_assign(lds, a, bid, G, tid);
#endif
#ifdef REP_P7
    GRID_BAR();
    FRESH_TID();
    p_assign(lds, a, bid, G, tid);
#endif
    GRID_BAR();
    FRESH_TID();
#ifndef SKIP_P8
    { pg8::Gemm g{(const bf16_t*)(ws + WS_U), (const bf16_t*)(ws + WS_W13T), MAXROWS, NE * DM, DM}; pg8::ExpertOrderG S{(const int*)(ws + WS_CTL), (const int*)(ws + WS_ROWTOK), G, bid};
      pg8::EpiExp1 E{(bf16_t*)(ws + WS_HID)};
      pg8::gemm_phase<pg8::EpiExp1, pg8::ExpertOrderG, true, true>(lds, g, S, E); }
#endif
#ifdef REP_P8
    GRID_BAR();
    FRESH_TID();
    { pg8::Gemm g{(const bf16_t*)(ws + WS_U), (const bf16_t*)(ws + WS_W13T), MAXROWS, NE * DM, DM}; pg8::ExpertOrderG S{(const int*)(ws + WS_CTL), (const int*)(ws + WS_ROWTOK), G, bid};
      pg8::EpiExp1 E{(bf16_t*)(ws + WS_HID)};
      pg8::gemm_phase<pg8::EpiExp1, pg8::ExpertOrderG, true, true>(lds, g, S, E); }
#endif
    GRID_BAR();
    FRESH_TID();
#ifndef SKIP_P9
    { pg8::Gemm g{(const bf16_t*)(ws + WS_HID), (const bf16_t*)(ws + WS_W2T), MAXROWS, NE * DM, DE}; pg8::ExpertOrder S{(const int*)(ws + WS_CTL), nullptr, G, bid};
      pg8::EpiY E{(bf16_t*)(ws + WS_Y)};
      pg8::gemm_phase<pg8::EpiY, pg8::ExpertOrder, true, true>(lds, g, S, E); }
#endif
#ifdef REP_P9
    GRID_BAR();
    FRESH_TID();
    { pg8::Gemm g{(const bf16_t*)(ws + WS_HID), (const bf16_t*)(ws + WS_W2T), MAXROWS, NE * DM, DE}; pg8::ExpertOrder S{(const int*)(ws + WS_CTL), nullptr, G, bid};
      pg8::EpiY E{(bf16_t*)(ws + WS_Y)};
      pg8::gemm_phase<pg8::EpiY, pg8::ExpertOrder, true, true>(lds, g, S, E); }
#endif
    GRID_BAR();
    FRESH_TID();
#ifdef REP_P10
    p_combine_ln2(a, bid, G, wave, lane, true);
    GRID_BAR();
    FRESH_TID();
#endif
#ifndef SKIP_P10
    p_combine_ln2(a, bid, G, wave, lane);
#endif
}

extern "C" void kernel_launch(void* const* d_in, const int* in_sizes, int n_in, void* d_out, int out_size, void* d_ws, size_t ws_size, hipStream_t stream) {
    static int grid = 0;
    if (grid == 0) {
        if (n_in != 26 || ws_size < WS_END) { fprintf(stderr, "kernel_launch: unexpected n_in %d or workspace %zu < %zu\n", n_in, ws_size, (size_t)WS_END); grid = -1; return; }
        int dev = 0, cus = 0, per_cu = 0;
        if (hipGetDevice(&dev) != hipSuccess || hipDeviceGetAttribute(&cus, hipDeviceAttributeMultiprocessorCount, dev) != hipSuccess) { grid = -1; return; }
        if (hipFuncSetAttribute((const void*)mega, hipFuncAttributeMaxDynamicSharedMemorySize, LDS_BYTES) != hipSuccess) { fprintf(stderr, "kernel_launch: hipFuncSetAttribute failed\n"); grid = -1; return; }
        if (hipOccupancyMaxActiveBlocksPerMultiprocessor(&per_cu, (const void*)mega, NTHREADS, LDS_BYTES) != hipSuccess || per_cu < 1) { fprintf(stderr, "kernel_launch: occupancy query says %d\n", per_cu); per_cu = 1; }
        (void)hipGetLastError();
        grid = cus;
        fprintf(stderr, "kernel_launch: grid %d (cus %d, per_cu %d), ws %zu\n", grid, cus, per_cu, ws_size);
    }
    if (grid < 0) return;
    (void)hipMemsetAsync(d_ws, 0, 131072, stream);
    Args a{};
    for (int i = 0; i < 26; ++i) a.in[i] = (const float*)d_in[i];
    a.out = (float*)d_out; a.ws = (unsigned char*)d_ws;
    void* params[] = {&a};
    hipError_t e = hipLaunchCooperativeKernel((const void*)mega, dim3(grid), dim3(NTHREADS), params, LDS_BYTES, stream);
    if (e != hipSuccess) fprintf(stderr, "kernel_launch: cooperative launch failed: %s (grid %d)\n", hipGetErrorString(e), grid);
}
```

```cpp
#include <hip/hip_runtime.h>
#include <hip/hip_cooperative_groups.h>
#include <cstdio>
#include <cstdint>
namespace cg = cooperative_groups;

typedef unsigned short bf16_t;
typedef short bf16x8 __attribute__((ext_vector_type(8)));
typedef float f32x4 __attribute__((ext_vector_type(4)));
typedef float f32x2 __attribute__((ext_vector_type(2)));
typedef unsigned u32x4 __attribute__((ext_vector_type(4)));
typedef unsigned u32x2 __attribute__((ext_vector_type(2)));
typedef int i32x4 __attribute__((ext_vector_type(4)));
#define LAS __attribute__((address_space(3)))

constexpr int NB = 16, SEQ = 4096, LC = 256, DM = 1024;
constexpr int T = NB * SEQ;
constexpr int TC = NB * LC;
constexpr int TA = T + TC;
constexpr int NIN = 3584;
constexpr int NE = 32, DE = 512;
constexpr int MAXROWS = 2 * T + NE * 256;
constexpr float ALPHA = 1.189207115002721f;
constexpr float LN_EPS = 1e-6f;
constexpr int NTHREADS = 512;

constexpr size_t MiB = 1u << 20;
constexpr size_t WS_CTL = 0;
constexpr size_t WS_BAR = 65536;
constexpr size_t WS_MOD = 1 * MiB;
constexpr size_t WS_EIDX = 3 * MiB;
constexpr size_t WS_EPOS = 3 * MiB + 512 * 1024;
constexpr size_t WS_EW = 4 * MiB;
constexpr size_t WS_DEST = 4 * MiB + 512 * 1024;
constexpr size_t WS_WINT = 6 * MiB;
constexpr size_t WS_WOUTT = 13 * MiB;
constexpr size_t WS_W13T = 15 * MiB;
constexpr size_t WS_W2T = 79 * MiB;
constexpr size_t WS_U = 112 * MiB;
constexpr size_t WS_PROJ = 248 * MiB;
constexpr size_t WS_XG = 248 * MiB;
constexpr size_t WS_HID = 520 * MiB;
constexpr size_t WS_Y = 656 * MiB;
constexpr size_t WS_MIXED = 724 * MiB;
constexpr size_t WS_OSUM = 852 * MiB;
constexpr size_t WS_END = 980 * MiB;
constexpr int LDS_BYTES = 163840;

__device__ __forceinline__ const bf16_t* proj_at(const bf16_t* P, int row, int col) { return P + (((size_t)(col >> 5) * TA + row) << 5) + (col & 31); }

__device__ __forceinline__ float bf2f(bf16_t b) { return __uint_as_float(((unsigned)b) << 16); }
__device__ __forceinline__ bf16_t f2bf(float f) { unsigned u = __float_as_uint(f); return (bf16_t)((u + 0x7fffu + ((u >> 16) & 1u)) >> 16); }
__device__ __forceinline__ unsigned pk2(float lo, float hi) { return (unsigned)f2bf(lo) | ((unsigned)f2bf(hi) << 16); }
__device__ __forceinline__ float frcp(float x) { return __builtin_amdgcn_rcpf(x); }
__device__ __forceinline__ float sigmoidf_(float x) { return frcp(1.0f + __expf(-x)); }
__device__ __forceinline__ float siluf_(float x) { return x * frcp(1.0f + __expf(-x)); }
__device__ __forceinline__ float gelu_tanh(float x) {
    const float y = 0.7978845608028654f * (x + 0.044715f * x * x * x);
    return x * frcp(1.0f + __expf(-2.0f * y));
}
__device__ __forceinline__ float softplusf_(float x) { return fmaxf(x, 0.f) + log1pf(expf(-fabsf(x))); }
__device__ __forceinline__ float wave_sum(float v) {
#pragma unroll
    for (int o = 1; o < 64; o <<= 1) v += __shfl_xor(v, o);
    return v;
}
constexpr int CSTR = 64;
__device__ __forceinline__ int pstart_of(const int* __restrict__ counts, int e) {
    int acc = 0;
    for (int i = 0; i < NE; ++i) { const int p = ((counts[i * CSTR] + 255) >> 8) << 8; if (i < e) acc += p; }
    return acc;
}

namespace pg8 {
#define PG8_LAS __attribute__((address_space(3)))
typedef unsigned short bf16_t;
typedef short bf16x8 __attribute__((ext_vector_type(8)));
typedef float f32x4 __attribute__((ext_vector_type(4)));
typedef unsigned u32x4 __attribute__((ext_vector_type(4)));
constexpr int BM = 256, BK = 64, HALF = 128, HTB = HALF * BK * 2  , STAGE_BYTES = 8 * HTB, NXCD = 8, WGM = 8;

__host__ __device__ __forceinline__ int lds_byte(int r, int c) { const int st = (r >> 4) * 2 + (c >> 5), rr = r & 15, cc = c & 31, ob = rr * 64 + cc * 2; return st * 1024 + (ob ^ (((ob >> 9) & 1) << 5)); }
__host__ __device__ __forceinline__ void stage_rc(int b, int& R, int& C) { const int st = b / 1024, sb = b % 1024, swz = sb ^ (((sb >> 9) & 1) << 5); R = (st >> 1) * 16 + swz / 64; C = (st & 1) * 32 + (swz % 64) / 2; }
__host__ __device__ __forceinline__ int perm32(int rho) { const int n = rho >> 4, i = rho & 15; return 8 * (i >> 2) + 4 * n + (i & 3); }

struct Unit { int pm, pn; };
struct Gemm { const bf16_t* A; const bf16_t* Bt; int M, N, K; };

struct StaticOrder {
    static constexpr bool GATHER = false; const int* rowtok = nullptr;
    int nM, nN, nwg, G, c;
    __host__ __device__ void init(int M, int N, int G_, int c_) { nM = M / BM; nN = N / BM; nwg = nM * nN; G = G_; c = c_; }
    __host__ __device__ bool next(int i, Unit& u) const {
        const long L = (long)i * G + c; if (L >= nwg) return false;
        int wgid = (int)L; { const int q = nwg / NXCD, r = nwg % NXCD, xcd = wgid % NXCD, off = wgid / NXCD; wgid = (xcd < r ? xcd * (q + 1) : r * (q + 1) + (xcd - r) * q) + off; }
        const int nig = WGM * nN, gid = wgid / nig, fm = gid * WGM, gsz = (nM - fm) < WGM ? (nM - fm) : WGM;
        u.pm = fm + ((wgid % nig) % gsz); u.pn = (wgid % nig) / gsz; return true;
    }
    __device__ __forceinline__ void a_ready(const Unit&) const {}
    __device__ __forceinline__ void done(const Unit&) const {}
};

__device__ __forceinline__ unsigned cvt_pk_bf16(float lo, float hi) { unsigned r; asm volatile("v_cvt_pk_bf16_f32 %0, %1, %2" : "=v"(r) : "v"(lo), "v"(hi)); return r; }

struct EpiInProj {
    static constexpr bool PERM = true, AFTER_DRAIN = false;
    bf16_t* P; int variant; int pad;
    __device__ __forceinline__ void operator()(const f32x4 (&acc)[2][2][4][2], const Unit& u, int wr, int wc, int fr_, int fq_) const {
        int fr = fr_, fq = fq_; asm volatile("" : "+v"(fr), "+v"(fq));
        const int row0 = u.pm * BM + wr * 64 + fr, col0 = u.pn * BM + wc * 32 + 8 * fq, grp = variant == 1 ? 0 : (u.pn >> 1);
#pragma unroll
        for (int ai = 0; ai < 2; ++ai)
#pragma unroll
            for (int m = 0; m < 4; ++m) { bf16_t* rowp = P + (((size_t)(8 * u.pn + wc) * TA + (row0 + ai * HALF + m * 16)) << 5) + 8 * fq;
#pragma unroll
                for (int bj = 0; bj < 2; ++bj) { f32x4 v0 = acc[ai][bj][m][0], v1 = acc[ai][bj][m][1];
                    if (grp == 1) {
#pragma unroll
                        for (int j = 0; j < 4; ++j) { v0[j] = gelu_tanh(v0[j]); v1[j] = gelu_tanh(v1[j]); } }
                    else if (grp == 2 || grp == 6) {
#pragma unroll
                        for (int j = 0; j < 4; ++j) { v0[j] = siluf_(v0[j]); v1[j] = siluf_(v1[j]); } }
                    u32x4 w; w.x = cvt_pk_bf16(v0[0], v0[1]); w.y = cvt_pk_bf16(v0[2], v0[3]); w.z = cvt_pk_bf16(v1[0], v1[1]); w.w = cvt_pk_bf16(v1[2], v1[3]);
                    if (variant == 3) { const int wv = __builtin_amdgcn_readfirstlane(threadIdx.x >> 6); *(u32x4*)(P + ((size_t)((u.pm * 14 + u.pn) * 8 + wv) * 16 + (ai * 4 + m) * 2 + bj) * 512 + (threadIdx.x & 63) * 8) = w; }
                    else if (variant != 2 || w.x == 0x12345678u) *(u32x4*)(rowp + (size_t)bj * 4 * TA * 32) = w; } }
    }
};
struct EpiNull {
    static constexpr bool PERM = true, AFTER_DRAIN = false;
    float* sink;
    __device__ __forceinline__ void operator()(const f32x4 (&acc)[2][2][4][2], const Unit& u, int wr, int wc, int fr_, int fq_) const {
        float s = 0.f;
#pragma unroll
        for (int ai = 0; ai < 2; ++ai)
#pragma unroll
            for (int bj = 0; bj < 2; ++bj)
#pragma unroll
                for (int m = 0; m < 4; ++m)
#pragma unroll
                    for (int n = 0; n < 2; ++n) s += acc[ai][bj][m][n][0] + acc[ai][bj][m][n][1] + acc[ai][bj][m][n][2] + acc[ai][bj][m][n][3];
        if (s == 123.456f) sink[0] = s;
    }
};
struct EpiF32 {
    static constexpr bool PERM = false, AFTER_DRAIN = false;
    float* C; int ldc; int pad;
    __device__ __forceinline__ void operator()(const f32x4 (&acc)[2][2][4][2], const Unit& u, int wr, int wc, int fr_, int fq_) const {
        int fr = fr_, fq = fq_; asm volatile("" : "+v"(fr), "+v"(fq));
        const int row0 = u.pm * BM + wr * 64 + fr, col0 = u.pn * BM + wc * 32 + 4 * fq;
#pragma unroll
        for (int ai = 0; ai < 2; ++ai)
#pragma unroll
            for (int m = 0; m < 4; ++m) { float* rowp = C + (size_t)(row0 + ai * HALF + m * 16) * ldc + col0;
#pragma unroll
                for (int bj = 0; bj < 2; ++bj)
#pragma unroll
                    for (int n = 0; n < 2; ++n) *(f32x4*)(rowp + bj * HALF + n * 16) = acc[ai][bj][m][n]; }
    }
};
struct EpiExp1 {
    static constexpr bool PERM = false, AFTER_DRAIN = false;
    bf16_t* H;
    __device__ __forceinline__ void operator()(const f32x4 (&acc)[2][2][4][2], const Unit& u, int wr, int wc, int fr_, int fq_) const {
        int fr = fr_, fq = fq_; asm volatile("" : "+v"(fr), "+v"(fq));
        const int row0 = u.pm * BM + wr * 64 + fr, hc0 = (((u.pn & 3) * BM + wc * 32) >> 1) + 4 * fq;
#pragma unroll
        for (int ai = 0; ai < 2; ++ai)
#pragma unroll
            for (int m = 0; m < 4; ++m) { bf16_t* rowp = H + (size_t)(row0 + ai * HALF + m * 16) * DE + hc0;
#pragma unroll
                for (int bj = 0; bj < 2; ++bj) { const f32x4 a = acc[ai][bj][m][0], b = acc[ai][bj][m][1];
                    u32x2 w; w.x = cvt_pk_bf16(siluf_(a[0]) * b[0], siluf_(a[1]) * b[1]); w.y = cvt_pk_bf16(siluf_(a[2]) * b[2], siluf_(a[3]) * b[3]);
                    *(u32x2*)(rowp + bj * 64) = w; } }
    }
};
struct EpiY {
    static constexpr bool PERM = true, AFTER_DRAIN = false;
    bf16_t* Y;
    __device__ __forceinline__ void operator()(const f32x4 (&acc)[2][2][4][2], const Unit& u, int wr, int wc, int fr_, int fq_) const {
        int fr = fr_, fq = fq_; asm volatile("" : "+v"(fr), "+v"(fq));
        const int row0 = u.pm * BM + wr * 64 + fr, col0 = (u.pn & 3) * BM + wc * 32 + 8 * fq;
#pragma unroll
        for (int ai = 0; ai < 2; ++ai)
#pragma unroll
            for (int m = 0; m < 4; ++m) { bf16_t* rowp = Y + (size_t)(row0 + ai * HALF + m * 16) * DM + col0;
#pragma unroll
                for (int bj = 0; bj < 2; ++bj) { const f32x4 v0 = acc[ai][bj][m][0], v1 = acc[ai][bj][m][1];
                    u32x4 w; w.x = cvt_pk_bf16(v0[0], v0[1]); w.y = cvt_pk_bf16(v0[2], v0[3]); w.z = cvt_pk_bf16(v1[0], v1[1]); w.w = cvt_pk_bf16(v1[2], v1[3]);
                    *(u32x4*)(rowp + bj * HALF) = w; } }
    }
};
template <bool GATHER_>
struct ExpertOrderT {
    static constexpr bool GATHER = GATHER_;
    const int* counts; const int* rowtok; int G, c;
    __device__ __forceinline__ bool next(int i, Unit& u) const {
        const int L = i * G + c, rb = L >> 2; int acc = 0, ef = -1;
        for (int e = 0; e < NE; ++e) { const int nb = (counts[e * CSTR] + 255) >> 8; if (rb >= acc && rb < acc + nb) ef = e; acc += nb; }
        if (ef < 0) return false;
        u.pm = rb; u.pn = ef * 4 + (L & 3); return true;
    }
    __device__ __forceinline__ void a_ready(const Unit&) const {}
    __device__ __forceinline__ void done(const Unit&) const {}
};
typedef ExpertOrderT<false> ExpertOrder;
typedef ExpertOrderT<true> ExpertOrderG;

template <class Epi, class Sched, bool ALIGN_EPI = false, bool SP2 = false>
__device__ __forceinline__ void gemm_phase(PG8_LAS unsigned char* lds, const Gemm g, const Sched& S, const Epi& E) {
    int tid_o = threadIdx.x; asm volatile("" : "+v"(tid_o));
    const int tid = tid_o, wid = __builtin_amdgcn_readfirstlane(tid >> 6), lane = tid & 63, wr = wid >> 2, wc = wid & 3, fr = lane & 15, fq = lane >> 4;
    static_assert(SP2 || !Sched::GATHER, "the gathered A operand is wired into the SP2 loop only");
    const int K = g.K, nt = K / BK;
    unsigned voffA[2], voffB[2];
    unsigned gAc[2][2], gAn[2][2]; int gR[2], gC[2];
#pragma unroll
    for (int i = 0; i < 2; ++i) { int R, C; stage_rc(tid * 16 + i * 8192, R, C); const int Rb = Epi::PERM ? ((R & ~31) + perm32(R & 31)) : R;
        voffA[i] = (unsigned)(R * K + C) * 2u; voffB[i] = (unsigned)(Rb * K + C) * 2u; gR[i] = R; gC[i] = C; }
    const size_t kstep = (size_t)(BK * 2);
    const size_t hstep = (size_t)HALF * K * 2;
    const size_t tstep = 2 * hstep;
    const unsigned ldsw = (unsigned)wid * 1024u;
    const int aoff = lds_byte(wr * 64 + fr, fq * 8), boff = lds_byte(wc * 32 + fr, fq * 8);
#define PG8_SA(b, h) (((b) * 2 + (h)) * HTB)
#define PG8_SB(b, h) ((4 + (b) * 2 + (h)) * HTB)
#define PG8_STAGE(bufoff, gbase, voff) do { _Pragma("unroll") for (int _i = 0; _i < 2; ++_i) \
        __builtin_amdgcn_global_load_lds((const unsigned*)((const char*)(gbase) + (voff)[_i]), (PG8_LAS unsigned*)(lds + (bufoff) + ldsw + _i * 8192), 16, 0, 0); } while (0)
#define PG8_STAGE_A(bufoff, ptr, h, goff) do { if constexpr (Sched::GATHER) { PG8_STAGE(bufoff, ptr, (goff)[h]); } else { PG8_STAGE(bufoff, (ptr) + (h) * hstep, voffA); } } while (0)
#define PG8_GLOAD(dst, u) do { _Pragma("unroll") for (int _h = 0; _h < 2; ++_h) _Pragma("unroll") for (int _i = 0; _i < 2; ++_i) \
        dst[_h][_i] = (unsigned)S.rowtok[(u).pm * BM + _h * HALF + gR[_i]] * (unsigned)(K * 2) + (unsigned)(gC[_i] * 2); } while (0)
#define PG8_LDA(dst, b, h) do { _Pragma("unroll") for (int m = 0; m < 4; ++m) _Pragma("unroll") for (int k = 0; k < 2; ++k) dst[m][k] = *(const PG8_LAS bf16x8*)(lds + PG8_SA(b, h) + aoff + m * 2048 + k * 1024); } while (0)
#define PG8_LDB(dst, b, h) do { _Pragma("unroll") for (int n = 0; n < 2; ++n) _Pragma("unroll") for (int k = 0; k < 2; ++k) dst[n][k] = *(const PG8_LAS bf16x8*)(lds + PG8_SB(b, h) + boff + n * 2048 + k * 1024); } while (0)
#define PG8_MMA(ai, bj, At, Bt) do { __builtin_amdgcn_s_setprio(1); _Pragma("unroll") for (int m = 0; m < 4; ++m) _Pragma("unroll") for (int n = 0; n < 2; ++n) _Pragma("unroll") for (int k = 0; k < 2; ++k) \
        acc[ai][bj][m][n] = __builtin_amdgcn_mfma_f32_16x16x32_bf16(Bt[n][k], At[m][k], acc[ai][bj][m][n], 0, 0, 0); __builtin_amdgcn_s_setprio(0); } while (0)
#define PG8_WAIT_V(n) asm volatile("s_waitcnt vmcnt(" #n ")" ::: "memory")
#define PG8_WAIT_L(n) asm volatile("s_waitcnt lgkmcnt(" #n ")" ::: "memory")
#define PG8_BAR __builtin_amdgcn_s_barrier()
#define PG8_SCHED __builtin_amdgcn_sched_barrier(0)
    Unit cur, nxt; int ui = 0;
    if (!S.next(0, cur)) return;
    f32x4 acc[2][2][4][2];
#pragma unroll
    for (int a = 0; a < 2; ++a)
#pragma unroll
        for (int b = 0; b < 2; ++b)
#pragma unroll
            for (int m = 0; m < 4; ++m)
#pragma unroll
                for (int n = 0; n < 2; ++n) acc[a][b][m][n] = (f32x4){0.f, 0.f, 0.f, 0.f};
    bf16x8 At[4][2], B0[2][2], B1[2][2];
    const char* cA = (const char*)g.A + (Sched::GATHER ? (size_t)0 : (size_t)cur.pm * tstep); const char* cB = (const char*)g.Bt + (size_t)cur.pn * tstep;
    if constexpr (Sched::GATHER) { PG8_GLOAD(gAc, cur); }
    S.a_ready(cur);
    if constexpr (SP2) {
        PG8_STAGE(PG8_SB(0, 0), cB, voffB); PG8_STAGE(PG8_SB(0, 1), cB + hstep, voffB); PG8_STAGE_A(PG8_SA(0, 0), cA, 0, gAc); PG8_STAGE_A(PG8_SA(0, 1), cA, 1, gAc);
        if (wr == 1) PG8_BAR;
        PG8_WAIT_V(2); PG8_BAR;
        PG8_STAGE(PG8_SB(1, 0), cB + kstep, voffB); PG8_STAGE_A(PG8_SA(1, 0), cA + kstep, 0, gAc); PG8_STAGE(PG8_SB(1, 1), cB + hstep + kstep, voffB);
        PG8_WAIT_V(6); PG8_BAR;
    } else {
        PG8_STAGE(PG8_SB(0, 0), cB, voffB); PG8_STAGE(PG8_SA(0, 0), cA, voffA); PG8_STAGE(PG8_SB(0, 1), cB + hstep, voffB); PG8_STAGE(PG8_SA(0, 1), cA + hstep, voffA);
        if (wr == 1) PG8_BAR;
        PG8_WAIT_V(4); PG8_BAR;
        PG8_STAGE(PG8_SB(1, 0), cB + kstep, voffB); PG8_STAGE(PG8_SA(1, 0), cA + kstep, voffA); PG8_STAGE(PG8_SB(1, 1), cB + hstep + kstep, voffB);
        PG8_WAIT_V(6); PG8_BAR;
    }
    for (;;) {
        const bool has_next = S.next(ui + 1, nxt);
        const char* nA = (has_next && !Sched::GATHER) ? (const char*)g.A + (size_t)nxt.pm * tstep : cA;
        if constexpr (Sched::GATHER) { if (has_next) { PG8_GLOAD(gAn, nxt); } else { _Pragma("unroll") for (int _h = 0; _h < 2; ++_h) _Pragma("unroll") for (int _i = 0; _i < 2; ++_i) gAn[_h][_i] = gAc[_h][_i]; } }
        const char* nB = has_next ? (const char*)g.Bt + (size_t)nxt.pn * tstep : cB;
        for (int t = 0; t < nt; t += 2) {
            const bool last = (t == nt - 2);
            const char* a1 = cA + (size_t)(t + 1) * kstep;
            const char* a2 = last ? nA : cA + (size_t)(t + 2) * kstep; const char* b2 = last ? nB : cB + (size_t)(t + 2) * kstep;
            const char* a3 = a2 + kstep; const char* b3 = b2 + kstep;
            if (last && has_next) S.a_ready(nxt);
            unsigned g2[2][2];
            if constexpr (Sched::GATHER) { _Pragma("unroll") for (int _h = 0; _h < 2; ++_h) _Pragma("unroll") for (int _i = 0; _i < 2; ++_i) g2[_h][_i] = last ? gAn[_h][_i] : gAc[_h][_i]; }
            if constexpr (SP2) {
            PG8_LDB(B0, 0, 0); PG8_LDB(B1, 0, 1); PG8_SCHED; PG8_LDA(At, 0, 0); PG8_STAGE_A(PG8_SA(1, 1), a1, 1, gAc);
            PG8_WAIT_V(8); PG8_WAIT_L(0); PG8_BAR; PG8_MMA(0, 0, At, B0); PG8_MMA(0, 1, At, B1); PG8_BAR; PG8_SCHED;
            PG8_LDA(At, 0, 1); PG8_STAGE(PG8_SB(0, 0), b2, voffB); PG8_STAGE(PG8_SB(0, 1), b2 + hstep, voffB); PG8_STAGE_A(PG8_SA(0, 0), a2, 0, g2);
            PG8_WAIT_V(8); PG8_WAIT_L(0); PG8_BAR; PG8_MMA(1, 0, At, B0); PG8_MMA(1, 1, At, B1); PG8_BAR; PG8_SCHED;
            PG8_LDB(B0, 1, 0); PG8_LDB(B1, 1, 1); PG8_SCHED; PG8_LDA(At, 1, 0); PG8_STAGE_A(PG8_SA(0, 1), a2, 1, g2);
            PG8_WAIT_V(8); PG8_WAIT_L(0); PG8_BAR; PG8_MMA(0, 0, At, B0); PG8_MMA(0, 1, At, B1); PG8_BAR; PG8_SCHED;
            PG8_LDA(At, 1, 1); PG8_STAGE(PG8_SB(1, 0), b3, voffB); PG8_STAGE(PG8_SB(1, 1), b3 + hstep, voffB); PG8_STAGE_A(PG8_SA(1, 0), a3, 0, g2);
            PG8_WAIT_V(8); PG8_WAIT_L(0); PG8_BAR; PG8_MMA(1, 0, At, B0); PG8_MMA(1, 1, At, B1); PG8_BAR; PG8_SCHED;
            } else {
            PG8_LDB(B0, 0, 0); PG8_SCHED; PG8_LDA(At, 0, 0); PG8_STAGE(PG8_SA(1, 1), a1 + hstep, voffA);
            PG8_WAIT_L(8); PG8_BAR; PG8_WAIT_L(0); PG8_MMA(0, 0, At, B0); PG8_BAR; PG8_SCHED;
            PG8_LDB(B1, 0, 1); PG8_STAGE(PG8_SB(0, 0), b2, voffB);
            PG8_BAR; PG8_WAIT_L(0); PG8_MMA(0, 1, At, B1); PG8_BAR;
            PG8_LDA(At, 0, 1); PG8_STAGE(PG8_SA(0, 0), a2, voffA);
            PG8_BAR; PG8_WAIT_L(0); PG8_MMA(1, 0, At, B0); PG8_BAR; PG8_SCHED;
            PG8_STAGE(PG8_SB(0, 1), b2 + hstep, voffB);
            PG8_WAIT_V(6); PG8_BAR; PG8_MMA(1, 1, At, B1); PG8_BAR;
            PG8_LDB(B0, 1, 0); PG8_SCHED; PG8_LDA(At, 1, 0); PG8_STAGE(PG8_SA(0, 1), a2 + hstep, voffA);
            PG8_WAIT_L(8); PG8_BAR; PG8_WAIT_L(0); PG8_MMA(0, 0, At, B0); PG8_BAR; PG8_SCHED;
            PG8_LDB(B1, 1, 1); PG8_STAGE(PG8_SB(1, 0), b3, voffB);
            PG8_BAR; PG8_WAIT_L(0); PG8_MMA(0, 1, At, B1); PG8_BAR;
            PG8_LDA(At, 1, 1); PG8_STAGE(PG8_SA(1, 0), a3, voffA);
            PG8_BAR; PG8_WAIT_L(0); PG8_MMA(1, 0, At, B0); PG8_BAR; PG8_SCHED;
            PG8_STAGE(PG8_SB(1, 1), b3 + hstep, voffB);
            PG8_WAIT_V(6); PG8_BAR; PG8_MMA(1, 1, At, B1); PG8_BAR;
            }
        }
        if constexpr (ALIGN_EPI) { if (wr == 0) PG8_BAR; }
        if constexpr (!Epi::AFTER_DRAIN) { E(acc, cur, wr, wc, fr, fq); S.done(cur); }
        if (!has_next) break;
#pragma unroll
        for (int a = 0; a < 2; ++a)
#pragma unroll
            for (int b = 0; b < 2; ++b)
#pragma unroll
                for (int m = 0; m < 4; ++m)
#pragma unroll
                    for (int n = 0; n < 2; ++n) acc[a][b][m][n] = (f32x4){0.f, 0.f, 0.f, 0.f};
        cur = nxt; cA = nA; cB = nB; ++ui;
        if constexpr (Sched::GATHER) { _Pragma("unroll") for (int _h = 0; _h < 2; ++_h) _Pragma("unroll") for (int _i = 0; _i < 2; ++_i) gAc[_h][_i] = gAn[_h][_i]; }
        if constexpr (ALIGN_EPI) { if (wr == 1) PG8_BAR; }
    }
    PG8_WAIT_V(0);
    if constexpr (!ALIGN_EPI) { if (wr == 0) PG8_BAR; }
    PG8_BAR;
    if constexpr (Epi::AFTER_DRAIN) { E.fused(acc, cur, wr, wc, fr, fq, lds, wid, lane); S.done(cur); }
#undef PG8_SA
#undef PG8_SB
#undef PG8_STAGE
#undef PG8_STAGE_A
#undef PG8_GLOAD
#undef PG8_LDA
#undef PG8_LDB
#undef PG8_MMA
#undef PG8_WAIT_V
#undef PG8_WAIT_L
#undef PG8_BAR
#undef PG8_SCHED
}
}

struct Args { const float* in[26]; float* out; unsigned char* ws; };

__device__ __forceinline__ void p_mod(LAS unsigned char* lds, const float* __restrict__ c, const float* __restrict__ c_ctx, const float* __restrict__ ada_w,
                                      const float* __restrict__ ada_b, float* __restrict__ mod, int bid, int G, int tid) {
    if (bid >= 96) return;
    LAS float* s = (LAS float*)lds;
    LAS float* red = s + 17 * 1024;
    for (int i = tid; i < 17 * 1024; i += NTHREADS) { const int r = i >> 10, k = i & 1023; const float v = r < NB ? c[r * DM + k] : c_ctx[k]; s[i] = v / (1.0f + expf(-v)); }
    __syncthreads();
    for (int it = bid; it < 96; it += G) {
        const int cc = tid & 63, kg = tid >> 6, col = it * 64 + cc;
        float acc[17];
#pragma unroll
        for (int r = 0; r < 17; ++r) acc[r] = 0.f;
        for (int k = kg * 128; k < kg * 128 + 128; ++k) {
            const float w = ada_w[(size_t)k * 6144 + col];
#pragma unroll
            for (int r = 0; r < 17; ++r) acc[r] += s[r * 1024 + k] * w;
        }
#pragma unroll
        for (int r = 0; r < 17; ++r) red[(kg * 17 + r) * 64 + cc] = acc[r];
        __syncthreads();
        for (int i = tid; i < 17 * 64; i += NTHREADS) {
            const int r = i >> 6, c2 = i & 63; float sum = 0.f;
#pragma unroll
            for (int g = 0; g < 8; ++g) sum += red[(g * 17 + r) * 64 + c2];
            mod[(size_t)r * 6144 + it * 64 + c2] = sum + ada_b[it * 64 + c2];
        }
        __syncthreads();
    }
}

struct TrTile { const float* W; bf16_t* O; int K, N, mode, k0, n0; };
__device__ __forceinline__ TrTile tr_decode(const Args& a, int r) {
    unsigned char* ws = a.ws;
    constexpr int I_IN = 16 * 56, I_OUT = 16 * 16, I_E = 32 * 128;
    TrTile t;
    if (r < I_IN) { t = TrTile{a.in[6], (bf16_t*)(ws + WS_WINT), DM, NIN, 0, (r & 15) * 64, (r >> 4) * 64}; return t; } r -= I_IN;
    if (r < I_OUT) { t = TrTile{a.in[14], (bf16_t*)(ws + WS_WOUTT), DM, DM, 0, (r & 15) * 64, (r >> 4) * 64}; return t; } r -= I_OUT;
    if (r < I_E) { const int e = r >> 7, q = r & 127; t = TrTile{a.in[21] + (size_t)e * DM * DE, (bf16_t*)(ws + WS_W13T) + (size_t)e * DM * DM, DM, DE, 1, (q & 15) * 64, (q >> 4) * 64}; return t; } r -= I_E;
    if (r < I_E) { const int e = r >> 7, q = r & 127; t = TrTile{a.in[22] + (size_t)e * DM * DE, (bf16_t*)(ws + WS_W13T) + (size_t)e * DM * DM, DM, DE, 2, (q & 15) * 64, (q >> 4) * 64}; return t; } r -= I_E;
    { const int e = r >> 7, q = r & 127; t = TrTile{a.in[23] + (size_t)e * DE * DM, (bf16_t*)(ws + WS_W2T) + (size_t)e * DM * DE, DE, DM, 0, (q & 7) * 64, (q >> 3) * 64}; return t; }
}
__device__ __forceinline__ void p_transposes(LAS unsigned char* lds, const Args& a, int bid, int G, int tid) {
    constexpr int NITEMS = (16 * 56 + 16 * 16 + 3 * 32 * 128) / 4;
    const int lrow = tid >> 4, lc4 = (tid & 15) * 4;
    const int sc = tid & 7, sn = tid >> 3;
    for (int it = bid; it < NITEMS; it += G) {
        f32x4 v[4][2]; TrTile t[4];
#pragma unroll
        for (int q = 0; q < 4; ++q) { t[q] = tr_decode(a, it * 4 + q);
#pragma unroll
            for (int h = 0; h < 2; ++h) v[q][h] = *(const f32x4*)(t[q].W + (size_t)(t[q].k0 + lrow + 32 * h) * t[q].N + t[q].n0 + lc4); }
        __syncthreads();
#pragma unroll
        for (int q = 0; q < 4; ++q) { LAS float* tile = (LAS float*)lds + q * (64 * 65);
#pragma unroll
            for (int h = 0; h < 2; ++h)
#pragma unroll
                for (int j = 0; j < 4; ++j) tile[(lrow + 32 * h) * 65 + lc4 + j] = v[q][h][j]; }
        __syncthreads();
#pragma unroll
        for (int q = 0; q < 4; ++q) { const LAS float* tile = (const LAS float*)lds + q * (64 * 65) + (8 * sc) * 65 + sn;
            const int n = t[q].n0 + sn, mode = t[q].mode;
            const int orow = mode == 0 ? n : ((n >> 4) * 32 + (mode == 2 ? 16 : 0) + (n & 15));
            u32x4 w; w.x = pk2(tile[0 * 65], tile[1 * 65]); w.y = pk2(tile[2 * 65], tile[3 * 65]); w.z = pk2(tile[4 * 65], tile[5 * 65]); w.w = pk2(tile[6 * 65], tile[7 * 65]);
            *(u32x4*)(t[q].O + (size_t)orow * t[q].K + t[q].k0 + 8 * sc) = w; }
    }
    __syncthreads();
}

__device__ __forceinline__ void p_u(const float* __restrict__ x, const float* __restrict__ ctx, const float* __restrict__ mod, bf16_t* __restrict__ U, int bid, int G, int tid) {
    const int c8 = (tid & 127) * 8, rsub = tid >> 7;
    for (int row0 = bid * 16; row0 < TA; row0 += G * 16) {
        f32x4 v[4][2];
#pragma unroll
        for (int q = 0; q < 4; ++q) { const int row = row0 + q * 4 + rsub; const float* src = row < T ? x + (size_t)row * DM : ctx + (size_t)(row - T) * DM;
            v[q][0] = *(const f32x4*)(src + c8); v[q][1] = *(const f32x4*)(src + c8 + 4); }
#pragma unroll
        for (int q = 0; q < 4; ++q) { const int row = row0 + q * 4 + rsub; const float* m = mod + (size_t)(row < T ? row / SEQ : 16) * 6144;
            const f32x4 sh0 = *(const f32x4*)(m + c8), sh1 = *(const f32x4*)(m + c8 + 4), sc0 = *(const f32x4*)(m + 1024 + c8), sc1 = *(const f32x4*)(m + 1024 + c8 + 4);
            const f32x4 u0 = v[q][0] * (1.0f + sc0) + sh0, u1 = v[q][1] * (1.0f + sc1) + sh1;
            u32x4 w; w.x = pk2(u0[0], u0[1]); w.y = pk2(u0[2], u0[3]); w.z = pk2(u1[0], u1[1]); w.w = pk2(u1[2], u1[3]);
            *(u32x4*)(U + (size_t)row * DM + c8) = w; }
    }
}

constexpr size_t WS_H1 = WS_XG + 128 * MiB;
constexpr size_t WS_WRT = 878 * MiB;
__device__ __forceinline__ void p_wrt(const float* __restrict__ rgw, const float* __restrict__ rew, bf16_t* __restrict__ wrt, int bid, int G, int tid) {
    for (int o = bid * NTHREADS + tid; o < 48 * 1024; o += G * NTHREADS) { const int e = o >> 10, k = o & 1023;
        const float w = e < 4 ? rgw[k * 4 + e] : (e < 36 ? rew[k * 32 + (e - 4)] : 0.f);
        const bf16_t hi = f2bf(w); wrt[o] = hi; wrt[48 * 1024 + o] = f2bf(w - bf2f(hi)); }
}
__device__ __forceinline__ void p_ln1_router(LAS unsigned char* lds, const Args& a, int bid, int G, int tid, int wave, int lane, bool dry = false, int parts = 3) {
    const float* __restrict__ x = a.in[0]; const bf16_t* yb = (const bf16_t*)(a.ws + WS_XG); bf16_t* h1o = (bf16_t*)(a.ws + (dry ? WS_HID : WS_H1)); const float* mod = (const float*)(a.ws + WS_MOD);
    const float* __restrict__ ln_g = a.in[15]; const float* __restrict__ ln_b = a.in[16]; const float* __restrict__ rgb = a.in[18]; const float* __restrict__ reb = a.in[20];
    bf16_t* U2 = (bf16_t*)(a.ws + (dry ? WS_Y + 16 * MiB : WS_U)); int* counts = (int*)(a.ws + WS_CTL) + (dry ? 32 * CSTR : 0);
    int2* eidx = (int2*)(a.ws + (dry ? WS_Y : WS_EIDX)); int2* epos = (int2*)(a.ws + (dry ? WS_Y + 4 * MiB : WS_EPOS)); float2* ew = (float2*)(a.ws + (dry ? WS_Y + 8 * MiB : WS_EW));
    const bf16_t* __restrict__ wrt = (const bf16_t*)(a.ws + WS_WRT);
    constexpr int WB_STRIDE = 528;
    LAS unsigned char* WB = lds;
    LAS float* LG = (LAS float*)(lds + 51200);
    LAS int* lcnt = (LAS int*)(lds + 102400);
    LAS int* lbase = lcnt + 32;
    LAS i32x4* tinfo = (LAS i32x4*)(lbase + 32);
    LAS f32x2* tw = (LAS f32x2*)(tinfo + 256);
    if (tid < 32) lcnt[tid] = 0;
    for (int blk = bid; blk < T / 256; blk += G) {
        const int tokb = blk * 256;
        const float* m = mod + (size_t)(tokb / SEQ) * 6144;
        if (parts & 1) {
            f32x4 xr[2][4]; u32x2 yr[2][4];
#pragma unroll
            for (int t = 0; t < 2; ++t)
#pragma unroll
                for (int j = 0; j < 4; ++j) { const int c4 = 4 * lane + 256 * j; const int tok = tokb + wave * 32 + t;
                    xr[t][j] = *(const f32x4*)(x + (size_t)tok * DM + c4); yr[t][j] = *(const u32x2*)(yb + (size_t)tok * DM + c4); }
#pragma unroll 1
            for (int it = 0; it < 16; ++it) {
                int l2 = lane; asm volatile("" : "+v"(l2)); const int lane = l2;
                const int tok0 = tokb + wave * 32 + 2 * it;
                f32x4 v[2][4]; float s[2] = {0.f, 0.f};
#pragma unroll
                for (int t = 0; t < 2; ++t)
#pragma unroll
                    for (int j = 0; j < 4; ++j) { const int c4 = 4 * lane + 256 * j;
                        const f32x4 g1 = *(const f32x4*)(m + 2048 + c4); const u32x2 yw = yr[t][j];
                        const f32x4 yv = (f32x4){__uint_as_float(yw.x << 16), __uint_as_float(yw.x & 0xffff0000u), __uint_as_float(yw.y << 16), __uint_as_float(yw.y & 0xffff0000u)};
                        v[t][j] = ALPHA * xr[t][j] + g1 * yv; s[t] += (v[t][j][0] + v[t][j][1]) + (v[t][j][2] + v[t][j][3]); }
                if (it < 15) {
#pragma unroll
                    for (int t = 0; t < 2; ++t)
#pragma unroll
                        for (int j = 0; j < 4; ++j) { const int c4 = 4 * lane + 256 * j; const int tok = tok0 + 2 + t;
                            xr[t][j] = *(const f32x4*)(x + (size_t)tok * DM + c4); yr[t][j] = *(const u32x2*)(yb + (size_t)tok * DM + c4); }
                }
                float rstd[2];
#pragma unroll
                for (int t = 0; t < 2; ++t) { const float mean = wave_sum(s[t]) * (1.0f / DM); float s2 = 0.f;
#pragma unroll
                    for (int j = 0; j < 4; ++j) { v[t][j] = v[t][j] - mean; s2 += (v[t][j][0] * v[t][j][0] + v[t][j][1] * v[t][j][1]) + (v[t][j][2] * v[t][j][2] + v[t][j][3] * v[t][j][3]); }
                    rstd[t] = rsqrtf(wave_sum(s2) * (1.0f / DM) + LN_EPS); }
#pragma unroll
                for (int j = 0; j < 4; ++j) { const int c4 = 4 * lane + 256 * j;
                    const f32x4 lg = *(const f32x4*)(ln_g + c4), lb = *(const f32x4*)(ln_b + c4), sc2 = *(const f32x4*)(m + 4096 + c4), sh2 = *(const f32x4*)(m + 3072 + c4);
#pragma unroll
                    for (int t = 0; t < 2; ++t) { const f32x4 h1 = v[t][j] * rstd[t] * lg + lb;
                        u32x2 hw; hw.x = pk2(h1[0], h1[1]); hw.y = pk2(h1[2], h1[3]);
                        *(u32x2*)(h1o + (size_t)(tok0 + t) * DM + c4) = hw;
                        const f32x4 u2 = h1 * (1.0f + sc2) + sh2;
                        u32x2 w; w.x = pk2(u2[0], u2[1]); w.y = pk2(u2[2], u2[3]);
                        *(u32x2*)(U2 + (size_t)(tok0 + t) * DM + c4) = w; }
                }
            }
        }
        __syncthreads();
        __builtin_amdgcn_fence(__ATOMIC_ACQUIRE, "agent");
        asm volatile("s_waitcnt vmcnt(0)" ::: "memory");
        const int fr = lane & 15, fq = lane >> 4;
        if (parts & 2) {
            f32x4 acc[2][3];
#pragma unroll
            for (int gi = 0; gi < 2; ++gi)
#pragma unroll
                for (int nt = 0; nt < 3; ++nt) acc[gi][nt] = (f32x4){0.f, 0.f, 0.f, 0.f};
            const bf16_t* arow0 = U2 + (size_t)(tokb + (wave * 2 + 0) * 16 + fr) * DM + fq * 8;
            const bf16_t* arow1 = arow0 + (size_t)16 * DM;
#pragma unroll 1
            for (int ch = 0; ch < 4; ++ch) {
                u32x4 wreg[6];
#pragma unroll
                for (int p = 0; p < 6; ++p) { const int idx = p * NTHREADS + tid, row = idx >> 5, piece = idx & 31;
                    wreg[p] = *(const u32x4*)(wrt + (size_t)row * 1024 + ch * 256 + piece * 8); }
                __syncthreads();
#pragma unroll
                for (int p = 0; p < 6; ++p) { const int idx = p * NTHREADS + tid, row = idx >> 5, piece = idx & 31;
                    *(LAS u32x4*)(WB + row * WB_STRIDE + piece * 16) = wreg[p]; }
                __syncthreads();
#pragma unroll 2
                for (int ks = 0; ks < 8; ++ks) {
                    const bf16x8 af0 = *(const bf16x8*)(arow0 + ch * 256 + ks * 32), af1 = *(const bf16x8*)(arow1 + ch * 256 + ks * 32);
#pragma unroll
                    for (int nt = 0; nt < 3; ++nt) {
                        const bf16x8 bh = *(const LAS bf16x8*)(WB + (nt * 16 + fr) * WB_STRIDE + (ks * 32 + fq * 8) * 2), bl = *(const LAS bf16x8*)(WB + (48 + nt * 16 + fr) * WB_STRIDE + (ks * 32 + fq * 8) * 2);
                        acc[0][nt] = __builtin_amdgcn_mfma_f32_16x16x32_bf16(af0, bh, acc[0][nt], 0, 0, 0);
                        acc[1][nt] = __builtin_amdgcn_mfma_f32_16x16x32_bf16(af1, bh, acc[1][nt], 0, 0, 0);
                        acc[0][nt] = __builtin_amdgcn_mfma_f32_16x16x32_bf16(af0, bl, acc[0][nt], 0, 0, 0);
                        acc[1][nt] = __builtin_amdgcn_mfma_f32_16x16x32_bf16(af1, bl, acc[1][nt], 0, 0, 0);
                    }
                }
            }
            LAS float* lg = LG + wave * (2 * 16 * 48);
#pragma unroll
            for (int gi = 0; gi < 2; ++gi)
#pragma unroll
                for (int nt = 0; nt < 3; ++nt)
#pragma unroll
                    for (int j = 0; j < 4; ++j) lg[(gi * 16 + 4 * fq + j) * 48 + 16 * nt + fr] = acc[gi][nt][j];
            asm volatile("s_waitcnt lgkmcnt(0)" ::: "memory");
            if (lane < 32) {
                float pl[36];
#pragma unroll
                for (int e4 = 0; e4 < 9; ++e4) { const f32x4 q = *(const LAS f32x4*)(lg + lane * 48 + 4 * e4);
#pragma unroll
                    for (int r = 0; r < 4; ++r) pl[4 * e4 + r] = q[r]; }
#pragma unroll
                for (int e = 0; e < 36; ++e) pl[e] += e < 4 ? rgb[e] : reb[e - 4];
                int gsel = 0; float gm = pl[0];
#pragma unroll
                for (int g = 1; g < 4; ++g) if (pl[g] > gm) { gm = pl[g]; gsel = g; }
                float den = 0.f;
#pragma unroll
                for (int g = 0; g < 4; ++g) den += __expf(pl[g] - gm);
                const float gval = frcp(den);
                int j0 = -1; float v0 = -3.0e38f;
#pragma unroll
                for (int j = 0; j < 32; ++j) { const bool in = (j >> 3) == gsel; if (in && (j0 < 0 || pl[4 + j] > v0)) { v0 = pl[4 + j]; j0 = j; } }
                int j1 = -1; float v1 = -3.0e38f;
#pragma unroll
                for (int j = 0; j < 32; ++j) { const bool in = (j >> 3) == gsel; if (in && j != j0 && (j1 < 0 || pl[4 + j] > v1)) { v1 = pl[4 + j]; j1 = j; } }
                const float tt = __expf(v1 - v0), w0 = frcp(1.0f + tt), w1 = tt * w0;
                const int p0 = __hip_atomic_fetch_add(lcnt + j0, 1, __ATOMIC_RELAXED, __HIP_MEMORY_SCOPE_WORKGROUP), p1 = __hip_atomic_fetch_add(lcnt + j1, 1, __ATOMIC_RELAXED, __HIP_MEMORY_SCOPE_WORKGROUP);
                const int slot = wave * 32 + lane;
                tinfo[slot] = (i32x4){j0, j1, p0, p1}; tw[slot] = (f32x2){gval * w0, gval * w1};
            }
        }
        __syncthreads();
        if (tid < 32) lbase[tid] = atomicAdd(&counts[tid * CSTR], lcnt[tid]);
        __syncthreads();
        if (tid < 256) {
            const int tok = tokb + tid; const i32x4 ti = tinfo[tid]; const f32x2 wv = tw[tid];
            eidx[tok] = make_int2(ti[0], ti[1]); epos[tok] = make_int2(lbase[ti[0]] + ti[2], lbase[ti[1]] + ti[3]); ew[tok] = make_float2(wv[0], wv[1]);
        }
        if (tid < 32) lcnt[tid] = 0;
        __syncthreads();
    }
}

constexpr size_t WS_ROWTOK = 5 * MiB;
__device__ __forceinline__ void p_assign(LAS unsigned char* lds, const Args& a, int bid, int G, int tid) {
    const int* counts = (const int*)(a.ws + WS_CTL);
    const int2* eidx = (const int2*)(a.ws + WS_EIDX); const int2* epos = (const int2*)(a.ws + WS_EPOS); int2* dest = (int2*)(a.ws + WS_DEST); int* rowtok = (int*)(a.ws + WS_ROWTOK);
    LAS int* ps = (LAS int*)lds;
    if (tid == 0) { int acc = 0; for (int e = 0; e < NE; ++e) { const int c = counts[e * CSTR]; ps[e] = acc; ps[32 + e] = c; acc += ((c + 255) >> 8) << 8; } }
    __syncthreads();
    for (int tok = bid * NTHREADS + tid; tok < T; tok += G * NTHREADS) {
        const int2 ei = eidx[tok], ep = epos[tok];
        const int d0 = ps[ei.x] + ep.x, d1 = ps[ei.y] + ep.y;
        rowtok[d0] = tok; rowtok[d1] = tok; dest[tok] = make_int2(d0, d1);
    }
    for (int i = bid * NTHREADS + tid; i < NE * 256; i += G * NTHREADS) {
        const int e = i >> 8, r = i & 255, c = ps[32 + e];
        if (c + r < (((c + 255) >> 8) << 8)) rowtok[ps[e] + c + r] = 0;
    }
    __syncthreads();
}

__device__ __forceinline__ void p_combine_ln2(const Args& a, int bid, int G, int wave, int lane, bool dry = false) {
    const bf16_t* h1b = (const bf16_t*)(a.ws + WS_H1); float* outw = dry ? (float*)(a.ws + WS_HID) : a.out; const bf16_t* Y = (const bf16_t*)(a.ws + WS_Y); const int2* dest = (const int2*)(a.ws + WS_DEST); const float2* ew = (const float2*)(a.ws + WS_EW);
    const float* mod = (const float*)(a.ws + WS_MOD); const float* __restrict__ ln_g = a.in[24]; const float* __restrict__ ln_b = a.in[25];
    int pr = bid * 8 + wave;
    int2 dn[2]; float2 wn[2];
#pragma unroll
    for (int t = 0; t < 2; ++t) { dn[t] = dest[2 * pr + t]; wn[t] = ew[2 * pr + t]; }
#pragma unroll 1
    for (; pr < T / 2; pr += G * 8) {
        int l2 = lane; asm volatile("" : "+v"(l2)); const int lane = l2;
        const int tok0 = 2 * pr;
        const float* m = mod + (size_t)(tok0 / SEQ) * 6144;
        int2 d[2]; float2 w[2];
#pragma unroll
        for (int t = 0; t < 2; ++t) { d[t] = dn[t]; w[t] = wn[t]; }
        f32x4 v[2][4]; float s[2] = {0.f, 0.f};
#pragma unroll
        for (int t = 0; t < 2; ++t)
#pragma unroll
            for (int j = 0; j < 4; ++j) { const int c4 = 4 * lane + 256 * j;
                const u32x2 ya = *(const u32x2*)(Y + (size_t)d[t].x * DM + c4), yb = *(const u32x2*)(Y + (size_t)d[t].y * DM + c4);
                const u32x2 hw = *(const u32x2*)(h1b + (size_t)(tok0 + t) * DM + c4); const f32x4 g2 = *(const f32x4*)(m + 5120 + c4);
                f32x4 f;
                f[0] = w[t].x * __uint_as_float(ya.x << 16) + w[t].y * __uint_as_float(yb.x << 16);
                f[1] = w[t].x * __uint_as_float(ya.x & 0xffff0000u) + w[t].y * __uint_as_float(yb.x & 0xffff0000u);
                f[2] = w[t].x * __uint_as_float(ya.y << 16) + w[t].y * __uint_as_float(yb.y << 16);
                f[3] = w[t].x * __uint_as_float(ya.y & 0xffff0000u) + w[t].y * __uint_as_float(yb.y & 0xffff0000u);
                const f32x4 h1 = (f32x4){__uint_as_float(hw.x << 16), __uint_as_float(hw.x & 0xffff0000u), __uint_as_float(hw.y << 16), __uint_as_float(hw.y & 0xffff0000u)};
                v[t][j] = ALPHA * h1 + g2 * f; s[t] += (v[t][j][0] + v[t][j][1]) + (v[t][j][2] + v[t][j][3]); }
        { const int pn = pr + G * 8; if (pn < T / 2) {
#pragma unroll
            for (int t = 0; t < 2; ++t) { dn[t] = dest[2 * pn + t]; wn[t] = ew[2 * pn + t]; } } }
#pragma unroll
        for (int t = 0; t < 2; ++t) { const float mean = wave_sum(s[t]) * (1.0f / DM); float s2 = 0.f;
#pragma unroll
            for (int j = 0; j < 4; ++j) { v[t][j] = v[t][j] - mean; s2 += (v[t][j][0] * v[t][j][0] + v[t][j][1] * v[t][j][1]) + (v[t][j][2] * v[t][j][2] + v[t][j][3] * v[t][j][3]); }
            const float rstd = rsqrtf(wave_sum(s2) * (1.0f / DM) + LN_EPS);
#pragma unroll
            for (int j = 0; j < 4; ++j) { const int c4 = 4 * lane + 256 * j;
                *(f32x4*)(outw + (size_t)(tok0 + t) * DM + c4) = v[t][j] * rstd * *(const f32x4*)(ln_g + c4) + *(const f32x4*)(ln_b + c4); } }
    }
}

constexpr size_t WS_HGK = WS_U;
constexpr size_t WS_HGD = 852 * MiB;
constexpr size_t WS_RGAGG = 854 * MiB;
constexpr size_t WS_RGCARRY = 864 * MiB;
constexpr size_t WS_GWT = 870 * MiB;
constexpr size_t WS_OFST = 880 * MiB;
constexpr int RG_UNITS_PER_B = 68, HG_SEGS = 17;

__device__ __forceinline__ void lds_barrier() { asm volatile("s_waitcnt lgkmcnt(0)" ::: "memory"); __builtin_amdgcn_s_barrier(); asm volatile("" ::: "memory"); }
__device__ __forceinline__ bf16x8 mk_bf16x8(u32x4 v) { return __builtin_bit_cast(bf16x8, v); }
__device__ __forceinline__ float bf_lo(unsigned w) { return __uint_as_float(w << 16); }
__device__ __forceinline__ float bf_hi(unsigned w) { return __uint_as_float(w & 0xffff0000u); }
__device__ __forceinline__ unsigned cvt2(float lo, float hi) { unsigned r; asm volatile("v_cvt_pk_bf16_f32 %0, %1, %2" : "=v"(r) : "v"(lo), "v"(hi)); return r; }

__device__ __forceinline__ void p_gwt(const float* __restrict__ gate_w, bf16_t* __restrict__ gwt, int bid, int G, int tid) {
    for (int o = bid * NTHREADS + tid; o < 32 * 4096; o += G * NTHREADS) { const int mat = o >> 12, d = (o >> 6) & 63, c = o & 63; gwt[o] = f2bf(gate_w[mat * 4096 + c * 64 + d]); }
}

constexpr int XC_STRIDE = 1040;
constexpr int RG_XC = 0, RG_OUT = 64 * XC_STRIDE;
constexpr size_t WS_RGPAR = 876 * MiB;

__device__ __forceinline__ void p_rgpar(const float* __restrict__ gate_b, const float* __restrict__ lam, float* __restrict__ par, int bid, int G, int tid) {
    for (int o = bid * NTHREADS + tid; o < 2 * 512; o += G * NTHREADS) { const int dir = o >> 9, ch = o & 511;
        par[(dir * 3 + 0) * 512 + ch] = gate_b[(dir * 2 + 0) * 512 + ch]; par[(dir * 3 + 1) * 512 + ch] = gate_b[(dir * 2 + 1) * 512 + ch]; par[(dir * 3 + 2) * 512 + ch] = softplusf_(-lam[dir * 512 + ch]); }
}

template <int DIR, bool OUT>
__device__ __forceinline__ void rg_scan64(const float (&av)[4][4], const float (&uv)[4][4], float& carry, float& atot, float (&hsum)[4][4], int fr, int fq) {
#pragma unroll
    for (int mm = 0; mm < 4; ++mm) {
        const int m = DIR == 0 ? mm : 3 - mm;
        float P, H;
        if (DIR == 0) { P = av[m][0]; H = uv[m][0];
#pragma unroll
            for (int j = 1; j < 4; ++j) { H = av[m][j] * H + uv[m][j]; P *= av[m][j]; } }
        else { P = av[m][3]; H = uv[m][3];
#pragma unroll
            for (int j = 2; j >= 0; --j) { H = av[m][j] * H + uv[m][j]; P *= av[m][j]; } }
        float Pn, Hn, Pe, He, Pt, Ht;
        if (DIR == 0) {
            Pn = __shfl_up(P, 16); Hn = __shfl_up(H, 16); if (fq >= 1) { H = P * Hn + H; P = P * Pn; }
            Pn = __shfl_up(P, 32); Hn = __shfl_up(H, 32); if (fq >= 2) { H = P * Hn + H; P = P * Pn; }
            Pe = __shfl_up(P, 16); He = __shfl_up(H, 16); if (fq == 0) { Pe = 1.f; He = 0.f; }
            Pt = __shfl(P, fr + 48); Ht = __shfl(H, fr + 48);
        } else {
            Pn = __shfl_down(P, 16); Hn = __shfl_down(H, 16); if (fq <= 2) { H = P * Hn + H; P = P * Pn; }
            Pn = __shfl_down(P, 32); Hn = __shfl_down(H, 32); if (fq <= 1) { H = P * Hn + H; P = P * Pn; }
            Pe = __shfl_down(P, 16); He = __shfl_down(H, 16); if (fq == 3) { Pe = 1.f; He = 0.f; }
            Pt = __shfl(P, fr); Ht = __shfl(H, fr);
        }
        if (OUT) {
            float hp = Pe * carry + He;
            if (DIR == 0) {
#pragma unroll
                for (int j = 0; j < 4; ++j) { hp = av[m][j] * hp + uv[m][j]; hsum[m][j] = hp; }
            } else {
#pragma unroll
                for (int j = 3; j >= 0; --j) { hp = av[m][j] * hp + uv[m][j]; hsum[m][j] += hp; }
            }
        }
        carry = Pt * carry + Ht; atot *= Pt;
    }
}

__device__ __forceinline__ void rg_agg_unit(LAS unsigned char* lds, const Args& a, int b, int k, int tid, int wave, int lane) {
    const bf16_t* __restrict__ proj = (const bf16_t*)(a.ws + WS_PROJ);
    const float* __restrict__ conv_w = a.in[7]; const float* __restrict__ conv_b = a.in[8];
    const bf16_t* __restrict__ gwt = (const bf16_t*)(a.ws + WS_GWT); const float* __restrict__ par = (const float*)(a.ws + WS_RGPAR);
    float* rgagg = (float*)(a.ws + WS_RGAGG);
    int rowbase, p0, lo, hi;
    if (k < 4) { rowbase = T + b * LC; p0 = k * 64; lo = 0; hi = LC; } else { rowbase = b * SEQ; p0 = (k - 4) * 64; lo = p0; hi = p0 + 64; }
    const int unit = b * RG_UNITS_PER_B + k;
    const int n = wave, fr = lane & 15, fq = lane >> 4;
    float pgr[4][2], pgi[4][2], psp[4][2];
#pragma unroll
    for (int nt = 0; nt < 4; ++nt)
#pragma unroll
        for (int dir = 0; dir < 2; ++dir) { const int ch = n * 64 + nt * 16 + fr;
            pgr[nt][dir] = par[(dir * 3 + 0) * 512 + ch]; pgi[nt][dir] = par[(dir * 3 + 1) * 512 + ch]; psp[nt][dir] = par[(dir * 3 + 2) * 512 + ch]; }
    {
        const int cgp = tid & 63, tg = tid >> 6, c0 = cgp * 8, i0 = tg * 8;
        u32x4 raw[11];
#pragma unroll
        for (int r = 0; r < 11; ++r) { const int p = p0 + i0 - 1 + r;
            raw[r] = (p >= lo && p < hi) ? *(const u32x4*)proj_at(proj, rowbase + p, c0) : (u32x4){0u, 0u, 0u, 0u}; }
        float cw[4][8], cb[8];
#pragma unroll
        for (int t4 = 0; t4 < 4; ++t4) { const f32x4 w0 = *(const f32x4*)(conv_w + t4 * 512 + c0), w1 = *(const f32x4*)(conv_w + t4 * 512 + c0 + 4);
#pragma unroll
            for (int q = 0; q < 4; ++q) { cw[t4][q] = w0[q]; cw[t4][4 + q] = w1[q]; } }
        { const f32x4 b0 = *(const f32x4*)(conv_b + c0), b1 = *(const f32x4*)(conv_b + c0 + 4);
#pragma unroll
            for (int q = 0; q < 4; ++q) { cb[q] = b0[q]; cb[4 + q] = b1[q]; } }
#pragma unroll
        for (int ii = 0; ii < 8; ++ii) {
            float xc[8];
#pragma unroll
            for (int c = 0; c < 8; ++c) xc[c] = cb[c];
#pragma unroll
            for (int t4 = 0; t4 < 4; ++t4) { const u32x4 rw = raw[ii + t4];
#pragma unroll
                for (int q = 0; q < 4; ++q) { xc[2 * q] += cw[t4][2 * q] * bf_lo(rw[q]); xc[2 * q + 1] += cw[t4][2 * q + 1] * bf_hi(rw[q]); } }
            u32x4 w; w.x = cvt2(xc[0], xc[1]); w.y = cvt2(xc[2], xc[3]); w.z = cvt2(xc[4], xc[5]); w.w = cvt2(xc[6], xc[7]);
            *(LAS u32x4*)(lds + RG_XC + (i0 + ii) * XC_STRIDE + c0 * 2) = w;
        }
    }
    lds_barrier();
    {
        bf16x8 afr[4][2];
#pragma unroll
        for (int m = 0; m < 4; ++m)
#pragma unroll
            for (int ks = 0; ks < 2; ++ks) afr[m][ks] = *(const LAS bf16x8*)(lds + RG_XC + (16 * m + fr) * XC_STRIDE + (n * 64 + ks * 32 + fq * 8) * 2);
        u32x4* stash = (k >= 4) ? (u32x4*)a.out + ((size_t)(b * 64 + (k - 4)) * 16384 + (size_t)wave * 2048 + lane) : nullptr;
        bf16x8 wfr[2][2][2];
#pragma unroll
        for (int dir = 0; dir < 2; ++dir)
#pragma unroll
            for (int g = 0; g < 2; ++g)
#pragma unroll
                for (int ks = 0; ks < 2; ++ks) wfr[dir][g][ks] = *(const bf16x8*)(gwt + ((size_t)(((dir * 2 + g) * 8 + n) * 64 + fr)) * 64 + ks * 32 + fq * 8);
#pragma unroll
        for (int nt = 0; nt < 4; ++nt) {
            const int ch = n * 64 + nt * 16 + fr;
            bf16x8 wnx[2][2][2];
            if (nt < 3) {
#pragma unroll
                for (int dir = 0; dir < 2; ++dir)
#pragma unroll
                    for (int g = 0; g < 2; ++g)
#pragma unroll
                        for (int ks = 0; ks < 2; ++ks) wnx[dir][g][ks] = *(const bf16x8*)(gwt + ((size_t)(((dir * 2 + g) * 8 + n) * 64 + (nt + 1) * 16 + fr)) * 64 + ks * 32 + fq * 8);
            }
            float xcv[4][4];
#pragma unroll
            for (int m = 0; m < 4; ++m)
#pragma unroll
                for (int j = 0; j < 4; ++j) xcv[m][j] = bf2f(*(const LAS bf16_t*)(lds + RG_XC + (16 * m + 4 * fq + j) * XC_STRIDE + ch * 2));
#pragma unroll
            for (int dir = 0; dir < 2; ++dir) {
                f32x4 accr[4], acci[4];
#pragma unroll
                for (int m = 0; m < 4; ++m) { accr[m] = (f32x4){0.f, 0.f, 0.f, 0.f}; acci[m] = (f32x4){0.f, 0.f, 0.f, 0.f}; }
#pragma unroll
                for (int ks = 0; ks < 2; ++ks)
#pragma unroll
                    for (int m = 0; m < 4; ++m) { accr[m] = __builtin_amdgcn_mfma_f32_16x16x32_bf16(afr[m][ks], wfr[dir][0][ks], accr[m], 0, 0, 0); acci[m] = __builtin_amdgcn_mfma_f32_16x16x32_bf16(afr[m][ks], wfr[dir][1][ks], acci[m], 0, 0, 0); }
                const float gbr = pgr[nt][dir], gbi = pgi[nt][dir], sp = psp[nt][dir];
                float av[4][4], uv[4][4];
                const bool exact = __any(8.0f * sp >= 0.25f);
#pragma unroll
                for (int m = 0; m < 4; ++m) {
                    unsigned pk[4];
                    if (!exact) {
#pragma unroll
                        for (int j = 0; j < 4; ++j) {
                            const float r = sigmoidf_(accr[m][j] + gbr), ig = sigmoidf_(acci[m][j] + gbi);
                            const float la = -8.0f * r * sp;
                            const float oma = -la * (1.f + la * (0.5f + la * (0.16666667f + la * (0.041666668f + la * 0.0083333338f))));
                            pk[j] = cvt2(oma, __builtin_amdgcn_sqrtf(oma * (2.0f - oma)) * ig * xcv[m][j]);
                        }
                    } else {
#pragma unroll
                        for (int j = 0; j < 4; ++j) {
                            const float r = sigmoidf_(accr[m][j] + gbr), ig = sigmoidf_(acci[m][j] + gbi);
                            const float la = -8.0f * r * sp;
                            const float ser = -la * (1.f + la * (0.5f + la * (0.16666667f + la * (0.041666668f + la * 0.0083333338f))));
                            const float oma = (la > -0.25f) ? ser : 1.f - __expf(la);
                            pk[j] = cvt2(oma, __builtin_amdgcn_sqrtf(oma * (2.0f - oma)) * ig * xcv[m][j]);
                        }
                    }
#pragma unroll
                    for (int j = 0; j < 4; ++j) { av[m][j] = 1.0f - bf_lo(pk[j]); uv[m][j] = bf_hi(pk[j]); }
                    if (stash) stash[((nt * 2 + dir) * 4 + m) * 64] = (u32x4){pk[0], pk[1], pk[2], pk[3]};
                }
                float carry = 0.f, atot = 1.f, hdummy[4][4];
                if (dir == 0) rg_scan64<0, false>(av, uv, carry, atot, hdummy, fr, fq); else rg_scan64<1, false>(av, uv, carry, atot, hdummy, fr, fq);
                if (fq == 0) { rgagg[(((size_t)unit * 2 + dir) * 2 + 0) * 512 + ch] = atot; rgagg[(((size_t)unit * 2 + dir) * 2 + 1) * 512 + ch] = carry; }
            }
            if (nt < 3) {
#pragma unroll
                for (int dir = 0; dir < 2; ++dir)
#pragma unroll
                    for (int g = 0; g < 2; ++g)
#pragma unroll
                        for (int ks = 0; ks < 2; ++ks) wfr[dir][g][ks] = wnx[dir][g][ks];
            }
        }
    }
    lds_barrier();
}

__device__ __forceinline__ void rg_final_unit(LAS unsigned char* lds, const Args& a, int b, int kl, int tid, int wave, int lane) {
    const bf16_t* __restrict__ proj = (const bf16_t*)(a.ws + WS_PROJ); const float* rgcarry = (const float*)(a.ws + WS_RGCARRY); bf16_t* mixed = (bf16_t*)(a.ws + WS_MIXED);
    const int rowbase = b * SEQ + kl * 64, unit = b * RG_UNITS_PER_B + 4 + kl;
    const int n = wave, fr = lane & 15, fq = lane >> 4;
    const u32x4* stash = (const u32x4*)a.out + ((size_t)(b * 64 + kl) * 16384 + (size_t)wave * 2048 + lane);
    u32x4 st[2][4];
#pragma unroll
    for (int dir = 0; dir < 2; ++dir)
#pragma unroll
        for (int m = 0; m < 4; ++m) st[dir][m] = stash[((0 * 2 + dir) * 4 + m) * 64];
    float cin[4][2];
#pragma unroll
    for (int nt = 0; nt < 4; ++nt)
#pragma unroll
        for (int dir = 0; dir < 2; ++dir) cin[nt][dir] = rgcarry[((size_t)unit * 2 + dir) * 512 + n * 64 + nt * 16 + fr];
    {
        const int cgp = tid & 63, tg = tid >> 6, c0 = cgp * 8, i0 = tg * 8;
        u32x4 g[8];
#pragma unroll
        for (int ii = 0; ii < 8; ++ii) g[ii] = *(const u32x4*)proj_at(proj, rowbase + i0 + ii, 512 + c0);
#pragma unroll
        for (int ii = 0; ii < 8; ++ii) *(LAS u32x4*)(lds + RG_XC + (i0 + ii) * XC_STRIDE + c0 * 2) = g[ii];
    }
    lds_barrier();
#pragma unroll
    for (int nt = 0; nt < 4; ++nt) {
        const int ch = n * 64 + nt * 16 + fr;
        u32x4 sn[2][4];
        if (nt < 3) {
#pragma unroll
            for (int dir = 0; dir < 2; ++dir)
#pragma unroll
                for (int m = 0; m < 4; ++m) sn[dir][m] = stash[(((nt + 1) * 2 + dir) * 4 + m) * 64];
        }
        float hsum[4][4];
#pragma unroll
        for (int dir = 0; dir < 2; ++dir) {
            float av[4][4], uv[4][4];
#pragma unroll
            for (int m = 0; m < 4; ++m)
#pragma unroll
                for (int j = 0; j < 4; ++j) { av[m][j] = 1.0f - bf_lo(st[dir][m][j]); uv[m][j] = bf_hi(st[dir][m][j]); }
            float carry = cin[nt][dir], atot = 1.f;
            if (dir == 0) rg_scan64<0, true>(av, uv, carry, atot, hsum, fr, fq); else rg_scan64<1, true>(av, uv, carry, atot, hsum, fr, fq);
        }
#pragma unroll
        for (int m = 0; m < 4; ++m)
#pragma unroll
            for (int j = 0; j < 4; ++j) { const int t = 16 * m + 4 * fq + j;
                const float gg = bf2f(*(const LAS bf16_t*)(lds + RG_XC + t * XC_STRIDE + ch * 2));
                *(LAS bf16_t*)(lds + RG_OUT + t * XC_STRIDE + ch * 2) = (bf16_t)(cvt2(hsum[m][j] * gg, 0.f) & 0xffffu); }
        if (nt < 3) {
#pragma unroll
            for (int dir = 0; dir < 2; ++dir)
#pragma unroll
                for (int m = 0; m < 4; ++m) st[dir][m] = sn[dir][m];
        }
    }
    lds_barrier();
    {
        const int cgp = tid & 63, tg = tid >> 6, c0 = cgp * 8, i0 = tg * 8;
#pragma unroll
        for (int ii = 0; ii < 8; ++ii) { const u32x4 w = *(const LAS u32x4*)(lds + RG_OUT + (i0 + ii) * XC_STRIDE + c0 * 2);
            *(u32x4*)(mixed + (size_t)(rowbase + i0 + ii) * DM + c0) = w; }
    }
}

__device__ __forceinline__ void rg_carry_item(const Args& a, int item, int tid) {
    const float* rgagg = (const float*)(a.ws + WS_RGAGG); float* rgcarry = (float*)(a.ws + WS_RGCARRY);
    const int gidx = item * NTHREADS + tid;
    const int ch = gidx & 511, dir = (gidx >> 9) & 1, b = gidx >> 10;
    float h = 0.f;
#pragma unroll 1
    for (int s0 = 0; s0 < RG_UNITS_PER_B; s0 += 17) {
        float Av[17], Hv[17];
#pragma unroll
        for (int s1 = 0; s1 < 17; ++s1) { const int s = s0 + s1;
            const int k = dir == 0 ? s : (s < 4 ? 3 - s : 67 - (s - 4));
            const size_t unit = (size_t)b * RG_UNITS_PER_B + k;
            Av[s1] = rgagg[((unit * 2 + dir) * 2 + 0) * 512 + ch]; Hv[s1] = rgagg[((unit * 2 + dir) * 2 + 1) * 512 + ch]; }
#pragma unroll
        for (int s1 = 0; s1 < 17; ++s1) { const int s = s0 + s1;
            const int k = dir == 0 ? s : (s < 4 ? 3 - s : 67 - (s - 4));
            const size_t unit = (size_t)b * RG_UNITS_PER_B + k;
            rgcarry[(unit * 2 + dir) * 512 + ch] = h;
            h = Av[s1] * h + Hv[s1]; }
    }
}

#ifndef HGX
#define HGX 0
#endif
__device__ __forceinline__ float row_allsum16(float v) {
    v += __builtin_bit_cast(float, __builtin_amdgcn_update_dpp(0, __builtin_bit_cast(int, v), 0x128, 0xf, 0xf, false));
    v += __builtin_bit_cast(float, __builtin_amdgcn_update_dpp(0, __builtin_bit_cast(int, v), 0x124, 0xf, 0xf, false));
    v += __builtin_bit_cast(float, __builtin_amdgcn_update_dpp(0, __builtin_bit_cast(int, v), 0x122, 0xf, 0xf, false));
    v += __builtin_bit_cast(float, __builtin_amdgcn_update_dpp(0, __builtin_bit_cast(int, v), 0x121, 0xf, 0xf, false));
    return v;
}
constexpr int HG_RAWZ = 0, HG_RAWV = 16384, HG_RAWQ = 32768;
constexpr int HG_KHT = 49152, HG_VT = 67584;
constexpr int HG_QT = 86016, HG_KT = 103424;
constexpr int HG_AM = 120832;
constexpr int HG_DS = 130048, HG_QSUM = 130560, HG_PART = 134656;
constexpr int HG_RAWG = 136704;
constexpr int HG_OST = HG_QT;
constexpr int TS = 144, QS = 272;

struct HgRaw { u32x4 z[2], v[2], q[2], g[2]; };
template <bool FULL, bool GATE>
__device__ __forceinline__ void hg_load_raw(HgRaw& r, const bf16_t* __restrict__ proj, int row0, int hd, int dir, int tid) {
#pragma unroll
    for (int i = 0; i < 2; ++i) { const int row = row0 + (tid >> 4) + 32 * i, col = hd * 128 + (tid & 15) * 8;
        r.z[i] = *(const u32x4*)proj_at(proj, row, col + (dir == 0 ? 1536 : 2048)); r.v[i] = *(const u32x4*)proj_at(proj, row, col + 2560);
        if (FULL) r.q[i] = *(const u32x4*)proj_at(proj, row, col + 1024); if (GATE) r.g[i] = *(const u32x4*)proj_at(proj, row, col + 3072); }
}
template <bool FULL, bool GATE>
__device__ __forceinline__ void hg_store_raw(LAS unsigned char* lds, const HgRaw& r, int tid) {
#pragma unroll
    for (int i = 0; i < 2; ++i) { const int off = ((tid >> 4) + 32 * i) * 256 + (tid & 15) * 16;
        *(LAS u32x4*)(lds + HG_RAWZ + off) = r.z[i]; *(LAS u32x4*)(lds + HG_RAWV + off) = r.v[i]; if (FULL) *(LAS u32x4*)(lds + HG_RAWQ + off) = r.q[i]; if (GATE) *(LAS u32x4*)(lds + HG_RAWG + off) = r.g[i]; }
}

template <int DIR, bool FULL, bool STORE_NEXT, bool NEXT_GATE>
__device__ __forceinline__ void hg_chunk(LAS unsigned char* lds, f32x4 (&accS)[8], f32x4 (&o)[4], float lb0, float lb1, float& dseg0, float& dseg1, const HgRaw& nxt, int tid, int wave, int lane, int xm = 0) {
    const int cp = lane, tg = wave, fr = lane & 15, fq = lane >> 4;
    float c0[8], c1[8], k0[8], k1[8];
    if (xm & 1) {
#pragma unroll
        for (int i = 0; i < 8; ++i) { c0[i] = 1.f; c1[i] = 1.f; k0[i] = 0.5f; k1[i] = 0.5f; }
    } else {
        float p0 = 1.f, p1 = 1.f;
#pragma unroll
        for (int ii = 0; ii < 8; ++ii) { const int i = DIR == 0 ? ii : 7 - ii;
            const unsigned zz = *(const LAS unsigned*)(lds + HG_RAWZ + (8 * tg + i) * 256 + cp * 4);
            const float e0 = __expf(-bf_lo(zz)), e1 = __expf(-bf_hi(zz)); const float s0 = frcp(1.0f + e0), s1 = frcp(1.0f + e1);
            k0[i] = (1.0f - lb0) * e0 * s0; k1[i] = (1.0f - lb1) * e1 * s1;
            p0 *= lb0 + (1.0f - lb0) * s0; p1 *= lb1 + (1.0f - lb1) * s1; c0[i] = p0; c1[i] = p1; }
        *(LAS f32x2*)(lds + HG_QSUM + (tg * 128 + 2 * cp) * 4) = (f32x2){p0, p1};
    }
    lds_barrier();
    float pre0 = 1.f, pre1 = 1.f, tot0 = 1.f, tot1 = 1.f;
#pragma unroll
    for (int g = 0; g < 8; ++g) { const f32x2 v = *(const LAS f32x2*)(lds + HG_QSUM + (g * 128 + 2 * cp) * 4); tot0 *= v[0]; tot1 *= v[1]; if (DIR == 0 ? (g < tg) : (g > tg)) { pre0 *= v[0]; pre1 *= v[1]; } }
    if (!(xm & 1)) {
        unsigned kh0[4], kh1[4], vt0[4], vt1[4];
#pragma unroll
        for (int i2 = 0; i2 < 4; ++i2) {
            const float Pa0 = pre0 * c0[2 * i2], Pb0 = pre0 * c0[2 * i2 + 1], Pa1 = pre1 * c1[2 * i2], Pb1 = pre1 * c1[2 * i2 + 1];
            const float ra0 = frcp(Pa0), rb0 = frcp(Pb0), ra1 = frcp(Pa1), rb1 = frcp(Pb1);
            const float kta0 = k0[2 * i2] * ra0, ktb0 = k0[2 * i2 + 1] * rb0, kta1 = k1[2 * i2] * ra1, ktb1 = k1[2 * i2 + 1] * rb1;
            kh0[i2] = cvt2(kta0 * tot0, ktb0 * tot0); kh1[i2] = cvt2(kta1 * tot1, ktb1 * tot1);
            const unsigned va = *(const LAS unsigned*)(lds + HG_RAWV + (8 * tg + 2 * i2) * 256 + cp * 4), vb = *(const LAS unsigned*)(lds + HG_RAWV + (8 * tg + 2 * i2 + 1) * 256 + cp * 4);
            vt0[i2] = __builtin_amdgcn_perm(vb, va, 0x05040100u); vt1[i2] = __builtin_amdgcn_perm(vb, va, 0x07060302u);
            if (FULL) {
                const unsigned qa = *(const LAS unsigned*)(lds + HG_RAWQ + (8 * tg + 2 * i2) * 256 + cp * 4), qb = *(const LAS unsigned*)(lds + HG_RAWQ + (8 * tg + 2 * i2 + 1) * 256 + cp * 4);
                *(LAS unsigned*)(lds + HG_QT + (8 * tg + 2 * i2) * QS + cp * 4) = cvt2(bf_lo(qa) * Pa0, bf_hi(qa) * Pa1);
                *(LAS unsigned*)(lds + HG_QT + (8 * tg + 2 * i2 + 1) * QS + cp * 4) = cvt2(bf_lo(qb) * Pb0, bf_hi(qb) * Pb1);
                *(LAS unsigned*)(lds + HG_KT + (8 * tg + 2 * i2) * QS + cp * 4) = cvt2(kta0, kta1);
                *(LAS unsigned*)(lds + HG_KT + (8 * tg + 2 * i2 + 1) * QS + cp * 4) = cvt2(ktb0, ktb1);
            }
        }
        *(LAS u32x4*)(lds + HG_KHT + (2 * cp) * TS + tg * 16) = (u32x4){kh0[0], kh0[1], kh0[2], kh0[3]}; *(LAS u32x4*)(lds + HG_KHT + (2 * cp + 1) * TS + tg * 16) = (u32x4){kh1[0], kh1[1], kh1[2], kh1[3]};
        *(LAS u32x4*)(lds + HG_VT + (2 * cp) * TS + tg * 16) = (u32x4){vt0[0], vt0[1], vt0[2], vt0[3]}; *(LAS u32x4*)(lds + HG_VT + (2 * cp + 1) * TS + tg * 16) = (u32x4){vt1[0], vt1[1], vt1[2], vt1[3]};
        if (tg == 0) { *(LAS f32x2*)(lds + HG_DS + 2 * cp * 4) = (f32x2){tot0, tot1}; dseg0 *= tot0; dseg1 *= tot1; }
    }
    lds_barrier();
    if (FULL) {
        if (!(xm & 2))
#pragma unroll
        for (int tt = 0; tt < 2; ++tt) {
            const int tl = 2 * wave + tt, ti = tl >> 2, si = tl & 3;
            f32x4 accA = (f32x4){0.f, 0.f, 0.f, 0.f};
#pragma unroll
            for (int ks = 0; ks < 4; ++ks) {
                const bf16x8 af = *(const LAS bf16x8*)(lds + HG_QT + (16 * ti + fr) * QS + (ks * 32 + fq * 8) * 2);
                const bf16x8 bf = *(const LAS bf16x8*)(lds + HG_KT + (16 * si + fr) * QS + (ks * 32 + fq * 8) * 2);
                accA = __builtin_amdgcn_mfma_f32_16x16x32_bf16(af, bf, accA, 0, 0, 0);
            }
#pragma unroll
            for (int j = 0; j < 4; ++j) { const int t = 16 * ti + 4 * fq + j, s = 16 * si + fr;
                const bool keep = DIR == 0 ? (s <= t) : (s >= t);
                *(LAS bf16_t*)(lds + HG_AM + t * TS + s * 2) = (bf16_t)(cvt2(keep ? accA[j] : 0.f, 0.f) & 0xffffu); }
        }
        lds_barrier();
#pragma unroll
        for (int m = 0; m < 4; ++m) o[m] = (f32x4){0.f, 0.f, 0.f, 0.f};
        if (!(xm & 4)) {
#pragma unroll
        for (int ks = 0; ks < 4; ++ks) {
            const u32x4 sw = (u32x4){cvt2(accS[2 * ks][0], accS[2 * ks][1]), cvt2(accS[2 * ks][2], accS[2 * ks][3]), cvt2(accS[2 * ks + 1][0], accS[2 * ks + 1][1]), cvt2(accS[2 * ks + 1][2], accS[2 * ks + 1][3])};
            const bf16x8 sf = mk_bf16x8(sw);
#pragma unroll
            for (int m = 0; m < 4; ++m) {
                const u32x2 qlo = *(const LAS u32x2*)(lds + HG_QT + (16 * m + fr) * QS + (32 * ks + 4 * fq) * 2), qhi = *(const LAS u32x2*)(lds + HG_QT + (16 * m + fr) * QS + (32 * ks + 16 + 4 * fq) * 2);
                const bf16x8 qf = mk_bf16x8((u32x4){qlo.x, qlo.y, qhi.x, qhi.y});
                o[m] = __builtin_amdgcn_mfma_f32_16x16x32_bf16(qf, sf, o[m], 0, 0, 0);
            }
        }
#pragma unroll
        for (int ks = 0; ks < 2; ++ks) {
            const bf16x8 vf = *(const LAS bf16x8*)(lds + HG_VT + (16 * wave + fr) * TS + (ks * 32 + fq * 8) * 2);
#pragma unroll
            for (int m = 0; m < 4; ++m) { const bf16x8 af = *(const LAS bf16x8*)(lds + HG_AM + (16 * m + fr) * TS + (ks * 32 + fq * 8) * 2);
                o[m] = __builtin_amdgcn_mfma_f32_16x16x32_bf16(af, vf, o[m], 0, 0, 0); }
        }
        }
    }
    if (!(xm & 8)) {
#pragma unroll
    for (int i = 0; i < 8; ++i) { const f32x4 dv = *(const LAS f32x4*)(lds + HG_DS + (16 * i + 4 * fq) * 4); accS[i] = accS[i] * dv; }
#pragma unroll
    for (int ks = 0; ks < 2; ++ks) {
        const bf16x8 vf = *(const LAS bf16x8*)(lds + HG_VT + (16 * wave + fr) * TS + (ks * 32 + fq * 8) * 2);
#pragma unroll
        for (int i = 0; i < 8; ++i) { const bf16x8 af = *(const LAS bf16x8*)(lds + HG_KHT + (16 * i + fr) * TS + (ks * 32 + fq * 8) * 2);
            accS[i] = __builtin_amdgcn_mfma_f32_16x16x32_bf16(af, vf, accS[i], 0, 0, 0); }
    }
    }
    if (STORE_NEXT) hg_store_raw<FULL, NEXT_GATE>(lds, nxt, tid);
}

__device__ __forceinline__ float hg_lb(const float* __restrict__ lb_logits, int dir, int col) {
    const float l0 = lb_logits[(0 * 2 + dir) * 512 + col], l1 = lb_logits[(1 * 2 + dir) * 512 + col];
    return 1.0f / (1.0f + expf(l1 - l0));
}

template <int DIR>
__device__ __forceinline__ void hg_agg_unit(LAS unsigned char* lds, const Args& a, int b, int hd, int sidx, int unit, int tid, int wave, int lane) {
    const bf16_t* __restrict__ proj = (const bf16_t*)(a.ws + WS_PROJ);
    const int rowbase = sidx == 0 ? T + b * LC : b * SEQ + (sidx - 1) * 256;
    const float lb0 = hg_lb(a.in[12], DIR, hd * 128 + 2 * lane), lb1 = hg_lb(a.in[12], DIR, hd * 128 + 2 * lane + 1);
    f32x4 accS[8], odummy[4];
#pragma unroll
    for (int i = 0; i < 8; ++i) accS[i] = (f32x4){0.f, 0.f, 0.f, 0.f};
    float dseg0 = 1.f, dseg1 = 1.f;
    HgRaw raw;
    hg_load_raw<false, false>(raw, proj, rowbase + (DIR == 0 ? 0 : 3) * 64, hd, DIR, tid);
    lds_barrier();
    hg_store_raw<false, false>(lds, raw, tid);
    lds_barrier();
#pragma unroll 1
    for (int cc = 0; cc < 3; ++cc) {
        hg_load_raw<false, false>(raw, proj, rowbase + (DIR == 0 ? cc + 1 : 2 - cc) * 64, hd, DIR, tid);
        hg_chunk<DIR, false, true, false>(lds, accS, odummy, lb0, lb1, dseg0, dseg1, raw, tid, wave, lane);
        lds_barrier();
    }
    hg_chunk<DIR, false, false, false>(lds, accS, odummy, lb0, lb1, dseg0, dseg1, raw, tid, wave, lane);
    float* K = (float*)(a.ws + WS_HGK) + (size_t)unit * 16384;
    const int fr = lane & 15, fq = lane >> 4;
#pragma unroll
    for (int i = 0; i < 8; ++i)
#pragma unroll
        for (int j = 0; j < 4; ++j) K[(16 * i + 4 * fq + j) * 128 + 16 * wave + fr] = accS[i][j];
    if (wave == 0) *(f32x2*)((float*)(a.ws + WS_HGD) + (size_t)unit * 128 + 2 * lane) = (f32x2){dseg0, dseg1};
}

__device__ __forceinline__ void hg_carry_item(const Args& a, int item, int tid, bool dry = false) {
    const int chain = item >> 3, part = item & 7, dir = chain & 1;
    float* K = (float*)(a.ws + WS_HGK) + (size_t)chain * HG_SEGS * 16384; const float* D = (const float*)(a.ws + WS_HGD) + (size_t)chain * HG_SEGS * 128;
    const int e4 = part * 512 + tid, dk = e4 >> 5;
    f32x4 kv[HG_SEGS]; float dv[HG_SEGS];
#pragma unroll
    for (int s = 0; s < HG_SEGS; ++s) { const int sidx = s == 0 ? 0 : (dir == 0 ? s : HG_SEGS - s); kv[s] = *(const f32x4*)(K + (size_t)sidx * 16384 + e4 * 4); dv[s] = D[sidx * 128 + dk]; }
    f32x4 S = (f32x4){0.f, 0.f, 0.f, 0.f};
#pragma unroll
    for (int s = 0; s < HG_SEGS; ++s) { const int sidx = s == 0 ? 0 : (dir == 0 ? s : HG_SEGS - s);
        if (dry) { const size_t o = ((size_t)(chain * HG_SEGS + sidx) * 16384 + e4 * 4) % (size_t)(32 * MiB); *(f32x4*)((float*)(a.ws + WS_MIXED) + o) = S; } else *(f32x4*)(K + (size_t)sidx * 16384 + e4 * 4) = S;
        S = S * dv[s] + kv[s]; }
}

__device__ __forceinline__ void hg_final_unit(LAS unsigned char* lds, const Args& a, int b, int hd, int seg, int tid, int wave, int lane, int xm = 0) {
    const bf16_t* __restrict__ proj = (const bf16_t*)(a.ws + WS_PROJ); bf16_t* mixed = (bf16_t*)(a.ws + WS_MIXED);
    const int rowbase = b * SEQ + seg * 256, fr = lane & 15, fq = lane >> 4;
    const float lbf0 = hg_lb(a.in[12], 0, hd * 128 + 2 * lane), lbf1 = hg_lb(a.in[12], 0, hd * 128 + 2 * lane + 1);
    const float lbb0 = hg_lb(a.in[12], 1, hd * 128 + 2 * lane), lbb1 = hg_lb(a.in[12], 1, hd * 128 + 2 * lane + 1);
    f32x4 accS[8], o[4];
    float dseg0 = 1.f, dseg1 = 1.f;
    HgRaw raw;
    f32x4* ofst = (f32x4*)(a.ws + WS_OFST) + (size_t)blockIdx.x * 8192 + wave * 256 + lane;
    hg_load_raw<true, false>(raw, proj, rowbase, hd, 0, tid);
    {
        const float* Sin = (const float*)(a.ws + WS_HGK) + (size_t)((((b * 4 + hd) * 2 + 0) * HG_SEGS) + 1 + seg) * 16384;
#pragma unroll
        for (int i = 0; i < 8; ++i)
#pragma unroll
            for (int j = 0; j < 4; ++j) accS[i][j] = Sin[(16 * i + 4 * fq + j) * 128 + 16 * wave + fr];
    }
    lds_barrier();
    hg_store_raw<true, false>(lds, raw, tid);
    lds_barrier();
#pragma unroll 1
    for (int cc = 0; cc < 3; ++cc) {
        hg_load_raw<true, false>(raw, proj, rowbase + (cc + 1) * 64, hd, 0, tid);
        hg_chunk<0, true, true, false>(lds, accS, o, lbf0, lbf1, dseg0, dseg1, raw, tid, wave, lane, xm);
#pragma unroll
        for (int m = 0; m < 4; ++m) ofst[cc * 2048 + m * 64] = o[m];
        lds_barrier();
    }
    hg_load_raw<true, false>(raw, proj, rowbase + 3 * 64, hd, 1, tid);
    hg_chunk<0, true, true, false>(lds, accS, o, lbf0, lbf1, dseg0, dseg1, raw, tid, wave, lane, xm);
#pragma unroll
    for (int m = 0; m < 4; ++m) ofst[3 * 2048 + m * 64] = o[m];
    {
        const float* Sin = (const float*)(a.ws + WS_HGK) + (size_t)((((b * 4 + hd) * 2 + 1) * HG_SEGS) + 1 + seg) * 16384;
#pragma unroll
        for (int i = 0; i < 8; ++i)
#pragma unroll
            for (int j = 0; j < 4; ++j) accS[i][j] = Sin[(16 * i + 4 * fq + j) * 128 + 16 * wave + fr];
    }
    lds_barrier();
    constexpr int OSF = 528;
    f32x4 ngv[2];
    { const float* ngp = a.in[13] + hd * 128 + (tid & 15) * 8; ngv[0] = *(const f32x4*)ngp; ngv[1] = *(const f32x4*)(ngp + 4); }
#pragma unroll 1
    for (int cc = 0; cc < 4; ++cc) {
        const int c = 3 - cc;
        f32x4 ofv[4]; u32x4 gq[2];
#pragma unroll
        for (int m = 0; m < 4; ++m) ofv[m] = ofst[c * 2048 + m * 64];
#pragma unroll
        for (int i = 0; i < 2; ++i) gq[i] = *(const u32x4*)proj_at(proj, rowbase + c * 64 + (tid >> 4) + 32 * i, 3072 + hd * 128 + (tid & 15) * 8);
        if (cc < 3) hg_load_raw<true, false>(raw, proj, rowbase + (c - 1) * 64, hd, 1, tid);
        if (cc < 3) hg_chunk<1, true, true, false>(lds, accS, o, lbb0, lbb1, dseg0, dseg1, raw, tid, wave, lane, xm);
        else hg_chunk<1, true, false, false>(lds, accS, o, lbb0, lbb1, dseg0, dseg1, raw, tid, wave, lane, xm);
        if (xm & 16) { lds_barrier(); continue; }
        lds_barrier();
#pragma unroll
        for (int m = 0; m < 4; ++m) { const f32x4 ot = o[m] + ofv[m];
#pragma unroll
            for (int j = 0; j < 4; ++j) *(LAS float*)(lds + HG_QT + (16 * m + 4 * fq + j) * OSF + (16 * wave + fr) * 4) = ot[j]; }
        lds_barrier();
#pragma unroll
        for (int i = 0; i < 2; ++i) { const int t = (tid >> 4) + 32 * i, c8 = (tid & 15) * 8;
            const f32x4 v0 = *(const LAS f32x4*)(lds + HG_QT + t * OSF + c8 * 4), v1 = *(const LAS f32x4*)(lds + HG_QT + t * OSF + c8 * 4 + 16);
            const float ss = row_allsum16((v0[0] * v0[0] + v0[1] * v0[1]) + (v0[2] * v0[2] + v0[3] * v0[3]) + (v1[0] * v1[0] + v1[1] * v1[1]) + (v1[2] * v1[2] + v1[3] * v1[3]));
            const float rinv = __builtin_amdgcn_rsqf(ss * (1.0f / 128.0f) + LN_EPS);
            const u32x4 g = gq[i];
            u32x4 w;
            w.x = cvt2(v0[0] * rinv * ngv[0][0] * bf_lo(g.x), v0[1] * rinv * ngv[0][1] * bf_hi(g.x)); w.y = cvt2(v0[2] * rinv * ngv[0][2] * bf_lo(g.y), v0[3] * rinv * ngv[0][3] * bf_hi(g.y));
            w.z = cvt2(v1[0] * rinv * ngv[1][0] * bf_lo(g.z), v1[1] * rinv * ngv[1][1] * bf_hi(g.z)); w.w = cvt2(v1[2] * rinv * ngv[1][2] * bf_lo(g.w), v1[3] * rinv * ngv[1][3] * bf_hi(g.w));
            *(u32x4*)(mixed + (size_t)(rowbase + c * 64 + t) * DM + 512 + hd * 128 + c8) = w; }
    }
}

__device__ __forceinline__ void p_scan_a(LAS unsigned char* lds, const Args& a, int bid, int G, int tid, int wave, int lane, int mask = 3) {
    constexpr int N_HG = NB * 4 * 2 * HG_SEGS, N_RG = NB * RG_UNITS_PER_B;
#pragma unroll 1
    for (int it = bid; it < N_HG + N_RG; it += G) {
        int t2 = tid; asm volatile("" : "+v"(t2)); const int tid = t2, lane = t2 & 63;
        if ((it < N_HG) ? !(mask & 1) : !(mask & 2)) continue;
        if (it < N_HG) { const int sidx = it % HG_SEGS, rest = it / HG_SEGS, dir = rest & 1, hd = (rest >> 1) & 3, b = rest >> 3;
            if (dir == 0) hg_agg_unit<0>(lds, a, b, hd, sidx, it, tid, wave, lane); else hg_agg_unit<1>(lds, a, b, hd, sidx, it, tid, wave, lane); }
        else { const int r = it - N_HG; __syncthreads(); rg_agg_unit(lds, a, r / RG_UNITS_PER_B, r % RG_UNITS_PER_B, tid, wave, lane); }
    }
}
__device__ __forceinline__ void p_scan_b(const Args& a, int bid, int G, int tid, bool dry = false) {
#pragma unroll 1
    for (int it = bid; it < 1024; it += G) hg_carry_item(a, it, tid, dry);
    if (bid >= G - 32) rg_carry_item(a, bid - (G - 32), tid);
}
__device__ __forceinline__ void p_scan_c(LAS unsigned char* lds, const Args& a, int bid, int G, int tid, int wave, int lane, int mask = 3, int xm = 0) {
#pragma unroll 1
    for (int it = bid; it < ((mask & 1) ? 1024 : 0); it += G) { const int seg = it & 15, hd = (it >> 4) & 3, b = it >> 6; int t2 = tid; asm volatile("" : "+v"(t2)); hg_final_unit(lds, a, b, hd, seg, t2, wave, t2 & 63, xm); }
#pragma unroll 1
    for (int r = bid; r < ((mask & 2) ? 1024 : 0); r += G) { __syncthreads(); int t2 = tid; asm volatile("" : "+v"(t2)); rg_final_unit(lds, a, r >> 6, r & 63, t2, wave, t2 & 63); }
}

#define GAS __attribute__((address_space(1)))
#define RLX_AGENT __ATOMIC_RELAXED, __HIP_MEMORY_SCOPE_AGENT
#define XB_TMO      128
#define XB_XCNT(j)  (256  + 64 * (j))
#define XB_XSUB(j)  (1280 + 64 * (j))
#define XB_XGEN(j)  (2304 + 64 * (j))
#define XB_TOP      3328
#define XB_TOPGEN   3392
#define XCD_BAR_WORDS 3456
#define XB_SPIN_CAP (1u << 18)

__device__ __forceinline__ unsigned xb_ld(unsigned* p)              { return __hip_atomic_load(p, __ATOMIC_RELAXED, __HIP_MEMORY_SCOPE_AGENT); }
__device__ __forceinline__ unsigned xb_add(unsigned* p, unsigned v) { return __hip_atomic_fetch_add(p, v, __ATOMIC_RELAXED, __HIP_MEMORY_SCOPE_AGENT); }
__device__ __forceinline__ unsigned xb_xcc_id() { return (unsigned)__builtin_amdgcn_s_getreg((3 << 11) | 20) & 0xFu; }
#define XB_SPIN(cond, bar) do { unsigned _sp = 0; while (cond) { __builtin_amdgcn_s_sleep(1); \
    if ((++_sp & 255u) == 0u) { if (xb_ld(&(bar)[XB_TMO])) break; if (_sp > XB_SPIN_CAP) { atomicAdd(&(bar)[XB_TMO], 1u); break; } } } } while (0)

struct XcdBarrier {
    unsigned* bar; unsigned x;
    volatile LAS unsigned* st;
};

__device__ __forceinline__ XcdBarrier xcd_barrier_post(unsigned* bar, volatile LAS unsigned* st) {
    XcdBarrier b; b.bar = bar; b.x = xb_xcc_id(); b.st = st;
    if (threadIdx.x == 0) (void)xb_add(&bar[XB_XCNT(b.x)], 1u);
    return b;
}
__device__ __forceinline__ void xcd_barrier_complete(unsigned* bar, unsigned x, unsigned& nloc, unsigned& nx) {
    const unsigned G = gridDim.x * gridDim.y * gridDim.z;
    unsigned sum, cnt, mine, sp = 0u;
    for (;;) {
        sum = 0u; cnt = 0u; mine = 0u;
#pragma unroll
        for (unsigned j = 0; j < 16; ++j) { const unsigned c = xb_ld(&bar[XB_XCNT(j)]); sum += c; cnt += (c > 0u) ? 1u : 0u; mine = (j == x) ? c : mine; }
        if (sum == G) break;
        __builtin_amdgcn_s_sleep(1);
        if ((++sp & 255u) == 0u) { if (xb_ld(&bar[XB_TMO])) break; if (sp > XB_SPIN_CAP) { atomicAdd(&bar[XB_TMO], 1u); break; } }
    }
    nloc = mine > 0u ? mine : 1u; nx = cnt > 0u ? cnt : 1u;
}

__device__ __forceinline__ void xcd_barrier(const XcdBarrier& b) {
    asm volatile("s_waitcnt vmcnt(0)" ::: "memory");
    __syncthreads();
    if (threadIdx.x == 0) {
        unsigned* bar = b.bar;
        __builtin_amdgcn_s_waitcnt(0);
        unsigned nloc = b.st[0], nx = b.st[1];
        if (nloc == 0u) { xcd_barrier_complete(bar, b.x, nloc, nx); b.st[0] = nloc; b.st[1] = nx; }
        const unsigned old = xb_add(&bar[XB_XSUB(b.x)], 1u);
        const unsigned gen = old / nloc;
        if (old + 1u == (gen + 1u) * nloc) {
            __builtin_amdgcn_fence(__ATOMIC_RELEASE, "agent");
            asm volatile("s_waitcnt vmcnt(0)" ::: "memory");
            const unsigned og = xb_add(&bar[XB_TOP], 1u);
            const unsigned tg = og / nx;
            if (og + 1u == (tg + 1u) * nx) xb_add(&bar[XB_TOPGEN], 1u);
            else XB_SPIN(xb_ld(&bar[XB_TOPGEN]) == tg, bar);
            __builtin_amdgcn_fence(__ATOMIC_ACQUIRE, "agent");
            xb_add(&bar[XB_XGEN(b.x)], 1u);
            asm volatile("s_waitcnt vmcnt(0)" ::: "memory");
        } else {
            XB_SPIN(xb_ld(&bar[XB_XGEN(b.x)]) == gen, bar);
            __builtin_amdgcn_fence(__ATOMIC_ACQUIRE, "agent");
            asm volatile("s_waitcnt vmcnt(0)" ::: "memory");
        }
    }
    __syncthreads();
}


__device__ __forceinline__ void stagger_wait(unsigned ticks) {
    if (ticks == 0u) return;
    const unsigned long long t0 = __builtin_amdgcn_s_memrealtime();
    while (__builtin_amdgcn_s_memrealtime() - t0 < ticks) __builtin_amdgcn_s_sleep(16);
}
#ifndef STAG_P2
#define STAG_P2 0
#endif

__global__ void __launch_bounds__(NTHREADS, 2) mega(Args a) {
    extern __shared__ __attribute__((aligned(16))) unsigned char lds_raw[];
    LAS unsigned char* lds = (LAS unsigned char*)lds_raw;
    cg::grid_group grid = cg::this_grid();
    const int wave = __builtin_amdgcn_readfirstlane(threadIdx.x >> 6), bid = blockIdx.x, G = gridDim.x;
    int tid = threadIdx.x, lane = tid & 63;
#define FRESH_TID() do { tid = threadIdx.x; asm volatile("" : "+v"(tid)); lane = tid & 63; } while (0)
    unsigned char* ws = a.ws;
    volatile LAS unsigned* bst = (volatile LAS unsigned*)(lds + LDS_BYTES - 64);
    if (threadIdx.x < 2) bst[threadIdx.x] = 0u;
    __syncthreads();
    XcdBarrier xbar = xcd_barrier_post((unsigned*)(ws + WS_BAR), bst);
#define GRID_BAR() xcd_barrier(xbar)
    float* mod = (float*)(ws + WS_MOD);
    bf16_t* U = (bf16_t*)(ws + WS_U);
    bf16_t* PROJ = (bf16_t*)(ws + WS_PROJ); bf16_t* MIXED = (bf16_t*)(ws + WS_MIXED);

#ifndef SKIP_P0
    p_mod(lds, a.in[1], a.in[3], a.in[4], a.in[5], mod, bid, G, tid);
    p_transposes(lds, a, bid, G, tid);
    p_gwt(a.in[9], (bf16_t*)(ws + WS_GWT), bid, G, tid);
    p_rgpar(a.in[10], a.in[11], (float*)(ws + WS_RGPAR), bid, G, tid);
    p_wrt(a.in[17], a.in[19], (bf16_t*)(ws + WS_WRT), bid, G, tid);
#endif
#ifdef REP_P0
    grid.sync();
    FRESH_TID();
    p_mod(lds, a.in[1], a.in[3], a.in[4], a.in[5], mod, bid, G, tid);
    p_transposes(lds, a, bid, G, tid);
    p_gwt(a.in[9], (bf16_t*)(ws + WS_GWT), bid, G, tid);
    p_rgpar(a.in[10], a.in[11], (float*)(ws + WS_RGPAR), bid, G, tid);
    p_wrt(a.in[17], a.in[19], (bf16_t*)(ws + WS_WRT), bid, G, tid);
#endif
    GRID_BAR();
    FRESH_TID();
#ifdef REP_SYNC
    for (int r = 0; r < 10; ++r) GRID_BAR();
#endif
#ifndef SKIP_P1
    p_u(a.in[0], a.in[2], mod, U, bid, G, tid);
#endif
#ifdef REP_P1
    GRID_BAR();
    FRESH_TID();
    p_u(a.in[0], a.in[2], mod, U, bid, G, tid);
#endif
    GRID_BAR();
    FRESH_TID();
#ifdef REP_P2X
    { pg8::Gemm g{U, (const bf16_t*)(ws + WS_WINT), TA, NIN, DM}; pg8::StaticOrder S; S.init(TA, NIN, G, bid);
#if REP_P2X == 1
      pg8::EpiNull E{(float*)(ws + WS_OFST)};
      pg8::gemm_phase<pg8::EpiNull, pg8::StaticOrder, true, true>(lds, g, S, E); }
#else
      pg8::EpiInProj E{PROJ, REP_P2X - 1, 0};
      pg8::gemm_phase<pg8::EpiInProj, pg8::StaticOrder, true, true>(lds, g, S, E); }
#endif
    GRID_BAR();
    FRESH_TID();
#endif
#ifndef SKIP_P2
    stagger_wait((unsigned)((bid >> 3) & 7) * STAG_P2);
    { pg8::Gemm g{U, (const bf16_t*)(ws + WS_WINT), TA, NIN, DM}; pg8::StaticOrder S; S.init(TA, NIN, G, bid);
      pg8::EpiInProj E{PROJ, 0, 0};
      pg8::gemm_phase<pg8::EpiInProj, pg8::StaticOrder, true, true>(lds, g, S, E); }
#endif
#ifdef REP_P2
    GRID_BAR();
    FRESH_TID();
    { pg8::Gemm g{U, (const bf16_t*)(ws + WS_WINT), TA, NIN, DM}; pg8::StaticOrder S; S.init(TA, NIN, G, bid);
      pg8::EpiInProj E{PROJ, 0, 0};
      pg8::gemm_phase<pg8::EpiInProj, pg8::StaticOrder, true, true>(lds, g, S, E); }
#endif
    GRID_BAR();
    FRESH_TID();
#ifndef SKIP_P3A
    p_scan_a(lds, a, bid, G, tid, wave, lane);
#endif
#ifdef REP_P3A
    GRID_BAR();
    FRESH_TID();
    p_scan_a(lds, a, bid, G, tid, wave, lane, REP_P3A);
#endif
    GRID_BAR();
    FRESH_TID();
#ifdef REP_P3B
    p_scan_b(a, bid, G, tid, true);
    GRID_BAR();
    FRESH_TID();
#endif
#ifndef SKIP_P3B
    p_scan_b(a, bid, G, tid);
#endif
    GRID_BAR();
    FRESH_TID();
#ifdef PRE_P3C
    p_scan_c(lds, a, bid, G, tid, wave, lane, 1, PRE_P3C);
    GRID_BAR();
    FRESH_TID();
#endif
#ifndef SKIP_P3C
    p_scan_c(lds, a, bid, G, tid, wave, lane);
#endif
#ifdef REP_P3C
    GRID_BAR();
    FRESH_TID();
    p_scan_c(lds, a, bid, G, tid, wave, lane, REP_P3C);
#endif
    GRID_BAR();
    FRESH_TID();
#ifndef SKIP_P5
    { pg8::Gemm g{MIXED, (const bf16_t*)(ws + WS_WOUTT), T, DM, DM}; pg8::StaticOrder S; S.init(T, DM, G, bid);
      pg8::EpiY E{(bf16_t*)(ws + WS_XG)};
      pg8::gemm_phase<pg8::EpiY, pg8::StaticOrder, true, true>(lds, g, S, E); }
#endif
#ifdef REP_P5
    GRID_BAR();
    FRESH_TID();
    { pg8::Gemm g{MIXED, (const bf16_t*)(ws + WS_WOUTT), T, DM, DM}; pg8::StaticOrder S; S.init(T, DM, G, bid);
      pg8::EpiY E{(bf16_t*)(ws + WS_XG)};
      pg8::gemm_phase<pg8::EpiY, pg8::StaticOrder, true, true>(lds, g, S, E); }
#endif
    GRID_BAR();
    FRESH_TID();
#ifdef REP_P6
#pragma unroll 1
    for (int rep = 0; rep < 2; ++rep) { p_ln1_router(lds, a, bid, G, tid, wave, lane, rep == 0, rep == 0 ? REP_P6 : 3); if (rep == 0) GRID_BAR(); }
#else
    p_ln1_router(lds, a, bid, G, tid, wave, lane);
#endif
    GRID_BAR();
    FRESH_TID();
#ifndef SKIP_P7
    p_assign(lds, a, bid, G, tid);
#endif
#ifdef REP_P7
    GRID_BAR();
    FRESH_TID();
    p_assign(lds, a, bid, G, tid);
#endif
    GRID_BAR();
    FRESH_TID();
#ifndef SKIP_P8
    { pg8::Gemm g{(const bf16_t*)(ws + WS_U), (const bf16_t*)(ws + WS_W13T), MAXROWS, NE * DM, DM}; pg8::ExpertOrderG S{(const int*)(ws + WS_CTL), (const int*)(ws + WS_ROWTOK), G, bid};
      pg8::EpiExp1 E{(bf16_t*)(ws + WS_HID)};
      pg8::gemm_phase<pg8::EpiExp1, pg8::ExpertOrderG, true, true>(lds, g, S, E); }
#endif
#ifdef REP_P8
    GRID_BAR();
    FRESH_TID();
    { pg8::Gemm g{(const bf16_t*)(ws + WS_U), (const bf16_t*)(ws + WS_W13T), MAXROWS, NE * DM, DM}; pg8::ExpertOrderG S{(const int*)(ws + WS_CTL), (const int*)(ws + WS_ROWTOK), G, bid};
      pg8::EpiExp1 E{(bf16_t*)(ws + WS_HID)};
      pg8::gemm_phase<pg8::EpiExp1, pg8::ExpertOrderG, true, true>(lds, g, S, E); }
#endif
    GRID_BAR();
    FRESH_TID();
#ifndef SKIP_P9
    { pg8::Gemm g{(const bf16_t*)(ws + WS_HID), (const bf16_t*)(ws + WS_W2T), MAXROWS, NE * DM, DE}; pg8::ExpertOrder S{(const int*)(ws + WS_CTL), nullptr, G, bid};
      pg8::EpiY E{(bf16_t*)(ws + WS_Y)};
      pg8::gemm_phase<pg8::EpiY, pg8::ExpertOrder, true, true>(lds, g, S, E); }
#endif
#ifdef REP_P9
    GRID_BAR();
    FRESH_TID();
    { pg8::Gemm g{(const bf16_t*)(ws + WS_HID), (const bf16_t*)(ws + WS_W2T), MAXROWS, NE * DM, DE}; pg8::ExpertOrder S{(const int*)(ws + WS_CTL), nullptr, G, bid};
      pg8::EpiY E{(bf16_t*)(ws + WS_Y)};
      pg8::gemm_phase<pg8::EpiY, pg8::ExpertOrder, true, true>(lds, g, S, E); }
#endif
    GRID_BAR();
    FRESH_TID();
#ifdef REP_P10
    p_combine_ln2(a, bid, G, wave, lane, true);
    GRID_BAR();
    FRESH_TID();
#endif
#ifndef SKIP_P10
    p_combine_ln2(a, bid, G, wave, lane);
#endif
}

extern "C" void kernel_launch(void* const* d_in, const int* in_sizes, int n_in, void* d_out, int out_size, void* d_ws, size_t ws_size, hipStream_t stream) {
    static int grid = 0;
    if (grid == 0) {
        if (n_in != 26 || ws_size < WS_END) { fprintf(stderr, "kernel_launch: unexpected n_in %d or workspace %zu < %zu\n", n_in, ws_size, (size_t)WS_END); grid = -1; return; }
        int dev = 0, cus = 0, per_cu = 0;
        if (hipGetDevice(&dev) != hipSuccess || hipDeviceGetAttribute(&cus, hipDeviceAttributeMultiprocessorCount, dev) != hipSuccess) { grid = -1; return; }
        if (hipFuncSetAttribute((const void*)mega, hipFuncAttributeMaxDynamicSharedMemorySize, LDS_BYTES) != hipSuccess) { fprintf(stderr, "kernel_launch: hipFuncSetAttribute failed\n"); grid = -1; return; }
        if (hipOccupancyMaxActiveBlocksPerMultiprocessor(&per_cu, (const void*)mega, NTHREADS, LDS_BYTES) != hipSuccess || per_cu < 1) { fprintf(stderr, "kernel_launch: occupancy query says %d\n", per_cu); per_cu = 1; }
        (void)hipGetLastError();
        grid = cus;
        fprintf(stderr, "kernel_launch: grid %d (cus %d, per_cu %d), ws %zu\n", grid, cus, per_cu, ws_size);
    }
    if (grid < 0) return;
    (void)hipMemsetAsync(d_ws, 0, 131072, stream);
    Args a{};
    for (int i = 0; i < 26; ++i) a.in[i] = (const float*)d_in[i];
    a.out = (float*)d_out; a.ws = (unsigned char*)d_ws;
    void* params[] = {&a};
    hipError_t e = hipLaunchCooperativeKernel((const void*)mega, dim3(grid), dim3(NTHREADS), params, LDS_BYTES, stream);
    if (e != hipSuccess) fprintf(stderr, "kernel_launch: cooperative launch failed: %s (grid %d)\n", hipGetErrorString(e), grid);
}
```

```cpp
#include <hip/hip_runtime.h>
#include <hip/hip_cooperative_groups.h>
#include <cstdio>
#include <cstdint>
namespace cg = cooperative_groups;

typedef unsigned short bf16_t;
typedef short bf16x8 __attribute__((ext_vector_type(8)));
typedef float f32x4 __attribute__((ext_vector_type(4)));
typedef float f32x2 __attribute__((ext_vector_type(2)));
typedef unsigned u32x4 __attribute__((ext_vector_type(4)));
typedef unsigned u32x2 __attribute__((ext_vector_type(2)));
typedef int i32x4 __attribute__((ext_vector_type(4)));
#define LAS __attribute__((address_space(3)))

constexpr int NB = 16, SEQ = 4096, LC = 256, DM = 1024;
constexpr int T = NB * SEQ;
constexpr int TC = NB * LC;
constexpr int TA = T + TC;
constexpr int NIN = 3584;
constexpr int NE = 32, DE = 512;
constexpr int MAXROWS = 2 * T + NE * 256;
constexpr float ALPHA = 1.189207115002721f;
constexpr float LN_EPS = 1e-6f;
constexpr int NTHREADS = 512;

constexpr size_t MiB = 1u << 20;
constexpr size_t WS_CTL = 0;
constexpr size_t WS_BAR = 65536;
constexpr size_t WS_MOD = 1 * MiB;
constexpr size_t WS_EIDX = 3 * MiB;
constexpr size_t WS_EPOS = 3 * MiB + 512 * 1024;
constexpr size_t WS_EW = 4 * MiB;
constexpr size_t WS_DEST = 4 * MiB + 512 * 1024;
constexpr size_t WS_WINT = 6 * MiB;
constexpr size_t WS_WOUTT = 13 * MiB;
constexpr size_t WS_W13T = 15 * MiB;
constexpr size_t WS_W2T = 79 * MiB;
constexpr size_t WS_U = 112 * MiB;
constexpr size_t WS_PROJ = 248 * MiB;
constexpr size_t WS_XG = 248 * MiB;
constexpr size_t WS_HID = 520 * MiB;
constexpr size_t WS_Y = 656 * MiB;
constexpr size_t WS_MIXED = 724 * MiB;
constexpr size_t WS_OSUM = 852 * MiB;
constexpr size_t WS_END = 980 * MiB;
constexpr int LDS_BYTES = 163840;

__device__ __forceinline__ const bf16_t* proj_at(const bf16_t* P, int row, int col) { return P + (((size_t)(col >> 5) * TA + row) << 5) + (col & 31); }

__device__ __forceinline__ float bf2f(bf16_t b) { return __uint_as_float(((unsigned)b) << 16); }
__device__ __forceinline__ bf16_t f2bf(float f) { unsigned u = __float_as_uint(f); return (bf16_t)((u + 0x7fffu + ((u >> 16) & 1u)) >> 16); }
__device__ __forceinline__ unsigned pk2(float lo, float hi) { return (unsigned)f2bf(lo) | ((unsigned)f2bf(hi) << 16); }
__device__ __forceinline__ float frcp(float x) { return __builtin_amdgcn_rcpf(x); }
__device__ __forceinline__ float sigmoidf_(float x) { return frcp(1.0f + __expf(-x)); }
__device__ __forceinline__ float siluf_(float x) { return x * frcp(1.0f + __expf(-x)); }
__device__ __forceinline__ float gelu_tanh(float x) {
    const float y = 0.7978845608028654f * (x + 0.044715f * x * x * x);
    return x * frcp(1.0f + __expf(-2.0f * y));
}
__device__ __forceinline__ float softplusf_(float x) { return fmaxf(x, 0.f) + log1pf(expf(-fabsf(x))); }
__device__ __forceinline__ float wave_sum(float v) {
#pragma unroll
    for (int o = 1; o < 64; o <<= 1) v += __shfl_xor(v, o);
    return v;
}
constexpr int CSTR = 64;
__device__ __forceinline__ int pstart_of(const int* __restrict__ counts, int e) {
    int acc = 0;
    for (int i = 0; i < NE; ++i) { const int p = ((counts[i * CSTR] + 255) >> 8) << 8; if (i < e) acc += p; }
    return acc;
}

namespace pg8 {
#define PG8_LAS __attribute__((address_space(3)))
typedef unsigned short bf16_t;
typedef short bf16x8 __attribute__((ext_vector_type(8)));
typedef float f32x4 __attribute__((ext_vector_type(4)));
typedef unsigned u32x4 __attribute__((ext_vector_type(4)));
constexpr int BM = 256, BK = 64, HALF = 128, HTB = HALF * BK * 2  , STAGE_BYTES = 8 * HTB, NXCD = 8, WGM = 8;

__host__ __device__ __forceinline__ int lds_byte(int r, int c) { const int st = (r >> 4) * 2 + (c >> 5), rr = r & 15, cc = c & 31, ob = rr * 64 + cc * 2; return st * 1024 + (ob ^ (((ob >> 9) & 1) << 5)); }
__host__ __device__ __forceinline__ void stage_rc(int b, int& R, int& C) { const int st = b / 1024, sb = b % 1024, swz = sb ^ (((sb >> 9) & 1) << 5); R = (st >> 1) * 16 + swz / 64; C = (st & 1) * 32 + (swz % 64) / 2; }
__host__ __device__ __forceinline__ int perm32(int rho) { const int n = rho >> 4, i = rho & 15; return 8 * (i >> 2) + 4 * n + (i & 3); }

struct Unit { int pm, pn; };
struct Gemm { const bf16_t* A; const bf16_t* Bt; int M, N, K; };

struct StaticOrder {
    static constexpr bool GATHER = false; const int* rowtok = nullptr;
    int nM, nN, nwg, G, c;
    __host__ __device__ void init(int M, int N, int G_, int c_) { nM = M / BM; nN = N / BM; nwg = nM * nN; G = G_; c = c_; }
    __host__ __device__ bool next(int i, Unit& u) const {
        const long L = (long)i * G + c; if (L >= nwg) return false;
        int wgid = (int)L; { const int q = nwg / NXCD, r = nwg % NXCD, xcd = wgid % NXCD, off = wgid / NXCD; wgid = (xcd < r ? xcd * (q + 1) : r * (q + 1) + (xcd - r) * q) + off; }
        const int nig = WGM * nN, gid = wgid / nig, fm = gid * WGM, gsz = (nM - fm) < WGM ? (nM - fm) : WGM;
        u.pm = fm + ((wgid % nig) % gsz); u.pn = (wgid % nig) / gsz; return true;
    }
    __device__ __forceinline__ void a_ready(const Unit&) const {}
    __device__ __forceinline__ void done(const Unit&) const {}
};

__device__ __forceinline__ unsigned cvt_pk_bf16(float lo, float hi) { unsigned r; asm volatile("v_cvt_pk_bf16_f32 %0, %1, %2" : "=v"(r) : "v"(lo), "v"(hi)); return r; }

struct EpiInProj {
    static constexpr bool PERM = true, AFTER_DRAIN = false;
    bf16_t* P; int variant; int pad;
    __device__ __forceinline__ void operator()(const f32x4 (&acc)[2][2][4][2], const Unit& u, int wr, int wc, int fr_, int fq_) const {
        int fr = fr_, fq = fq_; asm volatile("" : "+v"(fr), "+v"(fq));
        const int row0 = u.pm * BM + wr * 64 + fr, col0 = u.pn * BM + wc * 32 + 8 * fq, grp = variant == 1 ? 0 : (u.pn >> 1);
#pragma unroll
        for (int ai = 0; ai < 2; ++ai)
#pragma unroll
            for (int m = 0; m < 4; ++m) { bf16_t* rowp = P + (((size_t)(8 * u.pn + wc) * TA + (row0 + ai * HALF + m * 16)) << 5) + 8 * fq;
#pragma unroll
                for (int bj = 0; bj < 2; ++bj) { f32x4 v0 = acc[ai][bj][m][0], v1 = acc[ai][bj][m][1];
                    if (grp == 1) {
#pragma unroll
                        for (int j = 0; j < 4; ++j) { v0[j] = gelu_tanh(v0[j]); v1[j] = gelu_tanh(v1[j]); } }
                    else if (grp == 2 || grp == 6) {
#pragma unroll
                        for (int j = 0; j < 4; ++j) { v0[j] = siluf_(v0[j]); v1[j] = siluf_(v1[j]); } }
                    u32x4 w; w.x = cvt_pk_bf16(v0[0], v0[1]); w.y = cvt_pk_bf16(v0[2], v0[3]); w.z = cvt_pk_bf16(v1[0], v1[1]); w.w = cvt_pk_bf16(v1[2], v1[3]);
                    if (variant == 3) { const int wv = __builtin_amdgcn_readfirstlane(threadIdx.x >> 6); *(u32x4*)(P + ((size_t)((u.pm * 14 + u.pn) * 8 + wv) * 16 + (ai * 4 + m) * 2 + bj) * 512 + (threadIdx.x & 63) * 8) = w; }
                    else if (variant != 2 || w.x == 0x12345678u) *(u32x4*)(rowp + (size_t)bj * 4 * TA * 32) = w; } }
    }
};
struct EpiNull {
    static constexpr bool PERM = true, AFTER_DRAIN = false;
    float* sink;
    __device__ __forceinline__ void operator()(const f32x4 (&acc)[2][2][4][2], const Unit& u, int wr, int wc, int fr_, int fq_) const {
        float s = 0.f;
#pragma unroll
        for (int ai = 0; ai < 2; ++ai)
#pragma unroll
            for (int bj = 0; bj < 2; ++bj)
#pragma unroll
                for (int m = 0; m < 4; ++m)
#pragma unroll
                    for (int n = 0; n < 2; ++n) s += acc[ai][bj][m][n][0] + acc[ai][bj][m][n][1] + acc[ai][bj][m][n][2] + acc[ai][bj][m][n][3];
        if (s == 123.456f) sink[0] = s;
    }
};
struct EpiF32 {
    static constexpr bool PERM = false, AFTER_DRAIN = false;
    float* C; int ldc; int pad;
    __device__ __forceinline__ void operator()(const f32x4 (&acc)[2][2][4][2], const Unit& u, int wr, int wc, int fr_, int fq_) const {
        int fr = fr_, fq = fq_; asm volatile("" : "+v"(fr), "+v"(fq));
        const int row0 = u.pm * BM + wr * 64 + fr, col0 = u.pn * BM + wc * 32 + 4 * fq;
#pragma unroll
        for (int ai = 0; ai < 2; ++ai)
#pragma unroll
            for (int m = 0; m < 4; ++m) { float* rowp = C + (size_t)(row0 + ai * HALF + m * 16) * ldc + col0;
#pragma unroll
                for (int bj = 0; bj < 2; ++bj)
#pragma unroll
                    for (int n = 0; n < 2; ++n) *(f32x4*)(rowp + bj * HALF + n * 16) = acc[ai][bj][m][n]; }
    }
};
struct EpiExp1 {
    static constexpr bool PERM = false, AFTER_DRAIN = false;
    bf16_t* H;
    __device__ __forceinline__ void operator()(const f32x4 (&acc)[2][2][4][2], const Unit& u, int wr, int wc, int fr_, int fq_) const {
        int fr = fr_, fq = fq_; asm volatile("" : "+v"(fr), "+v"(fq));
        const int row0 = u.pm * BM + wr * 64 + fr, hc0 = (((u.pn & 3) * BM + wc * 32) >> 1) + 4 * fq;
#pragma unroll
        for (int ai = 0; ai < 2; ++ai)
#pragma unroll
            for (int m = 0; m < 4; ++m) { bf16_t* rowp = H + (size_t)(row0 + ai * HALF + m * 16) * DE + hc0;
#pragma unroll
                for (int bj = 0; bj < 2; ++bj) { const f32x4 a = acc[ai][bj][m][0], b = acc[ai][bj][m][1];
                    u32x2 w; w.x = cvt_pk_bf16(siluf_(a[0]) * b[0], siluf_(a[1]) * b[1]); w.y = cvt_pk_bf16(siluf_(a[2]) * b[2], siluf_(a[3]) * b[3]);
                    *(u32x2*)(rowp + bj * 64) = w; } }
    }
};
struct EpiY {
    static constexpr bool PERM = true, AFTER_DRAIN = false;
    bf16_t* Y;
    __device__ __forceinline__ void operator()(const f32x4 (&acc)[2][2][4][2], const Unit& u, int wr, int wc, int fr_, int fq_) const {
        int fr = fr_, fq = fq_; asm volatile("" : "+v"(fr), "+v"(fq));
        const int row0 = u.pm * BM + wr * 64 + fr, col0 = (u.pn & 3) * BM + wc * 32 + 8 * fq;
#pragma unroll
        for (int ai = 0; ai < 2; ++ai)
#pragma unroll
            for (int m = 0; m < 4; ++m) { bf16_t* rowp = Y + (size_t)(row0 + ai * HALF + m * 16) * DM + col0;
#pragma unroll
                for (int bj = 0; bj < 2; ++bj) { const f32x4 v0 = acc[ai][bj][m][0], v1 = acc[ai][bj][m][1];
                    u32x4 w; w.x = cvt_pk_bf16(v0[0], v0[1]); w.y = cvt_pk_bf16(v0[2], v0[3]); w.z = cvt_pk_bf16(v1[0], v1[1]); w.w = cvt_pk_bf16(v1[2], v1[3]);
                    *(u32x4*)(rowp + bj * HALF) = w; } }
    }
};
template <bool GATHER_>
struct ExpertOrderT {
    static constexpr bool GATHER = GATHER_;
    const int* rbpre; const int* rowtok; int G, c;
    __device__ __forceinline__ bool next(int i, Unit& u) const {
        const int cs = (G & 7) == 0 ? (c & 7) * (G >> 3) + (c >> 3) : c;
        const int L = i * G + cs, rb = L >> 2; int ef = -1;
        for (int e = 0; e < NE; ++e) { if (rb >= rbpre[e] && rb < rbpre[e + 1]) ef = e; }
        if (ef < 0) return false;
        u.pm = rb; u.pn = ef * 4 + (L & 3); return true;
    }
    __device__ __forceinline__ void a_ready(const Unit&) const {}
    __device__ __forceinline__ void done(const Unit&) const {}
};
typedef ExpertOrderT<false> ExpertOrder;
typedef ExpertOrderT<true> ExpertOrderG;

template <class Epi, class Sched, bool ALIGN_EPI = false, bool SP2 = false>
__device__ __forceinline__ void gemm_phase(PG8_LAS unsigned char* lds, const Gemm g, const Sched& S, const Epi& E) {
    int tid_o = threadIdx.x; asm volatile("" : "+v"(tid_o));
    const int tid = tid_o, wid = __builtin_amdgcn_readfirstlane(tid >> 6), lane = tid & 63, wr = wid >> 2, wc = wid & 3, fr = lane & 15, fq = lane >> 4;
    static_assert(SP2 || !Sched::GATHER, "the gathered A operand is wired into the SP2 loop only");
    const int K = g.K, nt = K / BK;
    unsigned voffA[2], voffB[2];
    unsigned gAc[2][2], gAn[2][2]; int gR[2], gC[2];
#pragma unroll
    for (int i = 0; i < 2; ++i) { int R, C; stage_rc(tid * 16 + i * 8192, R, C); const int Rb = Epi::PERM ? ((R & ~31) + perm32(R & 31)) : R;
        voffA[i] = (unsigned)(R * K + C) * 2u; voffB[i] = (unsigned)(Rb * K + C) * 2u; gR[i] = R; gC[i] = C; }
    const size_t kstep = (size_t)(BK * 2);
    const size_t hstep = (size_t)HALF * K * 2;
    const size_t tstep = 2 * hstep;
    const unsigned ldsw = (unsigned)wid * 1024u;
    const int aoff = lds_byte(wr * 64 + fr, fq * 8), boff = lds_byte(wc * 32 + fr, fq * 8);
#define PG8_SA(b, h) (((b) * 2 + (h)) * HTB)
#define PG8_SB(b, h) ((4 + (b) * 2 + (h)) * HTB)
#define PG8_STAGE(bufoff, gbase, voff) do { _Pragma("unroll") for (int _i = 0; _i < 2; ++_i) \
        __builtin_amdgcn_global_load_lds((const unsigned*)((const char*)(gbase) + (voff)[_i]), (PG8_LAS unsigned*)(lds + (bufoff) + ldsw + _i * 8192), 16, 0, 0); } while (0)
#define PG8_STAGE_A(bufoff, ptr, h, goff) do { if constexpr (Sched::GATHER) { PG8_STAGE(bufoff, ptr, (goff)[h]); } else { PG8_STAGE(bufoff, (ptr) + (h) * hstep, voffA); } } while (0)
#define PG8_GLOAD(dst, u) do { _Pragma("unroll") for (int _h = 0; _h < 2; ++_h) _Pragma("unroll") for (int _i = 0; _i < 2; ++_i) \
        dst[_h][_i] = (unsigned)S.rowtok[(u).pm * BM + _h * HALF + gR[_i]] * (unsigned)(K * 2) + (unsigned)(gC[_i] * 2); } while (0)
#define PG8_LDA(dst, b, h) do { _Pragma("unroll") for (int m = 0; m < 4; ++m) _Pragma("unroll") for (int k = 0; k < 2; ++k) dst[m][k] = *(const PG8_LAS bf16x8*)(lds + PG8_SA(b, h) + aoff + m * 2048 + k * 1024); } while (0)
#define PG8_LDB(dst, b, h) do { _Pragma("unroll") for (int n = 0; n < 2; ++n) _Pragma("unroll") for (int k = 0; k < 2; ++k) dst[n][k] = *(const PG8_LAS bf16x8*)(lds + PG8_SB(b, h) + boff + n * 2048 + k * 1024); } while (0)
#define PG8_MMA(ai, bj, At, Bt) do { __builtin_amdgcn_s_setprio(1); _Pragma("unroll") for (int m = 0; m < 4; ++m) _Pragma("unroll") for (int n = 0; n < 2; ++n) _Pragma("unroll") for (int k = 0; k < 2; ++k) \
        acc[ai][bj][m][n] = __builtin_amdgcn_mfma_f32_16x16x32_bf16(Bt[n][k], At[m][k], acc[ai][bj][m][n], 0, 0, 0); __builtin_amdgcn_s_setprio(0); } while (0)
#define PG8_WAIT_V(n) asm volatile("s_waitcnt vmcnt(" #n ")" ::: "memory")
#define PG8_WAIT_L(n) asm volatile("s_waitcnt lgkmcnt(" #n ")" ::: "memory")
#define PG8_BAR __builtin_amdgcn_s_barrier()
#define PG8_SCHED __builtin_amdgcn_sched_barrier(0)
    Unit cur, nxt; int ui = 0;
    if (!S.next(0, cur)) return;
    f32x4 acc[2][2][4][2];
#pragma unroll
    for (int a = 0; a < 2; ++a)
#pragma unroll
        for (int b = 0; b < 2; ++b)
#pragma unroll
            for (int m = 0; m < 4; ++m)
#pragma unroll
                for (int n = 0; n < 2; ++n) acc[a][b][m][n] = (f32x4){0.f, 0.f, 0.f, 0.f};
    bf16x8 At[4][2], B0[2][2], B1[2][2];
    const char* cA = (const char*)g.A + (Sched::GATHER ? (size_t)0 : (size_t)cur.pm * tstep); const char* cB = (const char*)g.Bt + (size_t)cur.pn * tstep;
    if constexpr (Sched::GATHER) { PG8_GLOAD(gAc, cur); }
    S.a_ready(cur);
    if constexpr (SP2) {
        PG8_STAGE(PG8_SB(0, 0), cB, voffB); PG8_STAGE(PG8_SB(0, 1), cB + hstep, voffB); PG8_STAGE_A(PG8_SA(0, 0), cA, 0, gAc); PG8_STAGE_A(PG8_SA(0, 1), cA, 1, gAc);
        if (wr == 1) PG8_BAR;
        PG8_WAIT_V(2); PG8_BAR;
        PG8_STAGE(PG8_SB(1, 0), cB + kstep, voffB); PG8_STAGE_A(PG8_SA(1, 0), cA + kstep, 0, gAc); PG8_STAGE(PG8_SB(1, 1), cB + hstep + kstep, voffB);
        PG8_WAIT_V(6); PG8_BAR;
    } else {
        PG8_STAGE(PG8_SB(0, 0), cB, voffB); PG8_STAGE(PG8_SA(0, 0), cA, voffA); PG8_STAGE(PG8_SB(0, 1), cB + hstep, voffB); PG8_STAGE(PG8_SA(0, 1), cA + hstep, voffA);
        if (wr == 1) PG8_BAR;
        PG8_WAIT_V(4); PG8_BAR;
        PG8_STAGE(PG8_SB(1, 0), cB + kstep, voffB); PG8_STAGE(PG8_SA(1, 0), cA + kstep, voffA); PG8_STAGE(PG8_SB(1, 1), cB + hstep + kstep, voffB);
        PG8_WAIT_V(6); PG8_BAR;
    }
    for (;;) {
        const bool has_next = S.next(ui + 1, nxt);
        const char* nA = (has_next && !Sched::GATHER) ? (const char*)g.A + (size_t)nxt.pm * tstep : cA;
        if constexpr (Sched::GATHER) { if (has_next) { PG8_GLOAD(gAn, nxt); } else { _Pragma("unroll") for (int _h = 0; _h < 2; ++_h) _Pragma("unroll") for (int _i = 0; _i < 2; ++_i) gAn[_h][_i] = gAc[_h][_i]; } }
        const char* nB = has_next ? (const char*)g.Bt + (size_t)nxt.pn * tstep : cB;
        for (int t = 0; t < nt; t += 2) {
            const bool last = (t == nt - 2);
            const char* a1 = cA + (size_t)(t + 1) * kstep;
            const char* a2 = last ? nA : cA + (size_t)(t + 2) * kstep; const char* b2 = last ? nB : cB + (size_t)(t + 2) * kstep;
            const char* a3 = a2 + kstep; const char* b3 = b2 + kstep;
            if (last && has_next) S.a_ready(nxt);
            unsigned g2[2][2];
            if constexpr (Sched::GATHER) { _Pragma("unroll") for (int _h = 0; _h < 2; ++_h) _Pragma("unroll") for (int _i = 0; _i < 2; ++_i) g2[_h][_i] = last ? gAn[_h][_i] : gAc[_h][_i]; }
            if constexpr (SP2) {
            PG8_LDB(B0, 0, 0); PG8_LDB(B1, 0, 1); PG8_SCHED; PG8_LDA(At, 0, 0); PG8_STAGE_A(PG8_SA(1, 1), a1, 1, gAc);
            PG8_WAIT_V(8); PG8_WAIT_L(0); PG8_BAR; PG8_MMA(0, 0, At, B0); PG8_MMA(0, 1, At, B1); PG8_BAR; PG8_SCHED;
            PG8_LDA(At, 0, 1); PG8_STAGE(PG8_SB(0, 0), b2, voffB); PG8_STAGE(PG8_SB(0, 1), b2 + hstep, voffB); PG8_STAGE_A(PG8_SA(0, 0), a2, 0, g2);
            PG8_WAIT_V(8); PG8_WAIT_L(0); PG8_BAR; PG8_MMA(1, 0, At, B0); PG8_MMA(1, 1, At, B1); PG8_BAR; PG8_SCHED;
            PG8_LDB(B0, 1, 0); PG8_LDB(B1, 1, 1); PG8_SCHED; PG8_LDA(At, 1, 0); PG8_STAGE_A(PG8_SA(0, 1), a2, 1, g2);
            PG8_WAIT_V(8); PG8_WAIT_L(0); PG8_BAR; PG8_MMA(0, 0, At, B0); PG8_MMA(0, 1, At, B1); PG8_BAR; PG8_SCHED;
            PG8_LDA(At, 1, 1); PG8_STAGE(PG8_SB(1, 0), b3, voffB); PG8_STAGE(PG8_SB(1, 1), b3 + hstep, voffB); PG8_STAGE_A(PG8_SA(1, 0), a3, 0, g2);
            PG8_WAIT_V(8); PG8_WAIT_L(0); PG8_BAR; PG8_MMA(1, 0, At, B0); PG8_MMA(1, 1, At, B1); PG8_BAR; PG8_SCHED;
            } else {
            PG8_LDB(B0, 0, 0); PG8_SCHED; PG8_LDA(At, 0, 0); PG8_STAGE(PG8_SA(1, 1), a1 + hstep, voffA);
            PG8_WAIT_L(8); PG8_BAR; PG8_WAIT_L(0); PG8_MMA(0, 0, At, B0); PG8_BAR; PG8_SCHED;
            PG8_LDB(B1, 0, 1); PG8_STAGE(PG8_SB(0, 0), b2, voffB);
            PG8_BAR; PG8_WAIT_L(0); PG8_MMA(0, 1, At, B1); PG8_BAR;
            PG8_LDA(At, 0, 1); PG8_STAGE(PG8_SA(0, 0), a2, voffA);
            PG8_BAR; PG8_WAIT_L(0); PG8_MMA(1, 0, At, B0); PG8_BAR; PG8_SCHED;
            PG8_STAGE(PG8_SB(0, 1), b2 + hstep, voffB);
            PG8_WAIT_V(6); PG8_BAR; PG8_MMA(1, 1, At, B1); PG8_BAR;
            PG8_LDB(B0, 1, 0); PG8_SCHED; PG8_LDA(At, 1, 0); PG8_STAGE(PG8_SA(0, 1), a2 + hstep, voffA);
            PG8_WAIT_L(8); PG8_BAR; PG8_WAIT_L(0); PG8_MMA(0, 0, At, B0); PG8_BAR; PG8_SCHED;
            PG8_LDB(B1, 1, 1); PG8_STAGE(PG8_SB(1, 0), b3, voffB);
            PG8_BAR; PG8_WAIT_L(0); PG8_MMA(0, 1, At, B1); PG8_BAR;
            PG8_LDA(At, 1, 1); PG8_STAGE(PG8_SA(1, 0), a3, voffA);
            PG8_BAR; PG8_WAIT_L(0); PG8_MMA(1, 0, At, B0); PG8_BAR; PG8_SCHED;
            PG8_STAGE(PG8_SB(1, 1), b3 + hstep, voffB);
            PG8_WAIT_V(6); PG8_BAR; PG8_MMA(1, 1, At, B1); PG8_BAR;
            }
        }
        if constexpr (ALIGN_EPI) { if (wr == 0) PG8_BAR; }
        if constexpr (!Epi::AFTER_DRAIN) { E(acc, cur, wr, wc, fr, fq); S.done(cur); }
        if (!has_next) break;
#pragma unroll
        for (int a = 0; a < 2; ++a)
#pragma unroll
            for (int b = 0; b < 2; ++b)
#pragma unroll
                for (int m = 0; m < 4; ++m)
#pragma unroll
                    for (int n = 0; n < 2; ++n) acc[a][b][m][n] = (f32x4){0.f, 0.f, 0.f, 0.f};
        cur = nxt; cA = nA; cB = nB; ++ui;
        if constexpr (Sched::GATHER) { _Pragma("unroll") for (int _h = 0; _h < 2; ++_h) _Pragma("unroll") for (int _i = 0; _i < 2; ++_i) gAc[_h][_i] = gAn[_h][_i]; }
        if constexpr (ALIGN_EPI) { if (wr == 1) PG8_BAR; }
    }
    PG8_WAIT_V(0);
    if constexpr (!ALIGN_EPI) { if (wr == 0) PG8_BAR; }
    PG8_BAR;
    if constexpr (Epi::AFTER_DRAIN) { E.fused(acc, cur, wr, wc, fr, fq, lds, wid, lane); S.done(cur); }
#undef PG8_SA
#undef PG8_SB
#undef PG8_STAGE
#undef PG8_STAGE_A
#undef PG8_GLOAD
#undef PG8_LDA
#undef PG8_LDB
#undef PG8_MMA
#undef PG8_WAIT_V
#undef PG8_WAIT_L
#undef PG8_BAR
#undef PG8_SCHED
}
}

struct Args { const float* in[26]; float* out; unsigned char* ws; };

__device__ __forceinline__ void p_mod(LAS unsigned char* lds, const float* __restrict__ c, const float* __restrict__ c_ctx, const float* __restrict__ ada_w,
                                      const float* __restrict__ ada_b, float* __restrict__ mod, int bid, int G, int tid) {
    if (bid >= 96) return;
    LAS float* s = (LAS float*)lds;
    LAS float* red = s + 17 * 1024;
    for (int i = tid; i < 17 * 1024; i += NTHREADS) { const int r = i >> 10, k = i & 1023; const float v = r < NB ? c[r * DM + k] : c_ctx[k]; s[i] = v / (1.0f + expf(-v)); }
    __syncthreads();
    for (int it = bid; it < 96; it += G) {
        const int cc = tid & 63, kg = tid >> 6, col = it * 64 + cc;
        float acc[17];
#pragma unroll
        for (int r = 0; r < 17; ++r) acc[r] = 0.f;
        for (int k = kg * 128; k < kg * 128 + 128; ++k) {
            const float w = ada_w[(size_t)k * 6144 + col];
#pragma unroll
            for (int r = 0; r < 17; ++r) acc[r] += s[r * 1024 + k] * w;
        }
#pragma unroll
        for (int r = 0; r < 17; ++r) red[(kg * 17 + r) * 64 + cc] = acc[r];
        __syncthreads();
        for (int i = tid; i < 17 * 64; i += NTHREADS) {
            const int r = i >> 6, c2 = i & 63; float sum = 0.f;
#pragma unroll
            for (int g = 0; g < 8; ++g) sum += red[(g * 17 + r) * 64 + c2];
            mod[(size_t)r * 6144 + it * 64 + c2] = sum + ada_b[it * 64 + c2];
        }
        __syncthreads();
    }
}

struct TrTile { const float* W; bf16_t* O; int K, N, mode, k0, n0; };
__device__ __forceinline__ TrTile tr_decode(const Args& a, int r) {
    unsigned char* ws = a.ws;
    constexpr int I_IN = 16 * 56, I_OUT = 16 * 16, I_E = 32 * 128;
    TrTile t;
    if (r < I_IN) { t = TrTile{a.in[6], (bf16_t*)(ws + WS_WINT), DM, NIN, 0, (r & 15) * 64, (r >> 4) * 64}; return t; } r -= I_IN;
    if (r < I_OUT) { t = TrTile{a.in[14], (bf16_t*)(ws + WS_WOUTT), DM, DM, 0, (r & 15) * 64, (r >> 4) * 64}; return t; } r -= I_OUT;
    if (r < I_E) { const int e = r >> 7, q = r & 127; t = TrTile{a.in[21] + (size_t)e * DM * DE, (bf16_t*)(ws + WS_W13T) + (size_t)e * DM * DM, DM, DE, 1, (q & 15) * 64, (q >> 4) * 64}; return t; } r -= I_E;
    if (r < I_E) { const int e = r >> 7, q = r & 127; t = TrTile{a.in[22] + (size_t)e * DM * DE, (bf16_t*)(ws + WS_W13T) + (size_t)e * DM * DM, DM, DE, 2, (q & 15) * 64, (q >> 4) * 64}; return t; } r -= I_E;
    { const int e = r >> 7, q = r & 127; t = TrTile{a.in[23] + (size_t)e * DE * DM, (bf16_t*)(ws + WS_W2T) + (size_t)e * DM * DE, DE, DM, 0, (q & 7) * 64, (q >> 3) * 64}; return t; }
}
__device__ __forceinline__ void p_transposes(LAS unsigned char* lds, const Args& a, int bid, int G, int tid) {
    constexpr int NITEMS = (16 * 56 + 16 * 16 + 3 * 32 * 128) / 4;
    const int lrow = tid >> 4, lc4 = (tid & 15) * 4;
    const int sc = tid & 7, sn = tid >> 3;
    for (int it = bid; it < NITEMS; it += G) {
        f32x4 v[4][2]; TrTile t[4];
#pragma unroll
        for (int q = 0; q < 4; ++q) { t[q] = tr_decode(a, it * 4 + q);
#pragma unroll
            for (int h = 0; h < 2; ++h) v[q][h] = *(const f32x4*)(t[q].W + (size_t)(t[q].k0 + lrow + 32 * h) * t[q].N + t[q].n0 + lc4); }
        __syncthreads();
#pragma unroll
        for (int q = 0; q < 4; ++q) { LAS float* tile = (LAS float*)lds + q * (64 * 65);
#pragma unroll
            for (int h = 0; h < 2; ++h)
#pragma unroll
                for (int j = 0; j < 4; ++j) tile[(lrow + 32 * h) * 65 + lc4 + j] = v[q][h][j]; }
        __syncthreads();
#pragma unroll
        for (int q = 0; q < 4; ++q) { const LAS float* tile = (const LAS float*)lds + q * (64 * 65) + (8 * sc) * 65 + sn;
            const int n = t[q].n0 + sn, mode = t[q].mode;
            const int orow = mode == 0 ? n : ((n >> 4) * 32 + (mode == 2 ? 16 : 0) + (n & 15));
            u32x4 w; w.x = pk2(tile[0 * 65], tile[1 * 65]); w.y = pk2(tile[2 * 65], tile[3 * 65]); w.z = pk2(tile[4 * 65], tile[5 * 65]); w.w = pk2(tile[6 * 65], tile[7 * 65]);
            *(u32x4*)(t[q].O + (size_t)orow * t[q].K + t[q].k0 + 8 * sc) = w; }
    }
    __syncthreads();
}

__device__ __forceinline__ void p_u(const float* __restrict__ x, const float* __restrict__ ctx, const float* __restrict__ mod, bf16_t* __restrict__ U, int bid, int G, int tid) {
    const int c8 = (tid & 127) * 8, rsub = tid >> 7;
    for (int row0 = bid * 16; row0 < TA; row0 += G * 16) {
        f32x4 v[4][2];
#pragma unroll
        for (int q = 0; q < 4; ++q) { const int row = row0 + q * 4 + rsub; const float* src = row < T ? x + (size_t)row * DM : ctx + (size_t)(row - T) * DM;
            v[q][0] = *(const f32x4*)(src + c8); v[q][1] = *(const f32x4*)(src + c8 + 4); }
#pragma unroll
        for (int q = 0; q < 4; ++q) { const int row = row0 + q * 4 + rsub; const float* m = mod + (size_t)(row < T ? row / SEQ : 16) * 6144;
            const f32x4 sh0 = *(const f32x4*)(m + c8), sh1 = *(const f32x4*)(m + c8 + 4), sc0 = *(const f32x4*)(m + 1024 + c8), sc1 = *(const f32x4*)(m + 1024 + c8 + 4);
            const f32x4 u0 = v[q][0] * (1.0f + sc0) + sh0, u1 = v[q][1] * (1.0f + sc1) + sh1;
            u32x4 w; w.x = pk2(u0[0], u0[1]); w.y = pk2(u0[2], u0[3]); w.z = pk2(u1[0], u1[1]); w.w = pk2(u1[2], u1[3]);
            *(u32x4*)(U + (size_t)row * DM + c8) = w; }
    }
}

constexpr size_t WS_H1 = WS_XG + 128 * MiB;
constexpr size_t WS_WRT = 878 * MiB;
__device__ __forceinline__ void p_wrt(const float* __restrict__ rgw, const float* __restrict__ rew, bf16_t* __restrict__ wrt, int bid, int G, int tid) {
    for (int o = bid * NTHREADS + tid; o < 48 * 1024; o += G * NTHREADS) { const int e = o >> 10, k = o & 1023;
        const float w = e < 4 ? rgw[k * 4 + e] : (e < 36 ? rew[k * 32 + (e - 4)] : 0.f);
        const bf16_t hi = f2bf(w); wrt[o] = hi; wrt[48 * 1024 + o] = f2bf(w - bf2f(hi)); }
}
__device__ __forceinline__ void p_ln1_router(LAS unsigned char* lds, const Args& a, int bid, int G, int tid, int wave, int lane, bool dry = false, int parts = 3) {
    const float* __restrict__ x = a.in[0]; const bf16_t* yb = (const bf16_t*)(a.ws + WS_XG); bf16_t* h1o = (bf16_t*)(a.ws + (dry ? WS_HID : WS_H1)); const float* mod = (const float*)(a.ws + WS_MOD);
    const float* __restrict__ ln_g = a.in[15]; const float* __restrict__ ln_b = a.in[16]; const float* __restrict__ rgb = a.in[18]; const float* __restrict__ reb = a.in[20];
    bf16_t* U2 = (bf16_t*)(a.ws + (dry ? WS_Y + 16 * MiB : WS_U)); int* counts = (int*)(a.ws + WS_CTL) + (dry ? 32 * CSTR : 0);
    int2* eidx = (int2*)(a.ws + (dry ? WS_Y : WS_EIDX)); int2* epos = (int2*)(a.ws + (dry ? WS_Y + 4 * MiB : WS_EPOS)); float2* ew = (float2*)(a.ws + (dry ? WS_Y + 8 * MiB : WS_EW));
    const bf16_t* __restrict__ wrt = (const bf16_t*)(a.ws + WS_WRT);
    constexpr int WB_STRIDE = 528;
    LAS unsigned char* WB = lds;
    LAS float* LG = (LAS float*)(lds + 51200);
    LAS int* lcnt = (LAS int*)(lds + 102400);
    LAS int* lbase = lcnt + 32;
    LAS i32x4* tinfo = (LAS i32x4*)(lbase + 32);
    LAS f32x2* tw = (LAS f32x2*)(tinfo + 256);
    if (tid < 32) lcnt[tid] = 0;
    for (int blk = bid; blk < T / 256; blk += G) {
        const int tokb = blk * 256;
        const float* m = mod + (size_t)(tokb / SEQ) * 6144;
        if (parts & 1) {
            f32x4 xr[2][4]; u32x2 yr[2][4];
#pragma unroll
            for (int t = 0; t < 2; ++t)
#pragma unroll
                for (int j = 0; j < 4; ++j) { const int c4 = 4 * lane + 256 * j; const int tok = tokb + wave * 32 + t;
                    xr[t][j] = *(const f32x4*)(x + (size_t)tok * DM + c4); yr[t][j] = *(const u32x2*)(yb + (size_t)tok * DM + c4); }
#pragma unroll 1
            for (int it = 0; it < 16; ++it) {
                int l2 = lane; asm volatile("" : "+v"(l2)); const int lane = l2;
                const int tok0 = tokb + wave * 32 + 2 * it;
                f32x4 v[2][4]; float s[2] = {0.f, 0.f};
#pragma unroll
                for (int t = 0; t < 2; ++t)
#pragma unroll
                    for (int j = 0; j < 4; ++j) { const int c4 = 4 * lane + 256 * j;
                        const f32x4 g1 = *(const f32x4*)(m + 2048 + c4); const u32x2 yw = yr[t][j];
                        const f32x4 yv = (f32x4){__uint_as_float(yw.x << 16), __uint_as_float(yw.x & 0xffff0000u), __uint_as_float(yw.y << 16), __uint_as_float(yw.y & 0xffff0000u)};
                        v[t][j] = ALPHA * xr[t][j] + g1 * yv; s[t] += (v[t][j][0] + v[t][j][1]) + (v[t][j][2] + v[t][j][3]); }
                if (it < 15) {
#pragma unroll
                    for (int t = 0; t < 2; ++t)
#pragma unroll
                        for (int j = 0; j < 4; ++j) { const int c4 = 4 * lane + 256 * j; const int tok = tok0 + 2 + t;
                            xr[t][j] = *(const f32x4*)(x + (size_t)tok * DM + c4); yr[t][j] = *(const u32x2*)(yb + (size_t)tok * DM + c4); }
                }
                float rstd[2];
#pragma unroll
                for (int t = 0; t < 2; ++t) { const float mean = wave_sum(s[t]) * (1.0f / DM); float s2 = 0.f;
#pragma unroll
                    for (int j = 0; j < 4; ++j) { v[t][j] = v[t][j] - mean; s2 += (v[t][j][0] * v[t][j][0] + v[t][j][1] * v[t][j][1]) + (v[t][j][2] * v[t][j][2] + v[t][j][3] * v[t][j][3]); }
                    rstd[t] = rsqrtf(wave_sum(s2) * (1.0f / DM) + LN_EPS); }
#pragma unroll
                for (int j = 0; j < 4; ++j) { const int c4 = 4 * lane + 256 * j;
                    const f32x4 lg = *(const f32x4*)(ln_g + c4), lb = *(const f32x4*)(ln_b + c4), sc2 = *(const f32x4*)(m + 4096 + c4), sh2 = *(const f32x4*)(m + 3072 + c4);
#pragma unroll
                    for (int t = 0; t < 2; ++t) { const f32x4 h1 = v[t][j] * rstd[t] * lg + lb;
                        u32x2 hw; hw.x = pk2(h1[0], h1[1]); hw.y = pk2(h1[2], h1[3]);
                        *(u32x2*)(h1o + (size_t)(tok0 + t) * DM + c4) = hw;
                        const f32x4 u2 = h1 * (1.0f + sc2) + sh2;
                        u32x2 w; w.x = pk2(u2[0], u2[1]); w.y = pk2(u2[2], u2[3]);
                        *(u32x2*)(U2 + (size_t)(tok0 + t) * DM + c4) = w; }
                }
            }
        }
        __syncthreads();
        __builtin_amdgcn_fence(__ATOMIC_ACQUIRE, "agent");
        asm volatile("s_waitcnt vmcnt(0)" ::: "memory");
        const int fr = lane & 15, fq = lane >> 4;
        if (parts & 2) {
            f32x4 acc[2][3];
#pragma unroll
            for (int gi = 0; gi < 2; ++gi)
#pragma unroll
                for (int nt = 0; nt < 3; ++nt) acc[gi][nt] = (f32x4){0.f, 0.f, 0.f, 0.f};
            const bf16_t* arow0 = U2 + (size_t)(tokb + (wave * 2 + 0) * 16 + fr) * DM + fq * 8;
            const bf16_t* arow1 = arow0 + (size_t)16 * DM;
#pragma unroll 1
            for (int ch = 0; ch < 4; ++ch) {
                u32x4 wreg[6];
#pragma unroll
                for (int p = 0; p < 6; ++p) { const int idx = p * NTHREADS + tid, row = idx >> 5, piece = idx & 31;
                    wreg[p] = *(const u32x4*)(wrt + (size_t)row * 1024 + ch * 256 + piece * 8); }
                __syncthreads();
#pragma unroll
                for (int p = 0; p < 6; ++p) { const int idx = p * NTHREADS + tid, row = idx >> 5, piece = idx & 31;
                    *(LAS u32x4*)(WB + row * WB_STRIDE + piece * 16) = wreg[p]; }
                __syncthreads();
#pragma unroll 2
                for (int ks = 0; ks < 8; ++ks) {
                    const bf16x8 af0 = *(const bf16x8*)(arow0 + ch * 256 + ks * 32), af1 = *(const bf16x8*)(arow1 + ch * 256 + ks * 32);
#pragma unroll
                    for (int nt = 0; nt < 3; ++nt) {
                        const bf16x8 bh = *(const LAS bf16x8*)(WB + (nt * 16 + fr) * WB_STRIDE + (ks * 32 + fq * 8) * 2), bl = *(const LAS bf16x8*)(WB + (48 + nt * 16 + fr) * WB_STRIDE + (ks * 32 + fq * 8) * 2);
                        acc[0][nt] = __builtin_amdgcn_mfma_f32_16x16x32_bf16(af0, bh, acc[0][nt], 0, 0, 0);
                        acc[1][nt] = __builtin_amdgcn_mfma_f32_16x16x32_bf16(af1, bh, acc[1][nt], 0, 0, 0);
                        acc[0][nt] = __builtin_amdgcn_mfma_f32_16x16x32_bf16(af0, bl, acc[0][nt], 0, 0, 0);
                        acc[1][nt] = __builtin_amdgcn_mfma_f32_16x16x32_bf16(af1, bl, acc[1][nt], 0, 0, 0);
                    }
                }
            }
            LAS float* lg = LG + wave * (2 * 16 * 48);
#pragma unroll
            for (int gi = 0; gi < 2; ++gi)
#pragma unroll
                for (int nt = 0; nt < 3; ++nt)
#pragma unroll
                    for (int j = 0; j < 4; ++j) lg[(gi * 16 + 4 * fq + j) * 48 + 16 * nt + fr] = acc[gi][nt][j];
            asm volatile("s_waitcnt lgkmcnt(0)" ::: "memory");
            if (lane < 32) {
                float pl[36];
#pragma unroll
                for (int e4 = 0; e4 < 9; ++e4) { const f32x4 q = *(const LAS f32x4*)(lg + lane * 48 + 4 * e4);
#pragma unroll
                    for (int r = 0; r < 4; ++r) pl[4 * e4 + r] = q[r]; }
#pragma unroll
                for (int e = 0; e < 36; ++e) pl[e] += e < 4 ? rgb[e] : reb[e - 4];
                int gsel = 0; float gm = pl[0];
#pragma unroll
                for (int g = 1; g < 4; ++g) if (pl[g] > gm) { gm = pl[g]; gsel = g; }
                float den = 0.f;
#pragma unroll
                for (int g = 0; g < 4; ++g) den += __expf(pl[g] - gm);
                const float gval = frcp(den);
                int j0 = -1; float v0 = -3.0e38f;
#pragma unroll
                for (int j = 0; j < 32; ++j) { const bool in = (j >> 3) == gsel; if (in && (j0 < 0 || pl[4 + j] > v0)) { v0 = pl[4 + j]; j0 = j; } }
                int j1 = -1; float v1 = -3.0e38f;
#pragma unroll
                for (int j = 0; j < 32; ++j) { const bool in = (j >> 3) == gsel; if (in && j != j0 && (j1 < 0 || pl[4 + j] > v1)) { v1 = pl[4 + j]; j1 = j; } }
                const float tt = __expf(v1 - v0), w0 = frcp(1.0f + tt), w1 = tt * w0;
                const int p0 = __hip_atomic_fetch_add(lcnt + j0, 1, __ATOMIC_RELAXED, __HIP_MEMORY_SCOPE_WORKGROUP), p1 = __hip_atomic_fetch_add(lcnt + j1, 1, __ATOMIC_RELAXED, __HIP_MEMORY_SCOPE_WORKGROUP);
                const int slot = wave * 32 + lane;
                tinfo[slot] = (i32x4){j0, j1, p0, p1}; tw[slot] = (f32x2){gval * w0, gval * w1};
            }
        }
        __syncthreads();
        if (tid < 32) lbase[tid] = atomicAdd(&counts[tid * CSTR], lcnt[tid]);
        __syncthreads();
        if (tid < 256) {
            const int tok = tokb + tid; const i32x4 ti = tinfo[tid]; const f32x2 wv = tw[tid];
            eidx[tok] = make_int2(ti[0], ti[1]); epos[tok] = make_int2(lbase[ti[0]] + ti[2], lbase[ti[1]] + ti[3]); ew[tok] = make_float2(wv[0], wv[1]);
        }
        if (tid < 32) lcnt[tid] = 0;
        __syncthreads();
    }
}

constexpr size_t WS_ROWTOK = 5 * MiB;
constexpr size_t WS_RBPRE = 2 * MiB;
__device__ __forceinline__ void p_assign(LAS unsigned char* lds, const Args& a, int bid, int G, int tid) {
    const int* counts = (const int*)(a.ws + WS_CTL);
    const int2* eidx = (const int2*)(a.ws + WS_EIDX); const int2* epos = (const int2*)(a.ws + WS_EPOS); int2* dest = (int2*)(a.ws + WS_DEST); int* rowtok = (int*)(a.ws + WS_ROWTOK);
    LAS int* ps = (LAS int*)lds;
    if (tid == 0) { int acc = 0; int* rbpre = (int*)(a.ws + WS_RBPRE); for (int e = 0; e < NE; ++e) { const int c = counts[e * CSTR]; ps[e] = acc; ps[32 + e] = c; if (bid == 0) rbpre[e] = acc >> 8; acc += ((c + 255) >> 8) << 8; } if (bid == 0) rbpre[NE] = acc >> 8; }
    __syncthreads();
    for (int tok = bid * NTHREADS + tid; tok < T; tok += G * NTHREADS) {
        const int2 ei = eidx[tok], ep = epos[tok];
        const int d0 = ps[ei.x] + ep.x, d1 = ps[ei.y] + ep.y;
        rowtok[d0] = tok; rowtok[d1] = tok; dest[tok] = make_int2(d0, d1);
    }
    for (int i = bid * NTHREADS + tid; i < NE * 256; i += G * NTHREADS) {
        const int e = i >> 8, r = i & 255, c = ps[32 + e];
        if (c + r < (((c + 255) >> 8) << 8)) rowtok[ps[e] + c + r] = 0;
    }
    __syncthreads();
}

__device__ __forceinline__ void p_combine_ln2(const Args& a, int bid, int G, int wave, int lane, bool dry = false) {
    const bf16_t* h1b = (const bf16_t*)(a.ws + WS_H1); float* outw = dry ? (float*)(a.ws + WS_HID) : a.out; const bf16_t* Y = (const bf16_t*)(a.ws + WS_Y); const int2* dest = (const int2*)(a.ws + WS_DEST); const float2* ew = (const float2*)(a.ws + WS_EW);
    const float* mod = (const float*)(a.ws + WS_MOD); const float* __restrict__ ln_g = a.in[24]; const float* __restrict__ ln_b = a.in[25];
    int pr = bid * 8 + wave;
    int2 dn[2]; float2 wn[2];
#pragma unroll
    for (int t = 0; t < 2; ++t) { dn[t] = dest[2 * pr + t]; wn[t] = ew[2 * pr + t]; }
#pragma unroll 1
    for (; pr < T / 2; pr += G * 8) {
        int l2 = lane; asm volatile("" : "+v"(l2)); const int lane = l2;
        const int tok0 = 2 * pr;
        const float* m = mod + (size_t)(tok0 / SEQ) * 6144;
        int2 d[2]; float2 w[2];
#pragma unroll
        for (int t = 0; t < 2; ++t) { d[t] = dn[t]; w[t] = wn[t]; }
        f32x4 v[2][4]; float s[2] = {0.f, 0.f};
#pragma unroll
        for (int t = 0; t < 2; ++t)
#pragma unroll
            for (int j = 0; j < 4; ++j) { const int c4 = 4 * lane + 256 * j;
                const u32x2 ya = *(const u32x2*)(Y + (size_t)d[t].x * DM + c4), yb = *(const u32x2*)(Y + (size_t)d[t].y * DM + c4);
                const u32x2 hw = *(const u32x2*)(h1b + (size_t)(tok0 + t) * DM + c4); const f32x4 g2 = *(const f32x4*)(m + 5120 + c4);
                f32x4 f;
                f[0] = w[t].x * __uint_as_float(ya.x << 16) + w[t].y * __uint_as_float(yb.x << 16);
                f[1] = w[t].x * __uint_as_float(ya.x & 0xffff0000u) + w[t].y * __uint_as_float(yb.x & 0xffff0000u);
                f[2] = w[t].x * __uint_as_float(ya.y << 16) + w[t].y * __uint_as_float(yb.y << 16);
                f[3] = w[t].x * __uint_as_float(ya.y & 0xffff0000u) + w[t].y * __uint_as_float(yb.y & 0xffff0000u);
                const f32x4 h1 = (f32x4){__uint_as_float(hw.x << 16), __uint_as_float(hw.x & 0xffff0000u), __uint_as_float(hw.y << 16), __uint_as_float(hw.y & 0xffff0000u)};
                v[t][j] = ALPHA * h1 + g2 * f; s[t] += (v[t][j][0] + v[t][j][1]) + (v[t][j][2] + v[t][j][3]); }
        { const int pn = pr + G * 8; if (pn < T / 2) {
#pragma unroll
            for (int t = 0; t < 2; ++t) { dn[t] = dest[2 * pn + t]; wn[t] = ew[2 * pn + t]; } } }
#pragma unroll
        for (int t = 0; t < 2; ++t) { const float mean = wave_sum(s[t]) * (1.0f / DM); float s2 = 0.f;
#pragma unroll
            for (int j = 0; j < 4; ++j) { v[t][j] = v[t][j] - mean; s2 += (v[t][j][0] * v[t][j][0] + v[t][j][1] * v[t][j][1]) + (v[t][j][2] * v[t][j][2] + v[t][j][3] * v[t][j][3]); }
            const float rstd = rsqrtf(wave_sum(s2) * (1.0f / DM) + LN_EPS);
#pragma unroll
            for (int j = 0; j < 4; ++j) { const int c4 = 4 * lane + 256 * j;
                *(f32x4*)(outw + (size_t)(tok0 + t) * DM + c4) = v[t][j] * rstd * *(const f32x4*)(ln_g + c4) + *(const f32x4*)(ln_b + c4); } }
    }
}

constexpr size_t WS_HGK = WS_U;
constexpr size_t WS_HGD = 852 * MiB;
constexpr size_t WS_RGAGG = 854 * MiB;
constexpr size_t WS_RGCARRY = 864 * MiB;
constexpr size_t WS_GWT = 870 * MiB;
constexpr size_t WS_OFST = 880 * MiB;
constexpr int RG_UNITS_PER_B = 68, HG_SEGS = 17;

__device__ __forceinline__ void lds_barrier() { asm volatile("s_waitcnt lgkmcnt(0)" ::: "memory"); __builtin_amdgcn_s_barrier(); asm volatile("" ::: "memory"); }
__device__ __forceinline__ bf16x8 mk_bf16x8(u32x4 v) { return __builtin_bit_cast(bf16x8, v); }
__device__ __forceinline__ float bf_lo(unsigned w) { return __uint_as_float(w << 16); }
__device__ __forceinline__ float bf_hi(unsigned w) { return __uint_as_float(w & 0xffff0000u); }
__device__ __forceinline__ unsigned cvt2(float lo, float hi) { unsigned r; asm volatile("v_cvt_pk_bf16_f32 %0, %1, %2" : "=v"(r) : "v"(lo), "v"(hi)); return r; }

__device__ __forceinline__ void p_gwt(const float* __restrict__ gate_w, bf16_t* __restrict__ gwt, int bid, int G, int tid) {
    for (int o = bid * NTHREADS + tid; o < 32 * 4096; o += G * NTHREADS) { const int mat = o >> 12, d = (o >> 6) & 63, c = o & 63; gwt[o] = f2bf(gate_w[mat * 4096 + c * 64 + d]); }
}

constexpr int XC_STRIDE = 1040;
constexpr int RG_XC = 0, RG_OUT = 64 * XC_STRIDE;
constexpr size_t WS_RGPAR = 876 * MiB;

__device__ __forceinline__ void p_rgpar(const float* __restrict__ gate_b, const float* __restrict__ lam, float* __restrict__ par, int bid, int G, int tid) {
    for (int o = bid * NTHREADS + tid; o < 2 * 512; o += G * NTHREADS) { const int dir = o >> 9, ch = o & 511;
        par[(dir * 3 + 0) * 512 + ch] = gate_b[(dir * 2 + 0) * 512 + ch]; par[(dir * 3 + 1) * 512 + ch] = gate_b[(dir * 2 + 1) * 512 + ch]; par[(dir * 3 + 2) * 512 + ch] = softplusf_(-lam[dir * 512 + ch]); }
}

template <int DIR, bool OUT>
__device__ __forceinline__ void rg_scan64(const float (&av)[4][4], const float (&uv)[4][4], float& carry, float& atot, float (&hsum)[4][4], int fr, int fq) {
#pragma unroll
    for (int mm = 0; mm < 4; ++mm) {
        const int m = DIR == 0 ? mm : 3 - mm;
        float P, H;
        if (DIR == 0) { P = av[m][0]; H = uv[m][0];
#pragma unroll
            for (int j = 1; j < 4; ++j) { H = av[m][j] * H + uv[m][j]; P *= av[m][j]; } }
        else { P = av[m][3]; H = uv[m][3];
#pragma unroll
            for (int j = 2; j >= 0; --j) { H = av[m][j] * H + uv[m][j]; P *= av[m][j]; } }
        float Pn, Hn, Pe, He, Pt, Ht;
        if (DIR == 0) {
            Pn = __shfl_up(P, 16); Hn = __shfl_up(H, 16); if (fq >= 1) { H = P * Hn + H; P = P * Pn; }
            Pn = __shfl_up(P, 32); Hn = __shfl_up(H, 32); if (fq >= 2) { H = P * Hn + H; P = P * Pn; }
            Pe = __shfl_up(P, 16); He = __shfl_up(H, 16); if (fq == 0) { Pe = 1.f; He = 0.f; }
            Pt = __shfl(P, fr + 48); Ht = __shfl(H, fr + 48);
        } else {
            Pn = __shfl_down(P, 16); Hn = __shfl_down(H, 16); if (fq <= 2) { H = P * Hn + H; P = P * Pn; }
            Pn = __shfl_down(P, 32); Hn = __shfl_down(H, 32); if (fq <= 1) { H = P * Hn + H; P = P * Pn; }
            Pe = __shfl_down(P, 16); He = __shfl_down(H, 16); if (fq == 3) { Pe = 1.f; He = 0.f; }
            Pt = __shfl(P, fr); Ht = __shfl(H, fr);
        }
        if (OUT) {
            float hp = Pe * carry + He;
            if (DIR == 0) {
#pragma unroll
                for (int j = 0; j < 4; ++j) { hp = av[m][j] * hp + uv[m][j]; hsum[m][j] = hp; }
            } else {
#pragma unroll
                for (int j = 3; j >= 0; --j) { hp = av[m][j] * hp + uv[m][j]; hsum[m][j] += hp; }
            }
        }
        carry = Pt * carry + Ht; atot *= Pt;
    }
}

__device__ __forceinline__ void rg_agg_unit(LAS unsigned char* lds, const Args& a, int b, int k, int tid, int wave, int lane, int xr = 0) {
    const bf16_t* __restrict__ proj = (const bf16_t*)(a.ws + WS_PROJ);
    const float* __restrict__ conv_w = a.in[7]; const float* __restrict__ conv_b = a.in[8];
    const bf16_t* __restrict__ gwt = (const bf16_t*)(a.ws + WS_GWT); const float* __restrict__ par = (const float*)(a.ws + WS_RGPAR);
    float* rgagg = (float*)(a.ws + WS_RGAGG);
    int rowbase, p0, lo, hi;
    if (k < 4) { rowbase = T + b * LC; p0 = k * 64; lo = 0; hi = LC; } else { rowbase = b * SEQ; p0 = (k - 4) * 64; lo = p0; hi = p0 + 64; }
    const int unit = b * RG_UNITS_PER_B + k;
    const int n = wave, fr = lane & 15, fq = lane >> 4;
    float pgr[4][2], pgi[4][2], psp[4][2];
#pragma unroll
    for (int nt = 0; nt < 4; ++nt)
#pragma unroll
        for (int dir = 0; dir < 2; ++dir) { const int ch = n * 64 + nt * 16 + fr;
            pgr[nt][dir] = par[(dir * 3 + 0) * 512 + ch]; pgi[nt][dir] = par[(dir * 3 + 1) * 512 + ch]; psp[nt][dir] = par[(dir * 3 + 2) * 512 + ch]; }
    if (!(xr & 1)) {
        const int cgp = tid & 63, tg = tid >> 6, c0 = cgp * 8, i0 = tg * 8;
        u32x4 raw[11];
#pragma unroll
        for (int r = 0; r < 11; ++r) { const int p = p0 + i0 - 1 + r;
            raw[r] = (p >= lo && p < hi) ? *(const u32x4*)proj_at(proj, rowbase + p, c0) : (u32x4){0u, 0u, 0u, 0u}; }
        float cw[4][8], cb[8];
#pragma unroll
        for (int t4 = 0; t4 < 4; ++t4) { const f32x4 w0 = *(const f32x4*)(conv_w + t4 * 512 + c0), w1 = *(const f32x4*)(conv_w + t4 * 512 + c0 + 4);
#pragma unroll
            for (int q = 0; q < 4; ++q) { cw[t4][q] = w0[q]; cw[t4][4 + q] = w1[q]; } }
        { const f32x4 b0 = *(const f32x4*)(conv_b + c0), b1 = *(const f32x4*)(conv_b + c0 + 4);
#pragma unroll
            for (int q = 0; q < 4; ++q) { cb[q] = b0[q]; cb[4 + q] = b1[q]; } }
#pragma unroll
        for (int ii = 0; ii < 8; ++ii) {
            float xc[8];
#pragma unroll
            for (int c = 0; c < 8; ++c) xc[c] = cb[c];
#pragma unroll
            for (int t4 = 0; t4 < 4; ++t4) { const u32x4 rw = raw[ii + t4];
#pragma unroll
                for (int q = 0; q < 4; ++q) { xc[2 * q] += cw[t4][2 * q] * bf_lo(rw[q]); xc[2 * q + 1] += cw[t4][2 * q + 1] * bf_hi(rw[q]); } }
            u32x4 w; w.x = cvt2(xc[0], xc[1]); w.y = cvt2(xc[2], xc[3]); w.z = cvt2(xc[4], xc[5]); w.w = cvt2(xc[6], xc[7]);
            *(LAS u32x4*)(lds + RG_XC + (i0 + ii) * XC_STRIDE + c0 * 2) = w;
        }
    }
    lds_barrier();
    {
        bf16x8 afr[4][2];
#pragma unroll
        for (int m = 0; m < 4; ++m)
#pragma unroll
            for (int ks = 0; ks < 2; ++ks) afr[m][ks] = *(const LAS bf16x8*)(lds + RG_XC + (16 * m + fr) * XC_STRIDE + (n * 64 + ks * 32 + fq * 8) * 2);
        u32x4* stash = (k >= 4) ? (u32x4*)a.out + ((size_t)(b * 64 + (k - 4)) * 16384 + (size_t)wave * 2048 + lane) : nullptr;
        bf16x8 wfr[2][2][2];
#pragma unroll
        for (int dir = 0; dir < 2; ++dir)
#pragma unroll
            for (int g = 0; g < 2; ++g)
#pragma unroll
                for (int ks = 0; ks < 2; ++ks) wfr[dir][g][ks] = *(const bf16x8*)(gwt + ((size_t)(((dir * 2 + g) * 8 + n) * 64 + fr)) * 64 + ks * 32 + fq * 8);
#pragma unroll
        for (int nt = 0; nt < 4; ++nt) {
            const int ch = n * 64 + nt * 16 + fr;
            bf16x8 wnx[2][2][2];
            if (nt < 3) {
#pragma unroll
                for (int dir = 0; dir < 2; ++dir)
#pragma unroll
                    for (int g = 0; g < 2; ++g)
#pragma unroll
                        for (int ks = 0; ks < 2; ++ks) wnx[dir][g][ks] = *(const bf16x8*)(gwt + ((size_t)(((dir * 2 + g) * 8 + n) * 64 + (nt + 1) * 16 + fr)) * 64 + ks * 32 + fq * 8);
            }
            float xcv[4][4];
#pragma unroll
            for (int m = 0; m < 4; ++m)
#pragma unroll
                for (int j = 0; j < 4; ++j) xcv[m][j] = bf2f(*(const LAS bf16_t*)(lds + RG_XC + (16 * m + 4 * fq + j) * XC_STRIDE + ch * 2));
#pragma unroll
            for (int dir = 0; dir < 2; ++dir) {
                f32x4 accr[4], acci[4];
#pragma unroll
                for (int m = 0; m < 4; ++m) { accr[m] = (f32x4){0.f, 0.f, 0.f, 0.f}; acci[m] = (f32x4){0.f, 0.f, 0.f, 0.f}; }
                if (!(xr & 2))
#pragma unroll
                for (int ks = 0; ks < 2; ++ks)
#pragma unroll
                    for (int m = 0; m < 4; ++m) { accr[m] = __builtin_amdgcn_mfma_f32_16x16x32_bf16(afr[m][ks], wfr[dir][0][ks], accr[m], 0, 0, 0); acci[m] = __builtin_amdgcn_mfma_f32_16x16x32_bf16(afr[m][ks], wfr[dir][1][ks], acci[m], 0, 0, 0); }
                const float gbr = pgr[nt][dir], gbi = pgi[nt][dir], sp = psp[nt][dir];
                float av[4][4], uv[4][4];
                const bool exact = __any(8.0f * sp >= 0.25f);
#pragma unroll
                for (int m = 0; m < 4; ++m) {
                    unsigned pk[4];
                    if (xr & 4) {
#pragma unroll
                        for (int j = 0; j < 4; ++j) pk[j] = __float_as_uint(accr[m][j] + acci[m][j] + xcv[m][j]);
                    } else if (!exact) {
#pragma unroll
                        for (int j = 0; j < 4; ++j) {
                            const float r = sigmoidf_(accr[m][j] + gbr), ig = sigmoidf_(acci[m][j] + gbi);
                            const float la = -8.0f * r * sp;
                            const float oma = -la * (1.f + la * (0.5f + la * (0.16666667f + la * (0.041666668f + la * 0.0083333338f))));
                            pk[j] = cvt2(oma, __builtin_amdgcn_sqrtf(oma * (2.0f - oma)) * ig * xcv[m][j]);
                        }
                    } else {
#pragma unroll
                        for (int j = 0; j < 4; ++j) {
                            const float r = sigmoidf_(accr[m][j] + gbr), ig = sigmoidf_(acci[m][j] + gbi);
                            const float la = -8.0f * r * sp;
                            const float ser = -la * (1.f + la * (0.5f + la * (0.16666667f + la * (0.041666668f + la * 0.0083333338f))));
                            const float oma = (la > -0.25f) ? ser : 1.f - __expf(la);
                            pk[j] = cvt2(oma, __builtin_amdgcn_sqrtf(oma * (2.0f - oma)) * ig * xcv[m][j]);
                        }
                    }
#pragma unroll
                    for (int j = 0; j < 4; ++j) { av[m][j] = 1.0f - bf_lo(pk[j]); uv[m][j] = bf_hi(pk[j]); }
                    if (stash && !(xr & 16)) stash[((nt * 2 + dir) * 4 + m) * 64] = (u32x4){pk[0], pk[1], pk[2], pk[3]};
                }
                float carry = 0.f, atot = 1.f, hdummy[4][4];
                if (xr & 8) { carry = av[0][0] + uv[3][3]; } else if (dir == 0) rg_scan64<0, false>(av, uv, carry, atot, hdummy, fr, fq); else rg_scan64<1, false>(av, uv, carry, atot, hdummy, fr, fq);
                if (fq == 0) { rgagg[(((size_t)unit * 2 + dir) * 2 + 0) * 512 + ch] = atot; rgagg[(((size_t)unit * 2 + dir) * 2 + 1) * 512 + ch] = carry; }
            }
            if (nt < 3) {
#pragma unroll
                for (int dir = 0; dir < 2; ++dir)
#pragma unroll
                    for (int g = 0; g < 2; ++g)
#pragma unroll
                        for (int ks = 0; ks < 2; ++ks) wfr[dir][g][ks] = wnx[dir][g][ks];
            }
        }
    }
    lds_barrier();
}

__device__ __forceinline__ void rg_final_unit(LAS unsigned char* lds, const Args& a, int b, int kl, int tid, int wave, int lane) {
    const bf16_t* __restrict__ proj = (const bf16_t*)(a.ws + WS_PROJ); const float* rgcarry = (const float*)(a.ws + WS_RGCARRY); bf16_t* mixed = (bf16_t*)(a.ws + WS_MIXED);
    const int rowbase = b * SEQ + kl * 64, unit = b * RG_UNITS_PER_B + 4 + kl;
    const int n = wave, fr = lane & 15, fq = lane >> 4;
    const u32x4* stash = (const u32x4*)a.out + ((size_t)(b * 64 + kl) * 16384 + (size_t)wave * 2048 + lane);
    u32x4 st[2][4];
#pragma unroll
    for (int dir = 0; dir < 2; ++dir)
#pragma unroll
        for (int m = 0; m < 4; ++m) st[dir][m] = stash[((0 * 2 + dir) * 4 + m) * 64];
    float cin[4][2];
#pragma unroll
    for (int nt = 0; nt < 4; ++nt)
#pragma unroll
        for (int dir = 0; dir < 2; ++dir) cin[nt][dir] = rgcarry[((size_t)unit * 2 + dir) * 512 + n * 64 + nt * 16 + fr];
    {
        const int cgp = tid & 63, tg = tid >> 6, c0 = cgp * 8, i0 = tg * 8;
        u32x4 g[8];
#pragma unroll
        for (int ii = 0; ii < 8; ++ii) g[ii] = *(const u32x4*)proj_at(proj, rowbase + i0 + ii, 512 + c0);
#pragma unroll
        for (int ii = 0; ii < 8; ++ii) *(LAS u32x4*)(lds + RG_XC + (i0 + ii) * XC_STRIDE + c0 * 2) = g[ii];
    }
    lds_barrier();
#pragma unroll
    for (int nt = 0; nt < 4; ++nt) {
        const int ch = n * 64 + nt * 16 + fr;
        u32x4 sn[2][4];
        if (nt < 3) {
#pragma unroll
            for (int dir = 0; dir < 2; ++dir)
#pragma unroll
                for (int m = 0; m < 4; ++m) sn[dir][m] = stash[(((nt + 1) * 2 + dir) * 4 + m) * 64];
        }
        float hsum[4][4];
#pragma unroll
        for (int dir = 0; dir < 2; ++dir) {
            float av[4][4], uv[4][4];
#pragma unroll
            for (int m = 0; m < 4; ++m)
#pragma unroll
                for (int j = 0; j < 4; ++j) { av[m][j] = 1.0f - bf_lo(st[dir][m][j]); uv[m][j] = bf_hi(st[dir][m][j]); }
            float carry = cin[nt][dir], atot = 1.f;
            if (dir == 0) rg_scan64<0, true>(av, uv, carry, atot, hsum, fr, fq); else rg_scan64<1, true>(av, uv, carry, atot, hsum, fr, fq);
        }
#pragma unroll
        for (int m = 0; m < 4; ++m)
#pragma unroll
            for (int j = 0; j < 4; ++j) { const int t = 16 * m + 4 * fq + j;
                const float gg = bf2f(*(const LAS bf16_t*)(lds + RG_XC + t * XC_STRIDE + ch * 2));
                *(LAS bf16_t*)(lds + RG_OUT + t * XC_STRIDE + ch * 2) = (bf16_t)(cvt2(hsum[m][j] * gg, 0.f) & 0xffffu); }
        if (nt < 3) {
#pragma unroll
            for (int dir = 0; dir < 2; ++dir)
#pragma unroll
                for (int m = 0; m < 4; ++m) st[dir][m] = sn[dir][m];
        }
    }
    lds_barrier();
    {
        const int cgp = tid & 63, tg = tid >> 6, c0 = cgp * 8, i0 = tg * 8;
#pragma unroll
        for (int ii = 0; ii < 8; ++ii) { const u32x4 w = *(const LAS u32x4*)(lds + RG_OUT + (i0 + ii) * XC_STRIDE + c0 * 2);
            *(u32x4*)(mixed + (size_t)(rowbase + i0 + ii) * DM + c0) = w; }
    }
}

__device__ __forceinline__ void rg_carry_item(const Args& a, int item, int tid) {
    const float* rgagg = (const float*)(a.ws + WS_RGAGG); float* rgcarry = (float*)(a.ws + WS_RGCARRY);
    const int gidx = item * NTHREADS + tid;
    const int ch = gidx & 511, dir = (gidx >> 9) & 1, b = gidx >> 10;
    float h = 0.f;
#pragma unroll 1
    for (int s0 = 0; s0 < RG_UNITS_PER_B; s0 += 17) {
        float Av[17], Hv[17];
#pragma unroll
        for (int s1 = 0; s1 < 17; ++s1) { const int s = s0 + s1;
            const int k = dir == 0 ? s : (s < 4 ? 3 - s : 67 - (s - 4));
            const size_t unit = (size_t)b * RG_UNITS_PER_B + k;
            Av[s1] = rgagg[((unit * 2 + dir) * 2 + 0) * 512 + ch]; Hv[s1] = rgagg[((unit * 2 + dir) * 2 + 1) * 512 + ch]; }
#pragma unroll
        for (int s1 = 0; s1 < 17; ++s1) { const int s = s0 + s1;
            const int k = dir == 0 ? s : (s < 4 ? 3 - s : 67 - (s - 4));
            const size_t unit = (size_t)b * RG_UNITS_PER_B + k;
            rgcarry[(unit * 2 + dir) * 512 + ch] = h;
            h = Av[s1] * h + Hv[s1]; }
    }
}

#ifndef HGX
#define HGX 0
#endif
__device__ __forceinline__ float row_allsum16(float v) {
    v += __builtin_bit_cast(float, __builtin_amdgcn_update_dpp(0, __builtin_bit_cast(int, v), 0x128, 0xf, 0xf, false));
    v += __builtin_bit_cast(float, __builtin_amdgcn_update_dpp(0, __builtin_bit_cast(int, v), 0x124, 0xf, 0xf, false));
    v += __builtin_bit_cast(float, __builtin_amdgcn_update_dpp(0, __builtin_bit_cast(int, v), 0x122, 0xf, 0xf, false));
    v += __builtin_bit_cast(float, __builtin_amdgcn_update_dpp(0, __builtin_bit_cast(int, v), 0x121, 0xf, 0xf, false));
    return v;
}
constexpr int HG_RAWZ = 0, HG_RAWV = 16384, HG_RAWQ = 32768;
constexpr int HG_KHT = 49152, HG_VT = 67584;
constexpr int HG_QT = 86016, HG_KT = 103424;
constexpr int HG_AM = 120832;
constexpr int HG_DS = 130048, HG_QSUM = 130560, HG_PART = 134656;
constexpr int HG_RAWG = 136704;
constexpr int HG_OST = HG_QT;
constexpr int TS = 144, QS = 272;

struct HgRaw { u32x4 z[2], v[2], q[2], g[2]; };
template <bool FULL, bool GATE>
__device__ __forceinline__ void hg_load_raw(HgRaw& r, const bf16_t* __restrict__ proj, int row0, int hd, int dir, int tid) {
#pragma unroll
    for (int i = 0; i < 2; ++i) { const int row = row0 + (tid >> 4) + 32 * i, col = hd * 128 + (tid & 15) * 8;
        r.z[i] = *(const u32x4*)proj_at(proj, row, col + (dir == 0 ? 1536 : 2048)); r.v[i] = *(const u32x4*)proj_at(proj, row, col + 2560);
        if (FULL) r.q[i] = *(const u32x4*)proj_at(proj, row, col + 1024); if (GATE) r.g[i] = *(const u32x4*)proj_at(proj, row, col + 3072); }
}
template <bool FULL, bool GATE>
__device__ __forceinline__ void hg_store_raw(LAS unsigned char* lds, const HgRaw& r, int tid) {
#pragma unroll
    for (int i = 0; i < 2; ++i) { const int off = ((tid >> 4) + 32 * i) * 256 + (tid & 15) * 16;
        *(LAS u32x4*)(lds + HG_RAWZ + off) = r.z[i]; *(LAS u32x4*)(lds + HG_RAWV + off) = r.v[i]; if (FULL) *(LAS u32x4*)(lds + HG_RAWQ + off) = r.q[i]; if (GATE) *(LAS u32x4*)(lds + HG_RAWG + off) = r.g[i]; }
}

template <int DIR, bool FULL, bool STORE_NEXT, bool NEXT_GATE>
__device__ __forceinline__ void hg_chunk(LAS unsigned char* lds, f32x4 (&accS)[8], f32x4 (&o)[4], float lb0, float lb1, float& dseg0, float& dseg1, const HgRaw& nxt, int tid, int wave, int lane, int xm = 0) {
    const int cp = lane, tg = wave, fr = lane & 15, fq = lane >> 4;
    float c0[8], c1[8], k0[8], k1[8];
    if (xm & 1) {
#pragma unroll
        for (int i = 0; i < 8; ++i) { c0[i] = 1.f; c1[i] = 1.f; k0[i] = 0.5f; k1[i] = 0.5f; }
    } else {
        float p0 = 1.f, p1 = 1.f;
#pragma unroll
        for (int ii = 0; ii < 8; ++ii) { const int i = DIR == 0 ? ii : 7 - ii;
            const unsigned zz = *(const LAS unsigned*)(lds + HG_RAWZ + (8 * tg + i) * 256 + cp * 4);
            const float e0 = __expf(-bf_lo(zz)), e1 = __expf(-bf_hi(zz)); const float s0 = frcp(1.0f + e0), s1 = frcp(1.0f + e1);
            k0[i] = (1.0f - lb0) * e0 * s0; k1[i] = (1.0f - lb1) * e1 * s1;
            p0 *= lb0 + (1.0f - lb0) * s0; p1 *= lb1 + (1.0f - lb1) * s1; c0[i] = p0; c1[i] = p1; }
        *(LAS f32x2*)(lds + HG_QSUM + (tg * 128 + 2 * cp) * 4) = (f32x2){p0, p1};
    }
    lds_barrier();
    float pre0 = 1.f, pre1 = 1.f, tot0 = 1.f, tot1 = 1.f;
#pragma unroll
    for (int g = 0; g < 8; ++g) { const f32x2 v = *(const LAS f32x2*)(lds + HG_QSUM + (g * 128 + 2 * cp) * 4); tot0 *= v[0]; tot1 *= v[1]; if (DIR == 0 ? (g < tg) : (g > tg)) { pre0 *= v[0]; pre1 *= v[1]; } }
    if (!(xm & 1)) {
        unsigned kh0[4], kh1[4], vt0[4], vt1[4];
#pragma unroll
        for (int i2 = 0; i2 < 4; ++i2) {
            const float Pa0 = pre0 * c0[2 * i2], Pb0 = pre0 * c0[2 * i2 + 1], Pa1 = pre1 * c1[2 * i2], Pb1 = pre1 * c1[2 * i2 + 1];
            const float ra0 = frcp(Pa0), rb0 = frcp(Pb0), ra1 = frcp(Pa1), rb1 = frcp(Pb1);
            const float kta0 = k0[2 * i2] * ra0, ktb0 = k0[2 * i2 + 1] * rb0, kta1 = k1[2 * i2] * ra1, ktb1 = k1[2 * i2 + 1] * rb1;
            kh0[i2] = cvt2(kta0 * tot0, ktb0 * tot0); kh1[i2] = cvt2(kta1 * tot1, ktb1 * tot1);
            const unsigned va = *(const LAS unsigned*)(lds + HG_RAWV + (8 * tg + 2 * i2) * 256 + cp * 4), vb = *(const LAS unsigned*)(lds + HG_RAWV + (8 * tg + 2 * i2 + 1) * 256 + cp * 4);
            vt0[i2] = __builtin_amdgcn_perm(vb, va, 0x05040100u); vt1[i2] = __builtin_amdgcn_perm(vb, va, 0x07060302u);
            if (FULL) {
                const unsigned qa = *(const LAS unsigned*)(lds + HG_RAWQ + (8 * tg + 2 * i2) * 256 + cp * 4), qb = *(const LAS unsigned*)(lds + HG_RAWQ + (8 * tg + 2 * i2 + 1) * 256 + cp * 4);
                *(LAS unsigned*)(lds + HG_QT + (8 * tg + 2 * i2) * QS + cp * 4) = cvt2(bf_lo(qa) * Pa0, bf_hi(qa) * Pa1);
                *(LAS unsigned*)(lds + HG_QT + (8 * tg + 2 * i2 + 1) * QS + cp * 4) = cvt2(bf_lo(qb) * Pb0, bf_hi(qb) * Pb1);
                *(LAS unsigned*)(lds + HG_KT + (8 * tg + 2 * i2) * QS + cp * 4) = cvt2(kta0, kta1);
                *(LAS unsigned*)(lds + HG_KT + (8 * tg + 2 * i2 + 1) * QS + cp * 4) = cvt2(ktb0, ktb1);
            }
        }
        *(LAS u32x4*)(lds + HG_KHT + (2 * cp) * TS + tg * 16) = (u32x4){kh0[0], kh0[1], kh0[2], kh0[3]}; *(LAS u32x4*)(lds + HG_KHT + (2 * cp + 1) * TS + tg * 16) = (u32x4){kh1[0], kh1[1], kh1[2], kh1[3]};
        *(LAS u32x4*)(lds + HG_VT + (2 * cp) * TS + tg * 16) = (u32x4){vt0[0], vt0[1], vt0[2], vt0[3]}; *(LAS u32x4*)(lds + HG_VT + (2 * cp + 1) * TS + tg * 16) = (u32x4){vt1[0], vt1[1], vt1[2], vt1[3]};
        if (tg == 0) { *(LAS f32x2*)(lds + HG_DS + 2 * cp * 4) = (f32x2){tot0, tot1}; dseg0 *= tot0; dseg1 *= tot1; }
    }
    lds_barrier();
    if (FULL) {
        if (!(xm & 2))
#pragma unroll
        for (int tt = 0; tt < 2; ++tt) {
            const int tl = 2 * wave + tt, ti = tl >> 2, si = tl & 3;
            f32x4 accA = (f32x4){0.f, 0.f, 0.f, 0.f};
#pragma unroll
            for (int ks = 0; ks < 4; ++ks) {
                const bf16x8 af = *(const LAS bf16x8*)(lds + HG_QT + (16 * ti + fr) * QS + (ks * 32 + fq * 8) * 2);
                const bf16x8 bf = *(const LAS bf16x8*)(lds + HG_KT + (16 * si + fr) * QS + (ks * 32 + fq * 8) * 2);
                accA = __builtin_amdgcn_mfma_f32_16x16x32_bf16(af, bf, accA, 0, 0, 0);
            }
#pragma unroll
            for (int j = 0; j < 4; ++j) { const int t = 16 * ti + 4 * fq + j, s = 16 * si + fr;
                const bool keep = DIR == 0 ? (s <= t) : (s >= t);
                *(LAS bf16_t*)(lds + HG_AM + t * TS + s * 2) = (bf16_t)(cvt2(keep ? accA[j] : 0.f, 0.f) & 0xffffu); }
        }
        lds_barrier();
#pragma unroll
        for (int m = 0; m < 4; ++m) o[m] = (f32x4){0.f, 0.f, 0.f, 0.f};
        if (!(xm & 4)) {
#pragma unroll
        for (int ks = 0; ks < 4; ++ks) {
            const u32x4 sw = (u32x4){cvt2(accS[2 * ks][0], accS[2 * ks][1]), cvt2(accS[2 * ks][2], accS[2 * ks][3]), cvt2(accS[2 * ks + 1][0], accS[2 * ks + 1][1]), cvt2(accS[2 * ks + 1][2], accS[2 * ks + 1][3])};
            const bf16x8 sf = mk_bf16x8(sw);
#pragma unroll
            for (int m = 0; m < 4; ++m) {
                const u32x2 qlo = *(const LAS u32x2*)(lds + HG_QT + (16 * m + fr) * QS + (32 * ks + 4 * fq) * 2), qhi = *(const LAS u32x2*)(lds + HG_QT + (16 * m + fr) * QS + (32 * ks + 16 + 4 * fq) * 2);
                const bf16x8 qf = mk_bf16x8((u32x4){qlo.x, qlo.y, qhi.x, qhi.y});
                o[m] = __builtin_amdgcn_mfma_f32_16x16x32_bf16(qf, sf, o[m], 0, 0, 0);
            }
        }
#pragma unroll
        for (int ks = 0; ks < 2; ++ks) {
            const bf16x8 vf = *(const LAS bf16x8*)(lds + HG_VT + (16 * wave + fr) * TS + (ks * 32 + fq * 8) * 2);
#pragma unroll
            for (int m = 0; m < 4; ++m) { const bf16x8 af = *(const LAS bf16x8*)(lds + HG_AM + (16 * m + fr) * TS + (ks * 32 + fq * 8) * 2);
                o[m] = __builtin_amdgcn_mfma_f32_16x16x32_bf16(af, vf, o[m], 0, 0, 0); }
        }
        }
    }
    if (!(xm & 8)) {
#pragma unroll
    for (int i = 0; i < 8; ++i) { const f32x4 dv = *(const LAS f32x4*)(lds + HG_DS + (16 * i + 4 * fq) * 4); accS[i] = accS[i] * dv; }
#pragma unroll
    for (int ks = 0; ks < 2; ++ks) {
        const bf16x8 vf = *(const LAS bf16x8*)(lds + HG_VT + (16 * wave + fr) * TS + (ks * 32 + fq * 8) * 2);
#pragma unroll
        for (int i = 0; i < 8; ++i) { const bf16x8 af = *(const LAS bf16x8*)(lds + HG_KHT + (16 * i + fr) * TS + (ks * 32 + fq * 8) * 2);
            accS[i] = __builtin_amdgcn_mfma_f32_16x16x32_bf16(af, vf, accS[i], 0, 0, 0); }
    }
    }
    if (STORE_NEXT) hg_store_raw<FULL, NEXT_GATE>(lds, nxt, tid);
}

__device__ __forceinline__ float hg_lb(const float* __restrict__ lb_logits, int dir, int col) {
    const float l0 = lb_logits[(0 * 2 + dir) * 512 + col], l1 = lb_logits[(1 * 2 + dir) * 512 + col];
    return 1.0f / (1.0f + expf(l1 - l0));
}

template <int DIR>
__device__ __forceinline__ void hg_agg_unit(LAS unsigned char* lds, const Args& a, int b, int hd, int sidx, int unit, int tid, int wave, int lane) {
    const bf16_t* __restrict__ proj = (const bf16_t*)(a.ws + WS_PROJ);
    const int rowbase = sidx == 0 ? T + b * LC : b * SEQ + (sidx - 1) * 256;
    const float lb0 = hg_lb(a.in[12], DIR, hd * 128 + 2 * lane), lb1 = hg_lb(a.in[12], DIR, hd * 128 + 2 * lane + 1);
    f32x4 accS[8], odummy[4];
#pragma unroll
    for (int i = 0; i < 8; ++i) accS[i] = (f32x4){0.f, 0.f, 0.f, 0.f};
    float dseg0 = 1.f, dseg1 = 1.f;
    HgRaw raw;
    hg_load_raw<false, false>(raw, proj, rowbase + (DIR == 0 ? 0 : 3) * 64, hd, DIR, tid);
    lds_barrier();
    hg_store_raw<false, false>(lds, raw, tid);
    lds_barrier();
#pragma unroll 1
    for (int cc = 0; cc < 3; ++cc) {
        hg_load_raw<false, false>(raw, proj, rowbase + (DIR == 0 ? cc + 1 : 2 - cc) * 64, hd, DIR, tid);
        hg_chunk<DIR, false, true, false>(lds, accS, odummy, lb0, lb1, dseg0, dseg1, raw, tid, wave, lane);
        lds_barrier();
    }
    hg_chunk<DIR, false, false, false>(lds, accS, odummy, lb0, lb1, dseg0, dseg1, raw, tid, wave, lane);
    float* K = (float*)(a.ws + WS_HGK) + (size_t)unit * 16384;
    const int fr = lane & 15, fq = lane >> 4;
#pragma unroll
    for (int i = 0; i < 8; ++i)
#pragma unroll
        for (int j = 0; j < 4; ++j) K[(16 * i + 4 * fq + j) * 128 + 16 * wave + fr] = accS[i][j];
    if (wave == 0) *(f32x2*)((float*)(a.ws + WS_HGD) + (size_t)unit * 128 + 2 * lane) = (f32x2){dseg0, dseg1};
}

__device__ __forceinline__ void hg_carry_item(const Args& a, int item, int tid, bool dry = false) {
    const int chain = item >> 3, part = item & 7, dir = chain & 1;
    float* K = (float*)(a.ws + WS_HGK) + (size_t)chain * HG_SEGS * 16384; const float* D = (const float*)(a.ws + WS_HGD) + (size_t)chain * HG_SEGS * 128;
    const int e4 = part * 512 + tid, dk = e4 >> 5;
    f32x4 kv[HG_SEGS]; float dv[HG_SEGS];
#pragma unroll
    for (int s = 0; s < HG_SEGS; ++s) { const int sidx = s == 0 ? 0 : (dir == 0 ? s : HG_SEGS - s); kv[s] = *(const f32x4*)(K + (size_t)sidx * 16384 + e4 * 4); dv[s] = D[sidx * 128 + dk]; }
    f32x4 S = (f32x4){0.f, 0.f, 0.f, 0.f};
#pragma unroll
    for (int s = 0; s < HG_SEGS; ++s) { const int sidx = s == 0 ? 0 : (dir == 0 ? s : HG_SEGS - s);
        if (dry) { const size_t o = ((size_t)(chain * HG_SEGS + sidx) * 16384 + e4 * 4) % (size_t)(32 * MiB); *(f32x4*)((float*)(a.ws + WS_MIXED) + o) = S; } else *(f32x4*)(K + (size_t)sidx * 16384 + e4 * 4) = S;
        S = S * dv[s] + kv[s]; }
}

__device__ __forceinline__ void hg_final_unit(LAS unsigned char* lds, const Args& a, int b, int hd, int seg, int tid, int wave, int lane, int xm = 0) {
    const bf16_t* __restrict__ proj = (const bf16_t*)(a.ws + WS_PROJ); bf16_t* mixed = (bf16_t*)(a.ws + WS_MIXED);
    const int rowbase = b * SEQ + seg * 256, fr = lane & 15, fq = lane >> 4;
    const float lbf0 = hg_lb(a.in[12], 0, hd * 128 + 2 * lane), lbf1 = hg_lb(a.in[12], 0, hd * 128 + 2 * lane + 1);
    const float lbb0 = hg_lb(a.in[12], 1, hd * 128 + 2 * lane), lbb1 = hg_lb(a.in[12], 1, hd * 128 + 2 * lane + 1);
    f32x4 accS[8], o[4];
    float dseg0 = 1.f, dseg1 = 1.f;
    HgRaw raw;
    f32x4* ofst = (f32x4*)(a.ws + WS_OFST) + (size_t)blockIdx.x * 8192 + wave * 256 + lane;
    hg_load_raw<true, false>(raw, proj, rowbase, hd, 0, tid);
    {
        const float* Sin = (const float*)(a.ws + WS_HGK) + (size_t)((((b * 4 + hd) * 2 + 0) * HG_SEGS) + 1 + seg) * 16384;
#pragma unroll
        for (int i = 0; i < 8; ++i)
#pragma unroll
            for (int j = 0; j < 4; ++j) accS[i][j] = Sin[(16 * i + 4 * fq + j) * 128 + 16 * wave + fr];
    }
    lds_barrier();
    hg_store_raw<true, false>(lds, raw, tid);
    lds_barrier();
#pragma unroll 1
    for (int cc = 0; cc < 3; ++cc) {
        hg_load_raw<true, false>(raw, proj, rowbase + (cc + 1) * 64, hd, 0, tid);
        hg_chunk<0, true, true, false>(lds, accS, o, lbf0, lbf1, dseg0, dseg1, raw, tid, wave, lane, xm);
#pragma unroll
        for (int m = 0; m < 4; ++m) ofst[cc * 2048 + m * 64] = o[m];
        lds_barrier();
    }
    hg_load_raw<true, false>(raw, proj, rowbase + 3 * 64, hd, 1, tid);
    hg_chunk<0, true, true, false>(lds, accS, o, lbf0, lbf1, dseg0, dseg1, raw, tid, wave, lane, xm);
#pragma unroll
    for (int m = 0; m < 4; ++m) ofst[3 * 2048 + m * 64] = o[m];
    {
        const float* Sin = (const float*)(a.ws + WS_HGK) + (size_t)((((b * 4 + hd) * 2 + 1) * HG_SEGS) + 1 + seg) * 16384;
#pragma unroll
        for (int i = 0; i < 8; ++i)
#pragma unroll
            for (int j = 0; j < 4; ++j) accS[i][j] = Sin[(16 * i + 4 * fq + j) * 128 + 16 * wave + fr];
    }
    lds_barrier();
    constexpr int OSF = 528;
    f32x4 ngv[2];
    { const float* ngp = a.in[13] + hd * 128 + (tid & 15) * 8; ngv[0] = *(const f32x4*)ngp; ngv[1] = *(const f32x4*)(ngp + 4); }
#pragma unroll 1
    for (int cc = 0; cc < 4; ++cc) {
        const int c = 3 - cc;
        f32x4 ofv[4]; u32x4 gq[2];
#pragma unroll
        for (int m = 0; m < 4; ++m) ofv[m] = ofst[c * 2048 + m * 64];
#pragma unroll
        for (int i = 0; i < 2; ++i) gq[i] = *(const u32x4*)proj_at(proj, rowbase + c * 64 + (tid >> 4) + 32 * i, 3072 + hd * 128 + (tid & 15) * 8);
        if (cc < 3) hg_load_raw<true, false>(raw, proj, rowbase + (c - 1) * 64, hd, 1, tid);
        if (cc < 3) hg_chunk<1, true, true, false>(lds, accS, o, lbb0, lbb1, dseg0, dseg1, raw, tid, wave, lane, xm);
        else hg_chunk<1, true, false, false>(lds, accS, o, lbb0, lbb1, dseg0, dseg1, raw, tid, wave, lane, xm);
        if (xm & 16) { lds_barrier(); continue; }
        lds_barrier();
#pragma unroll
        for (int m = 0; m < 4; ++m) { const f32x4 ot = o[m] + ofv[m];
#pragma unroll
            for (int j = 0; j < 4; ++j) *(LAS float*)(lds + HG_QT + (16 * m + 4 * fq + j) * OSF + (16 * wave + fr) * 4) = ot[j]; }
        lds_barrier();
#pragma unroll
        for (int i = 0; i < 2; ++i) { const int t = (tid >> 4) + 32 * i, c8 = (tid & 15) * 8;
            const f32x4 v0 = *(const LAS f32x4*)(lds + HG_QT + t * OSF + c8 * 4), v1 = *(const LAS f32x4*)(lds + HG_QT + t * OSF + c8 * 4 + 16);
            const float ss = row_allsum16((v0[0] * v0[0] + v0[1] * v0[1]) + (v0[2] * v0[2] + v0[3] * v0[3]) + (v1[0] * v1[0] + v1[1] * v1[1]) + (v1[2] * v1[2] + v1[3] * v1[3]));
            const float rinv = __builtin_amdgcn_rsqf(ss * (1.0f / 128.0f) + LN_EPS);
            const u32x4 g = gq[i];
            u32x4 w;
            w.x = cvt2(v0[0] * rinv * ngv[0][0] * bf_lo(g.x), v0[1] * rinv * ngv[0][1] * bf_hi(g.x)); w.y = cvt2(v0[2] * rinv * ngv[0][2] * bf_lo(g.y), v0[3] * rinv * ngv[0][3] * bf_hi(g.y));
            w.z = cvt2(v1[0] * rinv * ngv[1][0] * bf_lo(g.z), v1[1] * rinv * ngv[1][1] * bf_hi(g.z)); w.w = cvt2(v1[2] * rinv * ngv[1][2] * bf_lo(g.w), v1[3] * rinv * ngv[1][3] * bf_hi(g.w));
            *(u32x4*)(mixed + (size_t)(rowbase + c * 64 + t) * DM + 512 + hd * 128 + c8) = w; }
    }
}

__device__ __forceinline__ void p_scan_a(LAS unsigned char* lds, const Args& a, int bid, int G, int tid, int wave, int lane, int mask = 3, int xr = 0) {
    constexpr int N_HG = NB * 4 * 2 * HG_SEGS, N_RG = NB * RG_UNITS_PER_B;
#pragma unroll 1
    for (int it = bid; it < N_HG + N_RG; it += G) {
        int t2 = tid; asm volatile("" : "+v"(t2)); const int tid = t2, lane = t2 & 63;
        if ((it < N_HG) ? !(mask & 1) : !(mask & 2)) continue;
        if (it < N_HG) { const int sidx = it % HG_SEGS, rest = it / HG_SEGS, dir = rest & 1, hd = (rest >> 1) & 3, b = rest >> 3;
            if (dir == 0) hg_agg_unit<0>(lds, a, b, hd, sidx, it, tid, wave, lane); else hg_agg_unit<1>(lds, a, b, hd, sidx, it, tid, wave, lane); }
        else { const int r = it - N_HG; __syncthreads(); rg_agg_unit(lds, a, r / RG_UNITS_PER_B, r % RG_UNITS_PER_B, tid, wave, lane, xr); }
    }
}
__device__ __forceinline__ void p_scan_b(const Args& a, int bid, int G, int tid, bool dry = false) {
#pragma unroll 1
    for (int it = bid; it < 1024; it += G) hg_carry_item(a, it, tid, dry);
    if (bid >= G - 32) rg_carry_item(a, bid - (G - 32), tid);
}
__device__ __forceinline__ void p_scan_c(LAS unsigned char* lds, const Args& a, int bid, int G, int tid, int wave, int lane, int mask = 3, int xm = 0) {
#pragma unroll 1
    for (int it = bid; it < ((mask & 1) ? 1024 : 0); it += G) { const int seg = it & 15, hd = (it >> 4) & 3, b = it >> 6; int t2 = tid; asm volatile("" : "+v"(t2)); hg_final_unit(lds, a, b, hd, seg, t2, wave, t2 & 63, xm); }
#pragma unroll 1
    for (int r = bid; r < ((mask & 2) ? 1024 : 0); r += G) { __syncthreads(); int t2 = tid; asm volatile("" : "+v"(t2)); rg_final_unit(lds, a, r >> 6, r & 63, t2, wave, t2 & 63); }
}

#define GAS __attribute__((address_space(1)))
#define RLX_AGENT __ATOMIC_RELAXED, __HIP_MEMORY_SCOPE_AGENT
#define XB_TMO      128
#define XB_XCNT(j)  (256  + 64 * (j))
#define XB_XSUB(j)  (1280 + 64 * (j))
#define XB_XGEN(j)  (2304 + 64 * (j))
#define XB_TOP      3328
#define XB_TOPGEN   3392
#define XCD_BAR_WORDS 3456
#define XB_SPIN_CAP (1u << 18)

__device__ __forceinline__ unsigned xb_ld(unsigned* p)              { return __hip_atomic_load(p, __ATOMIC_RELAXED, __HIP_MEMORY_SCOPE_AGENT); }
__device__ __forceinline__ unsigned xb_add(unsigned* p, unsigned v) { return __hip_atomic_fetch_add(p, v, __ATOMIC_RELAXED, __HIP_MEMORY_SCOPE_AGENT); }
__device__ __forceinline__ unsigned xb_xcc_id() { return (unsigned)__builtin_amdgcn_s_getreg((3 << 11) | 20) & 0xFu; }
#define XB_SPIN(cond, bar) do { unsigned _sp = 0; while (cond) { __builtin_amdgcn_s_sleep(1); \
    if ((++_sp & 255u) == 0u) { if (xb_ld(&(bar)[XB_TMO])) break; if (_sp > XB_SPIN_CAP) { atomicAdd(&(bar)[XB_TMO], 1u); break; } } } } while (0)

struct XcdBarrier {
    unsigned* bar; unsigned x;
    volatile LAS unsigned* st;
};

__device__ __forceinline__ XcdBarrier xcd_barrier_post(unsigned* bar, volatile LAS unsigned* st) {
    XcdBarrier b; b.bar = bar; b.x = xb_xcc_id(); b.st = st;
    if (threadIdx.x == 0) (void)xb_add(&bar[XB_XCNT(b.x)], 1u);
    return b;
}
__device__ __forceinline__ void xcd_barrier_complete(unsigned* bar, unsigned x, unsigned& nloc, unsigned& nx) {
    const unsigned G = gridDim.x * gridDim.y * gridDim.z;
    unsigned sum, cnt, mine, sp = 0u;
    for (;;) {
        sum = 0u; cnt = 0u; mine = 0u;
#pragma unroll
        for (unsigned j = 0; j < 16; ++j) { const unsigned c = xb_ld(&bar[XB_XCNT(j)]); sum += c; cnt += (c > 0u) ? 1u : 0u; mine = (j == x) ? c : mine; }
        if (sum == G) break;
        __builtin_amdgcn_s_sleep(1);
        if ((++sp & 255u) == 0u) { if (xb_ld(&bar[XB_TMO])) break; if (sp > XB_SPIN_CAP) { atomicAdd(&bar[XB_TMO], 1u); break; } }
    }
    nloc = mine > 0u ? mine : 1u; nx = cnt > 0u ? cnt : 1u;
}

__device__ __forceinline__ void xcd_barrier(const XcdBarrier& b) {
    asm volatile("s_waitcnt vmcnt(0)" ::: "memory");
    __syncthreads();
    if (threadIdx.x == 0) {
        unsigned* bar = b.bar;
        __builtin_amdgcn_s_waitcnt(0);
        unsigned nloc = b.st[0], nx = b.st[1];
        if (nloc == 0u) { xcd_barrier_complete(bar, b.x, nloc, nx); b.st[0] = nloc; b.st[1] = nx; }
        const unsigned old = xb_add(&bar[XB_XSUB(b.x)], 1u);
        const unsigned gen = old / nloc;
        if (old + 1u == (gen + 1u) * nloc) {
            __builtin_amdgcn_fence(__ATOMIC_RELEASE, "agent");
            asm volatile("s_waitcnt vmcnt(0)" ::: "memory");
            const unsigned og = xb_add(&bar[XB_TOP], 1u);
            const unsigned tg = og / nx;
            if (og + 1u == (tg + 1u) * nx) xb_add(&bar[XB_TOPGEN], 1u);
            else XB_SPIN(xb_ld(&bar[XB_TOPGEN]) == tg, bar);
            __builtin_amdgcn_fence(__ATOMIC_ACQUIRE, "agent");
            xb_add(&bar[XB_XGEN(b.x)], 1u);
            asm volatile("s_waitcnt vmcnt(0)" ::: "memory");
        } else {
            XB_SPIN(xb_ld(&bar[XB_XGEN(b.x)]) == gen, bar);
            __builtin_amdgcn_fence(__ATOMIC_ACQUIRE, "agent");
            asm volatile("s_waitcnt vmcnt(0)" ::: "memory");
        }
    }
    __syncthreads();
}


__device__ __forceinline__ void stagger_wait(unsigned ticks) {
    if (ticks == 0u) return;
    const unsigned long long t0 = __builtin_amdgcn_s_memrealtime();
    while (__builtin_amdgcn_s_memrealtime() - t0 < ticks) __builtin_amdgcn_s_sleep(16);
}
#ifndef STAG_P2
#define STAG_P2 0
#endif

__global__ void __launch_bounds__(NTHREADS, 2) mega(Args a) {
    extern __shared__ __attribute__((aligned(16))) unsigned char lds_raw[];
    LAS unsigned char* lds = (LAS unsigned char*)lds_raw;
    cg::grid_group grid = cg::this_grid();
    const int wave = __builtin_amdgcn_readfirstlane(threadIdx.x >> 6), bid = blockIdx.x, G = gridDim.x;
    int tid = threadIdx.x, lane = tid & 63;
#define FRESH_TID() do { tid = threadIdx.x; asm volatile("" : "+v"(tid)); lane = tid & 63; } while (0)
    unsigned char* ws = a.ws;
    volatile LAS unsigned* bst = (volatile LAS unsigned*)(lds + LDS_BYTES - 64);
    if (threadIdx.x < 2) bst[threadIdx.x] = 0u;
    __syncthreads();
    XcdBarrier xbar = xcd_barrier_post((unsigned*)(ws + WS_BAR), bst);
#define GRID_BAR() xcd_barrier(xbar)
    float* mod = (float*)(ws + WS_MOD);
    bf16_t* U = (bf16_t*)(ws + WS_U);
    bf16_t* PROJ = (bf16_t*)(ws + WS_PROJ); bf16_t* MIXED = (bf16_t*)(ws + WS_MIXED);

#ifndef SKIP_P0
    p_mod(lds, a.in[1], a.in[3], a.in[4], a.in[5], mod, bid, G, tid);
    p_transposes(lds, a, bid, G, tid);
    p_gwt(a.in[9], (bf16_t*)(ws + WS_GWT), bid, G, tid);
    p_rgpar(a.in[10], a.in[11], (float*)(ws + WS_RGPAR), bid, G, tid);
    p_wrt(a.in[17], a.in[19], (bf16_t*)(ws + WS_WRT), bid, G, tid);
#endif
#ifdef REP_P0
    grid.sync();
    FRESH_TID();
    p_mod(lds, a.in[1], a.in[3], a.in[4], a.in[5], mod, bid, G, tid);
    p_transposes(lds, a, bid, G, tid);
    p_gwt(a.in[9], (bf16_t*)(ws + WS_GWT), bid, G, tid);
    p_rgpar(a.in[10], a.in[11], (float*)(ws + WS_RGPAR), bid, G, tid);
    p_wrt(a.in[17], a.in[19], (bf16_t*)(ws + WS_WRT), bid, G, tid);
#endif
    GRID_BAR();
    FRESH_TID();
#ifdef REP_SYNC
    for (int r = 0; r < 10; ++r) GRID_BAR();
#endif
#ifndef SKIP_P1
    p_u(a.in[0], a.in[2], mod, U, bid, G, tid);
#endif
#ifdef REP_P1
    GRID_BAR();
    FRESH_TID();
    p_u(a.in[0], a.in[2], mod, U, bid, G, tid);
#endif
    GRID_BAR();
    FRESH_TID();
#ifdef REP_P2X
    { pg8::Gemm g{U, (const bf16_t*)(ws + WS_WINT), TA, NIN, DM}; pg8::StaticOrder S; S.init(TA, NIN, G, bid);
#if REP_P2X == 1
      pg8::EpiNull E{(float*)(ws + WS_OFST)};
      pg8::gemm_phase<pg8::EpiNull, pg8::StaticOrder, true, true>(lds, g, S, E); }
#else
      pg8::EpiInProj E{PROJ, REP_P2X - 1, 0};
      pg8::gemm_phase<pg8::EpiInProj, pg8::StaticOrder, true, true>(lds, g, S, E); }
#endif
    GRID_BAR();
    FRESH_TID();
#endif
#ifndef SKIP_P2
    stagger_wait((unsigned)((bid >> 3) & 7) * STAG_P2);
    { pg8::Gemm g{U, (const bf16_t*)(ws + WS_WINT), TA, NIN, DM}; pg8::StaticOrder S; S.init(TA, NIN, G, bid);
      pg8::EpiInProj E{PROJ, 0, 0};
      pg8::gemm_phase<pg8::EpiInProj, pg8::StaticOrder, true, true>(lds, g, S, E); }
#endif
#ifdef REP_P2
    GRID_BAR();
    FRESH_TID();
    { pg8::Gemm g{U, (const bf16_t*)(ws + WS_WINT), TA, NIN, DM}; pg8::StaticOrder S; S.init(TA, NIN, G, bid);
      pg8::EpiInProj E{PROJ, 0, 0};
      pg8::gemm_phase<pg8::EpiInProj, pg8::StaticOrder, true, true>(lds, g, S, E); }
#endif
    GRID_BAR();
    FRESH_TID();
#ifdef PRE_P3A
    p_scan_a(lds, a, bid, G, tid, wave, lane, 2, PRE_P3A);
    GRID_BAR();
    FRESH_TID();
#endif
#ifndef SKIP_P3A
    p_scan_a(lds, a, bid, G, tid, wave, lane);
#endif
#ifdef REP_P3A
    GRID_BAR();
    FRESH_TID();
    p_scan_a(lds, a, bid, G, tid, wave, lane, REP_P3A);
#endif
    GRID_BAR();
    FRESH_TID();
#ifdef REP_P3B
    p_scan_b(a, bid, G, tid, true);
    GRID_BAR();
    FRESH_TID();
#endif
#ifndef SKIP_P3B
    p_scan_b(a, bid, G, tid);
#endif
    GRID_BAR();
    FRESH_TID();
#ifdef PRE_P3C
    p_scan_c(lds, a, bid, G, tid, wave, lane, 1, PRE_P3C);
    GRID_BAR();
    FRESH_TID();
#endif
#ifndef SKIP_P3C
    p_scan_c(lds, a, bid, G, tid, wave, lane);
#endif
#ifdef REP_P3C
    GRID_BAR();
    FRESH_TID();
    p_scan_c(lds, a, bid, G, tid, wave, lane, REP_P3C);
#endif
    GRID_BAR();
    FRESH_TID();
#ifndef SKIP_P5
    { pg8::Gemm g{MIXED, (const bf16_t*)(ws + WS_WOUTT), T, DM, DM}; pg8::StaticOrder S; S.init(T, DM, G, bid);
      pg8::EpiY E{(bf16_t*)(ws + WS_XG)};
      pg8::gemm_phase<pg8::EpiY, pg8::StaticOrder, true, true>(lds, g, S, E); }
#endif
#ifdef REP_P5
    GRID_BAR();
    FRESH_TID();
    { pg8::Gemm g{MIXED, (const bf16_t*)(ws + WS_WOUTT), T, DM, DM}; pg8::StaticOrder S; S.init(T, DM, G, bid);
      pg8::EpiY E{(bf16_t*)(ws + WS_XG)};
      pg8::gemm_phase<pg8::EpiY, pg8::StaticOrder, true, true>(lds, g, S, E); }
#endif
    GRID_BAR();
    FRESH_TID();
#ifdef REP_P6
#pragma unroll 1
    for (int rep = 0; rep < 2; ++rep) { p_ln1_router(lds, a, bid, G, tid, wave, lane, rep == 0, rep == 0 ? REP_P6 : 3); if (rep == 0) GRID_BAR(); }
#else
    p_ln1_router(lds, a, bid, G, tid, wave, lane);
#endif
    GRID_BAR();
    FRESH_TID();
#ifndef SKIP_P7
    p_assign(lds, a, bid, G, tid);
#endif
#ifdef REP_P7
    GRID_BAR();
    FRESH_TID();
    p_assign(lds, a, bid, G, tid);
#endif
    GRID_BAR();
    FRESH_TID();
#ifdef PRE_P8X
    { pg8::Gemm g{(const bf16_t*)(ws + WS_U), (const bf16_t*)(ws + WS_W13T), MAXROWS, NE * DM, DM}; pg8::ExpertOrderG S{(const int*)(ws + WS_RBPRE), (const int*)(ws + WS_ROWTOK), G, bid};
      pg8::EpiNull E{(float*)(ws + WS_OFST)};
      pg8::gemm_phase<pg8::EpiNull, pg8::ExpertOrderG, true, true>(lds, g, S, E); }
    GRID_BAR();
    FRESH_TID();
#endif
#ifndef SKIP_P8
    { pg8::Gemm g{(const bf16_t*)(ws + WS_U), (const bf16_t*)(ws + WS_W13T), MAXROWS, NE * DM, DM}; pg8::ExpertOrderG S{(const int*)(ws + WS_RBPRE), (const int*)(ws + WS_ROWTOK), G, bid};
      pg8::EpiExp1 E{(bf16_t*)(ws + WS_HID)};
      pg8::gemm_phase<pg8::EpiExp1, pg8::ExpertOrderG, true, true>(lds, g, S, E); }
#endif
#ifdef REP_P8
    GRID_BAR();
    FRESH_TID();
    { pg8::Gemm g{(const bf16_t*)(ws + WS_U), (const bf16_t*)(ws + WS_W13T), MAXROWS, NE * DM, DM}; pg8::ExpertOrderG S{(const int*)(ws + WS_RBPRE), (const int*)(ws + WS_ROWTOK), G, bid};
      pg8::EpiExp1 E{(bf16_t*)(ws + WS_HID)};
      pg8::gemm_phase<pg8::EpiExp1, pg8::ExpertOrderG, true, true>(lds, g, S, E); }
#endif
    GRID_BAR();
    FRESH_TID();
#ifdef PRE_P9X
    { pg8::Gemm g{(const bf16_t*)(ws + WS_HID), (const bf16_t*)(ws + WS_W2T), MAXROWS, NE * DM, DE}; pg8::ExpertOrder S{(const int*)(ws + WS_RBPRE), nullptr, G, bid};
      pg8::EpiNull E{(float*)(ws + WS_OFST)};
      pg8::gemm_phase<pg8::EpiNull, pg8::ExpertOrder, true, true>(lds, g, S, E); }
    GRID_BAR();
    FRESH_TID();
#endif
#ifndef SKIP_P9
    { pg8::Gemm g{(const bf16_t*)(ws + WS_HID), (const bf16_t*)(ws + WS_W2T), MAXROWS, NE * DM, DE}; pg8::ExpertOrder S{(const int*)(ws + WS_RBPRE), nullptr, G, bid};
      pg8::EpiY E{(bf16_t*)(ws + WS_Y)};
      pg8::gemm_phase<pg8::EpiY, pg8::ExpertOrder, true, true>(lds, g, S, E); }
#endif
#ifdef REP_P9
    GRID_BAR();
    FRESH_TID();
    { pg8::Gemm g{(const bf16_t*)(ws + WS_HID), (const bf16_t*)(ws + WS_W2T), MAXROWS, NE * DM, DE}; pg8::ExpertOrder S{(const int*)(ws + WS_RBPRE), nullptr, G, bid};
      pg8::EpiY E{(bf16_t*)(ws + WS_Y)};
      pg8::gemm_phase<pg8::EpiY, pg8::ExpertOrder, true, true>(lds, g, S, E); }
#endif
    GRID_BAR();
    FRESH_TID();
#ifdef REP_P10
    p_combine_ln2(a, bid, G, wave, lane, true);
    GRID_BAR();
    FRESH_TID();
#endif
#ifndef SKIP_P10
    p_combine_ln2(a, bid, G, wave, lane);
#endif
}

extern "C" void kernel_launch(void* const* d_in, const int* in_sizes, int n_in, void* d_out, int out_size, void* d_ws, size_t ws_size, hipStream_t stream) {
    static int grid = 0;
    if (grid == 0) {
        if (n_in != 26 || ws_size < WS_END) { fprintf(stderr, "kernel_launch: unexpected n_in %d or workspace %zu < %zu\n", n_in, ws_size, (size_t)WS_END); grid = -1; return; }
        int dev = 0, cus = 0, per_cu = 0;
        if (hipGetDevice(&dev) != hipSuccess || hipDeviceGetAttribute(&cus, hipDeviceAttributeMultiprocessorCount, dev) != hipSuccess) { grid = -1; return; }
        if (hipFuncSetAttribute((const void*)mega, hipFuncAttributeMaxDynamicSharedMemorySize, LDS_BYTES) != hipSuccess) { fprintf(stderr, "kernel_launch: hipFuncSetAttribute failed\n"); grid = -1; return; }
        if (hipOccupancyMaxActiveBlocksPerMultiprocessor(&per_cu, (const void*)mega, NTHREADS, LDS_BYTES) != hipSuccess || per_cu < 1) { fprintf(stderr, "kernel_launch: occupancy query says %d\n", per_cu); per_cu = 1; }
        (void)hipGetLastError();
        grid = cus;
        fprintf(stderr, "kernel_launch: grid %d (cus %d, per_cu %d), ws %zu\n", grid, cus, per_cu, ws_size);
    }
    if (grid < 0) return;
    (void)hipMemsetAsync(d_ws, 0, 131072, stream);
    Args a{};
    for (int i = 0; i < 26; ++i) a.in[i] = (const float*)d_in[i];
    a.out = (float*)d_out; a.ws = (unsigned char*)d_ws;
    void* params[] = {&a};
    hipError_t e = hipLaunchCooperativeKernel((const void*)mega, dim3(grid), dim3(NTHREADS), params, LDS_BYTES, stream);
    if (e != hipSuccess) fprintf(stderr, "kernel_launch: cooperative launch failed: %s (grid %d)\n", hipGetErrorString(e), grid);
}
```

```cpp
#include <hip/hip_runtime.h>
#include <hip/hip_cooperative_groups.h>
#include <cstdio>
#include <cstdint>
namespace cg = cooperative_groups;

typedef unsigned short bf16_t;
typedef short bf16x8 __attribute__((ext_vector_type(8)));
typedef float f32x4 __attribute__((ext_vector_type(4)));
typedef float f32x2 __attribute__((ext_vector_type(2)));
typedef unsigned u32x4 __attribute__((ext_vector_type(4)));
typedef unsigned u32x2 __attribute__((ext_vector_type(2)));
typedef int i32x4 __attribute__((ext_vector_type(4)));
#define LAS __attribute__((address_space(3)))

constexpr int NB = 16, SEQ = 4096, LC = 256, DM = 1024;
constexpr int T = NB * SEQ;
constexpr int TC = NB * LC;
constexpr int TA = T + TC;
constexpr int NIN = 3584;
constexpr int NE = 32, DE = 512;
constexpr int MAXROWS = 2 * T + NE * 256;
constexpr float ALPHA = 1.189207115002721f;
constexpr float LN_EPS = 1e-6f;
constexpr int NTHREADS = 512;

constexpr size_t MiB = 1u << 20;
constexpr size_t WS_CTL = 0;
constexpr size_t WS_BAR = 65536;
constexpr size_t WS_MOD = 1 * MiB;
constexpr size_t WS_EIDX = 3 * MiB;
constexpr size_t WS_EPOS = 3 * MiB + 512 * 1024;
constexpr size_t WS_EW = 4 * MiB;
constexpr size_t WS_DEST = 4 * MiB + 512 * 1024;
constexpr size_t WS_WINT = 6 * MiB;
constexpr size_t WS_WOUTT = 13 * MiB;
constexpr size_t WS_W13T = 15 * MiB;
constexpr size_t WS_W2T = 79 * MiB;
constexpr size_t WS_U = 112 * MiB;
constexpr size_t WS_PROJ = 248 * MiB;
constexpr size_t WS_XG = 248 * MiB;
constexpr size_t WS_HID = 520 * MiB;
constexpr size_t WS_Y = 656 * MiB;
constexpr size_t WS_MIXED = 724 * MiB;
constexpr size_t WS_OSUM = 852 * MiB;
constexpr size_t WS_END = 980 * MiB;
constexpr int LDS_BYTES = 163840;

__device__ __forceinline__ const bf16_t* proj_at(const bf16_t* P, int row, int col) { return P + (((size_t)(col >> 5) * TA + row) << 5) + (col & 31); }

__device__ __forceinline__ float bf2f(bf16_t b) { return __uint_as_float(((unsigned)b) << 16); }
__device__ __forceinline__ bf16_t f2bf(float f) { unsigned u = __float_as_uint(f); return (bf16_t)((u + 0x7fffu + ((u >> 16) & 1u)) >> 16); }
__device__ __forceinline__ unsigned pk2(float lo, float hi) { return (unsigned)f2bf(lo) | ((unsigned)f2bf(hi) << 16); }
__device__ __forceinline__ float frcp(float x) { return __builtin_amdgcn_rcpf(x); }
__device__ __forceinline__ float sigmoidf_(float x) { return frcp(1.0f + __expf(-x)); }
__device__ __forceinline__ float siluf_(float x) { return x * frcp(1.0f + __expf(-x)); }
__device__ __forceinline__ float gelu_tanh(float x) {
    const float y = 0.7978845608028654f * (x + 0.044715f * x * x * x);
    return x * frcp(1.0f + __expf(-2.0f * y));
}
__device__ __forceinline__ float softplusf_(float x) { return fmaxf(x, 0.f) + log1pf(expf(-fabsf(x))); }
__device__ __forceinline__ float wave_sum(float v) {
#pragma unroll
    for (int o = 1; o < 64; o <<= 1) v += __shfl_xor(v, o);
    return v;
}
constexpr int CSTR = 64;
__device__ __forceinline__ int pstart_of(const int* __restrict__ counts, int e) {
    int acc = 0;
    for (int i = 0; i < NE; ++i) { const int p = ((counts[i * CSTR] + 255) >> 8) << 8; if (i < e) acc += p; }
    return acc;
}

namespace pg8 {
#define PG8_LAS __attribute__((address_space(3)))
typedef unsigned short bf16_t;
typedef short bf16x8 __attribute__((ext_vector_type(8)));
typedef float f32x4 __attribute__((ext_vector_type(4)));
typedef unsigned u32x4 __attribute__((ext_vector_type(4)));
constexpr int BM = 256, BK = 64, HALF = 128, HTB = HALF * BK * 2  , STAGE_BYTES = 8 * HTB, NXCD = 8, WGM = 8;

__host__ __device__ __forceinline__ int lds_byte(int r, int c) { const int st = (r >> 4) * 2 + (c >> 5), rr = r & 15, cc = c & 31, ob = rr * 64 + cc * 2; return st * 1024 + (ob ^ (((ob >> 9) & 1) << 5)); }
__host__ __device__ __forceinline__ void stage_rc(int b, int& R, int& C) { const int st = b / 1024, sb = b % 1024, swz = sb ^ (((sb >> 9) & 1) << 5); R = (st >> 1) * 16 + swz / 64; C = (st & 1) * 32 + (swz % 64) / 2; }
__host__ __device__ __forceinline__ int perm32(int rho) { const int n = rho >> 4, i = rho & 15; return 8 * (i >> 2) + 4 * n + (i & 3); }

struct Unit { int pm, pn; };
struct Gemm { const bf16_t* A; const bf16_t* Bt; int M, N, K; };

struct StaticOrder {
    static constexpr bool GATHER = false; const int* rowtok = nullptr;
    int nM, nN, nwg, G, c;
    __host__ __device__ void init(int M, int N, int G_, int c_) { nM = M / BM; nN = N / BM; nwg = nM * nN; G = G_; c = c_; }
    __host__ __device__ bool next(int i, Unit& u) const {
        const long L = (long)i * G + c; if (L >= nwg) return false;
        int wgid = (int)L; { const int q = nwg / NXCD, r = nwg % NXCD, xcd = wgid % NXCD, off = wgid / NXCD; wgid = (xcd < r ? xcd * (q + 1) : r * (q + 1) + (xcd - r) * q) + off; }
        const int nig = WGM * nN, gid = wgid / nig, fm = gid * WGM, gsz = (nM - fm) < WGM ? (nM - fm) : WGM;
        u.pm = fm + ((wgid % nig) % gsz); u.pn = (wgid % nig) / gsz; return true;
    }
    __device__ __forceinline__ void a_ready(const Unit&) const {}
    __device__ __forceinline__ void done(const Unit&) const {}
};

__device__ __forceinline__ unsigned cvt_pk_bf16(float lo, float hi) { unsigned r; asm volatile("v_cvt_pk_bf16_f32 %0, %1, %2" : "=v"(r) : "v"(lo), "v"(hi)); return r; }

struct EpiInProj {
    static constexpr bool PERM = true, AFTER_DRAIN = false;
    bf16_t* P; int variant; int pad;
    __device__ __forceinline__ void operator()(const f32x4 (&acc)[2][2][4][2], const Unit& u, int wr, int wc, int fr_, int fq_) const {
        int fr = fr_, fq = fq_; asm volatile("" : "+v"(fr), "+v"(fq));
        const int row0 = u.pm * BM + wr * 64 + fr, col0 = u.pn * BM + wc * 32 + 8 * fq, grp = variant == 1 ? 0 : (u.pn >> 1);
#pragma unroll
        for (int ai = 0; ai < 2; ++ai)
#pragma unroll
            for (int m = 0; m < 4; ++m) { bf16_t* rowp = P + (((size_t)(8 * u.pn + wc) * TA + (row0 + ai * HALF + m * 16)) << 5) + 8 * fq;
#pragma unroll
                for (int bj = 0; bj < 2; ++bj) { f32x4 v0 = acc[ai][bj][m][0], v1 = acc[ai][bj][m][1];
                    if (grp == 1) {
#pragma unroll
                        for (int j = 0; j < 4; ++j) { v0[j] = gelu_tanh(v0[j]); v1[j] = gelu_tanh(v1[j]); } }
                    else if (grp == 2 || grp == 6) {
#pragma unroll
                        for (int j = 0; j < 4; ++j) { v0[j] = siluf_(v0[j]); v1[j] = siluf_(v1[j]); } }
                    u32x4 w; w.x = cvt_pk_bf16(v0[0], v0[1]); w.y = cvt_pk_bf16(v0[2], v0[3]); w.z = cvt_pk_bf16(v1[0], v1[1]); w.w = cvt_pk_bf16(v1[2], v1[3]);
                    if (variant == 3) { const int wv = __builtin_amdgcn_readfirstlane(threadIdx.x >> 6); *(u32x4*)(P + ((size_t)((u.pm * 14 + u.pn) * 8 + wv) * 16 + (ai * 4 + m) * 2 + bj) * 512 + (threadIdx.x & 63) * 8) = w; }
                    else if (variant != 2 || w.x == 0x12345678u) *(u32x4*)(rowp + (size_t)bj * 4 * TA * 32) = w; } }
    }
};
struct EpiNull {
    static constexpr bool PERM = true, AFTER_DRAIN = false;
    float* sink;
    __device__ __forceinline__ void operator()(const f32x4 (&acc)[2][2][4][2], const Unit& u, int wr, int wc, int fr_, int fq_) const {
        float s = 0.f;
#pragma unroll
        for (int ai = 0; ai < 2; ++ai)
#pragma unroll
            for (int bj = 0; bj < 2; ++bj)
#pragma unroll
                for (int m = 0; m < 4; ++m)
#pragma unroll
                    for (int n = 0; n < 2; ++n) s += acc[ai][bj][m][n][0] + acc[ai][bj][m][n][1] + acc[ai][bj][m][n][2] + acc[ai][bj][m][n][3];
        if (s == 123.456f) sink[0] = s;
    }
};
struct EpiF32 {
    static constexpr bool PERM = false, AFTER_DRAIN = false;
    float* C; int ldc; int pad;
    __device__ __forceinline__ void operator()(const f32x4 (&acc)[2][2][4][2], const Unit& u, int wr, int wc, int fr_, int fq_) const {
        int fr = fr_, fq = fq_; asm volatile("" : "+v"(fr), "+v"(fq));
        const int row0 = u.pm * BM + wr * 64 + fr, col0 = u.pn * BM + wc * 32 + 4 * fq;
#pragma unroll
        for (int ai = 0; ai < 2; ++ai)
#pragma unroll
            for (int m = 0; m < 4; ++m) { float* rowp = C + (size_t)(row0 + ai * HALF + m * 16) * ldc + col0;
#pragma unroll
                for (int bj = 0; bj < 2; ++bj)
#pragma unroll
                    for (int n = 0; n < 2; ++n) *(f32x4*)(rowp + bj * HALF + n * 16) = acc[ai][bj][m][n]; }
    }
};
struct EpiExp1 {
    static constexpr bool PERM = true, AFTER_DRAIN = false;
    bf16_t* H;
    __device__ __forceinline__ void operator()(const f32x4 (&acc)[2][2][4][2], const Unit& u, int wr, int wc, int fr_, int fq_) const {
        int fr = fr_, fq = fq_; asm volatile("" : "+v"(fr), "+v"(fq));
        const int row0 = u.pm * BM + wr * 64 + fr, hc0 = (u.pn & 3) * 128 + wc * 32 + 8 * fq;
#pragma unroll
        for (int ai = 0; ai < 2; ++ai)
#pragma unroll
            for (int m = 0; m < 4; ++m) { bf16_t* rowp = H + (size_t)(row0 + ai * HALF + m * 16) * DE + hc0;
                const f32x4 a0 = acc[ai][0][m][0], a1 = acc[ai][0][m][1], b0 = acc[ai][1][m][0], b1 = acc[ai][1][m][1];
                u32x4 w; w.x = cvt_pk_bf16(siluf_(a0[0]) * b0[0], siluf_(a0[1]) * b0[1]); w.y = cvt_pk_bf16(siluf_(a0[2]) * b0[2], siluf_(a0[3]) * b0[3]);
                w.z = cvt_pk_bf16(siluf_(a1[0]) * b1[0], siluf_(a1[1]) * b1[1]); w.w = cvt_pk_bf16(siluf_(a1[2]) * b1[2], siluf_(a1[3]) * b1[3]);
                *(u32x4*)rowp = w; }
    }
};
struct EpiY {
    static constexpr bool PERM = true, AFTER_DRAIN = false;
    bf16_t* Y;
    __device__ __forceinline__ void operator()(const f32x4 (&acc)[2][2][4][2], const Unit& u, int wr, int wc, int fr_, int fq_) const {
        int fr = fr_, fq = fq_; asm volatile("" : "+v"(fr), "+v"(fq));
        const int row0 = u.pm * BM + wr * 64 + fr, col0 = (u.pn & 3) * BM + wc * 32 + 8 * fq;
#pragma unroll
        for (int ai = 0; ai < 2; ++ai)
#pragma unroll
            for (int m = 0; m < 4; ++m) { bf16_t* rowp = Y + (size_t)(row0 + ai * HALF + m * 16) * DM + col0;
#pragma unroll
                for (int bj = 0; bj < 2; ++bj) { const f32x4 v0 = acc[ai][bj][m][0], v1 = acc[ai][bj][m][1];
                    u32x4 w; w.x = cvt_pk_bf16(v0[0], v0[1]); w.y = cvt_pk_bf16(v0[2], v0[3]); w.z = cvt_pk_bf16(v1[0], v1[1]); w.w = cvt_pk_bf16(v1[2], v1[3]);
                    *(u32x4*)(rowp + bj * HALF) = w; } }
    }
};
template <bool GATHER_>
struct ExpertOrderT {
    static constexpr bool GATHER = GATHER_;
    const int* rbpre; const int* rowtok; int G, c;
    __device__ __forceinline__ bool next(int i, Unit& u) const {
        const int cs = (G & 7) == 0 ? (c & 7) * (G >> 3) + (c >> 3) : c;
        const int L = i * G + cs, rb = L >> 2; int ef = -1;
        for (int e = 0; e < NE; ++e) { if (rb >= rbpre[e] && rb < rbpre[e + 1]) ef = e; }
        if (ef < 0) return false;
        u.pm = rb; u.pn = ef * 4 + (L & 3); return true;
    }
    __device__ __forceinline__ void a_ready(const Unit&) const {}
    __device__ __forceinline__ void done(const Unit&) const {}
};
typedef ExpertOrderT<false> ExpertOrder;
typedef ExpertOrderT<true> ExpertOrderG;

template <class Epi, class Sched, bool ALIGN_EPI = false, bool SP2 = false>
__device__ __forceinline__ void gemm_phase(PG8_LAS unsigned char* lds, const Gemm g, const Sched& S, const Epi& E) {
    int tid_o = threadIdx.x; asm volatile("" : "+v"(tid_o));
    const int tid = tid_o, wid = __builtin_amdgcn_readfirstlane(tid >> 6), lane = tid & 63, wr = wid >> 2, wc = wid & 3, fr = lane & 15, fq = lane >> 4;
    static_assert(SP2 || !Sched::GATHER, "the gathered A operand is wired into the SP2 loop only");
    const int K = g.K, nt = K / BK;
    unsigned voffA[2], voffB[2];
    unsigned gAc[2][2], gAn[2][2]; int gR[2], gC[2];
#pragma unroll
    for (int i = 0; i < 2; ++i) { int R, C; stage_rc(tid * 16 + i * 8192, R, C); const int Rb = Epi::PERM ? ((R & ~31) + perm32(R & 31)) : R;
        voffA[i] = (unsigned)(R * K + C) * 2u; voffB[i] = (unsigned)(Rb * K + C) * 2u; gR[i] = R; gC[i] = C; }
    const size_t kstep = (size_t)(BK * 2);
    const size_t hstep = (size_t)HALF * K * 2;
    const size_t tstep = 2 * hstep;
    const unsigned ldsw = (unsigned)wid * 1024u;
    const int aoff = lds_byte(wr * 64 + fr, fq * 8), boff = lds_byte(wc * 32 + fr, fq * 8);
#define PG8_SA(b, h) (((b) * 2 + (h)) * HTB)
#define PG8_SB(b, h) ((4 + (b) * 2 + (h)) * HTB)
#define PG8_STAGE(bufoff, gbase, voff) do { _Pragma("unroll") for (int _i = 0; _i < 2; ++_i) \
        __builtin_amdgcn_global_load_lds((const unsigned*)((const char*)(gbase) + (voff)[_i]), (PG8_LAS unsigned*)(lds + (bufoff) + ldsw + _i * 8192), 16, 0, 0); } while (0)
#define PG8_STAGE_A(bufoff, ptr, h, goff) do { if constexpr (Sched::GATHER) { PG8_STAGE(bufoff, ptr, (goff)[h]); } else { PG8_STAGE(bufoff, (ptr) + (h) * hstep, voffA); } } while (0)
#define PG8_GLOAD(dst, u) do { _Pragma("unroll") for (int _h = 0; _h < 2; ++_h) _Pragma("unroll") for (int _i = 0; _i < 2; ++_i) \
        dst[_h][_i] = (unsigned)S.rowtok[(u).pm * BM + _h * HALF + gR[_i]] * (unsigned)(K * 2) + (unsigned)(gC[_i] * 2); } while (0)
#define PG8_LDA(dst, b, h) do { _Pragma("unroll") for (int m = 0; m < 4; ++m) _Pragma("unroll") for (int k = 0; k < 2; ++k) dst[m][k] = *(const PG8_LAS bf16x8*)(lds + PG8_SA(b, h) + aoff + m * 2048 + k * 1024); } while (0)
#define PG8_LDB(dst, b, h) do { _Pragma("unroll") for (int n = 0; n < 2; ++n) _Pragma("unroll") for (int k = 0; k < 2; ++k) dst[n][k] = *(const PG8_LAS bf16x8*)(lds + PG8_SB(b, h) + boff + n * 2048 + k * 1024); } while (0)
#define PG8_MMA(ai, bj, At, Bt) do { __builtin_amdgcn_s_setprio(1); _Pragma("unroll") for (int m = 0; m < 4; ++m) _Pragma("unroll") for (int n = 0; n < 2; ++n) _Pragma("unroll") for (int k = 0; k < 2; ++k) \
        acc[ai][bj][m][n] = __builtin_amdgcn_mfma_f32_16x16x32_bf16(Bt[n][k], At[m][k], acc[ai][bj][m][n], 0, 0, 0); __builtin_amdgcn_s_setprio(0); } while (0)
#define PG8_WAIT_V(n) asm volatile("s_waitcnt vmcnt(" #n ")" ::: "memory")
#define PG8_WAIT_L(n) asm volatile("s_waitcnt lgkmcnt(" #n ")" ::: "memory")
#define PG8_BAR __builtin_amdgcn_s_barrier()
#define PG8_SCHED __builtin_amdgcn_sched_barrier(0)
    Unit cur, nxt; int ui = 0;
    if (!S.next(0, cur)) return;
    f32x4 acc[2][2][4][2];
#pragma unroll
    for (int a = 0; a < 2; ++a)
#pragma unroll
        for (int b = 0; b < 2; ++b)
#pragma unroll
            for (int m = 0; m < 4; ++m)
#pragma unroll
                for (int n = 0; n < 2; ++n) acc[a][b][m][n] = (f32x4){0.f, 0.f, 0.f, 0.f};
    bf16x8 At[4][2], B0[2][2], B1[2][2];
    const char* cA = (const char*)g.A + (Sched::GATHER ? (size_t)0 : (size_t)cur.pm * tstep); const char* cB = (const char*)g.Bt + (size_t)cur.pn * tstep;
    if constexpr (Sched::GATHER) { PG8_GLOAD(gAc, cur); }
    S.a_ready(cur);
    if constexpr (SP2) {
        PG8_STAGE(PG8_SB(0, 0), cB, voffB); PG8_STAGE(PG8_SB(0, 1), cB + hstep, voffB); PG8_STAGE_A(PG8_SA(0, 0), cA, 0, gAc); PG8_STAGE_A(PG8_SA(0, 1), cA, 1, gAc);
        if (wr == 1) PG8_BAR;
        PG8_WAIT_V(2); PG8_BAR;
        PG8_STAGE(PG8_SB(1, 0), cB + kstep, voffB); PG8_STAGE_A(PG8_SA(1, 0), cA + kstep, 0, gAc); PG8_STAGE(PG8_SB(1, 1), cB + hstep + kstep, voffB);
        PG8_WAIT_V(6); PG8_BAR;
    } else {
        PG8_STAGE(PG8_SB(0, 0), cB, voffB); PG8_STAGE(PG8_SA(0, 0), cA, voffA); PG8_STAGE(PG8_SB(0, 1), cB + hstep, voffB); PG8_STAGE(PG8_SA(0, 1), cA + hstep, voffA);
        if (wr == 1) PG8_BAR;
        PG8_WAIT_V(4); PG8_BAR;
        PG8_STAGE(PG8_SB(1, 0), cB + kstep, voffB); PG8_STAGE(PG8_SA(1, 0), cA + kstep, voffA); PG8_STAGE(PG8_SB(1, 1), cB + hstep + kstep, voffB);
        PG8_WAIT_V(6); PG8_BAR;
    }
    for (;;) {
        const bool has_next = S.next(ui + 1, nxt);
        const char* nA = (has_next && !Sched::GATHER) ? (const char*)g.A + (size_t)nxt.pm * tstep : cA;
        if constexpr (Sched::GATHER) { if (has_next) { PG8_GLOAD(gAn, nxt); } else { _Pragma("unroll") for (int _h = 0; _h < 2; ++_h) _Pragma("unroll") for (int _i = 0; _i < 2; ++_i) gAn[_h][_i] = gAc[_h][_i]; } }
        const char* nB = has_next ? (const char*)g.Bt + (size_t)nxt.pn * tstep : cB;
        for (int t = 0; t < nt; t += 2) {
            const bool last = (t == nt - 2);
            const char* a1 = cA + (size_t)(t + 1) * kstep;
            const char* a2 = last ? nA : cA + (size_t)(t + 2) * kstep; const char* b2 = last ? nB : cB + (size_t)(t + 2) * kstep;
            const char* a3 = a2 + kstep; const char* b3 = b2 + kstep;
            if (last && has_next) S.a_ready(nxt);
            unsigned g2[2][2];
            if constexpr (Sched::GATHER) { _Pragma("unroll") for (int _h = 0; _h < 2; ++_h) _Pragma("unroll") for (int _i = 0; _i < 2; ++_i) g2[_h][_i] = last ? gAn[_h][_i] : gAc[_h][_i]; }
            if constexpr (SP2) {
            PG8_LDB(B0, 0, 0); PG8_LDB(B1, 0, 1); PG8_SCHED; PG8_LDA(At, 0, 0); PG8_STAGE_A(PG8_SA(1, 1), a1, 1, gAc);
            PG8_WAIT_V(8); PG8_WAIT_L(0); PG8_BAR; PG8_MMA(0, 0, At, B0); PG8_MMA(0, 1, At, B1); PG8_BAR; PG8_SCHED;
            PG8_LDA(At, 0, 1); PG8_STAGE(PG8_SB(0, 0), b2, voffB); PG8_STAGE(PG8_SB(0, 1), b2 + hstep, voffB); PG8_STAGE_A(PG8_SA(0, 0), a2, 0, g2);
            PG8_WAIT_V(8); PG8_WAIT_L(0); PG8_BAR; PG8_MMA(1, 0, At, B0); PG8_MMA(1, 1, At, B1); PG8_BAR; PG8_SCHED;
            PG8_LDB(B0, 1, 0); PG8_LDB(B1, 1, 1); PG8_SCHED; PG8_LDA(At, 1, 0); PG8_STAGE_A(PG8_SA(0, 1), a2, 1, g2);
            PG8_WAIT_V(8); PG8_WAIT_L(0); PG8_BAR; PG8_MMA(0, 0, At, B0); PG8_MMA(0, 1, At, B1); PG8_BAR; PG8_SCHED;
            PG8_LDA(At, 1, 1); PG8_STAGE(PG8_SB(1, 0), b3, voffB); PG8_STAGE(PG8_SB(1, 1), b3 + hstep, voffB); PG8_STAGE_A(PG8_SA(1, 0), a3, 0, g2);
            PG8_WAIT_V(8); PG8_WAIT_L(0); PG8_BAR; PG8_MMA(1, 0, At, B0); PG8_MMA(1, 1, At, B1); PG8_BAR; PG8_SCHED;
            } else {
            PG8_LDB(B0, 0, 0); PG8_SCHED; PG8_LDA(At, 0, 0); PG8_STAGE(PG8_SA(1, 1), a1 + hstep, voffA);
            PG8_WAIT_L(8); PG8_BAR; PG8_WAIT_L(0); PG8_MMA(0, 0, At, B0); PG8_BAR; PG8_SCHED;
            PG8_LDB(B1, 0, 1); PG8_STAGE(PG8_SB(0, 0), b2, voffB);
            PG8_BAR; PG8_WAIT_L(0); PG8_MMA(0, 1, At, B1); PG8_BAR;
            PG8_LDA(At, 0, 1); PG8_STAGE(PG8_SA(0, 0), a2, voffA);
            PG8_BAR; PG8_WAIT_L(0); PG8_MMA(1, 0, At, B0); PG8_BAR; PG8_SCHED;
            PG8_STAGE(PG8_SB(0, 1), b2 + hstep, voffB);
            PG8_WAIT_V(6); PG8_BAR; PG8_MMA(1, 1, At, B1); PG8_BAR;
            PG8_LDB(B0, 1, 0); PG8_SCHED; PG8_LDA(At, 1, 0); PG8_STAGE(PG8_SA(0, 1), a2 + hstep, voffA);
            PG8_WAIT_L(8); PG8_BAR; PG8_WAIT_L(0); PG8_MMA(0, 0, At, B0); PG8_BAR; PG8_SCHED;
            PG8_LDB(B1, 1, 1); PG8_STAGE(PG8_SB(1, 0), b3, voffB);
            PG8_BAR; PG8_WAIT_L(0); PG8_MMA(0, 1, At, B1); PG8_BAR;
            PG8_LDA(At, 1, 1); PG8_STAGE(PG8_SA(1, 0), a3, voffA);
            PG8_BAR; PG8_WAIT_L(0); PG8_MMA(1, 0, At, B0); PG8_BAR; PG8_SCHED;
            PG8_STAGE(PG8_SB(1, 1), b3 + hstep, voffB);
            PG8_WAIT_V(6); PG8_BAR; PG8_MMA(1, 1, At, B1); PG8_BAR;
            }
        }
        if constexpr (ALIGN_EPI) { if (wr == 0) PG8_BAR; }
        if constexpr (!Epi::AFTER_DRAIN) { E(acc, cur, wr, wc, fr, fq); S.done(cur); }
        if (!has_next) break;
#pragma unroll
        for (int a = 0; a < 2; ++a)
#pragma unroll
            for (int b = 0; b < 2; ++b)
#pragma unroll
                for (int m = 0; m < 4; ++m)
#pragma unroll
                    for (int n = 0; n < 2; ++n) acc[a][b][m][n] = (f32x4){0.f, 0.f, 0.f, 0.f};
        cur = nxt; cA = nA; cB = nB; ++ui;
        if constexpr (Sched::GATHER) { _Pragma("unroll") for (int _h = 0; _h < 2; ++_h) _Pragma("unroll") for (int _i = 0; _i < 2; ++_i) gAc[_h][_i] = gAn[_h][_i]; }
        if constexpr (ALIGN_EPI) { if (wr == 1) PG8_BAR; }
    }
    PG8_WAIT_V(0);
    if constexpr (!ALIGN_EPI) { if (wr == 0) PG8_BAR; }
    PG8_BAR;
    if constexpr (Epi::AFTER_DRAIN) { E.fused(acc, cur, wr, wc, fr, fq, lds, wid, lane); S.done(cur); }
#undef PG8_SA
#undef PG8_SB
#undef PG8_STAGE
#undef PG8_STAGE_A
#undef PG8_GLOAD
#undef PG8_LDA
#undef PG8_LDB
#undef PG8_MMA
#undef PG8_WAIT_V
#undef PG8_WAIT_L
#undef PG8_BAR
#undef PG8_SCHED
}
}

struct Args { const float* in[26]; float* out; unsigned char* ws; };

__device__ __forceinline__ void p_mod(LAS unsigned char* lds, const float* __restrict__ c, const float* __restrict__ c_ctx, const float* __restrict__ ada_w,
                                      const float* __restrict__ ada_b, float* __restrict__ mod, int bid, int G, int tid) {
    if (bid >= 96) return;
    LAS float* s = (LAS float*)lds;
    LAS float* red = s + 17 * 1024;
    for (int i = tid; i < 17 * 1024; i += NTHREADS) { const int r = i >> 10, k = i & 1023; const float v = r < NB ? c[r * DM + k] : c_ctx[k]; s[i] = v / (1.0f + expf(-v)); }
    __syncthreads();
    for (int it = bid; it < 96; it += G) {
        const int cc = tid & 63, kg = tid >> 6, col = it * 64 + cc;
        float acc[17];
#pragma unroll
        for (int r = 0; r < 17; ++r) acc[r] = 0.f;
        for (int k = kg * 128; k < kg * 128 + 128; ++k) {
            const float w = ada_w[(size_t)k * 6144 + col];
#pragma unroll
            for (int r = 0; r < 17; ++r) acc[r] += s[r * 1024 + k] * w;
        }
#pragma unroll
        for (int r = 0; r < 17; ++r) red[(kg * 17 + r) * 64 + cc] = acc[r];
        __syncthreads();
        for (int i = tid; i < 17 * 64; i += NTHREADS) {
            const int r = i >> 6, c2 = i & 63; float sum = 0.f;
#pragma unroll
            for (int g = 0; g < 8; ++g) sum += red[(g * 17 + r) * 64 + c2];
            mod[(size_t)r * 6144 + it * 64 + c2] = sum + ada_b[it * 64 + c2];
        }
        __syncthreads();
    }
}

struct TrTile { const float* W; bf16_t* O; int K, N, mode, k0, n0; };
__device__ __forceinline__ TrTile tr_decode(const Args& a, int r) {
    unsigned char* ws = a.ws;
    constexpr int I_IN = 16 * 56, I_OUT = 16 * 16, I_E = 32 * 128;
    TrTile t;
    if (r < I_IN) { t = TrTile{a.in[6], (bf16_t*)(ws + WS_WINT), DM, NIN, 0, (r & 15) * 64, (r >> 4) * 64}; return t; } r -= I_IN;
    if (r < I_OUT) { t = TrTile{a.in[14], (bf16_t*)(ws + WS_WOUTT), DM, DM, 0, (r & 15) * 64, (r >> 4) * 64}; return t; } r -= I_OUT;
    if (r < I_E) { const int e = r >> 7, q = r & 127; t = TrTile{a.in[21] + (size_t)e * DM * DE, (bf16_t*)(ws + WS_W13T) + (size_t)e * DM * DM, DM, DE, 1, (q & 15) * 64, (q >> 4) * 64}; return t; } r -= I_E;
    if (r < I_E) { const int e = r >> 7, q = r & 127; t = TrTile{a.in[22] + (size_t)e * DM * DE, (bf16_t*)(ws + WS_W13T) + (size_t)e * DM * DM, DM, DE, 2, (q & 15) * 64, (q >> 4) * 64}; return t; } r -= I_E;
    { const int e = r >> 7, q = r & 127; t = TrTile{a.in[23] + (size_t)e * DE * DM, (bf16_t*)(ws + WS_W2T) + (size_t)e * DM * DE, DE, DM, 0, (q & 7) * 64, (q >> 3) * 64}; return t; }
}
__device__ __forceinline__ void p_transposes(LAS unsigned char* lds, const Args& a, int bid, int G, int tid) {
    constexpr int NITEMS = (16 * 56 + 16 * 16 + 3 * 32 * 128) / 4;
    const int lrow = tid >> 4, lc4 = (tid & 15) * 4;
    const int sc = tid & 7, sn = tid >> 3;
    for (int it = bid; it < NITEMS; it += G) {
        f32x4 v[4][2]; TrTile t[4];
#pragma unroll
        for (int q = 0; q < 4; ++q) { t[q] = tr_decode(a, it * 4 + q);
#pragma unroll
            for (int h = 0; h < 2; ++h) v[q][h] = *(const f32x4*)(t[q].W + (size_t)(t[q].k0 + lrow + 32 * h) * t[q].N + t[q].n0 + lc4); }
        __syncthreads();
#pragma unroll
        for (int q = 0; q < 4; ++q) { LAS float* tile = (LAS float*)lds + q * (64 * 65);
#pragma unroll
            for (int h = 0; h < 2; ++h)
#pragma unroll
                for (int j = 0; j < 4; ++j) tile[(lrow + 32 * h) * 65 + lc4 + j] = v[q][h][j]; }
        __syncthreads();
#pragma unroll
        for (int q = 0; q < 4; ++q) { const LAS float* tile = (const LAS float*)lds + q * (64 * 65) + (8 * sc) * 65 + sn;
            const int n = t[q].n0 + sn, mode = t[q].mode;
            const int orow = mode == 0 ? n : ((n >> 7) * 256 + (mode == 2 ? 128 : 0) + (n & 127));
            u32x4 w; w.x = pk2(tile[0 * 65], tile[1 * 65]); w.y = pk2(tile[2 * 65], tile[3 * 65]); w.z = pk2(tile[4 * 65], tile[5 * 65]); w.w = pk2(tile[6 * 65], tile[7 * 65]);
            *(u32x4*)(t[q].O + (size_t)orow * t[q].K + t[q].k0 + 8 * sc) = w; }
    }
    __syncthreads();
}

__device__ __forceinline__ void p_u(const float* __restrict__ x, const float* __restrict__ ctx, const float* __restrict__ mod, bf16_t* __restrict__ U, int bid, int G, int tid) {
    const int c8 = (tid & 127) * 8, rsub = tid >> 7;
    for (int row0 = bid * 16; row0 < TA; row0 += G * 16) {
        f32x4 v[4][2];
#pragma unroll
        for (int q = 0; q < 4; ++q) { const int row = row0 + q * 4 + rsub; const float* src = row < T ? x + (size_t)row * DM : ctx + (size_t)(row - T) * DM;
            v[q][0] = *(const f32x4*)(src + c8); v[q][1] = *(const f32x4*)(src + c8 + 4); }
#pragma unroll
        for (int q = 0; q < 4; ++q) { const int row = row0 + q * 4 + rsub; const float* m = mod + (size_t)(row < T ? row / SEQ : 16) * 6144;
            const f32x4 sh0 = *(const f32x4*)(m + c8), sh1 = *(const f32x4*)(m + c8 + 4), sc0 = *(const f32x4*)(m + 1024 + c8), sc1 = *(const f32x4*)(m + 1024 + c8 + 4);
            const f32x4 u0 = v[q][0] * (1.0f + sc0) + sh0, u1 = v[q][1] * (1.0f + sc1) + sh1;
            u32x4 w; w.x = pk2(u0[0], u0[1]); w.y = pk2(u0[2], u0[3]); w.z = pk2(u1[0], u1[1]); w.w = pk2(u1[2], u1[3]);
            *(u32x4*)(U + (size_t)row * DM + c8) = w; }
    }
}

constexpr size_t WS_H1 = WS_XG + 128 * MiB;
constexpr size_t WS_WRT = 878 * MiB;
__device__ __forceinline__ void p_wrt(const float* __restrict__ rgw, const float* __restrict__ rew, bf16_t* __restrict__ wrt, int bid, int G, int tid) {
    for (int o = bid * NTHREADS + tid; o < 48 * 1024; o += G * NTHREADS) { const int e = o >> 10, k = o & 1023;
        const float w = e < 4 ? rgw[k * 4 + e] : (e < 36 ? rew[k * 32 + (e - 4)] : 0.f);
        const bf16_t hi = f2bf(w); wrt[o] = hi; wrt[48 * 1024 + o] = f2bf(w - bf2f(hi)); }
}
__device__ __forceinline__ void p_ln1_router(LAS unsigned char* lds, const Args& a, int bid, int G, int tid, int wave, int lane, bool dry = false, int parts = 3) {
    const float* __restrict__ x = a.in[0]; const bf16_t* yb = (const bf16_t*)(a.ws + WS_XG); bf16_t* h1o = (bf16_t*)(a.ws + (dry ? WS_HID : WS_H1)); const float* mod = (const float*)(a.ws + WS_MOD);
    const float* __restrict__ ln_g = a.in[15]; const float* __restrict__ ln_b = a.in[16]; const float* __restrict__ rgb = a.in[18]; const float* __restrict__ reb = a.in[20];
    bf16_t* U2 = (bf16_t*)(a.ws + (dry ? WS_Y + 16 * MiB : WS_U)); int* counts = (int*)(a.ws + WS_CTL) + (dry ? 32 * CSTR : 0);
    int2* eidx = (int2*)(a.ws + (dry ? WS_Y : WS_EIDX)); int2* epos = (int2*)(a.ws + (dry ? WS_Y + 4 * MiB : WS_EPOS)); float2* ew = (float2*)(a.ws + (dry ? WS_Y + 8 * MiB : WS_EW));
    const bf16_t* __restrict__ wrt = (const bf16_t*)(a.ws + WS_WRT);
    constexpr int WB_STRIDE = 528;
    LAS unsigned char* WB = lds;
    LAS float* LG = (LAS float*)(lds + 51200);
    LAS int* lcnt = (LAS int*)(lds + 102400);
    LAS int* lbase = lcnt + 32;
    LAS i32x4* tinfo = (LAS i32x4*)(lbase + 32);
    LAS f32x2* tw = (LAS f32x2*)(tinfo + 256);
    if (tid < 32) lcnt[tid] = 0;
    for (int blk = bid; blk < T / 256; blk += G) {
        const int tokb = blk * 256;
        const float* m = mod + (size_t)(tokb / SEQ) * 6144;
        if (parts & 1) {
            f32x4 xr[2][4]; u32x2 yr[2][4];
#pragma unroll
            for (int t = 0; t < 2; ++t)
#pragma unroll
                for (int j = 0; j < 4; ++j) { const int c4 = 4 * lane + 256 * j; const int tok = tokb + wave * 32 + t;
                    xr[t][j] = *(const f32x4*)(x + (size_t)tok * DM + c4); yr[t][j] = *(const u32x2*)(yb + (size_t)tok * DM + c4); }
#pragma unroll 1
            for (int it = 0; it < 16; ++it) {
                int l2 = lane; asm volatile("" : "+v"(l2)); const int lane = l2;
                const int tok0 = tokb + wave * 32 + 2 * it;
                f32x4 v[2][4]; float s[2] = {0.f, 0.f};
#pragma unroll
                for (int t = 0; t < 2; ++t)
#pragma unroll
                    for (int j = 0; j < 4; ++j) { const int c4 = 4 * lane + 256 * j;
                        const f32x4 g1 = *(const f32x4*)(m + 2048 + c4); const u32x2 yw = yr[t][j];
                        const f32x4 yv = (f32x4){__uint_as_float(yw.x << 16), __uint_as_float(yw.x & 0xffff0000u), __uint_as_float(yw.y << 16), __uint_as_float(yw.y & 0xffff0000u)};
                        v[t][j] = ALPHA * xr[t][j] + g1 * yv; s[t] += (v[t][j][0] + v[t][j][1]) + (v[t][j][2] + v[t][j][3]); }
                if (it < 15) {
#pragma unroll
                    for (int t = 0; t < 2; ++t)
#pragma unroll
                        for (int j = 0; j < 4; ++j) { const int c4 = 4 * lane + 256 * j; const int tok = tok0 + 2 + t;
                            xr[t][j] = *(const f32x4*)(x + (size_t)tok * DM + c4); yr[t][j] = *(const u32x2*)(yb + (size_t)tok * DM + c4); }
                }
                float rstd[2];
#pragma unroll
                for (int t = 0; t < 2; ++t) { const float mean = wave_sum(s[t]) * (1.0f / DM); float s2 = 0.f;
#pragma unroll
                    for (int j = 0; j < 4; ++j) { v[t][j] = v[t][j] - mean; s2 += (v[t][j][0] * v[t][j][0] + v[t][j][1] * v[t][j][1]) + (v[t][j][2] * v[t][j][2] + v[t][j][3] * v[t][j][3]); }
                    rstd[t] = rsqrtf(wave_sum(s2) * (1.0f / DM) + LN_EPS); }
#pragma unroll
                for (int j = 0; j < 4; ++j) { const int c4 = 4 * lane + 256 * j;
                    const f32x4 lg = *(const f32x4*)(ln_g + c4), lb = *(const f32x4*)(ln_b + c4), sc2 = *(const f32x4*)(m + 4096 + c4), sh2 = *(const f32x4*)(m + 3072 + c4);
#pragma unroll
                    for (int t = 0; t < 2; ++t) { const f32x4 h1 = v[t][j] * rstd[t] * lg + lb;
                        u32x2 hw; hw.x = pk2(h1[0], h1[1]); hw.y = pk2(h1[2], h1[3]);
                        *(u32x2*)(h1o + (size_t)(tok0 + t) * DM + c4) = hw;
                        const f32x4 u2 = h1 * (1.0f + sc2) + sh2;
                        u32x2 w; w.x = pk2(u2[0], u2[1]); w.y = pk2(u2[2], u2[3]);
                        *(u32x2*)(U2 + (size_t)(tok0 + t) * DM + c4) = w; }
                }
            }
        }
        __syncthreads();
        __builtin_amdgcn_fence(__ATOMIC_ACQUIRE, "agent");
        asm volatile("s_waitcnt vmcnt(0)" ::: "memory");
        const int fr = lane & 15, fq = lane >> 4;
        if (parts & 2) {
            f32x4 acc[2][3];
#pragma unroll
            for (int gi = 0; gi < 2; ++gi)
#pragma unroll
                for (int nt = 0; nt < 3; ++nt) acc[gi][nt] = (f32x4){0.f, 0.f, 0.f, 0.f};
            const bf16_t* arow0 = U2 + (size_t)(tokb + (wave * 2 + 0) * 16 + fr) * DM + fq * 8;
            const bf16_t* arow1 = arow0 + (size_t)16 * DM;
#pragma unroll 1
            for (int ch = 0; ch < 4; ++ch) {
                u32x4 wreg[6];
#pragma unroll
                for (int p = 0; p < 6; ++p) { const int idx = p * NTHREADS + tid, row = idx >> 5, piece = idx & 31;
                    wreg[p] = *(const u32x4*)(wrt + (size_t)row * 1024 + ch * 256 + piece * 8); }
                __syncthreads();
#pragma unroll
                for (int p = 0; p < 6; ++p) { const int idx = p * NTHREADS + tid, row = idx >> 5, piece = idx & 31;
                    *(LAS u32x4*)(WB + row * WB_STRIDE + piece * 16) = wreg[p]; }
                __syncthreads();
#pragma unroll 2
                for (int ks = 0; ks < 8; ++ks) {
                    const bf16x8 af0 = *(const bf16x8*)(arow0 + ch * 256 + ks * 32), af1 = *(const bf16x8*)(arow1 + ch * 256 + ks * 32);
#pragma unroll
                    for (int nt = 0; nt < 3; ++nt) {
                        const bf16x8 bh = *(const LAS bf16x8*)(WB + (nt * 16 + fr) * WB_STRIDE + (ks * 32 + fq * 8) * 2), bl = *(const LAS bf16x8*)(WB + (48 + nt * 16 + fr) * WB_STRIDE + (ks * 32 + fq * 8) * 2);
                        acc[0][nt] = __builtin_amdgcn_mfma_f32_16x16x32_bf16(af0, bh, acc[0][nt], 0, 0, 0);
                        acc[1][nt] = __builtin_amdgcn_mfma_f32_16x16x32_bf16(af1, bh, acc[1][nt], 0, 0, 0);
                        acc[0][nt] = __builtin_amdgcn_mfma_f32_16x16x32_bf16(af0, bl, acc[0][nt], 0, 0, 0);
                        acc[1][nt] = __builtin_amdgcn_mfma_f32_16x16x32_bf16(af1, bl, acc[1][nt], 0, 0, 0);
                    }
                }
            }
            LAS float* lg = LG + wave * (2 * 16 * 48);
#pragma unroll
            for (int gi = 0; gi < 2; ++gi)
#pragma unroll
                for (int nt = 0; nt < 3; ++nt)
#pragma unroll
                    for (int j = 0; j < 4; ++j) lg[(gi * 16 + 4 * fq + j) * 48 + 16 * nt + fr] = acc[gi][nt][j];
            asm volatile("s_waitcnt lgkmcnt(0)" ::: "memory");
            if (lane < 32) {
                float pl[36];
#pragma unroll
                for (int e4 = 0; e4 < 9; ++e4) { const f32x4 q = *(const LAS f32x4*)(lg + lane * 48 + 4 * e4);
#pragma unroll
                    for (int r = 0; r < 4; ++r) pl[4 * e4 + r] = q[r]; }
#pragma unroll
                for (int e = 0; e < 36; ++e) pl[e] += e < 4 ? rgb[e] : reb[e - 4];
                int gsel = 0; float gm = pl[0];
#pragma unroll
                for (int g = 1; g < 4; ++g) if (pl[g] > gm) { gm = pl[g]; gsel = g; }
                float den = 0.f;
#pragma unroll
                for (int g = 0; g < 4; ++g) den += __expf(pl[g] - gm);
                const float gval = frcp(den);
                int j0 = -1; float v0 = -3.0e38f;
#pragma unroll
                for (int j = 0; j < 32; ++j) { const bool in = (j >> 3) == gsel; if (in && (j0 < 0 || pl[4 + j] > v0)) { v0 = pl[4 + j]; j0 = j; } }
                int j1 = -1; float v1 = -3.0e38f;
#pragma unroll
                for (int j = 0; j < 32; ++j) { const bool in = (j >> 3) == gsel; if (in && j != j0 && (j1 < 0 || pl[4 + j] > v1)) { v1 = pl[4 + j]; j1 = j; } }
                const float tt = __expf(v1 - v0), w0 = frcp(1.0f + tt), w1 = tt * w0;
                const int p0 = __hip_atomic_fetch_add(lcnt + j0, 1, __ATOMIC_RELAXED, __HIP_MEMORY_SCOPE_WORKGROUP), p1 = __hip_atomic_fetch_add(lcnt + j1, 1, __ATOMIC_RELAXED, __HIP_MEMORY_SCOPE_WORKGROUP);
                const int slot = wave * 32 + lane;
                tinfo[slot] = (i32x4){j0, j1, p0, p1}; tw[slot] = (f32x2){gval * w0, gval * w1};
            }
        }
        __syncthreads();
        if (tid < 32) lbase[tid] = atomicAdd(&counts[tid * CSTR], lcnt[tid]);
        __syncthreads();
        if (tid < 256) {
            const int tok = tokb + tid; const i32x4 ti = tinfo[tid]; const f32x2 wv = tw[tid];
            eidx[tok] = make_int2(ti[0], ti[1]); epos[tok] = make_int2(lbase[ti[0]] + ti[2], lbase[ti[1]] + ti[3]); ew[tok] = make_float2(wv[0], wv[1]);
        }
        if (tid < 32) lcnt[tid] = 0;
        __syncthreads();
    }
}

constexpr size_t WS_ROWTOK = 5 * MiB;
constexpr size_t WS_RBPRE = 2 * MiB;
__device__ __forceinline__ void p_assign(LAS unsigned char* lds, const Args& a, int bid, int G, int tid) {
    const int* counts = (const int*)(a.ws + WS_CTL);
    const int2* eidx = (const int2*)(a.ws + WS_EIDX); const int2* epos = (const int2*)(a.ws + WS_EPOS); int2* dest = (int2*)(a.ws + WS_DEST); int* rowtok = (int*)(a.ws + WS_ROWTOK);
    LAS int* ps = (LAS int*)lds;
    if (tid == 0) { int acc = 0; int* rbpre = (int*)(a.ws + WS_RBPRE); for (int e = 0; e < NE; ++e) { const int c = counts[e * CSTR]; ps[e] = acc; ps[32 + e] = c; if (bid == 0) rbpre[e] = acc >> 8; acc += ((c + 255) >> 8) << 8; } if (bid == 0) rbpre[NE] = acc >> 8; }
    __syncthreads();
    for (int tok = bid * NTHREADS + tid; tok < T; tok += G * NTHREADS) {
        const int2 ei = eidx[tok], ep = epos[tok];
        const int d0 = ps[ei.x] + ep.x, d1 = ps[ei.y] + ep.y;
        rowtok[d0] = tok; rowtok[d1] = tok; dest[tok] = make_int2(d0, d1);
    }
    for (int i = bid * NTHREADS + tid; i < NE * 256; i += G * NTHREADS) {
        const int e = i >> 8, r = i & 255, c = ps[32 + e];
        if (c + r < (((c + 255) >> 8) << 8)) rowtok[ps[e] + c + r] = 0;
    }
    __syncthreads();
}

__device__ __forceinline__ void p_combine_ln2(const Args& a, int bid, int G, int wave, int lane, bool dry = false) {
    const bf16_t* h1b = (const bf16_t*)(a.ws + WS_H1); float* outw = dry ? (float*)(a.ws + WS_HID) : a.out; const bf16_t* Y = (const bf16_t*)(a.ws + WS_Y); const int2* dest = (const int2*)(a.ws + WS_DEST); const float2* ew = (const float2*)(a.ws + WS_EW);
    const float* mod = (const float*)(a.ws + WS_MOD); const float* __restrict__ ln_g = a.in[24]; const float* __restrict__ ln_b = a.in[25];
    int pr = bid * 8 + wave;
    int2 dn[2]; float2 wn[2];
#pragma unroll
    for (int t = 0; t < 2; ++t) { dn[t] = dest[2 * pr + t]; wn[t] = ew[2 * pr + t]; }
#pragma unroll 1
    for (; pr < T / 2; pr += G * 8) {
        int l2 = lane; asm volatile("" : "+v"(l2)); const int lane = l2;
        const int tok0 = 2 * pr;
        const float* m = mod + (size_t)(tok0 / SEQ) * 6144;
        int2 d[2]; float2 w[2];
#pragma unroll
        for (int t = 0; t < 2; ++t) { d[t] = dn[t]; w[t] = wn[t]; }
        f32x4 v[2][4]; float s[2] = {0.f, 0.f};
#pragma unroll
        for (int t = 0; t < 2; ++t)
#pragma unroll
            for (int j = 0; j < 4; ++j) { const int c4 = 4 * lane + 256 * j;
                const u32x2 ya = *(const u32x2*)(Y + (size_t)d[t].x * DM + c4), yb = *(const u32x2*)(Y + (size_t)d[t].y * DM + c4);
                const u32x2 hw = *(const u32x2*)(h1b + (size_t)(tok0 + t) * DM + c4); const f32x4 g2 = *(const f32x4*)(m + 5120 + c4);
                f32x4 f;
                f[0] = w[t].x * __uint_as_float(ya.x << 16) + w[t].y * __uint_as_float(yb.x << 16);
                f[1] = w[t].x * __uint_as_float(ya.x & 0xffff0000u) + w[t].y * __uint_as_float(yb.x & 0xffff0000u);
                f[2] = w[t].x * __uint_as_float(ya.y << 16) + w[t].y * __uint_as_float(yb.y << 16);
                f[3] = w[t].x * __uint_as_float(ya.y & 0xffff0000u) + w[t].y * __uint_as_float(yb.y & 0xffff0000u);
                const f32x4 h1 = (f32x4){__uint_as_float(hw.x << 16), __uint_as_float(hw.x & 0xffff0000u), __uint_as_float(hw.y << 16), __uint_as_float(hw.y & 0xffff0000u)};
                v[t][j] = ALPHA * h1 + g2 * f; s[t] += (v[t][j][0] + v[t][j][1]) + (v[t][j][2] + v[t][j][3]); }
        { const int pn = pr + G * 8; if (pn < T / 2) {
#pragma unroll
            for (int t = 0; t < 2; ++t) { dn[t] = dest[2 * pn + t]; wn[t] = ew[2 * pn + t]; } } }
#pragma unroll
        for (int t = 0; t < 2; ++t) { const float mean = wave_sum(s[t]) * (1.0f / DM); float s2 = 0.f;
#pragma unroll
            for (int j = 0; j < 4; ++j) { v[t][j] = v[t][j] - mean; s2 += (v[t][j][0] * v[t][j][0] + v[t][j][1] * v[t][j][1]) + (v[t][j][2] * v[t][j][2] + v[t][j][3] * v[t][j][3]); }
            const float rstd = rsqrtf(wave_sum(s2) * (1.0f / DM) + LN_EPS);
#pragma unroll
            for (int j = 0; j < 4; ++j) { const int c4 = 4 * lane + 256 * j;
                *(f32x4*)(outw + (size_t)(tok0 + t) * DM + c4) = v[t][j] * rstd * *(const f32x4*)(ln_g + c4) + *(const f32x4*)(ln_b + c4); } }
    }
}

constexpr size_t WS_HGK = WS_U;
constexpr size_t WS_HGD = 852 * MiB;
constexpr size_t WS_RGAGG = 854 * MiB;
constexpr size_t WS_RGCARRY = 864 * MiB;
constexpr size_t WS_GWT = 870 * MiB;
constexpr size_t WS_OFST = 880 * MiB;
constexpr int RG_UNITS_PER_B = 68, HG_SEGS = 17;

__device__ __forceinline__ void lds_barrier() { asm volatile("s_waitcnt lgkmcnt(0)" ::: "memory"); __builtin_amdgcn_s_barrier(); asm volatile("" ::: "memory"); }
__device__ __forceinline__ bf16x8 mk_bf16x8(u32x4 v) { return __builtin_bit_cast(bf16x8, v); }
__device__ __forceinline__ float bf_lo(unsigned w) { return __uint_as_float(w << 16); }
__device__ __forceinline__ float bf_hi(unsigned w) { return __uint_as_float(w & 0xffff0000u); }
__device__ __forceinline__ unsigned cvt2(float lo, float hi) { unsigned r; asm volatile("v_cvt_pk_bf16_f32 %0, %1, %2" : "=v"(r) : "v"(lo), "v"(hi)); return r; }

__device__ __forceinline__ void p_gwt(const float* __restrict__ gate_w, bf16_t* __restrict__ gwt, int bid, int G, int tid) {
    for (int o = bid * NTHREADS + tid; o < 32 * 4096; o += G * NTHREADS) { const int mat = o >> 12, d = (o >> 6) & 63, c = o & 63; gwt[o] = f2bf(gate_w[mat * 4096 + c * 64 + d]); }
}

constexpr int XC_STRIDE = 1040;
constexpr int RG_XC = 0, RG_OUT = 64 * XC_STRIDE;
constexpr size_t WS_RGPAR = 876 * MiB;

__device__ __forceinline__ void p_rgpar(const float* __restrict__ gate_b, const float* __restrict__ lam, float* __restrict__ par, int bid, int G, int tid) {
    for (int o = bid * NTHREADS + tid; o < 2 * 512; o += G * NTHREADS) { const int dir = o >> 9, ch = o & 511;
        par[(dir * 3 + 0) * 512 + ch] = gate_b[(dir * 2 + 0) * 512 + ch]; par[(dir * 3 + 1) * 512 + ch] = gate_b[(dir * 2 + 1) * 512 + ch]; par[(dir * 3 + 2) * 512 + ch] = softplusf_(-lam[dir * 512 + ch]); }
}

template <int DIR, bool OUT>
__device__ __forceinline__ void rg_scan64(const float (&av)[4][4], const float (&uv)[4][4], float& carry, float& atot, float (&hsum)[4][4], int fr, int fq) {
#pragma unroll
    for (int mm = 0; mm < 4; ++mm) {
        const int m = DIR == 0 ? mm : 3 - mm;
        float P, H;
        if (DIR == 0) { P = av[m][0]; H = uv[m][0];
#pragma unroll
            for (int j = 1; j < 4; ++j) { H = av[m][j] * H + uv[m][j]; P *= av[m][j]; } }
        else { P = av[m][3]; H = uv[m][3];
#pragma unroll
            for (int j = 2; j >= 0; --j) { H = av[m][j] * H + uv[m][j]; P *= av[m][j]; } }
        float Pn, Hn, Pe, He, Pt, Ht;
        if (DIR == 0) {
            Pn = __shfl_up(P, 16); Hn = __shfl_up(H, 16); if (fq >= 1) { H = P * Hn + H; P = P * Pn; }
            Pn = __shfl_up(P, 32); Hn = __shfl_up(H, 32); if (fq >= 2) { H = P * Hn + H; P = P * Pn; }
            Pe = __shfl_up(P, 16); He = __shfl_up(H, 16); if (fq == 0) { Pe = 1.f; He = 0.f; }
            Pt = __shfl(P, fr + 48); Ht = __shfl(H, fr + 48);
        } else {
            Pn = __shfl_down(P, 16); Hn = __shfl_down(H, 16); if (fq <= 2) { H = P * Hn + H; P = P * Pn; }
            Pn = __shfl_down(P, 32); Hn = __shfl_down(H, 32); if (fq <= 1) { H = P * Hn + H; P = P * Pn; }
            Pe = __shfl_down(P, 16); He = __shfl_down(H, 16); if (fq == 3) { Pe = 1.f; He = 0.f; }
            Pt = __shfl(P, fr); Ht = __shfl(H, fr);
        }
        if (OUT) {
            float hp = Pe * carry + He;
            if (DIR == 0) {
#pragma unroll
                for (int j = 0; j < 4; ++j) { hp = av[m][j] * hp + uv[m][j]; hsum[m][j] = hp; }
            } else {
#pragma unroll
                for (int j = 3; j >= 0; --j) { hp = av[m][j] * hp + uv[m][j]; hsum[m][j] += hp; }
            }
        }
        carry = Pt * carry + Ht; atot *= Pt;
    }
}

__device__ __forceinline__ void rg_agg_unit(LAS unsigned char* lds, const Args& a, int b, int k, int tid, int wave, int lane, int xr = 0) {
    const bf16_t* __restrict__ proj = (const bf16_t*)(a.ws + WS_PROJ);
    const float* __restrict__ conv_w = a.in[7]; const float* __restrict__ conv_b = a.in[8];
    const bf16_t* __restrict__ gwt = (const bf16_t*)(a.ws + WS_GWT); const float* __restrict__ par = (const float*)(a.ws + WS_RGPAR);
    float* rgagg = (float*)(a.ws + WS_RGAGG);
    int rowbase, p0, lo, hi;
    if (k < 4) { rowbase = T + b * LC; p0 = k * 64; lo = 0; hi = LC; } else { rowbase = b * SEQ; p0 = (k - 4) * 64; lo = p0; hi = p0 + 64; }
    const int unit = b * RG_UNITS_PER_B + k;
    const int n = wave, fr = lane & 15, fq = lane >> 4;
    float pgr[4][2], pgi[4][2], psp[4][2];
#pragma unroll
    for (int nt = 0; nt < 4; ++nt)
#pragma unroll
        for (int dir = 0; dir < 2; ++dir) { const int ch = n * 64 + nt * 16 + fr;
            pgr[nt][dir] = par[(dir * 3 + 0) * 512 + ch]; pgi[nt][dir] = par[(dir * 3 + 1) * 512 + ch]; psp[nt][dir] = par[(dir * 3 + 2) * 512 + ch]; }
    if (!(xr & 1)) {
        const int cgp = tid & 63, tg = tid >> 6, c0 = cgp * 8, i0 = tg * 8;
        u32x4 raw[11];
#pragma unroll
        for (int r = 0; r < 11; ++r) { const int p = p0 + i0 - 1 + r;
            raw[r] = (p >= lo && p < hi) ? *(const u32x4*)proj_at(proj, rowbase + p, c0) : (u32x4){0u, 0u, 0u, 0u}; }
        float cw[4][8], cb[8];
#pragma unroll
        for (int t4 = 0; t4 < 4; ++t4) { const f32x4 w0 = *(const f32x4*)(conv_w + t4 * 512 + c0), w1 = *(const f32x4*)(conv_w + t4 * 512 + c0 + 4);
#pragma unroll
            for (int q = 0; q < 4; ++q) { cw[t4][q] = w0[q]; cw[t4][4 + q] = w1[q]; } }
        { const f32x4 b0 = *(const f32x4*)(conv_b + c0), b1 = *(const f32x4*)(conv_b + c0 + 4);
#pragma unroll
            for (int q = 0; q < 4; ++q) { cb[q] = b0[q]; cb[4 + q] = b1[q]; } }
#pragma unroll
        for (int ii = 0; ii < 8; ++ii) {
            float xc[8];
#pragma unroll
            for (int c = 0; c < 8; ++c) xc[c] = cb[c];
#pragma unroll
            for (int t4 = 0; t4 < 4; ++t4) { const u32x4 rw = raw[ii + t4];
#pragma unroll
                for (int q = 0; q < 4; ++q) { xc[2 * q] += cw[t4][2 * q] * bf_lo(rw[q]); xc[2 * q + 1] += cw[t4][2 * q + 1] * bf_hi(rw[q]); } }
            u32x4 w; w.x = cvt2(xc[0], xc[1]); w.y = cvt2(xc[2], xc[3]); w.z = cvt2(xc[4], xc[5]); w.w = cvt2(xc[6], xc[7]);
            *(LAS u32x4*)(lds + RG_XC + (i0 + ii) * XC_STRIDE + c0 * 2) = w;
        }
    }
    lds_barrier();
    {
        bf16x8 afr[4][2];
#pragma unroll
        for (int m = 0; m < 4; ++m)
#pragma unroll
            for (int ks = 0; ks < 2; ++ks) afr[m][ks] = *(const LAS bf16x8*)(lds + RG_XC + (16 * m + fr) * XC_STRIDE + (n * 64 + ks * 32 + fq * 8) * 2);
        u32x4* stash = (k >= 4) ? (u32x4*)a.out + ((size_t)(b * 64 + (k - 4)) * 16384 + (size_t)wave * 2048 + lane) : nullptr;
        bf16x8 wfr[2][2][2];
#pragma unroll
        for (int dir = 0; dir < 2; ++dir)
#pragma unroll
            for (int g = 0; g < 2; ++g)
#pragma unroll
                for (int ks = 0; ks < 2; ++ks) wfr[dir][g][ks] = *(const bf16x8*)(gwt + ((size_t)(((dir * 2 + g) * 8 + n) * 64 + fr)) * 64 + ks * 32 + fq * 8);
#pragma unroll
        for (int nt = 0; nt < 4; ++nt) {
            const int ch = n * 64 + nt * 16 + fr;
            bf16x8 wnx[2][2][2];
            if (nt < 3) {
#pragma unroll
                for (int dir = 0; dir < 2; ++dir)
#pragma unroll
                    for (int g = 0; g < 2; ++g)
#pragma unroll
                        for (int ks = 0; ks < 2; ++ks) wnx[dir][g][ks] = *(const bf16x8*)(gwt + ((size_t)(((dir * 2 + g) * 8 + n) * 64 + (nt + 1) * 16 + fr)) * 64 + ks * 32 + fq * 8);
            }
            float xcv[4][4];
#pragma unroll
            for (int m = 0; m < 4; ++m)
#pragma unroll
                for (int j = 0; j < 4; ++j) xcv[m][j] = bf2f(*(const LAS bf16_t*)(lds + RG_XC + (16 * m + 4 * fq + j) * XC_STRIDE + ch * 2));
#pragma unroll
            for (int dir = 0; dir < 2; ++dir) {
                f32x4 accr[4], acci[4];
#pragma unroll
                for (int m = 0; m < 4; ++m) { accr[m] = (f32x4){0.f, 0.f, 0.f, 0.f}; acci[m] = (f32x4){0.f, 0.f, 0.f, 0.f}; }
                if (!(xr & 2))
#pragma unroll
                for (int ks = 0; ks < 2; ++ks)
#pragma unroll
                    for (int m = 0; m < 4; ++m) { accr[m] = __builtin_amdgcn_mfma_f32_16x16x32_bf16(afr[m][ks], wfr[dir][0][ks], accr[m], 0, 0, 0); acci[m] = __builtin_amdgcn_mfma_f32_16x16x32_bf16(afr[m][ks], wfr[dir][1][ks], acci[m], 0, 0, 0); }
                const float gbr = pgr[nt][dir], gbi = pgi[nt][dir], sp = psp[nt][dir];
                float av[4][4], uv[4][4];
                const bool exact = __any(8.0f * sp >= 0.25f);
#pragma unroll
                for (int m = 0; m < 4; ++m) {
                    unsigned pk[4];
                    if (xr & 4) {
#pragma unroll
                        for (int j = 0; j < 4; ++j) pk[j] = __float_as_uint(accr[m][j] + acci[m][j] + xcv[m][j]);
                    } else if (!exact) {
#pragma unroll
                        for (int j = 0; j < 4; ++j) {
                            const float r = sigmoidf_(accr[m][j] + gbr), ig = sigmoidf_(acci[m][j] + gbi);
                            const float la = -8.0f * r * sp;
                            const float oma = -la * (1.f + la * (0.5f + la * (0.16666667f + la * (0.041666668f + la * 0.0083333338f))));
                            pk[j] = cvt2(oma, __builtin_amdgcn_sqrtf(oma * (2.0f - oma)) * ig * xcv[m][j]);
                        }
                    } else {
#pragma unroll
                        for (int j = 0; j < 4; ++j) {
                            const float r = sigmoidf_(accr[m][j] + gbr), ig = sigmoidf_(acci[m][j] + gbi);
                            const float la = -8.0f * r * sp;
                            const float ser = -la * (1.f + la * (0.5f + la * (0.16666667f + la * (0.041666668f + la * 0.0083333338f))));
                            const float oma = (la > -0.25f) ? ser : 1.f - __expf(la);
                            pk[j] = cvt2(oma, __builtin_amdgcn_sqrtf(oma * (2.0f - oma)) * ig * xcv[m][j]);
                        }
                    }
#pragma unroll
                    for (int j = 0; j < 4; ++j) { av[m][j] = 1.0f - bf_lo(pk[j]); uv[m][j] = bf_hi(pk[j]); }
                    if (stash && !(xr & 16)) stash[((nt * 2 + dir) * 4 + m) * 64] = (u32x4){pk[0], pk[1], pk[2], pk[3]};
                }
                float carry = 0.f, atot = 1.f, hdummy[4][4];
                if (xr & 8) { carry = av[0][0] + uv[3][3]; } else if (dir == 0) rg_scan64<0, false>(av, uv, carry, atot, hdummy, fr, fq); else rg_scan64<1, false>(av, uv, carry, atot, hdummy, fr, fq);
                if (fq == 0) { rgagg[(((size_t)unit * 2 + dir) * 2 + 0) * 512 + ch] = atot; rgagg[(((size_t)unit * 2 + dir) * 2 + 1) * 512 + ch] = carry; }
            }
            if (nt < 3) {
#pragma unroll
                for (int dir = 0; dir < 2; ++dir)
#pragma unroll
                    for (int g = 0; g < 2; ++g)
#pragma unroll
                        for (int ks = 0; ks < 2; ++ks) wfr[dir][g][ks] = wnx[dir][g][ks];
            }
        }
    }
    lds_barrier();
}

__device__ __forceinline__ void rg_final_unit(LAS unsigned char* lds, const Args& a, int b, int kl, int tid, int wave, int lane) {
    const bf16_t* __restrict__ proj = (const bf16_t*)(a.ws + WS_PROJ); const float* rgcarry = (const float*)(a.ws + WS_RGCARRY); bf16_t* mixed = (bf16_t*)(a.ws + WS_MIXED);
    const int rowbase = b * SEQ + kl * 64, unit = b * RG_UNITS_PER_B + 4 + kl;
    const int n = wave, fr = lane & 15, fq = lane >> 4;
    const u32x4* stash = (const u32x4*)a.out + ((size_t)(b * 64 + kl) * 16384 + (size_t)wave * 2048 + lane);
    u32x4 st[2][4];
#pragma unroll
    for (int dir = 0; dir < 2; ++dir)
#pragma unroll
        for (int m = 0; m < 4; ++m) st[dir][m] = stash[((0 * 2 + dir) * 4 + m) * 64];
    float cin[4][2];
#pragma unroll
    for (int nt = 0; nt < 4; ++nt)
#pragma unroll
        for (int dir = 0; dir < 2; ++dir) cin[nt][dir] = rgcarry[((size_t)unit * 2 + dir) * 512 + n * 64 + nt * 16 + fr];
    {
        const int cgp = tid & 63, tg = tid >> 6, c0 = cgp * 8, i0 = tg * 8;
        u32x4 g[8];
#pragma unroll
        for (int ii = 0; ii < 8; ++ii) g[ii] = *(const u32x4*)proj_at(proj, rowbase + i0 + ii, 512 + c0);
#pragma unroll
        for (int ii = 0; ii < 8; ++ii) *(LAS u32x4*)(lds + RG_XC + (i0 + ii) * XC_STRIDE + c0 * 2) = g[ii];
    }
    lds_barrier();
#pragma unroll
    for (int nt = 0; nt < 4; ++nt) {
        const int ch = n * 64 + nt * 16 + fr;
        u32x4 sn[2][4];
        if (nt < 3) {
#pragma unroll
            for (int dir = 0; dir < 2; ++dir)
#pragma unroll
                for (int m = 0; m < 4; ++m) sn[dir][m] = stash[(((nt + 1) * 2 + dir) * 4 + m) * 64];
        }
        float hsum[4][4];
#pragma unroll
        for (int dir = 0; dir < 2; ++dir) {
            float av[4][4], uv[4][4];
#pragma unroll
            for (int m = 0; m < 4; ++m)
#pragma unroll
                for (int j = 0; j < 4; ++j) { av[m][j] = 1.0f - bf_lo(st[dir][m][j]); uv[m][j] = bf_hi(st[dir][m][j]); }
            float carry = cin[nt][dir], atot = 1.f;
            if (dir == 0) rg_scan64<0, true>(av, uv, carry, atot, hsum, fr, fq); else rg_scan64<1, true>(av, uv, carry, atot, hsum, fr, fq);
        }
#pragma unroll
        for (int m = 0; m < 4; ++m)
#pragma unroll
            for (int j = 0; j < 4; ++j) { const int t = 16 * m + 4 * fq + j;
                const float gg = bf2f(*(const LAS bf16_t*)(lds + RG_XC + t * XC_STRIDE + ch * 2));
                *(LAS bf16_t*)(lds + RG_OUT + t * XC_STRIDE + ch * 2) = (bf16_t)(cvt2(hsum[m][j] * gg, 0.f) & 0xffffu); }
        if (nt < 3) {
#pragma unroll
            for (int dir = 0; dir < 2; ++dir)
#pragma unroll
                for (int m = 0; m < 4; ++m) st[dir][m] = sn[dir][m];
        }
    }
    lds_barrier();
    {
        const int cgp = tid & 63, tg = tid >> 6, c0 = cgp * 8, i0 = tg * 8;
#pragma unroll
        for (int ii = 0; ii < 8; ++ii) { const u32x4 w = *(const LAS u32x4*)(lds + RG_OUT + (i0 + ii) * XC_STRIDE + c0 * 2);
            *(u32x4*)(mixed + (size_t)(rowbase + i0 + ii) * DM + c0) = w; }
    }
}

__device__ __forceinline__ void rg_carry_item(const Args& a, int item, int tid) {
    const float* rgagg = (const float*)(a.ws + WS_RGAGG); float* rgcarry = (float*)(a.ws + WS_RGCARRY);
    const int gidx = item * NTHREADS + tid;
    const int ch = gidx & 511, dir = (gidx >> 9) & 1, b = gidx >> 10;
    float h = 0.f;
#pragma unroll 1
    for (int s0 = 0; s0 < RG_UNITS_PER_B; s0 += 17) {
        float Av[17], Hv[17];
#pragma unroll
        for (int s1 = 0; s1 < 17; ++s1) { const int s = s0 + s1;
            const int k = dir == 0 ? s : (s < 4 ? 3 - s : 67 - (s - 4));
            const size_t unit = (size_t)b * RG_UNITS_PER_B + k;
            Av[s1] = rgagg[((unit * 2 + dir) * 2 + 0) * 512 + ch]; Hv[s1] = rgagg[((unit * 2 + dir) * 2 + 1) * 512 + ch]; }
#pragma unroll
        for (int s1 = 0; s1 < 17; ++s1) { const int s = s0 + s1;
            const int k = dir == 0 ? s : (s < 4 ? 3 - s : 67 - (s - 4));
            const size_t unit = (size_t)b * RG_UNITS_PER_B + k;
            rgcarry[(unit * 2 + dir) * 512 + ch] = h;
            h = Av[s1] * h + Hv[s1]; }
    }
}

#ifndef HGX
#define HGX 0
#endif
__device__ __forceinline__ float row_allsum16(float v) {
    v += __builtin_bit_cast(float, __builtin_amdgcn_update_dpp(0, __builtin_bit_cast(int, v), 0x128, 0xf, 0xf, false));
    v += __builtin_bit_cast(float, __builtin_amdgcn_update_dpp(0, __builtin_bit_cast(int, v), 0x124, 0xf, 0xf, false));
    v += __builtin_bit_cast(float, __builtin_amdgcn_update_dpp(0, __builtin_bit_cast(int, v), 0x122, 0xf, 0xf, false));
    v += __builtin_bit_cast(float, __builtin_amdgcn_update_dpp(0, __builtin_bit_cast(int, v), 0x121, 0xf, 0xf, false));
    return v;
}
constexpr int HG_RAWZ = 0, HG_RAWV = 16384, HG_RAWQ = 32768;
constexpr int HG_KHT = 49152, HG_VT = 67584;
constexpr int HG_QT = 86016, HG_KT = 103424;
constexpr int HG_AM = 120832;
constexpr int HG_DS = 130048, HG_QSUM = 130560, HG_PART = 134656;
constexpr int HG_RAWG = 136704;
constexpr int HG_OST = HG_QT;
constexpr int TS = 144, QS = 272;

struct HgRaw { u32x4 z[2], v[2], q[2], g[2]; };
template <bool FULL, bool GATE>
__device__ __forceinline__ void hg_load_raw(HgRaw& r, const bf16_t* __restrict__ proj, int row0, int hd, int dir, int tid) {
#pragma unroll
    for (int i = 0; i < 2; ++i) { const int row = row0 + (tid >> 4) + 32 * i, col = hd * 128 + (tid & 15) * 8;
        r.z[i] = *(const u32x4*)proj_at(proj, row, col + (dir == 0 ? 1536 : 2048)); r.v[i] = *(const u32x4*)proj_at(proj, row, col + 2560);
        if (FULL) r.q[i] = *(const u32x4*)proj_at(proj, row, col + 1024); if (GATE) r.g[i] = *(const u32x4*)proj_at(proj, row, col + 3072); }
}
template <bool FULL, bool GATE>
__device__ __forceinline__ void hg_store_raw(LAS unsigned char* lds, const HgRaw& r, int tid) {
#pragma unroll
    for (int i = 0; i < 2; ++i) { const int off = ((tid >> 4) + 32 * i) * 256 + (tid & 15) * 16;
        *(LAS u32x4*)(lds + HG_RAWZ + off) = r.z[i]; *(LAS u32x4*)(lds + HG_RAWV + off) = r.v[i]; if (FULL) *(LAS u32x4*)(lds + HG_RAWQ + off) = r.q[i]; if (GATE) *(LAS u32x4*)(lds + HG_RAWG + off) = r.g[i]; }
}

template <int DIR, bool FULL, bool STORE_NEXT, bool NEXT_GATE>
__device__ __forceinline__ void hg_chunk(LAS unsigned char* lds, f32x4 (&accS)[8], f32x4 (&o)[4], float lb0, float lb1, float& dseg0, float& dseg1, const HgRaw& nxt, int tid, int wave, int lane, int xm = 0) {
    const int cp = lane, tg = wave, fr = lane & 15, fq = lane >> 4;
    float c0[8], c1[8], k0[8], k1[8];
    if (xm & 1) {
#pragma unroll
        for (int i = 0; i < 8; ++i) { c0[i] = 1.f; c1[i] = 1.f; k0[i] = 0.5f; k1[i] = 0.5f; }
    } else {
        float p0 = 1.f, p1 = 1.f;
#pragma unroll
        for (int ii = 0; ii < 8; ++ii) { const int i = DIR == 0 ? ii : 7 - ii;
            const unsigned zz = *(const LAS unsigned*)(lds + HG_RAWZ + (8 * tg + i) * 256 + cp * 4);
            const float e0 = __expf(-bf_lo(zz)), e1 = __expf(-bf_hi(zz)); const float s0 = frcp(1.0f + e0), s1 = frcp(1.0f + e1);
            k0[i] = (1.0f - lb0) * e0 * s0; k1[i] = (1.0f - lb1) * e1 * s1;
            p0 *= lb0 + (1.0f - lb0) * s0; p1 *= lb1 + (1.0f - lb1) * s1; c0[i] = p0; c1[i] = p1; }
        *(LAS f32x2*)(lds + HG_QSUM + (tg * 128 + 2 * cp) * 4) = (f32x2){p0, p1};
    }
    lds_barrier();
    float pre0 = 1.f, pre1 = 1.f, tot0 = 1.f, tot1 = 1.f;
#pragma unroll
    for (int g = 0; g < 8; ++g) { const f32x2 v = *(const LAS f32x2*)(lds + HG_QSUM + (g * 128 + 2 * cp) * 4); tot0 *= v[0]; tot1 *= v[1]; if (DIR == 0 ? (g < tg) : (g > tg)) { pre0 *= v[0]; pre1 *= v[1]; } }
    if (!(xm & 1)) {
        unsigned kh0[4], kh1[4], vt0[4], vt1[4];
#pragma unroll
        for (int i2 = 0; i2 < 4; ++i2) {
            const float Pa0 = pre0 * c0[2 * i2], Pb0 = pre0 * c0[2 * i2 + 1], Pa1 = pre1 * c1[2 * i2], Pb1 = pre1 * c1[2 * i2 + 1];
            const float ra0 = frcp(Pa0), rb0 = frcp(Pb0), ra1 = frcp(Pa1), rb1 = frcp(Pb1);
            const float kta0 = k0[2 * i2] * ra0, ktb0 = k0[2 * i2 + 1] * rb0, kta1 = k1[2 * i2] * ra1, ktb1 = k1[2 * i2 + 1] * rb1;
            kh0[i2] = cvt2(kta0 * tot0, ktb0 * tot0); kh1[i2] = cvt2(kta1 * tot1, ktb1 * tot1);
            const unsigned va = *(const LAS unsigned*)(lds + HG_RAWV + (8 * tg + 2 * i2) * 256 + cp * 4), vb = *(const LAS unsigned*)(lds + HG_RAWV + (8 * tg + 2 * i2 + 1) * 256 + cp * 4);
            vt0[i2] = __builtin_amdgcn_perm(vb, va, 0x05040100u); vt1[i2] = __builtin_amdgcn_perm(vb, va, 0x07060302u);
            if (FULL) {
                const unsigned qa = *(const LAS unsigned*)(lds + HG_RAWQ + (8 * tg + 2 * i2) * 256 + cp * 4), qb = *(const LAS unsigned*)(lds + HG_RAWQ + (8 * tg + 2 * i2 + 1) * 256 + cp * 4);
                *(LAS unsigned*)(lds + HG_QT + (8 * tg + 2 * i2) * QS + cp * 4) = cvt2(bf_lo(qa) * Pa0, bf_hi(qa) * Pa1);
                *(LAS unsigned*)(lds + HG_QT + (8 * tg + 2 * i2 + 1) * QS + cp * 4) = cvt2(bf_lo(qb) * Pb0, bf_hi(qb) * Pb1);
                *(LAS unsigned*)(lds + HG_KT + (8 * tg + 2 * i2) * QS + cp * 4) = cvt2(kta0, kta1);
                *(LAS unsigned*)(lds + HG_KT + (8 * tg + 2 * i2 + 1) * QS + cp * 4) = cvt2(ktb0, ktb1);
            }
        }
        *(LAS u32x4*)(lds + HG_KHT + (2 * cp) * TS + tg * 16) = (u32x4){kh0[0], kh0[1], kh0[2], kh0[3]}; *(LAS u32x4*)(lds + HG_KHT + (2 * cp + 1) * TS + tg * 16) = (u32x4){kh1[0], kh1[1], kh1[2], kh1[3]};
        *(LAS u32x4*)(lds + HG_VT + (2 * cp) * TS + tg * 16) = (u32x4){vt0[0], vt0[1], vt0[2], vt0[3]}; *(LAS u32x4*)(lds + HG_VT + (2 * cp + 1) * TS + tg * 16) = (u32x4){vt1[0], vt1[1], vt1[2], vt1[3]};
        if (tg == 0) { *(LAS f32x2*)(lds + HG_DS + 2 * cp * 4) = (f32x2){tot0, tot1}; dseg0 *= tot0; dseg1 *= tot1; }
    }
    lds_barrier();
    if (FULL) {
        if (!(xm & 2))
#pragma unroll
        for (int tt = 0; tt < 2; ++tt) {
            const int tl = 2 * wave + tt, ti = tl >> 2, si = tl & 3;
            f32x4 accA = (f32x4){0.f, 0.f, 0.f, 0.f};
#pragma unroll
            for (int ks = 0; ks < 4; ++ks) {
                const bf16x8 af = *(const LAS bf16x8*)(lds + HG_QT + (16 * ti + fr) * QS + (ks * 32 + fq * 8) * 2);
                const bf16x8 bf = *(const LAS bf16x8*)(lds + HG_KT + (16 * si + fr) * QS + (ks * 32 + fq * 8) * 2);
                accA = __builtin_amdgcn_mfma_f32_16x16x32_bf16(af, bf, accA, 0, 0, 0);
            }
#pragma unroll
            for (int j = 0; j < 4; ++j) { const int t = 16 * ti + 4 * fq + j, s = 16 * si + fr;
                const bool keep = DIR == 0 ? (s <= t) : (s >= t);
                *(LAS bf16_t*)(lds + HG_AM + t * TS + s * 2) = (bf16_t)(cvt2(keep ? accA[j] : 0.f, 0.f) & 0xffffu); }
        }
        lds_barrier();
#pragma unroll
        for (int m = 0; m < 4; ++m) o[m] = (f32x4){0.f, 0.f, 0.f, 0.f};
        if (!(xm & 4)) {
#pragma unroll
        for (int ks = 0; ks < 4; ++ks) {
            const u32x4 sw = (u32x4){cvt2(accS[2 * ks][0], accS[2 * ks][1]), cvt2(accS[2 * ks][2], accS[2 * ks][3]), cvt2(accS[2 * ks + 1][0], accS[2 * ks + 1][1]), cvt2(accS[2 * ks + 1][2], accS[2 * ks + 1][3])};
            const bf16x8 sf = mk_bf16x8(sw);
#pragma unroll
            for (int m = 0; m < 4; ++m) {
                const u32x2 qlo = *(const LAS u32x2*)(lds + HG_QT + (16 * m + fr) * QS + (32 * ks + 4 * fq) * 2), qhi = *(const LAS u32x2*)(lds + HG_QT + (16 * m + fr) * QS + (32 * ks + 16 + 4 * fq) * 2);
                const bf16x8 qf = mk_bf16x8((u32x4){qlo.x, qlo.y, qhi.x, qhi.y});
                o[m] = __builtin_amdgcn_mfma_f32_16x16x32_bf16(qf, sf, o[m], 0, 0, 0);
            }
        }
#pragma unroll
        for (int ks = 0; ks < 2; ++ks) {
            const bf16x8 vf = *(const LAS bf16x8*)(lds + HG_VT + (16 * wave + fr) * TS + (ks * 32 + fq * 8) * 2);
#pragma unroll
            for (int m = 0; m < 4; ++m) { const bf16x8 af = *(const LAS bf16x8*)(lds + HG_AM + (16 * m + fr) * TS + (ks * 32 + fq * 8) * 2);
                o[m] = __builtin_amdgcn_mfma_f32_16x16x32_bf16(af, vf, o[m], 0, 0, 0); }
        }
        }
    }
    if (!(xm & 8)) {
#pragma unroll
    for (int i = 0; i < 8; ++i) { const f32x4 dv = *(const LAS f32x4*)(lds + HG_DS + (16 * i + 4 * fq) * 4); accS[i] = accS[i] * dv; }
#pragma unroll
    for (int ks = 0; ks < 2; ++ks) {
        const bf16x8 vf = *(const LAS bf16x8*)(lds + HG_VT + (16 * wave + fr) * TS + (ks * 32 + fq * 8) * 2);
#pragma unroll
        for (int i = 0; i < 8; ++i) { const bf16x8 af = *(const LAS bf16x8*)(lds + HG_KHT + (16 * i + fr) * TS + (ks * 32 + fq * 8) * 2);
            accS[i] = __builtin_amdgcn_mfma_f32_16x16x32_bf16(af, vf, accS[i], 0, 0, 0); }
    }
    }
    if (STORE_NEXT) hg_store_raw<FULL, NEXT_GATE>(lds, nxt, tid);
}

__device__ __forceinline__ float hg_lb(const float* __restrict__ lb_logits, int dir, int col) {
    const float l0 = lb_logits[(0 * 2 + dir) * 512 + col], l1 = lb_logits[(1 * 2 + dir) * 512 + col];
    return 1.0f / (1.0f + expf(l1 - l0));
}

template <int DIR>
__device__ __forceinline__ void hg_agg_unit(LAS unsigned char* lds, const Args& a, int b, int hd, int sidx, int unit, int tid, int wave, int lane) {
    const bf16_t* __restrict__ proj = (const bf16_t*)(a.ws + WS_PROJ);
    const int rowbase = sidx == 0 ? T + b * LC : b * SEQ + (sidx - 1) * 256;
    const float lb0 = hg_lb(a.in[12], DIR, hd * 128 + 2 * lane), lb1 = hg_lb(a.in[12], DIR, hd * 128 + 2 * lane + 1);
    f32x4 accS[8], odummy[4];
#pragma unroll
    for (int i = 0; i < 8; ++i) accS[i] = (f32x4){0.f, 0.f, 0.f, 0.f};
    float dseg0 = 1.f, dseg1 = 1.f;
    HgRaw raw;
    hg_load_raw<false, false>(raw, proj, rowbase + (DIR == 0 ? 0 : 3) * 64, hd, DIR, tid);
    lds_barrier();
    hg_store_raw<false, false>(lds, raw, tid);
    lds_barrier();
#pragma unroll 1
    for (int cc = 0; cc < 3; ++cc) {
        hg_load_raw<false, false>(raw, proj, rowbase + (DIR == 0 ? cc + 1 : 2 - cc) * 64, hd, DIR, tid);
        hg_chunk<DIR, false, true, false>(lds, accS, odummy, lb0, lb1, dseg0, dseg1, raw, tid, wave, lane);
        lds_barrier();
    }
    hg_chunk<DIR, false, false, false>(lds, accS, odummy, lb0, lb1, dseg0, dseg1, raw, tid, wave, lane);
    float* K = (float*)(a.ws + WS_HGK) + (size_t)unit * 16384;
    const int fr = lane & 15, fq = lane >> 4;
#pragma unroll
    for (int i = 0; i < 8; ++i)
#pragma unroll
        for (int j = 0; j < 4; ++j) K[(16 * i + 4 * fq + j) * 128 + 16 * wave + fr] = accS[i][j];
    if (wave == 0) *(f32x2*)((float*)(a.ws + WS_HGD) + (size_t)unit * 128 + 2 * lane) = (f32x2){dseg0, dseg1};
}

__device__ __forceinline__ void hg_carry_item(const Args& a, int item, int tid, bool dry = false) {
    const int chain = item >> 3, part = item & 7, dir = chain & 1;
    float* K = (float*)(a.ws + WS_HGK) + (size_t)chain * HG_SEGS * 16384; const float* D = (const float*)(a.ws + WS_HGD) + (size_t)chain * HG_SEGS * 128;
    const int e4 = part * 512 + tid, dk = e4 >> 5;
    f32x4 kv[HG_SEGS]; float dv[HG_SEGS];
#pragma unroll
    for (int s = 0; s < HG_SEGS; ++s) { const int sidx = s == 0 ? 0 : (dir == 0 ? s : HG_SEGS - s); kv[s] = *(const f32x4*)(K + (size_t)sidx * 16384 + e4 * 4); dv[s] = D[sidx * 128 + dk]; }
    f32x4 S = (f32x4){0.f, 0.f, 0.f, 0.f};
#pragma unroll
    for (int s = 0; s < HG_SEGS; ++s) { const int sidx = s == 0 ? 0 : (dir == 0 ? s : HG_SEGS - s);
        if (dry) { const size_t o = ((size_t)(chain * HG_SEGS + sidx) * 16384 + e4 * 4) % (size_t)(32 * MiB); *(f32x4*)((float*)(a.ws + WS_MIXED) + o) = S; } else *(f32x4*)(K + (size_t)sidx * 16384 + e4 * 4) = S;
        S = S * dv[s] + kv[s]; }
}

__device__ __forceinline__ void hg_final_unit(LAS unsigned char* lds, const Args& a, int b, int hd, int seg, int tid, int wave, int lane, int xm = 0) {
    const bf16_t* __restrict__ proj = (const bf16_t*)(a.ws + WS_PROJ); bf16_t* mixed = (bf16_t*)(a.ws + WS_MIXED);
    const int rowbase = b * SEQ + seg * 256, fr = lane & 15, fq = lane >> 4;
    const float lbf0 = hg_lb(a.in[12], 0, hd * 128 + 2 * lane), lbf1 = hg_lb(a.in[12], 0, hd * 128 + 2 * lane + 1);
    const float lbb0 = hg_lb(a.in[12], 1, hd * 128 + 2 * lane), lbb1 = hg_lb(a.in[12], 1, hd * 128 + 2 * lane + 1);
    f32x4 accS[8], o[4];
    float dseg0 = 1.f, dseg1 = 1.f;
    HgRaw raw;
    f32x4* ofst = (f32x4*)(a.ws + WS_OFST) + (size_t)blockIdx.x * 8192 + wave * 256 + lane;
    hg_load_raw<true, false>(raw, proj, rowbase, hd, 0, tid);
    {
        const float* Sin = (const float*)(a.ws + WS_HGK) + (size_t)((((b * 4 + hd) * 2 + 0) * HG_SEGS) + 1 + seg) * 16384;
#pragma unroll
        for (int i = 0; i < 8; ++i)
#pragma unroll
            for (int j = 0; j < 4; ++j) accS[i][j] = Sin[(16 * i + 4 * fq + j) * 128 + 16 * wave + fr];
    }
    lds_barrier();
    hg_store_raw<true, false>(lds, raw, tid);
    lds_barrier();
#pragma unroll 1
    for (int cc = 0; cc < 3; ++cc) {
        hg_load_raw<true, false>(raw, proj, rowbase + (cc + 1) * 64, hd, 0, tid);
        hg_chunk<0, true, true, false>(lds, accS, o, lbf0, lbf1, dseg0, dseg1, raw, tid, wave, lane, xm);
#pragma unroll
        for (int m = 0; m < 4; ++m) ofst[cc * 2048 + m * 64] = o[m];
        lds_barrier();
    }
    hg_load_raw<true, false>(raw, proj, rowbase + 3 * 64, hd, 1, tid);
    hg_chunk<0, true, true, false>(lds, accS, o, lbf0, lbf1, dseg0, dseg1, raw, tid, wave, lane, xm);
#pragma unroll
    for (int m = 0; m < 4; ++m) ofst[3 * 2048 + m * 64] = o[m];
    {
        const float* Sin = (const float*)(a.ws + WS_HGK) + (size_t)((((b * 4 + hd) * 2 + 1) * HG_SEGS) + 1 + seg) * 16384;
#pragma unroll
        for (int i = 0; i < 8; ++i)
#pragma unroll
            for (int j = 0; j < 4; ++j) accS[i][j] = Sin[(16 * i + 4 * fq + j) * 128 + 16 * wave + fr];
    }
    lds_barrier();
    constexpr int OSF = 528;
    f32x4 ngv[2];
    { const float* ngp = a.in[13] + hd * 128 + (tid & 15) * 8; ngv[0] = *(const f32x4*)ngp; ngv[1] = *(const f32x4*)(ngp + 4); }
#pragma unroll 1
    for (int cc = 0; cc < 4; ++cc) {
        const int c = 3 - cc;
        f32x4 ofv[4]; u32x4 gq[2];
#pragma unroll
        for (int m = 0; m < 4; ++m) ofv[m] = ofst[c * 2048 + m * 64];
#pragma unroll
        for (int i = 0; i < 2; ++i) gq[i] = *(const u32x4*)proj_at(proj, rowbase + c * 64 + (tid >> 4) + 32 * i, 3072 + hd * 128 + (tid & 15) * 8);
        if (cc < 3) hg_load_raw<true, false>(raw, proj, rowbase + (c - 1) * 64, hd, 1, tid);
        if (cc < 3) hg_chunk<1, true, true, false>(lds, accS, o, lbb0, lbb1, dseg0, dseg1, raw, tid, wave, lane, xm);
        else hg_chunk<1, true, false, false>(lds, accS, o, lbb0, lbb1, dseg0, dseg1, raw, tid, wave, lane, xm);
        if (xm & 16) { lds_barrier(); continue; }
        lds_barrier();
#pragma unroll
        for (int m = 0; m < 4; ++m) { const f32x4 ot = o[m] + ofv[m];
#pragma unroll
            for (int j = 0; j < 4; ++j) *(LAS float*)(lds + HG_QT + (16 * m + 4 * fq + j) * OSF + (16 * wave + fr) * 4) = ot[j]; }
        lds_barrier();
#pragma unroll
        for (int i = 0; i < 2; ++i) { const int t = (tid >> 4) + 32 * i, c8 = (tid & 15) * 8;
            const f32x4 v0 = *(const LAS f32x4*)(lds + HG_QT + t * OSF + c8 * 4), v1 = *(const LAS f32x4*)(lds + HG_QT + t * OSF + c8 * 4 + 16);
            const float ss = row_allsum16((v0[0] * v0[0] + v0[1] * v0[1]) + (v0[2] * v0[2] + v0[3] * v0[3]) + (v1[0] * v1[0] + v1[1] * v1[1]) + (v1[2] * v1[2] + v1[3] * v1[3]));
            const float rinv = __builtin_amdgcn_rsqf(ss * (1.0f / 128.0f) + LN_EPS);
            const u32x4 g = gq[i];
            u32x4 w;
            w.x = cvt2(v0[0] * rinv * ngv[0][0] * bf_lo(g.x), v0[1] * rinv * ngv[0][1] * bf_hi(g.x)); w.y = cvt2(v0[2] * rinv * ngv[0][2] * bf_lo(g.y), v0[3] * rinv * ngv[0][3] * bf_hi(g.y));
            w.z = cvt2(v1[0] * rinv * ngv[1][0] * bf_lo(g.z), v1[1] * rinv * ngv[1][1] * bf_hi(g.z)); w.w = cvt2(v1[2] * rinv * ngv[1][2] * bf_lo(g.w), v1[3] * rinv * ngv[1][3] * bf_hi(g.w));
            *(u32x4*)(mixed + (size_t)(rowbase + c * 64 + t) * DM + 512 + hd * 128 + c8) = w; }
    }
}

__device__ __forceinline__ void p_scan_a(LAS unsigned char* lds, const Args& a, int bid, int G, int tid, int wave, int lane, int mask = 3, int xr = 0) {
    constexpr int N_HG = NB * 4 * 2 * HG_SEGS, N_RG = NB * RG_UNITS_PER_B;
#pragma unroll 1
    for (int it = bid; it < N_HG + N_RG; it += G) {
        int t2 = tid; asm volatile("" : "+v"(t2)); const int tid = t2, lane = t2 & 63;
        if ((it < N_HG) ? !(mask & 1) : !(mask & 2)) continue;
        if (it < N_HG) { const int sidx = it % HG_SEGS, rest = it / HG_SEGS, dir = rest & 1, hd = (rest >> 1) & 3, b = rest >> 3;
            if (dir == 0) hg_agg_unit<0>(lds, a, b, hd, sidx, it, tid, wave, lane); else hg_agg_unit<1>(lds, a, b, hd, sidx, it, tid, wave, lane); }
        else { const int r = it - N_HG; __syncthreads(); rg_agg_unit(lds, a, r / RG_UNITS_PER_B, r % RG_UNITS_PER_B, tid, wave, lane, xr); }
    }
}
__device__ __forceinline__ void p_scan_b(const Args& a, int bid, int G, int tid, bool dry = false) {
#pragma unroll 1
    for (int it = bid; it < 1024; it += G) hg_carry_item(a, it, tid, dry);
    if (bid >= G - 32) rg_carry_item(a, bid - (G - 32), tid);
}
__device__ __forceinline__ void p_scan_c(LAS unsigned char* lds, const Args& a, int bid, int G, int tid, int wave, int lane, int mask = 3, int xm = 0) {
#pragma unroll 1
    for (int it = bid; it < ((mask & 1) ? 1024 : 0); it += G) { const int seg = it & 15, hd = (it >> 4) & 3, b = it >> 6; int t2 = tid; asm volatile("" : "+v"(t2)); hg_final_unit(lds, a, b, hd, seg, t2, wave, t2 & 63, xm); }
#pragma unroll 1
    for (int r = bid; r < ((mask & 2) ? 1024 : 0); r += G) { __syncthreads(); int t2 = tid; asm volatile("" : "+v"(t2)); rg_final_unit(lds, a, r >> 6, r & 63, t2, wave, t2 & 63); }
}

#define GAS __attribute__((address_space(1)))
#define RLX_AGENT __ATOMIC_RELAXED, __HIP_MEMORY_SCOPE_AGENT
#define XB_TMO      128
#define XB_XCNT(j)  (256  + 64 * (j))
#define XB_XSUB(j)  (1280 + 64 * (j))
#define XB_XGEN(j)  (2304 + 64 * (j))
#define XB_TOP      3328
#define XB_TOPGEN   3392
#define XCD_BAR_WORDS 3456
#define XB_SPIN_CAP (1u << 18)

__device__ __forceinline__ unsigned xb_ld(unsigned* p)              { return __hip_atomic_load(p, __ATOMIC_RELAXED, __HIP_MEMORY_SCOPE_AGENT); }
__device__ __forceinline__ unsigned xb_add(unsigned* p, unsigned v) { return __hip_atomic_fetch_add(p, v, __ATOMIC_RELAXED, __HIP_MEMORY_SCOPE_AGENT); }
__device__ __forceinline__ unsigned xb_xcc_id() { return (unsigned)__builtin_amdgcn_s_getreg((3 << 11) | 20) & 0xFu; }
#define XB_SPIN(cond, bar) do { unsigned _sp = 0; while (cond) { __builtin_amdgcn_s_sleep(1); \
    if ((++_sp & 255u) == 0u) { if (xb_ld(&(bar)[XB_TMO])) break; if (_sp > XB_SPIN_CAP) { atomicAdd(&(bar)[XB_TMO], 1u); break; } } } } while (0)

struct XcdBarrier {
    unsigned* bar; unsigned x;
    volatile LAS unsigned* st;
};

__device__ __forceinline__ XcdBarrier xcd_barrier_post(unsigned* bar, volatile LAS unsigned* st) {
    XcdBarrier b; b.bar = bar; b.x = xb_xcc_id(); b.st = st;
    if (threadIdx.x == 0) (void)xb_add(&bar[XB_XCNT(b.x)], 1u);
    return b;
}
__device__ __forceinline__ void xcd_barrier_complete(unsigned* bar, unsigned x, unsigned& nloc, unsigned& nx) {
    const unsigned G = gridDim.x * gridDim.y * gridDim.z;
    unsigned sum, cnt, mine, sp = 0u;
    for (;;) {
        sum = 0u; cnt = 0u; mine = 0u;
#pragma unroll
        for (unsigned j = 0; j < 16; ++j) { const unsigned c = xb_ld(&bar[XB_XCNT(j)]); sum += c; cnt += (c > 0u) ? 1u : 0u; mine = (j == x) ? c : mine; }
        if (sum == G) break;
        __builtin_amdgcn_s_sleep(1);
        if ((++sp & 255u) == 0u) { if (xb_ld(&bar[XB_TMO])) break; if (sp > XB_SPIN_CAP) { atomicAdd(&bar[XB_TMO], 1u); break; } }
    }
    nloc = mine > 0u ? mine : 1u; nx = cnt > 0u ? cnt : 1u;
}

__device__ __forceinline__ void xcd_barrier(const XcdBarrier& b) {
    asm volatile("s_waitcnt vmcnt(0)" ::: "memory");
    __syncthreads();
    if (threadIdx.x == 0) {
        unsigned* bar = b.bar;
        __builtin_amdgcn_s_waitcnt(0);
        unsigned nloc = b.st[0], nx = b.st[1];
        if (nloc == 0u) { xcd_barrier_complete(bar, b.x, nloc, nx); b.st[0] = nloc; b.st[1] = nx; }
        const unsigned old = xb_add(&bar[XB_XSUB(b.x)], 1u);
        const unsigned gen = old / nloc;
        if (old + 1u == (gen + 1u) * nloc) {
            __builtin_amdgcn_fence(__ATOMIC_RELEASE, "agent");
            asm volatile("s_waitcnt vmcnt(0)" ::: "memory");
            const unsigned og = xb_add(&bar[XB_TOP], 1u);
            const unsigned tg = og / nx;
            if (og + 1u == (tg + 1u) * nx) xb_add(&bar[XB_TOPGEN], 1u);
            else XB_SPIN(xb_ld(&bar[XB_TOPGEN]) == tg, bar);
            __builtin_amdgcn_fence(__ATOMIC_ACQUIRE, "agent");
            xb_add(&bar[XB_XGEN(b.x)], 1u);
            asm volatile("s_waitcnt vmcnt(0)" ::: "memory");
        } else {
            XB_SPIN(xb_ld(&bar[XB_XGEN(b.x)]) == gen, bar);
            __builtin_amdgcn_fence(__ATOMIC_ACQUIRE, "agent");
            asm volatile("s_waitcnt vmcnt(0)" ::: "memory");
        }
    }
    __syncthreads();
}


__device__ __forceinline__ void stagger_wait(unsigned ticks) {
    if (ticks == 0u) return;
    const unsigned long long t0 = __builtin_amdgcn_s_memrealtime();
    while (__builtin_amdgcn_s_memrealtime() - t0 < ticks) __builtin_amdgcn_s_sleep(16);
}
#ifndef STAG_P2
#define STAG_P2 0
#endif

__global__ void __launch_bounds__(NTHREADS, 2) mega(Args a) {
    extern __shared__ __attribute__((aligned(16))) unsigned char lds_raw[];
    LAS unsigned char* lds = (LAS unsigned char*)lds_raw;
    cg::grid_group grid = cg::this_grid();
    const int wave = __builtin_amdgcn_readfirstlane(threadIdx.x >> 6), bid = blockIdx.x, G = gridDim.x;
    int tid = threadIdx.x, lane = tid & 63;
#define FRESH_TID() do { tid = threadIdx.x; asm volatile("" : "+v"(tid)); lane = tid & 63; } while (0)
    unsigned char* ws = a.ws;
    volatile LAS unsigned* bst = (volatile LAS unsigned*)(lds + LDS_BYTES - 64);
    if (threadIdx.x < 2) bst[threadIdx.x] = 0u;
    __syncthreads();
    XcdBarrier xbar = xcd_barrier_post((unsigned*)(ws + WS_BAR), bst);
#define GRID_BAR() xcd_barrier(xbar)
    float* mod = (float*)(ws + WS_MOD);
    bf16_t* U = (bf16_t*)(ws + WS_U);
    bf16_t* PROJ = (bf16_t*)(ws + WS_PROJ); bf16_t* MIXED = (bf16_t*)(ws + WS_MIXED);

#ifndef SKIP_P0
    p_mod(lds, a.in[1], a.in[3], a.in[4], a.in[5], mod, bid, G, tid);
    p_transposes(lds, a, bid, G, tid);
    p_gwt(a.in[9], (bf16_t*)(ws + WS_GWT), bid, G, tid);
    p_rgpar(a.in[10], a.in[11], (float*)(ws + WS_RGPAR), bid, G, tid);
    p_wrt(a.in[17], a.in[19], (bf16_t*)(ws + WS_WRT), bid, G, tid);
#endif
#ifdef REP_P0
    grid.sync();
    FRESH_TID();
    p_mod(lds, a.in[1], a.in[3], a.in[4], a.in[5], mod, bid, G, tid);
    p_transposes(lds, a, bid, G, tid);
    p_gwt(a.in[9], (bf16_t*)(ws + WS_GWT), bid, G, tid);
    p_rgpar(a.in[10], a.in[11], (float*)(ws + WS_RGPAR), bid, G, tid);
    p_wrt(a.in[17], a.in[19], (bf16_t*)(ws + WS_WRT), bid, G, tid);
#endif
    GRID_BAR();
    FRESH_TID();
#ifdef REP_SYNC
    for (int r = 0; r < 10; ++r) GRID_BAR();
#endif
#ifndef SKIP_P1
    p_u(a.in[0], a.in[2], mod, U, bid, G, tid);
#endif
#ifdef REP_P1
    GRID_BAR();
    FRESH_TID();
    p_u(a.in[0], a.in[2], mod, U, bid, G, tid);
#endif
    GRID_BAR();
    FRESH_TID();
#ifdef REP_P2X
    { pg8::Gemm g{U, (const bf16_t*)(ws + WS_WINT), TA, NIN, DM}; pg8::StaticOrder S; S.init(TA, NIN, G, bid);
#if REP_P2X == 1
      pg8::EpiNull E{(float*)(ws + WS_OFST)};
      pg8::gemm_phase<pg8::EpiNull, pg8::StaticOrder, true, true>(lds, g, S, E); }
#else
      pg8::EpiInProj E{PROJ, REP_P2X - 1, 0};
      pg8::gemm_phase<pg8::EpiInProj, pg8::StaticOrder, true, true>(lds, g, S, E); }
#endif
    GRID_BAR();
    FRESH_TID();
#endif
#ifndef SKIP_P2
    stagger_wait((unsigned)((bid >> 3) & 7) * STAG_P2);
    { pg8::Gemm g{U, (const bf16_t*)(ws + WS_WINT), TA, NIN, DM}; pg8::StaticOrder S; S.init(TA, NIN, G, bid);
      pg8::EpiInProj E{PROJ, 0, 0};
      pg8::gemm_phase<pg8::EpiInProj, pg8::StaticOrder, true, true>(lds, g, S, E); }
#endif
#ifdef REP_P2
    GRID_BAR();
    FRESH_TID();
    { pg8::Gemm g{U, (const bf16_t*)(ws + WS_WINT), TA, NIN, DM}; pg8::StaticOrder S; S.init(TA, NIN, G, bid);
      pg8::EpiInProj E{PROJ, 0, 0};
      pg8::gemm_phase<pg8::EpiInProj, pg8::StaticOrder, true, true>(lds, g, S, E); }
#endif
    GRID_BAR();
    FRESH_TID();
#ifdef PRE_P3A
    p_scan_a(lds, a, bid, G, tid, wave, lane, 2, PRE_P3A);
    GRID_BAR();
    FRESH_TID();
#endif
#ifndef SKIP_P3A
    p_scan_a(lds, a, bid, G, tid, wave, lane);
#endif
#ifdef REP_P3A
    GRID_BAR();
    FRESH_TID();
    p_scan_a(lds, a, bid, G, tid, wave, lane, REP_P3A);
#endif
    GRID_BAR();
    FRESH_TID();
#ifdef REP_P3B
    p_scan_b(a, bid, G, tid, true);
    GRID_BAR();
    FRESH_TID();
#endif
#ifndef SKIP_P3B
    p_scan_b(a, bid, G, tid);
#endif
    GRID_BAR();
    FRESH_TID();
#ifdef PRE_P3C
    p_scan_c(lds, a, bid, G, tid, wave, lane, 1, PRE_P3C);
    GRID_BAR();
    FRESH_TID();
#endif
#ifndef SKIP_P3C
    p_scan_c(lds, a, bid, G, tid, wave, lane);
#endif
#ifdef REP_P3C
    GRID_BAR();
    FRESH_TID();
    p_scan_c(lds, a, bid, G, tid, wave, lane, REP_P3C);
#endif
    GRID_BAR();
    FRESH_TID();
#ifndef SKIP_P5
    { pg8::Gemm g{MIXED, (const bf16_t*)(ws + WS_WOUTT), T, DM, DM}; pg8::StaticOrder S; S.init(T, DM, G, bid);
      pg8::EpiY E{(bf16_t*)(ws + WS_XG)};
      pg8::gemm_phase<pg8::EpiY, pg8::StaticOrder, true, true>(lds, g, S, E); }
#endif
#ifdef REP_P5
    GRID_BAR();
    FRESH_TID();
    { pg8::Gemm g{MIXED, (const bf16_t*)(ws + WS_WOUTT), T, DM, DM}; pg8::StaticOrder S; S.init(T, DM, G, bid);
      pg8::EpiY E{(bf16_t*)(ws + WS_XG)};
      pg8::gemm_phase<pg8::EpiY, pg8::StaticOrder, true, true>(lds, g, S, E); }
#endif
    GRID_BAR();
    FRESH_TID();
#ifdef REP_P6
#pragma unroll 1
    for (int rep = 0; rep < 2; ++rep) { p_ln1_router(lds, a, bid, G, tid, wave, lane, rep == 0, rep == 0 ? REP_P6 : 3); if (rep == 0) GRID_BAR(); }
#else
    p_ln1_router(lds, a, bid, G, tid, wave, lane);
#endif
    GRID_BAR();
    FRESH_TID();
#ifndef SKIP_P7
    p_assign(lds, a, bid, G, tid);
#endif
#ifdef REP_P7
    GRID_BAR();
    FRESH_TID();
    p_assign(lds, a, bid, G, tid);
#endif
    GRID_BAR();
    FRESH_TID();
#ifdef PRE_P8X
    { pg8::Gemm g{(const bf16_t*)(ws + WS_U), (const bf16_t*)(ws + WS_W13T), MAXROWS, NE * DM, DM}; pg8::ExpertOrderG S{(const int*)(ws + WS_RBPRE), (const int*)(ws + WS_ROWTOK), G, bid};
      pg8::EpiNull E{(float*)(ws + WS_OFST)};
      pg8::gemm_phase<pg8::EpiNull, pg8::ExpertOrderG, true, true>(lds, g, S, E); }
    GRID_BAR();
    FRESH_TID();
#endif
#ifndef SKIP_P8
    { pg8::Gemm g{(const bf16_t*)(ws + WS_U), (const bf16_t*)(ws + WS_W13T), MAXROWS, NE * DM, DM}; pg8::ExpertOrderG S{(const int*)(ws + WS_RBPRE), (const int*)(ws + WS_ROWTOK), G, bid};
      pg8::EpiExp1 E{(bf16_t*)(ws + WS_HID)};
      pg8::gemm_phase<pg8::EpiExp1, pg8::ExpertOrderG, true, true>(lds, g, S, E); }
#endif
#ifdef REP_P8
    GRID_BAR();
    FRESH_TID();
    { pg8::Gemm g{(const bf16_t*)(ws + WS_U), (const bf16_t*)(ws + WS_W13T), MAXROWS, NE * DM, DM}; pg8::ExpertOrderG S{(const int*)(ws + WS_RBPRE), (const int*)(ws + WS_ROWTOK), G, bid};
      pg8::EpiExp1 E{(bf16_t*)(ws + WS_HID)};
      pg8::gemm_phase<pg8::EpiExp1, pg8::ExpertOrderG, true, true>(lds, g, S, E); }
#endif
    GRID_BAR();
    FRESH_TID();
#ifdef PRE_P9X
    { pg8::Gemm g{(const bf16_t*)(ws + WS_HID), (const bf16_t*)(ws + WS_W2T), MAXROWS, NE * DM, DE}; pg8::ExpertOrder S{(const int*)(ws + WS_RBPRE), nullptr, G, bid};
      pg8::EpiNull E{(float*)(ws + WS_OFST)};
      pg8::gemm_phase<pg8::EpiNull, pg8::ExpertOrder, true, true>(lds, g, S, E); }
    GRID_BAR();
    FRESH_TID();
#endif
#ifndef SKIP_P9
    { pg8::Gemm g{(const bf16_t*)(ws + WS_HID), (const bf16_t*)(ws + WS_W2T), MAXROWS, NE * DM, DE}; pg8::ExpertOrder S{(const int*)(ws + WS_RBPRE), nullptr, G, bid};
      pg8::EpiY E{(bf16_t*)(ws + WS_Y)};
      pg8::gemm_phase<pg8::EpiY, pg8::ExpertOrder, true, true>(lds, g, S, E); }
#endif
#ifdef REP_P9
    GRID_BAR();
    FRESH_TID();
    { pg8::Gemm g{(const bf16_t*)(ws + WS_HID), (const bf16_t*)(ws + WS_W2T), MAXROWS, NE * DM, DE}; pg8::ExpertOrder S{(const int*)(ws + WS_RBPRE), nullptr, G, bid};
      pg8::EpiY E{(bf16_t*)(ws + WS_Y)};
      pg8::gemm_phase<pg8::EpiY, pg8::ExpertOrder, true, true>(lds, g, S, E); }
#endif
    GRID_BAR();
    FRESH_TID();
#ifdef REP_P10
    p_combine_ln2(a, bid, G, wave, lane, true);
    GRID_BAR();
    FRESH_TID();
#endif
#ifndef SKIP_P10
    p_combine_ln2(a, bid, G, wave, lane);
#endif
}

extern "C" void kernel_launch(void* const* d_in, const int* in_sizes, int n_in, void* d_out, int out_size, void* d_ws, size_t ws_size, hipStream_t stream) {
    static int grid = 0;
    if (grid == 0) {
        if (n_in != 26 || ws_size < WS_END) { fprintf(stderr, "kernel_launch: unexpected n_in %d or workspace %zu < %zu\n", n_in, ws_size, (size_t)WS_END); grid = -1; return; }
        int dev = 0, cus = 0, per_cu = 0;
        if (hipGetDevice(&dev) != hipSuccess || hipDeviceGetAttribute(&cus, hipDeviceAttributeMultiprocessorCount, dev) != hipSuccess) { grid = -1; return; }
        if (hipFuncSetAttribute((const void*)mega, hipFuncAttributeMaxDynamicSharedMemorySize, LDS_BYTES) != hipSuccess) { fprintf(stderr, "kernel_launch: hipFuncSetAttribute failed\n"); grid = -1; return; }
        if (hipOccupancyMaxActiveBlocksPerMultiprocessor(&per_cu, (const void*)mega, NTHREADS, LDS_BYTES) != hipSuccess || per_cu < 1) { fprintf(stderr, "kernel_launch: occupancy query says %d\n", per_cu); per_cu = 1; }
        (void)hipGetLastError();
        grid = cus;
        fprintf(stderr, "kernel_launch: grid %d (cus %d, per_cu %d), ws %zu\n", grid, cus, per_cu, ws_size);
    }
    if (grid < 0) return;
    (void)hipMemsetAsync(d_ws, 0, 131072, stream);
    Args a{};
    for (int i = 0; i < 26; ++i) a.in[i] = (const float*)d_in[i];
    a.out = (float*)d_out; a.ws = (unsigned char*)d_ws;
    void* params[] = {&a};
    hipError_t e = hipLaunchCooperativeKernel((const void*)mega, dim3(grid), dim3(NTHREADS), params, LDS_BYTES, stream);
    if (e != hipSuccess) fprintf(stderr, "kernel_launch: cooperative launch failed: %s (grid %d)\n", hipGetErrorString(e), grid);
}
```

```cpp
#include <hip/hip_runtime.h>
#include <hip/hip_cooperative_groups.h>
#include <cstdio>
#include <cstdint>
namespace cg = cooperative_groups;

typedef unsigned short bf16_t;
typedef short bf16x8 __attribute__((ext_vector_type(8)));
typedef float f32x4 __attribute__((ext_vector_type(4)));
typedef float f32x2 __attribute__((ext_vector_type(2)));
typedef unsigned u32x4 __attribute__((ext_vector_type(4)));
typedef unsigned u32x2 __attribute__((ext_vector_type(2)));
typedef int i32x4 __attribute__((ext_vector_type(4)));
#define LAS __attribute__((address_space(3)))

constexpr int NB = 16, SEQ = 4096, LC = 256, DM = 1024;
constexpr int T = NB * SEQ;
constexpr int TC = NB * LC;
constexpr int TA = T + TC;
constexpr int NIN = 3584;
constexpr int NE = 32, DE = 512;
constexpr int MAXROWS = 2 * T + NE * 256;
constexpr float ALPHA = 1.189207115002721f;
constexpr float LN_EPS = 1e-6f;
constexpr int NTHREADS = 512;

constexpr size_t MiB = 1u << 20;
constexpr size_t WS_CTL = 0;
constexpr size_t WS_BAR = 65536;
constexpr size_t WS_MOD = 1 * MiB;
constexpr size_t WS_EIDX = 3 * MiB;
constexpr size_t WS_EPOS = 3 * MiB + 512 * 1024;
constexpr size_t WS_EW = 4 * MiB;
constexpr size_t WS_DEST = 4 * MiB + 512 * 1024;
constexpr size_t WS_WINT = 6 * MiB;
constexpr size_t WS_WOUTT = 13 * MiB;
constexpr size_t WS_W13T = 15 * MiB;
constexpr size_t WS_W2T = 79 * MiB;
constexpr size_t WS_U = 112 * MiB;
constexpr size_t WS_PROJ = 248 * MiB;
constexpr size_t WS_XG = 248 * MiB;
constexpr size_t WS_HID = 520 * MiB;
constexpr size_t WS_Y = 656 * MiB;
constexpr size_t WS_MIXED = 724 * MiB;
constexpr size_t WS_OSUM = 852 * MiB;
constexpr size_t WS_END = 980 * MiB;
constexpr int LDS_BYTES = 163840;

__device__ __forceinline__ const bf16_t* proj_at(const bf16_t* P, int row, int col) { return P + (((size_t)(col >> 5) * TA + row) << 5) + (col & 31); }

template <class V> __device__ __forceinline__ V ntld(const V* p) { return __builtin_nontemporal_load(p); }
template <class V> __device__ __forceinline__ void ntst(V* p, V v) { __builtin_nontemporal_store(v, p); }

__device__ __forceinline__ float bf2f(bf16_t b) { return __uint_as_float(((unsigned)b) << 16); }
__device__ __forceinline__ bf16_t f2bf(float f) { unsigned u = __float_as_uint(f); return (bf16_t)((u + 0x7fffu + ((u >> 16) & 1u)) >> 16); }
__device__ __forceinline__ unsigned pk2(float lo, float hi) { unsigned r; asm volatile("v_cvt_pk_bf16_f32 %0, %1, %2" : "=v"(r) : "v"(lo), "v"(hi)); return r; }
__device__ __forceinline__ float frcp(float x) { return __builtin_amdgcn_rcpf(x); }
__device__ __forceinline__ float sigmoidf_(float x) { return frcp(1.0f + __expf(-x)); }
__device__ __forceinline__ float siluf_(float x) { return x * frcp(1.0f + __expf(-x)); }
__device__ __forceinline__ float gelu_tanh(float x) {
    const float y = 0.7978845608028654f * (x + 0.044715f * x * x * x);
    return x * frcp(1.0f + __expf(-2.0f * y));
}
__device__ __forceinline__ float softplusf_(float x) { return fmaxf(x, 0.f) + log1pf(expf(-fabsf(x))); }
__device__ __forceinline__ float wave_sum(float v) {
#pragma unroll
    for (int o = 1; o < 64; o <<= 1) v += __shfl_xor(v, o);
    return v;
}
constexpr int CSTR = 64;
__device__ __forceinline__ int pstart_of(const int* __restrict__ counts, int e) {
    int acc = 0;
    for (int i = 0; i < NE; ++i) { const int p = ((counts[i * CSTR] + 255) >> 8) << 8; if (i < e) acc += p; }
    return acc;
}

namespace pg8 {
#define PG8_LAS __attribute__((address_space(3)))
typedef unsigned short bf16_t;
typedef short bf16x8 __attribute__((ext_vector_type(8)));
typedef float f32x4 __attribute__((ext_vector_type(4)));
typedef unsigned u32x4 __attribute__((ext_vector_type(4)));
constexpr int BM = 256, BK = 64, HALF = 128, HTB = HALF * BK * 2  , STAGE_BYTES = 8 * HTB, NXCD = 8, WGM = 8;

__host__ __device__ __forceinline__ int lds_byte(int r, int c) { const int st = (r >> 4) * 2 + (c >> 5), rr = r & 15, cc = c & 31, ob = rr * 64 + cc * 2; return st * 1024 + (ob ^ (((ob >> 9) & 1) << 5)); }
__host__ __device__ __forceinline__ void stage_rc(int b, int& R, int& C) { const int st = b / 1024, sb = b % 1024, swz = sb ^ (((sb >> 9) & 1) << 5); R = (st >> 1) * 16 + swz / 64; C = (st & 1) * 32 + (swz % 64) / 2; }
__host__ __device__ __forceinline__ int perm32(int rho) { const int n = rho >> 4, i = rho & 15; return 8 * (i >> 2) + 4 * n + (i & 3); }

struct Unit { int pm, pn; };
struct Gemm { const bf16_t* A; const bf16_t* Bt; int M, N, K; };

struct StaticOrder {
    static constexpr bool GATHER = false; const int* rowtok = nullptr;
    int nM, nN, nwg, G, c;
    __host__ __device__ void init(int M, int N, int G_, int c_) { nM = M / BM; nN = N / BM; nwg = nM * nN; G = G_; c = c_; }
    __host__ __device__ bool next(int i, Unit& u) const {
        const long L = (long)i * G + c; if (L >= nwg) return false;
        int wgid = (int)L; { const int q = nwg / NXCD, r = nwg % NXCD, xcd = wgid % NXCD, off = wgid / NXCD; wgid = (xcd < r ? xcd * (q + 1) : r * (q + 1) + (xcd - r) * q) + off; }
        const int nig = WGM * nN, gid = wgid / nig, fm = gid * WGM, gsz = (nM - fm) < WGM ? (nM - fm) : WGM;
        u.pm = fm + ((wgid % nig) % gsz); u.pn = (wgid % nig) / gsz; return true;
    }
    __device__ __forceinline__ void a_ready(const Unit&) const {}
    __device__ __forceinline__ void done(const Unit&) const {}
};

__device__ __forceinline__ unsigned cvt_pk_bf16(float lo, float hi) { unsigned r; asm volatile("v_cvt_pk_bf16_f32 %0, %1, %2" : "=v"(r) : "v"(lo), "v"(hi)); return r; }

struct EpiInProj {
    static constexpr bool PERM = true, AFTER_DRAIN = false;
    bf16_t* P; int variant; int pad;
    __device__ __forceinline__ void operator()(const f32x4 (&acc)[2][2][4][2], const Unit& u, int wr, int wc, int fr_, int fq_) const {
        int fr = fr_, fq = fq_; asm volatile("" : "+v"(fr), "+v"(fq));
        const int row0 = u.pm * BM + wr * 64 + fr, col0 = u.pn * BM + wc * 32 + 8 * fq, grp = variant == 1 ? 0 : (u.pn >> 1);
#pragma unroll
        for (int ai = 0; ai < 2; ++ai)
#pragma unroll
            for (int m = 0; m < 4; ++m) { bf16_t* rowp = P + (((size_t)(8 * u.pn + wc) * TA + (row0 + ai * HALF + m * 16)) << 5) + 8 * fq;
#pragma unroll
                for (int bj = 0; bj < 2; ++bj) { f32x4 v0 = acc[ai][bj][m][0], v1 = acc[ai][bj][m][1];
                    if (grp == 1) {
#pragma unroll
                        for (int j = 0; j < 4; ++j) { v0[j] = gelu_tanh(v0[j]); v1[j] = gelu_tanh(v1[j]); } }
                    else if (grp == 2 || grp == 6) {
#pragma unroll
                        for (int j = 0; j < 4; ++j) { v0[j] = siluf_(v0[j]); v1[j] = siluf_(v1[j]); } }
                    u32x4 w; w.x = cvt_pk_bf16(v0[0], v0[1]); w.y = cvt_pk_bf16(v0[2], v0[3]); w.z = cvt_pk_bf16(v1[0], v1[1]); w.w = cvt_pk_bf16(v1[2], v1[3]);
                    if (variant == 3) { const int wv = __builtin_amdgcn_readfirstlane(threadIdx.x >> 6); *(u32x4*)(P + ((size_t)((u.pm * 14 + u.pn) * 8 + wv) * 16 + (ai * 4 + m) * 2 + bj) * 512 + (threadIdx.x & 63) * 8) = w; }
                    else if (variant != 2 || w.x == 0x12345678u) *(u32x4*)(rowp + (size_t)bj * 4 * TA * 32) = w; } }
    }
};
struct EpiNull {
    static constexpr bool PERM = true, AFTER_DRAIN = false;
    float* sink;
    __device__ __forceinline__ void operator()(const f32x4 (&acc)[2][2][4][2], const Unit& u, int wr, int wc, int fr_, int fq_) const {
        float s = 0.f;
#pragma unroll
        for (int ai = 0; ai < 2; ++ai)
#pragma unroll
            for (int bj = 0; bj < 2; ++bj)
#pragma unroll
                for (int m = 0; m < 4; ++m)
#pragma unroll
                    for (int n = 0; n < 2; ++n) s += acc[ai][bj][m][n][0] + acc[ai][bj][m][n][1] + acc[ai][bj][m][n][2] + acc[ai][bj][m][n][3];
        if (s == 123.456f) sink[0] = s;
    }
};
struct EpiF32 {
    static constexpr bool PERM = false, AFTER_DRAIN = false;
    float* C; int ldc; int pad;
    __device__ __forceinline__ void operator()(const f32x4 (&acc)[2][2][4][2], const Unit& u, int wr, int wc, int fr_, int fq_) const {
        int fr = fr_, fq = fq_; asm volatile("" : "+v"(fr), "+v"(fq));
        const int row0 = u.pm * BM + wr * 64 + fr, col0 = u.pn * BM + wc * 32 + 4 * fq;
#pragma unroll
        for (int ai = 0; ai < 2; ++ai)
#pragma unroll
            for (int m = 0; m < 4; ++m) { float* rowp = C + (size_t)(row0 + ai * HALF + m * 16) * ldc + col0;
#pragma unroll
                for (int bj = 0; bj < 2; ++bj)
#pragma unroll
                    for (int n = 0; n < 2; ++n) *(f32x4*)(rowp + bj * HALF + n * 16) = acc[ai][bj][m][n]; }
    }
};
struct EpiExp1 {
    static constexpr bool PERM = true, AFTER_DRAIN = false;
    bf16_t* H;
    __device__ __forceinline__ void operator()(const f32x4 (&acc)[2][2][4][2], const Unit& u, int wr, int wc, int fr_, int fq_) const {
        int fr = fr_, fq = fq_; asm volatile("" : "+v"(fr), "+v"(fq));
        const int row0 = u.pm * BM + wr * 64 + fr, hc0 = (u.pn & 3) * 128 + wc * 32 + 8 * fq;
#pragma unroll
        for (int ai = 0; ai < 2; ++ai)
#pragma unroll
            for (int m = 0; m < 4; ++m) { bf16_t* rowp = H + (size_t)(row0 + ai * HALF + m * 16) * DE + hc0;
                const f32x4 a0 = acc[ai][0][m][0], a1 = acc[ai][0][m][1], b0 = acc[ai][1][m][0], b1 = acc[ai][1][m][1];
                u32x4 w; w.x = cvt_pk_bf16(siluf_(a0[0]) * b0[0], siluf_(a0[1]) * b0[1]); w.y = cvt_pk_bf16(siluf_(a0[2]) * b0[2], siluf_(a0[3]) * b0[3]);
                w.z = cvt_pk_bf16(siluf_(a1[0]) * b1[0], siluf_(a1[1]) * b1[1]); w.w = cvt_pk_bf16(siluf_(a1[2]) * b1[2], siluf_(a1[3]) * b1[3]);
                *(u32x4*)rowp = w; }
    }
};
struct EpiY {
    static constexpr bool PERM = true, AFTER_DRAIN = false;
    bf16_t* Y;
    __device__ __forceinline__ void operator()(const f32x4 (&acc)[2][2][4][2], const Unit& u, int wr, int wc, int fr_, int fq_) const {
        int fr = fr_, fq = fq_; asm volatile("" : "+v"(fr), "+v"(fq));
        const int row0 = u.pm * BM + wr * 64 + fr, col0 = (u.pn & 3) * BM + wc * 32 + 8 * fq;
#pragma unroll
        for (int ai = 0; ai < 2; ++ai)
#pragma unroll
            for (int m = 0; m < 4; ++m) { bf16_t* rowp = Y + (size_t)(row0 + ai * HALF + m * 16) * DM + col0;
#pragma unroll
                for (int bj = 0; bj < 2; ++bj) { const f32x4 v0 = acc[ai][bj][m][0], v1 = acc[ai][bj][m][1];
                    u32x4 w; w.x = cvt_pk_bf16(v0[0], v0[1]); w.y = cvt_pk_bf16(v0[2], v0[3]); w.z = cvt_pk_bf16(v1[0], v1[1]); w.w = cvt_pk_bf16(v1[2], v1[3]);
                    *(u32x4*)(rowp + bj * HALF) = w; } }
    }
};
struct InProjOrder {
    static constexpr bool GATHER = false; const int* rowtok = nullptr;
    StaticOrder lat; int G, c;
    __device__ __forceinline__ void init(int G_, int c_) { lat.init(T, NIN, G_, c_); G = G_; c = c_; }
    __device__ __forceinline__ bool next(int i, Unit& u) const {
        const int L = i * G + c;
        if (L < lat.nwg) return lat.next(i, u);
        const int r = L - lat.nwg; if (r >= 16 * 8) return false;
        const int ct = r & 7; u.pm = 256 + (r >> 3); u.pn = ct < 2 ? ct : (ct < 6 ? ct + 4 : ct + 4);
        return true;
    }
    __device__ __forceinline__ void a_ready(const Unit&) const {}
    __device__ __forceinline__ void done(const Unit&) const {}
};
template <bool GATHER_>
struct ExpertOrderT {
    static constexpr bool GATHER = GATHER_;
    const int* rbpre; const int* rowtok; int G, c;
    __device__ __forceinline__ bool next(int i, Unit& u) const {
        const int cs = (G & 7) == 0 ? (c & 7) * (G >> 3) + (c >> 3) : c;
        const int L = i * G + cs, rb = L >> 2; int ef = -1;
        for (int e = 0; e < NE; ++e) { if (rb >= rbpre[e] && rb < rbpre[e + 1]) ef = e; }
        if (ef < 0) return false;
        u.pm = rb; u.pn = ef * 4 + (L & 3); return true;
    }
    __device__ __forceinline__ void a_ready(const Unit&) const {}
    __device__ __forceinline__ void done(const Unit&) const {}
};
typedef ExpertOrderT<false> ExpertOrder;
typedef ExpertOrderT<true> ExpertOrderG;

template <class Epi, class Sched, bool ALIGN_EPI = false, bool SP2 = false>
__device__ __forceinline__ void gemm_phase(PG8_LAS unsigned char* lds, const Gemm g, const Sched& S, const Epi& E) {
    int tid_o = threadIdx.x; asm volatile("" : "+v"(tid_o));
    const int tid = tid_o, wid = __builtin_amdgcn_readfirstlane(tid >> 6), lane = tid & 63, wr = wid >> 2, wc = wid & 3, fr = lane & 15, fq = lane >> 4;
    static_assert(SP2 || !Sched::GATHER, "the gathered A operand is wired into the SP2 loop only");
    const int K = g.K, nt = K / BK;
    unsigned voffA[2], voffB[2];
    unsigned gAc[2][2], gAn[2][2]; int gR[2], gC[2];
#pragma unroll
    for (int i = 0; i < 2; ++i) { int R, C; stage_rc(tid * 16 + i * 8192, R, C); const int Rb = Epi::PERM ? ((R & ~31) + perm32(R & 31)) : R;
        voffA[i] = (unsigned)(R * K + C) * 2u; voffB[i] = (unsigned)(Rb * K + C) * 2u; gR[i] = R; gC[i] = C; }
    const size_t kstep = (size_t)(BK * 2);
    const size_t hstep = (size_t)HALF * K * 2;
    const size_t tstep = 2 * hstep;
    const unsigned ldsw = (unsigned)wid * 1024u;
    const int aoff = lds_byte(wr * 64 + fr, fq * 8), boff = lds_byte(wc * 32 + fr, fq * 8);
#define PG8_SA(b, h) (((b) * 2 + (h)) * HTB)
#define PG8_SB(b, h) ((4 + (b) * 2 + (h)) * HTB)
#define PG8_STAGE(bufoff, gbase, voff) do { _Pragma("unroll") for (int _i = 0; _i < 2; ++_i) \
        __builtin_amdgcn_global_load_lds((const unsigned*)((const char*)(gbase) + (voff)[_i]), (PG8_LAS unsigned*)(lds + (bufoff) + ldsw + _i * 8192), 16, 0, 0); } while (0)
#define PG8_STAGE_A(bufoff, ptr, h, goff) do { if constexpr (Sched::GATHER) { PG8_STAGE(bufoff, ptr, (goff)[h]); } else { PG8_STAGE(bufoff, (ptr) + (h) * hstep, voffA); } } while (0)
#define PG8_GLOAD(dst, u) do { _Pragma("unroll") for (int _h = 0; _h < 2; ++_h) _Pragma("unroll") for (int _i = 0; _i < 2; ++_i) \
        dst[_h][_i] = (unsigned)S.rowtok[(u).pm * BM + _h * HALF + gR[_i]] * (unsigned)(K * 2) + (unsigned)(gC[_i] * 2); } while (0)
#define PG8_LDA(dst, b, h) do { _Pragma("unroll") for (int m = 0; m < 4; ++m) _Pragma("unroll") for (int k = 0; k < 2; ++k) dst[m][k] = *(const PG8_LAS bf16x8*)(lds + PG8_SA(b, h) + aoff + m * 2048 + k * 1024); } while (0)
#define PG8_LDB(dst, b, h) do { _Pragma("unroll") for (int n = 0; n < 2; ++n) _Pragma("unroll") for (int k = 0; k < 2; ++k) dst[n][k] = *(const PG8_LAS bf16x8*)(lds + PG8_SB(b, h) + boff + n * 2048 + k * 1024); } while (0)
#define PG8_MMA(ai, bj, At, Bt) do { __builtin_amdgcn_s_setprio(1); _Pragma("unroll") for (int m = 0; m < 4; ++m) _Pragma("unroll") for (int n = 0; n < 2; ++n) _Pragma("unroll") for (int k = 0; k < 2; ++k) \
        acc[ai][bj][m][n] = __builtin_amdgcn_mfma_f32_16x16x32_bf16(Bt[n][k], At[m][k], acc[ai][bj][m][n], 0, 0, 0); __builtin_amdgcn_s_setprio(0); } while (0)
#define PG8_WAIT_V(n) asm volatile("s_waitcnt vmcnt(" #n ")" ::: "memory")
#define PG8_WAIT_L(n) asm volatile("s_waitcnt lgkmcnt(" #n ")" ::: "memory")
#define PG8_BAR __builtin_amdgcn_s_barrier()
#define PG8_SCHED __builtin_amdgcn_sched_barrier(0)
    Unit cur, nxt; int ui = 0;
    if (!S.next(0, cur)) return;
    f32x4 acc[2][2][4][2];
#pragma unroll
    for (int a = 0; a < 2; ++a)
#pragma unroll
        for (int b = 0; b < 2; ++b)
#pragma unroll
            for (int m = 0; m < 4; ++m)
#pragma unroll
                for (int n = 0; n < 2; ++n) acc[a][b][m][n] = (f32x4){0.f, 0.f, 0.f, 0.f};
    bf16x8 At[4][2], B0[2][2], B1[2][2];
    const char* cA = (const char*)g.A + (Sched::GATHER ? (size_t)0 : (size_t)cur.pm * tstep); const char* cB = (const char*)g.Bt + (size_t)cur.pn * tstep;
    if constexpr (Sched::GATHER) { PG8_GLOAD(gAc, cur); }
    S.a_ready(cur);
    if constexpr (SP2) {
        PG8_STAGE(PG8_SB(0, 0), cB, voffB); PG8_STAGE(PG8_SB(0, 1), cB + hstep, voffB); PG8_STAGE_A(PG8_SA(0, 0), cA, 0, gAc); PG8_STAGE_A(PG8_SA(0, 1), cA, 1, gAc);
        if (wr == 1) PG8_BAR;
        PG8_WAIT_V(2); PG8_BAR;
        PG8_STAGE(PG8_SB(1, 0), cB + kstep, voffB); PG8_STAGE_A(PG8_SA(1, 0), cA + kstep, 0, gAc); PG8_STAGE(PG8_SB(1, 1), cB + hstep + kstep, voffB);
        PG8_WAIT_V(6); PG8_BAR;
    } else {
        PG8_STAGE(PG8_SB(0, 0), cB, voffB); PG8_STAGE(PG8_SA(0, 0), cA, voffA); PG8_STAGE(PG8_SB(0, 1), cB + hstep, voffB); PG8_STAGE(PG8_SA(0, 1), cA + hstep, voffA);
        if (wr == 1) PG8_BAR;
        PG8_WAIT_V(4); PG8_BAR;
        PG8_STAGE(PG8_SB(1, 0), cB + kstep, voffB); PG8_STAGE(PG8_SA(1, 0), cA + kstep, voffA); PG8_STAGE(PG8_SB(1, 1), cB + hstep + kstep, voffB);
        PG8_WAIT_V(6); PG8_BAR;
    }
    for (;;) {
        const bool has_next = S.next(ui + 1, nxt);
        const char* nA = (has_next && !Sched::GATHER) ? (const char*)g.A + (size_t)nxt.pm * tstep : cA;
        if constexpr (Sched::GATHER) { if (has_next) { PG8_GLOAD(gAn, nxt); } else { _Pragma("unroll") for (int _h = 0; _h < 2; ++_h) _Pragma("unroll") for (int _i = 0; _i < 2; ++_i) gAn[_h][_i] = gAc[_h][_i]; } }
        const char* nB = has_next ? (const char*)g.Bt + (size_t)nxt.pn * tstep : cB;
        for (int t = 0; t < nt; t += 2) {
            const bool last = (t == nt - 2);
            const char* a1 = cA + (size_t)(t + 1) * kstep;
            const char* a2 = last ? nA : cA + (size_t)(t + 2) * kstep; const char* b2 = last ? nB : cB + (size_t)(t + 2) * kstep;
            const char* a3 = a2 + kstep; const char* b3 = b2 + kstep;
            if (last && has_next) S.a_ready(nxt);
            unsigned g2[2][2];
            if constexpr (Sched::GATHER) { _Pragma("unroll") for (int _h = 0; _h < 2; ++_h) _Pragma("unroll") for (int _i = 0; _i < 2; ++_i) g2[_h][_i] = last ? gAn[_h][_i] : gAc[_h][_i]; }
            if constexpr (SP2) {
            PG8_LDB(B0, 0, 0); PG8_LDB(B1, 0, 1); PG8_SCHED; PG8_LDA(At, 0, 0); PG8_STAGE_A(PG8_SA(1, 1), a1, 1, gAc);
            PG8_WAIT_V(8); PG8_WAIT_L(0); PG8_BAR; PG8_MMA(0, 0, At, B0); PG8_MMA(0, 1, At, B1); PG8_BAR; PG8_SCHED;
            PG8_LDA(At, 0, 1); PG8_STAGE(PG8_SB(0, 0), b2, voffB); PG8_STAGE(PG8_SB(0, 1), b2 + hstep, voffB); PG8_STAGE_A(PG8_SA(0, 0), a2, 0, g2);
            PG8_WAIT_V(8); PG8_WAIT_L(0); PG8_BAR; PG8_MMA(1, 0, At, B0); PG8_MMA(1, 1, At, B1); PG8_BAR; PG8_SCHED;
            PG8_LDB(B0, 1, 0); PG8_LDB(B1, 1, 1); PG8_SCHED; PG8_LDA(At, 1, 0); PG8_STAGE_A(PG8_SA(0, 1), a2, 1, g2);
            PG8_WAIT_V(8); PG8_WAIT_L(0); PG8_BAR; PG8_MMA(0, 0, At, B0); PG8_MMA(0, 1, At, B1); PG8_BAR; PG8_SCHED;
            PG8_LDA(At, 1, 1); PG8_STAGE(PG8_SB(1, 0), b3, voffB); PG8_STAGE(PG8_SB(1, 1), b3 + hstep, voffB); PG8_STAGE_A(PG8_SA(1, 0), a3, 0, g2);
            PG8_WAIT_V(8); PG8_WAIT_L(0); PG8_BAR; PG8_MMA(1, 0, At, B0); PG8_MMA(1, 1, At, B1); PG8_BAR; PG8_SCHED;
            } else {
            PG8_LDB(B0, 0, 0); PG8_SCHED; PG8_LDA(At, 0, 0); PG8_STAGE(PG8_SA(1, 1), a1 + hstep, voffA);
            PG8_WAIT_L(8); PG8_BAR; PG8_WAIT_L(0); PG8_MMA(0, 0, At, B0); PG8_BAR; PG8_SCHED;
            PG8_LDB(B1, 0, 1); PG8_STAGE(PG8_SB(0, 0), b2, voffB);
            PG8_BAR; PG8_WAIT_L(0); PG8_MMA(0, 1, At, B1); PG8_BAR;
            PG8_LDA(At, 0, 1); PG8_STAGE(PG8_SA(0, 0), a2, voffA);
            PG8_BAR; PG8_WAIT_L(0); PG8_MMA(1, 0, At, B0); PG8_BAR; PG8_SCHED;
            PG8_STAGE(PG8_SB(0, 1), b2 + hstep, voffB);
            PG8_WAIT_V(6); PG8_BAR; PG8_MMA(1, 1, At, B1); PG8_BAR;
            PG8_LDB(B0, 1, 0); PG8_SCHED; PG8_LDA(At, 1, 0); PG8_STAGE(PG8_SA(0, 1), a2 + hstep, voffA);
            PG8_WAIT_L(8); PG8_BAR; PG8_WAIT_L(0); PG8_MMA(0, 0, At, B0); PG8_BAR; PG8_SCHED;
            PG8_LDB(B1, 1, 1); PG8_STAGE(PG8_SB(1, 0), b3, voffB);
            PG8_BAR; PG8_WAIT_L(0); PG8_MMA(0, 1, At, B1); PG8_BAR;
            PG8_LDA(At, 1, 1); PG8_STAGE(PG8_SA(1, 0), a3, voffA);
            PG8_BAR; PG8_WAIT_L(0); PG8_MMA(1, 0, At, B0); PG8_BAR; PG8_SCHED;
            PG8_STAGE(PG8_SB(1, 1), b3 + hstep, voffB);
            PG8_WAIT_V(6); PG8_BAR; PG8_MMA(1, 1, At, B1); PG8_BAR;
            }
        }
        if constexpr (ALIGN_EPI) { if (wr == 0) PG8_BAR; }
        if constexpr (!Epi::AFTER_DRAIN) { E(acc, cur, wr, wc, fr, fq); S.done(cur); }
        if (!has_next) break;
#pragma unroll
        for (int a = 0; a < 2; ++a)
#pragma unroll
            for (int b = 0; b < 2; ++b)
#pragma unroll
                for (int m = 0; m < 4; ++m)
#pragma unroll
                    for (int n = 0; n < 2; ++n) acc[a][b][m][n] = (f32x4){0.f, 0.f, 0.f, 0.f};
        cur = nxt; cA = nA; cB = nB; ++ui;
        if constexpr (Sched::GATHER) { _Pragma("unroll") for (int _h = 0; _h < 2; ++_h) _Pragma("unroll") for (int _i = 0; _i < 2; ++_i) gAc[_h][_i] = gAn[_h][_i]; }
        if constexpr (ALIGN_EPI) { if (wr == 1) PG8_BAR; }
    }
    PG8_WAIT_V(0);
    if constexpr (!ALIGN_EPI) { if (wr == 0) PG8_BAR; }
    PG8_BAR;
    if constexpr (Epi::AFTER_DRAIN) { E.fused(acc, cur, wr, wc, fr, fq, lds, wid, lane); S.done(cur); }
#undef PG8_SA
#undef PG8_SB
#undef PG8_STAGE
#undef PG8_STAGE_A
#undef PG8_GLOAD
#undef PG8_LDA
#undef PG8_LDB
#undef PG8_MMA
#undef PG8_WAIT_V
#undef PG8_WAIT_L
#undef PG8_BAR
#undef PG8_SCHED
}
}

struct Args { const float* in[26]; float* out; unsigned char* ws; };

__device__ __forceinline__ void p_mod(LAS unsigned char* lds, const float* __restrict__ c, const float* __restrict__ c_ctx, const float* __restrict__ ada_w,
                                      const float* __restrict__ ada_b, float* __restrict__ mod, int bid, int G, int tid) {
    if (bid >= 96) return;
    LAS float* s = (LAS float*)lds;
    LAS float* red = s + 17 * 1024;
    for (int i = tid; i < 17 * 1024; i += NTHREADS) { const int r = i >> 10, k = i & 1023; const float v = r < NB ? c[r * DM + k] : c_ctx[k]; s[i] = v / (1.0f + expf(-v)); }
    __syncthreads();
    for (int it = bid; it < 96; it += G) {
        const int cc = tid & 63, kg = tid >> 6, col = it * 64 + cc;
        float acc[17];
#pragma unroll
        for (int r = 0; r < 17; ++r) acc[r] = 0.f;
        for (int k = kg * 128; k < kg * 128 + 128; ++k) {
            const float w = ntld(ada_w + (size_t)k * 6144 + col);
#pragma unroll
            for (int r = 0; r < 17; ++r) acc[r] += s[r * 1024 + k] * w;
        }
#pragma unroll
        for (int r = 0; r < 17; ++r) red[(kg * 17 + r) * 64 + cc] = acc[r];
        __syncthreads();
        for (int i = tid; i < 17 * 64; i += NTHREADS) {
            const int r = i >> 6, c2 = i & 63; float sum = 0.f;
#pragma unroll
            for (int g = 0; g < 8; ++g) sum += red[(g * 17 + r) * 64 + c2];
            mod[(size_t)r * 6144 + it * 64 + c2] = sum + ada_b[it * 64 + c2];
        }
        __syncthreads();
    }
}

struct TrTile { const float* W; bf16_t* O; int K, N, mode, k0, n0; };
__device__ __forceinline__ TrTile tr_decode(const Args& a, int r) {
    unsigned char* ws = a.ws;
    constexpr int I_IN = 16 * 56, I_OUT = 16 * 16, I_E = 32 * 128;
    TrTile t;
    if (r < I_IN) { t = TrTile{a.in[6], (bf16_t*)(ws + WS_WINT), DM, NIN, 0, (r & 15) * 64, (r >> 4) * 64}; return t; } r -= I_IN;
    if (r < I_OUT) { t = TrTile{a.in[14], (bf16_t*)(ws + WS_WOUTT), DM, DM, 0, (r & 15) * 64, (r >> 4) * 64}; return t; } r -= I_OUT;
    if (r < I_E) { const int e = r >> 7, q = r & 127; t = TrTile{a.in[21] + (size_t)e * DM * DE, (bf16_t*)(ws + WS_W13T) + (size_t)e * DM * DM, DM, DE, 1, (q & 15) * 64, (q >> 4) * 64}; return t; } r -= I_E;
    if (r < I_E) { const int e = r >> 7, q = r & 127; t = TrTile{a.in[22] + (size_t)e * DM * DE, (bf16_t*)(ws + WS_W13T) + (size_t)e * DM * DM, DM, DE, 2, (q & 15) * 64, (q >> 4) * 64}; return t; } r -= I_E;
    { const int e = r >> 7, q = r & 127; t = TrTile{a.in[23] + (size_t)e * DE * DM, (bf16_t*)(ws + WS_W2T) + (size_t)e * DM * DE, DE, DM, 0, (q & 7) * 64, (q >> 3) * 64}; return t; }
}
__device__ __forceinline__ void p_transposes(LAS unsigned char* lds, const Args& a, int bid, int G, int tid) {
    constexpr int NITEMS = (16 * 56 + 16 * 16 + 3 * 32 * 128) / 4;
    const int lrow = tid >> 4, lc4 = (tid & 15) * 4;
    const int sc = tid & 7, sn = tid >> 3;
    for (int it = bid; it < NITEMS; it += G) {
        f32x4 v[4][2]; TrTile t[4];
#pragma unroll
        for (int q = 0; q < 4; ++q) { t[q] = tr_decode(a, it * 4 + q);
#pragma unroll
            for (int h = 0; h < 2; ++h) v[q][h] = ntld((const f32x4*)(t[q].W + (size_t)(t[q].k0 + lrow + 32 * h) * t[q].N + t[q].n0 + lc4)); }
        __syncthreads();
#pragma unroll
        for (int q = 0; q < 4; ++q) { LAS float* tile = (LAS float*)lds + q * (64 * 65);
#pragma unroll
            for (int h = 0; h < 2; ++h)
#pragma unroll
                for (int j = 0; j < 4; ++j) tile[(lrow + 32 * h) * 65 + lc4 + j] = v[q][h][j]; }
        __syncthreads();
#pragma unroll
        for (int q = 0; q < 4; ++q) { const LAS float* tile = (const LAS float*)lds + q * (64 * 65) + (8 * sc) * 65 + sn;
            const int n = t[q].n0 + sn, mode = t[q].mode;
            const int orow = mode == 0 ? n : ((n >> 7) * 256 + (mode == 2 ? 128 : 0) + (n & 127));
            u32x4 w; w.x = pk2(tile[0 * 65], tile[1 * 65]); w.y = pk2(tile[2 * 65], tile[3 * 65]); w.z = pk2(tile[4 * 65], tile[5 * 65]); w.w = pk2(tile[6 * 65], tile[7 * 65]);
            *(u32x4*)(t[q].O + (size_t)orow * t[q].K + t[q].k0 + 8 * sc) = w; }
    }
    __syncthreads();
}

__device__ __forceinline__ void p_u(const float* __restrict__ x, const float* __restrict__ ctx, const float* __restrict__ mod, bf16_t* __restrict__ U, int bid, int G, int tid) {
    const int lane = tid & 63, wave = tid >> 6;
    f32x4 vn[2][4];
    int row0 = bid * 16;
#pragma unroll
    for (int q = 0; q < 2; ++q) { const int row = row0 + wave * 2 + q; const float* src = row < T ? x + (size_t)row * DM : ctx + (size_t)(row - T) * DM;
#pragma unroll
        for (int j = 0; j < 4; ++j) vn[q][j] = ntld((const f32x4*)(src + 4 * lane + 256 * j)); }
#pragma unroll 1
    for (; row0 < TA; row0 += G * 16) {
        f32x4 v[2][4];
#pragma unroll
        for (int q = 0; q < 2; ++q)
#pragma unroll
            for (int j = 0; j < 4; ++j) v[q][j] = vn[q][j];
        if (row0 + G * 16 < TA) {
#pragma unroll
            for (int q = 0; q < 2; ++q) { const int row = row0 + G * 16 + wave * 2 + q; const float* src = row < T ? x + (size_t)row * DM : ctx + (size_t)(row - T) * DM;
#pragma unroll
                for (int j = 0; j < 4; ++j) vn[q][j] = ntld((const f32x4*)(src + 4 * lane + 256 * j)); }
        }
#pragma unroll
        for (int q = 0; q < 2; ++q) { const int row = row0 + wave * 2 + q; const float* m = mod + (size_t)(row < T ? row / SEQ : 16) * 6144;
#pragma unroll
            for (int j = 0; j < 4; ++j) { const int c4 = 4 * lane + 256 * j;
                const f32x4 sh = *(const f32x4*)(m + c4), sc = *(const f32x4*)(m + 1024 + c4);
                const f32x4 u = v[q][j] * (1.0f + sc) + sh;
                u32x2 w; w.x = pk2(u[0], u[1]); w.y = pk2(u[2], u[3]);
                *(u32x2*)(U + (size_t)row * DM + c4) = w; } }
    }
}

constexpr size_t WS_H1 = WS_XG + 128 * MiB;
constexpr size_t WS_WRT = 878 * MiB;
__device__ __forceinline__ void p_wrt(const float* __restrict__ rgw, const float* __restrict__ rew, bf16_t* __restrict__ wrt, int bid, int G, int tid) {
    for (int o = bid * NTHREADS + tid; o < 48 * 1024; o += G * NTHREADS) { const int e = o >> 10, k = o & 1023;
        const float w = e < 4 ? rgw[k * 4 + e] : (e < 36 ? rew[k * 32 + (e - 4)] : 0.f);
        const bf16_t hi = f2bf(w); wrt[o] = hi; wrt[48 * 1024 + o] = f2bf(w - bf2f(hi)); }
}
__device__ __forceinline__ void p_ln1_router(LAS unsigned char* lds, const Args& a, int bid, int G, int tid, int wave, int lane, bool dry = false, int parts = 3) {
    const float* __restrict__ x = a.in[0]; const bf16_t* yb = (const bf16_t*)(a.ws + WS_XG); bf16_t* h1o = (bf16_t*)(a.ws + (dry ? WS_HID : WS_H1)); const float* mod = (const float*)(a.ws + WS_MOD);
    const float* __restrict__ ln_g = a.in[15]; const float* __restrict__ ln_b = a.in[16]; const float* __restrict__ rgb = a.in[18]; const float* __restrict__ reb = a.in[20];
    bf16_t* U2 = (bf16_t*)(a.ws + (dry ? WS_Y + 16 * MiB : WS_U)); int* counts = (int*)(a.ws + WS_CTL) + (dry ? 32 * CSTR : 0);
    int2* eidx = (int2*)(a.ws + (dry ? WS_Y : WS_EIDX)); int2* epos = (int2*)(a.ws + (dry ? WS_Y + 4 * MiB : WS_EPOS)); float2* ew = (float2*)(a.ws + (dry ? WS_Y + 8 * MiB : WS_EW));
    const bf16_t* __restrict__ wrt = (const bf16_t*)(a.ws + WS_WRT);
    constexpr int WB_STRIDE = 528;
    LAS unsigned char* WB = lds;
    LAS float* LG = (LAS float*)(lds + 51200);
    LAS int* lcnt = (LAS int*)(lds + 102400);
    LAS int* lbase = lcnt + 32;
    LAS i32x4* tinfo = (LAS i32x4*)(lbase + 32);
    LAS f32x2* tw = (LAS f32x2*)(tinfo + 256);
    if (tid < 32) lcnt[tid] = 0;
    for (int blk = bid; blk < T / 256; blk += G) {
        const int tokb = blk * 256;
        const float* m = mod + (size_t)(tokb / SEQ) * 6144;
        if (parts & 1) {
            f32x4 xr[2][4]; u32x2 yr[2][4];
            f32x4 g1v[4], lgv[4], lbv[4], sc2v[4], sh2v[4];
#pragma unroll
            for (int j = 0; j < 4; ++j) { const int c4 = 4 * lane + 256 * j;
                g1v[j] = *(const f32x4*)(m + 2048 + c4); lgv[j] = *(const f32x4*)(ln_g + c4); lbv[j] = *(const f32x4*)(ln_b + c4); sc2v[j] = 1.0f + *(const f32x4*)(m + 4096 + c4); sh2v[j] = *(const f32x4*)(m + 3072 + c4); }
#pragma unroll
            for (int t = 0; t < 2; ++t)
#pragma unroll
                for (int j = 0; j < 4; ++j) { const int c4 = 4 * lane + 256 * j; const int tok = tokb + wave * 32 + t;
                    xr[t][j] = ntld((const f32x4*)(x + (size_t)tok * DM + c4)); yr[t][j] = ntld((const u32x2*)(yb + (size_t)tok * DM + c4)); }
#pragma unroll 1
            for (int it = 0; it < 16; ++it) {
                int l2 = lane; asm volatile("" : "+v"(l2)); const int lane = l2;
                const int tok0 = tokb + wave * 32 + 2 * it;
                f32x4 v[2][4]; float s[2] = {0.f, 0.f};
#pragma unroll
                for (int t = 0; t < 2; ++t)
#pragma unroll
                    for (int j = 0; j < 4; ++j) { const int c4 = 4 * lane + 256 * j;
                        const f32x4 g1 = g1v[j]; const u32x2 yw = yr[t][j];
                        const f32x4 yv = (f32x4){__uint_as_float(yw.x << 16), __uint_as_float(yw.x & 0xffff0000u), __uint_as_float(yw.y << 16), __uint_as_float(yw.y & 0xffff0000u)};
                        v[t][j] = ALPHA * xr[t][j] + g1 * yv; s[t] += (v[t][j][0] + v[t][j][1]) + (v[t][j][2] + v[t][j][3]); }
                if (it < 15) {
#pragma unroll
                    for (int t = 0; t < 2; ++t)
#pragma unroll
                        for (int j = 0; j < 4; ++j) { const int c4 = 4 * lane + 256 * j; const int tok = tok0 + 2 + t;
                            xr[t][j] = ntld((const f32x4*)(x + (size_t)tok * DM + c4)); yr[t][j] = ntld((const u32x2*)(yb + (size_t)tok * DM + c4)); }
                }
                float rstd[2];
#pragma unroll
                for (int t = 0; t < 2; ++t) { const float mean = wave_sum(s[t]) * (1.0f / DM); float s2 = 0.f;
#pragma unroll
                    for (int j = 0; j < 4; ++j) { v[t][j] = v[t][j] - mean; s2 += (v[t][j][0] * v[t][j][0] + v[t][j][1] * v[t][j][1]) + (v[t][j][2] * v[t][j][2] + v[t][j][3] * v[t][j][3]); }
                    rstd[t] = rsqrtf(wave_sum(s2) * (1.0f / DM) + LN_EPS); }
#pragma unroll
                for (int j = 0; j < 4; ++j) { const int c4 = 4 * lane + 256 * j;
                    const f32x4 lg = lgv[j], lb = lbv[j], sc2p = sc2v[j], sh2 = sh2v[j];
#pragma unroll
                    for (int t = 0; t < 2; ++t) { const f32x4 h1 = v[t][j] * rstd[t] * lg + lb;
                        u32x2 hw; hw.x = pk2(h1[0], h1[1]); hw.y = pk2(h1[2], h1[3]);
                        ntst((u32x2*)(h1o + (size_t)(tok0 + t) * DM + c4), hw);
                        const f32x4 u2 = h1 * sc2p + sh2;
                        u32x2 w; w.x = pk2(u2[0], u2[1]); w.y = pk2(u2[2], u2[3]);
                        *(u32x2*)(U2 + (size_t)(tok0 + t) * DM + c4) = w; }
                }
            }
        }
        __syncthreads();
        __builtin_amdgcn_fence(__ATOMIC_ACQUIRE, "agent");
        asm volatile("s_waitcnt vmcnt(0)" ::: "memory");
        const int fr = lane & 15, fq = lane >> 4;
        if (parts & 2) {
            f32x4 acc[2][3];
#pragma unroll
            for (int gi = 0; gi < 2; ++gi)
#pragma unroll
                for (int nt = 0; nt < 3; ++nt) acc[gi][nt] = (f32x4){0.f, 0.f, 0.f, 0.f};
            const bf16_t* arow0 = U2 + (size_t)(tokb + (wave * 2 + 0) * 16 + fr) * DM + fq * 8;
            const bf16_t* arow1 = arow0 + (size_t)16 * DM;
#pragma unroll 1
            for (int ch = 0; ch < 4; ++ch) {
                u32x4 wreg[6];
#pragma unroll
                for (int p = 0; p < 6; ++p) { const int idx = p * NTHREADS + tid, row = idx >> 5, piece = idx & 31;
                    wreg[p] = *(const u32x4*)(wrt + (size_t)row * 1024 + ch * 256 + piece * 8); }
                __syncthreads();
#pragma unroll
                for (int p = 0; p < 6; ++p) { const int idx = p * NTHREADS + tid, row = idx >> 5, piece = idx & 31;
                    *(LAS u32x4*)(WB + row * WB_STRIDE + piece * 16) = wreg[p]; }
                __syncthreads();
#pragma unroll 2
                for (int ks = 0; ks < 8; ++ks) {
                    const bf16x8 af0 = *(const bf16x8*)(arow0 + ch * 256 + ks * 32), af1 = *(const bf16x8*)(arow1 + ch * 256 + ks * 32);
#pragma unroll
                    for (int nt = 0; nt < 3; ++nt) {
                        const bf16x8 bh = *(const LAS bf16x8*)(WB + (nt * 16 + fr) * WB_STRIDE + (ks * 32 + fq * 8) * 2), bl = *(const LAS bf16x8*)(WB + (48 + nt * 16 + fr) * WB_STRIDE + (ks * 32 + fq * 8) * 2);
                        acc[0][nt] = __builtin_amdgcn_mfma_f32_16x16x32_bf16(af0, bh, acc[0][nt], 0, 0, 0);
                        acc[1][nt] = __builtin_amdgcn_mfma_f32_16x16x32_bf16(af1, bh, acc[1][nt], 0, 0, 0);
                        acc[0][nt] = __builtin_amdgcn_mfma_f32_16x16x32_bf16(af0, bl, acc[0][nt], 0, 0, 0);
                        acc[1][nt] = __builtin_amdgcn_mfma_f32_16x16x32_bf16(af1, bl, acc[1][nt], 0, 0, 0);
                    }
                }
            }
            LAS float* lg = LG + wave * (2 * 16 * 48);
#pragma unroll
            for (int gi = 0; gi < 2; ++gi)
#pragma unroll
                for (int nt = 0; nt < 3; ++nt)
#pragma unroll
                    for (int j = 0; j < 4; ++j) lg[(gi * 16 + 4 * fq + j) * 48 + 16 * nt + fr] = acc[gi][nt][j];
            asm volatile("s_waitcnt lgkmcnt(0)" ::: "memory");
            if (lane < 32) {
                float pl[36];
#pragma unroll
                for (int e4 = 0; e4 < 9; ++e4) { const f32x4 q = *(const LAS f32x4*)(lg + lane * 48 + 4 * e4);
#pragma unroll
                    for (int r = 0; r < 4; ++r) pl[4 * e4 + r] = q[r]; }
#pragma unroll
                for (int e = 0; e < 36; ++e) pl[e] += e < 4 ? rgb[e] : reb[e - 4];
                int gsel = 0; float gm = pl[0];
#pragma unroll
                for (int g = 1; g < 4; ++g) if (pl[g] > gm) { gm = pl[g]; gsel = g; }
                float den = 0.f;
#pragma unroll
                for (int g = 0; g < 4; ++g) den += __expf(pl[g] - gm);
                const float gval = frcp(den);
                int j0 = -1; float v0 = -3.0e38f;
#pragma unroll
                for (int j = 0; j < 32; ++j) { const bool in = (j >> 3) == gsel; if (in && (j0 < 0 || pl[4 + j] > v0)) { v0 = pl[4 + j]; j0 = j; } }
                int j1 = -1; float v1 = -3.0e38f;
#pragma unroll
                for (int j = 0; j < 32; ++j) { const bool in = (j >> 3) == gsel; if (in && j != j0 && (j1 < 0 || pl[4 + j] > v1)) { v1 = pl[4 + j]; j1 = j; } }
                const float tt = __expf(v1 - v0), w0 = frcp(1.0f + tt), w1 = tt * w0;
                const int p0 = __hip_atomic_fetch_add(lcnt + j0, 1, __ATOMIC_RELAXED, __HIP_MEMORY_SCOPE_WORKGROUP), p1 = __hip_atomic_fetch_add(lcnt + j1, 1, __ATOMIC_RELAXED, __HIP_MEMORY_SCOPE_WORKGROUP);
                const int slot = wave * 32 + lane;
                tinfo[slot] = (i32x4){j0, j1, p0, p1}; tw[slot] = (f32x2){gval * w0, gval * w1};
            }
        }
        __syncthreads();
        if (tid < 32) lbase[tid] = atomicAdd(&counts[tid * CSTR], lcnt[tid]);
        __syncthreads();
        if (tid < 256) {
            const int tok = tokb + tid; const i32x4 ti = tinfo[tid]; const f32x2 wv = tw[tid];
            eidx[tok] = make_int2(ti[0], ti[1]); epos[tok] = make_int2(lbase[ti[0]] + ti[2], lbase[ti[1]] + ti[3]); ew[tok] = make_float2(wv[0], wv[1]);
        }
        if (tid < 32) lcnt[tid] = 0;
        __syncthreads();
    }
}

constexpr size_t WS_ROWTOK = 5 * MiB;
constexpr size_t WS_RBPRE = 2 * MiB;
__device__ __forceinline__ void p_assign(LAS unsigned char* lds, const Args& a, int bid, int G, int tid) {
    const int* counts = (const int*)(a.ws + WS_CTL);
    const int2* eidx = (const int2*)(a.ws + WS_EIDX); const int2* epos = (const int2*)(a.ws + WS_EPOS); int2* dest = (int2*)(a.ws + WS_DEST); int* rowtok = (int*)(a.ws + WS_ROWTOK);
    LAS int* ps = (LAS int*)lds;
    if (tid == 0) { int acc = 0; int* rbpre = (int*)(a.ws + WS_RBPRE); for (int e = 0; e < NE; ++e) { const int c = counts[e * CSTR]; ps[e] = acc; ps[32 + e] = c; if (bid == 0) rbpre[e] = acc >> 8; acc += ((c + 255) >> 8) << 8; } if (bid == 0) rbpre[NE] = acc >> 8; }
    __syncthreads();
    for (int tok = bid * NTHREADS + tid; tok < T; tok += G * NTHREADS) {
        const int2 ei = eidx[tok], ep = epos[tok];
        const int d0 = ps[ei.x] + ep.x, d1 = ps[ei.y] + ep.y;
        rowtok[d0] = tok; rowtok[d1] = tok; dest[tok] = make_int2(d0, d1);
    }
    for (int i = bid * NTHREADS + tid; i < NE * 256; i += G * NTHREADS) {
        const int e = i >> 8, r = i & 255, c = ps[32 + e];
        if (c + r < (((c + 255) >> 8) << 8)) rowtok[ps[e] + c + r] = 0;
    }
    __syncthreads();
}

__device__ __forceinline__ void p_combine_ln2(const Args& a, int bid, int G, int wave, int lane, bool dry = false) {
    const bf16_t* h1b = (const bf16_t*)(a.ws + WS_H1); float* outw = dry ? (float*)(a.ws + WS_HID) : a.out; const bf16_t* Y = (const bf16_t*)(a.ws + WS_Y); const int2* dest = (const int2*)(a.ws + WS_DEST); const float2* ew = (const float2*)(a.ws + WS_EW);
    const float* mod = (const float*)(a.ws + WS_MOD); const float* __restrict__ ln_g = a.in[24]; const float* __restrict__ ln_b = a.in[25];
    const int npw = (T / 2 + G * 8 - 1) / (G * 8);
    int pr = (bid * 8 + wave) * npw; const int pend = min(pr + npw, T / 2); int curb = -1;
    f32x4 lgv[4], lbv[4], g2v[4];
#pragma unroll
    for (int j = 0; j < 4; ++j) { lgv[j] = *(const f32x4*)(ln_g + 4 * lane + 256 * j); lbv[j] = *(const f32x4*)(ln_b + 4 * lane + 256 * j); }
    int2 dn[2]; float2 wn[2];
#pragma unroll
    for (int t = 0; t < 2; ++t) { const int q = min(2 * pr + t, T - 1); dn[t] = dest[q]; wn[t] = ew[q]; }
#pragma unroll 1
    for (; pr < pend; ++pr) {
        int l2 = lane; asm volatile("" : "+v"(l2)); const int lane = l2;
        const int tok0 = 2 * pr;
        if (tok0 / SEQ != curb) { curb = tok0 / SEQ; const float* m = mod + (size_t)curb * 6144;
#pragma unroll
            for (int j = 0; j < 4; ++j) g2v[j] = *(const f32x4*)(m + 5120 + 4 * lane + 256 * j); }
        int2 d[2]; float2 w[2];
#pragma unroll
        for (int t = 0; t < 2; ++t) { d[t] = dn[t]; w[t] = wn[t]; }
        f32x4 v[2][4]; float s[2] = {0.f, 0.f};
#pragma unroll
        for (int t = 0; t < 2; ++t)
#pragma unroll
            for (int j = 0; j < 4; ++j) { const int c4 = 4 * lane + 256 * j;
                const u32x2 ya = ntld((const u32x2*)(Y + (size_t)d[t].x * DM + c4)), yb = ntld((const u32x2*)(Y + (size_t)d[t].y * DM + c4));
                const u32x2 hw = ntld((const u32x2*)(h1b + (size_t)(tok0 + t) * DM + c4)); const f32x4 g2 = g2v[j];
                f32x4 f;
                f[0] = w[t].x * __uint_as_float(ya.x << 16) + w[t].y * __uint_as_float(yb.x << 16);
                f[1] = w[t].x * __uint_as_float(ya.x & 0xffff0000u) + w[t].y * __uint_as_float(yb.x & 0xffff0000u);
                f[2] = w[t].x * __uint_as_float(ya.y << 16) + w[t].y * __uint_as_float(yb.y << 16);
                f[3] = w[t].x * __uint_as_float(ya.y & 0xffff0000u) + w[t].y * __uint_as_float(yb.y & 0xffff0000u);
                const f32x4 h1 = (f32x4){__uint_as_float(hw.x << 16), __uint_as_float(hw.x & 0xffff0000u), __uint_as_float(hw.y << 16), __uint_as_float(hw.y & 0xffff0000u)};
                v[t][j] = ALPHA * h1 + g2 * f; s[t] += (v[t][j][0] + v[t][j][1]) + (v[t][j][2] + v[t][j][3]); }
        { const int pn = pr + 1; if (pn < pend) {
#pragma unroll
            for (int t = 0; t < 2; ++t) { dn[t] = dest[2 * pn + t]; wn[t] = ew[2 * pn + t]; } } }
#pragma unroll
        for (int t = 0; t < 2; ++t) { const float mean = wave_sum(s[t]) * (1.0f / DM); float s2 = 0.f;
#pragma unroll
            for (int j = 0; j < 4; ++j) { v[t][j] = v[t][j] - mean; s2 += (v[t][j][0] * v[t][j][0] + v[t][j][1] * v[t][j][1]) + (v[t][j][2] * v[t][j][2] + v[t][j][3] * v[t][j][3]); }
            const float rstd = rsqrtf(wave_sum(s2) * (1.0f / DM) + LN_EPS);
#pragma unroll
            for (int j = 0; j < 4; ++j) { const int c4 = 4 * lane + 256 * j;
                ntst((f32x4*)(outw + (size_t)(tok0 + t) * DM + c4), (f32x4)(v[t][j] * rstd * lgv[j] + lbv[j])); } }
    }
}

constexpr size_t WS_HGK = WS_U;
constexpr size_t WS_HGD = 852 * MiB;
constexpr size_t WS_RGAGG = 854 * MiB;
constexpr size_t WS_RGCARRY = 864 * MiB;
constexpr size_t WS_GWT = 870 * MiB;
constexpr size_t WS_OFST = 880 * MiB;
constexpr int RG_UNITS_PER_B = 68, HG_SEGS = 17;

__device__ __forceinline__ void lds_barrier() { asm volatile("s_waitcnt lgkmcnt(0)" ::: "memory"); __builtin_amdgcn_s_barrier(); asm volatile("" ::: "memory"); }
__device__ __forceinline__ bf16x8 mk_bf16x8(u32x4 v) { return __builtin_bit_cast(bf16x8, v); }
__device__ __forceinline__ float bf_lo(unsigned w) { return __uint_as_float(w << 16); }
__device__ __forceinline__ float bf_hi(unsigned w) { return __uint_as_float(w & 0xffff0000u); }
__device__ __forceinline__ unsigned cvt2(float lo, float hi) { unsigned r; asm volatile("v_cvt_pk_bf16_f32 %0, %1, %2" : "=v"(r) : "v"(lo), "v"(hi)); return r; }

__device__ __forceinline__ void p_gwt(const float* __restrict__ gate_w, bf16_t* __restrict__ gwt, int bid, int G, int tid) {
    for (int o = bid * NTHREADS + tid; o < 32 * 4096; o += G * NTHREADS) { const int mat = o >> 12, d = (o >> 6) & 63, c = o & 63; gwt[o] = f2bf(gate_w[mat * 4096 + c * 64 + d]); }
}

constexpr int XC_STRIDE = 1040;
constexpr int RG_XC = 0, RG_OUT = 64 * XC_STRIDE;
constexpr size_t WS_RGPAR = 876 * MiB;

__device__ __forceinline__ void p_rgpar(const float* __restrict__ gate_b, const float* __restrict__ lam, float* __restrict__ par, int bid, int G, int tid) {
    for (int o = bid * NTHREADS + tid; o < 2 * 512; o += G * NTHREADS) { const int dir = o >> 9, ch = o & 511;
        par[(dir * 3 + 0) * 512 + ch] = gate_b[(dir * 2 + 0) * 512 + ch]; par[(dir * 3 + 1) * 512 + ch] = gate_b[(dir * 2 + 1) * 512 + ch]; par[(dir * 3 + 2) * 512 + ch] = softplusf_(-lam[dir * 512 + ch]); }
}

template <int DIR, bool OUT>
__device__ __forceinline__ void rg_scan64(const float (&av)[4][4], const float (&uv)[4][4], float& carry, float& atot, float (&hsum)[4][4], int fr, int fq) {
#pragma unroll
    for (int mm = 0; mm < 4; ++mm) {
        const int m = DIR == 0 ? mm : 3 - mm;
        float P, H;
        if (DIR == 0) { P = av[m][0]; H = uv[m][0];
#pragma unroll
            for (int j = 1; j < 4; ++j) { H = av[m][j] * H + uv[m][j]; P *= av[m][j]; } }
        else { P = av[m][3]; H = uv[m][3];
#pragma unroll
            for (int j = 2; j >= 0; --j) { H = av[m][j] * H + uv[m][j]; P *= av[m][j]; } }
        float Pn, Hn, Pe, He, Pt, Ht;
        if (DIR == 0) {
            Pn = __shfl_up(P, 16); Hn = __shfl_up(H, 16); if (fq >= 1) { H = P * Hn + H; P = P * Pn; }
            Pn = __shfl_up(P, 32); Hn = __shfl_up(H, 32); if (fq >= 2) { H = P * Hn + H; P = P * Pn; }
            Pe = __shfl_up(P, 16); He = __shfl_up(H, 16); if (fq == 0) { Pe = 1.f; He = 0.f; }
            Pt = __shfl(P, fr + 48); Ht = __shfl(H, fr + 48);
        } else {
            Pn = __shfl_down(P, 16); Hn = __shfl_down(H, 16); if (fq <= 2) { H = P * Hn + H; P = P * Pn; }
            Pn = __shfl_down(P, 32); Hn = __shfl_down(H, 32); if (fq <= 1) { H = P * Hn + H; P = P * Pn; }
            Pe = __shfl_down(P, 16); He = __shfl_down(H, 16); if (fq == 3) { Pe = 1.f; He = 0.f; }
            Pt = __shfl(P, fr); Ht = __shfl(H, fr);
        }
        if (OUT) {
            float hp = Pe * carry + He;
            if (DIR == 0) {
#pragma unroll
                for (int j = 0; j < 4; ++j) { hp = av[m][j] * hp + uv[m][j]; hsum[m][j] = hp; }
            } else {
#pragma unroll
                for (int j = 3; j >= 0; --j) { hp = av[m][j] * hp + uv[m][j]; hsum[m][j] += hp; }
            }
        }
        carry = Pt * carry + Ht; atot *= Pt;
    }
}

__device__ __forceinline__ void rg_load_raw(u32x4 (&raw)[11], const bf16_t* __restrict__ proj, int b, int k, int tid) {
    int rowbase, p0, lo, hi;
    if (k < 4) { rowbase = T + b * LC; p0 = k * 64; lo = 0; hi = LC; } else { rowbase = b * SEQ; p0 = (k - 4) * 64; lo = p0; hi = p0 + 64; }
    const int c0 = (tid & 63) * 8, i0 = (tid >> 6) * 8;
#pragma unroll
    for (int r = 0; r < 11; ++r) { const int p = p0 + i0 - 1 + r;
        raw[r] = (p >= lo && p < hi) ? *(const u32x4*)proj_at(proj, rowbase + p, c0) : (u32x4){0u, 0u, 0u, 0u}; }
}
__device__ __forceinline__ void rg_agg_unit(LAS unsigned char* lds, const Args& a, int b, int k, u32x4 (&raw)[11], int bn, int kn, int tid, int wave, int lane, int xr = 0) {
    const bf16_t* __restrict__ proj = (const bf16_t*)(a.ws + WS_PROJ);
    const float* __restrict__ conv_w = a.in[7]; const float* __restrict__ conv_b = a.in[8];
    const bf16_t* __restrict__ gwt = (const bf16_t*)(a.ws + WS_GWT); const float* __restrict__ par = (const float*)(a.ws + WS_RGPAR);
    float* rgagg = (float*)(a.ws + WS_RGAGG);
    int rowbase, p0, lo, hi;
    if (k < 4) { rowbase = T + b * LC; p0 = k * 64; lo = 0; hi = LC; } else { rowbase = b * SEQ; p0 = (k - 4) * 64; lo = p0; hi = p0 + 64; }
    const int unit = b * RG_UNITS_PER_B + k;
    const int n = wave, fr = lane & 15, fq = lane >> 4;
    float pgr[4][2], pgi[4][2], psp[4][2];
#pragma unroll
    for (int nt = 0; nt < 4; ++nt)
#pragma unroll
        for (int dir = 0; dir < 2; ++dir) { const int ch = n * 64 + nt * 16 + fr;
            pgr[nt][dir] = par[(dir * 3 + 0) * 512 + ch]; pgi[nt][dir] = par[(dir * 3 + 1) * 512 + ch]; psp[nt][dir] = par[(dir * 3 + 2) * 512 + ch]; }
    if (!(xr & 1)) {
        const int cgp = tid & 63, tg = tid >> 6, c0 = cgp * 8, i0 = tg * 8;
        float cw[4][8], cb[8];
#pragma unroll
        for (int t4 = 0; t4 < 4; ++t4) { const f32x4 w0 = *(const f32x4*)(conv_w + t4 * 512 + c0), w1 = *(const f32x4*)(conv_w + t4 * 512 + c0 + 4);
#pragma unroll
            for (int q = 0; q < 4; ++q) { cw[t4][q] = w0[q]; cw[t4][4 + q] = w1[q]; } }
        { const f32x4 b0 = *(const f32x4*)(conv_b + c0), b1 = *(const f32x4*)(conv_b + c0 + 4);
#pragma unroll
            for (int q = 0; q < 4; ++q) { cb[q] = b0[q]; cb[4 + q] = b1[q]; } }
#pragma unroll
        for (int ii = 0; ii < 8; ++ii) {
            float xc[8];
#pragma unroll
            for (int c = 0; c < 8; ++c) xc[c] = cb[c];
#pragma unroll
            for (int t4 = 0; t4 < 4; ++t4) { const u32x4 rw = raw[ii + t4];
#pragma unroll
                for (int q = 0; q < 4; ++q) { xc[2 * q] += cw[t4][2 * q] * bf_lo(rw[q]); xc[2 * q + 1] += cw[t4][2 * q + 1] * bf_hi(rw[q]); } }
            u32x4 w; w.x = cvt2(xc[0], xc[1]); w.y = cvt2(xc[2], xc[3]); w.z = cvt2(xc[4], xc[5]); w.w = cvt2(xc[6], xc[7]);
            *(LAS u32x4*)(lds + RG_XC + (i0 + ii) * XC_STRIDE + c0 * 2) = w;
        }
    }
    if (kn >= 0) rg_load_raw(raw, proj, bn, kn, tid);
    lds_barrier();
    {
        bf16x8 afr[4][2];
#pragma unroll
        for (int m = 0; m < 4; ++m)
#pragma unroll
            for (int ks = 0; ks < 2; ++ks) afr[m][ks] = *(const LAS bf16x8*)(lds + RG_XC + (16 * m + fr) * XC_STRIDE + (n * 64 + ks * 32 + fq * 8) * 2);
        u32x4* stash = (k >= 4) ? (u32x4*)a.out + ((size_t)(b * 64 + (k - 4)) * 16384 + (size_t)wave * 2048 + lane) : nullptr;
        bf16x8 wfr[2][2][2];
#pragma unroll
        for (int dir = 0; dir < 2; ++dir)
#pragma unroll
            for (int g = 0; g < 2; ++g)
#pragma unroll
                for (int ks = 0; ks < 2; ++ks) wfr[dir][g][ks] = *(const bf16x8*)(gwt + ((size_t)(((dir * 2 + g) * 8 + n) * 64 + fr)) * 64 + ks * 32 + fq * 8);
#pragma unroll
        for (int nt = 0; nt < 4; ++nt) {
            const int ch = n * 64 + nt * 16 + fr;
            bf16x8 wnx[2][2][2];
            if (nt < 3) {
#pragma unroll
                for (int dir = 0; dir < 2; ++dir)
#pragma unroll
                    for (int g = 0; g < 2; ++g)
#pragma unroll
                        for (int ks = 0; ks < 2; ++ks) wnx[dir][g][ks] = *(const bf16x8*)(gwt + ((size_t)(((dir * 2 + g) * 8 + n) * 64 + (nt + 1) * 16 + fr)) * 64 + ks * 32 + fq * 8);
            }
            float xcv[4][4];
#pragma unroll
            for (int m = 0; m < 4; ++m)
#pragma unroll
                for (int j = 0; j < 4; ++j) xcv[m][j] = bf2f(*(const LAS bf16_t*)(lds + RG_XC + (16 * m + 4 * fq + j) * XC_STRIDE + ch * 2));
#pragma unroll
            for (int dir = 0; dir < 2; ++dir) {
                f32x4 accr[4], acci[4];
#pragma unroll
                for (int m = 0; m < 4; ++m) { accr[m] = (f32x4){0.f, 0.f, 0.f, 0.f}; acci[m] = (f32x4){0.f, 0.f, 0.f, 0.f}; }
                if (!(xr & 2))
#pragma unroll
                for (int ks = 0; ks < 2; ++ks)
#pragma unroll
                    for (int m = 0; m < 4; ++m) { accr[m] = __builtin_amdgcn_mfma_f32_16x16x32_bf16(afr[m][ks], wfr[dir][0][ks], accr[m], 0, 0, 0); acci[m] = __builtin_amdgcn_mfma_f32_16x16x32_bf16(afr[m][ks], wfr[dir][1][ks], acci[m], 0, 0, 0); }
                const float gbr = pgr[nt][dir], gbi = pgi[nt][dir], sp = psp[nt][dir];
                float av[4][4], uv[4][4];
                const bool exact = __any(8.0f * sp >= 0.25f);
#pragma unroll
                for (int m = 0; m < 4; ++m) {
                    unsigned pk[4];
                    if (xr & 4) {
#pragma unroll
                        for (int j = 0; j < 4; ++j) pk[j] = __float_as_uint(accr[m][j] + acci[m][j] + xcv[m][j]);
                    } else if (!exact) {
#pragma unroll
                        for (int j = 0; j < 4; ++j) {
                            const float r = sigmoidf_(accr[m][j] + gbr), ig = sigmoidf_(acci[m][j] + gbi);
                            const float la = -8.0f * r * sp;
                            const float oma = -la * (1.f + la * (0.5f + la * (0.16666667f + la * (0.041666668f + la * 0.0083333338f))));
                            pk[j] = cvt2(oma, __builtin_amdgcn_sqrtf(oma * (2.0f - oma)) * ig * xcv[m][j]);
                        }
                    } else {
#pragma unroll
                        for (int j = 0; j < 4; ++j) {
                            const float r = sigmoidf_(accr[m][j] + gbr), ig = sigmoidf_(acci[m][j] + gbi);
                            const float la = -8.0f * r * sp;
                            const float ser = -la * (1.f + la * (0.5f + la * (0.16666667f + la * (0.041666668f + la * 0.0083333338f))));
                            const float oma = (la > -0.25f) ? ser : 1.f - __expf(la);
                            pk[j] = cvt2(oma, __builtin_amdgcn_sqrtf(oma * (2.0f - oma)) * ig * xcv[m][j]);
                        }
                    }
#pragma unroll
                    for (int j = 0; j < 4; ++j) { av[m][j] = 1.0f - bf_lo(pk[j]); uv[m][j] = bf_hi(pk[j]); }
                    if (stash && !(xr & 16)) ntst(stash + ((nt * 2 + dir) * 4 + m) * 64, (u32x4){pk[0], pk[1], pk[2], pk[3]});
                }
                float carry = 0.f, atot = 1.f, hdummy[4][4];
                if (xr & 8) { carry = av[0][0] + uv[3][3]; } else if (dir == 0) rg_scan64<0, false>(av, uv, carry, atot, hdummy, fr, fq); else rg_scan64<1, false>(av, uv, carry, atot, hdummy, fr, fq);
                if (fq == 0) { rgagg[(((size_t)unit * 2 + dir) * 2 + 0) * 512 + ch] = atot; rgagg[(((size_t)unit * 2 + dir) * 2 + 1) * 512 + ch] = carry; }
            }
            if (nt < 3) {
#pragma unroll
                for (int dir = 0; dir < 2; ++dir)
#pragma unroll
                    for (int g = 0; g < 2; ++g)
#pragma unroll
                        for (int ks = 0; ks < 2; ++ks) wfr[dir][g][ks] = wnx[dir][g][ks];
            }
        }
    }
    lds_barrier();
}

__device__ __forceinline__ void rg_final_load(u32x4 (&g)[8], u32x4 (&st)[2][4], const Args& a, int b, int kl, int tid, int wave, int lane) {
    const bf16_t* __restrict__ proj = (const bf16_t*)(a.ws + WS_PROJ);
    const int rowbase = b * SEQ + kl * 64, c0 = (tid & 63) * 8, i0 = (tid >> 6) * 8;
    const u32x4* stash = (const u32x4*)a.out + ((size_t)(b * 64 + kl) * 16384 + (size_t)wave * 2048 + lane);
#pragma unroll
    for (int ii = 0; ii < 8; ++ii) g[ii] = *(const u32x4*)proj_at(proj, rowbase + i0 + ii, 512 + c0);
#pragma unroll
    for (int dir = 0; dir < 2; ++dir)
#pragma unroll
        for (int m = 0; m < 4; ++m) st[dir][m] = ntld(stash + ((0 * 2 + dir) * 4 + m) * 64);
}
__device__ __forceinline__ void rg_final_unit(LAS unsigned char* lds, const Args& a, int b, int kl, u32x4 (&g)[8], u32x4 (&st)[2][4], int bn, int kn, int tid, int wave, int lane) {
    const float* rgcarry = (const float*)(a.ws + WS_RGCARRY); bf16_t* mixed = (bf16_t*)(a.ws + WS_MIXED);
    const int rowbase = b * SEQ + kl * 64, unit = b * RG_UNITS_PER_B + 4 + kl;
    const int n = wave, fr = lane & 15, fq = lane >> 4;
    const u32x4* stash = (const u32x4*)a.out + ((size_t)(b * 64 + kl) * 16384 + (size_t)wave * 2048 + lane);
    float cin[4][2];
#pragma unroll
    for (int nt = 0; nt < 4; ++nt)
#pragma unroll
        for (int dir = 0; dir < 2; ++dir) cin[nt][dir] = rgcarry[((size_t)unit * 2 + dir) * 512 + n * 64 + nt * 16 + fr];
    {
        const int c0 = (tid & 63) * 8, i0 = (tid >> 6) * 8;
#pragma unroll
        for (int ii = 0; ii < 8; ++ii) *(LAS u32x4*)(lds + RG_XC + (i0 + ii) * XC_STRIDE + c0 * 2) = g[ii];
    }
    lds_barrier();
#pragma unroll
    for (int nt = 0; nt < 4; ++nt) {
        const int ch = n * 64 + nt * 16 + fr;
        u32x4 sn[2][4];
        if (nt < 3) {
#pragma unroll
            for (int dir = 0; dir < 2; ++dir)
#pragma unroll
                for (int m = 0; m < 4; ++m) sn[dir][m] = ntld(stash + (((nt + 1) * 2 + dir) * 4 + m) * 64);
        }
        float hsum[4][4];
#pragma unroll
        for (int dir = 0; dir < 2; ++dir) {
            float av[4][4], uv[4][4];
#pragma unroll
            for (int m = 0; m < 4; ++m)
#pragma unroll
                for (int j = 0; j < 4; ++j) { av[m][j] = 1.0f - bf_lo(st[dir][m][j]); uv[m][j] = bf_hi(st[dir][m][j]); }
            float carry = cin[nt][dir], atot = 1.f;
            if (dir == 0) rg_scan64<0, true>(av, uv, carry, atot, hsum, fr, fq); else rg_scan64<1, true>(av, uv, carry, atot, hsum, fr, fq);
        }
#pragma unroll
        for (int m = 0; m < 4; ++m)
#pragma unroll
            for (int j = 0; j < 4; ++j) { const int t = 16 * m + 4 * fq + j;
                const float gg = bf2f(*(const LAS bf16_t*)(lds + RG_XC + t * XC_STRIDE + ch * 2));
                *(LAS bf16_t*)(lds + RG_OUT + t * XC_STRIDE + ch * 2) = (bf16_t)(cvt2(hsum[m][j] * gg, 0.f) & 0xffffu); }
        if (nt < 3) {
#pragma unroll
            for (int dir = 0; dir < 2; ++dir)
#pragma unroll
                for (int m = 0; m < 4; ++m) st[dir][m] = sn[dir][m];
        }
    }
    if (kn >= 0) rg_final_load(g, st, a, bn, kn, tid, wave, lane);
    lds_barrier();
    {
        const int c0 = (tid & 63) * 8, i0 = (tid >> 6) * 8;
#pragma unroll
        for (int ii = 0; ii < 8; ++ii) { const u32x4 w = *(const LAS u32x4*)(lds + RG_OUT + (i0 + ii) * XC_STRIDE + c0 * 2);
            *(u32x4*)(mixed + (size_t)(rowbase + i0 + ii) * DM + c0) = w; }
    }
}

__device__ __forceinline__ void rg_carry_item(const Args& a, int item, int tid) {
    const float* rgagg = (const float*)(a.ws + WS_RGAGG); float* rgcarry = (float*)(a.ws + WS_RGCARRY);
    const int gidx = item * NTHREADS + tid;
    const int ch = gidx & 511, dir = (gidx >> 9) & 1, b = gidx >> 10;
    float h = 0.f;
#pragma unroll 1
    for (int s0 = 0; s0 < RG_UNITS_PER_B; s0 += 17) {
        float Av[17], Hv[17];
#pragma unroll
        for (int s1 = 0; s1 < 17; ++s1) { const int s = s0 + s1;
            const int k = dir == 0 ? s : (s < 4 ? 3 - s : 67 - (s - 4));
            const size_t unit = (size_t)b * RG_UNITS_PER_B + k;
            Av[s1] = rgagg[((unit * 2 + dir) * 2 + 0) * 512 + ch]; Hv[s1] = rgagg[((unit * 2 + dir) * 2 + 1) * 512 + ch]; }
#pragma unroll
        for (int s1 = 0; s1 < 17; ++s1) { const int s = s0 + s1;
            const int k = dir == 0 ? s : (s < 4 ? 3 - s : 67 - (s - 4));
            const size_t unit = (size_t)b * RG_UNITS_PER_B + k;
            rgcarry[(unit * 2 + dir) * 512 + ch] = h;
            h = Av[s1] * h + Hv[s1]; }
    }
}

#ifndef HGX
#define HGX 0
#endif
__device__ __forceinline__ float row_allsum16(float v) {
    v += __builtin_bit_cast(float, __builtin_amdgcn_update_dpp(0, __builtin_bit_cast(int, v), 0x128, 0xf, 0xf, false));
    v += __builtin_bit_cast(float, __builtin_amdgcn_update_dpp(0, __builtin_bit_cast(int, v), 0x124, 0xf, 0xf, false));
    v += __builtin_bit_cast(float, __builtin_amdgcn_update_dpp(0, __builtin_bit_cast(int, v), 0x122, 0xf, 0xf, false));
    v += __builtin_bit_cast(float, __builtin_amdgcn_update_dpp(0, __builtin_bit_cast(int, v), 0x121, 0xf, 0xf, false));
    return v;
}
constexpr int HG_RAWZ = 0, HG_RAWV = 16384, HG_RAWQ = 32768;
constexpr int HG_KHT = 49152, HG_VT = 67584;
constexpr int HG_QT = 86016, HG_KT = 103424;
constexpr int HG_AM = 120832;
constexpr int HG_DS = 130048, HG_QSUM = 130560, HG_PART = 134656;
constexpr int HG_RAWG = 136704;
constexpr int HG_OST = HG_QT;
constexpr int TS = 144, QS = 272;

struct HgRaw { u32x4 z[2], v[2], q[2], g[2]; };
template <bool FULL, bool GATE>
__device__ __forceinline__ void hg_load_raw(HgRaw& r, const bf16_t* __restrict__ proj, int row0, int hd, int dir, int tid) {
#pragma unroll
    for (int i = 0; i < 2; ++i) { const int row = row0 + (tid >> 4) + 32 * i, col = hd * 128 + (tid & 15) * 8;
        r.z[i] = *(const u32x4*)proj_at(proj, row, col + (dir == 0 ? 1536 : 2048)); r.v[i] = *(const u32x4*)proj_at(proj, row, col + 2560);
        if (FULL) r.q[i] = *(const u32x4*)proj_at(proj, row, col + 1024); if (GATE) r.g[i] = *(const u32x4*)proj_at(proj, row, col + 3072); }
}
template <bool FULL, bool GATE>
__device__ __forceinline__ void hg_store_raw(LAS unsigned char* lds, const HgRaw& r, int tid) {
#pragma unroll
    for (int i = 0; i < 2; ++i) { const int off = ((tid >> 4) + 32 * i) * 256 + (tid & 15) * 16;
        *(LAS u32x4*)(lds + HG_RAWZ + off) = r.z[i]; *(LAS u32x4*)(lds + HG_RAWV + off) = r.v[i]; if (FULL) *(LAS u32x4*)(lds + HG_RAWQ + off) = r.q[i]; if (GATE) *(LAS u32x4*)(lds + HG_RAWG + off) = r.g[i]; }
}

template <int DIR, bool FULL, bool STORE_NEXT, bool NEXT_GATE>
__device__ __forceinline__ void hg_chunk(LAS unsigned char* lds, f32x4 (&accS)[8], f32x4 (&o)[4], float lb0, float lb1, float& dseg0, float& dseg1, const HgRaw& nxt, int tid, int wave, int lane, int xm = 0) {
    const int cp = lane, tg = wave, fr = lane & 15, fq = lane >> 4;
    float c0[8], c1[8], k0[8], k1[8];
    if (xm & 1) {
#pragma unroll
        for (int i = 0; i < 8; ++i) { c0[i] = 1.f; c1[i] = 1.f; k0[i] = 0.5f; k1[i] = 0.5f; }
    } else {
        float p0 = 1.f, p1 = 1.f;
#pragma unroll
        for (int ii = 0; ii < 8; ++ii) { const int i = DIR == 0 ? ii : 7 - ii;
            const unsigned zz = *(const LAS unsigned*)(lds + HG_RAWZ + (8 * tg + i) * 256 + cp * 4);
            const float e0 = __expf(-bf_lo(zz)), e1 = __expf(-bf_hi(zz)); const float s0 = frcp(1.0f + e0), s1 = frcp(1.0f + e1);
            k0[i] = (1.0f - lb0) * (1.0f - s0); k1[i] = (1.0f - lb1) * (1.0f - s1);
            p0 *= lb0 + (1.0f - lb0) * s0; p1 *= lb1 + (1.0f - lb1) * s1; c0[i] = p0; c1[i] = p1; }
        *(LAS f32x2*)(lds + HG_QSUM + (tg * 128 + 2 * cp) * 4) = (f32x2){p0, p1};
    }
    lds_barrier();
    float pre0 = 1.f, pre1 = 1.f, tot0 = 1.f, tot1 = 1.f;
#pragma unroll
    for (int g = 0; g < 8; ++g) { const f32x2 v = *(const LAS f32x2*)(lds + HG_QSUM + (g * 128 + 2 * cp) * 4); tot0 *= v[0]; tot1 *= v[1]; if (DIR == 0 ? (g < tg) : (g > tg)) { pre0 *= v[0]; pre1 *= v[1]; } }
    if (!(xm & 1)) {
        unsigned kh0[4], kh1[4], vt0[4], vt1[4];
#pragma unroll
        for (int i2 = 0; i2 < 4; ++i2) {
            const float Pa0 = pre0 * c0[2 * i2], Pb0 = pre0 * c0[2 * i2 + 1], Pa1 = pre1 * c1[2 * i2], Pb1 = pre1 * c1[2 * i2 + 1];
            const float ra0 = frcp(Pa0), rb0 = frcp(Pb0), ra1 = frcp(Pa1), rb1 = frcp(Pb1);
            const float kta0 = k0[2 * i2] * ra0, ktb0 = k0[2 * i2 + 1] * rb0, kta1 = k1[2 * i2] * ra1, ktb1 = k1[2 * i2 + 1] * rb1;
            kh0[i2] = cvt2(kta0 * tot0, ktb0 * tot0); kh1[i2] = cvt2(kta1 * tot1, ktb1 * tot1);
            const unsigned va = *(const LAS unsigned*)(lds + HG_RAWV + (8 * tg + 2 * i2) * 256 + cp * 4), vb = *(const LAS unsigned*)(lds + HG_RAWV + (8 * tg + 2 * i2 + 1) * 256 + cp * 4);
            vt0[i2] = __builtin_amdgcn_perm(vb, va, 0x05040100u); vt1[i2] = __builtin_amdgcn_perm(vb, va, 0x07060302u);
            if (FULL) {
                const unsigned qa = *(const LAS unsigned*)(lds + HG_RAWQ + (8 * tg + 2 * i2) * 256 + cp * 4), qb = *(const LAS unsigned*)(lds + HG_RAWQ + (8 * tg + 2 * i2 + 1) * 256 + cp * 4);
                *(LAS unsigned*)(lds + HG_QT + (8 * tg + 2 * i2) * QS + cp * 4) = cvt2(bf_lo(qa) * Pa0, bf_hi(qa) * Pa1);
                *(LAS unsigned*)(lds + HG_QT + (8 * tg + 2 * i2 + 1) * QS + cp * 4) = cvt2(bf_lo(qb) * Pb0, bf_hi(qb) * Pb1);
                *(LAS unsigned*)(lds + HG_KT + (8 * tg + 2 * i2) * QS + cp * 4) = cvt2(kta0, kta1);
                *(LAS unsigned*)(lds + HG_KT + (8 * tg + 2 * i2 + 1) * QS + cp * 4) = cvt2(ktb0, ktb1);
            }
        }
        *(LAS u32x4*)(lds + HG_KHT + (2 * cp) * TS + tg * 16) = (u32x4){kh0[0], kh0[1], kh0[2], kh0[3]}; *(LAS u32x4*)(lds + HG_KHT + (2 * cp + 1) * TS + tg * 16) = (u32x4){kh1[0], kh1[1], kh1[2], kh1[3]};
        *(LAS u32x4*)(lds + HG_VT + (2 * cp) * TS + tg * 16) = (u32x4){vt0[0], vt0[1], vt0[2], vt0[3]}; *(LAS u32x4*)(lds + HG_VT + (2 * cp + 1) * TS + tg * 16) = (u32x4){vt1[0], vt1[1], vt1[2], vt1[3]};
        if (tg == 0) { *(LAS f32x2*)(lds + HG_DS + 2 * cp * 4) = (f32x2){tot0, tot1}; dseg0 *= tot0; dseg1 *= tot1; }
    }
    lds_barrier();
    if (FULL) {
        if (!(xm & 2))
#pragma unroll
        for (int tt = 0; tt < 2; ++tt) {
            const int tl = 2 * wave + tt, ti = tl >> 2, si = tl & 3;
            f32x4 accA = (f32x4){0.f, 0.f, 0.f, 0.f};
#pragma unroll
            for (int ks = 0; ks < 4; ++ks) {
                const bf16x8 af = *(const LAS bf16x8*)(lds + HG_QT + (16 * ti + fr) * QS + (ks * 32 + fq * 8) * 2);
                const bf16x8 bf = *(const LAS bf16x8*)(lds + HG_KT + (16 * si + fr) * QS + (ks * 32 + fq * 8) * 2);
                accA = __builtin_amdgcn_mfma_f32_16x16x32_bf16(af, bf, accA, 0, 0, 0);
            }
#pragma unroll
            for (int j = 0; j < 4; ++j) { const int t = 16 * ti + 4 * fq + j, s = 16 * si + fr;
                const bool keep = DIR == 0 ? (s <= t) : (s >= t);
                *(LAS bf16_t*)(lds + HG_AM + t * TS + s * 2) = (bf16_t)(cvt2(keep ? accA[j] : 0.f, 0.f) & 0xffffu); }
        }
        lds_barrier();
#pragma unroll
        for (int m = 0; m < 4; ++m) o[m] = (f32x4){0.f, 0.f, 0.f, 0.f};
        if (!(xm & 4)) {
#pragma unroll
        for (int ks = 0; ks < 4; ++ks) {
            const u32x4 sw = (u32x4){cvt2(accS[2 * ks][0], accS[2 * ks][1]), cvt2(accS[2 * ks][2], accS[2 * ks][3]), cvt2(accS[2 * ks + 1][0], accS[2 * ks + 1][1]), cvt2(accS[2 * ks + 1][2], accS[2 * ks + 1][3])};
            const bf16x8 sf = mk_bf16x8(sw);
#pragma unroll
            for (int m = 0; m < 4; ++m) {
                const u32x2 qlo = *(const LAS u32x2*)(lds + HG_QT + (16 * m + fr) * QS + (32 * ks + 4 * fq) * 2), qhi = *(const LAS u32x2*)(lds + HG_QT + (16 * m + fr) * QS + (32 * ks + 16 + 4 * fq) * 2);
                const bf16x8 qf = mk_bf16x8((u32x4){qlo.x, qlo.y, qhi.x, qhi.y});
                o[m] = __builtin_amdgcn_mfma_f32_16x16x32_bf16(qf, sf, o[m], 0, 0, 0);
            }
        }
#pragma unroll
        for (int ks = 0; ks < 2; ++ks) {
            const bf16x8 vf = *(const LAS bf16x8*)(lds + HG_VT + (16 * wave + fr) * TS + (ks * 32 + fq * 8) * 2);
#pragma unroll
            for (int m = 0; m < 4; ++m) { const bf16x8 af = *(const LAS bf16x8*)(lds + HG_AM + (16 * m + fr) * TS + (ks * 32 + fq * 8) * 2);
                o[m] = __builtin_amdgcn_mfma_f32_16x16x32_bf16(af, vf, o[m], 0, 0, 0); }
        }
        }
    }
    if (!(xm & 8)) {
#pragma unroll
    for (int i = 0; i < 8; ++i) { const f32x4 dv = *(const LAS f32x4*)(lds + HG_DS + (16 * i + 4 * fq) * 4); accS[i] = accS[i] * dv; }
#pragma unroll
    for (int ks = 0; ks < 2; ++ks) {
        const bf16x8 vf = *(const LAS bf16x8*)(lds + HG_VT + (16 * wave + fr) * TS + (ks * 32 + fq * 8) * 2);
#pragma unroll
        for (int i = 0; i < 8; ++i) { const bf16x8 af = *(const LAS bf16x8*)(lds + HG_KHT + (16 * i + fr) * TS + (ks * 32 + fq * 8) * 2);
            accS[i] = __builtin_amdgcn_mfma_f32_16x16x32_bf16(af, vf, accS[i], 0, 0, 0); }
    }
    }
    if (STORE_NEXT) hg_store_raw<FULL, NEXT_GATE>(lds, nxt, tid);
}

__device__ __forceinline__ float hg_lb(const float* __restrict__ lb_logits, int dir, int col) {
    const float l0 = lb_logits[(0 * 2 + dir) * 512 + col], l1 = lb_logits[(1 * 2 + dir) * 512 + col];
    return 1.0f / (1.0f + expf(l1 - l0));
}

template <int DIR>
__device__ __forceinline__ void hg_agg_unit(LAS unsigned char* lds, const Args& a, int b, int hd, int sidx, int unit, int tid, int wave, int lane) {
    const bf16_t* __restrict__ proj = (const bf16_t*)(a.ws + WS_PROJ);
    const int rowbase = sidx == 0 ? T + b * LC : b * SEQ + (sidx - 1) * 256;
    const float lb0 = hg_lb(a.in[12], DIR, hd * 128 + 2 * lane), lb1 = hg_lb(a.in[12], DIR, hd * 128 + 2 * lane + 1);
    f32x4 accS[8], odummy[4];
#pragma unroll
    for (int i = 0; i < 8; ++i) accS[i] = (f32x4){0.f, 0.f, 0.f, 0.f};
    float dseg0 = 1.f, dseg1 = 1.f;
    HgRaw raw;
    hg_load_raw<false, false>(raw, proj, rowbase + (DIR == 0 ? 0 : 3) * 64, hd, DIR, tid);
    lds_barrier();
    hg_store_raw<false, false>(lds, raw, tid);
    lds_barrier();
#pragma unroll 1
    for (int cc = 0; cc < 3; ++cc) {
        hg_load_raw<false, false>(raw, proj, rowbase + (DIR == 0 ? cc + 1 : 2 - cc) * 64, hd, DIR, tid);
        hg_chunk<DIR, false, true, false>(lds, accS, odummy, lb0, lb1, dseg0, dseg1, raw, tid, wave, lane);
        lds_barrier();
    }
    hg_chunk<DIR, false, false, false>(lds, accS, odummy, lb0, lb1, dseg0, dseg1, raw, tid, wave, lane);
    float* K = (float*)(a.ws + WS_HGK) + (size_t)unit * 16384;
    const int fr = lane & 15, fq = lane >> 4;
#pragma unroll
    for (int i = 0; i < 8; ++i)
#pragma unroll
        for (int j = 0; j < 4; ++j) K[(16 * i + 4 * fq + j) * 128 + 16 * wave + fr] = accS[i][j];
    if (wave == 0) *(f32x2*)((float*)(a.ws + WS_HGD) + (size_t)unit * 128 + 2 * lane) = (f32x2){dseg0, dseg1};
}

__device__ __forceinline__ void hg_carry_item(const Args& a, int item, int tid, bool dry = false) {
    const int chain = item >> 3, part = item & 7, dir = chain & 1;
    float* K = (float*)(a.ws + WS_HGK) + (size_t)chain * HG_SEGS * 16384; const float* D = (const float*)(a.ws + WS_HGD) + (size_t)chain * HG_SEGS * 128;
    const int e4 = part * 512 + tid, dk = e4 >> 5;
    f32x4 kv[HG_SEGS]; float dv[HG_SEGS];
#pragma unroll
    for (int s = 0; s < HG_SEGS; ++s) { const int sidx = s == 0 ? 0 : (dir == 0 ? s : HG_SEGS - s); kv[s] = *(const f32x4*)(K + (size_t)sidx * 16384 + e4 * 4); dv[s] = D[sidx * 128 + dk]; }
    f32x4 S = (f32x4){0.f, 0.f, 0.f, 0.f};
#pragma unroll
    for (int s = 0; s < HG_SEGS; ++s) { const int sidx = s == 0 ? 0 : (dir == 0 ? s : HG_SEGS - s);
        if (dry) { const size_t o = ((size_t)(chain * HG_SEGS + sidx) * 16384 + e4 * 4) % (size_t)(32 * MiB); *(f32x4*)((float*)(a.ws + WS_MIXED) + o) = S; } else *(f32x4*)(K + (size_t)sidx * 16384 + e4 * 4) = S;
        S = S * dv[s] + kv[s]; }
}

__device__ __forceinline__ void hg_final_unit(LAS unsigned char* lds, const Args& a, int b, int hd, int seg, int tid, int wave, int lane, int xm = 0) {
    const bf16_t* __restrict__ proj = (const bf16_t*)(a.ws + WS_PROJ); bf16_t* mixed = (bf16_t*)(a.ws + WS_MIXED);
    const int rowbase = b * SEQ + seg * 256, fr = lane & 15, fq = lane >> 4;
    const float lbf0 = hg_lb(a.in[12], 0, hd * 128 + 2 * lane), lbf1 = hg_lb(a.in[12], 0, hd * 128 + 2 * lane + 1);
    const float lbb0 = hg_lb(a.in[12], 1, hd * 128 + 2 * lane), lbb1 = hg_lb(a.in[12], 1, hd * 128 + 2 * lane + 1);
    f32x4 accS[8], o[4];
    float dseg0 = 1.f, dseg1 = 1.f;
    HgRaw raw;
    f32x4* ofst = (f32x4*)(a.ws + WS_OFST) + (size_t)blockIdx.x * 8192 + wave * 256 + lane;
    hg_load_raw<true, false>(raw, proj, rowbase, hd, 0, tid);
    {
        const float* Sin = (const float*)(a.ws + WS_HGK) + (size_t)((((b * 4 + hd) * 2 + 0) * HG_SEGS) + 1 + seg) * 16384;
#pragma unroll
        for (int i = 0; i < 8; ++i)
#pragma unroll
            for (int j = 0; j < 4; ++j) accS[i][j] = Sin[(16 * i + 4 * fq + j) * 128 + 16 * wave + fr];
    }
    lds_barrier();
    hg_store_raw<true, false>(lds, raw, tid);
    lds_barrier();
#pragma unroll 1
    for (int cc = 0; cc < 3; ++cc) {
        hg_load_raw<true, false>(raw, proj, rowbase + (cc + 1) * 64, hd, 0, tid);
        hg_chunk<0, true, true, false>(lds, accS, o, lbf0, lbf1, dseg0, dseg1, raw, tid, wave, lane, xm);
#pragma unroll
        for (int m = 0; m < 4; ++m) ofst[cc * 2048 + m * 64] = o[m];
        lds_barrier();
    }
    hg_load_raw<true, false>(raw, proj, rowbase + 3 * 64, hd, 1, tid);
    hg_chunk<0, true, true, false>(lds, accS, o, lbf0, lbf1, dseg0, dseg1, raw, tid, wave, lane, xm);
#pragma unroll
    for (int m = 0; m < 4; ++m) ofst[3 * 2048 + m * 64] = o[m];
    {
        const float* Sin = (const float*)(a.ws + WS_HGK) + (size_t)((((b * 4 + hd) * 2 + 1) * HG_SEGS) + 1 + seg) * 16384;
#pragma unroll
        for (int i = 0; i < 8; ++i)
#pragma unroll
            for (int j = 0; j < 4; ++j) accS[i][j] = Sin[(16 * i + 4 * fq + j) * 128 + 16 * wave + fr];
    }
    lds_barrier();
    constexpr int OSF = 528;
    f32x4 ngv[2];
    { const float* ngp = a.in[13] + hd * 128 + (tid & 15) * 8; ngv[0] = *(const f32x4*)ngp; ngv[1] = *(const f32x4*)(ngp + 4); }
#pragma unroll 1
    for (int cc = 0; cc < 4; ++cc) {
        const int c = 3 - cc;
        f32x4 ofv[4]; u32x4 gq[2];
#pragma unroll
        for (int m = 0; m < 4; ++m) ofv[m] = ofst[c * 2048 + m * 64];
#pragma unroll
        for (int i = 0; i < 2; ++i) gq[i] = *(const u32x4*)proj_at(proj, rowbase + c * 64 + (tid >> 4) + 32 * i, 3072 + hd * 128 + (tid & 15) * 8);
        if (cc < 3) hg_load_raw<true, false>(raw, proj, rowbase + (c - 1) * 64, hd, 1, tid);
        if (cc < 3) hg_chunk<1, true, true, false>(lds, accS, o, lbb0, lbb1, dseg0, dseg1, raw, tid, wave, lane, xm);
        else hg_chunk<1, true, false, false>(lds, accS, o, lbb0, lbb1, dseg0, dseg1, raw, tid, wave, lane, xm);
        if (xm & 16) { lds_barrier(); continue; }
        lds_barrier();
#pragma unroll
        for (int m = 0; m < 4; ++m) { const f32x4 ot = o[m] + ofv[m];
#pragma unroll
            for (int j = 0; j < 4; ++j) *(LAS float*)(lds + HG_QT + (16 * m + 4 * fq + j) * OSF + (16 * wave + fr) * 4) = ot[j]; }
        lds_barrier();
#pragma unroll
        for (int i = 0; i < 2; ++i) { const int t = (tid >> 4) + 32 * i, c8 = (tid & 15) * 8;
            const f32x4 v0 = *(const LAS f32x4*)(lds + HG_QT + t * OSF + c8 * 4), v1 = *(const LAS f32x4*)(lds + HG_QT + t * OSF + c8 * 4 + 16);
            const float ss = row_allsum16((v0[0] * v0[0] + v0[1] * v0[1]) + (v0[2] * v0[2] + v0[3] * v0[3]) + (v1[0] * v1[0] + v1[1] * v1[1]) + (v1[2] * v1[2] + v1[3] * v1[3]));
            const float rinv = __builtin_amdgcn_rsqf(ss * (1.0f / 128.0f) + LN_EPS);
            const u32x4 g = gq[i];
            u32x4 w;
            w.x = cvt2(v0[0] * rinv * ngv[0][0] * bf_lo(g.x), v0[1] * rinv * ngv[0][1] * bf_hi(g.x)); w.y = cvt2(v0[2] * rinv * ngv[0][2] * bf_lo(g.y), v0[3] * rinv * ngv[0][3] * bf_hi(g.y));
            w.z = cvt2(v1[0] * rinv * ngv[1][0] * bf_lo(g.z), v1[1] * rinv * ngv[1][1] * bf_hi(g.z)); w.w = cvt2(v1[2] * rinv * ngv[1][2] * bf_lo(g.w), v1[3] * rinv * ngv[1][3] * bf_hi(g.w));
            *(u32x4*)(mixed + (size_t)(rowbase + c * 64 + t) * DM + 512 + hd * 128 + c8) = w; }
    }
}

__device__ __forceinline__ void p_scan_a(LAS unsigned char* lds, const Args& a, int bid, int G, int tid, int wave, int lane, int mask = 3, int xr = 0) {
    constexpr int N_HG = NB * 4 * 2 * HG_SEGS, N_RG = NB * RG_UNITS_PER_B;
    if (mask & 1) {
        const bool bal = G == 256;
        const int hn = bal ? (bid < 128 ? 9 : (bid < 192 ? 8 : 6)) : (2048 - bid + G - 1) / G;
        const int hs = bal ? (bid < 128 ? 9 * bid : (bid < 192 ? 1152 + 8 * (bid - 128) : 1664 + 6 * (bid - 192))) : bid, hstep = bal ? 1 : G;
#pragma unroll 1
        for (int k = 0; k < hn; ++k) {
            int t2 = tid; asm volatile("" : "+v"(t2)); const int tid = t2, lane = t2 & 63;
            const int it = hs + k * hstep, s16 = it & 15, rest = it >> 4, dir = rest & 1, hd = (rest >> 1) & 3, b = rest >> 3;
            const int sidx = dir == 0 ? s16 : (s16 == 0 ? 0 : s16 + 1), unit = rest * HG_SEGS + sidx;
            if (dir == 0) hg_agg_unit<0>(lds, a, b, hd, sidx, unit, tid, wave, lane); else hg_agg_unit<1>(lds, a, b, hd, sidx, unit, tid, wave, lane);
        }
    }
    if (mask & 2) {
        __syncthreads();
        u32x4 raw[11];
        int r = G - 1 - bid;
        if (r < N_RG) rg_load_raw(raw, (const bf16_t*)(a.ws + WS_PROJ), r / RG_UNITS_PER_B, r % RG_UNITS_PER_B, tid);
#pragma unroll 1
        for (; r < N_RG; r += G) {
            int t2 = tid; asm volatile("" : "+v"(t2)); const int tid = t2, lane = t2 & 63;
            const int rn = r + G;
            rg_agg_unit(lds, a, r / RG_UNITS_PER_B, r % RG_UNITS_PER_B, raw, rn / RG_UNITS_PER_B, rn < N_RG ? rn % RG_UNITS_PER_B : -1, tid, wave, lane, xr);
        }
    }
}
__device__ __forceinline__ void p_scan_b(const Args& a, int bid, int G, int tid, bool dry = false) {
#pragma unroll 1
    for (int it = bid; it < 1024; it += G) hg_carry_item(a, it, tid, dry);
    if (bid >= G - 32) rg_carry_item(a, bid - (G - 32), tid);
}
__device__ __forceinline__ void p_scan_c(LAS unsigned char* lds, const Args& a, int bid, int G, int tid, int wave, int lane, int mask = 3, int xm = 0) {
#pragma unroll 1
    for (int it = bid; it < ((mask & 1) ? 1024 : 0); it += G) { const int seg = it & 15, hd = (it >> 4) & 3, b = it >> 6; int t2 = tid; asm volatile("" : "+v"(t2)); hg_final_unit(lds, a, b, hd, seg, t2, wave, t2 & 63, xm); }
    if (mask & 2) {
        __syncthreads();
        u32x4 g[8], st[2][4];
        int r = bid;
        if (r < 1024) rg_final_load(g, st, a, r >> 6, r & 63, tid, wave, lane);
#pragma unroll 1
        for (; r < 1024; r += G) {
            int t2 = tid; asm volatile("" : "+v"(t2)); const int rn = r + G;
            rg_final_unit(lds, a, r >> 6, r & 63, g, st, rn >> 6, rn < 1024 ? (rn & 63) : -1, t2, wave, t2 & 63);
        }
    }
}

#define GAS __attribute__((address_space(1)))
#define RLX_AGENT __ATOMIC_RELAXED, __HIP_MEMORY_SCOPE_AGENT
#define XB_TMO      128
#define XB_XCNT(j)  (256  + 64 * (j))
#define XB_XSUB(j)  (1280 + 64 * (j))
#define XB_XGEN(j)  (2304 + 64 * (j))
#define XB_TOP      3328
#define XB_TOPGEN   3392
#define XCD_BAR_WORDS 3456
#define XB_SPIN_CAP (1u << 18)

__device__ __forceinline__ unsigned xb_ld(unsigned* p)              { return __hip_atomic_load(p, __ATOMIC_RELAXED, __HIP_MEMORY_SCOPE_AGENT); }
__device__ __forceinline__ unsigned xb_add(unsigned* p, unsigned v) { return __hip_atomic_fetch_add(p, v, __ATOMIC_RELAXED, __HIP_MEMORY_SCOPE_AGENT); }
__device__ __forceinline__ unsigned xb_xcc_id() { return (unsigned)__builtin_amdgcn_s_getreg((3 << 11) | 20) & 0xFu; }
#define XB_SPIN(cond, bar) do { unsigned _sp = 0; while (cond) { __builtin_amdgcn_s_sleep(1); \
    if ((++_sp & 255u) == 0u) { if (xb_ld(&(bar)[XB_TMO])) break; if (_sp > XB_SPIN_CAP) { atomicAdd(&(bar)[XB_TMO], 1u); break; } } } } while (0)

struct XcdBarrier {
    unsigned* bar; unsigned x;
    volatile LAS unsigned* st;
};

__device__ __forceinline__ XcdBarrier xcd_barrier_post(unsigned* bar, volatile LAS unsigned* st) {
    XcdBarrier b; b.bar = bar; b.x = xb_xcc_id(); b.st = st;
    if (threadIdx.x == 0) (void)xb_add(&bar[XB_XCNT(b.x)], 1u);
    return b;
}
__device__ __forceinline__ void xcd_barrier_complete(unsigned* bar, unsigned x, unsigned& nloc, unsigned& nx) {
    const unsigned G = gridDim.x * gridDim.y * gridDim.z;
    unsigned sum, cnt, mine, sp = 0u;
    for (;;) {
        sum = 0u; cnt = 0u; mine = 0u;
#pragma unroll
        for (unsigned j = 0; j < 16; ++j) { const unsigned c = xb_ld(&bar[XB_XCNT(j)]); sum += c; cnt += (c > 0u) ? 1u : 0u; mine = (j == x) ? c : mine; }
        if (sum == G) break;
        __builtin_amdgcn_s_sleep(1);
        if ((++sp & 255u) == 0u) { if (xb_ld(&bar[XB_TMO])) break; if (sp > XB_SPIN_CAP) { atomicAdd(&bar[XB_TMO], 1u); break; } }
    }
    nloc = mine > 0u ? mine : 1u; nx = cnt > 0u ? cnt : 1u;
}

__device__ __forceinline__ void xcd_barrier(const XcdBarrier& b) {
    asm volatile("s_waitcnt vmcnt(0)" ::: "memory");
    __syncthreads();
    if (threadIdx.x == 0) {
        unsigned* bar = b.bar;
        __builtin_amdgcn_s_waitcnt(0);
        unsigned nloc = b.st[0], nx = b.st[1];
        if (nloc == 0u) { xcd_barrier_complete(bar, b.x, nloc, nx); b.st[0] = nloc; b.st[1] = nx; }
        const unsigned old = xb_add(&bar[XB_XSUB(b.x)], 1u);
        const unsigned gen = old / nloc;
        if (old + 1u == (gen + 1u) * nloc) {
            __builtin_amdgcn_fence(__ATOMIC_RELEASE, "agent");
            asm volatile("s_waitcnt vmcnt(0)" ::: "memory");
            const unsigned og = xb_add(&bar[XB_TOP], 1u);
            const unsigned tg = og / nx;
            if (og + 1u == (tg + 1u) * nx) xb_add(&bar[XB_TOPGEN], 1u);
            else XB_SPIN(xb_ld(&bar[XB_TOPGEN]) == tg, bar);
            __builtin_amdgcn_fence(__ATOMIC_ACQUIRE, "agent");
            xb_add(&bar[XB_XGEN(b.x)], 1u);
            asm volatile("s_waitcnt vmcnt(0)" ::: "memory");
        } else {
            XB_SPIN(xb_ld(&bar[XB_XGEN(b.x)]) == gen, bar);
            __builtin_amdgcn_fence(__ATOMIC_ACQUIRE, "agent");
            asm volatile("s_waitcnt vmcnt(0)" ::: "memory");
        }
    }
    __syncthreads();
}


__device__ __forceinline__ void stagger_wait(unsigned ticks) {
    if (ticks == 0u) return;
    const unsigned long long t0 = __builtin_amdgcn_s_memrealtime();
    while (__builtin_amdgcn_s_memrealtime() - t0 < ticks) __builtin_amdgcn_s_sleep(16);
}
#ifndef STAG_P2
#define STAG_P2 0
#endif

__global__ void __launch_bounds__(NTHREADS, 2) mega(Args a) {
    extern __shared__ __attribute__((aligned(16))) unsigned char lds_raw[];
    LAS unsigned char* lds = (LAS unsigned char*)lds_raw;
    const int wave = __builtin_amdgcn_readfirstlane(threadIdx.x >> 6), bid = blockIdx.x, G = gridDim.x;
    int tid = threadIdx.x, lane = tid & 63;
#define FRESH_TID() do { tid = threadIdx.x; asm volatile("" : "+v"(tid)); lane = tid & 63; } while (0)
    unsigned char* ws = a.ws;
    volatile LAS unsigned* bst = (volatile LAS unsigned*)(lds + LDS_BYTES - 64);
    if (threadIdx.x < 2) bst[threadIdx.x] = 0u;
    __syncthreads();
    XcdBarrier xbar = xcd_barrier_post((unsigned*)(ws + WS_BAR), bst);
#define GRID_BAR() xcd_barrier(xbar)
    float* mod = (float*)(ws + WS_MOD);
    bf16_t* U = (bf16_t*)(ws + WS_U);
    bf16_t* PROJ = (bf16_t*)(ws + WS_PROJ); bf16_t* MIXED = (bf16_t*)(ws + WS_MIXED);

    p_mod(lds, a.in[1], a.in[3], a.in[4], a.in[5], mod, bid, G, tid);
    p_transposes(lds, a, bid, G, tid);
    p_gwt(a.in[9], (bf16_t*)(ws + WS_GWT), bid, G, tid);
    p_rgpar(a.in[10], a.in[11], (float*)(ws + WS_RGPAR), bid, G, tid);
    p_wrt(a.in[17], a.in[19], (bf16_t*)(ws + WS_WRT), bid, G, tid);
    GRID_BAR();
    FRESH_TID();
    p_u(a.in[0], a.in[2], mod, U, bid, G, tid);
    GRID_BAR();
    FRESH_TID();
    { pg8::Gemm g{U, (const bf16_t*)(ws + WS_WINT), TA, NIN, DM}; pg8::StaticOrder S; S.init(TA, NIN, G, bid);
      pg8::EpiInProj E{PROJ, 0, 0};
      pg8::gemm_phase<pg8::EpiInProj, pg8::StaticOrder, true, true>(lds, g, S, E); }
    GRID_BAR();
    FRESH_TID();
    p_scan_a(lds, a, bid, G, tid, wave, lane);
    GRID_BAR();
    FRESH_TID();
    p_scan_b(a, bid, G, tid);
    GRID_BAR();
    FRESH_TID();
    p_scan_c(lds, a, bid, G, tid, wave, lane);
    GRID_BAR();
    FRESH_TID();
    { pg8::Gemm g{MIXED, (const bf16_t*)(ws + WS_WOUTT), T, DM, DM}; pg8::StaticOrder S; S.init(T, DM, G, bid);
      pg8::EpiY E{(bf16_t*)(ws + WS_XG)};
      pg8::gemm_phase<pg8::EpiY, pg8::StaticOrder, true, true>(lds, g, S, E); }
    GRID_BAR();
    FRESH_TID();
    p_ln1_router(lds, a, bid, G, tid, wave, lane);
    GRID_BAR();
    FRESH_TID();
    p_assign(lds, a, bid, G, tid);
    GRID_BAR();
    FRESH_TID();
    { pg8::Gemm g{(const bf16_t*)(ws + WS_U), (const bf16_t*)(ws + WS_W13T), MAXROWS, NE * DM, DM}; pg8::ExpertOrderG S{(const int*)(ws + WS_RBPRE), (const int*)(ws + WS_ROWTOK), G, bid};
      pg8::EpiExp1 E{(bf16_t*)(ws + WS_HID)};
      pg8::gemm_phase<pg8::EpiExp1, pg8::ExpertOrderG, true, true>(lds, g, S, E); }
    GRID_BAR();
    FRESH_TID();
    { pg8::Gemm g{(const bf16_t*)(ws + WS_HID), (const bf16_t*)(ws + WS_W2T), MAXROWS, NE * DM, DE}; pg8::ExpertOrder S{(const int*)(ws + WS_RBPRE), nullptr, G, bid};
      pg8::EpiY E{(bf16_t*)(ws + WS_Y)};
      pg8::gemm_phase<pg8::EpiY, pg8::ExpertOrder, true, true>(lds, g, S, E); }
    GRID_BAR();
    FRESH_TID();
    p_combine_ln2(a, bid, G, wave, lane);
}

extern "C" void kernel_launch(void* const* d_in, const int* in_sizes, int n_in, void* d_out, int out_size, void* d_ws, size_t ws_size, hipStream_t stream) {
    static int grid = 0;
    if (grid == 0) {
        if (n_in != 26 || ws_size < WS_END) { fprintf(stderr, "kernel_launch: unexpected n_in %d or workspace %zu < %zu\n", n_in, ws_size, (size_t)WS_END); grid = -1; return; }
        int dev = 0, cus = 0, per_cu = 0;
        if (hipGetDevice(&dev) != hipSuccess || hipDeviceGetAttribute(&cus, hipDeviceAttributeMultiprocessorCount, dev) != hipSuccess) { grid = -1; return; }
        if (hipFuncSetAttribute((const void*)mega, hipFuncAttributeMaxDynamicSharedMemorySize, LDS_BYTES) != hipSuccess) { fprintf(stderr, "kernel_launch: hipFuncSetAttribute failed\n"); grid = -1; return; }
        if (hipOccupancyMaxActiveBlocksPerMultiprocessor(&per_cu, (const void*)mega, NTHREADS, LDS_BYTES) != hipSuccess || per_cu < 1) { fprintf(stderr, "kernel_launch: occupancy query says %d\n", per_cu); per_cu = 1; }
        (void)hipGetLastError();
        grid = cus;
        fprintf(stderr, "kernel_launch: grid %d (cus %d, per_cu %d), ws %zu\n", grid, cus, per_cu, ws_size);
    }
    if (grid < 0) return;
    (void)hipMemsetAsync(d_ws, 0, 131072, stream);
    Args a{};
    for (int i = 0; i < 26; ++i) a.in[i] = (const float*)d_in[i];
    a.out = (float*)d_out; a.ws = (unsigned char*)d_ws;
    void* params[] = {&a};
    hipError_t e = hipLaunchCooperativeKernel((const void*)mega, dim3(grid), dim3(NTHREADS), params, LDS_BYTES, stream);
    if (e != hipSuccess) fprintf(stderr, "kernel_launch: cooperative launch failed: %s (grid %d)\n", hipGetErrorString(e), grid);
}
```

```cpp
#include <hip/hip_runtime.h>
#include <hip/hip_cooperative_groups.h>
#include <cstdio>
#include <cstdint>
namespace cg = cooperative_groups;

typedef unsigned short bf16_t;
typedef short bf16x8 __attribute__((ext_vector_type(8)));
typedef float f32x4 __attribute__((ext_vector_type(4)));
typedef float f32x2 __attribute__((ext_vector_type(2)));
typedef unsigned u32x4 __attribute__((ext_vector_type(4)));
typedef unsigned u32x2 __attribute__((ext_vector_type(2)));
typedef int i32x4 __attribute__((ext_vector_type(4)));
#define LAS __attribute__((address_space(3)))

constexpr int NB = 16, SEQ = 4096, LC = 256, DM = 1024;
constexpr int T = NB * SEQ;
constexpr int TC = NB * LC;
constexpr int TA = T + TC;
constexpr int NIN = 3584;
constexpr int NE = 32, DE = 512;
constexpr int MAXROWS = 2 * T + NE * 256;
constexpr float ALPHA = 1.189207115002721f;
constexpr float LN_EPS = 1e-6f;
constexpr int NTHREADS = 512;

constexpr size_t MiB = 1u << 20;
constexpr size_t WS_CTL = 0;
constexpr size_t WS_BAR = 65536;
constexpr size_t WS_MOD = 1 * MiB;
constexpr size_t WS_EIDX = 3 * MiB;
constexpr size_t WS_EPOS = 3 * MiB + 512 * 1024;
constexpr size_t WS_EW = 4 * MiB;
constexpr size_t WS_DEST = 4 * MiB + 512 * 1024;
constexpr size_t WS_WINT = 6 * MiB;
constexpr size_t WS_WOUTT = 13 * MiB;
constexpr size_t WS_W13T = 15 * MiB;
constexpr size_t WS_W2T = 79 * MiB;
constexpr size_t WS_U = 112 * MiB;
constexpr size_t WS_PROJ = 248 * MiB;
constexpr size_t WS_XG = 248 * MiB;
constexpr size_t WS_HID = 520 * MiB;
constexpr size_t WS_Y = 656 * MiB;
constexpr size_t WS_MIXED = 724 * MiB;
constexpr size_t WS_OSUM = 852 * MiB;
constexpr size_t WS_END = 980 * MiB;
constexpr int LDS_BYTES = 163840;

__device__ __forceinline__ const bf16_t* proj_at(const bf16_t* P, int row, int col) { return P + (((size_t)(col >> 5) * TA + row) << 5) + (col & 31); }

template <class V> __device__ __forceinline__ V ntld(const V* p) { return __builtin_nontemporal_load(p); }
template <class V> __device__ __forceinline__ void ntst(V* p, V v) { __builtin_nontemporal_store(v, p); }

__device__ __forceinline__ float bf2f(bf16_t b) { return __uint_as_float(((unsigned)b) << 16); }
__device__ __forceinline__ bf16_t f2bf(float f) { unsigned u = __float_as_uint(f); return (bf16_t)((u + 0x7fffu + ((u >> 16) & 1u)) >> 16); }
__device__ __forceinline__ unsigned pk2(float lo, float hi) { unsigned r; asm volatile("v_cvt_pk_bf16_f32 %0, %1, %2" : "=v"(r) : "v"(lo), "v"(hi)); return r; }
__device__ __forceinline__ float frcp(float x) { return __builtin_amdgcn_rcpf(x); }
__device__ __forceinline__ float sigmoidf_(float x) { return frcp(1.0f + __expf(-x)); }
__device__ __forceinline__ float siluf_(float x) { return x * frcp(1.0f + __expf(-x)); }
__device__ __forceinline__ float gelu_tanh(float x) {
    const float y = 0.7978845608028654f * (x + 0.044715f * x * x * x);
    return x * frcp(1.0f + __expf(-2.0f * y));
}
__device__ __forceinline__ float softplusf_(float x) { return fmaxf(x, 0.f) + log1pf(expf(-fabsf(x))); }
__device__ __forceinline__ float wave_sum(float v) {
#pragma unroll
    for (int o = 1; o < 64; o <<= 1) v += __shfl_xor(v, o);
    return v;
}
constexpr int CSTR = 64;
__device__ __forceinline__ int pstart_of(const int* __restrict__ counts, int e) {
    int acc = 0;
    for (int i = 0; i < NE; ++i) { const int p = ((counts[i * CSTR] + 255) >> 8) << 8; if (i < e) acc += p; }
    return acc;
}

namespace pg8 {
#define PG8_LAS __attribute__((address_space(3)))
typedef unsigned short bf16_t;
typedef short bf16x8 __attribute__((ext_vector_type(8)));
typedef float f32x4 __attribute__((ext_vector_type(4)));
typedef unsigned u32x4 __attribute__((ext_vector_type(4)));
constexpr int BM = 256, BK = 64, HALF = 128, HTB = HALF * BK * 2  , STAGE_BYTES = 8 * HTB, NXCD = 8, WGM = 8;

__host__ __device__ __forceinline__ int lds_byte(int r, int c) { const int st = (r >> 4) * 2 + (c >> 5), rr = r & 15, cc = c & 31, ob = rr * 64 + cc * 2; return st * 1024 + (ob ^ (((ob >> 9) & 1) << 5)); }
__host__ __device__ __forceinline__ void stage_rc(int b, int& R, int& C) { const int st = b / 1024, sb = b % 1024, swz = sb ^ (((sb >> 9) & 1) << 5); R = (st >> 1) * 16 + swz / 64; C = (st & 1) * 32 + (swz % 64) / 2; }
__host__ __device__ __forceinline__ int perm32(int rho) { const int n = rho >> 4, i = rho & 15; return 8 * (i >> 2) + 4 * n + (i & 3); }

struct Unit { int pm, pn; };
struct Gemm { const bf16_t* A; const bf16_t* Bt; int M, N, K; };

struct StaticOrder {
    static constexpr bool GATHER = false; const int* rowtok = nullptr;
    int nM, nN, nwg, G, c;
    __host__ __device__ void init(int M, int N, int G_, int c_) { nM = M / BM; nN = N / BM; nwg = nM * nN; G = G_; c = c_; }
    __host__ __device__ bool next(int i, Unit& u) const {
        const long L = (long)i * G + c; if (L >= nwg) return false;
        int wgid = (int)L; { const int q = nwg / NXCD, r = nwg % NXCD, xcd = wgid % NXCD, off = wgid / NXCD; wgid = (xcd < r ? xcd * (q + 1) : r * (q + 1) + (xcd - r) * q) + off; }
        const int nig = WGM * nN, gid = wgid / nig, fm = gid * WGM, gsz = (nM - fm) < WGM ? (nM - fm) : WGM;
        u.pm = fm + ((wgid % nig) % gsz); u.pn = (wgid % nig) / gsz; return true;
    }
    __device__ __forceinline__ void a_ready(const Unit&) const {}
    __device__ __forceinline__ void done(const Unit&) const {}
};

__device__ __forceinline__ unsigned cvt_pk_bf16(float lo, float hi) { unsigned r; asm volatile("v_cvt_pk_bf16_f32 %0, %1, %2" : "=v"(r) : "v"(lo), "v"(hi)); return r; }

struct EpiInProj {
    static constexpr bool PERM = true, AFTER_DRAIN = false;
    bf16_t* P; int variant; int pad;
    __device__ __forceinline__ void operator()(const f32x4 (&acc)[2][2][4][2], const Unit& u, int wr, int wc, int fr_, int fq_) const {
        int fr = fr_, fq = fq_; asm volatile("" : "+v"(fr), "+v"(fq));
        const int row0 = u.pm * BM + wr * 64 + fr, col0 = u.pn * BM + wc * 32 + 8 * fq, grp = variant == 1 ? 0 : (u.pn >> 1);
#pragma unroll
        for (int ai = 0; ai < 2; ++ai)
#pragma unroll
            for (int m = 0; m < 4; ++m) { bf16_t* rowp = P + (((size_t)(8 * u.pn + wc) * TA + (row0 + ai * HALF + m * 16)) << 5) + 8 * fq;
#pragma unroll
                for (int bj = 0; bj < 2; ++bj) { f32x4 v0 = acc[ai][bj][m][0], v1 = acc[ai][bj][m][1];
                    if (grp == 1) {
#pragma unroll
                        for (int j = 0; j < 4; ++j) { v0[j] = gelu_tanh(v0[j]); v1[j] = gelu_tanh(v1[j]); } }
                    else if (grp == 2 || grp == 6) {
#pragma unroll
                        for (int j = 0; j < 4; ++j) { v0[j] = siluf_(v0[j]); v1[j] = siluf_(v1[j]); } }
                    u32x4 w; w.x = cvt_pk_bf16(v0[0], v0[1]); w.y = cvt_pk_bf16(v0[2], v0[3]); w.z = cvt_pk_bf16(v1[0], v1[1]); w.w = cvt_pk_bf16(v1[2], v1[3]);
                    if (variant == 3) { const int wv = __builtin_amdgcn_readfirstlane(threadIdx.x >> 6); *(u32x4*)(P + ((size_t)((u.pm * 14 + u.pn) * 8 + wv) * 16 + (ai * 4 + m) * 2 + bj) * 512 + (threadIdx.x & 63) * 8) = w; }
                    else if (variant != 2 || w.x == 0x12345678u) *(u32x4*)(rowp + (size_t)bj * 4 * TA * 32) = w; } }
    }
};
struct EpiNull {
    static constexpr bool PERM = true, AFTER_DRAIN = false;
    float* sink;
    __device__ __forceinline__ void operator()(const f32x4 (&acc)[2][2][4][2], const Unit& u, int wr, int wc, int fr_, int fq_) const {
        float s = 0.f;
#pragma unroll
        for (int ai = 0; ai < 2; ++ai)
#pragma unroll
            for (int bj = 0; bj < 2; ++bj)
#pragma unroll
                for (int m = 0; m < 4; ++m)
#pragma unroll
                    for (int n = 0; n < 2; ++n) s += acc[ai][bj][m][n][0] + acc[ai][bj][m][n][1] + acc[ai][bj][m][n][2] + acc[ai][bj][m][n][3];
        if (s == 123.456f) sink[0] = s;
    }
};
struct EpiF32 {
    static constexpr bool PERM = false, AFTER_DRAIN = false;
    float* C; int ldc; int pad;
    __device__ __forceinline__ void operator()(const f32x4 (&acc)[2][2][4][2], const Unit& u, int wr, int wc, int fr_, int fq_) const {
        int fr = fr_, fq = fq_; asm volatile("" : "+v"(fr), "+v"(fq));
        const int row0 = u.pm * BM + wr * 64 + fr, col0 = u.pn * BM + wc * 32 + 4 * fq;
#pragma unroll
        for (int ai = 0; ai < 2; ++ai)
#pragma unroll
            for (int m = 0; m < 4; ++m) { float* rowp = C + (size_t)(row0 + ai * HALF + m * 16) * ldc + col0;
#pragma unroll
                for (int bj = 0; bj < 2; ++bj)
#pragma unroll
                    for (int n = 0; n < 2; ++n) *(f32x4*)(rowp + bj * HALF + n * 16) = acc[ai][bj][m][n]; }
    }
};
struct EpiExp1 {
    static constexpr bool PERM = true, AFTER_DRAIN = false;
    bf16_t* H;
    __device__ __forceinline__ void operator()(const f32x4 (&acc)[2][2][4][2], const Unit& u, int wr, int wc, int fr_, int fq_) const {
        int fr = fr_, fq = fq_; asm volatile("" : "+v"(fr), "+v"(fq));
        const int row0 = u.pm * BM + wr * 64 + fr, hc0 = (u.pn & 3) * 128 + wc * 32 + 8 * fq;
#pragma unroll
        for (int ai = 0; ai < 2; ++ai)
#pragma unroll
            for (int m = 0; m < 4; ++m) { bf16_t* rowp = H + (size_t)(row0 + ai * HALF + m * 16) * DE + hc0;
                const f32x4 a0 = acc[ai][0][m][0], a1 = acc[ai][0][m][1], b0 = acc[ai][1][m][0], b1 = acc[ai][1][m][1];
                u32x4 w; w.x = cvt_pk_bf16(siluf_(a0[0]) * b0[0], siluf_(a0[1]) * b0[1]); w.y = cvt_pk_bf16(siluf_(a0[2]) * b0[2], siluf_(a0[3]) * b0[3]);
                w.z = cvt_pk_bf16(siluf_(a1[0]) * b1[0], siluf_(a1[1]) * b1[1]); w.w = cvt_pk_bf16(siluf_(a1[2]) * b1[2], siluf_(a1[3]) * b1[3]);
                *(u32x4*)rowp = w; }
    }
};
struct EpiY {
    static constexpr bool PERM = true, AFTER_DRAIN = false;
    bf16_t* Y;
    __device__ __forceinline__ void operator()(const f32x4 (&acc)[2][2][4][2], const Unit& u, int wr, int wc, int fr_, int fq_) const {
        int fr = fr_, fq = fq_; asm volatile("" : "+v"(fr), "+v"(fq));
        const int row0 = u.pm * BM + wr * 64 + fr, col0 = (u.pn & 3) * BM + wc * 32 + 8 * fq;
#pragma unroll
        for (int ai = 0; ai < 2; ++ai)
#pragma unroll
            for (int m = 0; m < 4; ++m) { bf16_t* rowp = Y + (size_t)(row0 + ai * HALF + m * 16) * DM + col0;
#pragma unroll
                for (int bj = 0; bj < 2; ++bj) { const f32x4 v0 = acc[ai][bj][m][0], v1 = acc[ai][bj][m][1];
                    u32x4 w; w.x = cvt_pk_bf16(v0[0], v0[1]); w.y = cvt_pk_bf16(v0[2], v0[3]); w.z = cvt_pk_bf16(v1[0], v1[1]); w.w = cvt_pk_bf16(v1[2], v1[3]);
                    *(u32x4*)(rowp + bj * HALF) = w; } }
    }
};
struct InProjOrder {
    static constexpr bool GATHER = false; const int* rowtok = nullptr;
    StaticOrder lat; int G, c;
    __device__ __forceinline__ void init(int G_, int c_) { lat.init(T, NIN, G_, c_); G = G_; c = c_; }
    __device__ __forceinline__ bool next(int i, Unit& u) const {
        const int L = i * G + c;
        if (L < lat.nwg) return lat.next(i, u);
        const int r = L - lat.nwg; if (r >= 16 * 8) return false;
        const int ct = r & 7; u.pm = 256 + (r >> 3); u.pn = ct < 2 ? ct : (ct < 6 ? ct + 4 : ct + 4);
        return true;
    }
    __device__ __forceinline__ void a_ready(const Unit&) const {}
    __device__ __forceinline__ void done(const Unit&) const {}
};
template <bool GATHER_>
struct ExpertOrderT {
    static constexpr bool GATHER = GATHER_;
    const int* rbpre; const int* rowtok; int G, c;
    __device__ __forceinline__ bool next(int i, Unit& u) const {
        const int cs = (G & 7) == 0 ? (c & 7) * (G >> 3) + (c >> 3) : c;
        const int L = i * G + cs, rb = L >> 2; int ef = -1;
        for (int e = 0; e < NE; ++e) { if (rb >= rbpre[e] && rb < rbpre[e + 1]) ef = e; }
        if (ef < 0) return false;
        u.pm = rb; u.pn = ef * 4 + (L & 3); return true;
    }
    __device__ __forceinline__ void a_ready(const Unit&) const {}
    __device__ __forceinline__ void done(const Unit&) const {}
};
typedef ExpertOrderT<false> ExpertOrder;
typedef ExpertOrderT<true> ExpertOrderG;

template <class Epi, class Sched, bool ALIGN_EPI = false, bool SP2 = false>
__device__ __forceinline__ void gemm_phase(PG8_LAS unsigned char* lds, const Gemm g, const Sched& S, const Epi& E) {
    int tid_o = threadIdx.x; asm volatile("" : "+v"(tid_o));
    const int tid = tid_o, wid = __builtin_amdgcn_readfirstlane(tid >> 6), lane = tid & 63, wr = wid >> 2, wc = wid & 3, fr = lane & 15, fq = lane >> 4;
    static_assert(SP2 || !Sched::GATHER, "the gathered A operand is wired into the SP2 loop only");
    const int K = g.K, nt = K / BK;
    unsigned voffA[2], voffB[2];
    unsigned gAc[2][2], gAn[2][2]; int gR[2], gC[2];
#pragma unroll
    for (int i = 0; i < 2; ++i) { int R, C; stage_rc(tid * 16 + i * 8192, R, C); const int Rb = Epi::PERM ? ((R & ~31) + perm32(R & 31)) : R;
        voffA[i] = (unsigned)(R * K + C) * 2u; voffB[i] = (unsigned)(Rb * K + C) * 2u; gR[i] = R; gC[i] = C; }
    const size_t kstep = (size_t)(BK * 2);
    const size_t hstep = (size_t)HALF * K * 2;
    const size_t tstep = 2 * hstep;
    const unsigned ldsw = (unsigned)wid * 1024u;
    const int aoff = lds_byte(wr * 64 + fr, fq * 8), boff = lds_byte(wc * 32 + fr, fq * 8);
#define PG8_SA(b, h) (((b) * 2 + (h)) * HTB)
#define PG8_SB(b, h) ((4 + (b) * 2 + (h)) * HTB)
#define PG8_STAGE(bufoff, gbase, voff) do { _Pragma("unroll") for (int _i = 0; _i < 2; ++_i) \
        __builtin_amdgcn_global_load_lds((const unsigned*)((const char*)(gbase) + (voff)[_i]), (PG8_LAS unsigned*)(lds + (bufoff) + ldsw + _i * 8192), 16, 0, 0); } while (0)
#define PG8_STAGE_A(bufoff, ptr, h, goff) do { if constexpr (Sched::GATHER) { PG8_STAGE(bufoff, ptr, (goff)[h]); } else { PG8_STAGE(bufoff, (ptr) + (h) * hstep, voffA); } } while (0)
#define PG8_GLOAD(dst, u) do { _Pragma("unroll") for (int _h = 0; _h < 2; ++_h) _Pragma("unroll") for (int _i = 0; _i < 2; ++_i) \
        dst[_h][_i] = (unsigned)S.rowtok[(u).pm * BM + _h * HALF + gR[_i]] * (unsigned)(K * 2) + (unsigned)(gC[_i] * 2); } while (0)
#define PG8_LDA(dst, b, h) do { _Pragma("unroll") for (int m = 0; m < 4; ++m) _Pragma("unroll") for (int k = 0; k < 2; ++k) dst[m][k] = *(const PG8_LAS bf16x8*)(lds + PG8_SA(b, h) + aoff + m * 2048 + k * 1024); } while (0)
#define PG8_LDB(dst, b, h) do { _Pragma("unroll") for (int n = 0; n < 2; ++n) _Pragma("unroll") for (int k = 0; k < 2; ++k) dst[n][k] = *(const PG8_LAS bf16x8*)(lds + PG8_SB(b, h) + boff + n * 2048 + k * 1024); } while (0)
#define PG8_MMA(ai, bj, At, Bt) do { __builtin_amdgcn_s_setprio(1); _Pragma("unroll") for (int m = 0; m < 4; ++m) _Pragma("unroll") for (int n = 0; n < 2; ++n) _Pragma("unroll") for (int k = 0; k < 2; ++k) \
        acc[ai][bj][m][n] = __builtin_amdgcn_mfma_f32_16x16x32_bf16(Bt[n][k], At[m][k], acc[ai][bj][m][n], 0, 0, 0); __builtin_amdgcn_s_setprio(0); } while (0)
#define PG8_WAIT_V(n) asm volatile("s_waitcnt vmcnt(" #n ")" ::: "memory")
#define PG8_WAIT_L(n) asm volatile("s_waitcnt lgkmcnt(" #n ")" ::: "memory")
#define PG8_BAR __builtin_amdgcn_s_barrier()
#define PG8_SCHED __builtin_amdgcn_sched_barrier(0)
    Unit cur, nxt; int ui = 0;
    if (!S.next(0, cur)) return;
    f32x4 acc[2][2][4][2];
#pragma unroll
    for (int a = 0; a < 2; ++a)
#pragma unroll
        for (int b = 0; b < 2; ++b)
#pragma unroll
            for (int m = 0; m < 4; ++m)
#pragma unroll
                for (int n = 0; n < 2; ++n) acc[a][b][m][n] = (f32x4){0.f, 0.f, 0.f, 0.f};
    bf16x8 At[4][2], B0[2][2], B1[2][2];
    const char* cA = (const char*)g.A + (Sched::GATHER ? (size_t)0 : (size_t)cur.pm * tstep); const char* cB = (const char*)g.Bt + (size_t)cur.pn * tstep;
    if constexpr (Sched::GATHER) { PG8_GLOAD(gAc, cur); }
    S.a_ready(cur);
    if constexpr (SP2) {
        PG8_STAGE(PG8_SB(0, 0), cB, voffB); PG8_STAGE(PG8_SB(0, 1), cB + hstep, voffB); PG8_STAGE_A(PG8_SA(0, 0), cA, 0, gAc); PG8_STAGE_A(PG8_SA(0, 1), cA, 1, gAc);
        if (wr == 1) PG8_BAR;
        PG8_WAIT_V(2); PG8_BAR;
        PG8_STAGE(PG8_SB(1, 0), cB + kstep, voffB); PG8_STAGE_A(PG8_SA(1, 0), cA + kstep, 0, gAc); PG8_STAGE(PG8_SB(1, 1), cB + hstep + kstep, voffB);
        PG8_WAIT_V(6); PG8_BAR;
    } else {
        PG8_STAGE(PG8_SB(0, 0), cB, voffB); PG8_STAGE(PG8_SA(0, 0), cA, voffA); PG8_STAGE(PG8_SB(0, 1), cB + hstep, voffB); PG8_STAGE(PG8_SA(0, 1), cA + hstep, voffA);
        if (wr == 1) PG8_BAR;
        PG8_WAIT_V(4); PG8_BAR;
        PG8_STAGE(PG8_SB(1, 0), cB + kstep, voffB); PG8_STAGE(PG8_SA(1, 0), cA + kstep, voffA); PG8_STAGE(PG8_SB(1, 1), cB + hstep + kstep, voffB);
        PG8_WAIT_V(6); PG8_BAR;
    }
    for (;;) {
        const bool has_next = S.next(ui + 1, nxt);
        const char* nA = (has_next && !Sched::GATHER) ? (const char*)g.A + (size_t)nxt.pm * tstep : cA;
        if constexpr (Sched::GATHER) { if (has_next) { PG8_GLOAD(gAn, nxt); } else { _Pragma("unroll") for (int _h = 0; _h < 2; ++_h) _Pragma("unroll") for (int _i = 0; _i < 2; ++_i) gAn[_h][_i] = gAc[_h][_i]; } }
        const char* nB = has_next ? (const char*)g.Bt + (size_t)nxt.pn * tstep : cB;
        for (int t = 0; t < nt; t += 2) {
            const bool last = (t == nt - 2);
            const char* a1 = cA + (size_t)(t + 1) * kstep;
            const char* a2 = last ? nA : cA + (size_t)(t + 2) * kstep; const char* b2 = last ? nB : cB + (size_t)(t + 2) * kstep;
            const char* a3 = a2 + kstep; const char* b3 = b2 + kstep;
            if (last && has_next) S.a_ready(nxt);
            unsigned g2[2][2];
            if constexpr (Sched::GATHER) { _Pragma("unroll") for (int _h = 0; _h < 2; ++_h) _Pragma("unroll") for (int _i = 0; _i < 2; ++_i) g2[_h][_i] = last ? gAn[_h][_i] : gAc[_h][_i]; }
            if constexpr (SP2) {
            PG8_LDB(B0, 0, 0); PG8_LDB(B1, 0, 1); PG8_SCHED; PG8_LDA(At, 0, 0); PG8_STAGE_A(PG8_SA(1, 1), a1, 1, gAc);
            PG8_WAIT_V(8); PG8_WAIT_L(0); PG8_BAR; PG8_MMA(0, 0, At, B0); PG8_MMA(0, 1, At, B1); PG8_BAR; PG8_SCHED;
            PG8_LDA(At, 0, 1); PG8_STAGE(PG8_SB(0, 0), b2, voffB); PG8_STAGE(PG8_SB(0, 1), b2 + hstep, voffB); PG8_STAGE_A(PG8_SA(0, 0), a2, 0, g2);
            PG8_WAIT_V(8); PG8_WAIT_L(0); PG8_BAR; PG8_MMA(1, 0, At, B0); PG8_MMA(1, 1, At, B1); PG8_BAR; PG8_SCHED;
            PG8_LDB(B0, 1, 0); PG8_LDB(B1, 1, 1); PG8_SCHED; PG8_LDA(At, 1, 0); PG8_STAGE_A(PG8_SA(0, 1), a2, 1, g2);
            PG8_WAIT_V(8); PG8_WAIT_L(0); PG8_BAR; PG8_MMA(0, 0, At, B0); PG8_MMA(0, 1, At, B1); PG8_BAR; PG8_SCHED;
            PG8_LDA(At, 1, 1); PG8_STAGE(PG8_SB(1, 0), b3, voffB); PG8_STAGE(PG8_SB(1, 1), b3 + hstep, voffB); PG8_STAGE_A(PG8_SA(1, 0), a3, 0, g2);
            PG8_WAIT_V(8); PG8_WAIT_L(0); PG8_BAR; PG8_MMA(1, 0, At, B0); PG8_MMA(1, 1, At, B1); PG8_BAR; PG8_SCHED;
            } else {
            PG8_LDB(B0, 0, 0); PG8_SCHED; PG8_LDA(At, 0, 0); PG8_STAGE(PG8_SA(1, 1), a1 + hstep, voffA);
            PG8_WAIT_L(8); PG8_BAR; PG8_WAIT_L(0); PG8_MMA(0, 0, At, B0); PG8_BAR; PG8_SCHED;
            PG8_LDB(B1, 0, 1); PG8_STAGE(PG8_SB(0, 0), b2, voffB);
            PG8_BAR; PG8_WAIT_L(0); PG8_MMA(0, 1, At, B1); PG8_BAR;
            PG8_LDA(At, 0, 1); PG8_STAGE(PG8_SA(0, 0), a2, voffA);
            PG8_BAR; PG8_WAIT_L(0); PG8_MMA(1, 0, At, B0); PG8_BAR; PG8_SCHED;
            PG8_STAGE(PG8_SB(0, 1), b2 + hstep, voffB);
            PG8_WAIT_V(6); PG8_BAR; PG8_MMA(1, 1, At, B1); PG8_BAR;
            PG8_LDB(B0, 1, 0); PG8_SCHED; PG8_LDA(At, 1, 0); PG8_STAGE(PG8_SA(0, 1), a2 + hstep, voffA);
            PG8_WAIT_L(8); PG8_BAR; PG8_WAIT_L(0); PG8_MMA(0, 0, At, B0); PG8_BAR; PG8_SCHED;
            PG8_LDB(B1, 1, 1); PG8_STAGE(PG8_SB(1, 0), b3, voffB);
            PG8_BAR; PG8_WAIT_L(0); PG8_MMA(0, 1, At, B1); PG8_BAR;
            PG8_LDA(At, 1, 1); PG8_STAGE(PG8_SA(1, 0), a3, voffA);
            PG8_BAR; PG8_WAIT_L(0); PG8_MMA(1, 0, At, B0); PG8_BAR; PG8_SCHED;
            PG8_STAGE(PG8_SB(1, 1), b3 + hstep, voffB);
            PG8_WAIT_V(6); PG8_BAR; PG8_MMA(1, 1, At, B1); PG8_BAR;
            }
        }
        if constexpr (ALIGN_EPI) { if (wr == 0) PG8_BAR; }
        if constexpr (!Epi::AFTER_DRAIN) { E(acc, cur, wr, wc, fr, fq); S.done(cur); }
        if (!has_next) break;
#pragma unroll
        for (int a = 0; a < 2; ++a)
#pragma unroll
            for (int b = 0; b < 2; ++b)
#pragma unroll
                for (int m = 0; m < 4; ++m)
#pragma unroll
                    for (int n = 0; n < 2; ++n) acc[a][b][m][n] = (f32x4){0.f, 0.f, 0.f, 0.f};
        cur = nxt; cA = nA; cB = nB; ++ui;
        if constexpr (Sched::GATHER) { _Pragma("unroll") for (int _h = 0; _h < 2; ++_h) _Pragma("unroll") for (int _i = 0; _i < 2; ++_i) gAc[_h][_i] = gAn[_h][_i]; }
        if constexpr (ALIGN_EPI) { if (wr == 1) PG8_BAR; }
    }
    PG8_WAIT_V(0);
    if constexpr (!ALIGN_EPI) { if (wr == 0) PG8_BAR; }
    PG8_BAR;
    if constexpr (Epi::AFTER_DRAIN) { E.fused(acc, cur, wr, wc, fr, fq, lds, wid, lane); S.done(cur); }
#undef PG8_SA
#undef PG8_SB
#undef PG8_STAGE
#undef PG8_STAGE_A
#undef PG8_GLOAD
#undef PG8_LDA
#undef PG8_LDB
#undef PG8_MMA
#undef PG8_WAIT_V
#undef PG8_WAIT_L
#undef PG8_BAR
#undef PG8_SCHED
}
}

struct Args { const float* in[26]; float* out; unsigned char* ws; };

__device__ __forceinline__ void p_mod(LAS unsigned char* lds, const float* __restrict__ c, const float* __restrict__ c_ctx, const float* __restrict__ ada_w,
                                      const float* __restrict__ ada_b, float* __restrict__ mod, int bid, int G, int tid) {
    if (bid >= 96) return;
    LAS float* s = (LAS float*)lds;
    LAS float* red = s + 17 * 1024;
    for (int i = tid; i < 17 * 1024; i += NTHREADS) { const int r = i >> 10, k = i & 1023; const float v = r < NB ? c[r * DM + k] : c_ctx[k]; s[i] = v / (1.0f + expf(-v)); }
    __syncthreads();
    for (int it = bid; it < 96; it += G) {
        const int cc = tid & 63, kg = tid >> 6, col = it * 64 + cc;
        float acc[17];
#pragma unroll
        for (int r = 0; r < 17; ++r) acc[r] = 0.f;
        for (int k = kg * 128; k < kg * 128 + 128; ++k) {
            const float w = ntld(ada_w + (size_t)k * 6144 + col);
#pragma unroll
            for (int r = 0; r < 17; ++r) acc[r] += s[r * 1024 + k] * w;
        }
#pragma unroll
        for (int r = 0; r < 17; ++r) red[(kg * 17 + r) * 64 + cc] = acc[r];
        __syncthreads();
        for (int i = tid; i < 17 * 64; i += NTHREADS) {
            const int r = i >> 6, c2 = i & 63; float sum = 0.f;
#pragma unroll
            for (int g = 0; g < 8; ++g) sum += red[(g * 17 + r) * 64 + c2];
            mod[(size_t)r * 6144 + it * 64 + c2] = sum + ada_b[it * 64 + c2];
        }
        __syncthreads();
    }
}

struct TrTile { const float* W; bf16_t* O; int K, N, mode, k0, n0; };
__device__ __forceinline__ TrTile tr_decode(const Args& a, int r) {
    unsigned char* ws = a.ws;
    constexpr int I_IN = 16 * 56, I_OUT = 16 * 16, I_E = 32 * 128;
    TrTile t;
    if (r < I_IN) { t = TrTile{a.in[6], (bf16_t*)(ws + WS_WINT), DM, NIN, 0, (r & 15) * 64, (r >> 4) * 64}; return t; } r -= I_IN;
    if (r < I_OUT) { t = TrTile{a.in[14], (bf16_t*)(ws + WS_WOUTT), DM, DM, 0, (r & 15) * 64, (r >> 4) * 64}; return t; } r -= I_OUT;
    if (r < I_E) { const int e = r >> 7, q = r & 127; t = TrTile{a.in[21] + (size_t)e * DM * DE, (bf16_t*)(ws + WS_W13T) + (size_t)e * DM * DM, DM, DE, 1, (q & 15) * 64, (q >> 4) * 64}; return t; } r -= I_E;
    if (r < I_E) { const int e = r >> 7, q = r & 127; t = TrTile{a.in[22] + (size_t)e * DM * DE, (bf16_t*)(ws + WS_W13T) + (size_t)e * DM * DM, DM, DE, 2, (q & 15) * 64, (q >> 4) * 64}; return t; } r -= I_E;
    { const int e = r >> 7, q = r & 127; t = TrTile{a.in[23] + (size_t)e * DE * DM, (bf16_t*)(ws + WS_W2T) + (size_t)e * DM * DE, DE, DM, 0, (q & 7) * 64, (q >> 3) * 64}; return t; }
}
__device__ __forceinline__ void p_transposes(LAS unsigned char* lds, const Args& a, int bid, int G, int tid) {
    constexpr int NITEMS = (16 * 56 + 16 * 16 + 3 * 32 * 128) / 4;
    const int lrow = tid >> 4, lc4 = (tid & 15) * 4;
    const int sc = tid & 7, sn = tid >> 3;
    for (int it = bid; it < NITEMS; it += G) {
        f32x4 v[4][2]; TrTile t[4];
#pragma unroll
        for (int q = 0; q < 4; ++q) { t[q] = tr_decode(a, it * 4 + q);
#pragma unroll
            for (int h = 0; h < 2; ++h) v[q][h] = ntld((const f32x4*)(t[q].W + (size_t)(t[q].k0 + lrow + 32 * h) * t[q].N + t[q].n0 + lc4)); }
        __syncthreads();
#pragma unroll
        for (int q = 0; q < 4; ++q) { LAS float* tile = (LAS float*)lds + q * (64 * 65);
#pragma unroll
            for (int h = 0; h < 2; ++h)
#pragma unroll
                for (int j = 0; j < 4; ++j) tile[(lrow + 32 * h) * 65 + lc4 + j] = v[q][h][j]; }
        __syncthreads();
#pragma unroll
        for (int q = 0; q < 4; ++q) { const LAS float* tile = (const LAS float*)lds + q * (64 * 65) + (8 * sc) * 65 + sn;
            const int n = t[q].n0 + sn, mode = t[q].mode;
            const int orow = mode == 0 ? n : ((n >> 7) * 256 + (mode == 2 ? 128 : 0) + (n & 127));
            u32x4 w; w.x = pk2(tile[0 * 65], tile[1 * 65]); w.y = pk2(tile[2 * 65], tile[3 * 65]); w.z = pk2(tile[4 * 65], tile[5 * 65]); w.w = pk2(tile[6 * 65], tile[7 * 65]);
            *(u32x4*)(t[q].O + (size_t)orow * t[q].K + t[q].k0 + 8 * sc) = w; }
    }
    __syncthreads();
}

__device__ __forceinline__ void p_u(const float* __restrict__ x, const float* __restrict__ ctx, const float* __restrict__ mod, bf16_t* __restrict__ U, int bid, int G, int tid) {
    const int lane = tid & 63, wave = tid >> 6;
    f32x4 vn[2][4];
    int row0 = bid * 16;
#pragma unroll
    for (int q = 0; q < 2; ++q) { const int row = row0 + wave * 2 + q; const float* src = row < T ? x + (size_t)row * DM : ctx + (size_t)(row - T) * DM;
#pragma unroll
        for (int j = 0; j < 4; ++j) vn[q][j] = ntld((const f32x4*)(src + 4 * lane + 256 * j)); }
#pragma unroll 1
    for (; row0 < TA; row0 += G * 16) {
        f32x4 v[2][4];
#pragma unroll
        for (int q = 0; q < 2; ++q)
#pragma unroll
            for (int j = 0; j < 4; ++j) v[q][j] = vn[q][j];
        if (row0 + G * 16 < TA) {
#pragma unroll
            for (int q = 0; q < 2; ++q) { const int row = row0 + G * 16 + wave * 2 + q; const float* src = row < T ? x + (size_t)row * DM : ctx + (size_t)(row - T) * DM;
#pragma unroll
                for (int j = 0; j < 4; ++j) vn[q][j] = ntld((const f32x4*)(src + 4 * lane + 256 * j)); }
        }
#pragma unroll
        for (int q = 0; q < 2; ++q) { const int row = row0 + wave * 2 + q; const float* m = mod + (size_t)(row < T ? row / SEQ : 16) * 6144;
#pragma unroll
            for (int j = 0; j < 4; ++j) { const int c4 = 4 * lane + 256 * j;
                const f32x4 sh = *(const f32x4*)(m + c4), sc = *(const f32x4*)(m + 1024 + c4);
                const f32x4 u = v[q][j] * (1.0f + sc) + sh;
                u32x2 w; w.x = pk2(u[0], u[1]); w.y = pk2(u[2], u[3]);
                *(u32x2*)(U + (size_t)row * DM + c4) = w; } }
    }
}

constexpr size_t WS_H1 = WS_XG + 128 * MiB;
constexpr size_t WS_WRT = 878 * MiB;
__device__ __forceinline__ void p_wrt(const float* __restrict__ rgw, const float* __restrict__ rew, bf16_t* __restrict__ wrt, int bid, int G, int tid) {
    for (int o = bid * NTHREADS + tid; o < 48 * 1024; o += G * NTHREADS) { const int e = o >> 10, k = o & 1023;
        const float w = e < 4 ? rgw[k * 4 + e] : (e < 36 ? rew[k * 32 + (e - 4)] : 0.f);
        const bf16_t hi = f2bf(w); wrt[o] = hi; wrt[48 * 1024 + o] = f2bf(w - bf2f(hi)); }
}
__device__ __forceinline__ void p_ln1_router(LAS unsigned char* lds, const Args& a, int bid, int G, int tid, int wave, int lane, bool dry = false, int parts = 3) {
    const float* __restrict__ x = a.in[0]; const bf16_t* yb = (const bf16_t*)(a.ws + WS_XG); bf16_t* h1o = (bf16_t*)(a.ws + (dry ? WS_HID : WS_H1)); const float* mod = (const float*)(a.ws + WS_MOD);
    const float* __restrict__ ln_g = a.in[15]; const float* __restrict__ ln_b = a.in[16]; const float* __restrict__ rgb = a.in[18]; const float* __restrict__ reb = a.in[20];
    bf16_t* U2 = (bf16_t*)(a.ws + (dry ? WS_Y + 16 * MiB : WS_U)); int* counts = (int*)(a.ws + WS_CTL) + (dry ? 32 * CSTR : 0);
    int2* eidx = (int2*)(a.ws + (dry ? WS_Y : WS_EIDX)); int2* epos = (int2*)(a.ws + (dry ? WS_Y + 4 * MiB : WS_EPOS)); float2* ew = (float2*)(a.ws + (dry ? WS_Y + 8 * MiB : WS_EW));
    const bf16_t* __restrict__ wrt = (const bf16_t*)(a.ws + WS_WRT);
    constexpr int WB_STRIDE = 528;
    LAS unsigned char* WB = lds;
    LAS float* LG = (LAS float*)(lds + 51200);
    LAS int* lcnt = (LAS int*)(lds + 102400);
    LAS int* lbase = lcnt + 32;
    LAS i32x4* tinfo = (LAS i32x4*)(lbase + 32);
    LAS f32x2* tw = (LAS f32x2*)(tinfo + 256);
    if (tid < 32) lcnt[tid] = 0;
    for (int blk = bid; blk < T / 256; blk += G) {
        static_assert(SEQ == 4096 && T / 256 == 256, "token grouping of the LN1/router phase");
        const int tok00 = (blk >> 4) * SEQ + (blk & 15) * 16;
        const float* m = mod + (size_t)(blk >> 4) * 6144;
        if (parts & 1) {
            f32x4 xr[2][4]; u32x2 yr[2][4];
            f32x4 g1v[4], lgv[4], lbv[4], sc2v[4], sh2v[4];
#pragma unroll
            for (int j = 0; j < 4; ++j) { const int c4 = 4 * lane + 256 * j;
                g1v[j] = *(const f32x4*)(m + 2048 + c4); lgv[j] = *(const f32x4*)(ln_g + c4); lbv[j] = *(const f32x4*)(ln_b + c4); sc2v[j] = 1.0f + *(const f32x4*)(m + 4096 + c4); sh2v[j] = *(const f32x4*)(m + 3072 + c4); }
#pragma unroll
            for (int t = 0; t < 2; ++t)
#pragma unroll
                for (int j = 0; j < 4; ++j) { const int c4 = 4 * lane + 256 * j; const int tok = tok00 + wave * 2 + t;
                    xr[t][j] = ntld((const f32x4*)(x + (size_t)tok * DM + c4)); yr[t][j] = ntld((const u32x2*)(yb + (size_t)tok * DM + c4)); }
#pragma unroll 1
            for (int it = 0; it < 16; ++it) {
                int l2 = lane; asm volatile("" : "+v"(l2)); const int lane = l2;
                const int tok0 = tok00 + it * 256 + wave * 2;
                f32x4 v[2][4]; float s[2] = {0.f, 0.f};
#pragma unroll
                for (int t = 0; t < 2; ++t)
#pragma unroll
                    for (int j = 0; j < 4; ++j) { const int c4 = 4 * lane + 256 * j;
                        const f32x4 g1 = g1v[j]; const u32x2 yw = yr[t][j];
                        const f32x4 yv = (f32x4){__uint_as_float(yw.x << 16), __uint_as_float(yw.x & 0xffff0000u), __uint_as_float(yw.y << 16), __uint_as_float(yw.y & 0xffff0000u)};
                        v[t][j] = ALPHA * xr[t][j] + g1 * yv; s[t] += (v[t][j][0] + v[t][j][1]) + (v[t][j][2] + v[t][j][3]); }
                if (it < 15) {
#pragma unroll
                    for (int t = 0; t < 2; ++t)
#pragma unroll
                        for (int j = 0; j < 4; ++j) { const int c4 = 4 * lane + 256 * j; const int tok = tok0 + 256 + t;
                            xr[t][j] = ntld((const f32x4*)(x + (size_t)tok * DM + c4)); yr[t][j] = ntld((const u32x2*)(yb + (size_t)tok * DM + c4)); }
                }
                float rstd[2];
#pragma unroll
                for (int t = 0; t < 2; ++t) { const float mean = wave_sum(s[t]) * (1.0f / DM); float s2 = 0.f;
#pragma unroll
                    for (int j = 0; j < 4; ++j) { v[t][j] = v[t][j] - mean; s2 += (v[t][j][0] * v[t][j][0] + v[t][j][1] * v[t][j][1]) + (v[t][j][2] * v[t][j][2] + v[t][j][3] * v[t][j][3]); }
                    rstd[t] = rsqrtf(wave_sum(s2) * (1.0f / DM) + LN_EPS); }
#pragma unroll
                for (int j = 0; j < 4; ++j) { const int c4 = 4 * lane + 256 * j;
                    const f32x4 lg = lgv[j], lb = lbv[j], sc2p = sc2v[j], sh2 = sh2v[j];
#pragma unroll
                    for (int t = 0; t < 2; ++t) { const f32x4 h1 = v[t][j] * rstd[t] * lg + lb;
                        u32x2 hw; hw.x = pk2(h1[0], h1[1]); hw.y = pk2(h1[2], h1[3]);
                        ntst((u32x2*)(h1o + (size_t)(tok0 + t) * DM + c4), hw);
                        const f32x4 u2 = h1 * sc2p + sh2;
                        u32x2 w; w.x = pk2(u2[0], u2[1]); w.y = pk2(u2[2], u2[3]);
                        *(u32x2*)(U2 + (size_t)(tok0 + t) * DM + c4) = w; }
                }
            }
        }
        __syncthreads();
        __builtin_amdgcn_fence(__ATOMIC_ACQUIRE, "agent");
        asm volatile("s_waitcnt vmcnt(0)" ::: "memory");
        const int fr = lane & 15, fq = lane >> 4;
        if (parts & 2) {
            f32x4 acc[2][3];
#pragma unroll
            for (int gi = 0; gi < 2; ++gi)
#pragma unroll
                for (int nt = 0; nt < 3; ++nt) acc[gi][nt] = (f32x4){0.f, 0.f, 0.f, 0.f};
            const bf16_t* arow0 = U2 + (size_t)(tok00 + (wave * 2 + 0) * 256 + fr) * DM + fq * 8;
            const bf16_t* arow1 = arow0 + (size_t)256 * DM;
#pragma unroll 1
            for (int ch = 0; ch < 4; ++ch) {
                u32x4 wreg[6];
#pragma unroll
                for (int p = 0; p < 6; ++p) { const int idx = p * NTHREADS + tid, row = idx >> 5, piece = idx & 31;
                    wreg[p] = *(const u32x4*)(wrt + (size_t)row * 1024 + ch * 256 + piece * 8); }
                __syncthreads();
#pragma unroll
                for (int p = 0; p < 6; ++p) { const int idx = p * NTHREADS + tid, row = idx >> 5, piece = idx & 31;
                    *(LAS u32x4*)(WB + row * WB_STRIDE + piece * 16) = wreg[p]; }
                __syncthreads();
#pragma unroll 2
                for (int ks = 0; ks < 8; ++ks) {
                    const bf16x8 af0 = *(const bf16x8*)(arow0 + ch * 256 + ks * 32), af1 = *(const bf16x8*)(arow1 + ch * 256 + ks * 32);
#pragma unroll
                    for (int nt = 0; nt < 3; ++nt) {
                        const bf16x8 bh = *(const LAS bf16x8*)(WB + (nt * 16 + fr) * WB_STRIDE + (ks * 32 + fq * 8) * 2), bl = *(const LAS bf16x8*)(WB + (48 + nt * 16 + fr) * WB_STRIDE + (ks * 32 + fq * 8) * 2);
                        acc[0][nt] = __builtin_amdgcn_mfma_f32_16x16x32_bf16(af0, bh, acc[0][nt], 0, 0, 0);
                        acc[1][nt] = __builtin_amdgcn_mfma_f32_16x16x32_bf16(af1, bh, acc[1][nt], 0, 0, 0);
                        acc[0][nt] = __builtin_amdgcn_mfma_f32_16x16x32_bf16(af0, bl, acc[0][nt], 0, 0, 0);
                        acc[1][nt] = __builtin_amdgcn_mfma_f32_16x16x32_bf16(af1, bl, acc[1][nt], 0, 0, 0);
                    }
                }
            }
            LAS float* lg = LG + wave * (2 * 16 * 48);
#pragma unroll
            for (int gi = 0; gi < 2; ++gi)
#pragma unroll
                for (int nt = 0; nt < 3; ++nt)
#pragma unroll
                    for (int j = 0; j < 4; ++j) lg[(gi * 16 + 4 * fq + j) * 48 + 16 * nt + fr] = acc[gi][nt][j];
            asm volatile("s_waitcnt lgkmcnt(0)" ::: "memory");
            if (lane < 32) {
                float pl[36];
#pragma unroll
                for (int e4 = 0; e4 < 9; ++e4) { const f32x4 q = *(const LAS f32x4*)(lg + lane * 48 + 4 * e4);
#pragma unroll
                    for (int r = 0; r < 4; ++r) pl[4 * e4 + r] = q[r]; }
#pragma unroll
                for (int e = 0; e < 36; ++e) pl[e] += e < 4 ? rgb[e] : reb[e - 4];
                int gsel = 0; float gm = pl[0];
#pragma unroll
                for (int g = 1; g < 4; ++g) if (pl[g] > gm) { gm = pl[g]; gsel = g; }
                float den = 0.f;
#pragma unroll
                for (int g = 0; g < 4; ++g) den += __expf(pl[g] - gm);
                const float gval = frcp(den);
                int j0 = -1; float v0 = -3.0e38f;
#pragma unroll
                for (int j = 0; j < 32; ++j) { const bool in = (j >> 3) == gsel; if (in && (j0 < 0 || pl[4 + j] > v0)) { v0 = pl[4 + j]; j0 = j; } }
                int j1 = -1; float v1 = -3.0e38f;
#pragma unroll
                for (int j = 0; j < 32; ++j) { const bool in = (j >> 3) == gsel; if (in && j != j0 && (j1 < 0 || pl[4 + j] > v1)) { v1 = pl[4 + j]; j1 = j; } }
                const float tt = __expf(v1 - v0), w0 = frcp(1.0f + tt), w1 = tt * w0;
                const int p0 = __hip_atomic_fetch_add(lcnt + j0, 1, __ATOMIC_RELAXED, __HIP_MEMORY_SCOPE_WORKGROUP), p1 = __hip_atomic_fetch_add(lcnt + j1, 1, __ATOMIC_RELAXED, __HIP_MEMORY_SCOPE_WORKGROUP);
                const int slot = wave * 32 + lane;
                tinfo[slot] = (i32x4){j0, j1, p0, p1}; tw[slot] = (f32x2){gval * w0, gval * w1};
            }
        }
        __syncthreads();
        if (tid < 32) lbase[tid] = atomicAdd(&counts[tid * CSTR], lcnt[tid]);
        __syncthreads();
        if (tid < 256) {
            const int tok = tok00 + (tid >> 4) * 256 + (tid & 15); const i32x4 ti = tinfo[tid]; const f32x2 wv = tw[tid];
            eidx[tok] = make_int2(ti[0], ti[1]); epos[tok] = make_int2(lbase[ti[0]] + ti[2], lbase[ti[1]] + ti[3]); ew[tok] = make_float2(wv[0], wv[1]);
        }
        if (tid < 32) lcnt[tid] = 0;
        __syncthreads();
    }
}

constexpr size_t WS_ROWTOK = 5 * MiB;
constexpr size_t WS_RBPRE = 2 * MiB;
__device__ __forceinline__ void p_assign(LAS unsigned char* lds, const Args& a, int bid, int G, int tid) {
    const int* counts = (const int*)(a.ws + WS_CTL);
    const int2* eidx = (const int2*)(a.ws + WS_EIDX); const int2* epos = (const int2*)(a.ws + WS_EPOS); int2* dest = (int2*)(a.ws + WS_DEST); int* rowtok = (int*)(a.ws + WS_ROWTOK);
    LAS int* ps = (LAS int*)lds;
    if (tid == 0) { int acc = 0; int* rbpre = (int*)(a.ws + WS_RBPRE); for (int e = 0; e < NE; ++e) { const int c = counts[e * CSTR]; ps[e] = acc; ps[32 + e] = c; if (bid == 0) rbpre[e] = acc >> 8; acc += ((c + 255) >> 8) << 8; } if (bid == 0) rbpre[NE] = acc >> 8; }
    __syncthreads();
    for (int tok = bid * NTHREADS + tid; tok < T; tok += G * NTHREADS) {
        const int2 ei = eidx[tok], ep = epos[tok];
        const int d0 = ps[ei.x] + ep.x, d1 = ps[ei.y] + ep.y;
        rowtok[d0] = tok; rowtok[d1] = tok; dest[tok] = make_int2(d0, d1);
    }
    for (int i = bid * NTHREADS + tid; i < NE * 256; i += G * NTHREADS) {
        const int e = i >> 8, r = i & 255, c = ps[32 + e];
        if (c + r < (((c + 255) >> 8) << 8)) rowtok[ps[e] + c + r] = 0;
    }
    __syncthreads();
}

__device__ __forceinline__ void p_combine_ln2(const Args& a, int bid, int G, int wave, int lane, bool dry = false) {
    const bf16_t* h1b = (const bf16_t*)(a.ws + WS_H1); float* outw = dry ? (float*)(a.ws + WS_HID) : a.out; const bf16_t* Y = (const bf16_t*)(a.ws + WS_Y); const int2* dest = (const int2*)(a.ws + WS_DEST); const float2* ew = (const float2*)(a.ws + WS_EW);
    const float* mod = (const float*)(a.ws + WS_MOD); const float* __restrict__ ln_g = a.in[24]; const float* __restrict__ ln_b = a.in[25];
    int pr = bid * 8 + wave;
    f32x4 lgv[4], lbv[4];
#pragma unroll
    for (int j = 0; j < 4; ++j) { lgv[j] = *(const f32x4*)(ln_g + 4 * lane + 256 * j); lbv[j] = *(const f32x4*)(ln_b + 4 * lane + 256 * j); }
    int2 dn[2]; float2 wn[2];
#pragma unroll
    for (int t = 0; t < 2; ++t) { dn[t] = dest[2 * pr + t]; wn[t] = ew[2 * pr + t]; }
#pragma unroll 1
    for (; pr < T / 2; pr += G * 8) {
        int l2 = lane; asm volatile("" : "+v"(l2)); const int lane = l2;
        const int tok0 = 2 * pr;
        const float* m = mod + (size_t)(tok0 / SEQ) * 6144;
        int2 d[2]; float2 w[2];
#pragma unroll
        for (int t = 0; t < 2; ++t) { d[t] = dn[t]; w[t] = wn[t]; }
        f32x4 v[2][4]; float s[2] = {0.f, 0.f};
#pragma unroll
        for (int t = 0; t < 2; ++t)
#pragma unroll
            for (int j = 0; j < 4; ++j) { const int c4 = 4 * lane + 256 * j;
                const u32x2 ya = ntld((const u32x2*)(Y + (size_t)d[t].x * DM + c4)), yb = ntld((const u32x2*)(Y + (size_t)d[t].y * DM + c4));
                const u32x2 hw = ntld((const u32x2*)(h1b + (size_t)(tok0 + t) * DM + c4)); const f32x4 g2 = *(const f32x4*)(m + 5120 + c4);
                f32x4 f;
                f[0] = w[t].x * __uint_as_float(ya.x << 16) + w[t].y * __uint_as_float(yb.x << 16);
                f[1] = w[t].x * __uint_as_float(ya.x & 0xffff0000u) + w[t].y * __uint_as_float(yb.x & 0xffff0000u);
                f[2] = w[t].x * __uint_as_float(ya.y << 16) + w[t].y * __uint_as_float(yb.y << 16);
                f[3] = w[t].x * __uint_as_float(ya.y & 0xffff0000u) + w[t].y * __uint_as_float(yb.y & 0xffff0000u);
                const f32x4 h1 = (f32x4){__uint_as_float(hw.x << 16), __uint_as_float(hw.x & 0xffff0000u), __uint_as_float(hw.y << 16), __uint_as_float(hw.y & 0xffff0000u)};
                v[t][j] = ALPHA * h1 + g2 * f; s[t] += (v[t][j][0] + v[t][j][1]) + (v[t][j][2] + v[t][j][3]); }
        { const int pn = pr + G * 8; if (pn < T / 2) {
#pragma unroll
            for (int t = 0; t < 2; ++t) { dn[t] = dest[2 * pn + t]; wn[t] = ew[2 * pn + t]; } } }
#pragma unroll
        for (int t = 0; t < 2; ++t) { const float mean = wave_sum(s[t]) * (1.0f / DM); float s2 = 0.f;
#pragma unroll
            for (int j = 0; j < 4; ++j) { v[t][j] = v[t][j] - mean; s2 += (v[t][j][0] * v[t][j][0] + v[t][j][1] * v[t][j][1]) + (v[t][j][2] * v[t][j][2] + v[t][j][3] * v[t][j][3]); }
            const float rstd = rsqrtf(wave_sum(s2) * (1.0f / DM) + LN_EPS);
#pragma unroll
            for (int j = 0; j < 4; ++j) { const int c4 = 4 * lane + 256 * j;
                ntst((f32x4*)(outw + (size_t)(tok0 + t) * DM + c4), (f32x4)(v[t][j] * rstd * lgv[j] + lbv[j])); } }
    }
}

constexpr size_t WS_HGK = WS_U;
constexpr size_t WS_HGD = 852 * MiB;
constexpr size_t WS_RGAGG = 854 * MiB;
constexpr size_t WS_RGCARRY = 864 * MiB;
constexpr size_t WS_GWT = 870 * MiB;
constexpr size_t WS_OFST = 880 * MiB;
constexpr int RG_UNITS_PER_B = 68, HG_SEGS = 17;

__device__ __forceinline__ void lds_barrier() { asm volatile("s_waitcnt lgkmcnt(0)" ::: "memory"); __builtin_amdgcn_s_barrier(); asm volatile("" ::: "memory"); }
__device__ __forceinline__ bf16x8 mk_bf16x8(u32x4 v) { return __builtin_bit_cast(bf16x8, v); }
__device__ __forceinline__ float bf_lo(unsigned w) { return __uint_as_float(w << 16); }
__device__ __forceinline__ float bf_hi(unsigned w) { return __uint_as_float(w & 0xffff0000u); }
__device__ __forceinline__ unsigned cvt2(float lo, float hi) { unsigned r; asm volatile("v_cvt_pk_bf16_f32 %0, %1, %2" : "=v"(r) : "v"(lo), "v"(hi)); return r; }

__device__ __forceinline__ void p_gwt(const float* __restrict__ gate_w, bf16_t* __restrict__ gwt, int bid, int G, int tid) {
    for (int o = bid * NTHREADS + tid; o < 32 * 4096; o += G * NTHREADS) { const int mat = o >> 12, d = (o >> 6) & 63, c = o & 63; gwt[o] = f2bf(gate_w[mat * 4096 + c * 64 + d]); }
}

constexpr int XC_STRIDE = 1040;
constexpr int RG_XC = 0, RG_OUT = 64 * XC_STRIDE;
constexpr size_t WS_RGPAR = 876 * MiB;

__device__ __forceinline__ void p_rgpar(const float* __restrict__ gate_b, const float* __restrict__ lam, float* __restrict__ par, int bid, int G, int tid) {
    for (int o = bid * NTHREADS + tid; o < 2 * 512; o += G * NTHREADS) { const int dir = o >> 9, ch = o & 511;
        par[(dir * 3 + 0) * 512 + ch] = gate_b[(dir * 2 + 0) * 512 + ch]; par[(dir * 3 + 1) * 512 + ch] = gate_b[(dir * 2 + 1) * 512 + ch]; par[(dir * 3 + 2) * 512 + ch] = softplusf_(-lam[dir * 512 + ch]); }
}

template <int DIR, bool OUT>
__device__ __forceinline__ void rg_scan64(const float (&av)[4][4], const float (&uv)[4][4], float& carry, float& atot, float (&hsum)[4][4], int fr, int fq) {
#pragma unroll
    for (int mm = 0; mm < 4; ++mm) {
        const int m = DIR == 0 ? mm : 3 - mm;
        float P, H;
        if (DIR == 0) { P = av[m][0]; H = uv[m][0];
#pragma unroll
            for (int j = 1; j < 4; ++j) { H = av[m][j] * H + uv[m][j]; P *= av[m][j]; } }
        else { P = av[m][3]; H = uv[m][3];
#pragma unroll
            for (int j = 2; j >= 0; --j) { H = av[m][j] * H + uv[m][j]; P *= av[m][j]; } }
        float Pn, Hn, Pe, He, Pt, Ht;
        if (DIR == 0) {
            Pn = __shfl_up(P, 16); Hn = __shfl_up(H, 16); if (fq >= 1) { H = P * Hn + H; P = P * Pn; }
            Pn = __shfl_up(P, 32); Hn = __shfl_up(H, 32); if (fq >= 2) { H = P * Hn + H; P = P * Pn; }
            Pe = __shfl_up(P, 16); He = __shfl_up(H, 16); if (fq == 0) { Pe = 1.f; He = 0.f; }
            Pt = __shfl(P, fr + 48); Ht = __shfl(H, fr + 48);
        } else {
            Pn = __shfl_down(P, 16); Hn = __shfl_down(H, 16); if (fq <= 2) { H = P * Hn + H; P = P * Pn; }
            Pn = __shfl_down(P, 32); Hn = __shfl_down(H, 32); if (fq <= 1) { H = P * Hn + H; P = P * Pn; }
            Pe = __shfl_down(P, 16); He = __shfl_down(H, 16); if (fq == 3) { Pe = 1.f; He = 0.f; }
            Pt = __shfl(P, fr); Ht = __shfl(H, fr);
        }
        if (OUT) {
            float hp = Pe * carry + He;
            if (DIR == 0) {
#pragma unroll
                for (int j = 0; j < 4; ++j) { hp = av[m][j] * hp + uv[m][j]; hsum[m][j] = hp; }
            } else {
#pragma unroll
                for (int j = 3; j >= 0; --j) { hp = av[m][j] * hp + uv[m][j]; hsum[m][j] += hp; }
            }
        }
        carry = Pt * carry + Ht; atot *= Pt;
    }
}

__device__ __forceinline__ void rg_load_raw(u32x4 (&raw)[11], const bf16_t* __restrict__ proj, int b, int k, int tid) {
    int rowbase, p0, lo, hi;
    if (k < 4) { rowbase = T + b * LC; p0 = k * 64; lo = 0; hi = LC; } else { rowbase = b * SEQ; p0 = (k - 4) * 64; lo = p0; hi = p0 + 64; }
    const int c0 = (tid & 63) * 8, i0 = (tid >> 6) * 8;
#pragma unroll
    for (int r = 0; r < 11; ++r) { const int p = p0 + i0 - 1 + r;
        raw[r] = (p >= lo && p < hi) ? *(const u32x4*)proj_at(proj, rowbase + p, c0) : (u32x4){0u, 0u, 0u, 0u}; }
}
__device__ __forceinline__ void rg_agg_unit(LAS unsigned char* lds, const Args& a, int b, int k, u32x4 (&raw)[11], int bn, int kn, int tid, int wave, int lane, int xr = 0) {
    const bf16_t* __restrict__ proj = (const bf16_t*)(a.ws + WS_PROJ);
    const float* __restrict__ conv_w = a.in[7]; const float* __restrict__ conv_b = a.in[8];
    const bf16_t* __restrict__ gwt = (const bf16_t*)(a.ws + WS_GWT); const float* __restrict__ par = (const float*)(a.ws + WS_RGPAR);
    float* rgagg = (float*)(a.ws + WS_RGAGG);
    int rowbase, p0, lo, hi;
    if (k < 4) { rowbase = T + b * LC; p0 = k * 64; lo = 0; hi = LC; } else { rowbase = b * SEQ; p0 = (k - 4) * 64; lo = p0; hi = p0 + 64; }
    const int unit = b * RG_UNITS_PER_B + k;
    const int n = wave, fr = lane & 15, fq = lane >> 4;
    float pgr[4][2], pgi[4][2], psp[4][2];
#pragma unroll
    for (int nt = 0; nt < 4; ++nt)
#pragma unroll
        for (int dir = 0; dir < 2; ++dir) { const int ch = n * 64 + nt * 16 + fr;
            pgr[nt][dir] = par[(dir * 3 + 0) * 512 + ch]; pgi[nt][dir] = par[(dir * 3 + 1) * 512 + ch]; psp[nt][dir] = par[(dir * 3 + 2) * 512 + ch]; }
    if (!(xr & 1)) {
        const int cgp = tid & 63, tg = tid >> 6, c0 = cgp * 8, i0 = tg * 8;
        float cw[4][8], cb[8];
#pragma unroll
        for (int t4 = 0; t4 < 4; ++t4) { const f32x4 w0 = *(const f32x4*)(conv_w + t4 * 512 + c0), w1 = *(const f32x4*)(conv_w + t4 * 512 + c0 + 4);
#pragma unroll
            for (int q = 0; q < 4; ++q) { cw[t4][q] = w0[q]; cw[t4][4 + q] = w1[q]; } }
        { const f32x4 b0 = *(const f32x4*)(conv_b + c0), b1 = *(const f32x4*)(conv_b + c0 + 4);
#pragma unroll
            for (int q = 0; q < 4; ++q) { cb[q] = b0[q]; cb[4 + q] = b1[q]; } }
#pragma unroll
        for (int ii = 0; ii < 8; ++ii) {
            float xc[8];
#pragma unroll
            for (int c = 0; c < 8; ++c) xc[c] = cb[c];
#pragma unroll
            for (int t4 = 0; t4 < 4; ++t4) { const u32x4 rw = raw[ii + t4];
#pragma unroll
                for (int q = 0; q < 4; ++q) { xc[2 * q] += cw[t4][2 * q] * bf_lo(rw[q]); xc[2 * q + 1] += cw[t4][2 * q + 1] * bf_hi(rw[q]); } }
            u32x4 w; w.x = cvt2(xc[0], xc[1]); w.y = cvt2(xc[2], xc[3]); w.z = cvt2(xc[4], xc[5]); w.w = cvt2(xc[6], xc[7]);
            *(LAS u32x4*)(lds + RG_XC + (i0 + ii) * XC_STRIDE + c0 * 2) = w;
        }
    }
    if (kn >= 0) rg_load_raw(raw, proj, bn, kn, tid);
    lds_barrier();
    {
        bf16x8 afr[4][2];
#pragma unroll
        for (int m = 0; m < 4; ++m)
#pragma unroll
            for (int ks = 0; ks < 2; ++ks) afr[m][ks] = *(const LAS bf16x8*)(lds + RG_XC + (16 * m + fr) * XC_STRIDE + (n * 64 + ks * 32 + fq * 8) * 2);
        u32x4* stash = (k >= 4) ? (u32x4*)a.out + ((size_t)(b * 64 + (k - 4)) * 16384 + (size_t)wave * 2048 + lane) : nullptr;
        bf16x8 wfr[2][2][2];
#pragma unroll
        for (int dir = 0; dir < 2; ++dir)
#pragma unroll
            for (int g = 0; g < 2; ++g)
#pragma unroll
                for (int ks = 0; ks < 2; ++ks) wfr[dir][g][ks] = *(const bf16x8*)(gwt + ((size_t)(((dir * 2 + g) * 8 + n) * 64 + fr)) * 64 + ks * 32 + fq * 8);
#pragma unroll
        for (int nt = 0; nt < 4; ++nt) {
            const int ch = n * 64 + nt * 16 + fr;
            bf16x8 wnx[2][2][2];
            if (nt < 3) {
#pragma unroll
                for (int dir = 0; dir < 2; ++dir)
#pragma unroll
                    for (int g = 0; g < 2; ++g)
#pragma unroll
                        for (int ks = 0; ks < 2; ++ks) wnx[dir][g][ks] = *(const bf16x8*)(gwt + ((size_t)(((dir * 2 + g) * 8 + n) * 64 + (nt + 1) * 16 + fr)) * 64 + ks * 32 + fq * 8);
            }
            float xcv[4][4];
#pragma unroll
            for (int m = 0; m < 4; ++m)
#pragma unroll
                for (int j = 0; j < 4; ++j) xcv[m][j] = bf2f(*(const LAS bf16_t*)(lds + RG_XC + (16 * m + 4 * fq + j) * XC_STRIDE + ch * 2));
#pragma unroll
            for (int dir = 0; dir < 2; ++dir) {
                f32x4 accr[4], acci[4];
#pragma unroll
                for (int m = 0; m < 4; ++m) { accr[m] = (f32x4){0.f, 0.f, 0.f, 0.f}; acci[m] = (f32x4){0.f, 0.f, 0.f, 0.f}; }
                if (!(xr & 2))
#pragma unroll
                for (int ks = 0; ks < 2; ++ks)
#pragma unroll
                    for (int m = 0; m < 4; ++m) { accr[m] = __builtin_amdgcn_mfma_f32_16x16x32_bf16(afr[m][ks], wfr[dir][0][ks], accr[m], 0, 0, 0); acci[m] = __builtin_amdgcn_mfma_f32_16x16x32_bf16(afr[m][ks], wfr[dir][1][ks], acci[m], 0, 0, 0); }
                const float gbr = pgr[nt][dir], gbi = pgi[nt][dir], sp = psp[nt][dir];
                float av[4][4], uv[4][4];
                const bool exact = __any(8.0f * sp >= 0.25f);
#pragma unroll
                for (int m = 0; m < 4; ++m) {
                    unsigned pk[4];
                    if (xr & 4) {
#pragma unroll
                        for (int j = 0; j < 4; ++j) pk[j] = __float_as_uint(accr[m][j] + acci[m][j] + xcv[m][j]);
                    } else if (!exact) {
#pragma unroll
                        for (int j = 0; j < 4; ++j) {
                            const float r = sigmoidf_(accr[m][j] + gbr), ig = sigmoidf_(acci[m][j] + gbi);
                            const float la = -8.0f * r * sp;
                            const float oma = -la * (1.f + la * (0.5f + la * (0.16666667f + la * (0.041666668f + la * 0.0083333338f))));
                            pk[j] = cvt2(oma, __builtin_amdgcn_sqrtf(oma * (2.0f - oma)) * ig * xcv[m][j]);
                        }
                    } else {
#pragma unroll
                        for (int j = 0; j < 4; ++j) {
                            const float r = sigmoidf_(accr[m][j] + gbr), ig = sigmoidf_(acci[m][j] + gbi);
                            const float la = -8.0f * r * sp;
                            const float ser = -la * (1.f + la * (0.5f + la * (0.16666667f + la * (0.041666668f + la * 0.0083333338f))));
                            const float oma = (la > -0.25f) ? ser : 1.f - __expf(la);
                            pk[j] = cvt2(oma, __builtin_amdgcn_sqrtf(oma * (2.0f - oma)) * ig * xcv[m][j]);
                        }
                    }
#pragma unroll
                    for (int j = 0; j < 4; ++j) { av[m][j] = 1.0f - bf_lo(pk[j]); uv[m][j] = bf_hi(pk[j]); }
                    if (stash && !(xr & 16)) ntst(stash + ((nt * 2 + dir) * 4 + m) * 64, (u32x4){pk[0], pk[1], pk[2], pk[3]});
                }
                float carry = 0.f, atot = 1.f, hdummy[4][4];
                if (xr & 8) { carry = av[0][0] + uv[3][3]; } else if (dir == 0) rg_scan64<0, false>(av, uv, carry, atot, hdummy, fr, fq); else rg_scan64<1, false>(av, uv, carry, atot, hdummy, fr, fq);
                if (fq == 0) { rgagg[(((size_t)unit * 2 + dir) * 2 + 0) * 512 + ch] = atot; rgagg[(((size_t)unit * 2 + dir) * 2 + 1) * 512 + ch] = carry; }
            }
            if (nt < 3) {
#pragma unroll
                for (int dir = 0; dir < 2; ++dir)
#pragma unroll
                    for (int g = 0; g < 2; ++g)
#pragma unroll
                        for (int ks = 0; ks < 2; ++ks) wfr[dir][g][ks] = wnx[dir][g][ks];
            }
        }
    }
    lds_barrier();
}

__device__ __forceinline__ void rg_final_load(u32x4 (&g)[8], u32x4 (&st)[2][4], const Args& a, int b, int kl, int tid, int wave, int lane) {
    const bf16_t* __restrict__ proj = (const bf16_t*)(a.ws + WS_PROJ);
    const int rowbase = b * SEQ + kl * 64, c0 = (tid & 63) * 8, i0 = (tid >> 6) * 8;
    const u32x4* stash = (const u32x4*)a.out + ((size_t)(b * 64 + kl) * 16384 + (size_t)wave * 2048 + lane);
#pragma unroll
    for (int ii = 0; ii < 8; ++ii) g[ii] = *(const u32x4*)proj_at(proj, rowbase + i0 + ii, 512 + c0);
#pragma unroll
    for (int dir = 0; dir < 2; ++dir)
#pragma unroll
        for (int m = 0; m < 4; ++m) st[dir][m] = ntld(stash + ((0 * 2 + dir) * 4 + m) * 64);
}
__device__ __forceinline__ void rg_final_unit(LAS unsigned char* lds, const Args& a, int b, int kl, u32x4 (&g)[8], u32x4 (&st)[2][4], int bn, int kn, int tid, int wave, int lane) {
    const float* rgcarry = (const float*)(a.ws + WS_RGCARRY); bf16_t* mixed = (bf16_t*)(a.ws + WS_MIXED);
    const int rowbase = b * SEQ + kl * 64, unit = b * RG_UNITS_PER_B + 4 + kl;
    const int n = wave, fr = lane & 15, fq = lane >> 4;
    const u32x4* stash = (const u32x4*)a.out + ((size_t)(b * 64 + kl) * 16384 + (size_t)wave * 2048 + lane);
    float cin[4][2];
#pragma unroll
    for (int nt = 0; nt < 4; ++nt)
#pragma unroll
        for (int dir = 0; dir < 2; ++dir) cin[nt][dir] = rgcarry[((size_t)unit * 2 + dir) * 512 + n * 64 + nt * 16 + fr];
    {
        const int c0 = (tid & 63) * 8, i0 = (tid >> 6) * 8;
#pragma unroll
        for (int ii = 0; ii < 8; ++ii) *(LAS u32x4*)(lds + RG_XC + (i0 + ii) * XC_STRIDE + c0 * 2) = g[ii];
    }
    lds_barrier();
#pragma unroll
    for (int nt = 0; nt < 4; ++nt) {
        const int ch = n * 64 + nt * 16 + fr;
        u32x4 sn[2][4];
        if (nt < 3) {
#pragma unroll
            for (int dir = 0; dir < 2; ++dir)
#pragma unroll
                for (int m = 0; m < 4; ++m) sn[dir][m] = ntld(stash + (((nt + 1) * 2 + dir) * 4 + m) * 64);
        }
        float hsum[4][4];
#pragma unroll
        for (int dir = 0; dir < 2; ++dir) {
            float av[4][4], uv[4][4];
#pragma unroll
            for (int m = 0; m < 4; ++m)
#pragma unroll
                for (int j = 0; j < 4; ++j) { av[m][j] = 1.0f - bf_lo(st[dir][m][j]); uv[m][j] = bf_hi(st[dir][m][j]); }
            float carry = cin[nt][dir], atot = 1.f;
            if (dir == 0) rg_scan64<0, true>(av, uv, carry, atot, hsum, fr, fq); else rg_scan64<1, true>(av, uv, carry, atot, hsum, fr, fq);
        }
#pragma unroll
        for (int m = 0; m < 4; ++m)
#pragma unroll
            for (int j = 0; j < 4; ++j) { const int t = 16 * m + 4 * fq + j;
                const float gg = bf2f(*(const LAS bf16_t*)(lds + RG_XC + t * XC_STRIDE + ch * 2));
                *(LAS bf16_t*)(lds + RG_OUT + t * XC_STRIDE + ch * 2) = (bf16_t)(cvt2(hsum[m][j] * gg, 0.f) & 0xffffu); }
        if (nt < 3) {
#pragma unroll
            for (int dir = 0; dir < 2; ++dir)
#pragma unroll
                for (int m = 0; m < 4; ++m) st[dir][m] = sn[dir][m];
        }
    }
    if (kn >= 0) rg_final_load(g, st, a, bn, kn, tid, wave, lane);
    lds_barrier();
    {
        const int c0 = (tid & 63) * 8, i0 = (tid >> 6) * 8;
#pragma unroll
        for (int ii = 0; ii < 8; ++ii) { const u32x4 w = *(const LAS u32x4*)(lds + RG_OUT + (i0 + ii) * XC_STRIDE + c0 * 2);
            *(u32x4*)(mixed + (size_t)(rowbase + i0 + ii) * DM + c0) = w; }
    }
}

__device__ __forceinline__ void rg_carry_item(const Args& a, int item, int tid) {
    const float* rgagg = (const float*)(a.ws + WS_RGAGG); float* rgcarry = (float*)(a.ws + WS_RGCARRY);
    const int gidx = item * NTHREADS + tid;
    const int ch = gidx & 511, dir = (gidx >> 9) & 1, b = gidx >> 10;
    float h = 0.f;
#pragma unroll 1
    for (int s0 = 0; s0 < RG_UNITS_PER_B; s0 += 17) {
        float Av[17], Hv[17];
#pragma unroll
        for (int s1 = 0; s1 < 17; ++s1) { const int s = s0 + s1;
            const int k = dir == 0 ? s : (s < 4 ? 3 - s : 67 - (s - 4));
            const size_t unit = (size_t)b * RG_UNITS_PER_B + k;
            Av[s1] = rgagg[((unit * 2 + dir) * 2 + 0) * 512 + ch]; Hv[s1] = rgagg[((unit * 2 + dir) * 2 + 1) * 512 + ch]; }
#pragma unroll
        for (int s1 = 0; s1 < 17; ++s1) { const int s = s0 + s1;
            const int k = dir == 0 ? s : (s < 4 ? 3 - s : 67 - (s - 4));
            const size_t unit = (size_t)b * RG_UNITS_PER_B + k;
            rgcarry[(unit * 2 + dir) * 512 + ch] = h;
            h = Av[s1] * h + Hv[s1]; }
    }
}

#ifndef HGX
#define HGX 0
#endif
__device__ __forceinline__ float row_allsum16(float v) {
    v += __builtin_bit_cast(float, __builtin_amdgcn_update_dpp(0, __builtin_bit_cast(int, v), 0x128, 0xf, 0xf, false));
    v += __builtin_bit_cast(float, __builtin_amdgcn_update_dpp(0, __builtin_bit_cast(int, v), 0x124, 0xf, 0xf, false));
    v += __builtin_bit_cast(float, __builtin_amdgcn_update_dpp(0, __builtin_bit_cast(int, v), 0x122, 0xf, 0xf, false));
    v += __builtin_bit_cast(float, __builtin_amdgcn_update_dpp(0, __builtin_bit_cast(int, v), 0x121, 0xf, 0xf, false));
    return v;
}
constexpr int HG_RAWZ = 0, HG_RAWV = 16384, HG_RAWQ = 32768;
constexpr int HG_KHT = 49152, HG_VT = 67584;
constexpr int HG_QT = 86016, HG_KT = 103424;
constexpr int HG_AM = 120832;
constexpr int HG_DS = 130048, HG_QSUM = 130560, HG_PART = 134656;
constexpr int HG_RAWG = 136704;
constexpr int HG_OST = HG_QT;
constexpr int TS = 144, QS = 272;

struct HgRaw { u32x4 z[2], v[2], q[2], g[2]; };
template <bool FULL, bool GATE>
__device__ __forceinline__ void hg_load_raw(HgRaw& r, const bf16_t* __restrict__ proj, int row0, int hd, int dir, int tid) {
#pragma unroll
    for (int i = 0; i < 2; ++i) { const int row = row0 + (tid >> 4) + 32 * i, col = hd * 128 + (tid & 15) * 8;
        r.z[i] = *(const u32x4*)proj_at(proj, row, col + (dir == 0 ? 1536 : 2048)); r.v[i] = *(const u32x4*)proj_at(proj, row, col + 2560);
        if (FULL) r.q[i] = *(const u32x4*)proj_at(proj, row, col + 1024); if (GATE) r.g[i] = *(const u32x4*)proj_at(proj, row, col + 3072); }
}
template <bool FULL, bool GATE>
__device__ __forceinline__ void hg_store_raw(LAS unsigned char* lds, const HgRaw& r, int tid) {
#pragma unroll
    for (int i = 0; i < 2; ++i) { const int off = ((tid >> 4) + 32 * i) * 256 + (tid & 15) * 16;
        *(LAS u32x4*)(lds + HG_RAWZ + off) = r.z[i]; *(LAS u32x4*)(lds + HG_RAWV + off) = r.v[i]; if (FULL) *(LAS u32x4*)(lds + HG_RAWQ + off) = r.q[i]; if (GATE) *(LAS u32x4*)(lds + HG_RAWG + off) = r.g[i]; }
}

template <int DIR, bool FULL, bool STORE_NEXT, bool NEXT_GATE>
__device__ __forceinline__ void hg_chunk(LAS unsigned char* lds, f32x4 (&accS)[8], f32x4 (&o)[4], float lb0, float lb1, float& dseg0, float& dseg1, const HgRaw& nxt, int tid, int wave, int lane, int xm = 0) {
    const int cp = lane, tg = wave, fr = lane & 15, fq = lane >> 4;
    float c0[8], c1[8], k0[8], k1[8];
    if (xm & 1) {
#pragma unroll
        for (int i = 0; i < 8; ++i) { c0[i] = 1.f; c1[i] = 1.f; k0[i] = 0.5f; k1[i] = 0.5f; }
    } else {
        float p0 = 1.f, p1 = 1.f;
#pragma unroll
        for (int ii = 0; ii < 8; ++ii) { const int i = DIR == 0 ? ii : 7 - ii;
            const unsigned zz = *(const LAS unsigned*)(lds + HG_RAWZ + (8 * tg + i) * 256 + cp * 4);
            const float e0 = __expf(-bf_lo(zz)), e1 = __expf(-bf_hi(zz)); const float s0 = frcp(1.0f + e0), s1 = frcp(1.0f + e1);
            k0[i] = (1.0f - lb0) * (1.0f - s0); k1[i] = (1.0f - lb1) * (1.0f - s1);
            p0 *= lb0 + (1.0f - lb0) * s0; p1 *= lb1 + (1.0f - lb1) * s1; c0[i] = p0; c1[i] = p1; }
        *(LAS f32x2*)(lds + HG_QSUM + (tg * 128 + 2 * cp) * 4) = (f32x2){p0, p1};
    }
    lds_barrier();
    float pre0 = 1.f, pre1 = 1.f, tot0 = 1.f, tot1 = 1.f;
#pragma unroll
    for (int g = 0; g < 8; ++g) { const f32x2 v = *(const LAS f32x2*)(lds + HG_QSUM + (g * 128 + 2 * cp) * 4); tot0 *= v[0]; tot1 *= v[1]; if (DIR == 0 ? (g < tg) : (g > tg)) { pre0 *= v[0]; pre1 *= v[1]; } }
    if (!(xm & 1)) {
        unsigned kh0[4], kh1[4], vt0[4], vt1[4];
#pragma unroll
        for (int i2 = 0; i2 < 4; ++i2) {
            const float Pa0 = pre0 * c0[2 * i2], Pb0 = pre0 * c0[2 * i2 + 1], Pa1 = pre1 * c1[2 * i2], Pb1 = pre1 * c1[2 * i2 + 1];
            const float ra0 = frcp(Pa0), rb0 = frcp(Pb0), ra1 = frcp(Pa1), rb1 = frcp(Pb1);
            const float kta0 = k0[2 * i2] * ra0, ktb0 = k0[2 * i2 + 1] * rb0, kta1 = k1[2 * i2] * ra1, ktb1 = k1[2 * i2 + 1] * rb1;
            kh0[i2] = cvt2(kta0 * tot0, ktb0 * tot0); kh1[i2] = cvt2(kta1 * tot1, ktb1 * tot1);
            const unsigned va = *(const LAS unsigned*)(lds + HG_RAWV + (8 * tg + 2 * i2) * 256 + cp * 4), vb = *(const LAS unsigned*)(lds + HG_RAWV + (8 * tg + 2 * i2 + 1) * 256 + cp * 4);
            vt0[i2] = __builtin_amdgcn_perm(vb, va, 0x05040100u); vt1[i2] = __builtin_amdgcn_perm(vb, va, 0x07060302u);
            if (FULL) {
                const unsigned qa = *(const LAS unsigned*)(lds + HG_RAWQ + (8 * tg + 2 * i2) * 256 + cp * 4), qb = *(const LAS unsigned*)(lds + HG_RAWQ + (8 * tg + 2 * i2 + 1) * 256 + cp * 4);
                *(LAS unsigned*)(lds + HG_QT + (8 * tg + 2 * i2) * QS + cp * 4) = cvt2(bf_lo(qa) * Pa0, bf_hi(qa) * Pa1);
                *(LAS unsigned*)(lds + HG_QT + (8 * tg + 2 * i2 + 1) * QS + cp * 4) = cvt2(bf_lo(qb) * Pb0, bf_hi(qb) * Pb1);
                *(LAS unsigned*)(lds + HG_KT + (8 * tg + 2 * i2) * QS + cp * 4) = cvt2(kta0, kta1);
                *(LAS unsigned*)(lds + HG_KT + (8 * tg + 2 * i2 + 1) * QS + cp * 4) = cvt2(ktb0, ktb1);
            }
        }
        *(LAS u32x4*)(lds + HG_KHT + (2 * cp) * TS + tg * 16) = (u32x4){kh0[0], kh0[1], kh0[2], kh0[3]}; *(LAS u32x4*)(lds + HG_KHT + (2 * cp + 1) * TS + tg * 16) = (u32x4){kh1[0], kh1[1], kh1[2], kh1[3]};
        *(LAS u32x4*)(lds + HG_VT + (2 * cp) * TS + tg * 16) = (u32x4){vt0[0], vt0[1], vt0[2], vt0[3]}; *(LAS u32x4*)(lds + HG_VT + (2 * cp + 1) * TS + tg * 16) = (u32x4){vt1[0], vt1[1], vt1[2], vt1[3]};
        if (tg == 0) { *(LAS f32x2*)(lds + HG_DS + 2 * cp * 4) = (f32x2){tot0, tot1}; dseg0 *= tot0; dseg1 *= tot1; }
    }
    lds_barrier();
    if (FULL) {
        if (!(xm & 2))
#pragma unroll
        for (int tt = 0; tt < 2; ++tt) {
            const int tl = 2 * wave + tt, ti = tl >> 2, si = tl & 3;
            f32x4 accA = (f32x4){0.f, 0.f, 0.f, 0.f};
#pragma unroll
            for (int ks = 0; ks < 4; ++ks) {
                const bf16x8 af = *(const LAS bf16x8*)(lds + HG_QT + (16 * ti + fr) * QS + (ks * 32 + fq * 8) * 2);
                const bf16x8 bf = *(const LAS bf16x8*)(lds + HG_KT + (16 * si + fr) * QS + (ks * 32 + fq * 8) * 2);
                accA = __builtin_amdgcn_mfma_f32_16x16x32_bf16(af, bf, accA, 0, 0, 0);
            }
#pragma unroll
            for (int j = 0; j < 4; ++j) { const int t = 16 * ti + 4 * fq + j, s = 16 * si + fr;
                const bool keep = DIR == 0 ? (s <= t) : (s >= t);
                *(LAS bf16_t*)(lds + HG_AM + t * TS + s * 2) = (bf16_t)(cvt2(keep ? accA[j] : 0.f, 0.f) & 0xffffu); }
        }
        lds_barrier();
#pragma unroll
        for (int m = 0; m < 4; ++m) o[m] = (f32x4){0.f, 0.f, 0.f, 0.f};
        if (!(xm & 4)) {
#pragma unroll
        for (int ks = 0; ks < 4; ++ks) {
            const u32x4 sw = (u32x4){cvt2(accS[2 * ks][0], accS[2 * ks][1]), cvt2(accS[2 * ks][2], accS[2 * ks][3]), cvt2(accS[2 * ks + 1][0], accS[2 * ks + 1][1]), cvt2(accS[2 * ks + 1][2], accS[2 * ks + 1][3])};
            const bf16x8 sf = mk_bf16x8(sw);
#pragma unroll
            for (int m = 0; m < 4; ++m) {
                const u32x2 qlo = *(const LAS u32x2*)(lds + HG_QT + (16 * m + fr) * QS + (32 * ks + 4 * fq) * 2), qhi = *(const LAS u32x2*)(lds + HG_QT + (16 * m + fr) * QS + (32 * ks + 16 + 4 * fq) * 2);
                const bf16x8 qf = mk_bf16x8((u32x4){qlo.x, qlo.y, qhi.x, qhi.y});
                o[m] = __builtin_amdgcn_mfma_f32_16x16x32_bf16(qf, sf, o[m], 0, 0, 0);
            }
        }
#pragma unroll
        for (int ks = 0; ks < 2; ++ks) {
            const bf16x8 vf = *(const LAS bf16x8*)(lds + HG_VT + (16 * wave + fr) * TS + (ks * 32 + fq * 8) * 2);
#pragma unroll
            for (int m = 0; m < 4; ++m) { const bf16x8 af = *(const LAS bf16x8*)(lds + HG_AM + (16 * m + fr) * TS + (ks * 32 + fq * 8) * 2);
                o[m] = __builtin_amdgcn_mfma_f32_16x16x32_bf16(af, vf, o[m], 0, 0, 0); }
        }
        }
    }
    if (!(xm & 8)) {
#pragma unroll
    for (int i = 0; i < 8; ++i) { const f32x4 dv = *(const LAS f32x4*)(lds + HG_DS + (16 * i + 4 * fq) * 4); accS[i] = accS[i] * dv; }
#pragma unroll
    for (int ks = 0; ks < 2; ++ks) {
        const bf16x8 vf = *(const LAS bf16x8*)(lds + HG_VT + (16 * wave + fr) * TS + (ks * 32 + fq * 8) * 2);
#pragma unroll
        for (int i = 0; i < 8; ++i) { const bf16x8 af = *(const LAS bf16x8*)(lds + HG_KHT + (16 * i + fr) * TS + (ks * 32 + fq * 8) * 2);
            accS[i] = __builtin_amdgcn_mfma_f32_16x16x32_bf16(af, vf, accS[i], 0, 0, 0); }
    }
    }
    if (STORE_NEXT) hg_store_raw<FULL, NEXT_GATE>(lds, nxt, tid);
}

__device__ __forceinline__ float hg_lb(const float* __restrict__ lb_logits, int dir, int col) {
    const float l0 = lb_logits[(0 * 2 + dir) * 512 + col], l1 = lb_logits[(1 * 2 + dir) * 512 + col];
    return 1.0f / (1.0f + expf(l1 - l0));
}

template <int DIR>
__device__ __forceinline__ void hg_agg_unit(LAS unsigned char* lds, const Args& a, int b, int hd, int sidx, int unit, int tid, int wave, int lane) {
    const bf16_t* __restrict__ proj = (const bf16_t*)(a.ws + WS_PROJ);
    const int rowbase = sidx == 0 ? T + b * LC : b * SEQ + (sidx - 1) * 256;
    const float lb0 = hg_lb(a.in[12], DIR, hd * 128 + 2 * lane), lb1 = hg_lb(a.in[12], DIR, hd * 128 + 2 * lane + 1);
    f32x4 accS[8], odummy[4];
#pragma unroll
    for (int i = 0; i < 8; ++i) accS[i] = (f32x4){0.f, 0.f, 0.f, 0.f};
    float dseg0 = 1.f, dseg1 = 1.f;
    HgRaw raw;
    hg_load_raw<false, false>(raw, proj, rowbase + (DIR == 0 ? 0 : 3) * 64, hd, DIR, tid);
    lds_barrier();
    hg_store_raw<false, false>(lds, raw, tid);
    lds_barrier();
#pragma unroll 1
    for (int cc = 0; cc < 3; ++cc) {
        hg_load_raw<false, false>(raw, proj, rowbase + (DIR == 0 ? cc + 1 : 2 - cc) * 64, hd, DIR, tid);
        hg_chunk<DIR, false, true, false>(lds, accS, odummy, lb0, lb1, dseg0, dseg1, raw, tid, wave, lane);
        lds_barrier();
    }
    hg_chunk<DIR, false, false, false>(lds, accS, odummy, lb0, lb1, dseg0, dseg1, raw, tid, wave, lane);
    float* K = (float*)(a.ws + WS_HGK) + (size_t)unit * 16384;
    const int fr = lane & 15, fq = lane >> 4;
#pragma unroll
    for (int i = 0; i < 8; ++i)
#pragma unroll
        for (int j = 0; j < 4; ++j) K[(16 * i + 4 * fq + j) * 128 + 16 * wave + fr] = accS[i][j];
    if (wave == 0) *(f32x2*)((float*)(a.ws + WS_HGD) + (size_t)unit * 128 + 2 * lane) = (f32x2){dseg0, dseg1};
}

__device__ __forceinline__ void hg_carry_item(const Args& a, int item, int tid, bool dry = false) {
    const int chain = item >> 3, part = item & 7, dir = chain & 1;
    float* K = (float*)(a.ws + WS_HGK) + (size_t)chain * HG_SEGS * 16384; const float* D = (const float*)(a.ws + WS_HGD) + (size_t)chain * HG_SEGS * 128;
    const int e4 = part * 512 + tid, dk = e4 >> 5;
    f32x4 kv[HG_SEGS]; float dv[HG_SEGS];
#pragma unroll
    for (int s = 0; s < HG_SEGS; ++s) { const int sidx = s == 0 ? 0 : (dir == 0 ? s : HG_SEGS - s); kv[s] = *(const f32x4*)(K + (size_t)sidx * 16384 + e4 * 4); dv[s] = D[sidx * 128 + dk]; }
    f32x4 S = (f32x4){0.f, 0.f, 0.f, 0.f};
#pragma unroll
    for (int s = 0; s < HG_SEGS; ++s) { const int sidx = s == 0 ? 0 : (dir == 0 ? s : HG_SEGS - s);
        if (dry) { const size_t o = ((size_t)(chain * HG_SEGS + sidx) * 16384 + e4 * 4) % (size_t)(32 * MiB); *(f32x4*)((float*)(a.ws + WS_MIXED) + o) = S; } else *(f32x4*)(K + (size_t)sidx * 16384 + e4 * 4) = S;
        S = S * dv[s] + kv[s]; }
}

__device__ __forceinline__ void hg_final_unit(LAS unsigned char* lds, const Args& a, int b, int hd, int seg, int tid, int wave, int lane, int xm = 0) {
    const bf16_t* __restrict__ proj = (const bf16_t*)(a.ws + WS_PROJ); bf16_t* mixed = (bf16_t*)(a.ws + WS_MIXED);
    const int rowbase = b * SEQ + seg * 256, fr = lane & 15, fq = lane >> 4;
    const float lbf0 = hg_lb(a.in[12], 0, hd * 128 + 2 * lane), lbf1 = hg_lb(a.in[12], 0, hd * 128 + 2 * lane + 1);
    const float lbb0 = hg_lb(a.in[12], 1, hd * 128 + 2 * lane), lbb1 = hg_lb(a.in[12], 1, hd * 128 + 2 * lane + 1);
    f32x4 accS[8], o[4];
    float dseg0 = 1.f, dseg1 = 1.f;
    HgRaw raw;
    f32x4* ofst = (f32x4*)(a.ws + WS_OFST) + (size_t)blockIdx.x * 8192 + wave * 256 + lane;
    hg_load_raw<true, false>(raw, proj, rowbase, hd, 0, tid);
    {
        const float* Sin = (const float*)(a.ws + WS_HGK) + (size_t)((((b * 4 + hd) * 2 + 0) * HG_SEGS) + 1 + seg) * 16384;
#pragma unroll
        for (int i = 0; i < 8; ++i)
#pragma unroll
            for (int j = 0; j < 4; ++j) accS[i][j] = Sin[(16 * i + 4 * fq + j) * 128 + 16 * wave + fr];
    }
    lds_barrier();
    hg_store_raw<true, false>(lds, raw, tid);
    lds_barrier();
#pragma unroll 1
    for (int cc = 0; cc < 3; ++cc) {
        hg_load_raw<true, false>(raw, proj, rowbase + (cc + 1) * 64, hd, 0, tid);
        hg_chunk<0, true, true, false>(lds, accS, o, lbf0, lbf1, dseg0, dseg1, raw, tid, wave, lane, xm);
#pragma unroll
        for (int m = 0; m < 4; ++m) ofst[cc * 2048 + m * 64] = o[m];
        lds_barrier();
    }
    hg_load_raw<true, false>(raw, proj, rowbase + 3 * 64, hd, 1, tid);
    hg_chunk<0, true, true, false>(lds, accS, o, lbf0, lbf1, dseg0, dseg1, raw, tid, wave, lane, xm);
#pragma unroll
    for (int m = 0; m < 4; ++m) ofst[3 * 2048 + m * 64] = o[m];
    {
        const float* Sin = (const float*)(a.ws + WS_HGK) + (size_t)((((b * 4 + hd) * 2 + 1) * HG_SEGS) + 1 + seg) * 16384;
#pragma unroll
        for (int i = 0; i < 8; ++i)
#pragma unroll
            for (int j = 0; j < 4; ++j) accS[i][j] = Sin[(16 * i + 4 * fq + j) * 128 + 16 * wave + fr];
    }
    lds_barrier();
    constexpr int OSF = 528;
    f32x4 ngv[2];
    { const float* ngp = a.in[13] + hd * 128 + (tid & 15) * 8; ngv[0] = *(const f32x4*)ngp; ngv[1] = *(const f32x4*)(ngp + 4); }
#pragma unroll 1
    for (int cc = 0; cc < 4; ++cc) {
        const int c = 3 - cc;
        f32x4 ofv[4]; u32x4 gq[2];
#pragma unroll
        for (int m = 0; m < 4; ++m) ofv[m] = ofst[c * 2048 + m * 64];
#pragma unroll
        for (int i = 0; i < 2; ++i) gq[i] = *(const u32x4*)proj_at(proj, rowbase + c * 64 + (tid >> 4) + 32 * i, 3072 + hd * 128 + (tid & 15) * 8);
        if (cc < 3) hg_load_raw<true, false>(raw, proj, rowbase + (c - 1) * 64, hd, 1, tid);
        if (cc < 3) hg_chunk<1, true, true, false>(lds, accS, o, lbb0, lbb1, dseg0, dseg1, raw, tid, wave, lane, xm);
        else hg_chunk<1, true, false, false>(lds, accS, o, lbb0, lbb1, dseg0, dseg1, raw, tid, wave, lane, xm);
        if (xm & 16) { lds_barrier(); continue; }
        lds_barrier();
#pragma unroll
        for (int m = 0; m < 4; ++m) { const f32x4 ot = o[m] + ofv[m];
#pragma unroll
            for (int j = 0; j < 4; ++j) *(LAS float*)(lds + HG_QT + (16 * m + 4 * fq + j) * OSF + (16 * wave + fr) * 4) = ot[j]; }
        lds_barrier();
#pragma unroll
        for (int i = 0; i < 2; ++i) { const int t = (tid >> 4) + 32 * i, c8 = (tid & 15) * 8;
            const f32x4 v0 = *(const LAS f32x4*)(lds + HG_QT + t * OSF + c8 * 4), v1 = *(const LAS f32x4*)(lds + HG_QT + t * OSF + c8 * 4 + 16);
            const float ss = row_allsum16((v0[0] * v0[0] + v0[1] * v0[1]) + (v0[2] * v0[2] + v0[3] * v0[3]) + (v1[0] * v1[0] + v1[1] * v1[1]) + (v1[2] * v1[2] + v1[3] * v1[3]));
            const float rinv = __builtin_amdgcn_rsqf(ss * (1.0f / 128.0f) + LN_EPS);
            const u32x4 g = gq[i];
            u32x4 w;
            w.x = cvt2(v0[0] * rinv * ngv[0][0] * bf_lo(g.x), v0[1] * rinv * ngv[0][1] * bf_hi(g.x)); w.y = cvt2(v0[2] * rinv * ngv[0][2] * bf_lo(g.y), v0[3] * rinv * ngv[0][3] * bf_hi(g.y));
            w.z = cvt2(v1[0] * rinv * ngv[1][0] * bf_lo(g.z), v1[1] * rinv * ngv[1][1] * bf_hi(g.z)); w.w = cvt2(v1[2] * rinv * ngv[1][2] * bf_lo(g.w), v1[3] * rinv * ngv[1][3] * bf_hi(g.w));
            *(u32x4*)(mixed + (size_t)(rowbase + c * 64 + t) * DM + 512 + hd * 128 + c8) = w; }
    }
}

__device__ __forceinline__ void p_scan_a(LAS unsigned char* lds, const Args& a, int bid, int G, int tid, int wave, int lane, int mask = 3, int xr = 0) {
    constexpr int N_HG = NB * 4 * 2 * HG_SEGS, N_RG = NB * RG_UNITS_PER_B;
    if (mask & 1) {
        const bool bal = G == 256;
        const int hn = bal ? (bid < 128 ? 9 : (bid < 192 ? 8 : 6)) : (2048 - bid + G - 1) / G;
        const int hs = bal ? (bid < 128 ? 9 * bid : (bid < 192 ? 1152 + 8 * (bid - 128) : 1664 + 6 * (bid - 192))) : bid, hstep = bal ? 1 : G;
#pragma unroll 1
        for (int k = 0; k < hn; ++k) {
            int t2 = tid; asm volatile("" : "+v"(t2)); const int tid = t2, lane = t2 & 63;
            const int it = hs + k * hstep, s16 = it & 15, rest = it >> 4, dir = rest & 1, hd = (rest >> 1) & 3, b = rest >> 3;
            const int sidx = dir == 0 ? s16 : (s16 == 0 ? 0 : s16 + 1), unit = rest * HG_SEGS + sidx;
            if (dir == 0) hg_agg_unit<0>(lds, a, b, hd, sidx, unit, tid, wave, lane); else hg_agg_unit<1>(lds, a, b, hd, sidx, unit, tid, wave, lane);
        }
    }
    if (mask & 2) {
        __syncthreads();
        u32x4 raw[11];
        int r = G - 1 - bid;
        if (r < N_RG) rg_load_raw(raw, (const bf16_t*)(a.ws + WS_PROJ), r / RG_UNITS_PER_B, r % RG_UNITS_PER_B, tid);
#pragma unroll 1
        for (; r < N_RG; r += G) {
            int t2 = tid; asm volatile("" : "+v"(t2)); const int tid = t2, lane = t2 & 63;
            const int rn = r + G;
            rg_agg_unit(lds, a, r / RG_UNITS_PER_B, r % RG_UNITS_PER_B, raw, rn / RG_UNITS_PER_B, rn < N_RG ? rn % RG_UNITS_PER_B : -1, tid, wave, lane, xr);
        }
    }
}
__device__ __forceinline__ void p_scan_b(const Args& a, int bid, int G, int tid, bool dry = false) {
#pragma unroll 1
    for (int it = bid; it < 1024; it += G) hg_carry_item(a, it, tid, dry);
    if (bid >= G - 32) rg_carry_item(a, bid - (G - 32), tid);
}
__device__ __forceinline__ void p_scan_c(LAS unsigned char* lds, const Args& a, int bid, int G, int tid, int wave, int lane, int mask = 3, int xm = 0) {
#pragma unroll 1
    for (int it = bid; it < ((mask & 1) ? 1024 : 0); it += G) { const int seg = it & 15, hd = (it >> 4) & 3, b = it >> 6; int t2 = tid; asm volatile("" : "+v"(t2)); hg_final_unit(lds, a, b, hd, seg, t2, wave, t2 & 63, xm); }
    if (mask & 2) {
        __syncthreads();
        u32x4 g[8], st[2][4];
        int r = bid;
        if (r < 1024) rg_final_load(g, st, a, r >> 6, r & 63, tid, wave, lane);
#pragma unroll 1
        for (; r < 1024; r += G) {
            int t2 = tid; asm volatile("" : "+v"(t2)); const int rn = r + G;
            rg_final_unit(lds, a, r >> 6, r & 63, g, st, rn >> 6, rn < 1024 ? (rn & 63) : -1, t2, wave, t2 & 63);
        }
    }
}

#define GAS __attribute__((address_space(1)))
#define RLX_AGENT __ATOMIC_RELAXED, __HIP_MEMORY_SCOPE_AGENT
#define XB_TMO      128
#define XB_XCNT(j)  (256  + 64 * (j))
#define XB_XSUB(j)  (1280 + 64 * (j))
#define XB_XGEN(j)  (2304 + 64 * (j))
#define XB_TOP      3328
#define XB_TOPGEN   3392
#define XCD_BAR_WORDS 3456
#define XB_SPIN_CAP (1u << 18)

__device__ __forceinline__ unsigned xb_ld(unsigned* p)              { return __hip_atomic_load(p, __ATOMIC_RELAXED, __HIP_MEMORY_SCOPE_AGENT); }
__device__ __forceinline__ unsigned xb_add(unsigned* p, unsigned v) { return __hip_atomic_fetch_add(p, v, __ATOMIC_RELAXED, __HIP_MEMORY_SCOPE_AGENT); }
__device__ __forceinline__ unsigned xb_xcc_id() { return (unsigned)__builtin_amdgcn_s_getreg((3 << 11) | 20) & 0xFu; }
#define XB_SPIN(cond, bar) do { unsigned _sp = 0; while (cond) { __builtin_amdgcn_s_sleep(1); \
    if ((++_sp & 255u) == 0u) { if (xb_ld(&(bar)[XB_TMO])) break; if (_sp > XB_SPIN_CAP) { atomicAdd(&(bar)[XB_TMO], 1u); break; } } } } while (0)

struct XcdBarrier {
    unsigned* bar; unsigned x;
    volatile LAS unsigned* st;
};

__device__ __forceinline__ XcdBarrier xcd_barrier_post(unsigned* bar, volatile LAS unsigned* st) {
    XcdBarrier b; b.bar = bar; b.x = xb_xcc_id(); b.st = st;
    if (threadIdx.x == 0) (void)xb_add(&bar[XB_XCNT(b.x)], 1u);
    return b;
}
__device__ __forceinline__ void xcd_barrier_complete(unsigned* bar, unsigned x, unsigned& nloc, unsigned& nx) {
    const unsigned G = gridDim.x * gridDim.y * gridDim.z;
    unsigned sum, cnt, mine, sp = 0u;
    for (;;) {
        sum = 0u; cnt = 0u; mine = 0u;
#pragma unroll
        for (unsigned j = 0; j < 16; ++j) { const unsigned c = xb_ld(&bar[XB_XCNT(j)]); sum += c; cnt += (c > 0u) ? 1u : 0u; mine = (j == x) ? c : mine; }
        if (sum == G) break;
        __builtin_amdgcn_s_sleep(1);
        if ((++sp & 255u) == 0u) { if (xb_ld(&bar[XB_TMO])) break; if (sp > XB_SPIN_CAP) { atomicAdd(&bar[XB_TMO], 1u); break; } }
    }
    nloc = mine > 0u ? mine : 1u; nx = cnt > 0u ? cnt : 1u;
}

__device__ __forceinline__ void xcd_barrier(const XcdBarrier& b) {
    asm volatile("s_waitcnt vmcnt(0)" ::: "memory");
    __syncthreads();
    if (threadIdx.x == 0) {
        unsigned* bar = b.bar;
        __builtin_amdgcn_s_waitcnt(0);
        unsigned nloc = b.st[0], nx = b.st[1];
        if (nloc == 0u) { xcd_barrier_complete(bar, b.x, nloc, nx); b.st[0] = nloc; b.st[1] = nx; }
        const unsigned old = xb_add(&bar[XB_XSUB(b.x)], 1u);
        const unsigned gen = old / nloc;
        if (old + 1u == (gen + 1u) * nloc) {
            __builtin_amdgcn_fence(__ATOMIC_RELEASE, "agent");
            asm volatile("s_waitcnt vmcnt(0)" ::: "memory");
            const unsigned og = xb_add(&bar[XB_TOP], 1u);
            const unsigned tg = og / nx;
            if (og + 1u == (tg + 1u) * nx) xb_add(&bar[XB_TOPGEN], 1u);
            else XB_SPIN(xb_ld(&bar[XB_TOPGEN]) == tg, bar);
            __builtin_amdgcn_fence(__ATOMIC_ACQUIRE, "agent");
            xb_add(&bar[XB_XGEN(b.x)], 1u);
            asm volatile("s_waitcnt vmcnt(0)" ::: "memory");
        } else {
            XB_SPIN(xb_ld(&bar[XB_XGEN(b.x)]) == gen, bar);
            __builtin_amdgcn_fence(__ATOMIC_ACQUIRE, "agent");
            asm volatile("s_waitcnt vmcnt(0)" ::: "memory");
        }
    }
    __syncthreads();
}


__device__ __forceinline__ void stagger_wait(unsigned ticks) {
    if (ticks == 0u) return;
    const unsigned long long t0 = __builtin_amdgcn_s_memrealtime();
    while (__builtin_amdgcn_s_memrealtime() - t0 < ticks) __builtin_amdgcn_s_sleep(16);
}
#ifndef STAG_P2
#define STAG_P2 0
#endif

__global__ void __launch_bounds__(NTHREADS, 2) mega(Args a) {
    extern __shared__ __attribute__((aligned(16))) unsigned char lds_raw[];
    LAS unsigned char* lds = (LAS unsigned char*)lds_raw;
    const int wave = __builtin_amdgcn_readfirstlane(threadIdx.x >> 6), bid = blockIdx.x, G = gridDim.x;
    int tid = threadIdx.x, lane = tid & 63;
#define FRESH_TID() do { tid = threadIdx.x; asm volatile("" : "+v"(tid)); lane = tid & 63; } while (0)
    unsigned char* ws = a.ws;
    volatile LAS unsigned* bst = (volatile LAS unsigned*)(lds + LDS_BYTES - 64);
    if (threadIdx.x < 2) bst[threadIdx.x] = 0u;
    __syncthreads();
    XcdBarrier xbar = xcd_barrier_post((unsigned*)(ws + WS_BAR), bst);
#define GRID_BAR() xcd_barrier(xbar)
    float* mod = (float*)(ws + WS_MOD);
    bf16_t* U = (bf16_t*)(ws + WS_U);
    bf16_t* PROJ = (bf16_t*)(ws + WS_PROJ); bf16_t* MIXED = (bf16_t*)(ws + WS_MIXED);

    p_mod(lds, a.in[1], a.in[3], a.in[4], a.in[5], mod, bid, G, tid);
    p_transposes(lds, a, bid, G, tid);
    p_gwt(a.in[9], (bf16_t*)(ws + WS_GWT), bid, G, tid);
    p_rgpar(a.in[10], a.in[11], (float*)(ws + WS_RGPAR), bid, G, tid);
    p_wrt(a.in[17], a.in[19], (bf16_t*)(ws + WS_WRT), bid, G, tid);
    GRID_BAR();
    FRESH_TID();
    p_u(a.in[0], a.in[2], mod, U, bid, G, tid);
    GRID_BAR();
    FRESH_TID();
    { pg8::Gemm g{U, (const bf16_t*)(ws + WS_WINT), TA, NIN, DM}; pg8::StaticOrder S; S.init(TA, NIN, G, bid);
      pg8::EpiInProj E{PROJ, 0, 0};
      pg8::gemm_phase<pg8::EpiInProj, pg8::StaticOrder, true, true>(lds, g, S, E); }
    GRID_BAR();
    FRESH_TID();
    p_scan_a(lds, a, bid, G, tid, wave, lane);
    GRID_BAR();
    FRESH_TID();
    p_scan_b(a, bid, G, tid);
    GRID_BAR();
    FRESH_TID();
    p_scan_c(lds, a, bid, G, tid, wave, lane);
    GRID_BAR();
    FRESH_TID();
    { pg8::Gemm g{MIXED, (const bf16_t*)(ws + WS_WOUTT), T, DM, DM}; pg8::StaticOrder S; S.init(T, DM, G, bid);
      pg8::EpiY E{(bf16_t*)(ws + WS_XG)};
      pg8::gemm_phase<pg8::EpiY, pg8::StaticOrder, true, true>(lds, g, S, E); }
    GRID_BAR();
    FRESH_TID();
    p_ln1_router(lds, a, bid, G, tid, wave, lane);
    GRID_BAR();
    FRESH_TID();
    p_assign(lds, a, bid, G, tid);
    GRID_BAR();
    FRESH_TID();
    { pg8::Gemm g{(const bf16_t*)(ws + WS_U), (const bf16_t*)(ws + WS_W13T), MAXROWS, NE * DM, DM}; pg8::ExpertOrderG S{(const int*)(ws + WS_RBPRE), (const int*)(ws + WS_ROWTOK), G, bid};
      pg8::EpiExp1 E{(bf16_t*)(ws + WS_HID)};
      pg8::gemm_phase<pg8::EpiExp1, pg8::ExpertOrderG, true, true>(lds, g, S, E); }
    GRID_BAR();
    FRESH_TID();
    { pg8::Gemm g{(const bf16_t*)(ws + WS_HID), (const bf16_t*)(ws + WS_W2T), MAXROWS, NE * DM, DE}; pg8::ExpertOrder S{(const int*)(ws + WS_RBPRE), nullptr, G, bid};
      pg8::EpiY E{(bf16_t*)(ws + WS_Y)};
      pg8::gemm_phase<pg8::EpiY, pg8::ExpertOrder, true, true>(lds, g, S, E); }
    GRID_BAR();
    FRESH_TID();
    p_combine_ln2(a, bid, G, wave, lane);
}

extern "C" void kernel_launch(void* const* d_in, const int* in_sizes, int n_in, void* d_out, int out_size, void* d_ws, size_t ws_size, hipStream_t stream) {
    static int grid = 0;
    if (grid == 0) {
        if (n_in != 26 || ws_size < WS_END) { fprintf(stderr, "kernel_launch: unexpected n_in %d or workspace %zu < %zu\n", n_in, ws_size, (size_t)WS_END); grid = -1; return; }
        int dev = 0, cus = 0, per_cu = 0;
        if (hipGetDevice(&dev) != hipSuccess || hipDeviceGetAttribute(&cus, hipDeviceAttributeMultiprocessorCount, dev) != hipSuccess) { grid = -1; return; }
        if (hipFuncSetAttribute((const void*)mega, hipFuncAttributeMaxDynamicSharedMemorySize, LDS_BYTES) != hipSuccess) { fprintf(stderr, "kernel_launch: hipFuncSetAttribute failed\n"); grid = -1; return; }
        if (hipOccupancyMaxActiveBlocksPerMultiprocessor(&per_cu, (const void*)mega, NTHREADS, LDS_BYTES) != hipSuccess || per_cu < 1) { fprintf(stderr, "kernel_launch: occupancy query says %d\n", per_cu); per_cu = 1; }
        (void)hipGetLastError();
        grid = cus;
        fprintf(stderr, "kernel_launch: grid %d (cus %d, per_cu %d), ws %zu\n", grid, cus, per_cu, ws_size);
    }
    if (grid < 0) return;
    (void)hipMemsetAsync(d_ws, 0, 131072, stream);
    Args a{};
    for (int i = 0; i < 26; ++i) a.in[i] = (const float*)d_in[i];
    a.out = (float*)d_out; a.ws = (unsigned char*)d_ws;
    void* params[] = {&a};
    hipError_t e = hipLaunchCooperativeKernel((const void*)mega, dim3(grid), dim3(NTHREADS), params, LDS_BYTES, stream);
    if (e != hipSuccess) fprintf(stderr, "kernel_launch: cooperative launch failed: %s (grid %d)\n", hipGetErrorString(e), grid);
}
```

```cpp
#include <hip/hip_runtime.h>
#include <hip/hip_cooperative_groups.h>
#include <cstdio>
#include <cstdint>
namespace cg = cooperative_groups;

typedef unsigned short bf16_t;
typedef short bf16x8 __attribute__((ext_vector_type(8)));
typedef float f32x4 __attribute__((ext_vector_type(4)));
typedef float f32x2 __attribute__((ext_vector_type(2)));
typedef unsigned u32x4 __attribute__((ext_vector_type(4)));
typedef unsigned u32x2 __attribute__((ext_vector_type(2)));
typedef int i32x4 __attribute__((ext_vector_type(4)));
#define LAS __attribute__((address_space(3)))

constexpr int NB = 16, SEQ = 4096, LC = 256, DM = 1024;
constexpr int T = NB * SEQ;
constexpr int TC = NB * LC;
constexpr int TA = T + TC;
constexpr int NIN = 3584;
constexpr int NE = 32, DE = 512;
constexpr int MAXROWS = 2 * T + NE * 256;
constexpr float ALPHA = 1.189207115002721f;
constexpr float LN_EPS = 1e-6f;
constexpr int NTHREADS = 512;

constexpr size_t MiB = 1u << 20;
constexpr size_t WS_CTL = 0;
constexpr size_t WS_BAR = 65536;
constexpr size_t WS_MOD = 1 * MiB;
constexpr size_t WS_EIDX = 3 * MiB;
constexpr size_t WS_EPOS = 3 * MiB + 512 * 1024;
constexpr size_t WS_EW = 4 * MiB;
constexpr size_t WS_DEST = 4 * MiB + 512 * 1024;
constexpr size_t WS_WINT = 6 * MiB;
constexpr size_t WS_WOUTT = 13 * MiB;
constexpr size_t WS_W13T = 15 * MiB;
constexpr size_t WS_W2T = 79 * MiB;
constexpr size_t WS_U = 112 * MiB;
constexpr size_t WS_PROJ = 248 * MiB;
constexpr size_t WS_XG = 248 * MiB;
constexpr size_t WS_HID = 520 * MiB;
constexpr size_t WS_Y = 656 * MiB;
constexpr size_t WS_MIXED = 724 * MiB;
constexpr size_t WS_OSUM = 852 * MiB;
constexpr size_t WS_END = 980 * MiB;
constexpr int LDS_BYTES = 163840;

__device__ __forceinline__ const bf16_t* proj_at(const bf16_t* P, int row, int col) { return P + (((size_t)(col >> 5) * TA + row) << 5) + (col & 31); }

template <class V> __device__ __forceinline__ V ntld(const V* p) { return __builtin_nontemporal_load(p); }
template <class V> __device__ __forceinline__ void ntst(V* p, V v) { __builtin_nontemporal_store(v, p); }

__device__ __forceinline__ float bf2f(bf16_t b) { return __uint_as_float(((unsigned)b) << 16); }
__device__ __forceinline__ bf16_t f2bf(float f) { unsigned u = __float_as_uint(f); return (bf16_t)((u + 0x7fffu + ((u >> 16) & 1u)) >> 16); }
__device__ __forceinline__ unsigned pk2(float lo, float hi) { unsigned r; asm volatile("v_cvt_pk_bf16_f32 %0, %1, %2" : "=v"(r) : "v"(lo), "v"(hi)); return r; }
__device__ __forceinline__ float frcp(float x) { return __builtin_amdgcn_rcpf(x); }
__device__ __forceinline__ float sigmoidf_(float x) { return frcp(1.0f + __expf(-x)); }
__device__ __forceinline__ float siluf_(float x) { return x * frcp(1.0f + __expf(-x)); }
__device__ __forceinline__ float gelu_tanh(float x) {
    const float y = 0.7978845608028654f * (x + 0.044715f * x * x * x);
    return x * frcp(1.0f + __expf(-2.0f * y));
}
__device__ __forceinline__ float softplusf_(float x) { return fmaxf(x, 0.f) + log1pf(expf(-fabsf(x))); }
__device__ __forceinline__ float wave_sum(float v) {
#pragma unroll
    for (int o = 1; o < 64; o <<= 1) v += __shfl_xor(v, o);
    return v;
}
constexpr int CSTR = 64;
__device__ __forceinline__ int pstart_of(const int* __restrict__ counts, int e) {
    int acc = 0;
    for (int i = 0; i < NE; ++i) { const int p = ((counts[i * CSTR] + 255) >> 8) << 8; if (i < e) acc += p; }
    return acc;
}

namespace pg8 {
#define PG8_LAS __attribute__((address_space(3)))
typedef unsigned short bf16_t;
typedef short bf16x8 __attribute__((ext_vector_type(8)));
typedef float f32x4 __attribute__((ext_vector_type(4)));
typedef unsigned u32x4 __attribute__((ext_vector_type(4)));
constexpr int BM = 256, BK = 64, HALF = 128, HTB = HALF * BK * 2  , STAGE_BYTES = 8 * HTB, NXCD = 8, WGM = 8;

__host__ __device__ __forceinline__ int lds_byte(int r, int c) { const int st = (r >> 4) * 2 + (c >> 5), rr = r & 15, cc = c & 31, ob = rr * 64 + cc * 2; return st * 1024 + (ob ^ (((ob >> 9) & 1) << 5)); }
__host__ __device__ __forceinline__ void stage_rc(int b, int& R, int& C) { const int st = b / 1024, sb = b % 1024, swz = sb ^ (((sb >> 9) & 1) << 5); R = (st >> 1) * 16 + swz / 64; C = (st & 1) * 32 + (swz % 64) / 2; }
__host__ __device__ __forceinline__ int perm32(int rho) { const int n = rho >> 4, i = rho & 15; return 8 * (i >> 2) + 4 * n + (i & 3); }

struct Unit { int pm, pn; };
struct Gemm { const bf16_t* A; const bf16_t* Bt; int M, N, K; };

struct StaticOrder {
    static constexpr bool GATHER = false; const int* rowtok = nullptr;
    int nM, nN, nwg, G, c;
    __host__ __device__ void init(int M, int N, int G_, int c_) { nM = M / BM; nN = N / BM; nwg = nM * nN; G = G_; c = c_; }
    __host__ __device__ bool next(int i, Unit& u) const {
        const long L = (long)i * G + c; if (L >= nwg) return false;
        int wgid = (int)L; { const int q = nwg / NXCD, r = nwg % NXCD, xcd = wgid % NXCD, off = wgid / NXCD; wgid = (xcd < r ? xcd * (q + 1) : r * (q + 1) + (xcd - r) * q) + off; }
        const int nig = WGM * nN, gid = wgid / nig, fm = gid * WGM, gsz = (nM - fm) < WGM ? (nM - fm) : WGM;
        u.pm = fm + ((wgid % nig) % gsz); u.pn = (wgid % nig) / gsz; return true;
    }
    __device__ __forceinline__ void a_ready(const Unit&) const {}
    __device__ __forceinline__ void done(const Unit&) const {}
};

__device__ __forceinline__ unsigned cvt_pk_bf16(float lo, float hi) { unsigned r; asm volatile("v_cvt_pk_bf16_f32 %0, %1, %2" : "=v"(r) : "v"(lo), "v"(hi)); return r; }

struct EpiInProj {
    static constexpr bool PERM = true, AFTER_DRAIN = false;
    bf16_t* P; int variant; int pad;
    __device__ __forceinline__ void operator()(const f32x4 (&acc)[2][2][4][2], const Unit& u, int wr, int wc, int fr_, int fq_) const {
        int fr = fr_, fq = fq_; asm volatile("" : "+v"(fr), "+v"(fq));
        const int row0 = u.pm * BM + wr * 64 + fr, col0 = u.pn * BM + wc * 32 + 8 * fq, grp = variant == 1 ? 0 : (u.pn >> 1);
#pragma unroll
        for (int ai = 0; ai < 2; ++ai)
#pragma unroll
            for (int m = 0; m < 4; ++m) { bf16_t* rowp = P + (((size_t)(8 * u.pn + wc) * TA + (row0 + ai * HALF + m * 16)) << 5) + 8 * fq;
#pragma unroll
                for (int bj = 0; bj < 2; ++bj) { f32x4 v0 = acc[ai][bj][m][0], v1 = acc[ai][bj][m][1];
                    if (grp == 1) {
#pragma unroll
                        for (int j = 0; j < 4; ++j) { v0[j] = gelu_tanh(v0[j]); v1[j] = gelu_tanh(v1[j]); } }
                    else if (grp == 2 || grp == 6) {
#pragma unroll
                        for (int j = 0; j < 4; ++j) { v0[j] = siluf_(v0[j]); v1[j] = siluf_(v1[j]); } }
                    u32x4 w; w.x = cvt_pk_bf16(v0[0], v0[1]); w.y = cvt_pk_bf16(v0[2], v0[3]); w.z = cvt_pk_bf16(v1[0], v1[1]); w.w = cvt_pk_bf16(v1[2], v1[3]);
                    if (variant == 3) { const int wv = __builtin_amdgcn_readfirstlane(threadIdx.x >> 6); *(u32x4*)(P + ((size_t)((u.pm * 14 + u.pn) * 8 + wv) * 16 + (ai * 4 + m) * 2 + bj) * 512 + (threadIdx.x & 63) * 8) = w; }
                    else if (variant != 2 || w.x == 0x12345678u) *(u32x4*)(rowp + (size_t)bj * 4 * TA * 32) = w; } }
    }
};
struct EpiNull {
    static constexpr bool PERM = true, AFTER_DRAIN = false;
    float* sink;
    __device__ __forceinline__ void operator()(const f32x4 (&acc)[2][2][4][2], const Unit& u, int wr, int wc, int fr_, int fq_) const {
        float s = 0.f;
#pragma unroll
        for (int ai = 0; ai < 2; ++ai)
#pragma unroll
            for (int bj = 0; bj < 2; ++bj)
#pragma unroll
                for (int m = 0; m < 4; ++m)
#pragma unroll
                    for (int n = 0; n < 2; ++n) s += acc[ai][bj][m][n][0] + acc[ai][bj][m][n][1] + acc[ai][bj][m][n][2] + acc[ai][bj][m][n][3];
        if (s == 123.456f) sink[0] = s;
    }
};
struct EpiF32 {
    static constexpr bool PERM = false, AFTER_DRAIN = false;
    float* C; int ldc; int pad;
    __device__ __forceinline__ void operator()(const f32x4 (&acc)[2][2][4][2], const Unit& u, int wr, int wc, int fr_, int fq_) const {
        int fr = fr_, fq = fq_; asm volatile("" : "+v"(fr), "+v"(fq));
        const int row0 = u.pm * BM + wr * 64 + fr, col0 = u.pn * BM + wc * 32 + 4 * fq;
#pragma unroll
        for (int ai = 0; ai < 2; ++ai)
#pragma unroll
            for (int m = 0; m < 4; ++m) { float* rowp = C + (size_t)(row0 + ai * HALF + m * 16) * ldc + col0;
#pragma unroll
                for (int bj = 0; bj < 2; ++bj)
#pragma unroll
                    for (int n = 0; n < 2; ++n) *(f32x4*)(rowp + bj * HALF + n * 16) = acc[ai][bj][m][n]; }
    }
};
struct EpiExp1 {
    static constexpr bool PERM = true, AFTER_DRAIN = false;
    bf16_t* H;
    __device__ __forceinline__ void operator()(const f32x4 (&acc)[2][2][4][2], const Unit& u, int wr, int wc, int fr_, int fq_) const {
        int fr = fr_, fq = fq_; asm volatile("" : "+v"(fr), "+v"(fq));
        const int row0 = u.pm * BM + wr * 64 + fr, hc0 = (u.pn & 3) * 128 + wc * 32 + 8 * fq;
#pragma unroll
        for (int ai = 0; ai < 2; ++ai)
#pragma unroll
            for (int m = 0; m < 4; ++m) { bf16_t* rowp = H + (size_t)(row0 + ai * HALF + m * 16) * DE + hc0;
                const f32x4 a0 = acc[ai][0][m][0], a1 = acc[ai][0][m][1], b0 = acc[ai][1][m][0], b1 = acc[ai][1][m][1];
                u32x4 w; w.x = cvt_pk_bf16(siluf_(a0[0]) * b0[0], siluf_(a0[1]) * b0[1]); w.y = cvt_pk_bf16(siluf_(a0[2]) * b0[2], siluf_(a0[3]) * b0[3]);
                w.z = cvt_pk_bf16(siluf_(a1[0]) * b1[0], siluf_(a1[1]) * b1[1]); w.w = cvt_pk_bf16(siluf_(a1[2]) * b1[2], siluf_(a1[3]) * b1[3]);
                *(u32x4*)rowp = w; }
    }
};
struct EpiY {
    static constexpr bool PERM = true, AFTER_DRAIN = false;
    bf16_t* Y;
    __device__ __forceinline__ void operator()(const f32x4 (&acc)[2][2][4][2], const Unit& u, int wr, int wc, int fr_, int fq_) const {
        int fr = fr_, fq = fq_; asm volatile("" : "+v"(fr), "+v"(fq));
        const int row0 = u.pm * BM + wr * 64 + fr, col0 = (u.pn & 3) * BM + wc * 32 + 8 * fq;
#pragma unroll
        for (int ai = 0; ai < 2; ++ai)
#pragma unroll
            for (int m = 0; m < 4; ++m) { bf16_t* rowp = Y + (size_t)(row0 + ai * HALF + m * 16) * DM + col0;
#pragma unroll
                for (int bj = 0; bj < 2; ++bj) { const f32x4 v0 = acc[ai][bj][m][0], v1 = acc[ai][bj][m][1];
                    u32x4 w; w.x = cvt_pk_bf16(v0[0], v0[1]); w.y = cvt_pk_bf16(v0[2], v0[3]); w.z = cvt_pk_bf16(v1[0], v1[1]); w.w = cvt_pk_bf16(v1[2], v1[3]);
                    *(u32x4*)(rowp + bj * HALF) = w; } }
    }
};
struct InProjOrder {
    static constexpr bool GATHER = false; const int* rowtok = nullptr;
    StaticOrder lat; int G, c;
    __device__ __forceinline__ void init(int G_, int c_) { lat.init(T, NIN, G_, c_); G = G_; c = c_; }
    __device__ __forceinline__ bool next(int i, Unit& u) const {
        const int L = i * G + c;
        if (L < lat.nwg) return lat.next(i, u);
        const int r = L - lat.nwg; if (r >= 16 * 8) return false;
        const int ct = r & 7; u.pm = 256 + (r >> 3); u.pn = ct < 2 ? ct : (ct < 6 ? ct + 4 : ct + 4);
        return true;
    }
    __device__ __forceinline__ void a_ready(const Unit&) const {}
    __device__ __forceinline__ void done(const Unit&) const {}
};
template <bool GATHER_>
struct ExpertOrderT {
    static constexpr bool GATHER = GATHER_;
    const int* rbpre; const int* rowtok; int G, c;
    __device__ __forceinline__ bool next(int i, Unit& u) const {
        const int cs = (G & 7) == 0 ? (c & 7) * (G >> 3) + (c >> 3) : c;
        const int L = i * G + cs, rb = L >> 2; int ef = -1;
        for (int e = 0; e < NE; ++e) { if (rb >= rbpre[e] && rb < rbpre[e + 1]) ef = e; }
        if (ef < 0) return false;
        u.pm = rb; u.pn = ef * 4 + (L & 3); return true;
    }
    __device__ __forceinline__ void a_ready(const Unit&) const {}
    __device__ __forceinline__ void done(const Unit&) const {}
};
typedef ExpertOrderT<false> ExpertOrder;
typedef ExpertOrderT<true> ExpertOrderG;

template <class Epi, class Sched, bool ALIGN_EPI = false, bool SP2 = false>
__device__ __forceinline__ void gemm_phase(PG8_LAS unsigned char* lds, const Gemm g, const Sched& S, const Epi& E) {
    int tid_o = threadIdx.x; asm volatile("" : "+v"(tid_o));
    const int tid = tid_o, wid = __builtin_amdgcn_readfirstlane(tid >> 6), lane = tid & 63, wr = wid >> 2, wc = wid & 3, fr = lane & 15, fq = lane >> 4;
    static_assert(SP2 || !Sched::GATHER, "the gathered A operand is wired into the SP2 loop only");
    const int K = g.K, nt = K / BK;
    unsigned voffA[2], voffB[2];
    unsigned gAc[2][2], gAn[2][2]; int gR[2], gC[2];
#pragma unroll
    for (int i = 0; i < 2; ++i) { int R, C; stage_rc(tid * 16 + i * 8192, R, C); const int Rb = Epi::PERM ? ((R & ~31) + perm32(R & 31)) : R;
        voffA[i] = (unsigned)(R * K + C) * 2u; voffB[i] = (unsigned)(Rb * K + C) * 2u; gR[i] = R; gC[i] = C; }
    const size_t kstep = (size_t)(BK * 2);
    const size_t hstep = (size_t)HALF * K * 2;
    const size_t tstep = 2 * hstep;
    const unsigned ldsw = (unsigned)wid * 1024u;
    const int aoff = lds_byte(wr * 64 + fr, fq * 8), boff = lds_byte(wc * 32 + fr, fq * 8);
#define PG8_SA(b, h) (((b) * 2 + (h)) * HTB)
#define PG8_SB(b, h) ((4 + (b) * 2 + (h)) * HTB)
#define PG8_STAGE(bufoff, gbase, voff) do { _Pragma("unroll") for (int _i = 0; _i < 2; ++_i) \
        __builtin_amdgcn_global_load_lds((const unsigned*)((const char*)(gbase) + (voff)[_i]), (PG8_LAS unsigned*)(lds + (bufoff) + ldsw + _i * 8192), 16, 0, 0); } while (0)
#define PG8_STAGE_A(bufoff, ptr, h, goff) do { if constexpr (Sched::GATHER) { PG8_STAGE(bufoff, ptr, (goff)[h]); } else { PG8_STAGE(bufoff, (ptr) + (h) * hstep, voffA); } } while (0)
#define PG8_GLOAD(dst, u) do { _Pragma("unroll") for (int _h = 0; _h < 2; ++_h) _Pragma("unroll") for (int _i = 0; _i < 2; ++_i) \
        dst[_h][_i] = (unsigned)S.rowtok[(u).pm * BM + _h * HALF + gR[_i]] * (unsigned)(K * 2) + (unsigned)(gC[_i] * 2); } while (0)
#define PG8_LDA(dst, b, h) do { _Pragma("unroll") for (int m = 0; m < 4; ++m) _Pragma("unroll") for (int k = 0; k < 2; ++k) dst[m][k] = *(const PG8_LAS bf16x8*)(lds + PG8_SA(b, h) + aoff + m * 2048 + k * 1024); } while (0)
#define PG8_LDB(dst, b, h) do { _Pragma("unroll") for (int n = 0; n < 2; ++n) _Pragma("unroll") for (int k = 0; k < 2; ++k) dst[n][k] = *(const PG8_LAS bf16x8*)(lds + PG8_SB(b, h) + boff + n * 2048 + k * 1024); } while (0)
#define PG8_MMA(ai, bj, At, Bt) do { __builtin_amdgcn_s_setprio(1); _Pragma("unroll") for (int m = 0; m < 4; ++m) _Pragma("unroll") for (int n = 0; n < 2; ++n) _Pragma("unroll") for (int k = 0; k < 2; ++k) \
        acc[ai][bj][m][n] = __builtin_amdgcn_mfma_f32_16x16x32_bf16(Bt[n][k], At[m][k], acc[ai][bj][m][n], 0, 0, 0); __builtin_amdgcn_s_setprio(0); } while (0)
#define PG8_WAIT_V(n) asm volatile("s_waitcnt vmcnt(" #n ")" ::: "memory")
#define PG8_WAIT_L(n) asm volatile("s_waitcnt lgkmcnt(" #n ")" ::: "memory")
#define PG8_BAR __builtin_amdgcn_s_barrier()
#define PG8_SCHED __builtin_amdgcn_sched_barrier(0)
    Unit cur, nxt; int ui = 0;
    if (!S.next(0, cur)) return;
    f32x4 acc[2][2][4][2];
#pragma unroll
    for (int a = 0; a < 2; ++a)
#pragma unroll
        for (int b = 0; b < 2; ++b)
#pragma unroll
            for (int m = 0; m < 4; ++m)
#pragma unroll
                for (int n = 0; n < 2; ++n) acc[a][b][m][n] = (f32x4){0.f, 0.f, 0.f, 0.f};
    bf16x8 At[4][2], B0[2][2], B1[2][2];
    const char* cA = (const char*)g.A + (Sched::GATHER ? (size_t)0 : (size_t)cur.pm * tstep); const char* cB = (const char*)g.Bt + (size_t)cur.pn * tstep;
    if constexpr (Sched::GATHER) { PG8_GLOAD(gAc, cur); }
    S.a_ready(cur);
    if constexpr (SP2) {
        PG8_STAGE(PG8_SB(0, 0), cB, voffB); PG8_STAGE(PG8_SB(0, 1), cB + hstep, voffB); PG8_STAGE_A(PG8_SA(0, 0), cA, 0, gAc); PG8_STAGE_A(PG8_SA(0, 1), cA, 1, gAc);
        if (wr == 1) PG8_BAR;
        PG8_WAIT_V(2); PG8_BAR;
        PG8_STAGE(PG8_SB(1, 0), cB + kstep, voffB); PG8_STAGE_A(PG8_SA(1, 0), cA + kstep, 0, gAc); PG8_STAGE(PG8_SB(1, 1), cB + hstep + kstep, voffB);
        PG8_WAIT_V(6); PG8_BAR;
    } else {
        PG8_STAGE(PG8_SB(0, 0), cB, voffB); PG8_STAGE(PG8_SA(0, 0), cA, voffA); PG8_STAGE(PG8_SB(0, 1), cB + hstep, voffB); PG8_STAGE(PG8_SA(0, 1), cA + hstep, voffA);
        if (wr == 1) PG8_BAR;
        PG8_WAIT_V(4); PG8_BAR;
        PG8_STAGE(PG8_SB(1, 0), cB + kstep, voffB); PG8_STAGE(PG8_SA(1, 0), cA + kstep, voffA); PG8_STAGE(PG8_SB(1, 1), cB + hstep + kstep, voffB);
        PG8_WAIT_V(6); PG8_BAR;
    }
    for (;;) {
        const bool has_next = S.next(ui + 1, nxt);
        const char* nA = (has_next && !Sched::GATHER) ? (const char*)g.A + (size_t)nxt.pm * tstep : cA;
        if constexpr (Sched::GATHER) { if (has_next) { PG8_GLOAD(gAn, nxt); } else { _Pragma("unroll") for (int _h = 0; _h < 2; ++_h) _Pragma("unroll") for (int _i = 0; _i < 2; ++_i) gAn[_h][_i] = gAc[_h][_i]; } }
        const char* nB = has_next ? (const char*)g.Bt + (size_t)nxt.pn * tstep : cB;
        for (int t = 0; t < nt; t += 2) {
            const bool last = (t == nt - 2);
            const char* a1 = cA + (size_t)(t + 1) * kstep;
            const char* a2 = last ? nA : cA + (size_t)(t + 2) * kstep; const char* b2 = last ? nB : cB + (size_t)(t + 2) * kstep;
            const char* a3 = a2 + kstep; const char* b3 = b2 + kstep;
            if (last && has_next) S.a_ready(nxt);
            unsigned g2[2][2];
            if constexpr (Sched::GATHER) { _Pragma("unroll") for (int _h = 0; _h < 2; ++_h) _Pragma("unroll") for (int _i = 0; _i < 2; ++_i) g2[_h][_i] = last ? gAn[_h][_i] : gAc[_h][_i]; }
            if constexpr (SP2) {
            PG8_LDB(B0, 0, 0); PG8_LDB(B1, 0, 1); PG8_SCHED; PG8_LDA(At, 0, 0); PG8_STAGE_A(PG8_SA(1, 1), a1, 1, gAc);
            PG8_WAIT_V(8); PG8_WAIT_L(0); PG8_BAR; PG8_MMA(0, 0, At, B0); PG8_MMA(0, 1, At, B1); PG8_BAR; PG8_SCHED;
            PG8_LDA(At, 0, 1); PG8_STAGE(PG8_SB(0, 0), b2, voffB); PG8_STAGE(PG8_SB(0, 1), b2 + hstep, voffB); PG8_STAGE_A(PG8_SA(0, 0), a2, 0, g2);
            PG8_WAIT_V(8); PG8_WAIT_L(0); PG8_BAR; PG8_MMA(1, 0, At, B0); PG8_MMA(1, 1, At, B1); PG8_BAR; PG8_SCHED;
            PG8_LDB(B0, 1, 0); PG8_LDB(B1, 1, 1); PG8_SCHED; PG8_LDA(At, 1, 0); PG8_STAGE_A(PG8_SA(0, 1), a2, 1, g2);
            PG8_WAIT_V(8); PG8_WAIT_L(0); PG8_BAR; PG8_MMA(0, 0, At, B0); PG8_MMA(0, 1, At, B1); PG8_BAR; PG8_SCHED;
            PG8_LDA(At, 1, 1); PG8_STAGE(PG8_SB(1, 0), b3, voffB); PG8_STAGE(PG8_SB(1, 1), b3 + hstep, voffB); PG8_STAGE_A(PG8_SA(1, 0), a3, 0, g2);
            PG8_WAIT_V(8); PG8_WAIT_L(0); PG8_BAR; PG8_MMA(1, 0, At, B0); PG8_MMA(1, 1, At, B1); PG8_BAR; PG8_SCHED;
            } else {
            PG8_LDB(B0, 0, 0); PG8_SCHED; PG8_LDA(At, 0, 0); PG8_STAGE(PG8_SA(1, 1), a1 + hstep, voffA);
            PG8_WAIT_L(8); PG8_BAR; PG8_WAIT_L(0); PG8_MMA(0, 0, At, B0); PG8_BAR; PG8_SCHED;
            PG8_LDB(B1, 0, 1); PG8_STAGE(PG8_SB(0, 0), b2, voffB);
            PG8_BAR; PG8_WAIT_L(0); PG8_MMA(0, 1, At, B1); PG8_BAR;
            PG8_LDA(At, 0, 1); PG8_STAGE(PG8_SA(0, 0), a2, voffA);
            PG8_BAR; PG8_WAIT_L(0); PG8_MMA(1, 0, At, B0); PG8_BAR; PG8_SCHED;
            PG8_STAGE(PG8_SB(0, 1), b2 + hstep, voffB);
            PG8_WAIT_V(6); PG8_BAR; PG8_MMA(1, 1, At, B1); PG8_BAR;
            PG8_LDB(B0, 1, 0); PG8_SCHED; PG8_LDA(At, 1, 0); PG8_STAGE(PG8_SA(0, 1), a2 + hstep, voffA);
            PG8_WAIT_L(8); PG8_BAR; PG8_WAIT_L(0); PG8_MMA(0, 0, At, B0); PG8_BAR; PG8_SCHED;
            PG8_LDB(B1, 1, 1); PG8_STAGE(PG8_SB(1, 0), b3, voffB);
            PG8_BAR; PG8_WAIT_L(0); PG8_MMA(0, 1, At, B1); PG8_BAR;
            PG8_LDA(At, 1, 1); PG8_STAGE(PG8_SA(1, 0), a3, voffA);
            PG8_BAR; PG8_WAIT_L(0); PG8_MMA(1, 0, At, B0); PG8_BAR; PG8_SCHED;
            PG8_STAGE(PG8_SB(1, 1), b3 + hstep, voffB);
            PG8_WAIT_V(6); PG8_BAR; PG8_MMA(1, 1, At, B1); PG8_BAR;
            }
        }
        if constexpr (ALIGN_EPI) { if (wr == 0) PG8_BAR; }
        if constexpr (!Epi::AFTER_DRAIN) { E(acc, cur, wr, wc, fr, fq); S.done(cur); }
        if (!has_next) break;
#pragma unroll
        for (int a = 0; a < 2; ++a)
#pragma unroll
            for (int b = 0; b < 2; ++b)
#pragma unroll
                for (int m = 0; m < 4; ++m)
#pragma unroll
                    for (int n = 0; n < 2; ++n) acc[a][b][m][n] = (f32x4){0.f, 0.f, 0.f, 0.f};
        cur = nxt; cA = nA; cB = nB; ++ui;
        if constexpr (Sched::GATHER) { _Pragma("unroll") for (int _h = 0; _h < 2; ++_h) _Pragma("unroll") for (int _i = 0; _i < 2; ++_i) gAc[_h][_i] = gAn[_h][_i]; }
        if constexpr (ALIGN_EPI) { if (wr == 1) PG8_BAR; }
    }
    PG8_WAIT_V(0);
    if constexpr (!ALIGN_EPI) { if (wr == 0) PG8_BAR; }
    PG8_BAR;
    if constexpr (Epi::AFTER_DRAIN) { E.fused(acc, cur, wr, wc, fr, fq, lds, wid, lane); S.done(cur); }
#undef PG8_SA
#undef PG8_SB
#undef PG8_STAGE
#undef PG8_STAGE_A
#undef PG8_GLOAD
#undef PG8_LDA
#undef PG8_LDB
#undef PG8_MMA
#undef PG8_WAIT_V
#undef PG8_WAIT_L
#undef PG8_BAR
#undef PG8_SCHED
}
}

struct Args { const float* in[26]; float* out; unsigned char* ws; };

__device__ __forceinline__ void p_mod(LAS unsigned char* lds, const float* __restrict__ c, const float* __restrict__ c_ctx, const float* __restrict__ ada_w,
                                      const float* __restrict__ ada_b, float* __restrict__ mod, int bid, int G, int tid) {
    if (bid >= 96) return;
    LAS float* s = (LAS float*)lds;
    LAS float* red = s + 17 * 1024;
    for (int i = tid; i < 17 * 1024; i += NTHREADS) { const int r = i >> 10, k = i & 1023; const float v = r < NB ? c[r * DM + k] : c_ctx[k]; s[i] = v / (1.0f + expf(-v)); }
    __syncthreads();
    for (int it = bid; it < 96; it += G) {
        const int cc = tid & 63, kg = tid >> 6, col = it * 64 + cc;
        float acc[17];
#pragma unroll
        for (int r = 0; r < 17; ++r) acc[r] = 0.f;
        for (int k = kg * 128; k < kg * 128 + 128; ++k) {
            const float w = ntld(ada_w + (size_t)k * 6144 + col);
#pragma unroll
            for (int r = 0; r < 17; ++r) acc[r] += s[r * 1024 + k] * w;
        }
#pragma unroll
        for (int r = 0; r < 17; ++r) red[(kg * 17 + r) * 64 + cc] = acc[r];
        __syncthreads();
        for (int i = tid; i < 17 * 64; i += NTHREADS) {
            const int r = i >> 6, c2 = i & 63; float sum = 0.f;
#pragma unroll
            for (int g = 0; g < 8; ++g) sum += red[(g * 17 + r) * 64 + c2];
            mod[(size_t)r * 6144 + it * 64 + c2] = sum + ada_b[it * 64 + c2];
        }
        __syncthreads();
    }
}

struct TrTile { const float* W; bf16_t* O; int K, N, mode, k0, n0; };
__device__ __forceinline__ TrTile tr_decode(const Args& a, int r) {
    unsigned char* ws = a.ws;
    constexpr int I_IN = 16 * 56, I_OUT = 16 * 16, I_E = 32 * 128;
    TrTile t;
    if (r < I_IN) { t = TrTile{a.in[6], (bf16_t*)(ws + WS_WINT), DM, NIN, 0, (r & 15) * 64, (r >> 4) * 64}; return t; } r -= I_IN;
    if (r < I_OUT) { t = TrTile{a.in[14], (bf16_t*)(ws + WS_WOUTT), DM, DM, 0, (r & 15) * 64, (r >> 4) * 64}; return t; } r -= I_OUT;
    if (r < I_E) { const int e = r >> 7, q = r & 127; t = TrTile{a.in[21] + (size_t)e * DM * DE, (bf16_t*)(ws + WS_W13T) + (size_t)e * DM * DM, DM, DE, 1, (q & 15) * 64, (q >> 4) * 64}; return t; } r -= I_E;
    if (r < I_E) { const int e = r >> 7, q = r & 127; t = TrTile{a.in[22] + (size_t)e * DM * DE, (bf16_t*)(ws + WS_W13T) + (size_t)e * DM * DM, DM, DE, 2, (q & 15) * 64, (q >> 4) * 64}; return t; } r -= I_E;
    { const int e = r >> 7, q = r & 127; t = TrTile{a.in[23] + (size_t)e * DE * DM, (bf16_t*)(ws + WS_W2T) + (size_t)e * DM * DE, DE, DM, 0, (q & 7) * 64, (q >> 3) * 64}; return t; }
}
__device__ __forceinline__ void p_transposes(LAS unsigned char* lds, const Args& a, int bid, int G, int tid) {
    constexpr int NITEMS = (16 * 56 + 16 * 16 + 3 * 32 * 128) / 4;
    const int lrow = tid >> 4, lc4 = (tid & 15) * 4;
    const int sc = tid & 7, sn = tid >> 3;
    for (int it = bid; it < NITEMS; it += G) {
        f32x4 v[4][2]; TrTile t[4];
#pragma unroll
        for (int q = 0; q < 4; ++q) { t[q] = tr_decode(a, it * 4 + q);
#pragma unroll
            for (int h = 0; h < 2; ++h) v[q][h] = ntld((const f32x4*)(t[q].W + (size_t)(t[q].k0 + lrow + 32 * h) * t[q].N + t[q].n0 + lc4)); }
        __syncthreads();
#pragma unroll
        for (int q = 0; q < 4; ++q) { LAS float* tile = (LAS float*)lds + q * (64 * 65);
#pragma unroll
            for (int h = 0; h < 2; ++h)
#pragma unroll
                for (int j = 0; j < 4; ++j) tile[(lrow + 32 * h) * 65 + lc4 + j] = v[q][h][j]; }
        __syncthreads();
#pragma unroll
        for (int q = 0; q < 4; ++q) { const LAS float* tile = (const LAS float*)lds + q * (64 * 65) + (8 * sc) * 65 + sn;
            const int n = t[q].n0 + sn, mode = t[q].mode;
            const int orow = mode == 0 ? n : ((n >> 7) * 256 + (mode == 2 ? 128 : 0) + (n & 127));
            u32x4 w; w.x = pk2(tile[0 * 65], tile[1 * 65]); w.y = pk2(tile[2 * 65], tile[3 * 65]); w.z = pk2(tile[4 * 65], tile[5 * 65]); w.w = pk2(tile[6 * 65], tile[7 * 65]);
            *(u32x4*)(t[q].O + (size_t)orow * t[q].K + t[q].k0 + 8 * sc) = w; }
    }
    __syncthreads();
}

__device__ __forceinline__ void p_u(const float* __restrict__ x, const float* __restrict__ ctx, const float* __restrict__ mod, bf16_t* __restrict__ U, int bid, int G, int tid) {
    const int lane = tid & 63, wave = tid >> 6;
    f32x4 vn[2][4];
    int row0 = bid * 16;
#pragma unroll
    for (int q = 0; q < 2; ++q) { const int row = row0 + wave * 2 + q; const float* src = row < T ? x + (size_t)row * DM : ctx + (size_t)(row - T) * DM;
#pragma unroll
        for (int j = 0; j < 4; ++j) vn[q][j] = ntld((const f32x4*)(src + 4 * lane + 256 * j)); }
#pragma unroll 1
    for (; row0 < TA; row0 += G * 16) {
        f32x4 v[2][4];
#pragma unroll
        for (int q = 0; q < 2; ++q)
#pragma unroll
            for (int j = 0; j < 4; ++j) v[q][j] = vn[q][j];
        if (row0 + G * 16 < TA) {
#pragma unroll
            for (int q = 0; q < 2; ++q) { const int row = row0 + G * 16 + wave * 2 + q; const float* src = row < T ? x + (size_t)row * DM : ctx + (size_t)(row - T) * DM;
#pragma unroll
                for (int j = 0; j < 4; ++j) vn[q][j] = ntld((const f32x4*)(src + 4 * lane + 256 * j)); }
        }
        const float* m = mod + (size_t)(row0 < T ? row0 / SEQ : 16) * 6144;
#pragma unroll
        for (int j = 0; j < 4; ++j) { const int c4 = 4 * lane + 256 * j;
            const f32x4 sh = *(const f32x4*)(m + c4), sc = 1.0f + *(const f32x4*)(m + 1024 + c4);
#pragma unroll
            for (int q = 0; q < 2; ++q) { const int row = row0 + wave * 2 + q;
                const f32x4 u = v[q][j] * sc + sh;
                u32x2 w; w.x = pk2(u[0], u[1]); w.y = pk2(u[2], u[3]);
                *(u32x2*)(U + (size_t)row * DM + c4) = w; } }
    }
}

constexpr size_t WS_H1 = WS_XG + 128 * MiB;
constexpr size_t WS_WRT = 878 * MiB;
__device__ __forceinline__ void p_wrt(const float* __restrict__ rgw, const float* __restrict__ rew, bf16_t* __restrict__ wrt, int bid, int G, int tid) {
    for (int o = bid * NTHREADS + tid; o < 48 * 1024; o += G * NTHREADS) { const int e = o >> 10, k = o & 1023;
        const float w = e < 4 ? rgw[k * 4 + e] : (e < 36 ? rew[k * 32 + (e - 4)] : 0.f);
        const bf16_t hi = f2bf(w); wrt[o] = hi; wrt[48 * 1024 + o] = f2bf(w - bf2f(hi)); }
}
__device__ __forceinline__ void p_ln1_router(LAS unsigned char* lds, const Args& a, int bid, int G, int tid, int wave, int lane, bool dry = false, int parts = 3) {
    const float* __restrict__ x = a.in[0]; const bf16_t* yb = (const bf16_t*)(a.ws + WS_XG); bf16_t* h1o = (bf16_t*)(a.ws + (dry ? WS_HID : WS_H1)); const float* mod = (const float*)(a.ws + WS_MOD);
    const float* __restrict__ ln_g = a.in[15]; const float* __restrict__ ln_b = a.in[16]; const float* __restrict__ rgb = a.in[18]; const float* __restrict__ reb = a.in[20];
    bf16_t* U2 = (bf16_t*)(a.ws + (dry ? WS_Y + 16 * MiB : WS_U)); int* counts = (int*)(a.ws + WS_CTL) + (dry ? 32 * CSTR : 0);
    int2* eidx = (int2*)(a.ws + (dry ? WS_Y : WS_EIDX)); int2* epos = (int2*)(a.ws + (dry ? WS_Y + 4 * MiB : WS_EPOS)); float2* ew = (float2*)(a.ws + (dry ? WS_Y + 8 * MiB : WS_EW));
    const bf16_t* __restrict__ wrt = (const bf16_t*)(a.ws + WS_WRT);
    constexpr int WB_STRIDE = 528;
    LAS unsigned char* WB = lds;
    LAS float* LG = (LAS float*)(lds + 51200);
    LAS int* lcnt = (LAS int*)(lds + 102400);
    LAS int* lbase = lcnt + 32;
    LAS i32x4* tinfo = (LAS i32x4*)(lbase + 32);
    LAS f32x2* tw = (LAS f32x2*)(tinfo + 256);
    if (tid < 32) lcnt[tid] = 0;
    for (int blk = bid; blk < T / 256; blk += G) {
        const int tokb = blk * 256;
        const float* m = mod + (size_t)(tokb / SEQ) * 6144;
        if (parts & 1) {
            f32x4 xr[2][4]; u32x2 yr[2][4];
            f32x4 g1v[4], lgv[4], lbv[4], sc2v[4], sh2v[4];
#pragma unroll
            for (int j = 0; j < 4; ++j) { const int c4 = 4 * lane + 256 * j;
                g1v[j] = *(const f32x4*)(m + 2048 + c4); lgv[j] = *(const f32x4*)(ln_g + c4); lbv[j] = *(const f32x4*)(ln_b + c4); sc2v[j] = 1.0f + *(const f32x4*)(m + 4096 + c4); sh2v[j] = *(const f32x4*)(m + 3072 + c4); }
#pragma unroll
            for (int t = 0; t < 2; ++t)
#pragma unroll
                for (int j = 0; j < 4; ++j) { const int c4 = 4 * lane + 256 * j; const int tok = tokb + wave * 32 + t;
                    xr[t][j] = ntld((const f32x4*)(x + (size_t)tok * DM + c4)); yr[t][j] = ntld((const u32x2*)(yb + (size_t)tok * DM + c4)); }
#pragma unroll 1
            for (int it = 0; it < 16; ++it) {
                int l2 = lane; asm volatile("" : "+v"(l2)); const int lane = l2;
                const int tok0 = tokb + wave * 32 + 2 * it;
                f32x4 v[2][4]; float s[2] = {0.f, 0.f};
#pragma unroll
                for (int t = 0; t < 2; ++t)
#pragma unroll
                    for (int j = 0; j < 4; ++j) { const int c4 = 4 * lane + 256 * j;
                        const f32x4 g1 = g1v[j]; const u32x2 yw = yr[t][j];
                        const f32x4 yv = (f32x4){__uint_as_float(yw.x << 16), __uint_as_float(yw.x & 0xffff0000u), __uint_as_float(yw.y << 16), __uint_as_float(yw.y & 0xffff0000u)};
                        v[t][j] = ALPHA * xr[t][j] + g1 * yv; s[t] += (v[t][j][0] + v[t][j][1]) + (v[t][j][2] + v[t][j][3]); }
                if (it < 15) {
#pragma unroll
                    for (int t = 0; t < 2; ++t)
#pragma unroll
                        for (int j = 0; j < 4; ++j) { const int c4 = 4 * lane + 256 * j; const int tok = tok0 + 2 + t;
                            xr[t][j] = ntld((const f32x4*)(x + (size_t)tok * DM + c4)); yr[t][j] = ntld((const u32x2*)(yb + (size_t)tok * DM + c4)); }
                }
                float rstd[2];
#pragma unroll
                for (int t = 0; t < 2; ++t) { const float mean = wave_sum(s[t]) * (1.0f / DM); float s2 = 0.f;
#pragma unroll
                    for (int j = 0; j < 4; ++j) { v[t][j] = v[t][j] - mean; s2 += (v[t][j][0] * v[t][j][0] + v[t][j][1] * v[t][j][1]) + (v[t][j][2] * v[t][j][2] + v[t][j][3] * v[t][j][3]); }
                    rstd[t] = rsqrtf(wave_sum(s2) * (1.0f / DM) + LN_EPS); }
#pragma unroll
                for (int j = 0; j < 4; ++j) { const int c4 = 4 * lane + 256 * j;
                    const f32x4 lg = lgv[j], lb = lbv[j], sc2p = sc2v[j], sh2 = sh2v[j];
#pragma unroll
                    for (int t = 0; t < 2; ++t) { const f32x4 h1 = v[t][j] * rstd[t] * lg + lb;
                        u32x2 hw; hw.x = pk2(h1[0], h1[1]); hw.y = pk2(h1[2], h1[3]);
                        ntst((u32x2*)(h1o + (size_t)(tok0 + t) * DM + c4), hw);
                        const f32x4 u2 = h1 * sc2p + sh2;
                        u32x2 w; w.x = pk2(u2[0], u2[1]); w.y = pk2(u2[2], u2[3]);
                        *(u32x2*)(U2 + (size_t)(tok0 + t) * DM + c4) = w; }
                }
            }
        }
        __syncthreads();
        __builtin_amdgcn_fence(__ATOMIC_ACQUIRE, "agent");
        asm volatile("s_waitcnt vmcnt(0)" ::: "memory");
        const int fr = lane & 15, fq = lane >> 4;
        if (parts & 2) {
            f32x4 acc[2][3];
#pragma unroll
            for (int gi = 0; gi < 2; ++gi)
#pragma unroll
                for (int nt = 0; nt < 3; ++nt) acc[gi][nt] = (f32x4){0.f, 0.f, 0.f, 0.f};
            const bf16_t* arow0 = U2 + (size_t)(tokb + (wave * 2 + 0) * 16 + fr) * DM + fq * 8;
            const bf16_t* arow1 = arow0 + (size_t)16 * DM;
#pragma unroll 1
            for (int ch = 0; ch < 4; ++ch) {
                u32x4 wreg[6];
#pragma unroll
                for (int p = 0; p < 6; ++p) { const int idx = p * NTHREADS + tid, row = idx >> 5, piece = idx & 31;
                    wreg[p] = *(const u32x4*)(wrt + (size_t)row * 1024 + ch * 256 + piece * 8); }
                __syncthreads();
#pragma unroll
                for (int p = 0; p < 6; ++p) { const int idx = p * NTHREADS + tid, row = idx >> 5, piece = idx & 31;
                    *(LAS u32x4*)(WB + row * WB_STRIDE + piece * 16) = wreg[p]; }
                __syncthreads();
#pragma unroll 2
                for (int ks = 0; ks < 8; ++ks) {
                    const bf16x8 af0 = *(const bf16x8*)(arow0 + ch * 256 + ks * 32), af1 = *(const bf16x8*)(arow1 + ch * 256 + ks * 32);
#pragma unroll
                    for (int nt = 0; nt < 3; ++nt) {
                        const bf16x8 bh = *(const LAS bf16x8*)(WB + (nt * 16 + fr) * WB_STRIDE + (ks * 32 + fq * 8) * 2), bl = *(const LAS bf16x8*)(WB + (48 + nt * 16 + fr) * WB_STRIDE + (ks * 32 + fq * 8) * 2);
                        acc[0][nt] = __builtin_amdgcn_mfma_f32_16x16x32_bf16(af0, bh, acc[0][nt], 0, 0, 0);
                        acc[1][nt] = __builtin_amdgcn_mfma_f32_16x16x32_bf16(af1, bh, acc[1][nt], 0, 0, 0);
                        acc[0][nt] = __builtin_amdgcn_mfma_f32_16x16x32_bf16(af0, bl, acc[0][nt], 0, 0, 0);
                        acc[1][nt] = __builtin_amdgcn_mfma_f32_16x16x32_bf16(af1, bl, acc[1][nt], 0, 0, 0);
                    }
                }
            }
            LAS float* lg = LG + wave * (2 * 16 * 48);
#pragma unroll
            for (int gi = 0; gi < 2; ++gi)
#pragma unroll
                for (int nt = 0; nt < 3; ++nt)
#pragma unroll
                    for (int j = 0; j < 4; ++j) lg[(gi * 16 + 4 * fq + j) * 48 + 16 * nt + fr] = acc[gi][nt][j];
            asm volatile("s_waitcnt lgkmcnt(0)" ::: "memory");
            if (lane < 32) {
                float pl[36];
#pragma unroll
                for (int e4 = 0; e4 < 9; ++e4) { const f32x4 q = *(const LAS f32x4*)(lg + lane * 48 + 4 * e4);
#pragma unroll
                    for (int r = 0; r < 4; ++r) pl[4 * e4 + r] = q[r]; }
#pragma unroll
                for (int e = 0; e < 36; ++e) pl[e] += e < 4 ? rgb[e] : reb[e - 4];
                int gsel = 0; float gm = pl[0];
#pragma unroll
                for (int g = 1; g < 4; ++g) if (pl[g] > gm) { gm = pl[g]; gsel = g; }
                float den = 0.f;
#pragma unroll
                for (int g = 0; g < 4; ++g) den += __expf(pl[g] - gm);
                const float gval = frcp(den);
                int j0 = -1; float v0 = -3.0e38f;
#pragma unroll
                for (int j = 0; j < 32; ++j) { const bool in = (j >> 3) == gsel; if (in && (j0 < 0 || pl[4 + j] > v0)) { v0 = pl[4 + j]; j0 = j; } }
                int j1 = -1; float v1 = -3.0e38f;
#pragma unroll
                for (int j = 0; j < 32; ++j) { const bool in = (j >> 3) == gsel; if (in && j != j0 && (j1 < 0 || pl[4 + j] > v1)) { v1 = pl[4 + j]; j1 = j; } }
                const float tt = __expf(v1 - v0), w0 = frcp(1.0f + tt), w1 = tt * w0;
                const int p0 = __hip_atomic_fetch_add(lcnt + j0, 1, __ATOMIC_RELAXED, __HIP_MEMORY_SCOPE_WORKGROUP), p1 = __hip_atomic_fetch_add(lcnt + j1, 1, __ATOMIC_RELAXED, __HIP_MEMORY_SCOPE_WORKGROUP);
                const int slot = wave * 32 + lane;
                tinfo[slot] = (i32x4){j0, j1, p0, p1}; tw[slot] = (f32x2){gval * w0, gval * w1};
            }
        }
        __syncthreads();
        if (tid < 32) lbase[tid] = atomicAdd(&counts[tid * CSTR], lcnt[tid]);
        __syncthreads();
        if (tid < 256) {
            const int tok = tokb + tid; const i32x4 ti = tinfo[tid]; const f32x2 wv = tw[tid];
            eidx[tok] = make_int2(ti[0], ti[1]); epos[tok] = make_int2(lbase[ti[0]] + ti[2], lbase[ti[1]] + ti[3]); ew[tok] = make_float2(wv[0], wv[1]);
        }
        if (tid < 32) lcnt[tid] = 0;
        __syncthreads();
    }
}

constexpr size_t WS_ROWTOK = 5 * MiB;
constexpr size_t WS_RBPRE = 2 * MiB;
__device__ __forceinline__ void p_assign(LAS unsigned char* lds, const Args& a, int bid, int G, int tid) {
    const int* counts = (const int*)(a.ws + WS_CTL);
    const int2* eidx = (const int2*)(a.ws + WS_EIDX); const int2* epos = (const int2*)(a.ws + WS_EPOS); int2* dest = (int2*)(a.ws + WS_DEST); int* rowtok = (int*)(a.ws + WS_ROWTOK);
    LAS int* ps = (LAS int*)lds;
    if (tid == 0) { int acc = 0; int* rbpre = (int*)(a.ws + WS_RBPRE); for (int e = 0; e < NE; ++e) { const int c = counts[e * CSTR]; ps[e] = acc; ps[32 + e] = c; if (bid == 0) rbpre[e] = acc >> 8; acc += ((c + 255) >> 8) << 8; } if (bid == 0) rbpre[NE] = acc >> 8; }
    __syncthreads();
    for (int tok = bid * NTHREADS + tid; tok < T; tok += G * NTHREADS) {
        const int2 ei = eidx[tok], ep = epos[tok];
        const int d0 = ps[ei.x] + ep.x, d1 = ps[ei.y] + ep.y;
        rowtok[d0] = tok; rowtok[d1] = tok; dest[tok] = make_int2(d0, d1);
    }
    for (int i = bid * NTHREADS + tid; i < NE * 256; i += G * NTHREADS) {
        const int e = i >> 8, r = i & 255, c = ps[32 + e];
        if (c + r < (((c + 255) >> 8) << 8)) rowtok[ps[e] + c + r] = 0;
    }
    __syncthreads();
}

__device__ __forceinline__ void p_combine_ln2(const Args& a, int bid, int G, int wave, int lane, bool dry = false) {
    const bf16_t* h1b = (const bf16_t*)(a.ws + WS_H1); float* outw = dry ? (float*)(a.ws + WS_HID) : a.out; const bf16_t* Y = (const bf16_t*)(a.ws + WS_Y); const int2* dest = (const int2*)(a.ws + WS_DEST); const float2* ew = (const float2*)(a.ws + WS_EW);
    const float* mod = (const float*)(a.ws + WS_MOD); const float* __restrict__ ln_g = a.in[24]; const float* __restrict__ ln_b = a.in[25];
    int pr = bid * 8 + wave;
    f32x4 lgv[4], lbv[4];
#pragma unroll
    for (int j = 0; j < 4; ++j) { lgv[j] = *(const f32x4*)(ln_g + 4 * lane + 256 * j); lbv[j] = *(const f32x4*)(ln_b + 4 * lane + 256 * j); }
    int2 dn[2]; float2 wn[2];
#pragma unroll
    for (int t = 0; t < 2; ++t) { dn[t] = dest[2 * pr + t]; wn[t] = ew[2 * pr + t]; }
#pragma unroll 1
    for (; pr < T / 2; pr += G * 8) {
        int l2 = lane; asm volatile("" : "+v"(l2)); const int lane = l2;
        const int tok0 = 2 * pr;
        const float* m = mod + (size_t)(tok0 / SEQ) * 6144;
        int2 d[2]; float2 w[2];
#pragma unroll
        for (int t = 0; t < 2; ++t) { d[t] = dn[t]; w[t] = wn[t]; }
        f32x4 v[2][4]; float s[2] = {0.f, 0.f};
#pragma unroll
        for (int t = 0; t < 2; ++t)
#pragma unroll
            for (int j = 0; j < 4; ++j) { const int c4 = 4 * lane + 256 * j;
                const u32x2 ya = ntld((const u32x2*)(Y + (size_t)d[t].x * DM + c4)), yb = ntld((const u32x2*)(Y + (size_t)d[t].y * DM + c4));
                const u32x2 hw = ntld((const u32x2*)(h1b + (size_t)(tok0 + t) * DM + c4)); const f32x4 g2 = *(const f32x4*)(m + 5120 + c4);
                f32x4 f;
                f[0] = w[t].x * __uint_as_float(ya.x << 16) + w[t].y * __uint_as_float(yb.x << 16);
                f[1] = w[t].x * __uint_as_float(ya.x & 0xffff0000u) + w[t].y * __uint_as_float(yb.x & 0xffff0000u);
                f[2] = w[t].x * __uint_as_float(ya.y << 16) + w[t].y * __uint_as_float(yb.y << 16);
                f[3] = w[t].x * __uint_as_float(ya.y & 0xffff0000u) + w[t].y * __uint_as_float(yb.y & 0xffff0000u);
                const f32x4 h1 = (f32x4){__uint_as_float(hw.x << 16), __uint_as_float(hw.x & 0xffff0000u), __uint_as_float(hw.y << 16), __uint_as_float(hw.y & 0xffff0000u)};
                v[t][j] = ALPHA * h1 + g2 * f; s[t] += (v[t][j][0] + v[t][j][1]) + (v[t][j][2] + v[t][j][3]); }
        { const int pn = pr + G * 8; if (pn < T / 2) {
#pragma unroll
            for (int t = 0; t < 2; ++t) { dn[t] = dest[2 * pn + t]; wn[t] = ew[2 * pn + t]; } } }
#pragma unroll
        for (int t = 0; t < 2; ++t) { const float mean = wave_sum(s[t]) * (1.0f / DM); float s2 = 0.f;
#pragma unroll
            for (int j = 0; j < 4; ++j) { v[t][j] = v[t][j] - mean; s2 += (v[t][j][0] * v[t][j][0] + v[t][j][1] * v[t][j][1]) + (v[t][j][2] * v[t][j][2] + v[t][j][3] * v[t][j][3]); }
            const float rstd = rsqrtf(wave_sum(s2) * (1.0f / DM) + LN_EPS);
#pragma unroll
            for (int j = 0; j < 4; ++j) { const int c4 = 4 * lane + 256 * j;
                ntst((f32x4*)(outw + (size_t)(tok0 + t) * DM + c4), (f32x4)(v[t][j] * rstd * lgv[j] + lbv[j])); } }
    }
}

constexpr size_t WS_HGK = WS_U;
constexpr size_t WS_HGD = 852 * MiB;
constexpr size_t WS_RGAGG = 854 * MiB;
constexpr size_t WS_RGCARRY = 864 * MiB;
constexpr size_t WS_GWT = 870 * MiB;
constexpr size_t WS_OFST = 880 * MiB;
constexpr int RG_UNITS_PER_B = 68, HG_SEGS = 17;

__device__ __forceinline__ void lds_barrier() { asm volatile("s_waitcnt lgkmcnt(0)" ::: "memory"); __builtin_amdgcn_s_barrier(); asm volatile("" ::: "memory"); }
__device__ __forceinline__ bf16x8 mk_bf16x8(u32x4 v) { return __builtin_bit_cast(bf16x8, v); }
__device__ __forceinline__ float bf_lo(unsigned w) { return __uint_as_float(w << 16); }
__device__ __forceinline__ float bf_hi(unsigned w) { return __uint_as_float(w & 0xffff0000u); }
__device__ __forceinline__ unsigned cvt2(float lo, float hi) { unsigned r; asm volatile("v_cvt_pk_bf16_f32 %0, %1, %2" : "=v"(r) : "v"(lo), "v"(hi)); return r; }

__device__ __forceinline__ void p_gwt(const float* __restrict__ gate_w, bf16_t* __restrict__ gwt, int bid, int G, int tid) {
    for (int o = bid * NTHREADS + tid; o < 32 * 4096; o += G * NTHREADS) { const int mat = o >> 12, d = (o >> 6) & 63, c = o & 63; gwt[o] = f2bf(gate_w[mat * 4096 + c * 64 + d]); }
}

constexpr int XC_STRIDE = 1040;
constexpr int RG_XC = 0, RG_OUT = 64 * XC_STRIDE;
constexpr size_t WS_RGPAR = 876 * MiB;

__device__ __forceinline__ void p_rgpar(const float* __restrict__ gate_b, const float* __restrict__ lam, float* __restrict__ par, int bid, int G, int tid) {
    for (int o = bid * NTHREADS + tid; o < 2 * 512; o += G * NTHREADS) { const int dir = o >> 9, ch = o & 511;
        par[(dir * 3 + 0) * 512 + ch] = gate_b[(dir * 2 + 0) * 512 + ch]; par[(dir * 3 + 1) * 512 + ch] = gate_b[(dir * 2 + 1) * 512 + ch]; par[(dir * 3 + 2) * 512 + ch] = softplusf_(-lam[dir * 512 + ch]); }
}

template <int DIR, bool OUT>
__device__ __forceinline__ void rg_scan64(const float (&av)[4][4], const float (&uv)[4][4], float& carry, float& atot, float (&hsum)[4][4], int fr, int fq) {
#pragma unroll
    for (int mm = 0; mm < 4; ++mm) {
        const int m = DIR == 0 ? mm : 3 - mm;
        float P, H;
        if (DIR == 0) { P = av[m][0]; H = uv[m][0];
#pragma unroll
            for (int j = 1; j < 4; ++j) { H = av[m][j] * H + uv[m][j]; P *= av[m][j]; } }
        else { P = av[m][3]; H = uv[m][3];
#pragma unroll
            for (int j = 2; j >= 0; --j) { H = av[m][j] * H + uv[m][j]; P *= av[m][j]; } }
        float Pn, Hn, Pe, He, Pt, Ht;
        if (DIR == 0) {
            Pn = __shfl_up(P, 16); Hn = __shfl_up(H, 16); if (fq >= 1) { H = P * Hn + H; P = P * Pn; }
            Pn = __shfl_up(P, 32); Hn = __shfl_up(H, 32); if (fq >= 2) { H = P * Hn + H; P = P * Pn; }
            Pe = __shfl_up(P, 16); He = __shfl_up(H, 16); if (fq == 0) { Pe = 1.f; He = 0.f; }
            Pt = __shfl(P, fr + 48); Ht = __shfl(H, fr + 48);
        } else {
            Pn = __shfl_down(P, 16); Hn = __shfl_down(H, 16); if (fq <= 2) { H = P * Hn + H; P = P * Pn; }
            Pn = __shfl_down(P, 32); Hn = __shfl_down(H, 32); if (fq <= 1) { H = P * Hn + H; P = P * Pn; }
            Pe = __shfl_down(P, 16); He = __shfl_down(H, 16); if (fq == 3) { Pe = 1.f; He = 0.f; }
            Pt = __shfl(P, fr); Ht = __shfl(H, fr);
        }
        if (OUT) {
            float hp = Pe * carry + He;
            if (DIR == 0) {
#pragma unroll
                for (int j = 0; j < 4; ++j) { hp = av[m][j] * hp + uv[m][j]; hsum[m][j] = hp; }
            } else {
#pragma unroll
                for (int j = 3; j >= 0; --j) { hp = av[m][j] * hp + uv[m][j]; hsum[m][j] += hp; }
            }
        }
        carry = Pt * carry + Ht; atot *= Pt;
    }
}

__device__ __forceinline__ void rg_load_raw(u32x4 (&raw)[11], const bf16_t* __restrict__ proj, int b, int k, int tid) {
    int rowbase, p0, lo, hi;
    if (k < 4) { rowbase = T + b * LC; p0 = k * 64; lo = 0; hi = LC; } else { rowbase = b * SEQ; p0 = (k - 4) * 64; lo = p0; hi = p0 + 64; }
    const int c0 = (tid & 63) * 8, i0 = (tid >> 6) * 8;
#pragma unroll
    for (int r = 0; r < 11; ++r) { const int p = p0 + i0 - 1 + r;
        raw[r] = (p >= lo && p < hi) ? *(const u32x4*)proj_at(proj, rowbase + p, c0) : (u32x4){0u, 0u, 0u, 0u}; }
}
__device__ __forceinline__ void rg_agg_unit(LAS unsigned char* lds, const Args& a, int b, int k, u32x4 (&raw)[11], int bn, int kn, int tid, int wave, int lane, int xr = 0) {
    const bf16_t* __restrict__ proj = (const bf16_t*)(a.ws + WS_PROJ);
    const float* __restrict__ conv_w = a.in[7]; const float* __restrict__ conv_b = a.in[8];
    const bf16_t* __restrict__ gwt = (const bf16_t*)(a.ws + WS_GWT); const float* __restrict__ par = (const float*)(a.ws + WS_RGPAR);
    float* rgagg = (float*)(a.ws + WS_RGAGG);
    int rowbase, p0, lo, hi;
    if (k < 4) { rowbase = T + b * LC; p0 = k * 64; lo = 0; hi = LC; } else { rowbase = b * SEQ; p0 = (k - 4) * 64; lo = p0; hi = p0 + 64; }
    const int unit = b * RG_UNITS_PER_B + k;
    const int n = wave, fr = lane & 15, fq = lane >> 4;
    float pgr[4][2], pgi[4][2], psp[4][2];
#pragma unroll
    for (int nt = 0; nt < 4; ++nt)
#pragma unroll
        for (int dir = 0; dir < 2; ++dir) { const int ch = n * 64 + nt * 16 + fr;
            pgr[nt][dir] = par[(dir * 3 + 0) * 512 + ch]; pgi[nt][dir] = par[(dir * 3 + 1) * 512 + ch]; psp[nt][dir] = par[(dir * 3 + 2) * 512 + ch]; }
    if (!(xr & 1)) {
        const int cgp = tid & 63, tg = tid >> 6, c0 = cgp * 8, i0 = tg * 8;
        float cw[4][8], cb[8];
#pragma unroll
        for (int t4 = 0; t4 < 4; ++t4) { const f32x4 w0 = *(const f32x4*)(conv_w + t4 * 512 + c0), w1 = *(const f32x4*)(conv_w + t4 * 512 + c0 + 4);
#pragma unroll
            for (int q = 0; q < 4; ++q) { cw[t4][q] = w0[q]; cw[t4][4 + q] = w1[q]; } }
        { const f32x4 b0 = *(const f32x4*)(conv_b + c0), b1 = *(const f32x4*)(conv_b + c0 + 4);
#pragma unroll
            for (int q = 0; q < 4; ++q) { cb[q] = b0[q]; cb[4 + q] = b1[q]; } }
#pragma unroll
        for (int ii = 0; ii < 8; ++ii) {
            float xc[8];
#pragma unroll
            for (int c = 0; c < 8; ++c) xc[c] = cb[c];
#pragma unroll
            for (int t4 = 0; t4 < 4; ++t4) { const u32x4 rw = raw[ii + t4];
#pragma unroll
                for (int q = 0; q < 4; ++q) { xc[2 * q] += cw[t4][2 * q] * bf_lo(rw[q]); xc[2 * q + 1] += cw[t4][2 * q + 1] * bf_hi(rw[q]); } }
            u32x4 w; w.x = cvt2(xc[0], xc[1]); w.y = cvt2(xc[2], xc[3]); w.z = cvt2(xc[4], xc[5]); w.w = cvt2(xc[6], xc[7]);
            *(LAS u32x4*)(lds + RG_XC + (i0 + ii) * XC_STRIDE + c0 * 2) = w;
        }
    }
    if (kn >= 0) rg_load_raw(raw, proj, bn, kn, tid);
    lds_barrier();
    {
        bf16x8 afr[4][2];
#pragma unroll
        for (int m = 0; m < 4; ++m)
#pragma unroll
            for (int ks = 0; ks < 2; ++ks) afr[m][ks] = *(const LAS bf16x8*)(lds + RG_XC + (16 * m + fr) * XC_STRIDE + (n * 64 + ks * 32 + fq * 8) * 2);
        u32x4* stash = (k >= 4) ? (u32x4*)a.out + ((size_t)(b * 64 + (k - 4)) * 16384 + (size_t)wave * 2048 + lane) : nullptr;
        bf16x8 wfr[2][2][2];
#pragma unroll
        for (int dir = 0; dir < 2; ++dir)
#pragma unroll
            for (int g = 0; g < 2; ++g)
#pragma unroll
                for (int ks = 0; ks < 2; ++ks) wfr[dir][g][ks] = *(const bf16x8*)(gwt + ((size_t)(((dir * 2 + g) * 8 + n) * 64 + fr)) * 64 + ks * 32 + fq * 8);
#pragma unroll
        for (int nt = 0; nt < 4; ++nt) {
            const int ch = n * 64 + nt * 16 + fr;
            bf16x8 wnx[2][2][2];
            if (nt < 3) {
#pragma unroll
                for (int dir = 0; dir < 2; ++dir)
#pragma unroll
                    for (int g = 0; g < 2; ++g)
#pragma unroll
                        for (int ks = 0; ks < 2; ++ks) wnx[dir][g][ks] = *(const bf16x8*)(gwt + ((size_t)(((dir * 2 + g) * 8 + n) * 64 + (nt + 1) * 16 + fr)) * 64 + ks * 32 + fq * 8);
            }
            float xcv[4][4];
#pragma unroll
            for (int m = 0; m < 4; ++m)
#pragma unroll
                for (int j = 0; j < 4; ++j) xcv[m][j] = bf2f(*(const LAS bf16_t*)(lds + RG_XC + (16 * m + 4 * fq + j) * XC_STRIDE + ch * 2));
#pragma unroll
            for (int dir = 0; dir < 2; ++dir) {
                f32x4 accr[4], acci[4];
#pragma unroll
                for (int m = 0; m < 4; ++m) { accr[m] = (f32x4){0.f, 0.f, 0.f, 0.f}; acci[m] = (f32x4){0.f, 0.f, 0.f, 0.f}; }
                if (!(xr & 2))
#pragma unroll
                for (int ks = 0; ks < 2; ++ks)
#pragma unroll
                    for (int m = 0; m < 4; ++m) { accr[m] = __builtin_amdgcn_mfma_f32_16x16x32_bf16(afr[m][ks], wfr[dir][0][ks], accr[m], 0, 0, 0); acci[m] = __builtin_amdgcn_mfma_f32_16x16x32_bf16(afr[m][ks], wfr[dir][1][ks], acci[m], 0, 0, 0); }
                const float gbr = pgr[nt][dir], gbi = pgi[nt][dir], sp = psp[nt][dir];
                float av[4][4], uv[4][4];
                const bool exact = __any(8.0f * sp >= 0.25f);
#pragma unroll
                for (int m = 0; m < 4; ++m) {
                    unsigned pk[4];
                    if (xr & 4) {
#pragma unroll
                        for (int j = 0; j < 4; ++j) pk[j] = __float_as_uint(accr[m][j] + acci[m][j] + xcv[m][j]);
                    } else if (!exact) {
#pragma unroll
                        for (int j = 0; j < 4; ++j) {
                            const float r = sigmoidf_(accr[m][j] + gbr), ig = sigmoidf_(acci[m][j] + gbi);
                            const float la = -8.0f * r * sp;
                            const float oma = -la * (1.f + la * (0.5f + la * (0.16666667f + la * (0.041666668f + la * 0.0083333338f))));
                            pk[j] = cvt2(oma, __builtin_amdgcn_sqrtf(oma * (2.0f - oma)) * ig * xcv[m][j]);
                        }
                    } else {
#pragma unroll
                        for (int j = 0; j < 4; ++j) {
                            const float r = sigmoidf_(accr[m][j] + gbr), ig = sigmoidf_(acci[m][j] + gbi);
                            const float la = -8.0f * r * sp;
                            const float ser = -la * (1.f + la * (0.5f + la * (0.16666667f + la * (0.041666668f + la * 0.0083333338f))));
                            const float oma = (la > -0.25f) ? ser : 1.f - __expf(la);
                            pk[j] = cvt2(oma, __builtin_amdgcn_sqrtf(oma * (2.0f - oma)) * ig * xcv[m][j]);
                        }
                    }
#pragma unroll
                    for (int j = 0; j < 4; ++j) { av[m][j] = 1.0f - bf_lo(pk[j]); uv[m][j] = bf_hi(pk[j]); }
                    if (stash && !(xr & 16)) ntst(stash + ((nt * 2 + dir) * 4 + m) * 64, (u32x4){pk[0], pk[1], pk[2], pk[3]});
                }
                float carry = 0.f, atot = 1.f, hdummy[4][4];
                if (xr & 8) { carry = av[0][0] + uv[3][3]; } else if (dir == 0) rg_scan64<0, false>(av, uv, carry, atot, hdummy, fr, fq); else rg_scan64<1, false>(av, uv, carry, atot, hdummy, fr, fq);
                if (fq == 0) { rgagg[(((size_t)unit * 2 + dir) * 2 + 0) * 512 + ch] = atot; rgagg[(((size_t)unit * 2 + dir) * 2 + 1) * 512 + ch] = carry; }
            }
            if (nt < 3) {
#pragma unroll
                for (int dir = 0; dir < 2; ++dir)
#pragma unroll
                    for (int g = 0; g < 2; ++g)
#pragma unroll
                        for (int ks = 0; ks < 2; ++ks) wfr[dir][g][ks] = wnx[dir][g][ks];
            }
        }
    }
    lds_barrier();
}

__device__ __forceinline__ void rg_final_load(u32x4 (&g)[8], u32x4 (&st)[2][4], const Args& a, int b, int kl, int tid, int wave, int lane) {
    const bf16_t* __restrict__ proj = (const bf16_t*)(a.ws + WS_PROJ);
    const int rowbase = b * SEQ + kl * 64, c0 = (tid & 63) * 8, i0 = (tid >> 6) * 8;
    const u32x4* stash = (const u32x4*)a.out + ((size_t)(b * 64 + kl) * 16384 + (size_t)wave * 2048 + lane);
#pragma unroll
    for (int ii = 0; ii < 8; ++ii) g[ii] = *(const u32x4*)proj_at(proj, rowbase + i0 + ii, 512 + c0);
#pragma unroll
    for (int dir = 0; dir < 2; ++dir)
#pragma unroll
        for (int m = 0; m < 4; ++m) st[dir][m] = ntld(stash + ((0 * 2 + dir) * 4 + m) * 64);
}
__device__ __forceinline__ void rg_final_unit(LAS unsigned char* lds, const Args& a, int b, int kl, u32x4 (&g)[8], u32x4 (&st)[2][4], int bn, int kn, int tid, int wave, int lane) {
    const float* rgcarry = (const float*)(a.ws + WS_RGCARRY); bf16_t* mixed = (bf16_t*)(a.ws + WS_MIXED);
    const int rowbase = b * SEQ + kl * 64, unit = b * RG_UNITS_PER_B + 4 + kl;
    const int n = wave, fr = lane & 15, fq = lane >> 4;
    const u32x4* stash = (const u32x4*)a.out + ((size_t)(b * 64 + kl) * 16384 + (size_t)wave * 2048 + lane);
    float cin[4][2];
#pragma unroll
    for (int nt = 0; nt < 4; ++nt)
#pragma unroll
        for (int dir = 0; dir < 2; ++dir) cin[nt][dir] = rgcarry[((size_t)unit * 2 + dir) * 512 + n * 64 + nt * 16 + fr];
    {
        const int c0 = (tid & 63) * 8, i0 = (tid >> 6) * 8;
#pragma unroll
        for (int ii = 0; ii < 8; ++ii) *(LAS u32x4*)(lds + RG_XC + (i0 + ii) * XC_STRIDE + c0 * 2) = g[ii];
    }
    lds_barrier();
#pragma unroll
    for (int nt = 0; nt < 4; ++nt) {
        const int ch = n * 64 + nt * 16 + fr;
        u32x4 sn[2][4];
        if (nt < 3) {
#pragma unroll
            for (int dir = 0; dir < 2; ++dir)
#pragma unroll
                for (int m = 0; m < 4; ++m) sn[dir][m] = ntld(stash + (((nt + 1) * 2 + dir) * 4 + m) * 64);
        }
        float hsum[4][4];
#pragma unroll
        for (int dir = 0; dir < 2; ++dir) {
            float av[4][4], uv[4][4];
#pragma unroll
            for (int m = 0; m < 4; ++m)
#pragma unroll
                for (int j = 0; j < 4; ++j) { av[m][j] = 1.0f - bf_lo(st[dir][m][j]); uv[m][j] = bf_hi(st[dir][m][j]); }
            float carry = cin[nt][dir], atot = 1.f;
            if (dir == 0) rg_scan64<0, true>(av, uv, carry, atot, hsum, fr, fq); else rg_scan64<1, true>(av, uv, carry, atot, hsum, fr, fq);
        }
#pragma unroll
        for (int m = 0; m < 4; ++m)
#pragma unroll
            for (int j = 0; j < 4; ++j) { const int t = 16 * m + 4 * fq + j;
                const float gg = bf2f(*(const LAS bf16_t*)(lds + RG_XC + t * XC_STRIDE + ch * 2));
                *(LAS bf16_t*)(lds + RG_OUT + t * XC_STRIDE + ch * 2) = (bf16_t)(cvt2(hsum[m][j] * gg, 0.f) & 0xffffu); }
        if (nt < 3) {
#pragma unroll
            for (int dir = 0; dir < 2; ++dir)
#pragma unroll
                for (int m = 0; m < 4; ++m) st[dir][m] = sn[dir][m];
        }
    }
    if (kn >= 0) rg_final_load(g, st, a, bn, kn, tid, wave, lane);
    lds_barrier();
    {
        const int c0 = (tid & 63) * 8, i0 = (tid >> 6) * 8;
#pragma unroll
        for (int ii = 0; ii < 8; ++ii) { const u32x4 w = *(const LAS u32x4*)(lds + RG_OUT + (i0 + ii) * XC_STRIDE + c0 * 2);
            *(u32x4*)(mixed + (size_t)(rowbase + i0 + ii) * DM + c0) = w; }
    }
}

__device__ __forceinline__ void rg_carry_item(const Args& a, int item, int tid) {
    const float* rgagg = (const float*)(a.ws + WS_RGAGG); float* rgcarry = (float*)(a.ws + WS_RGCARRY);
    const int gidx = item * NTHREADS + tid;
    const int ch = gidx & 511, dir = (gidx >> 9) & 1, b = gidx >> 10;
    float h = 0.f;
#pragma unroll 1
    for (int s0 = 0; s0 < RG_UNITS_PER_B; s0 += 17) {
        float Av[17], Hv[17];
#pragma unroll
        for (int s1 = 0; s1 < 17; ++s1) { const int s = s0 + s1;
            const int k = dir == 0 ? s : (s < 4 ? 3 - s : 67 - (s - 4));
            const size_t unit = (size_t)b * RG_UNITS_PER_B + k;
            Av[s1] = rgagg[((unit * 2 + dir) * 2 + 0) * 512 + ch]; Hv[s1] = rgagg[((unit * 2 + dir) * 2 + 1) * 512 + ch]; }
#pragma unroll
        for (int s1 = 0; s1 < 17; ++s1) { const int s = s0 + s1;
            const int k = dir == 0 ? s : (s < 4 ? 3 - s : 67 - (s - 4));
            const size_t unit = (size_t)b * RG_UNITS_PER_B + k;
            rgcarry[(unit * 2 + dir) * 512 + ch] = h;
            h = Av[s1] * h + Hv[s1]; }
    }
}

#ifndef HGX
#define HGX 0
#endif
__device__ __forceinline__ float row_allsum16(float v) {
    v += __builtin_bit_cast(float, __builtin_amdgcn_update_dpp(0, __builtin_bit_cast(int, v), 0x128, 0xf, 0xf, false));
    v += __builtin_bit_cast(float, __builtin_amdgcn_update_dpp(0, __builtin_bit_cast(int, v), 0x124, 0xf, 0xf, false));
    v += __builtin_bit_cast(float, __builtin_amdgcn_update_dpp(0, __builtin_bit_cast(int, v), 0x122, 0xf, 0xf, false));
    v += __builtin_bit_cast(float, __builtin_amdgcn_update_dpp(0, __builtin_bit_cast(int, v), 0x121, 0xf, 0xf, false));
    return v;
}
constexpr int HG_RAWZ = 0, HG_RAWV = 16384, HG_RAWQ = 32768;
constexpr int HG_KHT = 49152, HG_VT = 67584;
constexpr int HG_QT = 86016, HG_KT = 103424;
constexpr int HG_AM = 120832;
constexpr int HG_DS = 130048, HG_QSUM = 130560, HG_PART = 134656;
constexpr int HG_RAWG = 136704;
constexpr int HG_OST = HG_QT;
constexpr int TS = 144, QS = 272;

struct HgRaw { u32x4 z[2], v[2], q[2], g[2]; };
template <bool FULL, bool GATE>
__device__ __forceinline__ void hg_load_raw(HgRaw& r, const bf16_t* __restrict__ proj, int row0, int hd, int dir, int tid) {
#pragma unroll
    for (int i = 0; i < 2; ++i) { const int row = row0 + (tid >> 4) + 32 * i, col = hd * 128 + (tid & 15) * 8;
        r.z[i] = *(const u32x4*)proj_at(proj, row, col + (dir == 0 ? 1536 : 2048)); r.v[i] = *(const u32x4*)proj_at(proj, row, col + 2560);
        if (FULL) r.q[i] = *(const u32x4*)proj_at(proj, row, col + 1024); if (GATE) r.g[i] = *(const u32x4*)proj_at(proj, row, col + 3072); }
}
template <bool FULL, bool GATE>
__device__ __forceinline__ void hg_store_raw(LAS unsigned char* lds, const HgRaw& r, int tid) {
#pragma unroll
    for (int i = 0; i < 2; ++i) { const int off = ((tid >> 4) + 32 * i) * 256 + (tid & 15) * 16;
        *(LAS u32x4*)(lds + HG_RAWZ + off) = r.z[i]; *(LAS u32x4*)(lds + HG_RAWV + off) = r.v[i]; if (FULL) *(LAS u32x4*)(lds + HG_RAWQ + off) = r.q[i]; if (GATE) *(LAS u32x4*)(lds + HG_RAWG + off) = r.g[i]; }
}

template <int DIR, bool FULL, bool STORE_NEXT, bool NEXT_GATE>
__device__ __forceinline__ void hg_chunk(LAS unsigned char* lds, f32x4 (&accS)[8], f32x4 (&o)[4], float lb0, float lb1, float& dseg0, float& dseg1, const HgRaw& nxt, int tid, int wave, int lane, int xm = 0) {
    const int cp = lane, tg = wave, fr = lane & 15, fq = lane >> 4;
    float c0[8], c1[8], k0[8], k1[8];
    if (xm & 1) {
#pragma unroll
        for (int i = 0; i < 8; ++i) { c0[i] = 1.f; c1[i] = 1.f; k0[i] = 0.5f; k1[i] = 0.5f; }
    } else {
        float p0 = 1.f, p1 = 1.f;
#pragma unroll
        for (int ii = 0; ii < 8; ++ii) { const int i = DIR == 0 ? ii : 7 - ii;
            const unsigned zz = *(const LAS unsigned*)(lds + HG_RAWZ + (8 * tg + i) * 256 + cp * 4);
            const float e0 = __expf(-bf_lo(zz)), e1 = __expf(-bf_hi(zz)); const float s0 = frcp(1.0f + e0), s1 = frcp(1.0f + e1);
            k0[i] = (1.0f - lb0) * (1.0f - s0); k1[i] = (1.0f - lb1) * (1.0f - s1);
            p0 *= lb0 + (1.0f - lb0) * s0; p1 *= lb1 + (1.0f - lb1) * s1; c0[i] = p0; c1[i] = p1; }
        *(LAS f32x2*)(lds + HG_QSUM + (tg * 128 + 2 * cp) * 4) = (f32x2){p0, p1};
    }
    lds_barrier();
    float pre0 = 1.f, pre1 = 1.f, tot0 = 1.f, tot1 = 1.f;
#pragma unroll
    for (int g = 0; g < 8; ++g) { const f32x2 v = *(const LAS f32x2*)(lds + HG_QSUM + (g * 128 + 2 * cp) * 4); tot0 *= v[0]; tot1 *= v[1]; if (DIR == 0 ? (g < tg) : (g > tg)) { pre0 *= v[0]; pre1 *= v[1]; } }
    if (!(xm & 1)) {
        unsigned kh0[4], kh1[4], vt0[4], vt1[4];
#pragma unroll
        for (int i2 = 0; i2 < 4; ++i2) {
            const float Pa0 = pre0 * c0[2 * i2], Pb0 = pre0 * c0[2 * i2 + 1], Pa1 = pre1 * c1[2 * i2], Pb1 = pre1 * c1[2 * i2 + 1];
            const float ra0 = frcp(Pa0), rb0 = frcp(Pb0), ra1 = frcp(Pa1), rb1 = frcp(Pb1);
            const float kta0 = k0[2 * i2] * ra0, ktb0 = k0[2 * i2 + 1] * rb0, kta1 = k1[2 * i2] * ra1, ktb1 = k1[2 * i2 + 1] * rb1;
            kh0[i2] = cvt2(kta0 * tot0, ktb0 * tot0); kh1[i2] = cvt2(kta1 * tot1, ktb1 * tot1);
            const unsigned va = *(const LAS unsigned*)(lds + HG_RAWV + (8 * tg + 2 * i2) * 256 + cp * 4), vb = *(const LAS unsigned*)(lds + HG_RAWV + (8 * tg + 2 * i2 + 1) * 256 + cp * 4);
            vt0[i2] = __builtin_amdgcn_perm(vb, va, 0x05040100u); vt1[i2] = __builtin_amdgcn_perm(vb, va, 0x07060302u);
            if (FULL) {
                const unsigned qa = *(const LAS unsigned*)(lds + HG_RAWQ + (8 * tg + 2 * i2) * 256 + cp * 4), qb = *(const LAS unsigned*)(lds + HG_RAWQ + (8 * tg + 2 * i2 + 1) * 256 + cp * 4);
                *(LAS unsigned*)(lds + HG_QT + (8 * tg + 2 * i2) * QS + cp * 4) = cvt2(bf_lo(qa) * Pa0, bf_hi(qa) * Pa1);
                *(LAS unsigned*)(lds + HG_QT + (8 * tg + 2 * i2 + 1) * QS + cp * 4) = cvt2(bf_lo(qb) * Pb0, bf_hi(qb) * Pb1);
                *(LAS unsigned*)(lds + HG_KT + (8 * tg + 2 * i2) * QS + cp * 4) = cvt2(kta0, kta1);
                *(LAS unsigned*)(lds + HG_KT + (8 * tg + 2 * i2 + 1) * QS + cp * 4) = cvt2(ktb0, ktb1);
            }
        }
        *(LAS u32x4*)(lds + HG_KHT + (2 * cp) * TS + tg * 16) = (u32x4){kh0[0], kh0[1], kh0[2], kh0[3]}; *(LAS u32x4*)(lds + HG_KHT + (2 * cp + 1) * TS + tg * 16) = (u32x4){kh1[0], kh1[1], kh1[2], kh1[3]};
        *(LAS u32x4*)(lds + HG_VT + (2 * cp) * TS + tg * 16) = (u32x4){vt0[0], vt0[1], vt0[2], vt0[3]}; *(LAS u32x4*)(lds + HG_VT + (2 * cp + 1) * TS + tg * 16) = (u32x4){vt1[0], vt1[1], vt1[2], vt1[3]};
        if (tg == 0) { *(LAS f32x2*)(lds + HG_DS + 2 * cp * 4) = (f32x2){tot0, tot1}; dseg0 *= tot0; dseg1 *= tot1; }
    }
    lds_barrier();
    if (FULL) {
        if (!(xm & 2))
#pragma unroll
        for (int tt = 0; tt < 2; ++tt) {
            const int tl = 2 * wave + tt, ti = tl >> 2, si = tl & 3;
            f32x4 accA = (f32x4){0.f, 0.f, 0.f, 0.f};
#pragma unroll
            for (int ks = 0; ks < 4; ++ks) {
                const bf16x8 af = *(const LAS bf16x8*)(lds + HG_QT + (16 * ti + fr) * QS + (ks * 32 + fq * 8) * 2);
                const bf16x8 bf = *(const LAS bf16x8*)(lds + HG_KT + (16 * si + fr) * QS + (ks * 32 + fq * 8) * 2);
                accA = __builtin_amdgcn_mfma_f32_16x16x32_bf16(af, bf, accA, 0, 0, 0);
            }
#pragma unroll
            for (int j = 0; j < 4; ++j) { const int t = 16 * ti + 4 * fq + j, s = 16 * si + fr;
                const bool keep = DIR == 0 ? (s <= t) : (s >= t);
                *(LAS bf16_t*)(lds + HG_AM + t * TS + s * 2) = (bf16_t)(cvt2(keep ? accA[j] : 0.f, 0.f) & 0xffffu); }
        }
        lds_barrier();
#pragma unroll
        for (int m = 0; m < 4; ++m) o[m] = (f32x4){0.f, 0.f, 0.f, 0.f};
        if (!(xm & 4)) {
#pragma unroll
        for (int ks = 0; ks < 4; ++ks) {
            const u32x4 sw = (u32x4){cvt2(accS[2 * ks][0], accS[2 * ks][1]), cvt2(accS[2 * ks][2], accS[2 * ks][3]), cvt2(accS[2 * ks + 1][0], accS[2 * ks + 1][1]), cvt2(accS[2 * ks + 1][2], accS[2 * ks + 1][3])};
            const bf16x8 sf = mk_bf16x8(sw);
#pragma unroll
            for (int m = 0; m < 4; ++m) {
                const u32x2 qlo = *(const LAS u32x2*)(lds + HG_QT + (16 * m + fr) * QS + (32 * ks + 4 * fq) * 2), qhi = *(const LAS u32x2*)(lds + HG_QT + (16 * m + fr) * QS + (32 * ks + 16 + 4 * fq) * 2);
                const bf16x8 qf = mk_bf16x8((u32x4){qlo.x, qlo.y, qhi.x, qhi.y});
                o[m] = __builtin_amdgcn_mfma_f32_16x16x32_bf16(qf, sf, o[m], 0, 0, 0);
            }
        }
#pragma unroll
        for (int ks = 0; ks < 2; ++ks) {
            const bf16x8 vf = *(const LAS bf16x8*)(lds + HG_VT + (16 * wave + fr) * TS + (ks * 32 + fq * 8) * 2);
#pragma unroll
            for (int m = 0; m < 4; ++m) { const bf16x8 af = *(const LAS bf16x8*)(lds + HG_AM + (16 * m + fr) * TS + (ks * 32 + fq * 8) * 2);
                o[m] = __builtin_amdgcn_mfma_f32_16x16x32_bf16(af, vf, o[m], 0, 0, 0); }
        }
        }
    }
    if (!(xm & 8)) {
#pragma unroll
    for (int i = 0; i < 8; ++i) { const f32x4 dv = *(const LAS f32x4*)(lds + HG_DS + (16 * i + 4 * fq) * 4); accS[i] = accS[i] * dv; }
#pragma unroll
    for (int ks = 0; ks < 2; ++ks) {
        const bf16x8 vf = *(const LAS bf16x8*)(lds + HG_VT + (16 * wave + fr) * TS + (ks * 32 + fq * 8) * 2);
#pragma unroll
        for (int i = 0; i < 8; ++i) { const bf16x8 af = *(const LAS bf16x8*)(lds + HG_KHT + (16 * i + fr) * TS + (ks * 32 + fq * 8) * 2);
            accS[i] = __builtin_amdgcn_mfma_f32_16x16x32_bf16(af, vf, accS[i], 0, 0, 0); }
    }
    }
    if (STORE_NEXT) hg_store_raw<FULL, NEXT_GATE>(lds, nxt, tid);
}

__device__ __forceinline__ float hg_lb(const float* __restrict__ lb_logits, int dir, int col) {
    const float l0 = lb_logits[(0 * 2 + dir) * 512 + col], l1 = lb_logits[(1 * 2 + dir) * 512 + col];
    return 1.0f / (1.0f + expf(l1 - l0));
}

template <int DIR>
__device__ __forceinline__ void hg_agg_unit(LAS unsigned char* lds, const Args& a, int b, int hd, int sidx, int unit, int tid, int wave, int lane) {
    const bf16_t* __restrict__ proj = (const bf16_t*)(a.ws + WS_PROJ);
    const int rowbase = sidx == 0 ? T + b * LC : b * SEQ + (sidx - 1) * 256;
    const float lb0 = hg_lb(a.in[12], DIR, hd * 128 + 2 * lane), lb1 = hg_lb(a.in[12], DIR, hd * 128 + 2 * lane + 1);
    f32x4 accS[8], odummy[4];
#pragma unroll
    for (int i = 0; i < 8; ++i) accS[i] = (f32x4){0.f, 0.f, 0.f, 0.f};
    float dseg0 = 1.f, dseg1 = 1.f;
    HgRaw raw;
    hg_load_raw<false, false>(raw, proj, rowbase + (DIR == 0 ? 0 : 3) * 64, hd, DIR, tid);
    lds_barrier();
    hg_store_raw<false, false>(lds, raw, tid);
    lds_barrier();
#pragma unroll 1
    for (int cc = 0; cc < 3; ++cc) {
        hg_load_raw<false, false>(raw, proj, rowbase + (DIR == 0 ? cc + 1 : 2 - cc) * 64, hd, DIR, tid);
        hg_chunk<DIR, false, true, false>(lds, accS, odummy, lb0, lb1, dseg0, dseg1, raw, tid, wave, lane);
        lds_barrier();
    }
    hg_chunk<DIR, false, false, false>(lds, accS, odummy, lb0, lb1, dseg0, dseg1, raw, tid, wave, lane);
    float* K = (float*)(a.ws + WS_HGK) + (size_t)unit * 16384;
    const int fr = lane & 15, fq = lane >> 4;
#pragma unroll
    for (int i = 0; i < 8; ++i)
#pragma unroll
        for (int j = 0; j < 4; ++j) K[(16 * i + 4 * fq + j) * 128 + 16 * wave + fr] = accS[i][j];
    if (wave == 0) *(f32x2*)((float*)(a.ws + WS_HGD) + (size_t)unit * 128 + 2 * lane) = (f32x2){dseg0, dseg1};
}

__device__ __forceinline__ void hg_carry_item(const Args& a, int item, int tid, bool dry = false) {
    const int chain = item >> 3, part = item & 7, dir = chain & 1;
    float* K = (float*)(a.ws + WS_HGK) + (size_t)chain * HG_SEGS * 16384; const float* D = (const float*)(a.ws + WS_HGD) + (size_t)chain * HG_SEGS * 128;
    const int e4 = part * 512 + tid, dk = e4 >> 5;
    f32x4 kv[HG_SEGS]; float dv[HG_SEGS];
#pragma unroll
    for (int s = 0; s < HG_SEGS; ++s) { const int sidx = s == 0 ? 0 : (dir == 0 ? s : HG_SEGS - s); kv[s] = *(const f32x4*)(K + (size_t)sidx * 16384 + e4 * 4); dv[s] = D[sidx * 128 + dk]; }
    f32x4 S = (f32x4){0.f, 0.f, 0.f, 0.f};
#pragma unroll
    for (int s = 0; s < HG_SEGS; ++s) { const int sidx = s == 0 ? 0 : (dir == 0 ? s : HG_SEGS - s);
        if (dry) { const size_t o = ((size_t)(chain * HG_SEGS + sidx) * 16384 + e4 * 4) % (size_t)(32 * MiB); *(f32x4*)((float*)(a.ws + WS_MIXED) + o) = S; } else *(f32x4*)(K + (size_t)sidx * 16384 + e4 * 4) = S;
        S = S * dv[s] + kv[s]; }
}

__device__ __forceinline__ void hg_final_unit(LAS unsigned char* lds, const Args& a, int b, int hd, int seg, int tid, int wave, int lane, int xm = 0) {
    const bf16_t* __restrict__ proj = (const bf16_t*)(a.ws + WS_PROJ); bf16_t* mixed = (bf16_t*)(a.ws + WS_MIXED);
    const int rowbase = b * SEQ + seg * 256, fr = lane & 15, fq = lane >> 4;
    const float lbf0 = hg_lb(a.in[12], 0, hd * 128 + 2 * lane), lbf1 = hg_lb(a.in[12], 0, hd * 128 + 2 * lane + 1);
    const float lbb0 = hg_lb(a.in[12], 1, hd * 128 + 2 * lane), lbb1 = hg_lb(a.in[12], 1, hd * 128 + 2 * lane + 1);
    f32x4 accS[8], o[4];
    float dseg0 = 1.f, dseg1 = 1.f;
    HgRaw raw;
    f32x4* ofst = (f32x4*)(a.ws + WS_OFST) + (size_t)blockIdx.x * 8192 + wave * 256 + lane;
    hg_load_raw<true, false>(raw, proj, rowbase, hd, 0, tid);
    {
        const float* Sin = (const float*)(a.ws + WS_HGK) + (size_t)((((b * 4 + hd) * 2 + 0) * HG_SEGS) + 1 + seg) * 16384;
#pragma unroll
        for (int i = 0; i < 8; ++i)
#pragma unroll
            for (int j = 0; j < 4; ++j) accS[i][j] = Sin[(16 * i + 4 * fq + j) * 128 + 16 * wave + fr];
    }
    lds_barrier();
    hg_store_raw<true, false>(lds, raw, tid);
    lds_barrier();
#pragma unroll 1
    for (int cc = 0; cc < 3; ++cc) {
        hg_load_raw<true, false>(raw, proj, rowbase + (cc + 1) * 64, hd, 0, tid);
        hg_chunk<0, true, true, false>(lds, accS, o, lbf0, lbf1, dseg0, dseg1, raw, tid, wave, lane, xm);
#pragma unroll
        for (int m = 0; m < 4; ++m) ofst[cc * 2048 + m * 64] = o[m];
        lds_barrier();
    }
    hg_load_raw<true, false>(raw, proj, rowbase + 3 * 64, hd, 1, tid);
    hg_chunk<0, true, true, false>(lds, accS, o, lbf0, lbf1, dseg0, dseg1, raw, tid, wave, lane, xm);
#pragma unroll
    for (int m = 0; m < 4; ++m) ofst[3 * 2048 + m * 64] = o[m];
    {
        const float* Sin = (const float*)(a.ws + WS_HGK) + (size_t)((((b * 4 + hd) * 2 + 1) * HG_SEGS) + 1 + seg) * 16384;
#pragma unroll
        for (int i = 0; i < 8; ++i)
#pragma unroll
            for (int j = 0; j < 4; ++j) accS[i][j] = Sin[(16 * i + 4 * fq + j) * 128 + 16 * wave + fr];
    }
    lds_barrier();
    constexpr int OSF = 528;
    f32x4 ngv[2];
    { const float* ngp = a.in[13] + hd * 128 + (tid & 15) * 8; ngv[0] = *(const f32x4*)ngp; ngv[1] = *(const f32x4*)(ngp + 4); }
#pragma unroll 1
    for (int cc = 0; cc < 4; ++cc) {
        const int c = 3 - cc;
        f32x4 ofv[4]; u32x4 gq[2];
#pragma unroll
        for (int m = 0; m < 4; ++m) ofv[m] = ofst[c * 2048 + m * 64];
#pragma unroll
        for (int i = 0; i < 2; ++i) gq[i] = *(const u32x4*)proj_at(proj, rowbase + c * 64 + (tid >> 4) + 32 * i, 3072 + hd * 128 + (tid & 15) * 8);
        if (cc < 3) hg_load_raw<true, false>(raw, proj, rowbase + (c - 1) * 64, hd, 1, tid);
        if (cc < 3) hg_chunk<1, true, true, false>(lds, accS, o, lbb0, lbb1, dseg0, dseg1, raw, tid, wave, lane, xm);
        else hg_chunk<1, true, false, false>(lds, accS, o, lbb0, lbb1, dseg0, dseg1, raw, tid, wave, lane, xm);
        if (xm & 16) { lds_barrier(); continue; }
        lds_barrier();
#pragma unroll
        for (int m = 0; m < 4; ++m) { const f32x4 ot = o[m] + ofv[m];
#pragma unroll
            for (int j = 0; j < 4; ++j) *(LAS float*)(lds + HG_QT + (16 * m + 4 * fq + j) * OSF + (16 * wave + fr) * 4) = ot[j]; }
        lds_barrier();
#pragma unroll
        for (int i = 0; i < 2; ++i) { const int t = (tid >> 4) + 32 * i, c8 = (tid & 15) * 8;
            const f32x4 v0 = *(const LAS f32x4*)(lds + HG_QT + t * OSF + c8 * 4), v1 = *(const LAS f32x4*)(lds + HG_QT + t * OSF + c8 * 4 + 16);
            const float ss = row_allsum16((v0[0] * v0[0] + v0[1] * v0[1]) + (v0[2] * v0[2] + v0[3] * v0[3]) + (v1[0] * v1[0] + v1[1] * v1[1]) + (v1[2] * v1[2] + v1[3] * v1[3]));
            const float rinv = __builtin_amdgcn_rsqf(ss * (1.0f / 128.0f) + LN_EPS);
            const u32x4 g = gq[i];
            u32x4 w;
            w.x = cvt2(v0[0] * rinv * ngv[0][0] * bf_lo(g.x), v0[1] * rinv * ngv[0][1] * bf_hi(g.x)); w.y = cvt2(v0[2] * rinv * ngv[0][2] * bf_lo(g.y), v0[3] * rinv * ngv[0][3] * bf_hi(g.y));
            w.z = cvt2(v1[0] * rinv * ngv[1][0] * bf_lo(g.z), v1[1] * rinv * ngv[1][1] * bf_hi(g.z)); w.w = cvt2(v1[2] * rinv * ngv[1][2] * bf_lo(g.w), v1[3] * rinv * ngv[1][3] * bf_hi(g.w));
            *(u32x4*)(mixed + (size_t)(rowbase + c * 64 + t) * DM + 512 + hd * 128 + c8) = w; }
    }
}

__device__ __forceinline__ void p_scan_a(LAS unsigned char* lds, const Args& a, int bid, int G, int tid, int wave, int lane, int mask = 3, int xr = 0) {
    constexpr int N_HG = NB * 4 * 2 * HG_SEGS, N_RG = NB * RG_UNITS_PER_B;
    if (mask & 1) {
        const bool bal = G == 256;
        const int hn = bal ? (bid < 128 ? 9 : (bid < 192 ? 8 : 6)) : (2048 - bid + G - 1) / G;
        const int hs = bal ? (bid < 128 ? 9 * bid : (bid < 192 ? 1152 + 8 * (bid - 128) : 1664 + 6 * (bid - 192))) : bid, hstep = bal ? 1 : G;
#pragma unroll 1
        for (int k = 0; k < hn; ++k) {
            int t2 = tid; asm volatile("" : "+v"(t2)); const int tid = t2, lane = t2 & 63;
            const int it = hs + k * hstep, s16 = it & 15, rest = it >> 4, dir = rest & 1, hd = (rest >> 1) & 3, b = rest >> 3;
            const int sidx = dir == 0 ? s16 : (s16 == 0 ? 0 : s16 + 1), unit = rest * HG_SEGS + sidx;
            if (dir == 0) hg_agg_unit<0>(lds, a, b, hd, sidx, unit, tid, wave, lane); else hg_agg_unit<1>(lds, a, b, hd, sidx, unit, tid, wave, lane);
        }
    }
    if (mask & 2) {
        __syncthreads();
        u32x4 raw[11];
        int r = G - 1 - bid;
        if (r < N_RG) rg_load_raw(raw, (const bf16_t*)(a.ws + WS_PROJ), r / RG_UNITS_PER_B, r % RG_UNITS_PER_B, tid);
#pragma unroll 1
        for (; r < N_RG; r += G) {
            int t2 = tid; asm volatile("" : "+v"(t2)); const int tid = t2, lane = t2 & 63;
            const int rn = r + G;
            rg_agg_unit(lds, a, r / RG_UNITS_PER_B, r % RG_UNITS_PER_B, raw, rn / RG_UNITS_PER_B, rn < N_RG ? rn % RG_UNITS_PER_B : -1, tid, wave, lane, xr);
        }
    }
}
__device__ __forceinline__ void p_scan_b(const Args& a, int bid, int G, int tid, bool dry = false) {
#pragma unroll 1
    for (int it = bid; it < 1024; it += G) hg_carry_item(a, it, tid, dry);
    if (bid >= G - 32) rg_carry_item(a, bid - (G - 32), tid);
}
__device__ __forceinline__ void p_scan_c(LAS unsigned char* lds, const Args& a, int bid, int G, int tid, int wave, int lane, int mask = 3, int xm = 0) {
#pragma unroll 1
    for (int it = bid; it < ((mask & 1) ? 1024 : 0); it += G) { const int seg = it & 15, hd = (it >> 4) & 3, b = it >> 6; int t2 = tid; asm volatile("" : "+v"(t2)); hg_final_unit(lds, a, b, hd, seg, t2, wave, t2 & 63, xm); }
    if (mask & 2) {
        __syncthreads();
        u32x4 g[8], st[2][4];
        int r = bid;
        if (r < 1024) rg_final_load(g, st, a, r >> 6, r & 63, tid, wave, lane);
#pragma unroll 1
        for (; r < 1024; r += G) {
            int t2 = tid; asm volatile("" : "+v"(t2)); const int rn = r + G;
            rg_final_unit(lds, a, r >> 6, r & 63, g, st, rn >> 6, rn < 1024 ? (rn & 63) : -1, t2, wave, t2 & 63);
        }
    }
}

#define GAS __attribute__((address_space(1)))
#define RLX_AGENT __ATOMIC_RELAXED, __HIP_MEMORY_SCOPE_AGENT
#define XB_TMO      128
#define XB_XCNT(j)  (256  + 64 * (j))
#define XB_XSUB(j)  (1280 + 64 * (j))
#define XB_XGEN(j)  (2304 + 64 * (j))
#define XB_TOP      3328
#define XB_TOPGEN   3392
#define XCD_BAR_WORDS 3456
#define XB_SPIN_CAP (1u << 18)

__device__ __forceinline__ unsigned xb_ld(unsigned* p)              { return __hip_atomic_load(p, __ATOMIC_RELAXED, __HIP_MEMORY_SCOPE_AGENT); }
__device__ __forceinline__ unsigned xb_add(unsigned* p, unsigned v) { return __hip_atomic_fetch_add(p, v, __ATOMIC_RELAXED, __HIP_MEMORY_SCOPE_AGENT); }
__device__ __forceinline__ unsigned xb_xcc_id() { return (unsigned)__builtin_amdgcn_s_getreg((3 << 11) | 20) & 0xFu; }
#define XB_SPIN(cond, bar) do { unsigned _sp = 0; while (cond) { __builtin_amdgcn_s_sleep(1); \
    if ((++_sp & 255u) == 0u) { if (xb_ld(&(bar)[XB_TMO])) break; if (_sp > XB_SPIN_CAP) { atomicAdd(&(bar)[XB_TMO], 1u); break; } } } } while (0)

struct XcdBarrier {
    unsigned* bar; unsigned x;
    volatile LAS unsigned* st;
};

__device__ __forceinline__ XcdBarrier xcd_barrier_post(unsigned* bar, volatile LAS unsigned* st) {
    XcdBarrier b; b.bar = bar; b.x = xb_xcc_id(); b.st = st;
    if (threadIdx.x == 0) (void)xb_add(&bar[XB_XCNT(b.x)], 1u);
    return b;
}
__device__ __forceinline__ void xcd_barrier_complete(unsigned* bar, unsigned x, unsigned& nloc, unsigned& nx) {
    const unsigned G = gridDim.x * gridDim.y * gridDim.z;
    unsigned sum, cnt, mine, sp = 0u;
    for (;;) {
        sum = 0u; cnt = 0u; mine = 0u;
#pragma unroll
        for (unsigned j = 0; j < 16; ++j) { const unsigned c = xb_ld(&bar[XB_XCNT(j)]); sum += c; cnt += (c > 0u) ? 1u : 0u; mine = (j == x) ? c : mine; }
        if (sum == G) break;
        __builtin_amdgcn_s_sleep(1);
        if ((++sp & 255u) == 0u) { if (xb_ld(&bar[XB_TMO])) break; if (sp > XB_SPIN_CAP) { atomicAdd(&bar[XB_TMO], 1u); break; } }
    }
    nloc = mine > 0u ? mine : 1u; nx = cnt > 0u ? cnt : 1u;
}

__device__ __forceinline__ void xcd_barrier(const XcdBarrier& b) {
    asm volatile("s_waitcnt vmcnt(0)" ::: "memory");
    __syncthreads();
    if (threadIdx.x == 0) {
        unsigned* bar = b.bar;
        __builtin_amdgcn_s_waitcnt(0);
        unsigned nloc = b.st[0], nx = b.st[1];
        if (nloc == 0u) { xcd_barrier_complete(bar, b.x, nloc, nx); b.st[0] = nloc; b.st[1] = nx; }
        const unsigned old = xb_add(&bar[XB_XSUB(b.x)], 1u);
        const unsigned gen = old / nloc;
        if (old + 1u == (gen + 1u) * nloc) {
            __builtin_amdgcn_fence(__ATOMIC_RELEASE, "agent");
            asm volatile("s_waitcnt vmcnt(0)" ::: "memory");
            const unsigned og = xb_add(&bar[XB_TOP], 1u);
            const unsigned tg = og / nx;
            if (og + 1u == (tg + 1u) * nx) xb_add(&bar[XB_TOPGEN], 1u);
            else XB_SPIN(xb_ld(&bar[XB_TOPGEN]) == tg, bar);
            __builtin_amdgcn_fence(__ATOMIC_ACQUIRE, "agent");
            xb_add(&bar[XB_XGEN(b.x)], 1u);
            asm volatile("s_waitcnt vmcnt(0)" ::: "memory");
        } else {
            XB_SPIN(xb_ld(&bar[XB_XGEN(b.x)]) == gen, bar);
            __builtin_amdgcn_fence(__ATOMIC_ACQUIRE, "agent");
            asm volatile("s_waitcnt vmcnt(0)" ::: "memory");
        }
    }
    __syncthreads();
}


__device__ __forceinline__ void stagger_wait(unsigned ticks) {
    if (ticks == 0u) return;
    const unsigned long long t0 = __builtin_amdgcn_s_memrealtime();
    while (__builtin_amdgcn_s_memrealtime() - t0 < ticks) __builtin_amdgcn_s_sleep(16);
}
#ifndef STAG_P2
#define STAG_P2 0
#endif

__global__ void __launch_bounds__(NTHREADS, 2) mega(Args a) {
    extern __shared__ __attribute__((aligned(16))) unsigned char lds_raw[];
    LAS unsigned char* lds = (LAS unsigned char*)lds_raw;
    const int wave = __builtin_amdgcn_readfirstlane(threadIdx.x >> 6), bid = blockIdx.x, G = gridDim.x;
    int tid = threadIdx.x, lane = tid & 63;
#define FRESH_TID() do { tid = threadIdx.x; asm volatile("" : "+v"(tid)); lane = tid & 63; } while (0)
    unsigned char* ws = a.ws;
    volatile LAS unsigned* bst = (volatile LAS unsigned*)(lds + LDS_BYTES - 64);
    if (threadIdx.x < 2) bst[threadIdx.x] = 0u;
    __syncthreads();
    XcdBarrier xbar = xcd_barrier_post((unsigned*)(ws + WS_BAR), bst);
#define GRID_BAR() xcd_barrier(xbar)
    float* mod = (float*)(ws + WS_MOD);
    bf16_t* U = (bf16_t*)(ws + WS_U);
    bf16_t* PROJ = (bf16_t*)(ws + WS_PROJ); bf16_t* MIXED = (bf16_t*)(ws + WS_MIXED);

    p_mod(lds, a.in[1], a.in[3], a.in[4], a.in[5], mod, bid, G, tid);
    p_transposes(lds, a, bid, G, tid);
    p_gwt(a.in[9], (bf16_t*)(ws + WS_GWT), bid, G, tid);
    p_rgpar(a.in[10], a.in[11], (float*)(ws + WS_RGPAR), bid, G, tid);
    p_wrt(a.in[17], a.in[19], (bf16_t*)(ws + WS_WRT), bid, G, tid);
    GRID_BAR();
    FRESH_TID();
    p_u(a.in[0], a.in[2], mod, U, bid, G, tid);
    GRID_BAR();
    FRESH_TID();
    { pg8::Gemm g{U, (const bf16_t*)(ws + WS_WINT), TA, NIN, DM}; pg8::StaticOrder S; S.init(TA, NIN, G, bid);
      pg8::EpiInProj E{PROJ, 0, 0};
      pg8::gemm_phase<pg8::EpiInProj, pg8::StaticOrder, true, true>(lds, g, S, E); }
    GRID_BAR();
    FRESH_TID();
    p_scan_a(lds, a, bid, G, tid, wave, lane);
    GRID_BAR();
    FRESH_TID();
    p_scan_b(a, bid, G, tid);
    GRID_BAR();
    FRESH_TID();
    p_scan_c(lds, a, bid, G, tid, wave, lane);
    GRID_BAR();
    FRESH_TID();
    { pg8::Gemm g{MIXED, (const bf16_t*)(ws + WS_WOUTT), T, DM, DM}; pg8::StaticOrder S; S.init(T, DM, G, bid);
      pg8::EpiY E{(bf16_t*)(ws + WS_XG)};
      pg8::gemm_phase<pg8::EpiY, pg8::StaticOrder, true, true>(lds, g, S, E); }
    GRID_BAR();
    FRESH_TID();
    p_ln1_router(lds, a, bid, G, tid, wave, lane);
    GRID_BAR();
    FRESH_TID();
    p_assign(lds, a, bid, G, tid);
    GRID_BAR();
    FRESH_TID();
    { pg8::Gemm g{(const bf16_t*)(ws + WS_U), (const bf16_t*)(ws + WS_W13T), MAXROWS, NE * DM, DM}; pg8::ExpertOrderG S{(const int*)(ws + WS_RBPRE), (const int*)(ws + WS_ROWTOK), G, bid};
      pg8::EpiExp1 E{(bf16_t*)(ws + WS_HID)};
      pg8::gemm_phase<pg8::EpiExp1, pg8::ExpertOrderG, true, true>(lds, g, S, E); }
    GRID_BAR();
    FRESH_TID();
    { pg8::Gemm g{(const bf16_t*)(ws + WS_HID), (const bf16_t*)(ws + WS_W2T), MAXROWS, NE * DM, DE}; pg8::ExpertOrder S{(const int*)(ws + WS_RBPRE), nullptr, G, bid};
      pg8::EpiY E{(bf16_t*)(ws + WS_Y)};
      pg8::gemm_phase<pg8::EpiY, pg8::ExpertOrder, true, true>(lds, g, S, E); }
    GRID_BAR();
    FRESH_TID();
    p_combine_ln2(a, bid, G, wave, lane);
}

extern "C" void kernel_launch(void* const* d_in, const int* in_sizes, int n_in, void* d_out, int out_size, void* d_ws, size_t ws_size, hipStream_t stream) {
    static int grid = 0;
    if (grid == 0) {
        if (n_in != 26 || ws_size < WS_END) { fprintf(stderr, "kernel_launch: unexpected n_in %d or workspace %zu < %zu\n", n_in, ws_size, (size_t)WS_END); grid = -1; return; }
        int dev = 0, cus = 0, per_cu = 0;
        if (hipGetDevice(&dev) != hipSuccess || hipDeviceGetAttribute(&cus, hipDeviceAttributeMultiprocessorCount, dev) != hipSuccess) { grid = -1; return; }
        if (hipFuncSetAttribute((const void*)mega, hipFuncAttributeMaxDynamicSharedMemorySize, LDS_BYTES) != hipSuccess) { fprintf(stderr, "kernel_launch: hipFuncSetAttribute failed\n"); grid = -1; return; }
        if (hipOccupancyMaxActiveBlocksPerMultiprocessor(&per_cu, (const void*)mega, NTHREADS, LDS_BYTES) != hipSuccess || per_cu < 1) { fprintf(stderr, "kernel_launch: occupancy query says %d\n", per_cu); per_cu = 1; }
        (void)hipGetLastError();
        grid = cus;
        fprintf(stderr, "kernel_launch: grid %d (cus %d, per_cu %d), ws %zu\n", grid, cus, per_cu, ws_size);
    }
    if (grid < 0) return;
    (void)hipMemsetAsync(d_ws, 0, 131072, stream);
    Args a{};
    for (int i = 0; i < 26; ++i) a.in[i] = (const float*)d_in[i];
    a.out = (float*)d_out; a.ws = (unsigned char*)d_ws;
    void* params[] = {&a};
    hipError_t e = hipLaunchCooperativeKernel((const void*)mega, dim3(grid), dim3(NTHREADS), params, LDS_BYTES, stream);
    if (e != hipSuccess) fprintf(stderr, "kernel_launch: cooperative launch failed: %s (grid %d)\n", hipGetErrorString(e), grid);
}
```

```cpp
#include <hip/hip_runtime.h>
#include <hip/hip_cooperative_groups.h>
#include <cstdio>
#include <cstdint>
namespace cg = cooperative_groups;

typedef unsigned short bf16_t;
typedef short bf16x8 __attribute__((ext_vector_type(8)));
typedef float f32x4 __attribute__((ext_vector_type(4)));
typedef float f32x2 __attribute__((ext_vector_type(2)));
typedef unsigned u32x4 __attribute__((ext_vector_type(4)));
typedef unsigned u32x2 __attribute__((ext_vector_type(2)));
typedef int i32x4 __attribute__((ext_vector_type(4)));
#define LAS __attribute__((address_space(3)))

constexpr int NB = 16, SEQ = 4096, LC = 256, DM = 1024;
constexpr int T = NB * SEQ;
constexpr int TC = NB * LC;
constexpr int TA = T + TC;
constexpr int NIN = 3584;
constexpr int NE = 32, DE = 512;
constexpr int MAXROWS = 2 * T + NE * 256;
constexpr float ALPHA = 1.189207115002721f;
constexpr float LN_EPS = 1e-6f;
constexpr int NTHREADS = 512;

constexpr size_t MiB = 1u << 20;
constexpr size_t WS_CTL = 0;
constexpr size_t WS_BAR = 65536;
constexpr size_t WS_MOD = 1 * MiB;
constexpr size_t WS_EIDX = 3 * MiB;
constexpr size_t WS_EPOS = 3 * MiB + 512 * 1024;
constexpr size_t WS_EW = 4 * MiB;
constexpr size_t WS_DEST = 4 * MiB + 512 * 1024;
constexpr size_t WS_WINT = 6 * MiB;
constexpr size_t WS_WOUTT = 13 * MiB;
constexpr size_t WS_W13T = 15 * MiB;
constexpr size_t WS_W2T = 79 * MiB;
constexpr size_t WS_U = 112 * MiB;
constexpr size_t WS_PROJ = 248 * MiB;
constexpr size_t WS_XG = 248 * MiB;
constexpr size_t WS_HID = 520 * MiB;
constexpr size_t WS_Y = 656 * MiB;
constexpr size_t WS_MIXED = 724 * MiB;
constexpr size_t WS_OSUM = 852 * MiB;
constexpr size_t WS_U2Q = 930 * MiB;
constexpr float W13_SCALE = 64.0f;
constexpr size_t WS_END = 1000 * MiB;
constexpr int LDS_BYTES = 163840;

__device__ __forceinline__ const bf16_t* proj_at(const bf16_t* P, int row, int col) { return P + (((size_t)(col >> 5) * TA + row) << 5) + (col & 31); }

template <class V> __device__ __forceinline__ V ntld(const V* p) { return __builtin_nontemporal_load(p); }
template <class V> __device__ __forceinline__ void ntst(V* p, V v) { __builtin_nontemporal_store(v, p); }

__device__ __forceinline__ float bf2f(bf16_t b) { return __uint_as_float(((unsigned)b) << 16); }
__device__ __forceinline__ bf16_t f2bf(float f) { unsigned u = __float_as_uint(f); return (bf16_t)((u + 0x7fffu + ((u >> 16) & 1u)) >> 16); }
__device__ __forceinline__ unsigned pk2(float lo, float hi) { unsigned r; asm volatile("v_cvt_pk_bf16_f32 %0, %1, %2" : "=v"(r) : "v"(lo), "v"(hi)); return r; }
__device__ __forceinline__ float clamp_fp8(float x) { return __builtin_amdgcn_fmed3f(x, -448.0f, 448.0f); }
__device__ __forceinline__ unsigned pk4_fp8(float a, float b, float c, float d) { int r = __builtin_amdgcn_cvt_pk_fp8_f32(clamp_fp8(a), clamp_fp8(b), 0, false); r = __builtin_amdgcn_cvt_pk_fp8_f32(clamp_fp8(c), clamp_fp8(d), r, true); return (unsigned)r; }
__device__ __forceinline__ float frcp(float x) { return __builtin_amdgcn_rcpf(x); }
__device__ __forceinline__ float sigmoidf_(float x) { return frcp(1.0f + __expf(-x)); }
__device__ __forceinline__ float siluf_(float x) { return x * frcp(1.0f + __expf(-x)); }
__device__ __forceinline__ float gelu_tanh(float x) {
    const float y = 0.7978845608028654f * (x + 0.044715f * x * x * x);
    return x * frcp(1.0f + __expf(-2.0f * y));
}
__device__ __forceinline__ float softplusf_(float x) { return fmaxf(x, 0.f) + log1pf(expf(-fabsf(x))); }
__device__ __forceinline__ float wave_sum(float v) {
#pragma unroll
    for (int o = 1; o < 64; o <<= 1) v += __shfl_xor(v, o);
    return v;
}
constexpr int CSTR = 64;
__device__ __forceinline__ int pstart_of(const int* __restrict__ counts, int e) {
    int acc = 0;
    for (int i = 0; i < NE; ++i) { const int p = ((counts[i * CSTR] + 255) >> 8) << 8; if (i < e) acc += p; }
    return acc;
}

namespace pg8 {
#define PG8_LAS __attribute__((address_space(3)))
typedef unsigned short bf16_t;
typedef short bf16x8 __attribute__((ext_vector_type(8)));
typedef int pg8_i32x4 __attribute__((ext_vector_type(4)));
typedef int pg8_i32x8 __attribute__((ext_vector_type(8)));
template <bool MX> struct PgFrag;
template <> struct PgFrag<false> { bf16x8 k[2]; };
template <> struct PgFrag<true> { pg8_i32x8 v; };
__device__ __forceinline__ void pg_ld(PgFrag<false>& f, const PG8_LAS unsigned char* p) { f.k[0] = *(const PG8_LAS bf16x8*)p; f.k[1] = *(const PG8_LAS bf16x8*)(p + 1024); }
__device__ __forceinline__ void pg_ld(PgFrag<true>& f, const PG8_LAS unsigned char* p) {
    const pg8_i32x4 lo = *(const PG8_LAS pg8_i32x4*)p, hi = *(const PG8_LAS pg8_i32x4*)(p + 1024); f.v = __builtin_shufflevector(lo, hi, 0, 1, 2, 3, 4, 5, 6, 7); }
__device__ __forceinline__ f32x4 pg_mma(const PgFrag<false>& b, const PgFrag<false>& a, f32x4 c) {
    c = __builtin_amdgcn_mfma_f32_16x16x32_bf16(b.k[0], a.k[0], c, 0, 0, 0); return __builtin_amdgcn_mfma_f32_16x16x32_bf16(b.k[1], a.k[1], c, 0, 0, 0); }
__device__ __forceinline__ f32x4 pg_mma(const PgFrag<true>& b, const PgFrag<true>& a, f32x4 c) {
    asm volatile("s_nop 1\n\tv_mfma_scale_f32_16x16x128_f8f6f4 %0, %1, %2, %0, %3, %4 op_sel_hi:[0,0,0]" : "+v"(c) : "v"(b.v), "v"(a.v), "v"(0x79797979), "v"(0x7F7F7F7F));
    return c; }
__device__ __forceinline__ void pg_mma_drain() { asm volatile("s_nop 15\n\ts_nop 15\n\ts_nop 7" ::: "memory"); }

typedef float f32x4 __attribute__((ext_vector_type(4)));
typedef unsigned u32x4 __attribute__((ext_vector_type(4)));
constexpr int BM = 256, BK = 64, HALF = 128, HTB = HALF * BK * 2  , STAGE_BYTES = 8 * HTB, NXCD = 8, WGM = 8;

__host__ __device__ __forceinline__ int lds_byte(int r, int c) { const int st = (r >> 4) * 2 + (c >> 5), rr = r & 15, cc = c & 31, ob = rr * 64 + cc * 2; return st * 1024 + (ob ^ (((ob >> 9) & 1) << 5)); }
__host__ __device__ __forceinline__ void stage_rc(int b, int& R, int& C) { const int st = b / 1024, sb = b % 1024, swz = sb ^ (((sb >> 9) & 1) << 5); R = (st >> 1) * 16 + swz / 64; C = (st & 1) * 32 + (swz % 64) / 2; }
__host__ __device__ __forceinline__ int perm32(int rho) { const int n = rho >> 4, i = rho & 15; return 8 * (i >> 2) + 4 * n + (i & 3); }

struct Unit { int pm, pn; };
struct Gemm { const bf16_t* A; const bf16_t* Bt; int M, N, K; };

struct StaticOrder {
    static constexpr bool GATHER = false; const int* rowtok = nullptr;
    int nM, nN, nwg, G, c;
    __host__ __device__ void init(int M, int N, int G_, int c_) { nM = M / BM; nN = N / BM; nwg = nM * nN; G = G_; c = c_; }
    __host__ __device__ bool next(int i, Unit& u) const {
        const long L = (long)i * G + c; if (L >= nwg) return false;
        int wgid = (int)L; { const int q = nwg / NXCD, r = nwg % NXCD, xcd = wgid % NXCD, off = wgid / NXCD; wgid = (xcd < r ? xcd * (q + 1) : r * (q + 1) + (xcd - r) * q) + off; }
        const int nig = WGM * nN, gid = wgid / nig, fm = gid * WGM, gsz = (nM - fm) < WGM ? (nM - fm) : WGM;
        u.pm = fm + ((wgid % nig) % gsz); u.pn = (wgid % nig) / gsz; return true;
    }
    __device__ __forceinline__ void a_ready(const Unit&) const {}
    __device__ __forceinline__ void done(const Unit&) const {}
};

__device__ __forceinline__ unsigned cvt_pk_bf16(float lo, float hi) { unsigned r; asm volatile("v_cvt_pk_bf16_f32 %0, %1, %2" : "=v"(r) : "v"(lo), "v"(hi)); return r; }

struct EpiInProj {
    static constexpr bool PERM = true, AFTER_DRAIN = false;
    bf16_t* P; int variant; int pad;
    __device__ __forceinline__ void operator()(const f32x4 (&acc)[2][2][4][2], const Unit& u, int wr, int wc, int fr_, int fq_) const {
        int fr = fr_, fq = fq_; asm volatile("" : "+v"(fr), "+v"(fq));
        const int row0 = u.pm * BM + wr * 64 + fr, col0 = u.pn * BM + wc * 32 + 8 * fq, grp = variant == 1 ? 0 : (u.pn >> 1);
#pragma unroll
        for (int ai = 0; ai < 2; ++ai)
#pragma unroll
            for (int m = 0; m < 4; ++m) { bf16_t* rowp = P + (((size_t)(8 * u.pn + wc) * TA + (row0 + ai * HALF + m * 16)) << 5) + 8 * fq;
#pragma unroll
                for (int bj = 0; bj < 2; ++bj) { f32x4 v0 = acc[ai][bj][m][0], v1 = acc[ai][bj][m][1];
                    if (grp == 2) {
#pragma unroll
                        for (int j = 0; j < 4; ++j) { v0[j] = siluf_(v0[j]); v1[j] = siluf_(v1[j]); } }
                    u32x4 w; w.x = cvt_pk_bf16(v0[0], v0[1]); w.y = cvt_pk_bf16(v0[2], v0[3]); w.z = cvt_pk_bf16(v1[0], v1[1]); w.w = cvt_pk_bf16(v1[2], v1[3]);
                    if (variant == 3) { const int wv = __builtin_amdgcn_readfirstlane(threadIdx.x >> 6); *(u32x4*)(P + ((size_t)((u.pm * 14 + u.pn) * 8 + wv) * 16 + (ai * 4 + m) * 2 + bj) * 512 + (threadIdx.x & 63) * 8) = w; }
                    else if (variant != 2 || w.x == 0x12345678u) *(u32x4*)(rowp + (size_t)bj * 4 * TA * 32) = w; } }
    }
};
struct EpiNull {
    static constexpr bool PERM = true, AFTER_DRAIN = false;
    float* sink;
    __device__ __forceinline__ void operator()(const f32x4 (&acc)[2][2][4][2], const Unit& u, int wr, int wc, int fr_, int fq_) const {
        float s = 0.f;
#pragma unroll
        for (int ai = 0; ai < 2; ++ai)
#pragma unroll
            for (int bj = 0; bj < 2; ++bj)
#pragma unroll
                for (int m = 0; m < 4; ++m)
#pragma unroll
                    for (int n = 0; n < 2; ++n) s += acc[ai][bj][m][n][0] + acc[ai][bj][m][n][1] + acc[ai][bj][m][n][2] + acc[ai][bj][m][n][3];
        if (s == 123.456f) sink[0] = s;
    }
};
struct EpiF32 {
    static constexpr bool PERM = false, AFTER_DRAIN = false;
    float* C; int ldc; int pad;
    __device__ __forceinline__ void operator()(const f32x4 (&acc)[2][2][4][2], const Unit& u, int wr, int wc, int fr_, int fq_) const {
        int fr = fr_, fq = fq_; asm volatile("" : "+v"(fr), "+v"(fq));
        const int row0 = u.pm * BM + wr * 64 + fr, col0 = u.pn * BM + wc * 32 + 4 * fq;
#pragma unroll
        for (int ai = 0; ai < 2; ++ai)
#pragma unroll
            for (int m = 0; m < 4; ++m) { float* rowp = C + (size_t)(row0 + ai * HALF + m * 16) * ldc + col0;
#pragma unroll
                for (int bj = 0; bj < 2; ++bj)
#pragma unroll
                    for (int n = 0; n < 2; ++n) *(f32x4*)(rowp + bj * HALF + n * 16) = acc[ai][bj][m][n]; }
    }
};
struct EpiExp1 {
    static constexpr bool PERM = true, AFTER_DRAIN = false;
    bf16_t* H;
    __device__ __forceinline__ void operator()(const f32x4 (&acc)[2][2][4][2], const Unit& u, int wr, int wc, int fr_, int fq_) const {
        int fr = fr_, fq = fq_; asm volatile("" : "+v"(fr), "+v"(fq));
        const int row0 = u.pm * BM + wr * 64 + fr, hc0 = (u.pn & 3) * 128 + wc * 32 + 8 * fq;
#pragma unroll
        for (int ai = 0; ai < 2; ++ai)
#pragma unroll
            for (int m = 0; m < 4; ++m) { unsigned char* rowp = (unsigned char*)H + (size_t)(row0 + ai * HALF + m * 16) * DE + hc0;
                const f32x4 a0 = acc[ai][0][m][0], a1 = acc[ai][0][m][1], b0 = acc[ai][1][m][0], b1 = acc[ai][1][m][1];
                u32x2 w; w.x = pk4_fp8(siluf_(a0[0]) * b0[0], siluf_(a0[1]) * b0[1], siluf_(a0[2]) * b0[2], siluf_(a0[3]) * b0[3]);
                w.y = pk4_fp8(siluf_(a1[0]) * b1[0], siluf_(a1[1]) * b1[1], siluf_(a1[2]) * b1[2], siluf_(a1[3]) * b1[3]);
                *(u32x2*)rowp = w; }
    }
};
struct EpiY8 {
    static constexpr bool PERM = true, AFTER_DRAIN = false;
    unsigned char* Y;
    __device__ __forceinline__ void operator()(const f32x4 (&acc)[2][2][4][2], const Unit& u, int wr, int wc, int fr_, int fq_) const {
        int fr = fr_, fq = fq_; asm volatile("" : "+v"(fr), "+v"(fq));
        const int row0 = u.pm * BM + wr * 64 + fr, col0 = (u.pn & 3) * BM + wc * 32 + 8 * fq;
#pragma unroll
        for (int ai = 0; ai < 2; ++ai)
#pragma unroll
            for (int m = 0; m < 4; ++m) { unsigned char* rowp = Y + (size_t)(row0 + ai * HALF + m * 16) * DM + col0;
#pragma unroll
                for (int bj = 0; bj < 2; ++bj) { const f32x4 v0 = acc[ai][bj][m][0], v1 = acc[ai][bj][m][1];
                    u32x2 w; w.x = pk4_fp8(v0[0], v0[1], v0[2], v0[3]); w.y = pk4_fp8(v1[0], v1[1], v1[2], v1[3]);
                    *(u32x2*)(rowp + bj * HALF) = w; } }
    }
};
struct EpiY {
    static constexpr bool PERM = true, AFTER_DRAIN = false;
    bf16_t* Y;
    __device__ __forceinline__ void operator()(const f32x4 (&acc)[2][2][4][2], const Unit& u, int wr, int wc, int fr_, int fq_) const {
        int fr = fr_, fq = fq_; asm volatile("" : "+v"(fr), "+v"(fq));
        const int row0 = u.pm * BM + wr * 64 + fr, col0 = (u.pn & 3) * BM + wc * 32 + 8 * fq;
#pragma unroll
        for (int ai = 0; ai < 2; ++ai)
#pragma unroll
            for (int m = 0; m < 4; ++m) { bf16_t* rowp = Y + (size_t)(row0 + ai * HALF + m * 16) * DM + col0;
#pragma unroll
                for (int bj = 0; bj < 2; ++bj) { const f32x4 v0 = acc[ai][bj][m][0], v1 = acc[ai][bj][m][1];
                    u32x4 w; w.x = cvt_pk_bf16(v0[0], v0[1]); w.y = cvt_pk_bf16(v0[2], v0[3]); w.z = cvt_pk_bf16(v1[0], v1[1]); w.w = cvt_pk_bf16(v1[2], v1[3]);
                    *(u32x4*)(rowp + bj * HALF) = w; } }
    }
};
struct InProjOrder {
    static constexpr bool GATHER = false; const int* rowtok = nullptr;
    StaticOrder lat; int G, c;
    __device__ __forceinline__ void init(int G_, int c_) { lat.init(T, NIN, G_, c_); G = G_; c = c_; }
    __device__ __forceinline__ bool next(int i, Unit& u) const {
        const int L = i * G + c;
        if (L < lat.nwg) return lat.next(i, u);
        const int r = L - lat.nwg; if (r >= 16 * 8) return false;
        const int ct = r & 7; u.pm = 256 + (r >> 3); u.pn = ct < 2 ? ct : (ct < 6 ? ct + 4 : ct + 4);
        return true;
    }
    __device__ __forceinline__ void a_ready(const Unit&) const {}
    __device__ __forceinline__ void done(const Unit&) const {}
};
template <bool GATHER_>
struct ExpertOrderT {
    static constexpr bool GATHER = GATHER_;
    const int* rbpre; const int* rowtok; int G, c;
    __device__ __forceinline__ bool next(int i, Unit& u) const {
        const int cs = (G & 7) == 0 ? (c & 7) * (G >> 3) + (c >> 3) : c;
        const int L = i * G + cs, rb = L >> 2; int ef = -1;
        for (int e = 0; e < NE; ++e) { if (rb >= rbpre[e] && rb < rbpre[e + 1]) ef = e; }
        if (ef < 0) return false;
        u.pm = rb; u.pn = ef * 4 + (L & 3); return true;
    }
    __device__ __forceinline__ void a_ready(const Unit&) const {}
    __device__ __forceinline__ void done(const Unit&) const {}
};
typedef ExpertOrderT<false> ExpertOrder;
typedef ExpertOrderT<true> ExpertOrderG;

template <class Epi, class Sched, bool ALIGN_EPI = false, bool SP2 = false, bool MX = false>
__device__ __forceinline__ void gemm_phase(PG8_LAS unsigned char* lds, const Gemm g, const Sched& S, const Epi& E) {
    int tid_o = threadIdx.x; asm volatile("" : "+v"(tid_o));
    const int tid = tid_o, wid = __builtin_amdgcn_readfirstlane(tid >> 6), lane = tid & 63, wr = wid >> 2, wc = wid & 3, fr = lane & 15, fq = lane >> 4;
    static_assert(SP2 || !Sched::GATHER, "the gathered A operand is wired into the SP2 loop only");
    const int K = g.K, nt = K / BK;
    unsigned voffA[2], voffB[2];
    unsigned gAc[2][2], gAn[2][2]; int gR[2], gC[2];
#pragma unroll
    for (int i = 0; i < 2; ++i) { int R, C; stage_rc(tid * 16 + i * 8192, R, C); const int Rb = Epi::PERM ? ((R & ~31) + perm32(R & 31)) : R;
        voffA[i] = (unsigned)(R * K + C) * 2u; voffB[i] = (unsigned)(Rb * K + C) * 2u; gR[i] = R; gC[i] = C; }
    const size_t kstep = (size_t)(BK * 2);
    const size_t hstep = (size_t)HALF * K * 2;
    const size_t tstep = 2 * hstep;
    const unsigned ldsw = (unsigned)wid * 1024u;
    const int aoff = lds_byte(wr * 64 + fr, fq * 8), boff = lds_byte(wc * 32 + fr, fq * 8);
#define PG8_SA(b, h) (((b) * 2 + (h)) * HTB)
#define PG8_SB(b, h) ((4 + (b) * 2 + (h)) * HTB)
#define PG8_STAGE(bufoff, gbase, voff) do { _Pragma("unroll") for (int _i = 0; _i < 2; ++_i) \
        __builtin_amdgcn_global_load_lds((const unsigned*)((const char*)(gbase) + (voff)[_i]), (PG8_LAS unsigned*)(lds + (bufoff) + ldsw + _i * 8192), 16, 0, 0); } while (0)
#define PG8_STAGE_A(bufoff, ptr, h, goff) do { if constexpr (Sched::GATHER) { PG8_STAGE(bufoff, ptr, (goff)[h]); } else { PG8_STAGE(bufoff, (ptr) + (h) * hstep, voffA); } } while (0)
#define PG8_GLOAD(dst, u) do { _Pragma("unroll") for (int _h = 0; _h < 2; ++_h) _Pragma("unroll") for (int _i = 0; _i < 2; ++_i) \
        dst[_h][_i] = (unsigned)S.rowtok[(u).pm * BM + _h * HALF + gR[_i]] * (unsigned)(K * 2) + (unsigned)(gC[_i] * 2); } while (0)
#define PG8_LDA(dst, b, h) do { _Pragma("unroll") for (int m = 0; m < 4; ++m) pg_ld(dst[m], lds + PG8_SA(b, h) + aoff + m * 2048); } while (0)
#define PG8_LDB(dst, b, h) do { _Pragma("unroll") for (int n = 0; n < 2; ++n) pg_ld(dst[n], lds + PG8_SB(b, h) + boff + n * 2048); } while (0)
#define PG8_MMA(ai, bj, At, Bt) do { __builtin_amdgcn_s_setprio(1); _Pragma("unroll") for (int m = 0; m < 4; ++m) _Pragma("unroll") for (int n = 0; n < 2; ++n) \
        acc[ai][bj][m][n] = pg_mma(Bt[n], At[m], acc[ai][bj][m][n]); __builtin_amdgcn_s_setprio(0); } while (0)
#define PG8_WAIT_V(n) asm volatile("s_waitcnt vmcnt(" #n ")" ::: "memory")
#define PG8_WAIT_L(n) asm volatile("s_waitcnt lgkmcnt(" #n ")" ::: "memory")
#define PG8_BAR __builtin_amdgcn_s_barrier()
#define PG8_SCHED __builtin_amdgcn_sched_barrier(0)
    Unit cur, nxt; int ui = 0;
    if (!S.next(0, cur)) return;
    f32x4 acc[2][2][4][2];
#pragma unroll
    for (int a = 0; a < 2; ++a)
#pragma unroll
        for (int b = 0; b < 2; ++b)
#pragma unroll
            for (int m = 0; m < 4; ++m)
#pragma unroll
                for (int n = 0; n < 2; ++n) acc[a][b][m][n] = (f32x4){0.f, 0.f, 0.f, 0.f};
    PgFrag<MX> At[4], B0[2], B1[2];
    const char* cA = (const char*)g.A + (Sched::GATHER ? (size_t)0 : (size_t)cur.pm * tstep); const char* cB = (const char*)g.Bt + (size_t)cur.pn * tstep;
    if constexpr (Sched::GATHER) { PG8_GLOAD(gAc, cur); }
    S.a_ready(cur);
    if constexpr (SP2) {
        PG8_STAGE(PG8_SB(0, 0), cB, voffB); PG8_STAGE(PG8_SB(0, 1), cB + hstep, voffB); PG8_STAGE_A(PG8_SA(0, 0), cA, 0, gAc); PG8_STAGE_A(PG8_SA(0, 1), cA, 1, gAc);
        if (wr == 1) PG8_BAR;
        PG8_WAIT_V(2); PG8_BAR;
        PG8_STAGE(PG8_SB(1, 0), cB + kstep, voffB); PG8_STAGE_A(PG8_SA(1, 0), cA + kstep, 0, gAc); PG8_STAGE(PG8_SB(1, 1), cB + hstep + kstep, voffB);
        PG8_WAIT_V(6); PG8_BAR;
    } else {
        PG8_STAGE(PG8_SB(0, 0), cB, voffB); PG8_STAGE(PG8_SA(0, 0), cA, voffA); PG8_STAGE(PG8_SB(0, 1), cB + hstep, voffB); PG8_STAGE(PG8_SA(0, 1), cA + hstep, voffA);
        if (wr == 1) PG8_BAR;
        PG8_WAIT_V(4); PG8_BAR;
        PG8_STAGE(PG8_SB(1, 0), cB + kstep, voffB); PG8_STAGE(PG8_SA(1, 0), cA + kstep, voffA); PG8_STAGE(PG8_SB(1, 1), cB + hstep + kstep, voffB);
        PG8_WAIT_V(6); PG8_BAR;
    }
    for (;;) {
        const bool has_next = S.next(ui + 1, nxt);
        const char* nA = (has_next && !Sched::GATHER) ? (const char*)g.A + (size_t)nxt.pm * tstep : cA;
        if constexpr (Sched::GATHER) { if (has_next) { PG8_GLOAD(gAn, nxt); } else { _Pragma("unroll") for (int _h = 0; _h < 2; ++_h) _Pragma("unroll") for (int _i = 0; _i < 2; ++_i) gAn[_h][_i] = gAc[_h][_i]; } }
        const char* nB = has_next ? (const char*)g.Bt + (size_t)nxt.pn * tstep : cB;
        for (int t = 0; t < nt; t += 2) {
            const bool last = (t == nt - 2);
            const char* a1 = cA + (size_t)(t + 1) * kstep;
            const char* a2 = last ? nA : cA + (size_t)(t + 2) * kstep; const char* b2 = last ? nB : cB + (size_t)(t + 2) * kstep;
            const char* a3 = a2 + kstep; const char* b3 = b2 + kstep;
            if (last && has_next) S.a_ready(nxt);
            unsigned g2[2][2];
            if constexpr (Sched::GATHER) { _Pragma("unroll") for (int _h = 0; _h < 2; ++_h) _Pragma("unroll") for (int _i = 0; _i < 2; ++_i) g2[_h][_i] = last ? gAn[_h][_i] : gAc[_h][_i]; }
            if constexpr (SP2) {
            PG8_LDB(B0, 0, 0); PG8_LDB(B1, 0, 1); PG8_SCHED; PG8_LDA(At, 0, 0); PG8_STAGE_A(PG8_SA(1, 1), a1, 1, gAc);
            PG8_WAIT_V(8); PG8_WAIT_L(0); PG8_BAR; PG8_MMA(0, 0, At, B0); PG8_MMA(0, 1, At, B1); PG8_BAR; PG8_SCHED;
            PG8_LDA(At, 0, 1); PG8_STAGE(PG8_SB(0, 0), b2, voffB); PG8_STAGE(PG8_SB(0, 1), b2 + hstep, voffB); PG8_STAGE_A(PG8_SA(0, 0), a2, 0, g2);
            PG8_WAIT_V(8); PG8_WAIT_L(0); PG8_BAR; PG8_MMA(1, 0, At, B0); PG8_MMA(1, 1, At, B1); PG8_BAR; PG8_SCHED;
            PG8_LDB(B0, 1, 0); PG8_LDB(B1, 1, 1); PG8_SCHED; PG8_LDA(At, 1, 0); PG8_STAGE_A(PG8_SA(0, 1), a2, 1, g2);
            PG8_WAIT_V(8); PG8_WAIT_L(0); PG8_BAR; PG8_MMA(0, 0, At, B0); PG8_MMA(0, 1, At, B1); PG8_BAR; PG8_SCHED;
            PG8_LDA(At, 1, 1); PG8_STAGE(PG8_SB(1, 0), b3, voffB); PG8_STAGE(PG8_SB(1, 1), b3 + hstep, voffB); PG8_STAGE_A(PG8_SA(1, 0), a3, 0, g2);
            PG8_WAIT_V(8); PG8_WAIT_L(0); PG8_BAR; PG8_MMA(1, 0, At, B0); PG8_MMA(1, 1, At, B1); PG8_BAR; PG8_SCHED;
            } else {
            PG8_LDB(B0, 0, 0); PG8_SCHED; PG8_LDA(At, 0, 0); PG8_STAGE(PG8_SA(1, 1), a1 + hstep, voffA);
            PG8_WAIT_L(8); PG8_BAR; PG8_WAIT_L(0); PG8_MMA(0, 0, At, B0); PG8_BAR; PG8_SCHED;
            PG8_LDB(B1, 0, 1); PG8_STAGE(PG8_SB(0, 0), b2, voffB);
            PG8_BAR; PG8_WAIT_L(0); PG8_MMA(0, 1, At, B1); PG8_BAR;
            PG8_LDA(At, 0, 1); PG8_STAGE(PG8_SA(0, 0), a2, voffA);
            PG8_BAR; PG8_WAIT_L(0); PG8_MMA(1, 0, At, B0); PG8_BAR; PG8_SCHED;
            PG8_STAGE(PG8_SB(0, 1), b2 + hstep, voffB);
            PG8_WAIT_V(6); PG8_BAR; PG8_MMA(1, 1, At, B1); PG8_BAR;
            PG8_LDB(B0, 1, 0); PG8_SCHED; PG8_LDA(At, 1, 0); PG8_STAGE(PG8_SA(0, 1), a2 + hstep, voffA);
            PG8_WAIT_L(8); PG8_BAR; PG8_WAIT_L(0); PG8_MMA(0, 0, At, B0); PG8_BAR; PG8_SCHED;
            PG8_LDB(B1, 1, 1); PG8_STAGE(PG8_SB(1, 0), b3, voffB);
            PG8_BAR; PG8_WAIT_L(0); PG8_MMA(0, 1, At, B1); PG8_BAR;
            PG8_LDA(At, 1, 1); PG8_STAGE(PG8_SA(1, 0), a3, voffA);
            PG8_BAR; PG8_WAIT_L(0); PG8_MMA(1, 0, At, B0); PG8_BAR; PG8_SCHED;
            PG8_STAGE(PG8_SB(1, 1), b3 + hstep, voffB);
            PG8_WAIT_V(6); PG8_BAR; PG8_MMA(1, 1, At, B1); PG8_BAR;
            }
        }
        if constexpr (ALIGN_EPI) { if (wr == 0) PG8_BAR; }
        if constexpr (MX) pg_mma_drain();
        if constexpr (!Epi::AFTER_DRAIN) { E(acc, cur, wr, wc, fr, fq); S.done(cur); }
        if (!has_next) break;
#pragma unroll
        for (int a = 0; a < 2; ++a)
#pragma unroll
            for (int b = 0; b < 2; ++b)
#pragma unroll
                for (int m = 0; m < 4; ++m)
#pragma unroll
                    for (int n = 0; n < 2; ++n) acc[a][b][m][n] = (f32x4){0.f, 0.f, 0.f, 0.f};
        cur = nxt; cA = nA; cB = nB; ++ui;
        if constexpr (Sched::GATHER) { _Pragma("unroll") for (int _h = 0; _h < 2; ++_h) _Pragma("unroll") for (int _i = 0; _i < 2; ++_i) gAc[_h][_i] = gAn[_h][_i]; }
        if constexpr (ALIGN_EPI) { if (wr == 1) PG8_BAR; }
    }
    PG8_WAIT_V(0);
    if constexpr (!ALIGN_EPI) { if (wr == 0) PG8_BAR; }
    PG8_BAR;
    if constexpr (Epi::AFTER_DRAIN) { E.fused(acc, cur, wr, wc, fr, fq, lds, wid, lane); S.done(cur); }
#undef PG8_SA
#undef PG8_SB
#undef PG8_STAGE
#undef PG8_STAGE_A
#undef PG8_GLOAD
#undef PG8_LDA
#undef PG8_LDB
#undef PG8_MMA
#undef PG8_WAIT_V
#undef PG8_WAIT_L
#undef PG8_BAR
#undef PG8_SCHED
}
}

struct Args { const float* in[26]; float* out; unsigned char* ws; };

__device__ __forceinline__ void p_mod(LAS unsigned char* lds, const float* __restrict__ c, const float* __restrict__ c_ctx, const float* __restrict__ ada_w,
                                      const float* __restrict__ ada_b, float* __restrict__ mod, int bid, int G, int tid) {
    if (bid >= 96) return;
    LAS float* s = (LAS float*)lds;
    LAS float* red = s + 17 * 1024;
    {
        static_assert(17 * 1024 == 34 * NTHREADS, "p_mod staging");
        float cv[34];
#pragma unroll
        for (int q = 0; q < 34; ++q) { const int i = tid + q * NTHREADS, r = i >> 10, k = i & 1023; cv[q] = r < NB ? c[r * DM + k] : c_ctx[k]; }
#pragma unroll
        for (int q = 0; q < 34; ++q) { const float v = cv[q]; s[tid + q * NTHREADS] = v / (1.0f + expf(-v)); }
    }
    __syncthreads();
    for (int it = bid; it < 96; it += G) {
        const int cc = tid & 63, kg = tid >> 6, col = it * 64 + cc;
        float acc[17];
#pragma unroll
        for (int r = 0; r < 17; ++r) acc[r] = 0.f;
#pragma unroll 1
        for (int k0 = kg * 128; k0 < kg * 128 + 128; k0 += 16) {
            float w[16];
#pragma unroll
            for (int j = 0; j < 16; ++j) w[j] = ntld(ada_w + (size_t)(k0 + j) * 6144 + col);
#pragma unroll
            for (int j = 0; j < 16; ++j)
#pragma unroll
                for (int r = 0; r < 17; ++r) acc[r] += s[r * 1024 + k0 + j] * w[j];
        }
#pragma unroll
        for (int r = 0; r < 17; ++r) red[(kg * 17 + r) * 64 + cc] = acc[r];
        __syncthreads();
        for (int i = tid; i < 17 * 64; i += NTHREADS) {
            const int r = i >> 6, c2 = i & 63; float sum = 0.f;
#pragma unroll
            for (int g = 0; g < 8; ++g) sum += red[(g * 17 + r) * 64 + c2];
            mod[(size_t)r * 6144 + it * 64 + c2] = sum + ada_b[it * 64 + c2];
        }
        __syncthreads();
    }
}

struct TrTile { const float* W; bf16_t* O; int K, N, mode, k0, n0; };
__device__ __forceinline__ TrTile tr_decode(const Args& a, int r) {
    unsigned char* ws = a.ws;
    constexpr int I_IN = 16 * 56, I_OUT = 16 * 16, I_E = 32 * 128;
    TrTile t;
    if (r < I_IN) { t = TrTile{a.in[6], (bf16_t*)(ws + WS_WINT), DM, NIN, 0, (r & 15) * 64, (r >> 4) * 64}; return t; } r -= I_IN;
    if (r < I_OUT) { t = TrTile{a.in[14], (bf16_t*)(ws + WS_WOUTT), DM, DM, 0, (r & 15) * 64, (r >> 4) * 64}; return t; } r -= I_OUT;
    if (r < I_E) { const int e = r >> 7, q = r & 127; t = TrTile{a.in[21] + (size_t)e * DM * DE, (bf16_t*)(ws + WS_W13T + (size_t)e * DM * DM), DM, DE, 1, (q & 15) * 64, (q >> 4) * 64}; return t; } r -= I_E;
    if (r < I_E) { const int e = r >> 7, q = r & 127; t = TrTile{a.in[22] + (size_t)e * DM * DE, (bf16_t*)(ws + WS_W13T + (size_t)e * DM * DM), DM, DE, 2, (q & 15) * 64, (q >> 4) * 64}; return t; } r -= I_E;
    { const int e = r >> 7, q = r & 127; t = TrTile{a.in[23] + (size_t)e * DE * DM, (bf16_t*)(ws + WS_W2T + (size_t)e * DM * DE), DE, DM, 3, (q & 7) * 64, (q >> 3) * 64}; return t; }
}
constexpr int TR_LATE = 512;
__device__ __forceinline__ void p_transposes(LAS unsigned char* lds, const Args& a, int bid, int G, int tid, int late = 0) {
    constexpr int NITEMS = (16 * 56 + 16 * 16 + 3 * 32 * 128) / 4;
    const int lrow = tid >> 4, lc4 = (tid & 15) * 4;
    const int sc = tid & 7, sn = tid >> 3;
    const bool bal = G == 256;
    int istart, iend, istep = 1;
    if (late == 2) { istart = NITEMS - TR_LATE + (bid - 128) * 4; iend = istart + 4; }
    else if (bal && late == 1) { istart = bid < 96 ? bid * 10 : 960 + (bid - 96) * 12; iend = min(istart + (bid < 96 ? 10 : 12), NITEMS - TR_LATE); }
    else if (bal) { istart = bid < 96 ? bid * 12 : 1152 + (bid - 96) * 14; iend = min(istart + (bid < 96 ? 12 : 14), NITEMS); }
    else { istart = bid; istep = G; iend = NITEMS; }
#pragma unroll 1
    for (int it = istart; it < iend; it += istep) {
        f32x4 v[4][2]; TrTile t[4];
#pragma unroll
        for (int q = 0; q < 4; ++q) { t[q] = tr_decode(a, it * 4 + q);
#pragma unroll
            for (int h = 0; h < 2; ++h) v[q][h] = ntld((const f32x4*)(t[q].W + (size_t)(t[q].k0 + lrow + 32 * h) * t[q].N + t[q].n0 + lc4)); }
        __syncthreads();
#pragma unroll
        for (int q = 0; q < 4; ++q) { LAS float* tile = (LAS float*)lds + q * (64 * 65);
#pragma unroll
            for (int h = 0; h < 2; ++h)
#pragma unroll
                for (int j = 0; j < 4; ++j) tile[(lrow + 32 * h) * 65 + lc4 + j] = v[q][h][j]; }
        __syncthreads();
#pragma unroll
        for (int q = 0; q < 4; ++q) { const LAS float* tile = (const LAS float*)lds + q * (64 * 65) + (8 * sc) * 65 + sn;
            const int n = t[q].n0 + sn, mode = t[q].mode;
            const int orow = (mode == 0 || mode == 3) ? n : ((n >> 7) * 256 + (mode == 2 ? 128 : 0) + (n & 127));
            if (mode == 0) {
                u32x4 w; w.x = pk2(tile[0 * 65], tile[1 * 65]); w.y = pk2(tile[2 * 65], tile[3 * 65]); w.z = pk2(tile[4 * 65], tile[5 * 65]); w.w = pk2(tile[6 * 65], tile[7 * 65]);
                *(u32x4*)(t[q].O + (size_t)orow * t[q].K + t[q].k0 + 8 * sc) = w;
            } else {
                u32x2 w; w.x = pk4_fp8(W13_SCALE * tile[0 * 65], W13_SCALE * tile[1 * 65], W13_SCALE * tile[2 * 65], W13_SCALE * tile[3 * 65]);
                w.y = pk4_fp8(W13_SCALE * tile[4 * 65], W13_SCALE * tile[5 * 65], W13_SCALE * tile[6 * 65], W13_SCALE * tile[7 * 65]);
                *(u32x2*)((unsigned char*)t[q].O + (size_t)orow * t[q].K + t[q].k0 + 8 * sc) = w; } }
    }
    __syncthreads();
}

__device__ __forceinline__ void p_u(const float* __restrict__ x, const float* __restrict__ ctx, const float* __restrict__ mod, bf16_t* __restrict__ U, int bid, int G, int tid) {
    const int lane = tid & 63, wave = tid >> 6;
    f32x4 vn[2][4];
    int row0 = bid * 16;
#pragma unroll
    for (int q = 0; q < 2; ++q) { const int row = row0 + wave * 2 + q; const float* src = row < T ? x + (size_t)row * DM : ctx + (size_t)(row - T) * DM;
#pragma unroll
        for (int j = 0; j < 4; ++j) vn[q][j] = ntld((const f32x4*)(src + 4 * lane + 256 * j)); }
#pragma unroll 1
    for (; row0 < TA; row0 += G * 16) {
        f32x4 v[2][4];
#pragma unroll
        for (int q = 0; q < 2; ++q)
#pragma unroll
            for (int j = 0; j < 4; ++j) v[q][j] = vn[q][j];
        if (row0 + G * 16 < TA) {
#pragma unroll
            for (int q = 0; q < 2; ++q) { const int row = row0 + G * 16 + wave * 2 + q; const float* src = row < T ? x + (size_t)row * DM : ctx + (size_t)(row - T) * DM;
#pragma unroll
                for (int j = 0; j < 4; ++j) vn[q][j] = ntld((const f32x4*)(src + 4 * lane + 256 * j)); }
        }
        const float* m = mod + (size_t)(row0 < T ? row0 / SEQ : 16) * 6144;
#pragma unroll
        for (int j = 0; j < 4; ++j) { const int c4 = 4 * lane + 256 * j;
            const f32x4 sh = *(const f32x4*)(m + c4), sc = 1.0f + *(const f32x4*)(m + 1024 + c4);
#pragma unroll
            for (int q = 0; q < 2; ++q) { const int row = row0 + wave * 2 + q;
                const f32x4 u = v[q][j] * sc + sh;
                u32x2 w; w.x = pk2(u[0], u[1]); w.y = pk2(u[2], u[3]);
                *(u32x2*)(U + (size_t)row * DM + c4) = w; } }
    }
}

constexpr size_t WS_H1 = WS_XG + 128 * MiB;
constexpr size_t WS_WRT = 878 * MiB;
constexpr size_t WS_WRT2 = 995 * MiB;
constexpr size_t WS_RBIAS = 998 * MiB;
__device__ __forceinline__ float router_w(const float* __restrict__ rgw, const float* __restrict__ rew, int e, int k) { return e < 4 ? rgw[k * 4 + e] : (e < 36 ? rew[k * 32 + (e - 4)] : 0.f); }
__device__ __forceinline__ void p_wrt(const Args& a, int bid, int G, int tid) {
    const float* __restrict__ rgw = a.in[17]; const float* __restrict__ rew = a.in[19]; const float* mod = (const float*)(a.ws + WS_MOD);
    bf16_t* wrt = (bf16_t*)(a.ws + WS_WRT2); float* rb = (float*)(a.ws + WS_RBIAS);
#pragma unroll 6
    for (int o = bid * NTHREADS + tid; o < NB * 48 * 1024; o += G * NTHREADS) { const int b = o / (48 * 1024), r = o - b * (48 * 1024), e = r >> 10, k = r & 1023;
        const float w = router_w(rgw, rew, e, k) * (1.0f + mod[(size_t)b * 6144 + 4096 + k]);
        const bf16_t hi = f2bf(w); wrt[(size_t)b * (96 * 1024) + r] = hi; wrt[(size_t)b * (96 * 1024) + 48 * 1024 + r] = f2bf(w - bf2f(hi)); }
    const int wave = tid >> 6, lane = tid & 63;
    for (int i = bid * 8 + wave; i < NB * 48; i += G * 8) { const int b = i / 48, e = i - b * 48;
        float s = 0.f;
        if (e < 36) {
#pragma unroll
            for (int kk = 0; kk < 16; ++kk) { const int k = lane + 64 * kk; s += mod[(size_t)b * 6144 + 3072 + k] * router_w(rgw, rew, e, k); } }
        s = wave_sum(s);
        if (lane == 0) rb[i] = e < 36 ? s + (e < 4 ? a.in[18][e] : a.in[20][e - 4]) : 0.f; }
}
__device__ __forceinline__ void p_ln1_router(LAS unsigned char* lds, const Args& a, int bid, int G, int tid, int wave, int lane, bool dry = false, int parts = 3) {
    const float* __restrict__ x = a.in[0]; const bf16_t* yb = (const bf16_t*)(a.ws + WS_XG); bf16_t* h1o = (bf16_t*)(a.ws + (dry ? WS_HID : WS_H1)); const float* mod = (const float*)(a.ws + WS_MOD);
    const float* __restrict__ ln_g = a.in[15]; const float* __restrict__ ln_b = a.in[16]; const float* __restrict__ rgb = a.in[18]; const float* __restrict__ reb = a.in[20];
    bf16_t* U2 = (bf16_t*)(a.ws + (dry ? WS_Y + 16 * MiB : WS_U)); int* counts = (int*)(a.ws + WS_CTL) + (dry ? 32 * CSTR : 0);
    int2* eidx = (int2*)(a.ws + (dry ? WS_Y : WS_EIDX)); int2* epos = (int2*)(a.ws + (dry ? WS_Y + 4 * MiB : WS_EPOS)); float2* ew = (float2*)(a.ws + (dry ? WS_Y + 8 * MiB : WS_EW));
    const bf16_t* __restrict__ wrt0 = (const bf16_t*)(a.ws + WS_WRT2); const float* __restrict__ rbias0 = (const float*)(a.ws + WS_RBIAS); unsigned char* U2q = a.ws + (dry ? WS_Y + 32 * MiB : WS_U2Q);
    constexpr int WB_STRIDE = 528;
    LAS unsigned char* WB = lds;
    LAS float* LG = (LAS float*)(lds + 51200);
    LAS int* lcnt = (LAS int*)(lds + 102400);
    LAS int* lbase = lcnt + 32;
    LAS i32x4* tinfo = (LAS i32x4*)(lbase + 32);
    LAS f32x2* tw = (LAS f32x2*)(tinfo + 256);
    if (tid < 32) lcnt[tid] = 0;
    for (int blk = bid; blk < T / 256; blk += G) {
        const int tokb = blk * 256;
        const float* m = mod + (size_t)(tokb / SEQ) * 6144;
        const bf16_t* __restrict__ wrt = wrt0 + (size_t)(tokb / SEQ) * (96 * 1024); const float* __restrict__ rbias = rbias0 + (tokb / SEQ) * 48;
        if (parts & 1) {
            f32x4 xr[2][4]; u32x2 yr[2][4];
            f32x4 g1v[4], lgv[4], lbv[4], sc2v[4], sh2v[4];
#pragma unroll
            for (int j = 0; j < 4; ++j) { const int c4 = 4 * lane + 256 * j;
                g1v[j] = *(const f32x4*)(m + 2048 + c4); lgv[j] = *(const f32x4*)(ln_g + c4); lbv[j] = *(const f32x4*)(ln_b + c4); sc2v[j] = 1.0f + *(const f32x4*)(m + 4096 + c4); sh2v[j] = *(const f32x4*)(m + 3072 + c4); }
#pragma unroll
            for (int t = 0; t < 2; ++t)
#pragma unroll
                for (int j = 0; j < 4; ++j) { const int c4 = 4 * lane + 256 * j; const int tok = tokb + wave * 32 + t;
                    xr[t][j] = ntld((const f32x4*)(x + (size_t)tok * DM + c4)); yr[t][j] = ntld((const u32x2*)(yb + (size_t)tok * DM + c4)); }
#pragma unroll 1
            for (int it = 0; it < 16; ++it) {
                int l2 = lane; asm volatile("" : "+v"(l2)); const int lane = l2;
                const int tok0 = tokb + wave * 32 + 2 * it;
                f32x4 v[2][4]; float s[2] = {0.f, 0.f};
#pragma unroll
                for (int t = 0; t < 2; ++t)
#pragma unroll
                    for (int j = 0; j < 4; ++j) { const int c4 = 4 * lane + 256 * j;
                        const f32x4 g1 = g1v[j]; const u32x2 yw = yr[t][j];
                        const f32x4 yv = (f32x4){__uint_as_float(yw.x << 16), __uint_as_float(yw.x & 0xffff0000u), __uint_as_float(yw.y << 16), __uint_as_float(yw.y & 0xffff0000u)};
                        v[t][j] = ALPHA * xr[t][j] + g1 * yv; s[t] += (v[t][j][0] + v[t][j][1]) + (v[t][j][2] + v[t][j][3]); }
                if (it < 15) {
#pragma unroll
                    for (int t = 0; t < 2; ++t)
#pragma unroll
                        for (int j = 0; j < 4; ++j) { const int c4 = 4 * lane + 256 * j; const int tok = tok0 + 2 + t;
                            xr[t][j] = ntld((const f32x4*)(x + (size_t)tok * DM + c4)); yr[t][j] = ntld((const u32x2*)(yb + (size_t)tok * DM + c4)); }
                }
                float rstd[2];
#pragma unroll
                for (int t = 0; t < 2; ++t) { const float mean = wave_sum(s[t]) * (1.0f / DM); float s2 = 0.f;
#pragma unroll
                    for (int j = 0; j < 4; ++j) { v[t][j] = v[t][j] - mean; s2 += (v[t][j][0] * v[t][j][0] + v[t][j][1] * v[t][j][1]) + (v[t][j][2] * v[t][j][2] + v[t][j][3] * v[t][j][3]); }
                    rstd[t] = rsqrtf(wave_sum(s2) * (1.0f / DM) + LN_EPS); }
#pragma unroll
                for (int j = 0; j < 4; ++j) { const int c4 = 4 * lane + 256 * j;
                    const f32x4 lg = lgv[j], lb = lbv[j], sc2p = sc2v[j], sh2 = sh2v[j];
#pragma unroll
                    for (int t = 0; t < 2; ++t) { const f32x4 h1 = v[t][j] * rstd[t] * lg + lb;
                        u32x2 hw; hw.x = pk2(h1[0], h1[1]); hw.y = pk2(h1[2], h1[3]);
                        *(u32x2*)(h1o + (size_t)(tok0 + t) * DM + c4) = hw;
                        const f32x4 u2 = h1 * sc2p + sh2;
                        ntst((unsigned*)(U2q + (size_t)(tok0 + t) * DM + c4), pk4_fp8(u2[0], u2[1], u2[2], u2[3])); }
                }
            }
        }
        __syncthreads();
        __builtin_amdgcn_fence(__ATOMIC_ACQUIRE, "agent");
        asm volatile("s_waitcnt vmcnt(0)" ::: "memory");
        const int fr = lane & 15, fq = lane >> 4;
        if (parts & 2) {
            f32x4 acc[2][3];
#pragma unroll
            for (int gi = 0; gi < 2; ++gi)
#pragma unroll
                for (int nt = 0; nt < 3; ++nt) acc[gi][nt] = (f32x4){0.f, 0.f, 0.f, 0.f};
            const bf16_t* arow0 = h1o + (size_t)(tokb + (wave * 2 + 0) * 16 + fr) * DM + fq * 8;
            const bf16_t* arow1 = arow0 + (size_t)16 * DM;
            u32x4 wreg[6];
#pragma unroll
            for (int p = 0; p < 6; ++p) { const int idx = p * NTHREADS + tid, row = idx >> 5, piece = idx & 31;
                wreg[p] = *(const u32x4*)(wrt + (size_t)row * 1024 + piece * 8); }
#pragma unroll 1
            for (int ch = 0; ch < 4; ++ch) {
                asm volatile("s_waitcnt lgkmcnt(0)" ::: "memory"); __builtin_amdgcn_s_barrier(); asm volatile("" ::: "memory");
#pragma unroll
                for (int p = 0; p < 6; ++p) { const int idx = p * NTHREADS + tid, row = idx >> 5, piece = idx & 31;
                    *(LAS u32x4*)(WB + row * WB_STRIDE + piece * 16) = wreg[p]; }
                if (ch < 3) {
#pragma unroll
                    for (int p = 0; p < 6; ++p) { const int idx = p * NTHREADS + tid, row = idx >> 5, piece = idx & 31;
                        wreg[p] = *(const u32x4*)(wrt + (size_t)row * 1024 + (ch + 1) * 256 + piece * 8); }
                }
                asm volatile("s_waitcnt lgkmcnt(0)" ::: "memory"); __builtin_amdgcn_s_barrier(); asm volatile("" ::: "memory");
#pragma unroll 2
                for (int ks = 0; ks < 8; ++ks) {
                    const bf16x8 af0 = *(const bf16x8*)(arow0 + ch * 256 + ks * 32), af1 = *(const bf16x8*)(arow1 + ch * 256 + ks * 32);
#pragma unroll
                    for (int nt = 0; nt < 3; ++nt) {
                        const bf16x8 bh = *(const LAS bf16x8*)(WB + (nt * 16 + fr) * WB_STRIDE + (ks * 32 + fq * 8) * 2), bl = *(const LAS bf16x8*)(WB + (48 + nt * 16 + fr) * WB_STRIDE + (ks * 32 + fq * 8) * 2);
                        acc[0][nt] = __builtin_amdgcn_mfma_f32_16x16x32_bf16(af0, bh, acc[0][nt], 0, 0, 0);
                        acc[1][nt] = __builtin_amdgcn_mfma_f32_16x16x32_bf16(af1, bh, acc[1][nt], 0, 0, 0);
                        acc[0][nt] = __builtin_amdgcn_mfma_f32_16x16x32_bf16(af0, bl, acc[0][nt], 0, 0, 0);
                        acc[1][nt] = __builtin_amdgcn_mfma_f32_16x16x32_bf16(af1, bl, acc[1][nt], 0, 0, 0);
                    }
                }
            }
            LAS float* lg = LG + wave * (2 * 16 * 48);
#pragma unroll
            for (int gi = 0; gi < 2; ++gi)
#pragma unroll
                for (int nt = 0; nt < 3; ++nt)
#pragma unroll
                    for (int j = 0; j < 4; ++j) lg[(gi * 16 + 4 * fq + j) * 48 + 16 * nt + fr] = acc[gi][nt][j];
            asm volatile("s_waitcnt lgkmcnt(0)" ::: "memory");
            if (lane < 32) {
                float pl[36];
#pragma unroll
                for (int e4 = 0; e4 < 9; ++e4) { const f32x4 q = *(const LAS f32x4*)(lg + lane * 48 + 4 * e4);
#pragma unroll
                    for (int r = 0; r < 4; ++r) pl[4 * e4 + r] = q[r]; }
#pragma unroll
                for (int e = 0; e < 36; ++e) pl[e] += rbias[e];
                int gsel = 0; float gm = pl[0];
#pragma unroll
                for (int g = 1; g < 4; ++g) if (pl[g] > gm) { gm = pl[g]; gsel = g; }
                float den = 0.f;
#pragma unroll
                for (int g = 0; g < 4; ++g) den += __expf(pl[g] - gm);
                const float gval = frcp(den);
                int j0 = -1; float v0 = -3.0e38f;
#pragma unroll
                for (int j = 0; j < 32; ++j) { const bool in = (j >> 3) == gsel; if (in && (j0 < 0 || pl[4 + j] > v0)) { v0 = pl[4 + j]; j0 = j; } }
                int j1 = -1; float v1 = -3.0e38f;
#pragma unroll
                for (int j = 0; j < 32; ++j) { const bool in = (j >> 3) == gsel; if (in && j != j0 && (j1 < 0 || pl[4 + j] > v1)) { v1 = pl[4 + j]; j1 = j; } }
                const float tt = __expf(v1 - v0), w0 = frcp(1.0f + tt), w1 = tt * w0;
                const int p0 = __hip_atomic_fetch_add(lcnt + j0, 1, __ATOMIC_RELAXED, __HIP_MEMORY_SCOPE_WORKGROUP), p1 = __hip_atomic_fetch_add(lcnt + j1, 1, __ATOMIC_RELAXED, __HIP_MEMORY_SCOPE_WORKGROUP);
                const int slot = wave * 32 + lane;
                tinfo[slot] = (i32x4){j0, j1, p0, p1}; tw[slot] = (f32x2){gval * w0, gval * w1};
            }
        }
        __syncthreads();
        if (tid < 32) lbase[tid] = atomicAdd(&counts[tid * CSTR], lcnt[tid]);
        __syncthreads();
        if (tid < 256) {
            const int tok = tokb + tid; const i32x4 ti = tinfo[tid]; const f32x2 wv = tw[tid];
            eidx[tok] = make_int2(ti[0], ti[1]); epos[tok] = make_int2(lbase[ti[0]] + ti[2], lbase[ti[1]] + ti[3]); ew[tok] = make_float2(wv[0], wv[1]);
        }
        if (tid < 32) lcnt[tid] = 0;
        __syncthreads();
    }
}

constexpr size_t WS_ROWTOK = 5 * MiB;
constexpr size_t WS_RBPRE = 2 * MiB;
__device__ __forceinline__ void p_assign(LAS unsigned char* lds, const Args& a, int bid, int G, int tid) {
    const int* counts = (const int*)(a.ws + WS_CTL);
    const int2* eidx = (const int2*)(a.ws + WS_EIDX); const int2* epos = (const int2*)(a.ws + WS_EPOS); int2* dest = (int2*)(a.ws + WS_DEST); int* rowtok = (int*)(a.ws + WS_ROWTOK);
    LAS int* ps = (LAS int*)lds;
    if (tid < 64) {
        int* rbpre = (int*)(a.ws + WS_RBPRE);
        const int cnt = tid < NE ? counts[tid * CSTR] : 0, pad = ((cnt + 255) >> 8) << 8;
        int inc = pad;
#pragma unroll
        for (int d = 1; d < 32; d <<= 1) { const int o = __shfl_up(inc, d); if (tid >= d) inc += o; }
        if (tid < NE) { ps[tid] = inc - pad; ps[32 + tid] = cnt; if (bid == 0) rbpre[tid] = (inc - pad) >> 8; }
        if (tid == NE - 1 && bid == 0) rbpre[NE] = inc >> 8;
    }
    __syncthreads();
    for (int tok = bid * NTHREADS + tid; tok < T; tok += G * NTHREADS) {
        const int2 ei = eidx[tok], ep = epos[tok];
        const int d0 = ps[ei.x] + ep.x, d1 = ps[ei.y] + ep.y;
        rowtok[d0] = tok; rowtok[d1] = tok; dest[tok] = make_int2(d0, d1);
    }
    for (int i = bid * NTHREADS + tid; i < NE * 256; i += G * NTHREADS) {
        const int e = i >> 8, r = i & 255, c = ps[32 + e];
        if (c + r < (((c + 255) >> 8) << 8)) rowtok[ps[e] + c + r] = 0;
    }
    __syncthreads();
}

__device__ __forceinline__ void p_combine_ln2(const Args& a, int bid, int G, int wave, int lane, bool dry = false) {
    const bf16_t* h1b = (const bf16_t*)(a.ws + WS_H1); float* outw = dry ? (float*)(a.ws + WS_HID) : a.out; const unsigned char* Y = a.ws + WS_Y;        const int2* dest = (const int2*)(a.ws + WS_DEST); const float2* ew = (const float2*)(a.ws + WS_EW);
    const float* mod = (const float*)(a.ws + WS_MOD); const float* __restrict__ ln_g = a.in[24]; const float* __restrict__ ln_b = a.in[25];
    int pr = bid * 8 + wave;
    f32x4 lgv[4], lbv[4];
#pragma unroll
    for (int j = 0; j < 4; ++j) { lgv[j] = *(const f32x4*)(ln_g + 4 * lane + 256 * j); lbv[j] = *(const f32x4*)(ln_b + 4 * lane + 256 * j); }
    int2 dn[2]; float2 wn[2];
#pragma unroll
    for (int t = 0; t < 2; ++t) { dn[t] = dest[2 * pr + t]; wn[t] = ew[2 * pr + t]; }
#pragma unroll 1
    for (; pr < T / 2; pr += G * 8) {
        int l2 = lane; asm volatile("" : "+v"(l2)); const int lane = l2;
        const int tok0 = 2 * pr;
        const float* m = mod + (size_t)(tok0 / SEQ) * 6144;
        int2 d[2]; float2 w[2];
#pragma unroll
        for (int t = 0; t < 2; ++t) { d[t] = dn[t]; w[t] = wn[t]; }
        f32x4 v[2][4]; float s[2] = {0.f, 0.f};
#pragma unroll
        for (int t = 0; t < 2; ++t)
#pragma unroll
            for (int j = 0; j < 4; ++j) { const int c4 = 4 * lane + 256 * j;
                const unsigned ya = ntld((const unsigned*)(Y + (size_t)d[t].x * DM + c4)), yb = ntld((const unsigned*)(Y + (size_t)d[t].y * DM + c4));
                const u32x2 hw = ntld((const u32x2*)(h1b + (size_t)(tok0 + t) * DM + c4)); const f32x4 g2 = *(const f32x4*)(m + 5120 + c4);
                const f32x2 a01 = __builtin_amdgcn_cvt_pk_f32_fp8((int)ya, false), a23 = __builtin_amdgcn_cvt_pk_f32_fp8((int)ya, true), b01 = __builtin_amdgcn_cvt_pk_f32_fp8((int)yb, false), b23 = __builtin_amdgcn_cvt_pk_f32_fp8((int)yb, true);
                f32x4 f;
                f[0] = w[t].x * a01[0] + w[t].y * b01[0]; f[1] = w[t].x * a01[1] + w[t].y * b01[1];
                f[2] = w[t].x * a23[0] + w[t].y * b23[0]; f[3] = w[t].x * a23[1] + w[t].y * b23[1];
                const f32x4 h1 = (f32x4){__uint_as_float(hw.x << 16), __uint_as_float(hw.x & 0xffff0000u), __uint_as_float(hw.y << 16), __uint_as_float(hw.y & 0xffff0000u)};
                v[t][j] = ALPHA * h1 + g2 * f; s[t] += (v[t][j][0] + v[t][j][1]) + (v[t][j][2] + v[t][j][3]); }
        { const int pn = pr + G * 8; if (pn < T / 2) {
#pragma unroll
            for (int t = 0; t < 2; ++t) { dn[t] = dest[2 * pn + t]; wn[t] = ew[2 * pn + t]; } } }
#pragma unroll
        for (int t = 0; t < 2; ++t) { const float mean = wave_sum(s[t]) * (1.0f / DM); float s2 = 0.f;
#pragma unroll
            for (int j = 0; j < 4; ++j) { v[t][j] = v[t][j] - mean; s2 += (v[t][j][0] * v[t][j][0] + v[t][j][1] * v[t][j][1]) + (v[t][j][2] * v[t][j][2] + v[t][j][3] * v[t][j][3]); }
            const float rstd = rsqrtf(wave_sum(s2) * (1.0f / DM) + LN_EPS);
#pragma unroll
            for (int j = 0; j < 4; ++j) { const int c4 = 4 * lane + 256 * j;
                ntst((f32x4*)(outw + (size_t)(tok0 + t) * DM + c4), (f32x4)(v[t][j] * rstd * lgv[j] + lbv[j])); } }
    }
}

constexpr size_t WS_HGK = WS_U;
constexpr size_t WS_HGD = 852 * MiB;
constexpr size_t WS_RGAGG = 854 * MiB;
constexpr size_t WS_RGCARRY = 864 * MiB;
constexpr size_t WS_GWT = 870 * MiB;
constexpr size_t WS_OFST = 880 * MiB;
constexpr int RG_UNITS_PER_B = 68, HG_SEGS = 17;

__device__ __forceinline__ void lds_barrier() { asm volatile("s_waitcnt lgkmcnt(0)" ::: "memory"); __builtin_amdgcn_s_barrier(); asm volatile("" ::: "memory"); }
__device__ __forceinline__ bf16x8 mk_bf16x8(u32x4 v) { return __builtin_bit_cast(bf16x8, v); }
__device__ __forceinline__ float bf_lo(unsigned w) { return __uint_as_float(w << 16); }
__device__ __forceinline__ float bf_hi(unsigned w) { return __uint_as_float(w & 0xffff0000u); }
__device__ __forceinline__ unsigned cvt2(float lo, float hi) { unsigned r; asm volatile("v_cvt_pk_bf16_f32 %0, %1, %2" : "=v"(r) : "v"(lo), "v"(hi)); return r; }

__device__ __forceinline__ void p_gwt(const float* __restrict__ gate_w, bf16_t* __restrict__ gwt, int bid, int G, int tid) {
    for (int o = bid * NTHREADS + tid; o < 32 * 4096; o += G * NTHREADS) { const int mat = o >> 12, d = (o >> 6) & 63, c = o & 63; gwt[o] = f2bf(gate_w[mat * 4096 + c * 64 + d]); }
}

constexpr int XC_STRIDE = 1040;
constexpr int RG_XC = 0, RG_OUT = 64 * XC_STRIDE;
constexpr size_t WS_RGPAR = 876 * MiB;

__device__ __forceinline__ void p_rgpar(const float* __restrict__ gate_b, const float* __restrict__ lam, float* __restrict__ par, int bid, int G, int tid) {
    for (int o = bid * NTHREADS + tid; o < 2 * 512; o += G * NTHREADS) { const int dir = o >> 9, ch = o & 511;
        par[(dir * 3 + 0) * 512 + ch] = gate_b[(dir * 2 + 0) * 512 + ch]; par[(dir * 3 + 1) * 512 + ch] = gate_b[(dir * 2 + 1) * 512 + ch]; par[(dir * 3 + 2) * 512 + ch] = softplusf_(-lam[dir * 512 + ch]); }
}

template <int DIR, bool OUT>
__device__ __forceinline__ void rg_scan64(const float (&av)[4][4], const float (&uv)[4][4], float& carry, float& atot, float (&hsum)[4][4], int fr, int fq) {
#pragma unroll
    for (int mm = 0; mm < 4; ++mm) {
        const int m = DIR == 0 ? mm : 3 - mm;
        float P, H;
        if (DIR == 0) { P = av[m][0]; H = uv[m][0];
#pragma unroll
            for (int j = 1; j < 4; ++j) { H = av[m][j] * H + uv[m][j]; P *= av[m][j]; } }
        else { P = av[m][3]; H = uv[m][3];
#pragma unroll
            for (int j = 2; j >= 0; --j) { H = av[m][j] * H + uv[m][j]; P *= av[m][j]; } }
        float Pn, Hn, Pe, He, Pt, Ht;
        if (DIR == 0) {
            Pn = __shfl_up(P, 16); Hn = __shfl_up(H, 16); if (fq >= 1) { H = P * Hn + H; P = P * Pn; }
            Pn = __shfl_up(P, 32); Hn = __shfl_up(H, 32); if (fq >= 2) { H = P * Hn + H; P = P * Pn; }
            Pe = __shfl_up(P, 16); He = __shfl_up(H, 16); if (fq == 0) { Pe = 1.f; He = 0.f; }
            Pt = __shfl(P, fr + 48); Ht = __shfl(H, fr + 48);
        } else {
            Pn = __shfl_down(P, 16); Hn = __shfl_down(H, 16); if (fq <= 2) { H = P * Hn + H; P = P * Pn; }
            Pn = __shfl_down(P, 32); Hn = __shfl_down(H, 32); if (fq <= 1) { H = P * Hn + H; P = P * Pn; }
            Pe = __shfl_down(P, 16); He = __shfl_down(H, 16); if (fq == 3) { Pe = 1.f; He = 0.f; }
            Pt = __shfl(P, fr); Ht = __shfl(H, fr);
        }
        if (OUT) {
            float hp = Pe * carry + He;
            if (DIR == 0) {
#pragma unroll
                for (int j = 0; j < 4; ++j) { hp = av[m][j] * hp + uv[m][j]; hsum[m][j] = hp; }
            } else {
#pragma unroll
                for (int j = 3; j >= 0; --j) { hp = av[m][j] * hp + uv[m][j]; hsum[m][j] += hp; }
            }
        }
        carry = Pt * carry + Ht; atot *= Pt;
    }
}

__device__ __forceinline__ void rg_load_raw(u32x4 (&raw)[11], const bf16_t* __restrict__ proj, int b, int k, int tid) {
    int rowbase, p0, lo, hi;
    if (k < 4) { rowbase = T + b * LC; p0 = k * 64; lo = 0; hi = LC; } else { rowbase = b * SEQ; p0 = (k - 4) * 64; lo = p0; hi = p0 + 64; }
    const int c0 = (tid & 63) * 8, i0 = (tid >> 6) * 8;
#pragma unroll
    for (int r = 0; r < 11; ++r) { const int p = p0 + i0 - 1 + r;
        raw[r] = (p >= lo && p < hi) ? *(const u32x4*)proj_at(proj, rowbase + p, c0) : (u32x4){0u, 0u, 0u, 0u}; }
}
__device__ __forceinline__ void rg_agg_unit(LAS unsigned char* lds, const Args& a, int b, int k, u32x4 (&raw)[11], int bn, int kn, int tid, int wave, int lane, int xr = 0) {
    const bf16_t* __restrict__ proj = (const bf16_t*)(a.ws + WS_PROJ);
    const float* __restrict__ conv_w = a.in[7]; const float* __restrict__ conv_b = a.in[8];
    const bf16_t* __restrict__ gwt = (const bf16_t*)(a.ws + WS_GWT); const float* __restrict__ par = (const float*)(a.ws + WS_RGPAR);
    float* rgagg = (float*)(a.ws + WS_RGAGG);
    int rowbase, p0, lo, hi;
    if (k < 4) { rowbase = T + b * LC; p0 = k * 64; lo = 0; hi = LC; } else { rowbase = b * SEQ; p0 = (k - 4) * 64; lo = p0; hi = p0 + 64; }
    const int unit = b * RG_UNITS_PER_B + k;
    const int n = wave, fr = lane & 15, fq = lane >> 4;
    float pgr[4][2], pgi[4][2], psp[4][2];
#pragma unroll
    for (int nt = 0; nt < 4; ++nt)
#pragma unroll
        for (int dir = 0; dir < 2; ++dir) { const int ch = n * 64 + nt * 16 + fr;
            pgr[nt][dir] = par[(dir * 3 + 0) * 512 + ch]; pgi[nt][dir] = par[(dir * 3 + 1) * 512 + ch]; psp[nt][dir] = par[(dir * 3 + 2) * 512 + ch]; }
    if (!(xr & 1)) {
        const int cgp = tid & 63, tg = tid >> 6, c0 = cgp * 8, i0 = tg * 8;
        float cw[4][8], cb[8];
#pragma unroll
        for (int t4 = 0; t4 < 4; ++t4) { const f32x4 w0 = *(const f32x4*)(conv_w + t4 * 512 + c0), w1 = *(const f32x4*)(conv_w + t4 * 512 + c0 + 4);
#pragma unroll
            for (int q = 0; q < 4; ++q) { cw[t4][q] = w0[q]; cw[t4][4 + q] = w1[q]; } }
        { const f32x4 b0 = *(const f32x4*)(conv_b + c0), b1 = *(const f32x4*)(conv_b + c0 + 4);
#pragma unroll
            for (int q = 0; q < 4; ++q) { cb[q] = b0[q]; cb[4 + q] = b1[q]; } }
#pragma unroll
        for (int ii = 0; ii < 8; ++ii) {
            float xc[8];
#pragma unroll
            for (int c = 0; c < 8; ++c) xc[c] = cb[c];
#pragma unroll
            for (int t4 = 0; t4 < 4; ++t4) { const u32x4 rw = raw[ii + t4];
#pragma unroll
                for (int q = 0; q < 4; ++q) { xc[2 * q] += cw[t4][2 * q] * bf_lo(rw[q]); xc[2 * q + 1] += cw[t4][2 * q + 1] * bf_hi(rw[q]); } }
            u32x4 w; w.x = cvt2(xc[0], xc[1]); w.y = cvt2(xc[2], xc[3]); w.z = cvt2(xc[4], xc[5]); w.w = cvt2(xc[6], xc[7]);
            *(LAS u32x4*)(lds + RG_XC + (i0 + ii) * XC_STRIDE + c0 * 2) = w;
        }
    }
    if (kn >= 0) rg_load_raw(raw, proj, bn, kn, tid);
    lds_barrier();
    {
        bf16x8 afr[4][2];
#pragma unroll
        for (int m = 0; m < 4; ++m)
#pragma unroll
            for (int ks = 0; ks < 2; ++ks) afr[m][ks] = *(const LAS bf16x8*)(lds + RG_XC + (16 * m + fr) * XC_STRIDE + (n * 64 + ks * 32 + fq * 8) * 2);
        u32x4* stash = (k >= 4) ? (u32x4*)a.out + ((size_t)(b * 64 + (k - 4)) * 16384 + (size_t)wave * 2048 + lane) : nullptr;
        bf16x8 wfr[2][2][2];
#pragma unroll
        for (int dir = 0; dir < 2; ++dir)
#pragma unroll
            for (int g = 0; g < 2; ++g)
#pragma unroll
                for (int ks = 0; ks < 2; ++ks) wfr[dir][g][ks] = *(const bf16x8*)(gwt + ((size_t)(((dir * 2 + g) * 8 + n) * 64 + fr)) * 64 + ks * 32 + fq * 8);
#pragma unroll
        for (int nt = 0; nt < 4; ++nt) {
            const int ch = n * 64 + nt * 16 + fr;
            bf16x8 wnx[2][2][2];
            if (nt < 3) {
#pragma unroll
                for (int dir = 0; dir < 2; ++dir)
#pragma unroll
                    for (int g = 0; g < 2; ++g)
#pragma unroll
                        for (int ks = 0; ks < 2; ++ks) wnx[dir][g][ks] = *(const bf16x8*)(gwt + ((size_t)(((dir * 2 + g) * 8 + n) * 64 + (nt + 1) * 16 + fr)) * 64 + ks * 32 + fq * 8);
            }
            float xcv[4][4];
#pragma unroll
            for (int m = 0; m < 4; ++m)
#pragma unroll
                for (int j = 0; j < 4; ++j) xcv[m][j] = bf2f(*(const LAS bf16_t*)(lds + RG_XC + (16 * m + 4 * fq + j) * XC_STRIDE + ch * 2));
#pragma unroll
            for (int dir = 0; dir < 2; ++dir) {
                f32x4 accr[4], acci[4];
#pragma unroll
                for (int m = 0; m < 4; ++m) { accr[m] = (f32x4){0.f, 0.f, 0.f, 0.f}; acci[m] = (f32x4){0.f, 0.f, 0.f, 0.f}; }
                if (!(xr & 2))
#pragma unroll
                for (int ks = 0; ks < 2; ++ks)
#pragma unroll
                    for (int m = 0; m < 4; ++m) { accr[m] = __builtin_amdgcn_mfma_f32_16x16x32_bf16(afr[m][ks], wfr[dir][0][ks], accr[m], 0, 0, 0); acci[m] = __builtin_amdgcn_mfma_f32_16x16x32_bf16(afr[m][ks], wfr[dir][1][ks], acci[m], 0, 0, 0); }
                const float gbr = pgr[nt][dir], gbi = pgi[nt][dir], sp = psp[nt][dir];
                float av[4][4], uv[4][4];
                const bool exact = __any(8.0f * sp >= 0.25f);
#pragma unroll
                for (int m = 0; m < 4; ++m) {
                    unsigned pk[4];
                    if (xr & 4) {
#pragma unroll
                        for (int j = 0; j < 4; ++j) pk[j] = __float_as_uint(accr[m][j] + acci[m][j] + xcv[m][j]);
                    } else if (!exact) {
#pragma unroll
                        for (int j = 0; j < 4; ++j) {
                            const float r = sigmoidf_(accr[m][j] + gbr), ig = sigmoidf_(acci[m][j] + gbi);
                            const float la = -8.0f * r * sp;
                            const float oma = -la * (1.f + la * (0.5f + la * (0.16666667f + la * (0.041666668f + la * 0.0083333338f))));
                            pk[j] = cvt2(oma, __builtin_amdgcn_sqrtf(oma * (2.0f - oma)) * ig * xcv[m][j]);
                        }
                    } else {
#pragma unroll
                        for (int j = 0; j < 4; ++j) {
                            const float r = sigmoidf_(accr[m][j] + gbr), ig = sigmoidf_(acci[m][j] + gbi);
                            const float la = -8.0f * r * sp;
                            const float ser = -la * (1.f + la * (0.5f + la * (0.16666667f + la * (0.041666668f + la * 0.0083333338f))));
                            const float oma = (la > -0.25f) ? ser : 1.f - __expf(la);
                            pk[j] = cvt2(oma, __builtin_amdgcn_sqrtf(oma * (2.0f - oma)) * ig * xcv[m][j]);
                        }
                    }
#pragma unroll
                    for (int j = 0; j < 4; ++j) { av[m][j] = 1.0f - bf_lo(pk[j]); uv[m][j] = bf_hi(pk[j]); }
                    if (stash && !(xr & 16)) ntst(stash + ((nt * 2 + dir) * 4 + m) * 64, (u32x4){pk[0], pk[1], pk[2], pk[3]});
                }
                float carry = 0.f, atot = 1.f, hdummy[4][4];
                if (xr & 8) { carry = av[0][0] + uv[3][3]; } else if (dir == 0) rg_scan64<0, false>(av, uv, carry, atot, hdummy, fr, fq); else rg_scan64<1, false>(av, uv, carry, atot, hdummy, fr, fq);
                if (fq == 0) { rgagg[(((size_t)unit * 2 + dir) * 2 + 0) * 512 + ch] = atot; rgagg[(((size_t)unit * 2 + dir) * 2 + 1) * 512 + ch] = carry; }
            }
            if (nt < 3) {
#pragma unroll
                for (int dir = 0; dir < 2; ++dir)
#pragma unroll
                    for (int g = 0; g < 2; ++g)
#pragma unroll
                        for (int ks = 0; ks < 2; ++ks) wfr[dir][g][ks] = wnx[dir][g][ks];
            }
        }
    }
    lds_barrier();
}

__device__ __forceinline__ void rg_final_load(u32x4 (&g)[8], u32x4 (&st)[2][4], const Args& a, int b, int kl, int tid, int wave, int lane) {
    const bf16_t* __restrict__ proj = (const bf16_t*)(a.ws + WS_PROJ);
    const int rowbase = b * SEQ + kl * 64, c0 = (tid & 63) * 8, i0 = (tid >> 6) * 8;
    const u32x4* stash = (const u32x4*)a.out + ((size_t)(b * 64 + kl) * 16384 + (size_t)wave * 2048 + lane);
#pragma unroll
    for (int ii = 0; ii < 8; ++ii) g[ii] = *(const u32x4*)proj_at(proj, rowbase + i0 + ii, 512 + c0);
#pragma unroll
    for (int dir = 0; dir < 2; ++dir)
#pragma unroll
        for (int m = 0; m < 4; ++m) st[dir][m] = ntld(stash + ((0 * 2 + dir) * 4 + m) * 64);
}
__device__ __forceinline__ void rg_final_unit(LAS unsigned char* lds, const Args& a, int b, int kl, u32x4 (&g)[8], u32x4 (&st)[2][4], int bn, int kn, int tid, int wave, int lane) {
    const float* rgcarry = (const float*)(a.ws + WS_RGCARRY); bf16_t* mixed = (bf16_t*)(a.ws + WS_MIXED);
    const int rowbase = b * SEQ + kl * 64, unit = b * RG_UNITS_PER_B + 4 + kl;
    const int n = wave, fr = lane & 15, fq = lane >> 4;
    const u32x4* stash = (const u32x4*)a.out + ((size_t)(b * 64 + kl) * 16384 + (size_t)wave * 2048 + lane);
    float cin[4][2];
#pragma unroll
    for (int nt = 0; nt < 4; ++nt)
#pragma unroll
        for (int dir = 0; dir < 2; ++dir) cin[nt][dir] = rgcarry[((size_t)unit * 2 + dir) * 512 + n * 64 + nt * 16 + fr];
    {
        const int c0 = (tid & 63) * 8, i0 = (tid >> 6) * 8;
#pragma unroll
        for (int ii = 0; ii < 8; ++ii) *(LAS u32x4*)(lds + RG_XC + (i0 + ii) * XC_STRIDE + c0 * 2) = g[ii];
    }
    lds_barrier();
#pragma unroll
    for (int nt = 0; nt < 4; ++nt) {
        const int ch = n * 64 + nt * 16 + fr;
        u32x4 sn[2][4];
        if (nt < 3) {
#pragma unroll
            for (int dir = 0; dir < 2; ++dir)
#pragma unroll
                for (int m = 0; m < 4; ++m) sn[dir][m] = ntld(stash + (((nt + 1) * 2 + dir) * 4 + m) * 64);
        }
        float hsum[4][4];
#pragma unroll
        for (int dir = 0; dir < 2; ++dir) {
            float av[4][4], uv[4][4];
#pragma unroll
            for (int m = 0; m < 4; ++m)
#pragma unroll
                for (int j = 0; j < 4; ++j) { av[m][j] = 1.0f - bf_lo(st[dir][m][j]); uv[m][j] = bf_hi(st[dir][m][j]); }
            float carry = cin[nt][dir], atot = 1.f;
            if (dir == 0) rg_scan64<0, true>(av, uv, carry, atot, hsum, fr, fq); else rg_scan64<1, true>(av, uv, carry, atot, hsum, fr, fq);
        }
#pragma unroll
        for (int m = 0; m < 4; ++m)
#pragma unroll
            for (int j = 0; j < 4; ++j) { const int t = 16 * m + 4 * fq + j;
                const float gg = gelu_tanh(bf2f(*(const LAS bf16_t*)(lds + RG_XC + t * XC_STRIDE + ch * 2)));
                *(LAS bf16_t*)(lds + RG_OUT + t * XC_STRIDE + ch * 2) = (bf16_t)(cvt2(hsum[m][j] * gg, 0.f) & 0xffffu); }
        if (nt < 3) {
#pragma unroll
            for (int dir = 0; dir < 2; ++dir)
#pragma unroll
                for (int m = 0; m < 4; ++m) st[dir][m] = sn[dir][m];
        }
    }
    if (kn >= 0) rg_final_load(g, st, a, bn, kn, tid, wave, lane);
    lds_barrier();
    {
        const int c0 = (tid & 63) * 8, i0 = (tid >> 6) * 8;
#pragma unroll
        for (int ii = 0; ii < 8; ++ii) { const u32x4 w = *(const LAS u32x4*)(lds + RG_OUT + (i0 + ii) * XC_STRIDE + c0 * 2);
            *(u32x4*)(mixed + (size_t)(rowbase + i0 + ii) * DM + c0) = w; }
    }
}

__device__ __forceinline__ void rg_carry_item(const Args& a, int item, int tid) {
    const float* rgagg = (const float*)(a.ws + WS_RGAGG); float* rgcarry = (float*)(a.ws + WS_RGCARRY);
    const int gidx = item * NTHREADS + tid;
    const int ch = gidx & 511, dir = (gidx >> 9) & 1, b = gidx >> 10;
    float h = 0.f;
#pragma unroll 1
    for (int s0 = 0; s0 < RG_UNITS_PER_B; s0 += 17) {
        float Av[17], Hv[17];
#pragma unroll
        for (int s1 = 0; s1 < 17; ++s1) { const int s = s0 + s1;
            const int k = dir == 0 ? s : (s < 4 ? 3 - s : 67 - (s - 4));
            const size_t unit = (size_t)b * RG_UNITS_PER_B + k;
            Av[s1] = rgagg[((unit * 2 + dir) * 2 + 0) * 512 + ch]; Hv[s1] = rgagg[((unit * 2 + dir) * 2 + 1) * 512 + ch]; }
#pragma unroll
        for (int s1 = 0; s1 < 17; ++s1) { const int s = s0 + s1;
            const int k = dir == 0 ? s : (s < 4 ? 3 - s : 67 - (s - 4));
            const size_t unit = (size_t)b * RG_UNITS_PER_B + k;
            rgcarry[(unit * 2 + dir) * 512 + ch] = h;
            h = Av[s1] * h + Hv[s1]; }
    }
}

#ifndef HGX
#define HGX 0
#endif
__device__ __forceinline__ float row_allsum16(float v) {
    v += __builtin_bit_cast(float, __builtin_amdgcn_update_dpp(0, __builtin_bit_cast(int, v), 0x128, 0xf, 0xf, false));
    v += __builtin_bit_cast(float, __builtin_amdgcn_update_dpp(0, __builtin_bit_cast(int, v), 0x124, 0xf, 0xf, false));
    v += __builtin_bit_cast(float, __builtin_amdgcn_update_dpp(0, __builtin_bit_cast(int, v), 0x122, 0xf, 0xf, false));
    v += __builtin_bit_cast(float, __builtin_amdgcn_update_dpp(0, __builtin_bit_cast(int, v), 0x121, 0xf, 0xf, false));
    return v;
}
constexpr int HG_RAWZ = 0, HG_RAWV = 16384, HG_RAWQ = 32768;
constexpr int HG_KHT = 49152, HG_VT = 67584;
constexpr int HG_QT = 86016, HG_KT = 103424;
constexpr int HG_AM = 120832;
constexpr int HG_DS = 130048, HG_QSUM = 130560, HG_PART = 134656;
constexpr int HG_RAWG = 136704;
constexpr int HG_OST = HG_QT;
constexpr int TS = 144, QS = 272;

struct HgRaw { u32x4 z[2], v[2], q[2], g[2]; };
template <bool FULL, bool GATE>
__device__ __forceinline__ void hg_load_raw(HgRaw& r, const bf16_t* __restrict__ proj, int row0, int hd, int dir, int tid) {
#pragma unroll
    for (int i = 0; i < 2; ++i) { const int row = row0 + (tid >> 4) + 32 * i, col = hd * 128 + (tid & 15) * 8;
        r.z[i] = *(const u32x4*)proj_at(proj, row, col + (dir == 0 ? 1536 : 2048)); r.v[i] = *(const u32x4*)proj_at(proj, row, col + 2560);
        if (FULL) r.q[i] = *(const u32x4*)proj_at(proj, row, col + 1024); if (GATE) r.g[i] = *(const u32x4*)proj_at(proj, row, col + 3072); }
}
template <bool FULL, bool GATE>
__device__ __forceinline__ void hg_store_raw(LAS unsigned char* lds, const HgRaw& r, int tid) {
#pragma unroll
    for (int i = 0; i < 2; ++i) { const int off = ((tid >> 4) + 32 * i) * 256 + (tid & 15) * 16;
        *(LAS u32x4*)(lds + HG_RAWZ + off) = r.z[i]; *(LAS u32x4*)(lds + HG_RAWV + off) = r.v[i]; if (FULL) *(LAS u32x4*)(lds + HG_RAWQ + off) = r.q[i]; if (GATE) *(LAS u32x4*)(lds + HG_RAWG + off) = r.g[i]; }
}

template <int DIR, bool FULL, bool STORE_NEXT, bool NEXT_GATE>
__device__ __forceinline__ void hg_chunk(LAS unsigned char* lds, f32x4 (&accS)[8], f32x4 (&o)[4], float lb0, float lb1, float& dseg0, float& dseg1, const HgRaw& nxt, int tid, int wave, int lane, int xm = 0) {
    const int cp = lane, tg = wave, fr = lane & 15, fq = lane >> 4;
    float c0[8], c1[8], k0[8], k1[8];
    if (xm & 1) {
#pragma unroll
        for (int i = 0; i < 8; ++i) { c0[i] = 1.f; c1[i] = 1.f; k0[i] = 0.5f; k1[i] = 0.5f; }
    } else {
        float p0 = 1.f, p1 = 1.f;
#pragma unroll
        for (int ii = 0; ii < 8; ++ii) { const int i = DIR == 0 ? ii : 7 - ii;
            const unsigned zz = *(const LAS unsigned*)(lds + HG_RAWZ + (8 * tg + i) * 256 + cp * 4);
            const float e0 = __expf(-bf_lo(zz)), e1 = __expf(-bf_hi(zz)); const float s0 = frcp(1.0f + e0), s1 = frcp(1.0f + e1);
            k0[i] = (1.0f - lb0) * (1.0f - s0); k1[i] = (1.0f - lb1) * (1.0f - s1);
            p0 *= lb0 + (1.0f - lb0) * s0; p1 *= lb1 + (1.0f - lb1) * s1; c0[i] = p0; c1[i] = p1; }
        *(LAS f32x2*)(lds + HG_QSUM + (tg * 128 + 2 * cp) * 4) = (f32x2){p0, p1};
    }
    lds_barrier();
    float pre0 = 1.f, pre1 = 1.f, tot0 = 1.f, tot1 = 1.f;
#pragma unroll
    for (int g = 0; g < 8; ++g) { const f32x2 v = *(const LAS f32x2*)(lds + HG_QSUM + (g * 128 + 2 * cp) * 4); tot0 *= v[0]; tot1 *= v[1]; if (DIR == 0 ? (g < tg) : (g > tg)) { pre0 *= v[0]; pre1 *= v[1]; } }
    if (!(xm & 1)) {
        unsigned kh0[4], kh1[4], vt0[4], vt1[4];
#pragma unroll
        for (int i2 = 0; i2 < 4; ++i2) {
            const float Pa0 = pre0 * c0[2 * i2], Pb0 = pre0 * c0[2 * i2 + 1], Pa1 = pre1 * c1[2 * i2], Pb1 = pre1 * c1[2 * i2 + 1];
            const float ra0 = frcp(Pa0), rb0 = frcp(Pb0), ra1 = frcp(Pa1), rb1 = frcp(Pb1);
            const float kta0 = k0[2 * i2] * ra0, ktb0 = k0[2 * i2 + 1] * rb0, kta1 = k1[2 * i2] * ra1, ktb1 = k1[2 * i2 + 1] * rb1;
            kh0[i2] = cvt2(kta0 * tot0, ktb0 * tot0); kh1[i2] = cvt2(kta1 * tot1, ktb1 * tot1);
            const unsigned va = *(const LAS unsigned*)(lds + HG_RAWV + (8 * tg + 2 * i2) * 256 + cp * 4), vb = *(const LAS unsigned*)(lds + HG_RAWV + (8 * tg + 2 * i2 + 1) * 256 + cp * 4);
            vt0[i2] = __builtin_amdgcn_perm(vb, va, 0x05040100u); vt1[i2] = __builtin_amdgcn_perm(vb, va, 0x07060302u);
            if (FULL) {
                const unsigned qa = *(const LAS unsigned*)(lds + HG_RAWQ + (8 * tg + 2 * i2) * 256 + cp * 4), qb = *(const LAS unsigned*)(lds + HG_RAWQ + (8 * tg + 2 * i2 + 1) * 256 + cp * 4);
                *(LAS unsigned*)(lds + HG_QT + (8 * tg + 2 * i2) * QS + cp * 4) = cvt2(bf_lo(qa) * Pa0, bf_hi(qa) * Pa1);
                *(LAS unsigned*)(lds + HG_QT + (8 * tg + 2 * i2 + 1) * QS + cp * 4) = cvt2(bf_lo(qb) * Pb0, bf_hi(qb) * Pb1);
                *(LAS unsigned*)(lds + HG_KT + (8 * tg + 2 * i2) * QS + cp * 4) = cvt2(kta0, kta1);
                *(LAS unsigned*)(lds + HG_KT + (8 * tg + 2 * i2 + 1) * QS + cp * 4) = cvt2(ktb0, ktb1);
            }
        }
        *(LAS u32x4*)(lds + HG_KHT + (2 * cp) * TS + tg * 16) = (u32x4){kh0[0], kh0[1], kh0[2], kh0[3]}; *(LAS u32x4*)(lds + HG_KHT + (2 * cp + 1) * TS + tg * 16) = (u32x4){kh1[0], kh1[1], kh1[2], kh1[3]};
        *(LAS u32x4*)(lds + HG_VT + (2 * cp) * TS + tg * 16) = (u32x4){vt0[0], vt0[1], vt0[2], vt0[3]}; *(LAS u32x4*)(lds + HG_VT + (2 * cp + 1) * TS + tg * 16) = (u32x4){vt1[0], vt1[1], vt1[2], vt1[3]};
        if (tg == 0) { *(LAS f32x2*)(lds + HG_DS + 2 * cp * 4) = (f32x2){tot0, tot1}; dseg0 *= tot0; dseg1 *= tot1; }
    }
    lds_barrier();
    if (FULL) {
        if (!(xm & 2))
#pragma unroll
        for (int tt = 0; tt < 2; ++tt) {
            const int tl = 2 * wave + tt, ti = tl >> 2, si = tl & 3;
            f32x4 accA = (f32x4){0.f, 0.f, 0.f, 0.f};
#pragma unroll
            for (int ks = 0; ks < 4; ++ks) {
                const bf16x8 af = *(const LAS bf16x8*)(lds + HG_QT + (16 * ti + fr) * QS + (ks * 32 + fq * 8) * 2);
                const bf16x8 bf = *(const LAS bf16x8*)(lds + HG_KT + (16 * si + fr) * QS + (ks * 32 + fq * 8) * 2);
                accA = __builtin_amdgcn_mfma_f32_16x16x32_bf16(af, bf, accA, 0, 0, 0);
            }
#pragma unroll
            for (int j = 0; j < 4; ++j) { const int t = 16 * ti + 4 * fq + j, s = 16 * si + fr;
                const bool keep = DIR == 0 ? (s <= t) : (s >= t);
                *(LAS bf16_t*)(lds + HG_AM + t * TS + s * 2) = (bf16_t)(cvt2(keep ? accA[j] : 0.f, 0.f) & 0xffffu); }
        }
        lds_barrier();
#pragma unroll
        for (int m = 0; m < 4; ++m) o[m] = (f32x4){0.f, 0.f, 0.f, 0.f};
        if (!(xm & 4)) {
#pragma unroll
        for (int ks = 0; ks < 4; ++ks) {
            const u32x4 sw = (u32x4){cvt2(accS[2 * ks][0], accS[2 * ks][1]), cvt2(accS[2 * ks][2], accS[2 * ks][3]), cvt2(accS[2 * ks + 1][0], accS[2 * ks + 1][1]), cvt2(accS[2 * ks + 1][2], accS[2 * ks + 1][3])};
            const bf16x8 sf = mk_bf16x8(sw);
#pragma unroll
            for (int m = 0; m < 4; ++m) {
                const u32x2 qlo = *(const LAS u32x2*)(lds + HG_QT + (16 * m + fr) * QS + (32 * ks + 4 * fq) * 2), qhi = *(const LAS u32x2*)(lds + HG_QT + (16 * m + fr) * QS + (32 * ks + 16 + 4 * fq) * 2);
                const bf16x8 qf = mk_bf16x8((u32x4){qlo.x, qlo.y, qhi.x, qhi.y});
                o[m] = __builtin_amdgcn_mfma_f32_16x16x32_bf16(qf, sf, o[m], 0, 0, 0);
            }
        }
#pragma unroll
        for (int ks = 0; ks < 2; ++ks) {
            const bf16x8 vf = *(const LAS bf16x8*)(lds + HG_VT + (16 * wave + fr) * TS + (ks * 32 + fq * 8) * 2);
#pragma unroll
            for (int m = 0; m < 4; ++m) { const bf16x8 af = *(const LAS bf16x8*)(lds + HG_AM + (16 * m + fr) * TS + (ks * 32 + fq * 8) * 2);
                o[m] = __builtin_amdgcn_mfma_f32_16x16x32_bf16(af, vf, o[m], 0, 0, 0); }
        }
        }
    }
    if (!(xm & 8)) {
#pragma unroll
    for (int i = 0; i < 8; ++i) { const f32x4 dv = *(const LAS f32x4*)(lds + HG_DS + (16 * i + 4 * fq) * 4); accS[i] = accS[i] * dv; }
#pragma unroll
    for (int ks = 0; ks < 2; ++ks) {
        const bf16x8 vf = *(const LAS bf16x8*)(lds + HG_VT + (16 * wave + fr) * TS + (ks * 32 + fq * 8) * 2);
#pragma unroll
        for (int i = 0; i < 8; ++i) { const bf16x8 af = *(const LAS bf16x8*)(lds + HG_KHT + (16 * i + fr) * TS + (ks * 32 + fq * 8) * 2);
            accS[i] = __builtin_amdgcn_mfma_f32_16x16x32_bf16(af, vf, accS[i], 0, 0, 0); }
    }
    }
    if (STORE_NEXT) hg_store_raw<FULL, NEXT_GATE>(lds, nxt, tid);
}

__device__ __forceinline__ float hg_lb(const float* __restrict__ lb_logits, int dir, int col) {
    const float l0 = lb_logits[(0 * 2 + dir) * 512 + col], l1 = lb_logits[(1 * 2 + dir) * 512 + col];
    return 1.0f / (1.0f + expf(l1 - l0));
}

template <int DIR>
__device__ __forceinline__ void hg_agg_unit(LAS unsigned char* lds, const Args& a, int b, int hd, int sidx, int unit, int tid, int wave, int lane, HgRaw& raw, bool have, int nrow, int nhd, int ndir, float lb0, float lb1) {
    const bf16_t* __restrict__ proj = (const bf16_t*)(a.ws + WS_PROJ);
    const int rowbase = sidx == 0 ? T + b * LC : b * SEQ + (sidx - 1) * 256;
    f32x4 accS[8], odummy[4];
#pragma unroll
    for (int i = 0; i < 8; ++i) accS[i] = (f32x4){0.f, 0.f, 0.f, 0.f};
    float dseg0 = 1.f, dseg1 = 1.f;
    if (!have) hg_load_raw<false, false>(raw, proj, rowbase + (DIR == 0 ? 0 : 3) * 64, hd, DIR, tid);
    lds_barrier();
    hg_store_raw<false, false>(lds, raw, tid);
    lds_barrier();
#pragma unroll 1
    for (int cc = 0; cc < 3; ++cc) {
        hg_load_raw<false, false>(raw, proj, rowbase + (DIR == 0 ? cc + 1 : 2 - cc) * 64, hd, DIR, tid);
        hg_chunk<DIR, false, true, false>(lds, accS, odummy, lb0, lb1, dseg0, dseg1, raw, tid, wave, lane);
        lds_barrier();
    }
    if (nrow >= 0) hg_load_raw<false, false>(raw, proj, nrow, nhd, ndir, tid);
    hg_chunk<DIR, false, false, false>(lds, accS, odummy, lb0, lb1, dseg0, dseg1, raw, tid, wave, lane);
    float* K = (float*)(a.ws + WS_HGK) + (size_t)unit * 16384;
#pragma unroll
    for (int i = 0; i < 8; ++i) *(f32x4*)(K + (size_t)(((8 * i + wave) * 64 + lane) * 4)) = accS[i];
    if (wave == 0) *(f32x2*)((float*)(a.ws + WS_HGD) + (size_t)unit * 128 + 2 * lane) = (f32x2){dseg0, dseg1};
}

__device__ __forceinline__ void hg_carry_item(const Args& a, int item, int tid, bool dry = false) {
    const int chain = item >> 3, part = item & 7, dir = chain & 1;
    float* K = (float*)(a.ws + WS_HGK) + (size_t)chain * HG_SEGS * 16384; const float* D = (const float*)(a.ws + WS_HGD) + (size_t)chain * HG_SEGS * 128;
    const int e4 = part * 512 + tid, dk0 = 16 * part + 4 * ((tid & 63) >> 4);
    f32x4 kv[HG_SEGS], dv[HG_SEGS];
#pragma unroll
    for (int s = 0; s < HG_SEGS; ++s) { const int sidx = s == 0 ? 0 : (dir == 0 ? s : HG_SEGS - s); kv[s] = *(const f32x4*)(K + (size_t)sidx * 16384 + e4 * 4); dv[s] = *(const f32x4*)(D + sidx * 128 + dk0); }
    f32x4 S = (f32x4){0.f, 0.f, 0.f, 0.f};
#pragma unroll
    for (int s = 0; s < HG_SEGS; ++s) { const int sidx = s == 0 ? 0 : (dir == 0 ? s : HG_SEGS - s);
        if (dry) { const size_t o = ((size_t)(chain * HG_SEGS + sidx) * 16384 + e4 * 4) % (size_t)(32 * MiB); *(f32x4*)((float*)(a.ws + WS_MIXED) + o) = S; } else *(f32x4*)(K + (size_t)sidx * 16384 + e4 * 4) = S;
        S = S * dv[s] + kv[s]; }
}

__device__ __forceinline__ void hg_final_unit(LAS unsigned char* lds, const Args& a, int b, int hd, int seg, int tid, int wave, int lane, int xm, float lbf0, float lbf1, float lbb0, float lbb1) {
    const bf16_t* __restrict__ proj = (const bf16_t*)(a.ws + WS_PROJ); bf16_t* mixed = (bf16_t*)(a.ws + WS_MIXED);
    const int rowbase = b * SEQ + seg * 256, fr = lane & 15, fq = lane >> 4;
    f32x4 accS[8], o[4];
    float dseg0 = 1.f, dseg1 = 1.f;
    HgRaw raw;
    f32x4* ofst = (f32x4*)(a.ws + WS_OFST) + (size_t)blockIdx.x * 8192 + wave * 256 + lane;
    hg_load_raw<true, false>(raw, proj, rowbase, hd, 0, tid);
    {
        const float* Sin = (const float*)(a.ws + WS_HGK) + (size_t)((((b * 4 + hd) * 2 + 0) * HG_SEGS) + 1 + seg) * 16384;
#pragma unroll
        for (int i = 0; i < 8; ++i) accS[i] = *(const f32x4*)(Sin + (size_t)(((8 * i + wave) * 64 + lane) * 4));
    }
    lds_barrier();
    hg_store_raw<true, false>(lds, raw, tid);
    lds_barrier();
#pragma unroll 1
    for (int cc = 0; cc < 3; ++cc) {
        hg_load_raw<true, false>(raw, proj, rowbase + (cc + 1) * 64, hd, 0, tid);
        hg_chunk<0, true, true, false>(lds, accS, o, lbf0, lbf1, dseg0, dseg1, raw, tid, wave, lane, xm);
#pragma unroll
        for (int m = 0; m < 4; ++m) ofst[cc * 2048 + m * 64] = o[m];
        lds_barrier();
    }
    hg_load_raw<true, false>(raw, proj, rowbase + 3 * 64, hd, 1, tid);
    hg_chunk<0, true, true, false>(lds, accS, o, lbf0, lbf1, dseg0, dseg1, raw, tid, wave, lane, xm);
#pragma unroll
    for (int m = 0; m < 4; ++m) ofst[3 * 2048 + m * 64] = o[m];
    {
        const float* Sin = (const float*)(a.ws + WS_HGK) + (size_t)((((b * 4 + hd) * 2 + 1) * HG_SEGS) + 1 + seg) * 16384;
#pragma unroll
        for (int i = 0; i < 8; ++i) accS[i] = *(const f32x4*)(Sin + (size_t)(((8 * i + wave) * 64 + lane) * 4));
    }
    lds_barrier();
    constexpr int OSF = 528;
    f32x4 ngv[2];
    { const float* ngp = a.in[13] + hd * 128 + (tid & 15) * 8; ngv[0] = *(const f32x4*)ngp; ngv[1] = *(const f32x4*)(ngp + 4); }
#pragma unroll 1
    for (int cc = 0; cc < 4; ++cc) {
        const int c = 3 - cc;
        f32x4 ofv[4]; u32x4 gq[2];
#pragma unroll
        for (int m = 0; m < 4; ++m) ofv[m] = ofst[c * 2048 + m * 64];
#pragma unroll
        for (int i = 0; i < 2; ++i) gq[i] = *(const u32x4*)proj_at(proj, rowbase + c * 64 + (tid >> 4) + 32 * i, 3072 + hd * 128 + (tid & 15) * 8);
        if (cc < 3) hg_load_raw<true, false>(raw, proj, rowbase + (c - 1) * 64, hd, 1, tid);
        if (cc < 3) hg_chunk<1, true, true, false>(lds, accS, o, lbb0, lbb1, dseg0, dseg1, raw, tid, wave, lane, xm);
        else hg_chunk<1, true, false, false>(lds, accS, o, lbb0, lbb1, dseg0, dseg1, raw, tid, wave, lane, xm);
        if (xm & 16) { lds_barrier(); continue; }
        lds_barrier();
#pragma unroll
        for (int m = 0; m < 4; ++m) { const f32x4 ot = o[m] + ofv[m];
#pragma unroll
            for (int j = 0; j < 4; ++j) *(LAS float*)(lds + HG_QT + (16 * m + 4 * fq + j) * OSF + (16 * wave + fr) * 4) = ot[j]; }
        lds_barrier();
#pragma unroll
        for (int i = 0; i < 2; ++i) { const int t = (tid >> 4) + 32 * i, c8 = (tid & 15) * 8;
            const f32x4 v0 = *(const LAS f32x4*)(lds + HG_QT + t * OSF + c8 * 4), v1 = *(const LAS f32x4*)(lds + HG_QT + t * OSF + c8 * 4 + 16);
            const float ss = row_allsum16((v0[0] * v0[0] + v0[1] * v0[1]) + (v0[2] * v0[2] + v0[3] * v0[3]) + (v1[0] * v1[0] + v1[1] * v1[1]) + (v1[2] * v1[2] + v1[3] * v1[3]));
            const float rinv = __builtin_amdgcn_rsqf(ss * (1.0f / 128.0f) + LN_EPS);
            const u32x4 g = gq[i];
            const float g0 = siluf_(bf_lo(g.x)), g1 = siluf_(bf_hi(g.x)), g2 = siluf_(bf_lo(g.y)), g3 = siluf_(bf_hi(g.y)), g4 = siluf_(bf_lo(g.z)), g5 = siluf_(bf_hi(g.z)), g6 = siluf_(bf_lo(g.w)), g7 = siluf_(bf_hi(g.w));
            u32x4 w;
            w.x = cvt2(v0[0] * rinv * ngv[0][0] * g0, v0[1] * rinv * ngv[0][1] * g1); w.y = cvt2(v0[2] * rinv * ngv[0][2] * g2, v0[3] * rinv * ngv[0][3] * g3);
            w.z = cvt2(v1[0] * rinv * ngv[1][0] * g4, v1[1] * rinv * ngv[1][1] * g5); w.w = cvt2(v1[2] * rinv * ngv[1][2] * g6, v1[3] * rinv * ngv[1][3] * g7);
            *(u32x4*)(mixed + (size_t)(rowbase + c * 64 + t) * DM + 512 + hd * 128 + c8) = w; }
    }
}

__device__ __forceinline__ void p_scan_a(LAS unsigned char* lds, const Args& a, int bid, int G, int tid, int wave, int lane, int mask = 3, int xr = 0) {
    constexpr int N_HG = NB * 4 * 2 * HG_SEGS, N_RG = NB * RG_UNITS_PER_B;
    if (mask & 1) {
        const bool bal = G == 256;
        const int hn = bal ? (bid < 128 ? 9 : (bid < 192 ? 8 : 6)) : (2048 - bid + G - 1) / G;
        const int hs = bal ? (bid < 128 ? 9 * bid : (bid < 192 ? 1152 + 8 * (bid - 128) : 1664 + 6 * (bid - 192))) : bid, hstep = bal ? 1 : G;
        HgRaw hraw; int cdir = -1, chd = -1; float lb0 = 0.f, lb1 = 0.f;
#pragma unroll 1
        for (int k = 0; k < hn; ++k) {
            int t2 = tid; asm volatile("" : "+v"(t2)); const int tid = t2, lane = t2 & 63;
            const int it = hs + k * hstep, s16 = it & 15, rest = it >> 4, dir = rest & 1, hd = (rest >> 1) & 3, b = rest >> 3;
            const int sidx = dir == 0 ? s16 : (s16 == 0 ? 0 : s16 + 1), unit = rest * HG_SEGS + sidx;
            int nrow = -1, nhd = 0, ndir = 0;
            if (k + 1 < hn) { const int it2 = it + hstep, s2 = it2 & 15, rest2 = it2 >> 4, b2 = rest2 >> 3; ndir = rest2 & 1; nhd = (rest2 >> 1) & 3;
                const int sidx2 = ndir == 0 ? s2 : (s2 == 0 ? 0 : s2 + 1);
                nrow = (sidx2 == 0 ? T + b2 * LC : b2 * SEQ + (sidx2 - 1) * 256) + (ndir == 0 ? 0 : 3) * 64; }
            if (dir != cdir || hd != chd) { cdir = dir; chd = hd; lb0 = hg_lb(a.in[12], dir, hd * 128 + 2 * lane); lb1 = hg_lb(a.in[12], dir, hd * 128 + 2 * lane + 1); }
            if (dir == 0) hg_agg_unit<0>(lds, a, b, hd, sidx, unit, tid, wave, lane, hraw, k > 0, nrow, nhd, ndir, lb0, lb1); else hg_agg_unit<1>(lds, a, b, hd, sidx, unit, tid, wave, lane, hraw, k > 0, nrow, nhd, ndir, lb0, lb1);
        }
    }
    if (mask & 2) {
        __syncthreads();
        u32x4 raw[11];
        int r = G - 1 - bid;
        if (r < N_RG) rg_load_raw(raw, (const bf16_t*)(a.ws + WS_PROJ), r / RG_UNITS_PER_B, r % RG_UNITS_PER_B, tid);
#pragma unroll 1
        for (; r < N_RG; r += G) {
            int t2 = tid; asm volatile("" : "+v"(t2)); const int tid = t2, lane = t2 & 63;
            const int rn = r + G;
            rg_agg_unit(lds, a, r / RG_UNITS_PER_B, r % RG_UNITS_PER_B, raw, rn / RG_UNITS_PER_B, rn < N_RG ? rn % RG_UNITS_PER_B : -1, tid, wave, lane, xr);
        }
    }
}
__device__ __forceinline__ void p_scan_b(const Args& a, int bid, int G, int tid, bool dry = false) {
#pragma unroll 1
    for (int it = bid; it < 1024; it += G) hg_carry_item(a, it, tid, dry);
    if (bid >= G - 32) rg_carry_item(a, bid - (G - 32), tid);
}
__device__ __forceinline__ void p_scan_c(LAS unsigned char* lds, const Args& a, int bid, int G, int tid, int wave, int lane, int mask = 3, int xm = 0) {
    int chd = -1; float lbf0 = 0.f, lbf1 = 0.f, lbb0 = 0.f, lbb1 = 0.f;
#pragma unroll 1
    for (int it = bid; it < ((mask & 1) ? 1024 : 0); it += G) { const int seg = it & 15, hd = (it >> 4) & 3, b = it >> 6; int t2 = tid; asm volatile("" : "+v"(t2));
        if (hd != chd) { chd = hd; const int l2 = t2 & 63;
            lbf0 = hg_lb(a.in[12], 0, hd * 128 + 2 * l2); lbf1 = hg_lb(a.in[12], 0, hd * 128 + 2 * l2 + 1); lbb0 = hg_lb(a.in[12], 1, hd * 128 + 2 * l2); lbb1 = hg_lb(a.in[12], 1, hd * 128 + 2 * l2 + 1); }
        hg_final_unit(lds, a, b, hd, seg, t2, wave, t2 & 63, xm, lbf0, lbf1, lbb0, lbb1); }
    if (mask & 2) {
        __syncthreads();
        u32x4 g[8], st[2][4];
        int r = bid;
        if (r < 1024) rg_final_load(g, st, a, r >> 6, r & 63, tid, wave, lane);
#pragma unroll 1
        for (; r < 1024; r += G) {
            int t2 = tid; asm volatile("" : "+v"(t2)); const int rn = r + G;
            rg_final_unit(lds, a, r >> 6, r & 63, g, st, rn >> 6, rn < 1024 ? (rn & 63) : -1, t2, wave, t2 & 63);
        }
    }
}

#define GAS __attribute__((address_space(1)))
#define RLX_AGENT __ATOMIC_RELAXED, __HIP_MEMORY_SCOPE_AGENT
#define XB_TMO      128
#define XB_XCNT(j)  (256  + 64 * (j))
#define XB_XSUB(j)  (1280 + 64 * (j))
#define XB_XGEN(j)  (2304 + 64 * (j))
#define XB_TOP      3328
#define XB_TOPGEN   3392
#define XCD_BAR_WORDS 3456
#define XB_SPIN_CAP (1u << 18)

__device__ __forceinline__ unsigned xb_ld(unsigned* p)              { return __hip_atomic_load(p, __ATOMIC_RELAXED, __HIP_MEMORY_SCOPE_AGENT); }
__device__ __forceinline__ unsigned xb_add(unsigned* p, unsigned v) { return __hip_atomic_fetch_add(p, v, __ATOMIC_RELAXED, __HIP_MEMORY_SCOPE_AGENT); }
__device__ __forceinline__ unsigned xb_xcc_id() { return (unsigned)__builtin_amdgcn_s_getreg((3 << 11) | 20) & 0xFu; }
#define XB_SPIN(cond, bar) do { unsigned _sp = 0; while (cond) { __builtin_amdgcn_s_sleep(1); \
    if ((++_sp & 255u) == 0u) { if (xb_ld(&(bar)[XB_TMO])) break; if (_sp > XB_SPIN_CAP) { atomicAdd(&(bar)[XB_TMO], 1u); break; } } } } while (0)

struct XcdBarrier {
    unsigned* bar; unsigned x;
    volatile LAS unsigned* st;
};

__device__ __forceinline__ XcdBarrier xcd_barrier_post(unsigned* bar, volatile LAS unsigned* st) {
    XcdBarrier b; b.bar = bar; b.x = xb_xcc_id(); b.st = st;
    if (threadIdx.x == 0) (void)xb_add(&bar[XB_XCNT(b.x)], 1u);
    return b;
}
__device__ __forceinline__ void xcd_barrier_complete(unsigned* bar, unsigned x, unsigned& nloc, unsigned& nx) {
    const unsigned G = gridDim.x * gridDim.y * gridDim.z;
    unsigned sum, cnt, mine, sp = 0u;
    for (;;) {
        sum = 0u; cnt = 0u; mine = 0u;
#pragma unroll
        for (unsigned j = 0; j < 16; ++j) { const unsigned c = xb_ld(&bar[XB_XCNT(j)]); sum += c; cnt += (c > 0u) ? 1u : 0u; mine = (j == x) ? c : mine; }
        if (sum == G) break;
        __builtin_amdgcn_s_sleep(1);
        if ((++sp & 255u) == 0u) { if (xb_ld(&bar[XB_TMO])) break; if (sp > XB_SPIN_CAP) { atomicAdd(&bar[XB_TMO], 1u); break; } }
    }
    nloc = mine > 0u ? mine : 1u; nx = cnt > 0u ? cnt : 1u;
}

__device__ __forceinline__ void xcd_barrier(const XcdBarrier& b) {
    asm volatile("s_waitcnt vmcnt(0)" ::: "memory");
    __syncthreads();
    if (threadIdx.x == 0) {
        unsigned* bar = b.bar;
        __builtin_amdgcn_s_waitcnt(0);
        unsigned nloc = b.st[0], nx = b.st[1];
        if (nloc == 0u) { xcd_barrier_complete(bar, b.x, nloc, nx); b.st[0] = nloc; b.st[1] = nx; }
        const unsigned old = xb_add(&bar[XB_XSUB(b.x)], 1u);
        const unsigned gen = old / nloc;
        if (old + 1u == (gen + 1u) * nloc) {
            __builtin_amdgcn_fence(__ATOMIC_RELEASE, "agent");
            asm volatile("s_waitcnt vmcnt(0)" ::: "memory");
            const unsigned og = xb_add(&bar[XB_TOP], 1u);
            const unsigned tg = og / nx;
            if (og + 1u == (tg + 1u) * nx) xb_add(&bar[XB_TOPGEN], 1u);
            else XB_SPIN(xb_ld(&bar[XB_TOPGEN]) == tg, bar);
            __builtin_amdgcn_fence(__ATOMIC_ACQUIRE, "agent");
            xb_add(&bar[XB_XGEN(b.x)], 1u);
            asm volatile("s_waitcnt vmcnt(0)" ::: "memory");
        } else {
            XB_SPIN(xb_ld(&bar[XB_XGEN(b.x)]) == gen, bar);
            __builtin_amdgcn_fence(__ATOMIC_ACQUIRE, "agent");
            asm volatile("s_waitcnt vmcnt(0)" ::: "memory");
        }
    }
    __syncthreads();
}


__device__ __forceinline__ void stagger_wait(unsigned ticks) {
    if (ticks == 0u) return;
    const unsigned long long t0 = __builtin_amdgcn_s_memrealtime();
    while (__builtin_amdgcn_s_memrealtime() - t0 < ticks) __builtin_amdgcn_s_sleep(16);
}
#ifndef STAG_P2
#define STAG_P2 0
#endif

constexpr size_t WS_SEAM = 12288;
__device__ __forceinline__ void seam_arrive(unsigned* cnt) {
    asm volatile("s_waitcnt vmcnt(0)" ::: "memory");
    __syncthreads();
    if (threadIdx.x == 0) { __builtin_amdgcn_fence(__ATOMIC_RELEASE, "agent"); asm volatile("s_waitcnt vmcnt(0)" ::: "memory"); (void)xb_add(cnt, 1u); }
}
__device__ __forceinline__ void seam_wait(unsigned* cnt, unsigned* bar, unsigned G) {
    if (threadIdx.x == 0) { XB_SPIN(xb_ld(cnt) < G, bar); __builtin_amdgcn_fence(__ATOMIC_ACQUIRE, "agent"); asm volatile("s_waitcnt vmcnt(0)" ::: "memory"); }
    __syncthreads();
}

__global__ void __launch_bounds__(NTHREADS, 2) mega(Args a) {
    extern __shared__ __attribute__((aligned(16))) unsigned char lds_raw[];
    LAS unsigned char* lds = (LAS unsigned char*)lds_raw;
    const int wave = __builtin_amdgcn_readfirstlane(threadIdx.x >> 6), bid = blockIdx.x, G = gridDim.x;
    int tid = threadIdx.x, lane = tid & 63;
#define FRESH_TID() do { tid = threadIdx.x; asm volatile("" : "+v"(tid)); lane = tid & 63; } while (0)
    unsigned char* ws = a.ws;
    volatile LAS unsigned* bst = (volatile LAS unsigned*)(lds + LDS_BYTES - 64);
    if (threadIdx.x < 2) bst[threadIdx.x] = 0u;
    __syncthreads();
    XcdBarrier xbar = xcd_barrier_post((unsigned*)(ws + WS_BAR), bst);
#define GRID_BAR() xcd_barrier(xbar)
    float* mod = (float*)(ws + WS_MOD);
    bf16_t* U = (bf16_t*)(ws + WS_U);
    bf16_t* PROJ = (bf16_t*)(ws + WS_PROJ); bf16_t* MIXED = (bf16_t*)(ws + WS_MIXED);

    p_mod(lds, a.in[1], a.in[3], a.in[4], a.in[5], mod, bid, G, tid);
    seam_arrive((unsigned*)(ws + WS_SEAM));
    p_transposes(lds, a, bid, G, tid, G == 256 ? 1 : 0);
    p_gwt(a.in[9], (bf16_t*)(ws + WS_GWT), bid, G, tid);
    p_rgpar(a.in[10], a.in[11], (float*)(ws + WS_RGPAR), bid, G, tid);
    seam_wait((unsigned*)(ws + WS_SEAM), (unsigned*)(ws + WS_BAR), (unsigned)G);
    FRESH_TID();
    p_u(a.in[0], a.in[2], mod, U, bid, G, tid);
    p_wrt(a, bid, G, tid);
    GRID_BAR();
    FRESH_TID();
    { pg8::Gemm g{U, (const bf16_t*)(ws + WS_WINT), TA, NIN, DM}; pg8::InProjOrder S; S.init(G, bid);
      pg8::EpiInProj E{PROJ, 0, 0};
      pg8::gemm_phase<pg8::EpiInProj, pg8::InProjOrder, true, true>(lds, g, S, E); }
    if (G == 256 && bid >= 128) { FRESH_TID(); p_transposes(lds, a, bid, G, tid, 2); }
    GRID_BAR();
    FRESH_TID();
    p_scan_a(lds, a, bid, G, tid, wave, lane);
    GRID_BAR();
    FRESH_TID();
    p_scan_b(a, bid, G, tid);
    GRID_BAR();
    FRESH_TID();
    p_scan_c(lds, a, bid, G, tid, wave, lane);
    GRID_BAR();
    FRESH_TID();
    { pg8::Gemm g{MIXED, (const bf16_t*)(ws + WS_WOUTT), T, DM, DM}; pg8::StaticOrder S; S.init(T, DM, G, bid);
      pg8::EpiY E{(bf16_t*)(ws + WS_XG)};
      pg8::gemm_phase<pg8::EpiY, pg8::StaticOrder, true, true>(lds, g, S, E); }
    GRID_BAR();
    FRESH_TID();
    p_ln1_router(lds, a, bid, G, tid, wave, lane);
    GRID_BAR();
    FRESH_TID();
    p_assign(lds, a, bid, G, tid);
    GRID_BAR();
    FRESH_TID();
    { pg8::Gemm g{(const bf16_t*)(ws + WS_U2Q), (const bf16_t*)(ws + WS_W13T), MAXROWS, NE * DM, DM / 2}  ; pg8::ExpertOrderG S{(const int*)(ws + WS_RBPRE), (const int*)(ws + WS_ROWTOK), G, bid};
      pg8::EpiExp1 E{(bf16_t*)(ws + WS_HID)};
      pg8::gemm_phase<pg8::EpiExp1, pg8::ExpertOrderG, true, true, true>(lds, g, S, E); }
    GRID_BAR();
    FRESH_TID();
    { pg8::Gemm g{(const bf16_t*)(ws + WS_HID), (const bf16_t*)(ws + WS_W2T), MAXROWS, NE * DM, DE / 2}  ; pg8::ExpertOrder S{(const int*)(ws + WS_RBPRE), nullptr, G, bid};
      pg8::EpiY8 E{ws + WS_Y};
      pg8::gemm_phase<pg8::EpiY8, pg8::ExpertOrder, true, true, true>(lds, g, S, E); }
    GRID_BAR();
    FRESH_TID();
    p_combine_ln2(a, bid, G, wave, lane);
}

extern "C" void kernel_launch(void* const* d_in, const int* in_sizes, int n_in, void* d_out, int out_size, void* d_ws, size_t ws_size, hipStream_t stream) {
    static int grid = 0;
    if (grid == 0) {
        if (n_in != 26 || ws_size < WS_END) { fprintf(stderr, "kernel_launch: unexpected n_in %d or workspace %zu < %zu\n", n_in, ws_size, (size_t)WS_END); grid = -1; return; }
        int dev = 0, cus = 0, per_cu = 0;
        if (hipGetDevice(&dev) != hipSuccess || hipDeviceGetAttribute(&cus, hipDeviceAttributeMultiprocessorCount, dev) != hipSuccess) { grid = -1; return; }
        if (hipFuncSetAttribute((const void*)mega, hipFuncAttributeMaxDynamicSharedMemorySize, LDS_BYTES) != hipSuccess) { fprintf(stderr, "kernel_launch: hipFuncSetAttribute failed\n"); grid = -1; return; }
        if (hipOccupancyMaxActiveBlocksPerMultiprocessor(&per_cu, (const void*)mega, NTHREADS, LDS_BYTES) != hipSuccess || per_cu < 1) { fprintf(stderr, "kernel_launch: occupancy query says %d\n", per_cu); per_cu = 1; }
        (void)hipGetLastError();
        grid = cus;
        fprintf(stderr, "kernel_launch: grid %d (cus %d, per_cu %d), ws %zu\n", grid, cus, per_cu, ws_size);
    }
    if (grid < 0) return;
    (void)hipMemsetAsync(d_ws, 0, 131072, stream);
    Args a{};
    for (int i = 0; i < 26; ++i) a.in[i] = (const float*)d_in[i];
    a.out = (float*)d_out; a.ws = (unsigned char*)d_ws;
    void* params[] = {&a};
    hipError_t e = hipLaunchCooperativeKernel((const void*)mega, dim3(grid), dim3(NTHREADS), params, LDS_BYTES, stream);
    if (e != hipSuccess) fprintf(stderr, "kernel_launch: cooperative launch failed: %s (grid %d)\n", hipGetErrorString(e), grid);
}
```
